# Optimizing an MI355X kernel written in HIP

```python
import math
import jax
import jax.numpy as jnp
from jax import lax
import numpy as np

D_MODEL = 1024
BATCH = 4
SEQ = 4096
DEPTH = 4

CTX_LEN = 256
GRID_W = 64

MLA_HEADS = 4
MLA_NOPE = 128
MLA_ROPE = 64
MLA_V = 128
MLA_Q_LORA = 256
MLA_KV_LORA = 128
RET_HEADS = 4
RET_DK = 128
RET_DV = 128
GDN_HEADS = 4
GDN_DK = 128
GDN_DV = 128
GDN_CONV = 5

MLA_W = MLA_HEADS * MLA_V
RET_W = RET_HEADS * RET_DV
GDN_W = GDN_HEADS * GDN_DV
MIX_W = MLA_W + RET_W + GDN_W
GDN_CONV_CH = 2 * GDN_HEADS * GDN_DK + GDN_W

IN_SIZES = (MLA_Q_LORA, MLA_KV_LORA, MLA_ROPE,
            RET_HEADS * RET_DK, RET_HEADS * RET_DK, RET_W, RET_W,
            GDN_HEADS * GDN_DK, GDN_HEADS * GDN_DK, GDN_W, GDN_W,
            2 * GDN_HEADS, 2 * GDN_HEADS)
IN_W = sum(IN_SIZES)

N_EXPERTS = 32
TOP_K = 4
D_EXPERT = 1024
SWIGLU_LIMIT = 7.0
SWIGLU_ALPHA = 1.702
MOE_BLOCK = 256

CHUNK = 64
Q_BLOCK = 128
ROPE_BASE = 10000.0
NORM_EPS = 1e-6

kernel_name = "hybrid_mla_retention_gdn_moe_dit"


def rms_norm(x, g, eps=NORM_EPS):
    xf = x.astype(jnp.float32)
    y = xf * lax.rsqrt(jnp.mean(xf * xf, -1, keepdims=True) + eps)
    return (y * g.astype(jnp.float32)).astype(x.dtype)


def l2norm(a, eps=1e-6):
    return a * lax.rsqrt(jnp.sum(a * a, -1, keepdims=True) + eps)


def axial_rope(x, rows, cols):
    d = x.shape[-1]
    half = d // 2
    quarter = half // 2
    inv = ROPE_BASE ** (-jnp.arange(quarter, dtype=jnp.float32) / quarter)
    xf = x.astype(jnp.float32)

    def rot(xh, p):
        ang = p.astype(jnp.float32)[:, None] * inv[None, :]
        cos = jnp.cos(ang)[None, :, None, :]
        sin = jnp.sin(ang)[None, :, None, :]
        x1, x2 = xh[..., :quarter], xh[..., quarter:]
        return jnp.concatenate([x1 * cos - x2 * sin, x2 * cos + x1 * sin], -1)

    out = jnp.concatenate([rot(xf[..., :half], rows), rot(xf[..., half:], cols)], -1)
    return out.astype(x.dtype)


def split_columns(p):
    idx = []
    acc = 0
    for sz in IN_SIZES[:-1]:
        acc += sz
        idx.append(acc)
    return jnp.split(p, idx, axis=-1)


def depthwise_conv(x, w):
    k = w.shape[0]
    return lax.conv_general_dilated(x, w[:, None, :], window_strides=(1,), padding=((k // 2, k // 2),),
                                    dimension_numbers=('NWC', 'WIO', 'NWC'), feature_group_count=x.shape[-1])


def softmax_attend(q, k, v):
    s = jnp.einsum('bqhd,bkhd->bhqk', q, k).astype(jnp.float32) * (q.shape[-1] ** -0.5)
    p = jax.nn.softmax(s, axis=-1).astype(v.dtype)
    return jnp.einsum('bhqk,bkhd->bqhd', p, v)


def mla_qkv(dq, dkv, kr, g_cq, g_ckv, w_uq, w_ukv, pos):
    b, t = dq.shape[:2]
    q = (rms_norm(dq, g_cq) @ w_uq).reshape(b, t, MLA_HEADS, MLA_NOPE + MLA_ROPE)
    kv = (rms_norm(dkv, g_ckv) @ w_ukv).reshape(b, t, MLA_HEADS, MLA_NOPE + MLA_V)
    q_nope, q_rope = q[..., :MLA_NOPE], q[..., MLA_NOPE:]
    k_nope, v = kv[..., :MLA_NOPE], kv[..., MLA_NOPE:]
    k_rope = kr[:, :, None, :]
    if pos is not None:
        q_rope = axial_rope(q_rope, pos[0], pos[1])
        k_rope = axial_rope(k_rope, pos[0], pos[1])
    k_rope = jnp.broadcast_to(k_rope, (b, t, MLA_HEADS, MLA_ROPE))
    return (jnp.concatenate([q_nope, q_rope], -1), jnp.concatenate([k_nope, k_rope], -1), v)


def mla_mixer(pc, pl, pos, g_cq, g_ckv, w_uq, w_ukv, g_out):
    q_c, k_c, v_c = mla_qkv(pc[0], pc[1], pc[2], g_cq, g_ckv, w_uq, w_ukv, None)
    q_l, k_l, v_l = mla_qkv(pl[0], pl[1], pl[2], g_cq, g_ckv, w_uq, w_ukv, pos)
    b, s = q_l.shape[:2]
    o_c = softmax_attend(q_c, k_c, v_c).reshape(b, -1, MLA_W)
    k_all = jnp.concatenate([k_c, k_l], 1)
    v_all = jnp.concatenate([v_c, v_l], 1)
    nb = s // Q_BLOCK
    q_blocks = jnp.moveaxis(q_l.reshape(b, nb, Q_BLOCK, MLA_HEADS, -1), 1, 0)
    o_l = lax.map(lambda qb: softmax_attend(qb, k_all, v_all), q_blocks)
    o_l = jnp.moveaxis(o_l, 0, 1).reshape(b, s, MLA_W)
    return rms_norm(o_c, g_out), rms_norm(o_l, g_out)


def flip_t(arrs):
    return tuple(jnp.flip(a, 1) for a in arrs)


def prefix_bidirectional(scan_f, scan_b, ctx_f, ctx_b, lat_f, lat_b, s0):
    o_cf, s_cf = scan_f(*ctx_f, s0)
    o_cb, s_cb = scan_b(*flip_t(ctx_b), s0)
    o_lf, _ = scan_f(*lat_f, s_cf)
    o_lb, _ = scan_b(*flip_t(lat_b), s_cb)
    return o_cf + jnp.flip(o_cb, 1), o_lf + jnp.flip(o_lb, 1)


def retention_chunked(q, k, v, log_gamma, s0):
    b, t, h, dk = q.shape
    dv = v.shape[-1]
    n = t // CHUNK
    qc = q.reshape(b, n, CHUNK, h, dk)
    kc = k.reshape(b, n, CHUNK, h, dk)
    vc = v.reshape(b, n, CHUNK, h, dv)
    pos = jnp.arange(CHUNK, dtype=jnp.float32)
    diff = pos[:, None] - pos[None, :]
    decay = jnp.where(diff >= 0, jnp.exp(log_gamma[:, None, None] * jnp.maximum(diff, 0.0)), 0.0)
    scores = jnp.einsum('bnihd,bnjhd->bnhij', qc, kc) * decay
    o_inner = jnp.einsum('bnhij,bnjhe->bnihe', scores, vc)
    k_w = jnp.exp(log_gamma[None, :] * (CHUNK - 1.0 - pos)[:, None])
    u = jnp.einsum('bnjhd,jh,bnjhe->nbhde', kc, k_w, vc)
    chunk_decay = jnp.exp(log_gamma * CHUNK)[None, :, None, None]

    def step(s, u_c):
        return chunk_decay * s + u_c, s

    s_fin, s_prev = lax.scan(step, s0, u)
    q_w = jnp.exp(log_gamma[None, :] * (pos + 1.0)[:, None])
    o_cross = jnp.einsum('bnihd,ih,nbhde->bnihe', qc, q_w, s_prev)
    return (o_inner + o_cross).reshape(b, t, h, dv), s_fin


def head_group_norm(o, g, eps=1e-5):
    b, t, h, dv = o.shape
    mu = jnp.mean(o, -1, keepdims=True)
    var = jnp.mean(jnp.square(o - mu), -1, keepdims=True)
    return ((o - mu) * lax.rsqrt(var + eps)).reshape(b, t, h * dv) * g.astype(jnp.float32)


def retention_mixer(pc, pl, pos, ret_decay, g_out):
    f32 = lambda a: a.astype(jnp.float32)

    def heads(a, d):
        return a.reshape(a.shape[0], a.shape[1], RET_HEADS, d)

    ql = axial_rope(heads(pl[0], RET_DK), pos[0], pos[1])
    kl = axial_rope(heads(pl[1], RET_DK), pos[0], pos[1])
    scale = RET_DK ** -0.5
    ctx_seq = (f32(heads(pc[0], RET_DK)), f32(heads(pc[1], RET_DK)) * scale, f32(heads(pc[2], RET_DV)))
    lat_seq = (f32(ql), f32(kl) * scale, f32(heads(pl[2], RET_DV)))
    log_gamma = jnp.log1p(-jnp.exp(ret_decay.astype(jnp.float32)))
    scan_f = lambda q, k, v, s: retention_chunked(q, k, v, log_gamma[0], s)
    scan_b = lambda q, k, v, s: retention_chunked(q, k, v, log_gamma[1], s)
    s0 = jnp.zeros((pl[0].shape[0], RET_HEADS, RET_DK, RET_DV), jnp.float32)
    o_c, o_l = prefix_bidirectional(scan_f, scan_b, ctx_seq, ctx_seq, lat_seq, lat_seq, s0)
    out_c = (head_group_norm(o_c, g_out) * jax.nn.silu(f32(pc[3]))).astype(pc[3].dtype)
    out_l = (head_group_norm(o_l, g_out) * jax.nn.silu(f32(pl[3]))).astype(pl[3].dtype)
    return out_c, out_l


def unit_lower_inverse(a):
    c = a.shape[-1]
    eye = jnp.eye(c, dtype=a.dtype)
    p = -a
    t = eye + p
    for _ in range(int(math.log2(c)) - 1):
        p = p @ p
        t = t @ (eye + p)
    return t


def gated_delta_chunked(q, k, v, log_a, beta, s0):
    b, t, h, dk = q.shape
    dv = v.shape[-1]
    n = t // CHUNK

    def chunks(a):
        return jnp.moveaxis(a.reshape((b, n, CHUNK) + a.shape[2:]), 2, 3)

    qc, kc, vc = chunks(q), chunks(k), chunks(v)
    bc = chunks(beta)
    g = jnp.cumsum(chunks(log_a), axis=-1)
    lower = jnp.tril(jnp.ones((CHUNK, CHUNK), bool))
    strict = jnp.tril(jnp.ones((CHUNK, CHUNK), bool), -1)
    gdiff = g[..., :, None] - g[..., None, :]
    decay = jnp.where(lower, jnp.exp(jnp.where(lower, gdiff, 0.0)), 0.0)
    kb = kc * bc[..., None]
    a_mat = jnp.where(strict, jnp.einsum('bnhid,bnhjd->bnhij', kb, kc) * decay, 0.0)
    tmat = unit_lower_inverse(a_mat)
    u = tmat @ (vc * bc[..., None])
    w = tmat @ (kb * jnp.exp(g)[..., None])
    attn = jnp.where(lower, jnp.einsum('bnhid,bnhjd->bnhij', qc, kc) * decay, 0.0)
    q_in = qc * jnp.exp(g)[..., None]
    g_last = g[..., -1]
    k_tail = kc * jnp.exp(g_last[..., None] - g)[..., None]

    def step(s, xs):
        u_c, w_c, a_c, qi_c, kt_c, gl_c = xs
        v_new = u_c - w_c @ s
        o = qi_c @ s + a_c @ v_new
        s = s * jnp.exp(gl_c)[..., None, None] + jnp.swapaxes(kt_c, -1, -2) @ v_new
        return s, o

    xs = tuple(jnp.moveaxis(a, 1, 0) for a in (u, w, attn, q_in, k_tail, g_last))
    s_fin, o = lax.scan(step, s0, xs)
    o = jnp.moveaxis(jnp.moveaxis(o, 0, 1), 3, 2).reshape(b, t, h, dv)
    return o, s_fin


def gdn_prepare(q, k, v, a, bg, conv_w, a_log, dt_bias):
    bsz, t = q.shape[:2]
    f32 = jnp.float32
    qkv = jax.nn.silu(depthwise_conv(jnp.concatenate([q, k, v], -1), conv_w)).astype(f32)
    nq = GDN_HEADS * GDN_DK
    qh = l2norm(qkv[..., :nq].reshape(bsz, t, GDN_HEADS, GDN_DK)) * (GDN_DK ** -0.5)
    kh = l2norm(qkv[..., nq:2 * nq].reshape(bsz, t, GDN_HEADS, GDN_DK))
    vh = qkv[..., 2 * nq:].reshape(bsz, t, GDN_HEADS, GDN_DV)
    log_a = -jnp.exp(a_log.astype(f32)) * jax.nn.softplus(a.astype(f32).reshape(bsz, t, 2, GDN_HEADS) + dt_bias.astype(f32))
    beta = jax.nn.sigmoid(bg.astype(f32).reshape(bsz, t, 2, GDN_HEADS))
    fwd = (qh, kh, vh, log_a[:, :, 0], beta[:, :, 0])
    bwd = (qh, kh, vh, log_a[:, :, 1], beta[:, :, 1])
    return fwd, bwd


def gdn_mixer(pc, pl, conv_w, a_log, dt_bias, g_out):
    cf, cb = gdn_prepare(pc[0], pc[1], pc[2], pc[4], pc[5], conv_w, a_log, dt_bias)
    lf, lb = gdn_prepare(pl[0], pl[1], pl[2], pl[4], pl[5], conv_w, a_log, dt_bias)
    s0 = jnp.zeros((pl[0].shape[0], GDN_HEADS, GDN_DK, GDN_DV), jnp.float32)
    o_c, o_l = prefix_bidirectional(gated_delta_chunked, gated_delta_chunked, cf, cb, lf, lb, s0)

    def gated_norm(o, z):
        bsz, t = o.shape[:2]
        zf = z.astype(jnp.float32).reshape(bsz, t, GDN_HEADS, GDN_DV)
        y = o * lax.rsqrt(jnp.mean(o * o, -1, keepdims=True) + NORM_EPS) * g_out.astype(jnp.float32) * jax.nn.silu(zf)
        return y.reshape(bsz, t, GDN_W).astype(z.dtype)

    return gated_norm(o_c, pc[3]), gated_norm(o_l, pl[3])


def token_mixer(h_ctx, h_lat, pos, w_in, g_cq, g_ckv, w_uq, w_ukv, g_mla, ret_decay, g_ret,
                gdn_conv, gdn_a_log, gdn_dt_bias, g_gdn, w_out):
    pc = split_columns(h_ctx @ w_in)
    pl = split_columns(h_lat @ w_in)
    mc, ml = mla_mixer(pc[0:3], pl[0:3], pos, g_cq, g_ckv, w_uq, w_ukv, g_mla)
    rc, rl = retention_mixer(pc[3:7], pl[3:7], pos, ret_decay, g_ret)
    gc, gl = gdn_mixer(pc[7:13], pl[7:13], gdn_conv, gdn_a_log, gdn_dt_bias, g_gdn)
    o_ctx = jnp.concatenate([mc, rc, gc], -1) @ w_out
    o_lat = jnp.concatenate([ml, rl, gl], -1) @ w_out
    return o_ctx, o_lat


def moe_ffn(h, w_router, b_router, w_gu, b_gu, w_dn, b_dn):
    n_tok, d = h.shape
    e_n = w_router.shape[-1]
    logits = (h @ w_router).astype(jnp.float32) + b_router.astype(jnp.float32)
    top_val, top_idx = lax.top_k(logits, TOP_K)
    gate_w = jax.nn.softmax(top_val, axis=-1).astype(h.dtype)
    nk = n_tok * TOP_K
    e_flat = top_idx.reshape(-1)
    tok_flat = jnp.arange(nk, dtype=jnp.int32) // TOP_K
    order = jnp.argsort(e_flat)
    e_sorted = e_flat[order]
    counts = jnp.zeros((e_n,), jnp.int32).at[e_flat].add(1)
    padded = (counts + MOE_BLOCK - 1) // MOE_BLOCK * MOE_BLOCK
    start = jnp.cumsum(counts) - counts
    pend = jnp.cumsum(padded)
    pstart = pend - padded
    dest_sorted = pstart[e_sorted] + (jnp.arange(nk, dtype=jnp.int32) - start[e_sorted])
    n_blocks = -(-nk // MOE_BLOCK) + e_n
    rows_p = n_blocks * MOE_BLOCK
    row_tok = jnp.full((rows_p,), n_tok, jnp.int32).at[dest_sorted].set(tok_flat[order])
    h_pad = jnp.concatenate([h, jnp.zeros((1, d), h.dtype)], 0)
    xs = h_pad[row_tok].reshape(n_blocks, MOE_BLOCK, d)
    block_e = jnp.minimum(jnp.searchsorted(pend, jnp.arange(n_blocks, dtype=jnp.int32) * MOE_BLOCK, side='right'), e_n - 1)

    def expert_block(args):
        xb, e = args
        gu = xb @ w_gu[e] + b_gu[e]
        gate = jnp.minimum(gu[:, :D_EXPERT], SWIGLU_LIMIT)
        up = jnp.clip(gu[:, D_EXPERT:], -SWIGLU_LIMIT, SWIGLU_LIMIT)
        act = (up + 1.0) * (gate * jax.nn.sigmoid(gate * SWIGLU_ALPHA))
        return act @ w_dn[e] + b_dn[e]

    ys = lax.map(expert_block, (xs, block_e)).reshape(rows_p, d)
    dest_slot = jnp.zeros((nk,), jnp.int32).at[order].set(dest_sorted)
    y = ys[dest_slot].reshape(n_tok, TOP_K, d)
    return jnp.einsum('nkd,nk->nd', y, gate_w)


def setup_inputs(seed: int = 0) -> dict:
    key = jax.random.key(seed)
    ks = jax.random.split(key, 28)
    f32 = jnp.float32
    nrm = lambda k, shape, scale: jax.random.normal(k, shape, f32) * scale
    gain = lambda k, shape: 1.0 + 0.02 * jax.random.normal(k, shape, f32)
    L, D, E, F = DEPTH, D_MODEL, N_EXPERTS, D_EXPERT
    ret_base = -math.log(2.0) * (5.0 + jnp.arange(RET_HEADS, dtype=f32))
    dt = jnp.exp(jax.random.uniform(ks[18], (L, 2, GDN_HEADS), f32, math.log(1e-3), math.log(1e-1)))
    return {
        'x': nrm(ks[0], (BATCH, SEQ, D), 1.0),
        'c': nrm(ks[1], (BATCH, D), 1.0),
        'ctx': nrm(ks[2], (BATCH, CTX_LEN, D), 1.0),
        'c_ctx': nrm(ks[3], (D,), 1.0),
        'w_mod': nrm(ks[4], (L, D, 6 * D), 0.5 * D ** -0.5),
        'b_mod': nrm(ks[5], (L, 6 * D), 0.02),
        'g_norm1': gain(ks[6], (L, D)),
        'g_norm2': gain(ks[7], (L, D)),
        'w_in': nrm(ks[8], (L, D, IN_W), D ** -0.5),
        'g_cq': gain(ks[9], (L, MLA_Q_LORA)),
        'g_ckv': gain(ks[10], (L, MLA_KV_LORA)),
        'w_uq': nrm(ks[11], (L, MLA_Q_LORA, MLA_HEADS * (MLA_NOPE + MLA_ROPE)), MLA_Q_LORA ** -0.5),
        'w_ukv': nrm(ks[12], (L, MLA_KV_LORA, MLA_HEADS * (MLA_NOPE + MLA_V)), MLA_KV_LORA ** -0.5),
        'g_mla': gain(ks[13], (L, MLA_W)),
        'ret_decay': ret_base + nrm(ks[14], (L, 2, RET_HEADS), 0.1),
        'g_ret': gain(ks[15], (L, RET_W)),
        'gdn_conv': nrm(ks[16], (L, GDN_CONV, GDN_CONV_CH), GDN_CONV ** -0.5),
        'gdn_a_log': jnp.log(jax.random.uniform(ks[17], (L, 2, GDN_HEADS), f32, 1.0, 16.0)),
        'gdn_dt_bias': dt + jnp.log(-jnp.expm1(-dt)),
        'g_gdn': gain(ks[19], (L, GDN_DV)),
        'w_out': nrm(ks[20], (L, MIX_W, D), MIX_W ** -0.5),
        'w_router': nrm(ks[21], (L, D, E), D ** -0.5),
        'b_router': nrm(ks[22], (L, E), 0.01),
        'w_gate_up': nrm(ks[23], (L, E, D, 2 * F), D ** -0.5),
        'b_gate_up': nrm(ks[24], (L, E, 2 * F), 0.01),
        'w_down': nrm(ks[25], (L, E, F, D), F ** -0.5),
        'b_down': nrm(ks[26], (L, E, D), 0.01),
        'g_final': gain(ks[27], (D,)),
    }


def reference(x, c, ctx, c_ctx, w_mod, b_mod, g_norm1, g_norm2, w_in, g_cq, g_ckv, w_uq, w_ukv, g_mla,
              ret_decay, g_ret, gdn_conv, gdn_a_log, gdn_dt_bias, g_gdn, w_out, w_router, b_router,
              w_gate_up, b_gate_up, w_down, b_down, g_final):
    b, s, d = x.shape
    grid_rows = s // GRID_W
    rows = jnp.repeat(jnp.arange(grid_rows, dtype=jnp.int32), GRID_W)
    cols = jnp.tile(jnp.arange(GRID_W, dtype=jnp.int32), grid_rows)
    pos = (rows, cols)
    xc = ctx
    n_ctx_tok = b * ctx.shape[1]
    for l in range(DEPTH):
        last = l == DEPTH - 1
        mod_l = jax.nn.silu(c) @ w_mod[l] + b_mod[l]
        mod_c = jax.nn.silu(c_ctx) @ w_mod[l] + b_mod[l]
        sh1, sc1, gt1, sh2, sc2, gt2 = jnp.split(mod_l[:, None, :], 6, axis=-1)
        csh1, csc1, cgt1, csh2, csc2, cgt2 = jnp.split(mod_c, 6, axis=-1)
        h_l = rms_norm(x, g_norm1[l]) * (1.0 + sc1) + sh1
        h_c = rms_norm(xc, g_norm1[l]) * (1.0 + csc1) + csh1
        o_c, o_l = token_mixer(h_c, h_l, pos, w_in[l], g_cq[l], g_ckv[l], w_uq[l], w_ukv[l], g_mla[l],
                               ret_decay[l], g_ret[l], gdn_conv[l], gdn_a_log[l], gdn_dt_bias[l], g_gdn[l], w_out[l])
        x = x + gt1 * o_l
        h_l = rms_norm(x, g_norm2[l]) * (1.0 + sc2) + sh2
        if last:
            y = moe_ffn(h_l.reshape(-1, d), w_router[l], b_router[l], w_gate_up[l], b_gate_up[l], w_down[l], b_down[l])
            x = x + gt2 * y.reshape(b, s, d)
        else:
            xc = xc + cgt1 * o_c
            h_c = rms_norm(xc, g_norm2[l]) * (1.0 + csc2) + csh2
            tokens = jnp.concatenate([h_c.reshape(-1, d), h_l.reshape(-1, d)], 0)
            y = moe_ffn(tokens, w_router[l], b_router[l], w_gate_up[l], b_gate_up[l], w_down[l], b_down[l])
            xc = xc + cgt2 * y[:n_ctx_tok].reshape(xc.shape)
            x = x + gt2 * y[n_ctx_tok:].reshape(b, s, d)
    return rms_norm(x, g_final)
```

```cpp
#include <hip/hip_runtime.h>
#include <stdint.h>
#include <stdio.h>

namespace cfg {
constexpr int D = 1024, NB = 4, SEQ = 4096, DEPTH = 4, CTX = 256, GW = 64;
constexpr int SB = CTX + SEQ;
constexpr int T = NB * SB;
constexpr int INW = 4560;
constexpr int C_DQ = 0, C_DKV = 256, C_KR = 384, C_RQ = 448, C_RK = 960, C_RV = 1472, C_RG = 1984, C_GQ = 2496, C_GK = 3008, C_GV = 3520, C_GZ = 4032, C_GA = 4544, C_GB = 4552;
constexpr int NE = 32, TOPK = 4, DE = 1024;
}
namespace orc {
using namespace cfg;

__device__ __forceinline__ float silu_f(float v) { return v / (1.f + expf(-v)); }
__device__ __forceinline__ float sigm_f(float v) { return 1.f / (1.f + expf(-v)); }

__device__ __forceinline__ float block_sum256(float v, float* red) {
  for (int o = 32; o >= 1; o >>= 1) v += __shfl_xor(v, o);
  __syncthreads();
  if ((threadIdx.x & 63) == 0) red[threadIdx.x >> 6] = v;
  __syncthreads();
  float s = 0.f;
  for (int i = 0; i < (int)(blockDim.x >> 6); ++i) s += red[i];
  return s;
}

__global__ __launch_bounds__(256) void o_mod(const float* c, const float* c_ctx, const float* w_mod, const float* b_mod, float* MOD) {
  __shared__ float sc[5][1024];
  const int j = blockIdx.x * 256 + threadIdx.x, l = blockIdx.y;
  for (int i = threadIdx.x; i < 5 * 1024; i += 256) { int r = i >> 10, k = i & 1023; float v = r < 4 ? c[r * 1024 + k] : c_ctx[k]; sc[r][k] = silu_f(v); }
  __syncthreads();
  float acc[5] = {0.f, 0.f, 0.f, 0.f, 0.f};
  const float* w = w_mod + (size_t)l * 1024 * 6144 + j;
  for (int k = 0; k < 1024; ++k) { float wv = w[(size_t)k * 6144];
#pragma unroll
    for (int r = 0; r < 5; ++r) acc[r] += sc[r][k] * wv; }
#pragma unroll
  for (int r = 0; r < 5; ++r) MOD[(size_t)(l * 5 + r) * 6144 + j] = acc[r] + b_mod[l * 6144 + j];
}

__global__ __launch_bounds__(256) void o_init(const float* x, const float* ctx, float* X) {
  const int row = blockIdx.x, b = row / SB, s = row % SB;
  const float* src = s < CTX ? ctx + ((size_t)b * CTX + s) * D : x + ((size_t)b * SEQ + (s - CTX)) * D;
  for (int i = threadIdx.x; i < D; i += 256) X[(size_t)row * D + i] = src[i];
}

__global__ __launch_bounds__(256) void o_norm(const float* X, const float* g, const float* MODl, int off_sh, int off_sc, float* H) {
  __shared__ float red[8];
  const int row = blockIdx.x, b = row / SB, s = row % SB, r = s < CTX ? 4 : b;
  const float* x = X + (size_t)row * D; float v[4]; float ss = 0.f;
#pragma unroll
  for (int i = 0; i < 4; ++i) { v[i] = x[threadIdx.x + 256 * i]; ss += v[i] * v[i]; }
  ss = block_sum256(ss, red);
  const float rs = rsqrtf(ss * (1.f / 1024.f) + 1e-6f);
  const float* m = MODl + (size_t)r * 6144;
#pragma unroll
  for (int i = 0; i < 4; ++i) { int col = threadIdx.x + 256 * i; H[(size_t)row * D + col] = v[i] * rs * g[col] * (1.f + m[off_sc + col]) + m[off_sh + col]; }
}

struct GP { const float* A; const float* B; float* C; const float* bias; const int* gather; const int* cnt; const int* off;
  int M, N, K, lda, ldb, ldc; long sA1, sA2, sB1, sB2, sC1, sC2, sBias; int zdiv; int pad_; };

template <bool TB> __global__ __launch_bounds__(256) void o_gemm(GP p) {
  __shared__ float As[16][68], Bs[16][68];
  const int z = blockIdx.z, z1 = z / p.zdiv, z2 = z % p.zdiv;
  const float* A = p.A + z1 * p.sA1 + z2 * p.sA2; const float* B = p.B + z1 * p.sB1 + z2 * p.sB2; float* C = p.C + z1 * p.sC1 + z2 * p.sC2;
  const float* bias = p.bias ? p.bias + z * p.sBias : nullptr;
  int M = p.M, rowoff = 0; if (p.cnt) { M = p.cnt[z]; rowoff = p.off[z]; }
  const int m0 = blockIdx.y * 64, n0 = blockIdx.x * 64; if (m0 >= M) return;
  const int t = threadIdx.x, ty = t >> 4, tx = t & 15;
  const int ar = t >> 2, ak = (t & 3) * 4; const int gm = m0 + ar; const bool av = gm < M;
  long arow = 0; if (av) arow = p.gather ? (long)p.gather[rowoff + gm] : (long)(rowoff + gm);
  const float* Ap = A + arow * p.lda + ak;
  float acc[4][4] = {};
  for (int k0 = 0; k0 < p.K; k0 += 16) {
    float4 a4 = make_float4(0.f, 0.f, 0.f, 0.f); if (av) a4 = *(const float4*)(Ap + k0);
    As[ak + 0][ar] = a4.x; As[ak + 1][ar] = a4.y; As[ak + 2][ar] = a4.z; As[ak + 3][ar] = a4.w;
    if (!TB) { const int bk = t >> 4, bn = (t & 15) * 4; float4 b4 = make_float4(0.f, 0.f, 0.f, 0.f);
      if (n0 + bn < p.N) b4 = *(const float4*)(B + (long)(k0 + bk) * p.ldb + n0 + bn);
      Bs[bk][bn + 0] = b4.x; Bs[bk][bn + 1] = b4.y; Bs[bk][bn + 2] = b4.z; Bs[bk][bn + 3] = b4.w;
    } else { const int bn = t >> 2, bk = (t & 3) * 4; float4 b4 = make_float4(0.f, 0.f, 0.f, 0.f);
      if (n0 + bn < p.N) b4 = *(const float4*)(B + (long)(n0 + bn) * p.ldb + k0 + bk);
      Bs[bk + 0][bn] = b4.x; Bs[bk + 1][bn] = b4.y; Bs[bk + 2][bn] = b4.z; Bs[bk + 3][bn] = b4.w; }
    __syncthreads();
#pragma unroll
    for (int k = 0; k < 16; ++k) { float a[4], b[4];
#pragma unroll
      for (int i = 0; i < 4; ++i) { a[i] = As[k][ty * 4 + i]; b[i] = Bs[k][tx * 4 + i]; }
#pragma unroll
      for (int i = 0; i < 4; ++i)
#pragma unroll
        for (int j = 0; j < 4; ++j) acc[i][j] += a[i] * b[j]; }
    __syncthreads();
  }
#pragma unroll
  for (int i = 0; i < 4; ++i) { const int m = m0 + ty * 4 + i; if (m >= M) continue;
#pragma unroll
    for (int j = 0; j < 4; ++j) { const int n = n0 + tx * 4 + j; if (n < p.N) C[(long)(rowoff + m) * p.ldc + n] = acc[i][j] + (bias ? bias[n] : 0.f); } }
}

__global__ __launch_bounds__(256) void o_mla_prep(const float* P, const float* g_cq, const float* g_ckv, float* AQ, float* AKV) {
  __shared__ float red[8];
  const int row = blockIdx.x, t = threadIdx.x; const float* p = P + (size_t)row * INW;
  const float q = p[C_DQ + t]; const float s1 = block_sum256(q * q, red);
  AQ[(size_t)row * 256 + t] = q * rsqrtf(s1 * (1.f / 256.f) + 1e-6f) * g_cq[t];
  const float kv = t < 128 ? p[C_DKV + t] : 0.f; const float s2 = block_sum256(kv * kv, red);
  if (t < 128) AKV[(size_t)row * 128 + t] = kv * rsqrtf(s2 * (1.f / 128.f) + 1e-6f) * g_ckv[t];
}

__device__ __forceinline__ float rope_elem(const float* x, int i, int n, int prow, int pcol) {
  const int half = n / 2, quarter = n / 4; const int hh = i / half, ii = i % half; const int pos = hh == 0 ? prow : pcol;
  const int fi = ii % quarter; const float inv = expf(-(float)fi / (float)quarter * 9.210340371976184f);
  const float ang = (float)pos * inv; const float cs = cosf(ang), sn = sinf(ang);
  const float* xh = x + hh * half;
  return ii < quarter ? xh[ii] * cs - xh[ii + quarter] * sn : xh[ii] * cs + xh[ii - quarter] * sn;
}

__global__ __launch_bounds__(256) void o_mla_asm(const float* P, const float* QRAW, const float* KVRAW, float* Q, float* K, float* V) {
  const int row = blockIdx.x, s = row % SB, t = threadIdx.x; const bool lat = s >= CTX; const int tok = s - CTX, prow = tok / GW, pcol = tok % GW;
  for (int i = t; i < 768; i += 256) { const int h = i / 192, d = i % 192; float v;
    if (d < 128) v = QRAW[(size_t)row * 768 + i];
    else { const float* xr = QRAW + (size_t)row * 768 + h * 192 + 128; v = lat ? rope_elem(xr, d - 128, 64, prow, pcol) : xr[d - 128]; }
    Q[(size_t)row * 768 + i] = v; }
  for (int i = t; i < 768; i += 256) { const int h = i / 192, d = i % 192; float v;
    if (d < 128) v = KVRAW[(size_t)row * 1024 + h * 256 + d];
    else { const float* xr = P + (size_t)row * INW + C_KR; v = lat ? rope_elem(xr, d - 128, 64, prow, pcol) : xr[d - 128]; }
    K[(size_t)row * 768 + i] = v; }
  for (int i = t; i < 512; i += 256) { const int h = i / 128, d = i % 128; V[(size_t)row * 512 + i] = KVRAW[(size_t)row * 1024 + h * 256 + 128 + d]; }
}

__global__ __launch_bounds__(256) void o_softmax(float* S, int N, long ld, float scale) {
  __shared__ float red[8];
  float* s = S + (size_t)blockIdx.x * ld; float mx = -3.0e38f;
  for (int i = threadIdx.x; i < N; i += 256) mx = fmaxf(mx, s[i] * scale);
  for (int o = 32; o >= 1; o >>= 1) mx = fmaxf(mx, __shfl_xor(mx, o));
  __syncthreads(); if ((threadIdx.x & 63) == 0) red[threadIdx.x >> 6] = mx; __syncthreads();
  mx = fmaxf(fmaxf(red[0], red[1]), fmaxf(red[2], red[3]));
  float sum = 0.f;
  for (int i = threadIdx.x; i < N; i += 256) { float e = expf(s[i] * scale - mx); s[i] = e; sum += e; }
  sum = block_sum256(sum, red);
  const float inv = 1.f / sum;
  for (int i = threadIdx.x; i < N; i += 256) s[i] *= inv;
}

__global__ __launch_bounds__(256) void o_mla_out(const float* AO, const float* g_mla, float* CAT) {
  __shared__ float red[8];
  const int row = blockIdx.x, t = threadIdx.x; const float a = AO[(size_t)row * 512 + t], b = AO[(size_t)row * 512 + 256 + t];
  const float ss = block_sum256(a * a + b * b, red); const float rs = rsqrtf(ss * (1.f / 512.f) + 1e-6f);
  CAT[(size_t)row * 1536 + t] = a * rs * g_mla[t]; CAT[(size_t)row * 1536 + 256 + t] = b * rs * g_mla[256 + t];
}

__global__ __launch_bounds__(256) void o_ret_prep(const float* P, float* RQ, float* RK) {
  const int row = blockIdx.x, s = row % SB, t = threadIdx.x; const bool lat = s >= CTX; const int tok = s - CTX, prow = tok / GW, pcol = tok % GW;
  for (int i = t; i < 512; i += 256) { const int h = i / 128, d = i % 128;
    const float* xq = P + (size_t)row * INW + C_RQ + h * 128; const float* xk = P + (size_t)row * INW + C_RK + h * 128;
    RQ[(size_t)row * 512 + i] = lat ? rope_elem(xq, d, 128, prow, pcol) : xq[d];
    RK[(size_t)row * 512 + i] = (lat ? rope_elem(xk, d, 128, prow, pcol) : xk[d]) * 0.08838834764831845f; }
}

template <bool GDN> __global__ __launch_bounds__(128) void o_recur(const float* Qp, int ldq, const float* Kp, int ldk, const float* Vp, int ldv,
                                                                   const float* LA, const float* BT, const float* ret_decay, float* O) {
  __shared__ float sq[128], sk[128];
  const int z = blockIdx.x, dir = z & 1, h = (z >> 1) & 3, b = z >> 3, e = threadIdx.x;
  float S[128];
#pragma unroll
  for (int d = 0; d < 128; ++d) S[d] = 0.f;
  const float gamma = GDN ? 0.f : 1.f - expf(ret_decay[dir * 4 + h]);
  for (int step = 0; step < SB; ++step) {
    const int s = dir == 0 ? step : (step < CTX ? CTX - 1 - step : SB - 1 - (step - CTX));
    const size_t row = (size_t)b * SB + s;
    __syncthreads();
    sq[e] = Qp[row * ldq + h * 128 + e]; sk[e] = Kp[row * ldk + h * 128 + e];
    const float v = Vp[row * ldv + h * 128 + e];
    __syncthreads();
    float o = 0.f;
    if (GDN) { const float a = expf(LA[row * 8 + dir * 4 + h]), bt = BT[row * 8 + dir * 4 + h]; float r = 0.f;
#pragma unroll
      for (int d = 0; d < 128; ++d) { S[d] *= a; r += S[d] * sk[d]; }
      const float vn = bt * (v - r);
#pragma unroll
      for (int d = 0; d < 128; ++d) { S[d] += sk[d] * vn; o += S[d] * sq[d]; }
    } else {
#pragma unroll
      for (int d = 0; d < 128; ++d) { S[d] = gamma * S[d] + sk[d] * v; o += S[d] * sq[d]; }
    }
    O[((size_t)dir * T + row) * 512 + h * 128 + e] = o;
  }
}

__global__ __launch_bounds__(256) void o_ret_post(const float* RO, const float* P, const float* g_ret, float* CAT) {
  const int row = blockIdx.x, h = threadIdx.x >> 6, lane = threadIdx.x & 63;
  float o[2]; float sm = 0.f;
#pragma unroll
  for (int i = 0; i < 2; ++i) { const int c = h * 128 + lane + 64 * i; o[i] = RO[(size_t)row * 512 + c] + RO[((size_t)T + row) * 512 + c]; sm += o[i]; }
  for (int k = 32; k >= 1; k >>= 1) sm += __shfl_xor(sm, k);
  const float mu = sm * (1.f / 128.f); float vq = 0.f;
#pragma unroll
  for (int i = 0; i < 2; ++i) vq += (o[i] - mu) * (o[i] - mu);
  for (int k = 32; k >= 1; k >>= 1) vq += __shfl_xor(vq, k);
  const float rs = rsqrtf(vq * (1.f / 128.f) + 1e-5f);
#pragma unroll
  for (int i = 0; i < 2; ++i) { const int c = h * 128 + lane + 64 * i; const float g = P[(size_t)row * INW + C_RG + c];
    CAT[(size_t)row * 1536 + 512 + c] = (o[i] - mu) * rs * g_ret[c] * silu_f(g); }
}

__global__ __launch_bounds__(256) void o_gdn_prep(const float* P, const float* conv_w, const float* a_log, const float* dt_bias,
                                                  float* GQ, float* GK, float* GV, float* LA, float* BT) {
  __shared__ float sv[1536];
  const int row = blockIdx.x, s = row % SB, t = threadIdx.x; const bool lat = s >= CTX; const int lo = lat ? CTX : 0, hi = lat ? SB : CTX;
  for (int c = t; c < 1536; c += 256) { float acc = 0.f;
#pragma unroll
    for (int j = 0; j < 5; ++j) { const int s2 = s + j - 2; if (s2 >= lo && s2 < hi) acc += conv_w[j * 1536 + c] * P[(size_t)(row + j - 2) * INW + C_GQ + c]; }
    sv[c] = silu_f(acc); }
  __syncthreads();
  const int h = t >> 6, lane = t & 63;
  { float a0 = sv[h * 128 + lane], a1 = sv[h * 128 + lane + 64]; float ss = a0 * a0 + a1 * a1; for (int k = 32; k >= 1; k >>= 1) ss += __shfl_xor(ss, k);
    const float rs = rsqrtf(ss + 1e-6f) * 0.08838834764831845f; GQ[(size_t)row * 512 + h * 128 + lane] = a0 * rs; GQ[(size_t)row * 512 + h * 128 + lane + 64] = a1 * rs; }
  { float a0 = sv[512 + h * 128 + lane], a1 = sv[512 + h * 128 + lane + 64]; float ss = a0 * a0 + a1 * a1; for (int k = 32; k >= 1; k >>= 1) ss += __shfl_xor(ss, k);
    const float rs = rsqrtf(ss + 1e-6f); GK[(size_t)row * 512 + h * 128 + lane] = a0 * rs; GK[(size_t)row * 512 + h * 128 + lane + 64] = a1 * rs; }
  GV[(size_t)row * 512 + t] = sv[1024 + t]; GV[(size_t)row * 512 + 256 + t] = sv[1024 + 256 + t];
  if (t < 8) { const float a = P[(size_t)row * INW + C_GA + t] + dt_bias[t]; const float sp = a > 20.f ? a : log1pf(expf(a));
    LA[(size_t)row * 8 + t] = -expf(a_log[t]) * sp; BT[(size_t)row * 8 + t] = sigm_f(P[(size_t)row * INW + C_GB + t]); }
}

__global__ __launch_bounds__(256) void o_gdn_post(const float* GO, const float* P, const float* g_gdn, float* CAT) {
  const int row = blockIdx.x, h = threadIdx.x >> 6, lane = threadIdx.x & 63;
  float o[2]; float ss = 0.f;
#pragma unroll
  for (int i = 0; i < 2; ++i) { const int c = h * 128 + lane + 64 * i; o[i] = GO[(size_t)row * 512 + c] + GO[((size_t)T + row) * 512 + c]; ss += o[i] * o[i]; }
  for (int k = 32; k >= 1; k >>= 1) ss += __shfl_xor(ss, k);
  const float rs = rsqrtf(ss * (1.f / 128.f) + 1e-6f);
#pragma unroll
  for (int i = 0; i < 2; ++i) { const int c = h * 128 + lane + 64 * i; const float zz = P[(size_t)row * INW + C_GZ + c];
    CAT[(size_t)row * 1536 + 1024 + c] = o[i] * rs * g_gdn[lane + 64 * i] * silu_f(zz); }
}

__global__ __launch_bounds__(256) void o_resid(float* X, const float* TMP, const float* MODl, int off_gt) {
  const int row = blockIdx.x, b = row / SB, s = row % SB, r = s < CTX ? 4 : b; const float* m = MODl + (size_t)r * 6144 + off_gt;
  for (int i = threadIdx.x; i < D; i += 256) X[(size_t)row * D + i] += m[i] * TMP[(size_t)row * D + i];
}

__global__ __launch_bounds__(256) void o_topk(const float* LOG, int* TOPI, float* TOPW, int* TOPP, int* cnt) {
  const int tok = blockIdx.x * 256 + threadIdx.x; if (tok >= T) return;
  float v[32];
#pragma unroll
  for (int i = 0; i < 32; ++i) v[i] = LOG[(size_t)tok * 32 + i];
  int idx[4]; float val[4];
#pragma unroll
  for (int k = 0; k < 4; ++k) { float best = -3.0e38f; int bi = 0;
#pragma unroll
    for (int i = 0; i < 32; ++i) { if (v[i] > best) { best = v[i]; bi = i; } }
    idx[k] = bi; val[k] = best;
#pragma unroll
    for (int i = 0; i < 32; ++i) if (i == bi) v[i] = -3.0e38f; }
  float e[4], sum = 0.f;
#pragma unroll
  for (int k = 0; k < 4; ++k) { e[k] = expf(val[k] - val[0]); sum += e[k]; }
#pragma unroll
  for (int k = 0; k < 4; ++k) { TOPI[tok * 4 + k] = idx[k]; TOPW[tok * 4 + k] = e[k] / sum; TOPP[tok * 4 + k] = atomicAdd(&cnt[idx[k]], 1); }
}
__global__ void o_offsets(const int* cnt, int* off) { if (threadIdx.x == 0) { int a = 0; for (int e = 0; e < NE; ++e) { off[e] = a; a += cnt[e]; } } }
__global__ __launch_bounds__(256) void o_scatter(const int* TOPI, const int* TOPP, const int* off, int* LIST, int* SLOT) {
  const int i = blockIdx.x * 256 + threadIdx.x; if (i >= T * 4) return;
  const int slot = off[TOPI[i]] + TOPP[i]; LIST[slot] = i >> 2; SLOT[i] = slot;
}
__global__ __launch_bounds__(256) void o_act(const float* GU, float* ACT) {
  const size_t r = blockIdx.x; for (int j = threadIdx.x; j < 1024; j += 256) {
    const float g = fminf(GU[r * 2048 + j], 7.f), u = fminf(fmaxf(GU[r * 2048 + 1024 + j], -7.f), 7.f);
    ACT[r * 1024 + j] = (u + 1.f) * (g * sigm_f(g * 1.702f)); }
}
__global__ __launch_bounds__(256) void o_combine(float* X, const float* Y, const int* SLOT, const float* TOPW, const float* MODl, int off_gt) {
  const int row = blockIdx.x, b = row / SB, s = row % SB, r = s < CTX ? 4 : b; const float* m = MODl + (size_t)r * 6144 + off_gt;
  int sl[4]; float w[4];
#pragma unroll
  for (int k = 0; k < 4; ++k) { sl[k] = SLOT[row * 4 + k]; w[k] = TOPW[row * 4 + k]; }
  for (int i = threadIdx.x; i < D; i += 256) { float y = 0.f;
#pragma unroll
    for (int k = 0; k < 4; ++k) y += w[k] * Y[(size_t)sl[k] * 1024 + i];
    X[(size_t)row * D + i] += m[i] * y; }
}
__global__ __launch_bounds__(256) void o_final(const float* X, const float* g, float* out) {
  __shared__ float red[8];
  const int orow = blockIdx.x, b = orow / SEQ, t = orow % SEQ; const float* x = X + ((size_t)b * SB + CTX + t) * D; float v[4]; float ss = 0.f;
#pragma unroll
  for (int i = 0; i < 4; ++i) { v[i] = x[threadIdx.x + 256 * i]; ss += v[i] * v[i]; }
  ss = block_sum256(ss, red); const float rs = rsqrtf(ss * (1.f / 1024.f) + 1e-6f);
#pragma unroll
  for (int i = 0; i < 4; ++i) { int col = threadIdx.x + 256 * i; out[(size_t)orow * D + col] = v[i] * rs * g[col]; }
}

struct OWs { float *MOD, *X, *H, *P, *AQ, *AKV, *QRAW, *KVRAW, *Q, *K, *V, *AO, *CAT, *RQ, *RK, *RO, *GQ, *GK, *GV, *LA, *BT, *GO, *TMP, *LOG, *TOPW, *S, *GU, *ACT, *Y;
  int *TOPI, *TOPP, *cnt, *off, *LIST, *SLOT; };

static size_t o_layout(char* base, OWs& w) {
  size_t o = 0; auto take = [&](size_t bytes) { char* p = base + o; o += (bytes + 255) & ~(size_t)255; return p; };
  w.MOD = (float*)take((size_t)DEPTH * 5 * 6144 * 4);
  w.X = (float*)take((size_t)T * D * 4); w.H = (float*)take((size_t)T * D * 4); w.P = (float*)take((size_t)T * INW * 4);
  w.AQ = (float*)take((size_t)T * 256 * 4); w.AKV = (float*)take((size_t)T * 128 * 4);
  w.QRAW = (float*)take((size_t)T * 768 * 4); w.KVRAW = (float*)take((size_t)T * 1024 * 4);
  w.Q = (float*)take((size_t)T * 768 * 4); w.K = (float*)take((size_t)T * 768 * 4); w.V = (float*)take((size_t)T * 512 * 4);
  w.AO = (float*)take((size_t)T * 512 * 4); w.CAT = (float*)take((size_t)T * 1536 * 4);
  w.RQ = (float*)take((size_t)T * 512 * 4); w.RK = (float*)take((size_t)T * 512 * 4); w.RO = (float*)take((size_t)2 * T * 512 * 4);
  w.GQ = (float*)take((size_t)T * 512 * 4); w.GK = (float*)take((size_t)T * 512 * 4); w.GV = (float*)take((size_t)T * 512 * 4);
  w.LA = (float*)take((size_t)T * 8 * 4); w.BT = (float*)take((size_t)T * 8 * 4); w.GO = (float*)take((size_t)2 * T * 512 * 4);
  w.TMP = (float*)take((size_t)T * D * 4); w.LOG = (float*)take((size_t)T * 32 * 4); w.TOPW = (float*)take((size_t)T * 4 * 4);
  w.TOPI = (int*)take((size_t)T * 4 * 4); w.TOPP = (int*)take((size_t)T * 4 * 4); w.cnt = (int*)take(256); w.off = (int*)take(256);
  w.LIST = (int*)take((size_t)T * 4 * 4); w.SLOT = (int*)take((size_t)T * 4 * 4);
  const size_t sbytes = (size_t)16 * SEQ * SB * 4; char* big = take(sbytes);
  w.S = (float*)big; w.GU = (float*)big; w.ACT = (float*)(big + (size_t)T * 4 * 2048 * 4); w.Y = (float*)(big + (size_t)T * 4 * 2048 * 4 + (size_t)T * 4 * 1024 * 4);
  return o;
}

static void gemm(hipStream_t st, bool tb, const float* A, int lda, const float* B, int ldb, float* C, int ldc, int M, int N, int K, const float* bias = nullptr,
                 int nz = 1, int zdiv = 1, long sA1 = 0, long sA2 = 0, long sB1 = 0, long sB2 = 0, long sC1 = 0, long sC2 = 0, long sBias = 0,
                 const int* gather = nullptr, const int* cnt = nullptr, const int* off = nullptr) {
  GP p{}; p.A = A; p.B = B; p.C = C; p.bias = bias; p.gather = gather; p.cnt = cnt; p.off = off; p.M = M; p.N = N; p.K = K; p.lda = lda; p.ldb = ldb; p.ldc = ldc;
  p.sA1 = sA1; p.sA2 = sA2; p.sB1 = sB1; p.sB2 = sB2; p.sC1 = sC1; p.sC2 = sC2; p.sBias = sBias; p.zdiv = zdiv; p.pad_ = 0;
  dim3 grid((N + 63) / 64, (M + 63) / 64, nz);
  if (tb) hipLaunchKernelGGL(o_gemm<true>, grid, dim3(256), 0, st, p); else hipLaunchKernelGGL(o_gemm<false>, grid, dim3(256), 0, st, p);
}

struct In { const float *x, *c, *ctx, *c_ctx, *w_mod, *b_mod, *g_norm1, *g_norm2, *w_in, *g_cq, *g_ckv, *w_uq, *w_ukv, *g_mla, *ret_decay, *g_ret, *gdn_conv, *gdn_a_log,
  *gdn_dt_bias, *g_gdn, *w_out, *w_router, *b_router, *w_gate_up, *b_gate_up, *w_down, *b_down, *g_final; };

static void run(hipStream_t st, const In& in, const OWs& w, float* out, int nlayers = DEPTH) {
  hipLaunchKernelGGL(o_mod, dim3(6144 / 256, DEPTH), dim3(256), 0, st, in.c, in.c_ctx, in.w_mod, in.b_mod, w.MOD);
  hipLaunchKernelGGL(o_init, dim3(T), dim3(256), 0, st, in.x, in.ctx, w.X);
  for (int l = 0; l < nlayers; ++l) {
    const float* MODl = w.MOD + (size_t)l * 5 * 6144;
    hipLaunchKernelGGL(o_norm, dim3(T), dim3(256), 0, st, w.X, in.g_norm1 + l * D, MODl, 0, 1024, w.H);
    gemm(st, false, w.H, D, in.w_in + (size_t)l * D * INW, INW, w.P, INW, T, INW, D);
    hipLaunchKernelGGL(o_mla_prep, dim3(T), dim3(256), 0, st, w.P, in.g_cq + l * 256, in.g_ckv + l * 128, w.AQ, w.AKV);
    gemm(st, false, w.AQ, 256, in.w_uq + (size_t)l * 256 * 768, 768, w.QRAW, 768, T, 768, 256);
    gemm(st, false, w.AKV, 128, in.w_ukv + (size_t)l * 128 * 1024, 1024, w.KVRAW, 1024, T, 1024, 128);
    hipLaunchKernelGGL(o_mla_asm, dim3(T), dim3(256), 0, st, w.P, w.QRAW, w.KVRAW, w.Q, w.K, w.V);
    const float scale = 0.07216878364870322f;
    gemm(st, true, w.Q + (size_t)CTX * 768, 768, w.K, 768, w.S, SB, SEQ, SB, 192, nullptr, 16, 4, (long)SB * 768, 192, (long)SB * 768, 192, (long)4 * SEQ * SB, (long)SEQ * SB);
    hipLaunchKernelGGL(o_softmax, dim3(16 * SEQ), dim3(256), 0, st, w.S, SB, (long)SB, scale);
    gemm(st, false, w.S, SB, w.V, 512, w.AO + (size_t)CTX * 512, 512, SEQ, 128, SB, nullptr, 16, 4, (long)4 * SEQ * SB, (long)SEQ * SB, (long)SB * 512, 128, (long)SB * 512, 128);
    gemm(st, true, w.Q, 768, w.K, 768, w.S, CTX, CTX, CTX, 192, nullptr, 16, 4, (long)SB * 768, 192, (long)SB * 768, 192, (long)4 * CTX * CTX, (long)CTX * CTX);
    hipLaunchKernelGGL(o_softmax, dim3(16 * CTX), dim3(256), 0, st, w.S, CTX, (long)CTX, scale);
    gemm(st, false, w.S, CTX, w.V, 512, w.AO, 512, CTX, 128, CTX, nullptr, 16, 4, (long)4 * CTX * CTX, (long)CTX * CTX, (long)SB * 512, 128, (long)SB * 512, 128);
    hipLaunchKernelGGL(o_mla_out, dim3(T), dim3(256), 0, st, w.AO, in.g_mla + l * 512, w.CAT);
    hipLaunchKernelGGL(o_ret_prep, dim3(T), dim3(256), 0, st, w.P, w.RQ, w.RK);
    hipLaunchKernelGGL(o_recur<false>, dim3(32), dim3(128), 0, st, w.RQ, 512, w.RK, 512, w.P + C_RV, INW, (const float*)nullptr, (const float*)nullptr, in.ret_decay + l * 8, w.RO);
    hipLaunchKernelGGL(o_ret_post, dim3(T), dim3(256), 0, st, w.RO, w.P, in.g_ret + l * 512, w.CAT);
    hipLaunchKernelGGL(o_gdn_prep, dim3(T), dim3(256), 0, st, w.P, in.gdn_conv + (size_t)l * 5 * 1536, in.gdn_a_log + l * 8, in.gdn_dt_bias + l * 8, w.GQ, w.GK, w.GV, w.LA, w.BT);
    hipLaunchKernelGGL(o_recur<true>, dim3(32), dim3(128), 0, st, w.GQ, 512, w.GK, 512, w.GV, 512, w.LA, w.BT, (const float*)nullptr, w.GO);
    hipLaunchKernelGGL(o_gdn_post, dim3(T), dim3(256), 0, st, w.GO, w.P, in.g_gdn + l * 128, w.CAT);
    gemm(st, false, w.CAT, 1536, in.w_out + (size_t)l * 1536 * D, D, w.TMP, D, T, D, 1536);
    hipLaunchKernelGGL(o_resid, dim3(T), dim3(256), 0, st, w.X, w.TMP, MODl, 2048);
    hipLaunchKernelGGL(o_norm, dim3(T), dim3(256), 0, st, w.X, in.g_norm2 + l * D, MODl, 3072, 4096, w.H);
    gemm(st, false, w.H, D, in.w_router + (size_t)l * D * NE, NE, w.LOG, NE, T, NE, D, in.b_router + l * NE);
    hipMemsetAsync(w.cnt, 0, 256, st);
    hipLaunchKernelGGL(o_topk, dim3(T / 256), dim3(256), 0, st, w.LOG, w.TOPI, w.TOPW, w.TOPP, w.cnt);
    hipLaunchKernelGGL(o_offsets, dim3(1), dim3(64), 0, st, w.cnt, w.off);
    hipLaunchKernelGGL(o_scatter, dim3(T * 4 / 256), dim3(256), 0, st, w.TOPI, w.TOPP, w.off, w.LIST, w.SLOT);
    gemm(st, false, w.H, D, in.w_gate_up + (size_t)l * NE * D * 2048, 2048, w.GU, 2048, T, 2048, D, in.b_gate_up + (size_t)l * NE * 2048,
         NE, 1, 0, 0, (long)D * 2048, 0, 0, 0, 2048, w.LIST, w.cnt, w.off);
    hipLaunchKernelGGL(o_act, dim3(T * 4), dim3(256), 0, st, w.GU, w.ACT);
    gemm(st, false, w.ACT, 1024, in.w_down + (size_t)l * NE * 1024 * D, D, w.Y, D, T, D, 1024, in.b_down + (size_t)l * NE * D,
         NE, 1, 0, 0, (long)1024 * D, 0, 0, 0, D, nullptr, w.cnt, w.off);
    hipLaunchKernelGGL(o_combine, dim3(T), dim3(256), 0, st, w.X, w.Y, w.SLOT, w.TOPW, MODl, 5120);
  }
  if (out) hipLaunchKernelGGL(o_final, dim3(NB * SEQ), dim3(256), 0, st, w.X, in.g_final, out);
}
}
extern "C" void kernel_launch(void* const* d_in, const int* in_sizes, int n_in, void* d_out, int out_size, void* d_ws, size_t ws_size, hipStream_t stream) {
  orc::In in{};
  const float** f = (const float**)&in;
  for (int i = 0; i < 28; ++i) f[i] = (const float*)d_in[i];
  orc::OWs w{};
  const size_t need = orc::o_layout((char*)d_ws, w);
  if (need > ws_size || n_in != 28) { fprintf(stderr, "kernel_launch: ws too small (%zu > %zu) or n_in %d\n", need, ws_size, n_in); return; }
  orc::run(stream, in, w, (float*)d_out);
}
```

```cpp
#include <hip/hip_runtime.h>
#include <stdint.h>
#include <stdio.h>

namespace cfg {
constexpr int D = 1024, NB = 4, SEQ = 4096, DEPTH = 4, CTX = 256, GW = 64;
constexpr int SB = CTX + SEQ;
constexpr int T = NB * SB;
constexpr int INW = 4560;
constexpr int C_DQ = 0, C_DKV = 256, C_KR = 384, C_RQ = 448, C_RK = 960, C_RV = 1472, C_RG = 1984, C_GQ = 2496, C_GK = 3008, C_GV = 3520, C_GZ = 4032, C_GA = 4544, C_GB = 4552;
constexpr int NE = 32, TOPK = 4, DE = 1024;
}
namespace fx {
using namespace cfg;
#define LAS __attribute__((address_space(3)))
typedef unsigned short bf16_t;
typedef short bf16x8 __attribute__((ext_vector_type(8)));
typedef short s16x4 __attribute__((ext_vector_type(4)));
typedef float f32x4 __attribute__((ext_vector_type(4)));
typedef float f32x16 __attribute__((ext_vector_type(16)));
typedef unsigned u32x4 __attribute__((ext_vector_type(4)));
typedef unsigned u32x2 __attribute__((ext_vector_type(2)));

constexpr int NTHREADS = 512, NWAVES = 8;
constexpr int BM = 256, BK = 64, HALF = 128, HTB = HALF * BK * 2, STAGE_BYTES = 8 * HTB, NXCD = 8, WGM = 8;
constexpr int LDS_MISC = STAGE_BYTES;
constexpr int LDS_BYTES = 147456;
constexpr int INWP = 4608;
constexpr int MLAN = 1792, MLAK = 384;
constexpr int MAXBLK = (T * TOPK) / 256 + NE;
constexpr int ROWS_P = MAXBLK * 256;

__device__ __forceinline__ unsigned cvt_pk_bf16(float lo, float hi) { unsigned r; asm volatile("v_cvt_pk_bf16_f32 %0, %1, %2" : "=v"(r) : "v"(lo), "v"(hi)); return r; }
__device__ __forceinline__ float bf2f(unsigned short b) { return __uint_as_float(((unsigned)b) << 16); }
__device__ __forceinline__ float bflo(unsigned w) { return __uint_as_float(w << 16); }
__device__ __forceinline__ float bfhi(unsigned w) { return __uint_as_float(w & 0xffff0000u); }
__device__ __forceinline__ float silu_f(float v) { return v / (1.f + __expf(-v)); }

__host__ __device__ __forceinline__ int lds_byte(int r, int c) { const int st = (r >> 4) * 2 + (c >> 5), rr = r & 15, cc = c & 31, ob = rr * 64 + cc * 2; return st * 1024 + (ob ^ (((ob >> 9) & 1) << 5)); }
__host__ __device__ __forceinline__ void stage_rc(int b, int& R, int& C) { const int st = b / 1024, sb = b % 1024, swz = sb ^ (((sb >> 9) & 1) << 5); R = (st >> 1) * 16 + swz / 64; C = (st & 1) * 32 + (swz % 64) / 2; }
__host__ __device__ __forceinline__ int perm32(int rho) { const int n = rho >> 4, i = rho & 15; return 8 * (i >> 2) + 4 * n + (i & 3); }

struct Unit { int pm, pn, e, pad_; long aoff, boff; };
struct Gemm { const bf16_t* A; const bf16_t* Bt; int M, N, K; };

struct StaticOrder {
    int nM, nN, nwg, G, c, K;
    __device__ void init(int M, int N, int K_, int G_, int c_) { nM = M / BM; nN = N / BM; nwg = nM * nN; G = G_; c = c_; K = K_; }
    __device__ bool next(int i, Unit& u) const {
        const long L = (long)i * G + c; if (L >= nwg) return false;
        int wgid = (int)L; { const int q = nwg / NXCD, r = nwg % NXCD, xcd = wgid % NXCD, off = wgid / NXCD; wgid = (xcd < r ? xcd * (q + 1) : r * (q + 1) + (xcd - r) * q) + off; }
        const int nig = WGM * nN, gid = wgid / nig, fm = gid * WGM, gsz = (nM - fm) < WGM ? (nM - fm) : WGM;
        u.pm = fm + ((wgid % nig) % gsz); u.pn = (wgid % nig) / gsz; u.e = 0; u.pad_ = 0;
        u.aoff = (long)u.pm * BM * K * 2; u.boff = (long)u.pn * BM * K * 2; return true;
    }
    __device__ __forceinline__ void a_off(const Unit&, const int (&R)[2], const int (&C)[2], unsigned (&v)[2][2]) const {
#pragma unroll
        for (int h = 0; h < 2; ++h)
#pragma unroll
            for (int i = 0; i < 2; ++i) v[h][i] = (unsigned)((h * HALF + R[i]) * K + C[i]) * 2u;
    }
};
template <bool GATHER> struct MoeOrder {
    int nblk, NPN, G, c, K; const LAS int* blk_e; const LAS int* blk_j; const int* rowtok; const int* cnt; long bstride;
    __device__ bool next(int i, Unit& u) const {
        const long L = (long)i * G + c; if (L >= (long)nblk * NPN) return false;
        const int blk = (int)(L / NPN); u.pn = (int)(L % NPN); u.pm = blk; u.e = blk_e[blk]; u.pad_ = blk_j[blk];
        u.aoff = GATHER ? 0 : (long)blk * BM * K * 2; u.boff = (long)u.e * bstride + (long)u.pn * BM * K * 2; return true;
    }
    __device__ __forceinline__ void a_off(const Unit& u, const int (&R)[2], const int (&C)[2], unsigned (&v)[2][2]) const {
        if (GATHER) { const int n = cnt[u.e]; const int* lst = rowtok + (size_t)u.e * T + u.pad_ * 256;
#pragma unroll
            for (int h = 0; h < 2; ++h)
#pragma unroll
                for (int i = 0; i < 2; ++i) { const int rr = h * HALF + R[i]; const int tok = (u.pad_ * 256 + rr < n) ? lst[rr] : 0; v[h][i] = (unsigned)(tok * K + C[i]) * 2u; }
        } else {
#pragma unroll
            for (int h = 0; h < 2; ++h)
#pragma unroll
                for (int i = 0; i < 2; ++i) v[h][i] = (unsigned)((h * HALF + R[i]) * K + C[i]) * 2u;
        }
    }
};

struct EpiInproj {
    static constexpr bool PERM = true;
    bf16_t* O; float* GAB;
    __device__ __forceinline__ void operator()(const f32x4 (&acc)[2][2][4][2], const Unit& u, int wr, int wc, int fr, int fq) const {
        const int row0 = u.pm * BM + wr * 64 + fr, col0 = u.pn * BM + wc * 32 + 8 * fq;
#pragma unroll
        for (int ai = 0; ai < 2; ++ai)
#pragma unroll
            for (int m = 0; m < 4; ++m) { const int row = row0 + ai * HALF + m * 16; bf16_t* rowp = O + (size_t)row * INWP + col0;
#pragma unroll
                for (int bj = 0; bj < 2; ++bj) { const f32x4 v0 = acc[ai][bj][m][0], v1 = acc[ai][bj][m][1];
                    u32x4 w; w.x = cvt_pk_bf16(v0[0], v0[1]); w.y = cvt_pk_bf16(v0[2], v0[3]); w.z = cvt_pk_bf16(v1[0], v1[1]); w.w = cvt_pk_bf16(v1[2], v1[3]);
                    *(u32x4*)(rowp + bj * HALF) = w; }
                if (u.pn == 17 && wc == 2 && fq < 2) { float* gp = GAB + (size_t)row * 16 + fq * 8; *(f32x4*)gp = acc[ai][1][m][0]; *(f32x4*)(gp + 4) = acc[ai][1][m][1]; } }
    }
};
struct EpiOutproj {
    static constexpr bool PERM = false;
    float* X; const float* MODl;
    __device__ __forceinline__ void operator()(const f32x4 (&acc)[2][2][4][2], const Unit& u, int wr, int wc, int fr, int fq) const {
        const int row0 = u.pm * BM + wr * 64 + fr, col0 = u.pn * BM + wc * 32 + 4 * fq; const int rmod = (u.pm % 17 == 0) ? 4 : u.pm / 17;
        const float* gt = MODl + (size_t)rmod * 6144 + 2048 + col0; f32x4 gv[2][2];
#pragma unroll
        for (int bj = 0; bj < 2; ++bj)
#pragma unroll
            for (int n = 0; n < 2; ++n) gv[bj][n] = *(const f32x4*)(gt + bj * HALF + n * 16);
#pragma unroll
        for (int ai = 0; ai < 2; ++ai)
#pragma unroll
            for (int m = 0; m < 4; ++m) { float* rowp = X + (size_t)(row0 + ai * HALF + m * 16) * D + col0;
#pragma unroll
                for (int bj = 0; bj < 2; ++bj)
#pragma unroll
                    for (int n = 0; n < 2; ++n) { f32x4* p = (f32x4*)(rowp + bj * HALF + n * 16); *p = *p + gv[bj][n] * acc[ai][bj][m][n]; } }
    }
};
struct EpiGateUp {
    static constexpr bool PERM = true;
    bf16_t* ACT; const float* bgu;
    __device__ __forceinline__ void operator()(const f32x4 (&acc)[2][2][4][2], const Unit& u, int wr, int wc, int fr, int fq) const {
        const int row0 = u.pm * BM + wr * 64 + fr, oc = u.pn * HALF + wc * 32 + 8 * fq; const float* bg = bgu + (size_t)u.e * 2048 + oc;
        f32x4 bgv[2], buv[2];
#pragma unroll
        for (int n = 0; n < 2; ++n) { bgv[n] = *(const f32x4*)(bg + 4 * n); buv[n] = *(const f32x4*)(bg + 1024 + 4 * n); }
#pragma unroll
        for (int ai = 0; ai < 2; ++ai)
#pragma unroll
            for (int m = 0; m < 4; ++m) { float o[8];
#pragma unroll
                for (int n = 0; n < 2; ++n) { const f32x4 gv = acc[ai][0][m][n] + bgv[n], uv = acc[ai][1][m][n] + buv[n];
#pragma unroll
                    for (int j = 0; j < 4; ++j) { const float gg = fminf(gv[j], 7.f), uu = fminf(fmaxf(uv[j], -7.f), 7.f); o[n * 4 + j] = (uu + 1.f) * gg / (1.f + __expf(-1.702f * gg)); } }
                u32x4 w; w.x = cvt_pk_bf16(o[0], o[1]); w.y = cvt_pk_bf16(o[2], o[3]); w.z = cvt_pk_bf16(o[4], o[5]); w.w = cvt_pk_bf16(o[6], o[7]);
                *(u32x4*)(ACT + (size_t)(row0 + ai * HALF + m * 16) * 1024 + oc) = w; }
    }
};
struct EpiDown {
    static constexpr bool PERM = true;
    bf16_t* YS; const float* bdn;
    __device__ __forceinline__ void operator()(const f32x4 (&acc)[2][2][4][2], const Unit& u, int wr, int wc, int fr, int fq) const {
        const int row0 = u.pm * BM + wr * 64 + fr, col0 = u.pn * BM + wc * 32 + 8 * fq; const float* bb = bdn + (size_t)u.e * 1024 + col0;
        f32x4 bv[2][2];
#pragma unroll
        for (int bj = 0; bj < 2; ++bj)
#pragma unroll
            for (int n = 0; n < 2; ++n) bv[bj][n] = *(const f32x4*)(bb + bj * HALF + 4 * n);
#pragma unroll
        for (int ai = 0; ai < 2; ++ai)
#pragma unroll
            for (int m = 0; m < 4; ++m) { bf16_t* rowp = YS + (size_t)(row0 + ai * HALF + m * 16) * 1024 + col0;
#pragma unroll
                for (int bj = 0; bj < 2; ++bj) { const f32x4 v0 = acc[ai][bj][m][0] + bv[bj][0], v1 = acc[ai][bj][m][1] + bv[bj][1];
                    u32x4 w; w.x = cvt_pk_bf16(v0[0], v0[1]); w.y = cvt_pk_bf16(v0[2], v0[3]); w.z = cvt_pk_bf16(v1[0], v1[1]); w.w = cvt_pk_bf16(v1[2], v1[3]);
                    *(u32x4*)(rowp + bj * HALF) = w; } }
    }
};

template <class Epi, class Sched>
__device__ __forceinline__ void gemm_phase(LAS unsigned char* lds, const Gemm g, const Sched& S, const Epi& E) {
    const int tid = threadIdx.x, wid = __builtin_amdgcn_readfirstlane(tid >> 6), lane = tid & 63, wr = wid >> 2, wc = wid & 3, fr = lane & 15, fq = lane >> 4;
    const int K = g.K, nt = K / BK;
    int Rr[2], Cc[2]; unsigned voffB[2];
#pragma unroll
    for (int i = 0; i < 2; ++i) { int R, C; stage_rc(tid * 16 + i * 8192, R, C); Rr[i] = R; Cc[i] = C; const int Rb = Epi::PERM ? ((R & ~31) + perm32(R & 31)) : R; voffB[i] = (unsigned)(Rb * K + C) * 2u; }
    const size_t kstep = (size_t)(BK * 2);
    const size_t hstep = (size_t)HALF * K * 2;
    const unsigned ldsw = (unsigned)wid * 1024u;
    const int aoff = lds_byte(wr * 64 + fr, fq * 8), boff = lds_byte(wc * 32 + fr, fq * 8);
#define PG8_SA(b, h) (((b) * 2 + (h)) * HTB)
#define PG8_SB(b, h) ((4 + (b) * 2 + (h)) * HTB)
#define PG8_STAGE(bufoff, gbase, voff) do { _Pragma("unroll") for (int _i = 0; _i < 2; ++_i) \
        __builtin_amdgcn_global_load_lds((const unsigned*)((const char*)(gbase) + (voff)[_i]), (LAS unsigned*)(lds + (bufoff) + ldsw + _i * 8192), 16, 0, 0); } while (0)
#define PG8_LDA(dst, b, h) do { _Pragma("unroll") for (int m = 0; m < 4; ++m) _Pragma("unroll") for (int k = 0; k < 2; ++k) dst[m][k] = *(const LAS bf16x8*)(lds + PG8_SA(b, h) + aoff + m * 2048 + k * 1024); } while (0)
#define PG8_LDB(dst, b, h) do { _Pragma("unroll") for (int n = 0; n < 2; ++n) _Pragma("unroll") for (int k = 0; k < 2; ++k) dst[n][k] = *(const LAS bf16x8*)(lds + PG8_SB(b, h) + boff + n * 2048 + k * 1024); } while (0)
#define PG8_MMA(ai, bj, At, Bt) do { __builtin_amdgcn_s_setprio(1); _Pragma("unroll") for (int m = 0; m < 4; ++m) _Pragma("unroll") for (int n = 0; n < 2; ++n) _Pragma("unroll") for (int k = 0; k < 2; ++k) \
        acc[ai][bj][m][n] = __builtin_amdgcn_mfma_f32_16x16x32_bf16(Bt[n][k], At[m][k], acc[ai][bj][m][n], 0, 0, 0); __builtin_amdgcn_s_setprio(0); } while (0)
#define PG8_WAIT_V(n) asm volatile("s_waitcnt vmcnt(" #n ")" ::: "memory")
#define PG8_WAIT_L(n) asm volatile("s_waitcnt lgkmcnt(" #n ")" ::: "memory")
#define PG8_BAR __builtin_amdgcn_s_barrier()
#define PG8_SCHED __builtin_amdgcn_sched_barrier(0)
    Unit cur, nxt; int ui = 0;
    if (!S.next(0, cur)) return;
    f32x4 acc[2][2][4][2];
#pragma unroll
    for (int a = 0; a < 2; ++a)
#pragma unroll
        for (int b = 0; b < 2; ++b)
#pragma unroll
            for (int m = 0; m < 4; ++m)
#pragma unroll
                for (int n = 0; n < 2; ++n) acc[a][b][m][n] = (f32x4){0.f, 0.f, 0.f, 0.f};
    bf16x8 At[4][2], B0[2][2], B1[2][2];
    unsigned vAc[2][2], vAn[2][2];
    S.a_off(cur, Rr, Cc, vAc);
    const char* cA = (const char*)g.A + cur.aoff; const char* cB = (const char*)g.Bt + cur.boff;
    PG8_STAGE(PG8_SB(0, 0), cB, voffB); PG8_STAGE(PG8_SA(0, 0), cA, vAc[0]); PG8_STAGE(PG8_SB(0, 1), cB + hstep, voffB); PG8_STAGE(PG8_SA(0, 1), cA, vAc[1]);
    if (wr == 1) PG8_BAR;
    PG8_WAIT_V(4); PG8_BAR;
    PG8_STAGE(PG8_SB(1, 0), cB + kstep, voffB); PG8_STAGE(PG8_SA(1, 0), cA + kstep, vAc[0]); PG8_STAGE(PG8_SB(1, 1), cB + hstep + kstep, voffB);
    PG8_WAIT_V(6); PG8_BAR;
    for (;;) {
        const bool has_next = S.next(ui + 1, nxt);
        if (has_next) S.a_off(nxt, Rr, Cc, vAn);
        else {
#pragma unroll
            for (int h = 0; h < 2; ++h)
#pragma unroll
                for (int i = 0; i < 2; ++i) vAn[h][i] = vAc[h][i]; }
        const char* nA = has_next ? (const char*)g.A + nxt.aoff : cA; const char* nB = has_next ? (const char*)g.Bt + nxt.boff : cB;
        for (int t = 0; t < nt; t += 2) {
            const bool last = (t == nt - 2);
            const char* a1 = cA + (size_t)(t + 1) * kstep;
            const char* a2 = last ? nA : cA + (size_t)(t + 2) * kstep; const char* b2 = last ? nB : cB + (size_t)(t + 2) * kstep;
            const char* a3 = a2 + kstep; const char* b3 = b2 + kstep;
            unsigned w2[2][2];
#pragma unroll
            for (int h = 0; h < 2; ++h)
#pragma unroll
                for (int i = 0; i < 2; ++i) w2[h][i] = last ? vAn[h][i] : vAc[h][i];
            PG8_LDB(B0, 0, 0); PG8_SCHED; PG8_LDA(At, 0, 0); PG8_STAGE(PG8_SA(1, 1), a1, vAc[1]);
            PG8_WAIT_L(8); PG8_BAR; PG8_WAIT_L(0); PG8_MMA(0, 0, At, B0); PG8_BAR; PG8_SCHED;
            PG8_LDB(B1, 0, 1); PG8_STAGE(PG8_SB(0, 0), b2, voffB);
            PG8_BAR; PG8_WAIT_L(0); PG8_MMA(0, 1, At, B1); PG8_BAR;
            PG8_LDA(At, 0, 1); PG8_STAGE(PG8_SA(0, 0), a2, w2[0]);
            PG8_BAR; PG8_WAIT_L(0); PG8_MMA(1, 0, At, B0); PG8_BAR; PG8_SCHED;
            PG8_STAGE(PG8_SB(0, 1), b2 + hstep, voffB);
            PG8_WAIT_V(6); PG8_BAR; PG8_MMA(1, 1, At, B1); PG8_BAR;
            PG8_LDB(B0, 1, 0); PG8_SCHED; PG8_LDA(At, 1, 0); PG8_STAGE(PG8_SA(0, 1), a2, w2[1]);
            PG8_WAIT_L(8); PG8_BAR; PG8_WAIT_L(0); PG8_MMA(0, 0, At, B0); PG8_BAR; PG8_SCHED;
            PG8_LDB(B1, 1, 1); PG8_STAGE(PG8_SB(1, 0), b3, voffB);
            PG8_BAR; PG8_WAIT_L(0); PG8_MMA(0, 1, At, B1); PG8_BAR;
            PG8_LDA(At, 1, 1); PG8_STAGE(PG8_SA(1, 0), a3, w2[0]);
            PG8_BAR; PG8_WAIT_L(0); PG8_MMA(1, 0, At, B0); PG8_BAR; PG8_SCHED;
            PG8_STAGE(PG8_SB(1, 1), b3 + hstep, voffB);
            PG8_WAIT_V(6); PG8_BAR; PG8_MMA(1, 1, At, B1); PG8_BAR;
        }
        { int tz = threadIdx.x; asm volatile("" : "+v"(tz)); const int wz = tz >> 6, lz = tz & 63; E(acc, cur, wz >> 2, wz & 3, lz & 15, lz >> 4); }
        if (!has_next) break;
#pragma unroll
        for (int a = 0; a < 2; ++a)
#pragma unroll
            for (int b = 0; b < 2; ++b)
#pragma unroll
                for (int m = 0; m < 4; ++m)
#pragma unroll
                    for (int n = 0; n < 2; ++n) acc[a][b][m][n] = (f32x4){0.f, 0.f, 0.f, 0.f};
        cur = nxt; cA = nA; cB = nB; ++ui;
#pragma unroll
        for (int h = 0; h < 2; ++h)
#pragma unroll
            for (int i = 0; i < 2; ++i) vAc[h][i] = vAn[h][i];
    }
    PG8_WAIT_V(0);
    if (wr == 0) PG8_BAR;
    PG8_BAR;
#undef PG8_SA
#undef PG8_SB
#undef PG8_STAGE
#undef PG8_LDA
#undef PG8_LDB
#undef PG8_MMA
#undef PG8_WAIT_V
#undef PG8_WAIT_L
#undef PG8_BAR
#undef PG8_SCHED
}
struct FP {
  const float *x, *c, *ctx, *c_ctx, *w_mod, *b_mod, *g_norm1, *g_norm2, *w_in, *g_cq, *g_ckv, *w_uq, *w_ukv, *g_mla, *ret_decay, *g_ret, *gdn_conv, *gdn_a_log,
      *gdn_dt_bias, *g_gdn, *w_out, *w_router, *b_router, *w_gate_up, *b_gate_up, *w_down, *b_down, *g_final;
  float* out;
  unsigned* ctl; int* cnt;
  bf16_t *Wt_in, *Wt_mla, *Wt_out, *Wt_gu, *Wt_dn;
  float *MOD, *X, *GAB, *TOPW;
  bf16_t *Hb, *H2b, *Pb, *CATb, *ACTb, *YSb;
  int *TOPE, *TOPP, *ROWTOK;
  bf16_t *A2b, *Qb, *Knb, *Vb, *KRb, *AOb;
  bf16_t *RQb, *RKb, *RKWT, *RVTB, *RVTA, *RST;
  bf16_t *GQb, *GKb, *GVb, *GUT, *GWb, *GKTT, *GVNT, *GST;
  float *GG, *GBETA, *GLA;
};
constexpr int CTL_WORDS = 4096 + DEPTH * 32;

template <int MAP> __device__ __forceinline__ void tr_tile(const float* src, int lds_, int k0, int n0, int N, bf16_t* dst, int ldd, int kcol0, LAS float* tile) {
  const int t = threadIdx.x;
#pragma unroll
  for (int i = 0; i < 2; ++i) { const int idx = t + 512 * i, k = idx >> 4, n4 = (idx & 15) * 4; f32x4 v = (f32x4){0.f, 0.f, 0.f, 0.f};
    if (n0 + n4 < N) v = *(const f32x4*)(src + (size_t)(k0 + k) * lds_ + n0 + n4);
    tile[k * 65 + n4 + 0] = v[0]; tile[k * 65 + n4 + 1] = v[1]; tile[k * 65 + n4 + 2] = v[2]; tile[k * 65 + n4 + 3] = v[3]; }
  __syncthreads();
  { const int n = t >> 3, k8 = (t & 7) * 8; float o[8];
#pragma unroll
    for (int j = 0; j < 8; ++j) o[j] = tile[(k8 + j) * 65 + n];
    u32x4 w; w.x = cvt_pk_bf16(o[0], o[1]); w.y = cvt_pk_bf16(o[2], o[3]); w.z = cvt_pk_bf16(o[4], o[5]); w.w = cvt_pk_bf16(o[6], o[7]);
    int gn = n0 + n, row;
    if (MAP == 1) { const int bj = gn >> 10, c = gn & 1023; row = (c >> 7) * 256 + bj * 128 + (c & 127); }
    else row = gn;
    *(u32x4*)(dst + (size_t)row * ldd + kcol0 + k0 + k8) = w; }
  __syncthreads();
}

__device__ void ph_prologue(const FP& p, LAS unsigned char* lds) {
  LAS float* tile = (LAS float*)lds;
  const int G = gridDim.x, bid = blockIdx.x, t = threadIdx.x;
  constexpr int S_GU = DEPTH * NE * 16 * 32, S_DN = DEPTH * NE * 16 * 16, S_IN = DEPTH * 16 * 72, S_OUT = DEPTH * 24 * 16, S_UQ = DEPTH * 4 * 12, S_UKV = DEPTH * 2 * 16;
  constexpr int S_TOT = S_GU + S_DN + S_IN + S_OUT + S_UQ + S_UKV;
  for (int id = bid; id < S_TOT; id += G) {
    int r = id;
    if (r < S_GU) { const int m = r / 512, tt = r % 512, kt = tt / 32, nt = tt % 32;
      tr_tile<1>(p.w_gate_up + (size_t)m * 1024 * 2048, 2048, kt * 64, nt * 64, 2048, p.Wt_gu + (size_t)m * 2048 * 1024, 1024, 0, tile); continue; }
    r -= S_GU;
    if (r < S_DN) { const int m = r / 256, tt = r % 256, kt = tt / 16, nt = tt % 16;
      tr_tile<0>(p.w_down + (size_t)m * 1024 * 1024, 1024, kt * 64, nt * 64, 1024, p.Wt_dn + (size_t)m * 1024 * 1024, 1024, 0, tile); continue; }
    r -= S_DN;
    if (r < S_IN) { const int l = r / 1152, tt = r % 1152, kt = tt / 72, nt = tt % 72;
      tr_tile<0>(p.w_in + (size_t)l * 1024 * INW, INW, kt * 64, nt * 64, INW, p.Wt_in + (size_t)l * INWP * 1024, 1024, 0, tile); continue; }
    r -= S_IN;
    if (r < S_OUT) { const int l = r / 384, tt = r % 384, kt = tt / 16, nt = tt % 16;
      tr_tile<0>(p.w_out + (size_t)l * 1536 * 1024, 1024, kt * 64, nt * 64, 1024, p.Wt_out + (size_t)l * 1024 * 1536, 1536, 0, tile); continue; }
    r -= S_OUT;
    if (r < S_UQ) { const int l = r / 48, tt = r % 48, kt = tt / 12, nt = tt % 12;
      tr_tile<0>(p.w_uq + (size_t)l * 256 * 768, 768, kt * 64, nt * 64, 768, p.Wt_mla + (size_t)l * MLAN * MLAK, MLAK, 0, tile); continue; }
    r -= S_UQ;
    { const int l = r / 32, tt = r % 32, kt = tt / 16, nt = tt % 16;
      tr_tile<0>(p.w_ukv + (size_t)l * 128 * 1024, 1024, kt * 64, nt * 64, 1024, p.Wt_mla + (size_t)l * MLAN * MLAK + (size_t)768 * MLAK, MLAK, 256, tile); }
  }
  { const u32x4 z = (u32x4){0u, 0u, 0u, 0u}; const int gtid = bid * NTHREADS + t, gstr = G * NTHREADS;
    for (int i = gtid; i < DEPTH * 768 * 16; i += gstr) { const int l = i / (768 * 16), rr = (i / 16) % 768, c8 = (i % 16) * 8; *(u32x4*)(p.Wt_mla + ((size_t)l * MLAN + rr) * MLAK + 256 + c8) = z; }
    for (int i = gtid; i < DEPTH * 1024 * 32; i += gstr) { const int l = i / (1024 * 32), rr = (i / 32) % 1024, c8 = (i % 32) * 8; *(u32x4*)(p.Wt_mla + ((size_t)l * MLAN + 768 + rr) * MLAK + c8) = z; } }
  { const int gw = bid * NWAVES + (t >> 6), lane = t & 63;
    for (int row = gw; row < T; row += G * NWAVES) { const int b = row / SB, s = row % SB;
      const float* src = s < CTX ? p.ctx + ((size_t)b * CTX + s) * D : p.x + ((size_t)b * SEQ + (s - CTX)) * D;
#pragma unroll
      for (int i = 0; i < 4; ++i) *(f32x4*)(p.X + (size_t)row * D + i * 256 + lane * 4) = *(const f32x4*)(src + i * 256 + lane * 4); } }
  { LAS float* sc = (LAS float*)(lds + 32768);
    LAS float* part = (LAS float*)(lds + 32768 + 5 * 1024 * 4);
    __syncthreads();
    for (int i = t; i < 5 * 1024; i += NTHREADS) { const int r = i >> 10, k = i & 1023; const float v = r < 4 ? p.c[r * 1024 + k] : p.c_ctx[k]; sc[i] = v / (1.f + expf(-v)); }
    __syncthreads();
    for (int item = bid; item < DEPTH * 24; item += G) { const int l = item / 24, j = (item % 24) * 256 + (t & 255), kh = t >> 8;
      float a[5] = {0.f, 0.f, 0.f, 0.f, 0.f}; const float* w = p.w_mod + (size_t)l * 1024 * 6144 + j;
      for (int k = kh * 512; k < kh * 512 + 512; ++k) { const float wv = w[(size_t)k * 6144];
#pragma unroll
        for (int r = 0; r < 5; ++r) a[r] += sc[r * 1024 + k] * wv; }
      if (kh == 1) {
#pragma unroll
        for (int r = 0; r < 5; ++r) part[r * 256 + (t & 255)] = a[r]; }
      __syncthreads();
      if (kh == 0) {
#pragma unroll
        for (int r = 0; r < 5; ++r) p.MOD[(size_t)(l * 5 + r) * 6144 + j] = a[r] + part[r * 256 + (t & 255)] + p.b_mod[l * 6144 + j]; }
      __syncthreads(); } }
}

struct MoeTab { LAS int* blk_e; LAS int* blk_j; LAS int* start; int nblk; };
__device__ __forceinline__ MoeTab moe_tables(const int* cntl, LAS unsigned char* misc) {
  MoeTab m; m.blk_e = (LAS int*)misc; m.blk_j = m.blk_e + MAXBLK; m.start = m.blk_j + MAXBLK;
  const int t = threadIdx.x;
  __syncthreads();
  if (t < 64) { const int e = t & 31; const int nb = (cntl[e] + 255) >> 8; int incl = nb;
#pragma unroll
    for (int o = 1; o < 32; o <<= 1) { const int v = __shfl_up(incl, o, 32); if ((t & 31) >= o) incl += v; }
    if (t < 32) { m.start[e] = incl - nb; if (e == 31) m.start[32] = incl; } }
  __syncthreads();
  m.nblk = m.start[32];
  for (int blk = t; blk < m.nblk; blk += NTHREADS) { int e = 0;
    while (m.start[e + 1] <= blk) ++e;
    m.blk_e[blk] = e; m.blk_j[blk] = blk - m.start[e]; }
  __syncthreads();
  return m;
}

__device__ __forceinline__ float wave_sum(float v) {
#pragma unroll
  for (int o = 32; o >= 1; o >>= 1) v += __shfl_xor(v, o);
  return v; }

__device__ __forceinline__ void moe_combine_row(const FP& p, int lprev, int row, const LAS int* start, const float* gate, int lane, f32x4 (&x)[4]) {
  int sl[4]; float w[4];
#pragma unroll
  for (int k = 0; k < 4; ++k) { const int e = p.TOPE[row * 4 + k]; sl[k] = start[e] * 256 + p.TOPP[row * 4 + k]; w[k] = p.TOPW[row * 4 + k]; }
#pragma unroll
  for (int i = 0; i < 4; ++i) { f32x4 y = (f32x4){0.f, 0.f, 0.f, 0.f};
#pragma unroll
    for (int k = 0; k < 4; ++k) { const u32x2 v = *(const u32x2*)(p.YSb + (size_t)sl[k] * 1024 + i * 256 + lane * 4);
      y[0] += w[k] * bflo(v.x); y[1] += w[k] * bfhi(v.x); y[2] += w[k] * bflo(v.y); y[3] += w[k] * bfhi(v.y); }
    const f32x4 g = *(const f32x4*)(gate + i * 256 + lane * 4); x[i] = x[i] + g * y; }
}

__device__ void ph_norm1(const FP& p, int l, LAS unsigned char* lds) {
  const int t = threadIdx.x, lane = t & 63, gw = blockIdx.x * NWAVES + (t >> 6), GWN = gridDim.x * NWAVES;
  MoeTab mt{}; if (l > 0) mt = moe_tables(p.cnt + (l - 1) * 32, lds + LDS_MISC);
  const float* MODl = p.MOD + (size_t)l * 5 * 6144; const float* MODp = p.MOD + (size_t)(l > 0 ? l - 1 : 0) * 5 * 6144; const float* g1 = p.g_norm1 + l * D;
  for (int row = gw; row < T; row += GWN) { const int b = row / SB, s = row % SB, r = s < CTX ? 4 : b;
    f32x4 x[4];
#pragma unroll
    for (int i = 0; i < 4; ++i) x[i] = *(const f32x4*)(p.X + (size_t)row * D + i * 256 + lane * 4);
    if (l > 0) { moe_combine_row(p, l - 1, row, mt.start, MODp + (size_t)r * 6144 + 5120, lane, x);
#pragma unroll
      for (int i = 0; i < 4; ++i) *(f32x4*)(p.X + (size_t)row * D + i * 256 + lane * 4) = x[i]; }
    float ss = 0.f;
#pragma unroll
    for (int i = 0; i < 4; ++i) ss += x[i][0] * x[i][0] + x[i][1] * x[i][1] + x[i][2] * x[i][2] + x[i][3] * x[i][3];
    ss = wave_sum(ss); const float rs = rsqrtf(ss * (1.f / 1024.f) + 1e-6f);
    const float* m = MODl + (size_t)r * 6144;
#pragma unroll
    for (int i = 0; i < 4; ++i) { const int c = i * 256 + lane * 4; const f32x4 g = *(const f32x4*)(g1 + c), sc = *(const f32x4*)(m + 1024 + c), sh = *(const f32x4*)(m + c);
      const f32x4 h = x[i] * rs * g * (sc + 1.f) + sh; u32x2 w; w.x = cvt_pk_bf16(h[0], h[1]); w.y = cvt_pk_bf16(h[2], h[3]);
      *(u32x2*)(p.Hb + (size_t)row * D + c) = w; } }
}

__device__ void ph_norm2(const FP& p, int l, LAS unsigned char* lds) {
  const int t = threadIdx.x, lane = t & 63, gw = blockIdx.x * NWAVES + (t >> 6), GWN = gridDim.x * NWAVES;
  LAS float* wT = (LAS float*)lds;
  __syncthreads();
  { const float* wr = p.w_router + (size_t)l * D * NE;
    for (int i = t; i < D * NE / 4; i += NTHREADS) { const int c = i >> 3, e4 = (i & 7) * 4; const f32x4 v = *(const f32x4*)(wr + (size_t)c * NE + e4);
      wT[(e4 + 0) * 1024 + c] = v[0]; wT[(e4 + 1) * 1024 + c] = v[1]; wT[(e4 + 2) * 1024 + c] = v[2]; wT[(e4 + 3) * 1024 + c] = v[3]; } }
  __syncthreads();
  const float* MODl = p.MOD + (size_t)l * 5 * 6144; const float* g2 = p.g_norm2 + l * D; int* cntl = p.cnt + l * 32;
  const float myb = p.b_router[l * NE + (lane >> 1)];
  for (int row = gw; row < T; row += GWN) { const int b = row / SB, s = row % SB, r = s < CTX ? 4 : b;
    if (l == DEPTH - 1 && s < CTX) continue;
    f32x4 h[4]; float ss = 0.f;
#pragma unroll
    for (int i = 0; i < 4; ++i) { h[i] = *(const f32x4*)(p.X + (size_t)row * D + i * 256 + lane * 4); ss += h[i][0] * h[i][0] + h[i][1] * h[i][1] + h[i][2] * h[i][2] + h[i][3] * h[i][3]; }
    ss = wave_sum(ss); const float rs = rsqrtf(ss * (1.f / 1024.f) + 1e-6f);
    const float* m = MODl + (size_t)r * 6144;
#pragma unroll
    for (int i = 0; i < 4; ++i) { const int c = i * 256 + lane * 4; const f32x4 g = *(const f32x4*)(g2 + c), sc = *(const f32x4*)(m + 4096 + c), sh = *(const f32x4*)(m + 3072 + c);
      h[i] = h[i] * rs * g * (sc + 1.f) + sh; u32x2 w; w.x = cvt_pk_bf16(h[i][0], h[i][1]); w.y = cvt_pk_bf16(h[i][2], h[i][3]);
      *(u32x2*)(p.H2b + (size_t)row * D + c) = w; }
    float acc[32];
#pragma unroll
    for (int e = 0; e < 32; ++e) { float a = 0.f;
#pragma unroll
      for (int i = 0; i < 4; ++i) { const f32x4 w = *(const LAS f32x4*)(wT + e * 1024 + i * 256 + lane * 4); a += h[i][0] * w[0] + h[i][1] * w[1] + h[i][2] * w[2] + h[i][3] * w[3]; }
      acc[e] = a; }
#define BFLY(NV, BIT) { const bool up = (lane >> (BIT)) & 1; _Pragma("unroll") for (int e = 0; e < (NV) / 2; ++e) { const float a = acc[e], bq = acc[e + (NV) / 2]; const float keep = up ? bq : a, send = up ? a : bq; acc[e] = keep + __shfl_xor(send, 1 << (BIT)); } }
    BFLY(32, 5) BFLY(16, 4) BFLY(8, 3) BFLY(4, 2) BFLY(2, 1)
#undef BFLY
    float v = acc[0] + __shfl_xor(acc[0], 1); v += myb;
    int myi = lane >> 1; if (lane & 1) v = -3.0e38f;
    float tv[4]; int ti[4];
#pragma unroll
    for (int k = 0; k < 4; ++k) { float bv = v; int bi = myi;
#pragma unroll
      for (int o = 32; o >= 1; o >>= 1) { const float ov = __shfl_xor(bv, o); const int oi = __shfl_xor(bi, o); if (ov > bv || (ov == bv && oi < bi)) { bv = ov; bi = oi; } }
      tv[k] = bv; ti[k] = bi; if (!(lane & 1) && myi == bi) v = -3.0e38f; }
    if (lane == 0) { float e4[4], sum = 0.f;
#pragma unroll
      for (int k = 0; k < 4; ++k) { e4[k] = expf(tv[k] - tv[0]); sum += e4[k]; }
      const float inv = 1.f / sum;
#pragma unroll
      for (int k = 0; k < 4; ++k) { const int pos = atomicAdd(&cntl[ti[k]], 1); p.TOPE[row * 4 + k] = ti[k]; p.TOPP[row * 4 + k] = pos; p.TOPW[row * 4 + k] = e4[k] * inv; p.ROWTOK[(size_t)ti[k] * T + pos] = row; } } }
}

__device__ void ph_final(const FP& p, LAS unsigned char* lds) {
  const int t = threadIdx.x, lane = t & 63, gw = blockIdx.x * NWAVES + (t >> 6), GWN = gridDim.x * NWAVES;
  MoeTab mt = moe_tables(p.cnt + (DEPTH - 1) * 32, lds + LDS_MISC);
  const float* MODp = p.MOD + (size_t)(DEPTH - 1) * 5 * 6144;
  for (int orow = gw; orow < NB * SEQ; orow += GWN) { const int b = orow / SEQ, tk = orow % SEQ, row = b * SB + CTX + tk;
    f32x4 x[4];
#pragma unroll
    for (int i = 0; i < 4; ++i) x[i] = *(const f32x4*)(p.X + (size_t)row * D + i * 256 + lane * 4);
    moe_combine_row(p, DEPTH - 1, row, mt.start, MODp + (size_t)b * 6144 + 5120, lane, x);
    float ss = 0.f;
#pragma unroll
    for (int i = 0; i < 4; ++i) ss += x[i][0] * x[i][0] + x[i][1] * x[i][1] + x[i][2] * x[i][2] + x[i][3] * x[i][3];
    ss = wave_sum(ss); const float rs = rsqrtf(ss * (1.f / 1024.f) + 1e-6f);
#pragma unroll
    for (int i = 0; i < 4; ++i) { const int c = i * 256 + lane * 4; const f32x4 g = *(const f32x4*)(p.g_final + c); *(f32x4*)(p.out + (size_t)orow * D + c) = x[i] * rs * g; } }
}

__device__ void ph_inproj(const FP& p, int l, LAS unsigned char* lds) {
  Gemm g; g.A = p.Hb; g.Bt = p.Wt_in + (size_t)l * INWP * 1024; g.M = T; g.N = INWP; g.K = 1024;
  StaticOrder S; S.init(T, INWP, 1024, gridDim.x, blockIdx.x); EpiInproj E; E.O = p.Pb; E.GAB = p.GAB;
  gemm_phase<EpiInproj, StaticOrder>(lds, g, S, E);
}
__device__ void ph_outproj(const FP& p, int l, LAS unsigned char* lds) {
  Gemm g; g.A = p.CATb; g.Bt = p.Wt_out + (size_t)l * 1024 * 1536; g.M = T; g.N = 1024; g.K = 1536;
  StaticOrder S; S.init(T, 1024, 1536, gridDim.x, blockIdx.x); EpiOutproj E; E.X = p.X; E.MODl = p.MOD + (size_t)l * 5 * 6144;
  gemm_phase<EpiOutproj, StaticOrder>(lds, g, S, E);
}
__device__ void ph_gemm1(const FP& p, int l, LAS unsigned char* lds) {
  MoeTab mt = moe_tables(p.cnt + l * 32, lds + LDS_MISC);
  Gemm g; g.A = p.H2b; g.Bt = p.Wt_gu + (size_t)l * NE * 2048 * 1024; g.M = 0; g.N = 2048; g.K = 1024;
  MoeOrder<true> S; S.nblk = mt.nblk; S.NPN = 8; S.G = gridDim.x; S.c = blockIdx.x; S.K = 1024; S.blk_e = mt.blk_e; S.blk_j = mt.blk_j; S.rowtok = p.ROWTOK; S.cnt = p.cnt + l * 32; S.bstride = (long)2048 * 1024 * 2;
  EpiGateUp E; E.ACT = p.ACTb; E.bgu = p.b_gate_up + (size_t)l * NE * 2048;
  gemm_phase<EpiGateUp, MoeOrder<true>>(lds, g, S, E);
}
__device__ void ph_gemm2(const FP& p, int l, LAS unsigned char* lds) {
  MoeTab mt = moe_tables(p.cnt + l * 32, lds + LDS_MISC);
  Gemm g; g.A = p.ACTb; g.Bt = p.Wt_dn + (size_t)l * NE * 1024 * 1024; g.M = 0; g.N = 1024; g.K = 1024;
  MoeOrder<false> S; S.nblk = mt.nblk; S.NPN = 4; S.G = gridDim.x; S.c = blockIdx.x; S.K = 1024; S.blk_e = mt.blk_e; S.blk_j = mt.blk_j; S.rowtok = nullptr; S.cnt = p.cnt + l * 32; S.bstride = (long)1024 * 1024 * 2;
  EpiDown E; E.YS = p.YSb; E.bdn = p.b_down + (size_t)l * NE * 1024;
  gemm_phase<EpiDown, MoeOrder<false>>(lds, g, S, E);
}
constexpr float QSCALE = 0.07216878364870322f * 1.4426950408889634f;

__device__ __forceinline__ void prep_mla_row(const FP& p, int l, int row, int lane) {
  const int s = row % SB; const bool lat = s >= CTX; const int tok = s - CTX;
  const bf16_t* pr = p.Pb + (size_t)row * INWP;
  { const u32x2 v = *(const u32x2*)(pr + C_DQ + lane * 4); float x[4] = {bflo(v.x), bfhi(v.x), bflo(v.y), bfhi(v.y)};
    const float ss = wave_sum(x[0] * x[0] + x[1] * x[1] + x[2] * x[2] + x[3] * x[3]); const float rs = rsqrtf(ss * (1.f / 256.f) + 1e-6f);
    const f32x4 g = *(const f32x4*)(p.g_cq + l * 256 + lane * 4); u32x2 w; w.x = cvt_pk_bf16(x[0] * rs * g[0], x[1] * rs * g[1]); w.y = cvt_pk_bf16(x[2] * rs * g[2], x[3] * rs * g[3]);
    *(u32x2*)(p.A2b + (size_t)row * MLAK + lane * 4) = w; }
  { const unsigned v = *(const unsigned*)(pr + C_DKV + lane * 2); const float x0 = bflo(v), x1 = bfhi(v);
    const float ss = wave_sum(x0 * x0 + x1 * x1); const float rs = rsqrtf(ss * (1.f / 128.f) + 1e-6f);
    const float g0 = p.g_ckv[l * 128 + lane * 2], g1 = p.g_ckv[l * 128 + lane * 2 + 1];
    *(unsigned*)(p.A2b + (size_t)row * MLAK + 256 + lane * 2) = cvt_pk_bf16(x0 * rs * g0, x1 * rs * g1); }
  { const float x = bf2f(pr[C_KR + lane]); const float xp = __shfl_xor(x, 16); float y = x;
    if (lat) { const int hh = lane >> 5, ii = lane & 31, fi = ii & 15; const float pos = (float)(hh == 0 ? (tok >> 6) : (tok & 63));
      const float ang = pos * __expf(-(float)fi * (9.210340371976184f / 16.f)); const float cs = __cosf(ang), sn = __sinf(ang);
      y = ii < 16 ? x * cs - xp * sn : x * cs + xp * sn; }
    unsigned u = __float_as_uint(y); u += 0x7fffu + ((u >> 16) & 1u); p.KRb[(size_t)row * 64 + lane] = (bf16_t)(u >> 16); }
}

struct EpiMla {
    static constexpr bool PERM = false;
    bf16_t *Q, *Kn, *V;
    __device__ __forceinline__ void operator()(const f32x4 (&acc)[2][2][4][2], const Unit& u, int wr, int wc, int fr, int fq) const {
        const int row0 = u.pm * BM + wr * 64 + fr; const bool ctxt = (u.pm % 17) == 0; const int tok0 = (u.pm % 17 - 1) * 256 + wr * 64 + fr;
        if (u.pn < 3) {
#pragma unroll
            for (int bj = 0; bj < 2; ++bj) { const int cg = u.pn * 256 + bj * 128 + wc * 32;
                const int g6 = (cg >> 5) % 6;
                float inv[4];
#pragma unroll
                for (int j = 0; j < 4; ++j) inv[j] = __expf(-(float)(4 * fq + j) * (9.210340371976184f / 16.f));
#pragma unroll
                for (int ai = 0; ai < 2; ++ai)
#pragma unroll
                    for (int m = 0; m < 4; ++m) { const int row = row0 + ai * HALF + m * 16; f32x4 v0 = acc[ai][bj][m][0], v1 = acc[ai][bj][m][1];
                        if (g6 >= 4 && !ctxt) { const int tok = tok0 + ai * HALF + m * 16; const float pos = (float)(g6 == 4 ? (tok >> 6) : (tok & 63));
#pragma unroll
                            for (int j = 0; j < 4; ++j) { const float ang = pos * inv[j]; const float cs = __cosf(ang), sn = __sinf(ang); const float x1 = v0[j], x2 = v1[j]; v0[j] = x1 * cs - x2 * sn; v1[j] = x2 * cs + x1 * sn; } }
                        v0 = v0 * QSCALE; v1 = v1 * QSCALE;
                        bf16_t* qp = Q + (size_t)row * 768 + cg + 4 * fq; u32x2 w0, w1; w0.x = cvt_pk_bf16(v0[0], v0[1]); w0.y = cvt_pk_bf16(v0[2], v0[3]); w1.x = cvt_pk_bf16(v1[0], v1[1]); w1.y = cvt_pk_bf16(v1[2], v1[3]);
                        *(u32x2*)qp = w0; *(u32x2*)(qp + 16) = w1; } }
        } else { const int h = u.pn - 3;
#pragma unroll
            for (int bj = 0; bj < 2; ++bj) { bf16_t* base = (bj == 0 ? Kn : V) + h * 128 + wc * 32 + 4 * fq;
#pragma unroll
                for (int ai = 0; ai < 2; ++ai)
#pragma unroll
                    for (int m = 0; m < 4; ++m) { const int row = row0 + ai * HALF + m * 16; const f32x4 v0 = acc[ai][bj][m][0], v1 = acc[ai][bj][m][1];
                        u32x2 w0, w1; w0.x = cvt_pk_bf16(v0[0], v0[1]); w0.y = cvt_pk_bf16(v0[2], v0[3]); w1.x = cvt_pk_bf16(v1[0], v1[1]); w1.y = cvt_pk_bf16(v1[2], v1[3]);
                        *(u32x2*)(base + (size_t)row * 512) = w0; *(u32x2*)(base + (size_t)row * 512 + 16) = w1; } } }
    }
};
__device__ void ph_mla_gemm(const FP& p, int l, LAS unsigned char* lds) {
  Gemm g; g.A = p.A2b; g.Bt = p.Wt_mla + (size_t)l * MLAN * MLAK; g.M = T; g.N = MLAN; g.K = MLAK;
  StaticOrder S; S.init(T, MLAN, MLAK, gridDim.x, blockIdx.x); EpiMla E; E.Q = p.Qb; E.Kn = p.Knb; E.V = p.Vb;
  gemm_phase<EpiMla, StaticOrder>(lds, g, S, E);
}

namespace att {
constexpr int NW = 8, QBLK = 32, KVBLK = 64;
constexpr float THRL = 8.f * 1.4426950408889634f;
constexpr int SHM_V = KVBLK * 128 * 2, SHM_K = KVBLK * 128 * 2, SHM_R = KVBLK * 64 * 2;
constexpr int OFF_V = 0, OFF_K = 2 * SHM_V, OFF_R = OFF_K + 2 * SHM_K, OFF_WS = OFF_R + 2 * SHM_R, OFF_Q = OFF_WS + NW * 64 * 4, SHM_ATTN = OFF_Q + 256 * 128;
#define KSWZ(row, colB) ((row) * 256 + ((colB) ^ (((row) & 7) << 4)))
#define RSWZ(row, colB) ((row) * 128 + ((colB) ^ ((((row) >> 1) & 7) << 4)))
#define SBAR() __builtin_amdgcn_sched_barrier(0)
__device__ __forceinline__ int crow(int r, int hi) { return (r & 3) + 8 * (r >> 2) + 4 * hi; }
__device__ __forceinline__ void partialSM(f32x16& p0, f32x16& p1, float& m_reg, float& mn, float& alpha) {
  float pmax = p0[0];
#pragma unroll
  for (int r = 1; r < 16; ++r) pmax = fmaxf(pmax, p0[r]);
#pragma unroll
  for (int r = 0; r < 16; ++r) pmax = fmaxf(pmax, p1[r]);
  { auto rr = __builtin_amdgcn_permlane32_swap(__float_as_uint(pmax), __float_as_uint(pmax), false, false); pmax = fmaxf(__uint_as_float(rr[0]), __uint_as_float(rr[1])); }
  if (__builtin_expect(__all(pmax - m_reg <= THRL), 1)) { mn = m_reg; alpha = 1.f; }
  else { mn = fmaxf(m_reg, pmax); alpha = __builtin_amdgcn_exp2f(m_reg - mn); m_reg = mn; }
#pragma unroll
  for (int r = 0; r < 16; ++r) p0[r] = p0[r] - mn;
#pragma unroll
  for (int r = 0; r < 16; ++r) p1[r] = p1[r] - mn;
#pragma unroll
  for (int r = 0; r < 16; ++r) p0[r] = __builtin_amdgcn_exp2f(p0[r]);
}
__device__ __forceinline__ void finishSM(f32x16& p0, f32x16& p1, float alpha, float& l_reg, bf16x8& pa0, bf16x8& pa1, bf16x8& pa2, bf16x8& pa3) {
#pragma unroll
  for (int r = 0; r < 16; ++r) p1[r] = __builtin_amdgcn_exp2f(p1[r]);
  float ps = 0;
#pragma unroll
  for (int r = 0; r < 16; ++r) ps += p0[r];
#pragma unroll
  for (int r = 0; r < 16; ++r) ps += p1[r];
  { auto rr = __builtin_amdgcn_permlane32_swap(__float_as_uint(ps), __float_as_uint(ps), false, false); ps = __uint_as_float(rr[0]) + __uint_as_float(rr[1]); }
  l_reg = l_reg * alpha + ps;
#define PK4(P, BASE, OUT) do { unsigned a0 = cvt_pk_bf16(P[BASE + 0], P[BASE + 1]), a1 = cvt_pk_bf16(P[BASE + 2], P[BASE + 3]);   \
    unsigned b0 = cvt_pk_bf16(P[BASE + 4], P[BASE + 5]), b1 = cvt_pk_bf16(P[BASE + 6], P[BASE + 7]);                              \
    auto r0 = __builtin_amdgcn_permlane32_swap(a0, b0, false, false); auto r1 = __builtin_amdgcn_permlane32_swap(a1, b1, false, false); \
    u32x4 w = {r0[0], r1[0], r0[1], r1[1]}; OUT = *reinterpret_cast<bf16x8*>(&w); } while (0)
  PK4(p0, 0, pa0); PK4(p0, 8, pa1); PK4(p1, 0, pa2); PK4(p1, 8, pa3);
#undef PK4
}
__device__ __forceinline__ void qkt(f32x16& p0, f32x16& p1, const char* Ks, const char* Rs, const bf16x8* qr, const char* qrow, int qsw, int r32, int hi) {
  p0 = f32x16{}; p1 = f32x16{};
#pragma unroll
  for (int d0 = 0; d0 < 8; ++d0) { const int cb = (d0 * 16 + hi * 8) * 2;
    const bf16x8 b0 = *reinterpret_cast<const bf16x8*>(Ks + KSWZ(r32, cb));
    const bf16x8 b1 = *reinterpret_cast<const bf16x8*>(Ks + KSWZ(32 + r32, cb));
    p0 = __builtin_amdgcn_mfma_f32_32x32x16_bf16(b0, qr[d0], p0, 0, 0, 0);
    p1 = __builtin_amdgcn_mfma_f32_32x32x16_bf16(b1, qr[d0], p1, 0, 0, 0); }
#pragma unroll
  for (int d0 = 0; d0 < 4; ++d0) { const int cb = (d0 * 16 + hi * 8) * 2;
    const bf16x8 b0 = *reinterpret_cast<const bf16x8*>(Rs + RSWZ(r32, cb));
    const bf16x8 b1 = *reinterpret_cast<const bf16x8*>(Rs + RSWZ(32 + r32, cb));
    const bf16x8 qf = *reinterpret_cast<const bf16x8*>(qrow + (cb ^ qsw));
    p0 = __builtin_amdgcn_mfma_f32_32x32x16_bf16(b0, qf, p0, 0, 0, 0);
    p1 = __builtin_amdgcn_mfma_f32_32x32x16_bf16(b1, qf, p1, 0, 0, 0); }
}
__device__ __forceinline__ int v_st(int k, int c) { const int kk = (k & ~0xC) | ((k & 4) << 1) | ((k & 8) >> 1); return ((kk >> 3) * 4 + (c >> 5)) * 512 + ((kk & 7) * 32 + (c & 31)) * 2; }
__device__ __forceinline__ int v_rd_base(int lane) { return ((lane & 3) << 3) | (((lane >> 2) & 3) << 6) | (((lane >> 4) & 1) << 5) | (((lane >> 5) & 1) << 8); }
constexpr int v_rd_off(int d0, int ks, int half) { return d0 * 512 + ks * 4096 + half * 2048; }
template <int OFF> __device__ __forceinline__ s16x4 tr_read(int vb) { s16x4 r; asm volatile("ds_read_b64_tr_b16 %0, %1 offset:%2" : "=&v"(r) : "v"(vb), "i"(OFF) : "memory"); return r; }
template <int D0> __device__ __forceinline__ void pv_one(f32x16& od, int vb, bf16x8 pa0, bf16x8 pa1, bf16x8 pa2, bf16x8 pa3) {
  const s16x4 l0 = tr_read<v_rd_off(D0, 0, 0)>(vb), h0 = tr_read<v_rd_off(D0, 0, 1)>(vb), l1 = tr_read<v_rd_off(D0, 1, 0)>(vb), h1 = tr_read<v_rd_off(D0, 1, 1)>(vb);
  const s16x4 l2 = tr_read<v_rd_off(D0, 2, 0)>(vb), h2 = tr_read<v_rd_off(D0, 2, 1)>(vb), l3 = tr_read<v_rd_off(D0, 3, 0)>(vb), h3 = tr_read<v_rd_off(D0, 3, 1)>(vb);
  asm volatile("s_waitcnt lgkmcnt(0)" ::: "memory"); SBAR();
#define PK(L, H) (bf16x8){L[0], L[1], L[2], L[3], H[0], H[1], H[2], H[3]}
  od = __builtin_amdgcn_mfma_f32_32x32x16_bf16(pa0, PK(l0, h0), od, 0, 0, 0);
  od = __builtin_amdgcn_mfma_f32_32x32x16_bf16(pa1, PK(l1, h1), od, 0, 0, 0);
  od = __builtin_amdgcn_mfma_f32_32x32x16_bf16(pa2, PK(l2, h2), od, 0, 0, 0);
  od = __builtin_amdgcn_mfma_f32_32x32x16_bf16(pa3, PK(l3, h3), od, 0, 0, 0);
#undef PK
}
__device__ __forceinline__ void pv_d0(f32x16* o, int vb, bf16x8 pa0, bf16x8 pa1, bf16x8 pa2, bf16x8 pa3) {
  pv_one<0>(o[0], vb, pa0, pa1, pa2, pa3); pv_one<1>(o[1], vb, pa0, pa1, pa2, pa3); pv_one<2>(o[2], vb, pa0, pa1, pa2, pa3); pv_one<3>(o[3], vb, pa0, pa1, pa2, pa3);
}
__device__ __forceinline__ void attn_body(const bf16_t* __restrict__ Qb, const bf16_t* __restrict__ Kh, const bf16_t* __restrict__ Rh, const bf16_t* __restrict__ Vh,
                                          bf16_t* __restrict__ Ob, int seq, char* lds) {
  const int tid = threadIdx.x, wid = tid >> 6, lane = tid & 63, r32 = lane & 31, hi = lane >> 5;
  char* V_lds = lds + OFF_V; char* K_lds = lds + OFF_K; char* R_lds = lds + OFF_R;
  float* ws = (float*)(lds + OFF_WS) + wid * 64; float* li_l = ws; float* al_l = ws + 32;
  float m_reg = -1e30f, l_reg = 0; f32x16 o[4] = {}; bf16x8 qr[8];
  const bf16_t* Qw = Qb + (size_t)(wid * QBLK + r32) * 768 + hi * 8;
#pragma unroll
  for (int d0 = 0; d0 < 8; ++d0) qr[d0] = *reinterpret_cast<const bf16x8*>(Qw + d0 * 16);
  const int qrowi = wid * QBLK + r32; char* qrow = lds + OFF_Q + qrowi * 128; const int qsw = ((qrowi >> 1) & 7) << 4;
#pragma unroll
  for (int d0 = 0; d0 < 4; ++d0) *reinterpret_cast<bf16x8*>(qrow + (((d0 * 16 + hi * 8) * 2) ^ qsw)) = *reinterpret_cast<const bf16x8*>(Qw + (8 + d0) * 16);
  const int sr = tid >> 4, sc = (tid & 15) * 8, vst0 = v_st(sr, sc), vst1 = v_st(32 + sr, sc);
  const int rr = tid >> 3, rc = (tid & 7) * 8;
  const int vb0 = (int)(uintptr_t)V_lds + v_rd_base(lane);
  bf16x8 vs0, vs1, ks0, ks1, rs0;
  const unsigned kvo0 = (unsigned)(sr * 512 + sc) * 2u, kvo1 = kvo0 + 32u * 512u * 2u, ro0 = (unsigned)(rr * 64 + rc) * 2u;
#define SLOAD(k0) do { const char* Vt = (const char*)Vh + (size_t)(k0) * 1024; const char* Kt = (const char*)Kh + (size_t)(k0) * 1024; const char* Rt = (const char*)Rh + (size_t)(k0) * 128; \
    vs0 = *(const bf16x8*)(Vt + kvo0); vs1 = *(const bf16x8*)(Vt + kvo1); ks0 = *(const bf16x8*)(Kt + kvo0); ks1 = *(const bf16x8*)(Kt + kvo1); rs0 = *(const bf16x8*)(Rt + ro0); } while (0)
#define SWRITE(b) do { *(bf16x8*)(V_lds + (b) * SHM_V + vst0) = vs0; *(bf16x8*)(V_lds + (b) * SHM_V + vst1) = vs1; const int kc = sc * 2; \
    *(bf16x8*)(K_lds + (b) * SHM_K + KSWZ(sr, kc)) = ks0; *(bf16x8*)(K_lds + (b) * SHM_K + KSWZ(32 + sr, kc)) = ks1; \
    *(bf16x8*)(R_lds + (b) * SHM_R + RSWZ(rr, rc * 2)) = rs0; } while (0)
#define SWAIT() asm volatile("s_waitcnt vmcnt(0)" ::: "memory")
#define RESC(a) do { if (__any((a) < 1.f)) { if (hi == 0) al_l[r32] = (a); asm volatile("s_waitcnt lgkmcnt(0)" ::: "memory"); \
    _Pragma("unroll") for (int d = 0; d < 4; ++d) _Pragma("unroll") for (int r = 0; r < 16; ++r) o[d][r] *= al_l[crow(r, hi)]; } } while (0)
  f32x16 pA0, pA1, pB0, pB1; float mnA, mnB, alA, alB; bf16x8 pa0, pa1, pa2, pa3; const int NT = seq / KVBLK;
  SLOAD(0); SWAIT(); SWRITE(0); __syncthreads();
  qkt(pA0, pA1, K_lds, R_lds, qr, qrow, qsw, r32, hi); partialSM(pA0, pA1, m_reg, mnA, alA);
  SLOAD(KVBLK);
  SWAIT(); SWRITE(1); __syncthreads();
  for (int j = 1; j + 1 < NT; j += 2) {
    SBAR(); qkt(pB0, pB1, K_lds + SHM_K, R_lds + SHM_R, qr, qrow, qsw, r32, hi);
    finishSM(pA0, pA1, alA, l_reg, pa0, pa1, pa2, pa3); SBAR();
    SLOAD((j + 1) * KVBLK); SBAR();
    pv_d0(o, vb0, pa0, pa1, pa2, pa3); partialSM(pB0, pB1, m_reg, mnB, alB);
    __syncthreads(); SWAIT(); SWRITE(0);
    RESC(alB); __syncthreads();
    SBAR(); qkt(pA0, pA1, K_lds, R_lds, qr, qrow, qsw, r32, hi);
    finishSM(pB0, pB1, alB, l_reg, pa0, pa1, pa2, pa3); SBAR();
    SLOAD((j + 2) * KVBLK); SBAR();
    pv_d0(o, vb0 + SHM_V, pa0, pa1, pa2, pa3); partialSM(pA0, pA1, m_reg, mnA, alA);
    __syncthreads(); SWAIT(); SWRITE(1);
    RESC(alA); __syncthreads();
  }
  SBAR(); qkt(pB0, pB1, K_lds + SHM_K, R_lds + SHM_R, qr, qrow, qsw, r32, hi);
  finishSM(pA0, pA1, alA, l_reg, pa0, pa1, pa2, pa3); SBAR();
  pv_d0(o, vb0, pa0, pa1, pa2, pa3); partialSM(pB0, pB1, m_reg, mnB, alB);
  __syncthreads(); RESC(alB);
  finishSM(pB0, pB1, alB, l_reg, pa0, pa1, pa2, pa3); SBAR();
  pv_d0(o, vb0 + SHM_V, pa0, pa1, pa2, pa3);
  if (hi == 0) li_l[r32] = l_reg; asm volatile("s_waitcnt lgkmcnt(0)" ::: "memory");
  float rli[16];
#pragma unroll
  for (int r = 0; r < 16; ++r) rli[r] = __builtin_amdgcn_rcpf(li_l[crow(r, hi)]);
  { int tz = threadIdx.x; asm volatile("" : "+v"(tz)); const int wz = tz >> 6, lz = tz & 63; const unsigned ob = (unsigned)((wz * QBLK + 4 * (lz >> 5)) * 512 + (lz & 31)) * 2u;
#pragma unroll
    for (int r = 0; r < 16; ++r) {
#pragma unroll
      for (int d0 = 0; d0 < 4; ++d0) { unsigned u = __float_as_uint(o[d0][r] * rli[r]); u += 0x7fffu + ((u >> 16) & 1u);
        *(bf16_t*)((char*)Ob + ob + (unsigned)((((r & 3) + 8 * (r >> 2)) * 512 + d0 * 32) * 2)) = (bf16_t)(u >> 16); } } }
  __syncthreads();
#undef SLOAD
#undef SWRITE
#undef SWAIT
#undef RESC
}
}

__device__ void ph_attn(const FP& p, int l, char* shm) {
  const int nctx = (l == DEPTH - 1) ? 0 : NB * 4; const int nun = NB * 4 * 16 + nctx;
  for (int u = blockIdx.x; u < nun; u += gridDim.x) {
    int b, h, qoff, seq;
    if (u < NB * 4 * 16) { b = u >> 6; h = (u >> 4) & 3; qoff = CTX + (u & 15) * 256; seq = SB; }
    else { const int uu = u - NB * 4 * 16; b = uu >> 2; h = uu & 3; qoff = 0; seq = CTX; }
    const size_t r0 = (size_t)b * SB, q0 = r0 + qoff;
    att::attn_body(p.Qb + q0 * 768 + h * 192, p.Knb + r0 * 512 + h * 128, p.KRb + r0 * 64, p.Vb + r0 * 512 + h * 128, p.AOb + q0 * 512 + h * 128, seq, shm);
  }
}

__device__ __forceinline__ void mla_out_row(const FP& p, int l, int row, int lane) {
  const u32x4 v = *(const u32x4*)(p.AOb + (size_t)row * 512 + lane * 8);
  float x[8] = {bflo(v.x), bfhi(v.x), bflo(v.y), bfhi(v.y), bflo(v.z), bfhi(v.z), bflo(v.w), bfhi(v.w)}; float ss = 0.f;
#pragma unroll
  for (int j = 0; j < 8; ++j) ss += x[j] * x[j];
  ss = wave_sum(ss); const float rs = rsqrtf(ss * (1.f / 512.f) + 1e-6f);
  const f32x4 g0 = *(const f32x4*)(p.g_mla + l * 512 + lane * 8), g1 = *(const f32x4*)(p.g_mla + l * 512 + lane * 8 + 4);
  u32x4 w; w.x = cvt_pk_bf16(x[0] * rs * g0[0], x[1] * rs * g0[1]); w.y = cvt_pk_bf16(x[2] * rs * g0[2], x[3] * rs * g0[3]);
  w.z = cvt_pk_bf16(x[4] * rs * g1[0], x[5] * rs * g1[1]); w.w = cvt_pk_bf16(x[6] * rs * g1[2], x[7] * rs * g1[3]);
  *(u32x4*)(p.CATb + (size_t)row * 1536 + lane * 8) = w;
}
constexpr int NCH = SB / 64;
__device__ __forceinline__ int item_idx(int dir, int bh, int cn) { return (dir * 16 + bh) * NCH + cn; }
__device__ __forceinline__ bf16_t f2bf(float f) { unsigned u = __float_as_uint(f); u += 0x7fffu + ((u >> 16) & 1u); return (bf16_t)(u >> 16); }
__device__ __forceinline__ int scan_chunk(int dir, int n) { return dir == 0 ? n : (n < 4 ? 3 - n : 71 - n); }

__device__ __forceinline__ void prep_ret_row(const FP& p, int row, int lane) {
  const int s = row % SB; const bool lat = s >= CTX; const int tok = s - CTX;
  const bf16_t* pr = p.Pb + (size_t)row * INWP;
  const u32x4 qv = *(const u32x4*)(pr + C_RQ + lane * 8), kv = *(const u32x4*)(pr + C_RK + lane * 8);
  float q[8] = {bflo(qv.x), bfhi(qv.x), bflo(qv.y), bfhi(qv.y), bflo(qv.z), bfhi(qv.z), bflo(qv.w), bfhi(qv.w)};
  float k[8] = {bflo(kv.x), bfhi(kv.x), bflo(kv.y), bfhi(kv.y), bflo(kv.z), bfhi(kv.z), bflo(kv.w), bfhi(kv.w)};
  float qo[8], ko[8];
  const bool lowh = (lane & 4) == 0;
  const float pos = (float)(((lane >> 3) & 1) == 0 ? (tok >> 6) : (tok & 63));
#pragma unroll
  for (int e = 0; e < 8; ++e) { const float qp = __shfl_xor(q[e], 4), kp = __shfl_xor(k[e], 4);
    if (lat) { const int fi = (lane & 3) * 8 + e; const float ang = pos * __expf(-(float)fi * (9.210340371976184f / 32.f)); const float cs = __cosf(ang), sn = __sinf(ang);
      qo[e] = lowh ? q[e] * cs - qp * sn : q[e] * cs + qp * sn; ko[e] = lowh ? k[e] * cs - kp * sn : k[e] * cs + kp * sn; }
    else { qo[e] = q[e]; ko[e] = k[e]; } }
  const float sc = 0.08838834764831845f;
  u32x4 wq, wk; wq.x = cvt_pk_bf16(qo[0], qo[1]); wq.y = cvt_pk_bf16(qo[2], qo[3]); wq.z = cvt_pk_bf16(qo[4], qo[5]); wq.w = cvt_pk_bf16(qo[6], qo[7]);
  wk.x = cvt_pk_bf16(ko[0] * sc, ko[1] * sc); wk.y = cvt_pk_bf16(ko[2] * sc, ko[3] * sc); wk.z = cvt_pk_bf16(ko[4] * sc, ko[5] * sc); wk.w = cvt_pk_bf16(ko[6] * sc, ko[7] * sc);
  *(u32x4*)(p.RQb + (size_t)row * 512 + lane * 8) = wq; *(u32x4*)(p.RKb + (size_t)row * 512 + lane * 8) = wk;
}

__device__ __forceinline__ void r2_item(const FP& p, int l, int bh, int cn, int t, LAS unsigned char* hl) {
  const int b = bh >> 2, h = bh & 3; const size_t row0 = (size_t)b * SB + cn * 64;
  LAS bf16_t* sk = (LAS bf16_t*)hl; LAS bf16_t* sv = sk + 64 * 136;
#pragma unroll
  for (int i = 0; i < 4; ++i) { const int idx = t + 256 * i, r = idx >> 4, c8 = (idx & 15) * 8;
    *(LAS u32x4*)(sk + r * 136 + c8) = *(const u32x4*)(p.RKb + (row0 + r) * 512 + h * 128 + c8);
    *(LAS u32x4*)(sv + r * 136 + c8) = *(const u32x4*)(p.Pb + (row0 + r) * INWP + C_RV + h * 128 + c8); }
  __syncthreads();
  const float lgf = __log2f(1.f - __expf(p.ret_decay[l * 8 + h])), lgb = __log2f(1.f - __expf(p.ret_decay[l * 8 + 4 + h]));
#pragma unroll
  for (int q = 0; q < 4; ++q) { const int sidx = t + 256 * q, f = sidx >> 6, ln = sidx & 63, tt = f >> 2, s = f & 3, c = tt * 32 + (ln & 31), hh = ln >> 5;
    { float kf[8];
#pragma unroll
      for (int jj = 0; jj < 8; ++jj) kf[jj] = bf2f(sk[(16 * s + 8 * hh + jj) * 136 + c]);
      u32x4 wf, wb; unsigned tmpf[4], tmpb[4];
#pragma unroll
      for (int jp = 0; jp < 4; ++jp) { const int j0 = 16 * s + 8 * hh + 2 * jp;
        tmpf[jp] = cvt_pk_bf16(kf[2 * jp] * exp2f(lgf * (float)(63 - j0)), kf[2 * jp + 1] * exp2f(lgf * (float)(62 - j0)));
        tmpb[jp] = cvt_pk_bf16(kf[2 * jp] * exp2f(lgb * (float)j0), kf[2 * jp + 1] * exp2f(lgb * (float)(j0 + 1))); }
      wf.x = tmpf[0]; wf.y = tmpf[1]; wf.z = tmpf[2]; wf.w = tmpf[3]; wb.x = tmpb[0]; wb.y = tmpb[1]; wb.z = tmpb[2]; wb.w = tmpb[3];
      *(u32x4*)(p.RKWT + (size_t)item_idx(0, bh, cn) * 8192 + sidx * 8) = wf; *(u32x4*)(p.RKWT + (size_t)item_idx(1, bh, cn) * 8192 + sidx * 8) = wb; }
    { unsigned short vb[8], va[8];
#pragma unroll
      for (int jj = 0; jj < 8; ++jj) { vb[jj] = sv[(16 * s + 8 * hh + jj) * 136 + c]; va[jj] = sv[(16 * s + 8 * (jj >> 2) + 4 * hh + (jj & 3)) * 136 + c]; }
      u32x4 wb2, wa2; wb2.x = vb[0] | ((unsigned)vb[1] << 16); wb2.y = vb[2] | ((unsigned)vb[3] << 16); wb2.z = vb[4] | ((unsigned)vb[5] << 16); wb2.w = vb[6] | ((unsigned)vb[7] << 16);
      wa2.x = va[0] | ((unsigned)va[1] << 16); wa2.y = va[2] | ((unsigned)va[3] << 16); wa2.z = va[4] | ((unsigned)va[5] << 16); wa2.w = va[6] | ((unsigned)va[7] << 16);
      *(u32x4*)(p.RVTB + ((size_t)bh * NCH + cn) * 8192 + sidx * 8) = wb2; *(u32x4*)(p.RVTA + ((size_t)bh * NCH + cn) * 8192 + sidx * 8) = wa2; } }
  __syncthreads();
}

__device__ void ret_scan_job(const FP& p, int l, int bh, int dir, LAS unsigned char* lds) {
  const int t = threadIdx.x, wid = __builtin_amdgcn_readfirstlane(t >> 6), lane = t & 63, hi = lane >> 5;
  const int h = bh & 3; const float lg = __log2f(1.f - __expf(p.ret_decay[l * 8 + dir * 4 + h])); const float g64 = exp2f(lg * 64.f);
  f32x16 S[4];
#pragma unroll
  for (int d = 0; d < 4; ++d)
#pragma unroll
    for (int r = 0; r < 16; ++r) S[d][r] = 0.f;
#define RS_STAGE(cn, buf) do { const char* ga = (const char*)(p.RKWT + (size_t)item_idx(dir, bh, (cn)) * 8192); const char* gb = (const char*)(p.RVTB + ((size_t)bh * NCH + (cn)) * 8192); \
    _Pragma("unroll") for (int q = 0; q < 4; ++q) { const int pc = wid + 8 * q; const char* src = (pc < 16 ? ga + pc * 1024 : gb + (pc - 16) * 1024) + lane * 16; \
      __builtin_amdgcn_global_load_lds((const unsigned*)src, (LAS unsigned*)(lds + (buf) * 32768 + pc * 1024), 16, 0, 0); } } while (0)
  __syncthreads();
  RS_STAGE(scan_chunk(dir, 0), 0);
  for (int n = 0; n < NCH; ++n) { const int cn = scan_chunk(dir, n), buf = n & 1;
    asm volatile("s_waitcnt vmcnt(0)" ::: "memory"); __syncthreads();
    if (n + 1 < NCH) RS_STAGE(scan_chunk(dir, n + 1), buf ^ 1);
    if (wid < 4) {
      bf16_t* st = p.RST + (size_t)item_idx(dir, bh, cn) * 16384;
#pragma unroll
      for (int dt = 0; dt < 4; ++dt)
#pragma unroll
        for (int g = 0; g < 4; ++g) { u32x2 w; w.x = cvt_pk_bf16(S[dt][4 * g], S[dt][4 * g + 1]); w.y = cvt_pk_bf16(S[dt][4 * g + 2], S[dt][4 * g + 3]);
          *(u32x2*)(st + ((wid * 8 + 2 * dt + (g >> 1)) * 64 + (lane & 31) + 32 * (g & 1)) * 8 + 4 * hi) = w; }
#pragma unroll
      for (int dt = 0; dt < 4; ++dt)
#pragma unroll
        for (int r = 0; r < 16; ++r) S[dt][r] *= g64;
      const LAS unsigned char* bb = lds + buf * 32768;
#pragma unroll
      for (int s = 0; s < 4; ++s) { const bf16x8 bf = *(const LAS bf16x8*)(bb + 16384 + (wid * 4 + s) * 1024 + lane * 16);
#pragma unroll
        for (int dt = 0; dt < 4; ++dt) { const bf16x8 af = *(const LAS bf16x8*)(bb + (dt * 4 + s) * 1024 + lane * 16); S[dt] = __builtin_amdgcn_mfma_f32_32x32x16_bf16(af, bf, S[dt], 0, 0, 0); } }
    }
  }
  asm volatile("s_waitcnt vmcnt(0)" ::: "memory"); __syncthreads();
#undef RS_STAGE
}

__device__ __forceinline__ bf16x8 pack_step(const f32x16& x, int s) {
  u32x4 pk; pk.x = cvt_pk_bf16(x[8 * s], x[8 * s + 1]); pk.y = cvt_pk_bf16(x[8 * s + 2], x[8 * s + 3]); pk.z = cvt_pk_bf16(x[8 * s + 4], x[8 * s + 5]); pk.w = cvt_pk_bf16(x[8 * s + 6], x[8 * s + 7]);
  return __builtin_bit_cast(bf16x8, pk);
}
__device__ __forceinline__ bf16x8 scale_frag(bf16x8 a, float f) {
  const u32x4 v = __builtin_bit_cast(u32x4, a); u32x4 o;
  o.x = cvt_pk_bf16(bflo(v.x) * f, bfhi(v.x) * f); o.y = cvt_pk_bf16(bflo(v.y) * f, bfhi(v.y) * f); o.z = cvt_pk_bf16(bflo(v.z) * f, bfhi(v.z) * f); o.w = cvt_pk_bf16(bflo(v.w) * f, bfhi(v.w) * f);
  return __builtin_bit_cast(bf16x8, o);
}
__device__ __forceinline__ int crow16(int r, int hi) { return (r & 3) + 8 * (r >> 2) + 4 * hi; }

__device__ void ret_out_unit(const FP& p, int l, int bh, int cn, int ih, int lane) {
  const int b = bh >> 2, h = bh & 3, c32 = lane & 31, hi = lane >> 5; const size_t row0 = (size_t)b * SB + cn * 64; const int ipos = 32 * ih + c32;
  const float lgf = __log2f(1.f - __expf(p.ret_decay[l * 8 + h])), lgb = __log2f(1.f - __expf(p.ret_decay[l * 8 + 4 + h]));
  const unsigned lo16 = (unsigned)lane * 16u;
  f32x16 P0, P1;
#pragma unroll
  for (int r = 0; r < 16; ++r) { P0[r] = 0.f; P1[r] = 0.f; }
  const char* qb = (const char*)(p.RQb + (row0 + 32 * ih) * 512 + h * 128); const char* kb = (const char*)(p.RKb + row0 * 512 + h * 128);
  const unsigned rowoff = (unsigned)(c32 * 512 + 8 * hi) * 2u;
#pragma unroll 1
  for (int s = 0; s < 8; ++s) { const bf16x8 qf = *(const bf16x8*)(qb + rowoff + s * 32); const bf16x8 k0 = *(const bf16x8*)(kb + rowoff + s * 32), k1 = *(const bf16x8*)(kb + 32 * 1024 + rowoff + s * 32);
    P0 = __builtin_amdgcn_mfma_f32_32x32x16_bf16(k0, qf, P0, 0, 0, 0); P1 = __builtin_amdgcn_mfma_f32_32x32x16_bf16(k1, qf, P1, 0, 0, 0); }
  bf16x8 pb[2][2][2];
#pragma unroll
  for (int dir = 0; dir < 2; ++dir) { const float lg = dir == 0 ? lgf : lgb;
#pragma unroll
    for (int jt = 0; jt < 2; ++jt) { f32x16 pd;
#pragma unroll
      for (int r = 0; r < 16; ++r) { const int j = 32 * jt + crow16(r, hi); const int dlt = dir == 0 ? ipos - j : j - ipos; const float pv = jt == 0 ? P0[r] : P1[r]; pd[r] = dlt >= 0 ? pv * exp2f(lg * (float)dlt) : 0.f; }
      pb[dir][jt][0] = pack_step(pd, 0); pb[dir][jt][1] = pack_step(pd, 1); } }
  __builtin_amdgcn_sched_barrier(0);
  f32x16 O[4];
  const char* va = (const char*)(p.RVTA + ((size_t)bh * NCH + cn) * 8192);
#pragma unroll
  for (int et = 0; et < 4; ++et) { f32x16 a;
#pragma unroll
    for (int r = 0; r < 16; ++r) a[r] = 0.f;
    const char* vae = va + et * 4096;
#pragma unroll
    for (int jt = 0; jt < 2; ++jt)
#pragma unroll
      for (int ss = 0; ss < 2; ++ss) { const bf16x8 af = *(const bf16x8*)(vae + lo16 + (2 * jt + ss) * 1024);
        a = __builtin_amdgcn_mfma_f32_32x32x16_bf16(af, pb[0][jt][ss], a, 0, 0, 0); a = __builtin_amdgcn_mfma_f32_32x32x16_bf16(af, pb[1][jt][ss], a, 0, 0, 0); }
    O[et] = a; __builtin_amdgcn_sched_barrier(0); }
  const float facf = exp2f(lgf * (float)(ipos + 1)), facb = exp2f(lgb * (float)(64 - ipos));
  const char* stf = (const char*)(p.RST + (size_t)item_idx(0, bh, cn) * 16384); const char* stb = (const char*)(p.RST + (size_t)item_idx(1, bh, cn) * 16384);
#pragma unroll 1
  for (int s = 0; s < 8; ++s) { const bf16x8 qf = *(const bf16x8*)(qb + rowoff + s * 32); const bf16x8 qsf = scale_frag(qf, facf), qsb = scale_frag(qf, facb);
#pragma unroll
    for (int et = 0; et < 4; ++et) { const bf16x8 af = *(const bf16x8*)(stf + et * 8192 + s * 1024 + lo16), ab = *(const bf16x8*)(stb + et * 8192 + s * 1024 + lo16);
      O[et] = __builtin_amdgcn_mfma_f32_32x32x16_bf16(af, qsf, O[et], 0, 0, 0); O[et] = __builtin_amdgcn_mfma_f32_32x32x16_bf16(ab, qsb, O[et], 0, 0, 0); } }
  float sm = 0.f;
#pragma unroll
  for (int et = 0; et < 4; ++et)
#pragma unroll
    for (int r = 0; r < 16; ++r) sm += O[et][r];
  sm += __shfl_xor(sm, 32); const float mu = sm * (1.f / 128.f); float vq = 0.f;
#pragma unroll
  for (int et = 0; et < 4; ++et)
#pragma unroll
    for (int r = 0; r < 16; ++r) { const float dd = O[et][r] - mu; vq += dd * dd; }
  vq += __shfl_xor(vq, 32); const float rs = rsqrtf(vq * (1.f / 128.f) + 1e-5f);
  const size_t row = row0 + ipos; const bf16_t* gp = p.Pb + row * INWP + C_RG + h * 128; const float* gr = p.g_ret + l * 512 + h * 128; bf16_t* op = p.CATb + row * 1536 + 512 + h * 128;
#pragma unroll
  for (int et = 0; et < 4; ++et)
#pragma unroll
    for (int g = 0; g < 4; ++g) { const int e0 = 32 * et + 8 * g + 4 * hi; const u32x2 gz = *(const u32x2*)(gp + e0); const f32x4 gg = *(const f32x4*)(gr + e0);
      const float z[4] = {bflo(gz.x), bfhi(gz.x), bflo(gz.y), bfhi(gz.y)}; float y[4];
#pragma unroll
      for (int j = 0; j < 4; ++j) y[j] = (O[et][4 * g + j] - mu) * rs * gg[j] * silu_f(z[j]);
      u32x2 w; w.x = cvt_pk_bf16(y[0], y[1]); w.y = cvt_pk_bf16(y[2], y[3]); *(u32x2*)(op + e0) = w; }
}
__device__ __forceinline__ void prep_gdn_row(const FP& p, int l, int row, int lane) {
  const int s = row % SB; const bool lat = s >= CTX; const int lo = lat ? CTX : 0, hi_ = lat ? SB : CTX;
  const float* cw = p.gdn_conv + (size_t)l * 5 * 1536;
  float o[3][8];
#pragma unroll
  for (int blk = 0; blk < 3; ++blk) {
#pragma unroll
    for (int e = 0; e < 8; ++e) o[blk][e] = 0.f;
#pragma unroll
    for (int j = 0; j < 5; ++j) { const int s2 = s + j - 2; if (s2 < lo || s2 >= hi_) continue;
      const u32x4 xv = *(const u32x4*)(p.Pb + (size_t)(row + j - 2) * INWP + C_GQ + blk * 512 + lane * 8);
      const f32x4 w0 = *(const f32x4*)(cw + j * 1536 + blk * 512 + lane * 8), w1 = *(const f32x4*)(cw + j * 1536 + blk * 512 + lane * 8 + 4);
      o[blk][0] += w0[0] * bflo(xv.x); o[blk][1] += w0[1] * bfhi(xv.x); o[blk][2] += w0[2] * bflo(xv.y); o[blk][3] += w0[3] * bfhi(xv.y);
      o[blk][4] += w1[0] * bflo(xv.z); o[blk][5] += w1[1] * bfhi(xv.z); o[blk][6] += w1[2] * bflo(xv.w); o[blk][7] += w1[3] * bfhi(xv.w); }
#pragma unroll
    for (int e = 0; e < 8; ++e) o[blk][e] = silu_f(o[blk][e]); }
#pragma unroll
  for (int blk = 0; blk < 2; ++blk) { float ss = 0.f;
#pragma unroll
    for (int e = 0; e < 8; ++e) ss += o[blk][e] * o[blk][e];
    ss += __shfl_xor(ss, 1); ss += __shfl_xor(ss, 2); ss += __shfl_xor(ss, 4); ss += __shfl_xor(ss, 8);
    const float rs = rsqrtf(ss + 1e-6f) * (blk == 0 ? 0.08838834764831845f : 1.f);
#pragma unroll
    for (int e = 0; e < 8; ++e) o[blk][e] *= rs; }
  u32x4 w;
  w.x = cvt_pk_bf16(o[0][0], o[0][1]); w.y = cvt_pk_bf16(o[0][2], o[0][3]); w.z = cvt_pk_bf16(o[0][4], o[0][5]); w.w = cvt_pk_bf16(o[0][6], o[0][7]); *(u32x4*)(p.GQb + (size_t)row * 512 + lane * 8) = w;
  w.x = cvt_pk_bf16(o[1][0], o[1][1]); w.y = cvt_pk_bf16(o[1][2], o[1][3]); w.z = cvt_pk_bf16(o[1][4], o[1][5]); w.w = cvt_pk_bf16(o[1][6], o[1][7]); *(u32x4*)(p.GKb + (size_t)row * 512 + lane * 8) = w;
  w.x = cvt_pk_bf16(o[2][0], o[2][1]); w.y = cvt_pk_bf16(o[2][2], o[2][3]); w.z = cvt_pk_bf16(o[2][4], o[2][5]); w.w = cvt_pk_bf16(o[2][6], o[2][7]); *(u32x4*)(p.GVb + (size_t)row * 512 + lane * 8) = w;
  if (lane < 8) { const float a = p.GAB[(size_t)row * 16 + lane] + p.gdn_dt_bias[l * 8 + lane]; const float sp = a > 20.f ? a : log1pf(expf(a));
    p.GLA[(size_t)row * 8 + lane] = -expf(p.gdn_a_log[l * 8 + lane]) * sp; p.GBETA[(size_t)row * 8 + lane] = 1.f / (1.f + expf(-p.GAB[(size_t)row * 16 + 8 + lane])); }
}

__device__ __forceinline__ void g2_item(const FP& p, int bh, int dir, int cn, int t, LAS unsigned char* hl) {
  const int b = bh >> 2, h = bh & 3, w = t >> 6, lane = t & 63, c32 = lane & 31, hi = lane >> 5; const size_t row0 = (size_t)b * SB + cn * 64;
  LAS float* sA = (LAS float*)hl; LAS float* sg = sA + 64 * 64; LAS float* sb = sg + 64;
  const int item = item_idx(dir, bh, cn);
  if (w == 0) { float la = p.GLA[(row0 + lane) * 8 + dir * 4 + h]; const float bt = p.GBETA[(row0 + lane) * 8 + dir * 4 + h];
#pragma unroll
    for (int o = 1; o < 64; o <<= 1) { const float v = dir == 0 ? __shfl_up(la, o) : __shfl_down(la, o); if (dir == 0 ? lane >= o : lane + o < 64) la += v; }
    sg[lane] = la; sb[lane] = bt; p.GG[(size_t)item * 64 + lane] = la; }
  __syncthreads();
  { const int it = w >> 1, jt = w & 1; f32x16 a;
#pragma unroll
    for (int r = 0; r < 16; ++r) a[r] = 0.f;
    const bf16_t* ka = p.GKb + (row0 + 32 * it + c32) * 512 + h * 128 + 8 * hi; const bf16_t* kb = p.GKb + (row0 + 32 * jt + c32) * 512 + h * 128 + 8 * hi;
#pragma unroll
    for (int s = 0; s < 8; ++s) a = __builtin_amdgcn_mfma_f32_32x32x16_bf16(*(const bf16x8*)(ka + 16 * s), *(const bf16x8*)(kb + 16 * s), a, 0, 0, 0);
    const int j = 32 * jt + c32; const float gj = sg[j];
#pragma unroll
    for (int r = 0; r < 16; ++r) { const int i = 32 * it + crow16(r, hi); const bool before = dir == 0 ? j < i : j > i;
      const float v = before ? sb[i] * a[r] * __expf(fminf(sg[i] - gj, 0.f)) : 0.f;
      if (dir == 0) sA[i * 64 + j] = v; else sA[(63 - i) * 64 + (63 - j)] = v; } }
  __syncthreads();
  { float x[64]; const float glast = sg[dir == 0 ? 63 : 0];
    if (t < 128) {
#pragma unroll
      for (int ip = 0; ip < 64; ++ip) { const int i = dir == 0 ? ip : 63 - ip; x[ip] = sb[i] * bf2f(p.GVb[(row0 + i) * 512 + h * 128 + t]); }
    } else { const int d = t - 128; bf16_t* kt = p.GKTT + (size_t)item * 8192;
#pragma unroll
      for (int ip = 0; ip < 64; ++ip) { const int i = dir == 0 ? ip : 63 - ip; const float kv = bf2f(p.GKb[(row0 + i) * 512 + h * 128 + d]); x[ip] = sb[i] * kv * __expf(sg[i]);
        const float ktv = kv * __expf(glast - sg[i]); const int kk = i & 15, hp = (kk >> 2) & 1, jj = ((kk >> 3) << 2) | (kk & 3);
        kt[(((d >> 5) * 4 + (i >> 4)) * 64 + (d & 31) + 32 * hp) * 8 + jj] = f2bf(ktv); } }
#pragma unroll
    for (int ip = 1; ip < 64; ++ip) { float acc = x[ip];
#pragma unroll
      for (int jp = 0; jp < ip; ++jp) acc -= sA[ip * 64 + jp] * x[jp];
      x[ip] = acc; }
    if (t < 128) { const int e = t; bf16_t* ut = p.GUT + (size_t)item * 8192;
#pragma unroll
      for (int ip = 0; ip < 64; ++ip) { const int i = dir == 0 ? ip : 63 - ip; const int rem = i & 31;
        ut[((((e >> 5) * 2 + (i >> 5)) * 4 + (rem >> 3)) * 64 + (e & 31) + 32 * ((rem >> 2) & 1)) * 4 + (rem & 3)] = f2bf(x[ip]); }
    } else { const int d = t - 128; bf16_t* gw = p.GWb + (size_t)item * 8192; const int kk = d & 15, hp = (kk >> 2) & 1, jj = ((kk >> 3) << 2) | (kk & 3);
#pragma unroll
      for (int ip = 0; ip < 64; ++ip) { const int i = dir == 0 ? ip : 63 - ip; gw[(((i >> 5) * 8 + (d >> 4)) * 64 + (i & 31) + 32 * hp) * 8 + jj] = f2bf(x[ip]); } } }
  __syncthreads();
}

__device__ void gdn_scan_job(const FP& p, int bh, int dir, LAS unsigned char* lds) {
  const int t = threadIdx.x, wid = __builtin_amdgcn_readfirstlane(t >> 6), lane = t & 63, hi = lane >> 5;
  f32x16 S[4];
#pragma unroll
  for (int d = 0; d < 4; ++d)
#pragma unroll
    for (int r = 0; r < 16; ++r) S[d][r] = 0.f;
#define GS_STAGE(cn, buf) do { const size_t io = (size_t)item_idx(dir, bh, (cn)) * 8192 * 2; const char* g0 = (const char*)p.GWb + io; const char* g1 = (const char*)p.GKTT + io; const char* g2 = (const char*)p.GUT + io; \
    _Pragma("unroll") for (int q = 0; q < 6; ++q) { const int pc = wid + 8 * q; const char* src = (pc < 16 ? g0 + pc * 1024 : (pc < 32 ? g1 + (pc - 16) * 1024 : g2 + (pc - 32) * 1024)) + lane * 16; \
      __builtin_amdgcn_global_load_lds((const unsigned*)src, (LAS unsigned*)(lds + (buf) * 49152 + pc * 1024), 16, 0, 0); } } while (0)
  __syncthreads();
  GS_STAGE(scan_chunk(dir, 0), 0);
  for (int n = 0; n < NCH; ++n) { const int cn = scan_chunk(dir, n), buf = n & 1;
    asm volatile("s_waitcnt vmcnt(0)" ::: "memory"); __syncthreads();
    if (n + 1 < NCH) GS_STAGE(scan_chunk(dir, n + 1), buf ^ 1);
    if (wid < 4) { const int item = item_idx(dir, bh, cn);
      const float adec = __expf(p.GG[(size_t)item * 64 + (dir == 0 ? 63 : 0)]);
      bf16_t* st = p.GST + (size_t)item * 16384;
#pragma unroll
      for (int dt = 0; dt < 4; ++dt)
#pragma unroll
        for (int g = 0; g < 4; ++g) { u32x2 w; w.x = cvt_pk_bf16(S[dt][4 * g], S[dt][4 * g + 1]); w.y = cvt_pk_bf16(S[dt][4 * g + 2], S[dt][4 * g + 3]);
          *(u32x2*)(st + ((wid * 8 + 2 * dt + (g >> 1)) * 64 + (lane & 31) + 32 * (g & 1)) * 8 + 4 * hi) = w; }
      const LAS unsigned char* bb = lds + buf * 49152;
      f32x16 vn[2];
#pragma unroll
      for (int it = 0; it < 2; ++it)
#pragma unroll
        for (int r = 0; r < 16; ++r) vn[it][r] = 0.f;
#pragma unroll
      for (int s = 0; s < 8; ++s) { const bf16x8 sf = pack_step(S[s >> 1], s & 1);
#pragma unroll
        for (int it = 0; it < 2; ++it) { const bf16x8 af = *(const LAS bf16x8*)(bb + (it * 8 + s) * 1024 + lane * 16); vn[it] = __builtin_amdgcn_mfma_f32_32x32x16_bf16(af, sf, vn[it], 0, 0, 0); } }
      bf16_t* vt = p.GVNT + (size_t)item * 8192;
#pragma unroll
      for (int it = 0; it < 2; ++it)
#pragma unroll
        for (int g = 0; g < 4; ++g) { const u32x2 uu = *(const LAS u32x2*)(bb + 32768 + (((wid * 2 + it) * 4 + g) * 64 + lane) * 8);
          vn[it][4 * g] = bflo(uu.x) - vn[it][4 * g]; vn[it][4 * g + 1] = bfhi(uu.x) - vn[it][4 * g + 1]; vn[it][4 * g + 2] = bflo(uu.y) - vn[it][4 * g + 2]; vn[it][4 * g + 3] = bfhi(uu.y) - vn[it][4 * g + 3];
          u32x2 w; w.x = cvt_pk_bf16(vn[it][4 * g], vn[it][4 * g + 1]); w.y = cvt_pk_bf16(vn[it][4 * g + 2], vn[it][4 * g + 3]);
          *(u32x2*)(vt + ((wid * 4 + 2 * it + (g >> 1)) * 64 + lane) * 8 + 4 * (g & 1)) = w; }
#pragma unroll
      for (int dt = 0; dt < 4; ++dt)
#pragma unroll
        for (int r = 0; r < 16; ++r) S[dt][r] *= adec;
#pragma unroll
      for (int s = 0; s < 4; ++s) { const bf16x8 vf = pack_step(vn[s >> 1], s & 1);
#pragma unroll
        for (int dt = 0; dt < 4; ++dt) { const bf16x8 af = *(const LAS bf16x8*)(bb + 16384 + (dt * 4 + s) * 1024 + lane * 16); S[dt] = __builtin_amdgcn_mfma_f32_32x32x16_bf16(af, vf, S[dt], 0, 0, 0); } }
    }
  }
  asm volatile("s_waitcnt vmcnt(0)" ::: "memory"); __syncthreads();
#undef GS_STAGE
}

__device__ void gdn_out_unit(const FP& p, int l, int bh, int cn, int ih, int lane) {
  const int b = bh >> 2, h = bh & 3, c32 = lane & 31, hi = lane >> 5; const size_t row0 = (size_t)b * SB + cn * 64; const int ipos = 32 * ih + c32;
  const unsigned lo16 = (unsigned)lane * 16u;
  const int itf = item_idx(0, bh, cn), itb = item_idx(1, bh, cn);
  f32x16 P0, P1;
#pragma unroll
  for (int r = 0; r < 16; ++r) { P0[r] = 0.f; P1[r] = 0.f; }
  const char* qb = (const char*)(p.GQb + (row0 + 32 * ih) * 512 + h * 128); const char* kb = (const char*)(p.GKb + row0 * 512 + h * 128);
  const unsigned rowoff = (unsigned)(c32 * 512 + 8 * hi) * 2u;
#pragma unroll 1
  for (int s = 0; s < 8; ++s) { const bf16x8 qf = *(const bf16x8*)(qb + rowoff + s * 32); const bf16x8 k0 = *(const bf16x8*)(kb + rowoff + s * 32), k1 = *(const bf16x8*)(kb + 32 * 1024 + rowoff + s * 32);
    P0 = __builtin_amdgcn_mfma_f32_32x32x16_bf16(k0, qf, P0, 0, 0, 0); P1 = __builtin_amdgcn_mfma_f32_32x32x16_bf16(k1, qf, P1, 0, 0, 0); }
  const float* ggf = p.GG + (size_t)itf * 64; const float* ggb = p.GG + (size_t)itb * 64;
  const float gfi = ggf[ipos], gbi = ggb[ipos];
  bf16x8 pb[2][2][2];
#pragma unroll
  for (int dir = 0; dir < 2; ++dir) { const float* gg = dir == 0 ? ggf : ggb; const float gi = dir == 0 ? gfi : gbi;
#pragma unroll
    for (int jt = 0; jt < 2; ++jt) { f32x16 pd;
#pragma unroll
      for (int g = 0; g < 4; ++g) { const f32x4 gj = *(const f32x4*)(gg + 32 * jt + 8 * g + 4 * hi);
#pragma unroll
        for (int r3 = 0; r3 < 4; ++r3) { const int r = 4 * g + r3; const int j = 32 * jt + 8 * g + 4 * hi + r3; const bool ok = dir == 0 ? j <= ipos : j >= ipos; const float pv = jt == 0 ? P0[r] : P1[r];
          pd[r] = ok ? pv * __expf(fminf(gi - gj[r3], 0.f)) : 0.f; } }
      pb[dir][jt][0] = pack_step(pd, 0); pb[dir][jt][1] = pack_step(pd, 1); } }
  __builtin_amdgcn_sched_barrier(0);
  f32x16 O[4];
  const char* vaf = (const char*)(p.GVNT + (size_t)itf * 8192); const char* vab = (const char*)(p.GVNT + (size_t)itb * 8192);
#pragma unroll
  for (int et = 0; et < 4; ++et) { f32x16 a;
#pragma unroll
    for (int r = 0; r < 16; ++r) a[r] = 0.f;
#pragma unroll
    for (int jt = 0; jt < 2; ++jt)
#pragma unroll
      for (int ss = 0; ss < 2; ++ss) { const bf16x8 af = *(const bf16x8*)(vaf + et * 4096 + lo16 + (2 * jt + ss) * 1024), ab = *(const bf16x8*)(vab + et * 4096 + lo16 + (2 * jt + ss) * 1024);
        a = __builtin_amdgcn_mfma_f32_32x32x16_bf16(af, pb[0][jt][ss], a, 0, 0, 0); a = __builtin_amdgcn_mfma_f32_32x32x16_bf16(ab, pb[1][jt][ss], a, 0, 0, 0); }
    O[et] = a; __builtin_amdgcn_sched_barrier(0); }
  const float facf = __expf(gfi), facb = __expf(gbi);
  const char* stf = (const char*)(p.GST + (size_t)itf * 16384); const char* stb = (const char*)(p.GST + (size_t)itb * 16384);
#pragma unroll 1
  for (int s = 0; s < 8; ++s) { const bf16x8 qf = *(const bf16x8*)(qb + rowoff + s * 32); const bf16x8 qsf = scale_frag(qf, facf), qsb = scale_frag(qf, facb);
#pragma unroll
    for (int et = 0; et < 4; ++et) { const bf16x8 af = *(const bf16x8*)(stf + et * 8192 + s * 1024 + lo16), ab = *(const bf16x8*)(stb + et * 8192 + s * 1024 + lo16);
      O[et] = __builtin_amdgcn_mfma_f32_32x32x16_bf16(af, qsf, O[et], 0, 0, 0); O[et] = __builtin_amdgcn_mfma_f32_32x32x16_bf16(ab, qsb, O[et], 0, 0, 0); } }
  float ss2 = 0.f;
#pragma unroll
  for (int et = 0; et < 4; ++et)
#pragma unroll
    for (int r = 0; r < 16; ++r) ss2 += O[et][r] * O[et][r];
  ss2 += __shfl_xor(ss2, 32); const float rs = rsqrtf(ss2 * (1.f / 128.f) + 1e-6f);
  const size_t row = row0 + ipos; const bf16_t* zp = p.Pb + row * INWP + C_GZ + h * 128; const float* gr = p.g_gdn + l * 128; bf16_t* op = p.CATb + row * 1536 + 1024 + h * 128;
#pragma unroll
  for (int et = 0; et < 4; ++et)
#pragma unroll
    for (int g = 0; g < 4; ++g) { const int e0 = 32 * et + 8 * g + 4 * hi; const u32x2 gz = *(const u32x2*)(zp + e0); const f32x4 gg = *(const f32x4*)(gr + e0);
      const float z[4] = {bflo(gz.x), bfhi(gz.x), bflo(gz.y), bfhi(gz.y)}; float y[4];
#pragma unroll
      for (int j = 0; j < 4; ++j) y[j] = O[et][4 * g + j] * rs * gg[j] * silu_f(z[j]);
      u32x2 w; w.x = cvt_pk_bf16(y[0], y[1]); w.y = cvt_pk_bf16(y[2], y[3]); *(u32x2*)(op + e0) = w; }
}
enum { PH_PROLOGUE = 0, PH_NORM1, PH_INPROJ, PH_OUTPROJ, PH_NORM2, PH_GEMM1, PH_GEMM2, PH_FINAL, PH_PREP, PH_MLAGEMM, PH_ATTN, PH_POST };
__device__ void ph_prep(const FP& p, int l) { const int t = threadIdx.x, lane = t & 63, gw = blockIdx.x * NWAVES + (t >> 6), GWN = gridDim.x * NWAVES;
  for (int row = gw; row < T; row += GWN) { prep_mla_row(p, l, row, lane); prep_ret_row(p, row, lane); prep_gdn_row(p, l, row, lane); } }
__device__ void ph_post(const FP& p, int l) { const int t = threadIdx.x, lane = t & 63, gw = blockIdx.x * NWAVES + (t >> 6), GWN = gridDim.x * NWAVES;
  for (int row = gw; row < T; row += GWN) mla_out_row(p, l, row, lane);
  for (int u = gw; u < 16 * NCH * 2; u += GWN) { ret_out_unit(p, l, u / (NCH * 2), (u >> 1) % NCH, u & 1, lane); gdn_out_unit(p, l, u / (NCH * 2), (u >> 1) % NCH, u & 1, lane); } }
template <int PH> __global__ __launch_bounds__(512, 2) void k_phase(FP p, int l) {
  extern __shared__ __attribute__((aligned(16))) unsigned char shm[];
  LAS unsigned char* lds = (LAS unsigned char*)shm;
  if constexpr (PH == PH_PROLOGUE) ph_prologue(p, lds);
  if constexpr (PH == PH_NORM1) ph_norm1(p, l, lds);
  if constexpr (PH == PH_INPROJ) ph_inproj(p, l, lds);
  if constexpr (PH == PH_OUTPROJ) ph_outproj(p, l, lds);
  if constexpr (PH == PH_NORM2) ph_norm2(p, l, lds);
  if constexpr (PH == PH_GEMM1) ph_gemm1(p, l, lds);
  if constexpr (PH == PH_GEMM2) ph_gemm2(p, l, lds);
  if constexpr (PH == PH_FINAL) ph_final(p, lds);
  if constexpr (PH == PH_PREP) ph_prep(p, l);
  if constexpr (PH == PH_MLAGEMM) { ph_mla_gemm(p, l, lds);
    for (int pr = blockIdx.x; pr < 16 * NCH / 2; pr += gridDim.x) { const int it = pr * 2 + (threadIdx.x >> 8); r2_item(p, l, it / NCH, it % NCH, threadIdx.x & 255, lds + (threadIdx.x >> 8) * 40960); }
    for (int pr = blockIdx.x; pr < 2 * 16 * NCH / 2; pr += gridDim.x) { const int it = pr * 2 + (threadIdx.x >> 8); g2_item(p, (it / NCH) & 15, it / (16 * NCH), it % NCH, threadIdx.x & 255, lds + (threadIdx.x >> 8) * 20480); } }
  if constexpr (PH == PH_ATTN) { if (blockIdx.x < 32) ret_scan_job(p, l, blockIdx.x >> 1, blockIdx.x & 1, lds); else if (blockIdx.x < 64) gdn_scan_job(p, (blockIdx.x - 32) >> 1, blockIdx.x & 1, lds); ph_attn(p, l, (char*)shm); }
  if constexpr (PH == PH_POST) ph_post(p, l);
}
__global__ __launch_bounds__(256) void a_p2f(const bf16_t* Pb, const float* GAB, float* P) {
  const int row = blockIdx.x; for (int c = threadIdx.x; c < INW; c += 256) P[(size_t)row * INW + c] = c >= C_GA ? GAB[(size_t)row * 16 + (c - C_GA)] : bf2f(Pb[(size_t)row * INWP + c]);
}
__global__ __launch_bounds__(256) void a_cat(const float* CAT, bf16_t* CATb, int c0) {
  const int row = blockIdx.x; for (int c = c0 + threadIdx.x; c < 1536; c += 256) { unsigned u = __float_as_uint(CAT[(size_t)row * 1536 + c]); u += 0x7fffu + ((u >> 16) & 1u); CATb[(size_t)row * 1536 + c] = (bf16_t)(u >> 16); }
}
__global__ __launch_bounds__(256) void a_f2b(const float* src, bf16_t* dst, size_t n) {
  for (size_t i = (size_t)blockIdx.x * 256 + threadIdx.x; i < n; i += (size_t)gridDim.x * 256) { unsigned u = __float_as_uint(src[i]); u += 0x7fffu + ((u >> 16) & 1u); dst[i] = (bf16_t)(u >> 16); }
}
static size_t f_layout(char* base, FP& p) {
  size_t o = 0; auto take = [&](size_t bytes) { char* q = base + o; o += (bytes + 255) & ~(size_t)255; return q; };
  p.ctl = (unsigned*)take((size_t)CTL_WORDS * 4); p.cnt = (int*)(p.ctl + 4096);
  p.Wt_in = (bf16_t*)take((size_t)DEPTH * INWP * 1024 * 2); p.Wt_mla = (bf16_t*)take((size_t)DEPTH * MLAN * MLAK * 2); p.Wt_out = (bf16_t*)take((size_t)DEPTH * 1024 * 1536 * 2);
  p.Wt_gu = (bf16_t*)take((size_t)DEPTH * NE * 2048 * 1024 * 2); p.Wt_dn = (bf16_t*)take((size_t)DEPTH * NE * 1024 * 1024 * 2);
  p.MOD = (float*)take((size_t)DEPTH * 5 * 6144 * 4); p.X = (float*)take((size_t)T * D * 4); p.GAB = (float*)take((size_t)T * 16 * 4); p.TOPW = (float*)take((size_t)T * 4 * 4);
  p.Hb = (bf16_t*)take((size_t)T * D * 2); p.H2b = (bf16_t*)take((size_t)T * D * 2); p.Pb = (bf16_t*)take((size_t)T * INWP * 2); p.CATb = (bf16_t*)take((size_t)T * 1536 * 2);
  p.ACTb = (bf16_t*)take((size_t)ROWS_P * 1024 * 2); p.YSb = (bf16_t*)take((size_t)ROWS_P * 1024 * 2);
  p.A2b = (bf16_t*)take((size_t)T * MLAK * 2); p.Qb = (bf16_t*)take((size_t)T * 768 * 2); p.Knb = (bf16_t*)take((size_t)T * 512 * 2); p.Vb = (bf16_t*)take((size_t)T * 512 * 2);
  p.KRb = (bf16_t*)take((size_t)T * 64 * 2); p.AOb = (bf16_t*)take((size_t)T * 512 * 2);
  p.RQb = (bf16_t*)take((size_t)T * 512 * 2); p.RKb = (bf16_t*)take((size_t)T * 512 * 2); p.RKWT = (bf16_t*)take((size_t)2 * 16 * NCH * 8192 * 2);
  p.RVTB = (bf16_t*)take((size_t)16 * NCH * 8192 * 2); p.RVTA = (bf16_t*)take((size_t)16 * NCH * 8192 * 2); p.RST = (bf16_t*)take((size_t)2 * 16 * NCH * 16384 * 2);
  p.GQb = (bf16_t*)take((size_t)T * 512 * 2); p.GKb = (bf16_t*)take((size_t)T * 512 * 2); p.GVb = (bf16_t*)take((size_t)T * 512 * 2);
  p.GLA = (float*)take((size_t)T * 8 * 4); p.GBETA = (float*)take((size_t)T * 8 * 4); p.GG = (float*)take((size_t)2 * 16 * NCH * 64 * 4);
  p.GWb = (bf16_t*)take((size_t)2 * 16 * NCH * 8192 * 2); p.GKTT = (bf16_t*)take((size_t)2 * 16 * NCH * 8192 * 2); p.GUT = (bf16_t*)take((size_t)2 * 16 * NCH * 8192 * 2);
  p.GVNT = (bf16_t*)take((size_t)2 * 16 * NCH * 8192 * 2); p.GST = (bf16_t*)take((size_t)2 * 16 * NCH * 16384 * 2);
  p.TOPE = (int*)take((size_t)T * 4 * 4); p.TOPP = (int*)take((size_t)T * 4 * 4); p.ROWTOK = (int*)take((size_t)NE * T * 4);
  return o;
}
}

template <int PH> static void launch_phase(hipStream_t st, const fx::FP& p, int l) {
  static bool attr = false;
  if (!attr) { (void)hipFuncSetAttribute((const void*)fx::k_phase<PH>, hipFuncAttributeMaxDynamicSharedMemorySize, fx::LDS_BYTES); attr = true; }
  hipLaunchKernelGGL(fx::k_phase<PH>, dim3(256), dim3(512), fx::LDS_BYTES, st, p, l);
}

extern "C" void kernel_launch(void* const* d_in, const int* in_sizes, int n_in, void* d_out, int out_size, void* d_ws, size_t ws_size, hipStream_t stream) {
  using namespace cfg;
  const size_t osz = 0;
  fx::FP p{}; { const float** f = (const float**)&p; for (int i = 0; i < 28; ++i) f[i] = (const float*)d_in[i]; }
  p.out = (float*)d_out;
  const size_t fsz = fx::f_layout((char*)d_ws + osz, p);
  if (osz + fsz > ws_size || n_in != 28) { fprintf(stderr, "kernel_launch: ws too small (%zu > %zu) or n_in %d\n", osz + fsz, ws_size, n_in); return; }
  (void)hipMemsetAsync(p.ctl, 0, (size_t)fx::CTL_WORDS * 4, stream);
  launch_phase<fx::PH_PROLOGUE>(stream, p, 0);
  for (int l = 0; l < DEPTH; ++l) {
    launch_phase<fx::PH_NORM1>(stream, p, l);
    launch_phase<fx::PH_INPROJ>(stream, p, l);
    launch_phase<fx::PH_PREP>(stream, p, l);
    launch_phase<fx::PH_MLAGEMM>(stream, p, l);
    launch_phase<fx::PH_ATTN>(stream, p, l);
    launch_phase<fx::PH_POST>(stream, p, l);
    launch_phase<fx::PH_OUTPROJ>(stream, p, l);
    launch_phase<fx::PH_NORM2>(stream, p, l);
    launch_phase<fx::PH_GEMM1>(stream, p, l);
    launch_phase<fx::PH_GEMM2>(stream, p, l);
  }
  launch_phase<fx::PH_FINAL>(stream, p, 0);
}
```

```cpp
#include <hip/hip_runtime.h>
#include <stdint.h>
#include <stdio.h>

namespace cfg {
constexpr int D = 1024, NB = 4, SEQ = 4096, DEPTH = 4, CTX = 256, GW = 64;
constexpr int SB = CTX + SEQ;
constexpr int T = NB * SB;
constexpr int INW = 4560;
constexpr int C_DQ = 0, C_DKV = 256, C_KR = 384, C_RQ = 448, C_RK = 960, C_RV = 1472, C_RG = 1984, C_GQ = 2496, C_GK = 3008, C_GV = 3520, C_GZ = 4032, C_GA = 4544, C_GB = 4552;
constexpr int NE = 32, TOPK = 4, DE = 1024;
}
namespace fx {
using namespace cfg;
#define LAS __attribute__((address_space(3)))
typedef unsigned short bf16_t;
typedef short bf16x8 __attribute__((ext_vector_type(8)));
typedef short s16x4 __attribute__((ext_vector_type(4)));
typedef float f32x4 __attribute__((ext_vector_type(4)));
typedef float f32x16 __attribute__((ext_vector_type(16)));
typedef unsigned u32x4 __attribute__((ext_vector_type(4)));
typedef unsigned u32x2 __attribute__((ext_vector_type(2)));

__device__ __forceinline__ int opaque_tid() { int t = threadIdx.x; asm volatile("" : "+v"(t)); return t; }
#define TIDX opaque_tid()
__device__ __forceinline__ float shx(float v, int m) { const int ln = TIDX & 63; return __int_as_float(__builtin_amdgcn_ds_bpermute((ln ^ m) << 2, __float_as_int(v))); }
__device__ __forceinline__ int shxi(int v, int m) { const int ln = TIDX & 63; return __builtin_amdgcn_ds_bpermute((ln ^ m) << 2, v); }
__device__ __forceinline__ float shup(float v, int o) { const int ln = TIDX & 63; const int src = ln >= o ? ln - o : ln; return __int_as_float(__builtin_amdgcn_ds_bpermute(src << 2, __float_as_int(v))); }
__device__ __forceinline__ int shupi(int v, int o) { const int ln = TIDX & 63; const int src = ln >= o ? ln - o : ln; return __builtin_amdgcn_ds_bpermute(src << 2, v); }
__device__ __forceinline__ float shdn(float v, int o) { const int ln = TIDX & 63; const int src = ln + o < 64 ? ln + o : ln; return __int_as_float(__builtin_amdgcn_ds_bpermute(src << 2, __float_as_int(v))); }
constexpr int NTHREADS = 512, NWAVES = 8;
constexpr int BM = 256, BK = 64, HALF = 128, HTB = HALF * BK * 2, STAGE_BYTES = 8 * HTB, NXCD = 8, WGM = 8;
constexpr int LDS_MISC = STAGE_BYTES;
constexpr int LDS_BYTES = 147456;
constexpr int INWP = 4608;
constexpr int MLAN = 1792, MLAK = 384;
constexpr int MAXBLK = (T * TOPK) / 256 + NE;
constexpr int ROWS_P = MAXBLK * 256;

__device__ __forceinline__ unsigned cvt_pk_bf16(float lo, float hi) { unsigned r; asm volatile("v_cvt_pk_bf16_f32 %0, %1, %2" : "=v"(r) : "v"(lo), "v"(hi)); return r; }
__device__ __forceinline__ float bf2f(unsigned short b) { return __uint_as_float(((unsigned)b) << 16); }
__device__ __forceinline__ float bflo(unsigned w) { return __uint_as_float(w << 16); }
__device__ __forceinline__ float bfhi(unsigned w) { return __uint_as_float(w & 0xffff0000u); }
__device__ __forceinline__ float silu_f(float v) { return v / (1.f + __expf(-v)); }

__host__ __device__ __forceinline__ int lds_byte(int r, int c) { const int st = (r >> 4) * 2 + (c >> 5), rr = r & 15, cc = c & 31, ob = rr * 64 + cc * 2; return st * 1024 + (ob ^ (((ob >> 9) & 1) << 5)); }
__host__ __device__ __forceinline__ void stage_rc(int b, int& R, int& C) { const int st = b / 1024, sb = b % 1024, swz = sb ^ (((sb >> 9) & 1) << 5); R = (st >> 1) * 16 + swz / 64; C = (st & 1) * 32 + (swz % 64) / 2; }
__host__ __device__ __forceinline__ int perm32(int rho) { const int n = rho >> 4, i = rho & 15; return 8 * (i >> 2) + 4 * n + (i & 3); }

struct Unit { int pm, pn, e, pad_; long aoff, boff; };
struct Gemm { const bf16_t* A; const bf16_t* Bt; int M, N, K; };

struct StaticOrder {
    int nM, nN, nwg, G, c, K;
    __device__ void init(int M, int N, int K_, int G_, int c_) { nM = M / BM; nN = N / BM; nwg = nM * nN; G = G_; c = c_; K = K_; }
    __device__ bool next(int i, Unit& u) const {
        const long L = (long)i * G + c; if (L >= nwg) return false;
        int wgid = (int)L; { const int q = nwg / NXCD, r = nwg % NXCD, xcd = wgid % NXCD, off = wgid / NXCD; wgid = (xcd < r ? xcd * (q + 1) : r * (q + 1) + (xcd - r) * q) + off; }
        const int nig = WGM * nN, gid = wgid / nig, fm = gid * WGM, gsz = (nM - fm) < WGM ? (nM - fm) : WGM;
        u.pm = fm + ((wgid % nig) % gsz); u.pn = (wgid % nig) / gsz; u.e = 0; u.pad_ = 0;
        u.aoff = (long)u.pm * BM * K * 2; u.boff = (long)u.pn * BM * K * 2; return true;
    }
    __device__ __forceinline__ void a_off(const Unit&, const int (&R)[2], const int (&C)[2], unsigned (&v)[2][2]) const {
#pragma unroll
        for (int h = 0; h < 2; ++h)
#pragma unroll
            for (int i = 0; i < 2; ++i) v[h][i] = (unsigned)((h * HALF + R[i]) * K + C[i]) * 2u;
    }
};
template <bool GATHER> struct MoeOrder {
    int nblk, NPN, G, c, K; const LAS int* blk_e; const LAS int* blk_j; const int* rowtok; const int* cnt; long bstride;
    __device__ bool next(int i, Unit& u) const {
        const long L = (long)i * G + c; if (L >= (long)nblk * NPN) return false;
        const int blk = (int)(L / NPN); u.pn = (int)(L % NPN); u.pm = blk; u.e = blk_e[blk]; u.pad_ = blk_j[blk];
        u.aoff = GATHER ? 0 : (long)blk * BM * K * 2; u.boff = (long)u.e * bstride + (long)u.pn * BM * K * 2; return true;
    }
    __device__ __forceinline__ void a_off(const Unit& u, const int (&R)[2], const int (&C)[2], unsigned (&v)[2][2]) const {
        if (GATHER) { const int n = cnt[u.e]; const int* lst = rowtok + (size_t)u.e * T + u.pad_ * 256;
#pragma unroll
            for (int h = 0; h < 2; ++h)
#pragma unroll
                for (int i = 0; i < 2; ++i) { const int rr = h * HALF + R[i]; const int tok = (u.pad_ * 256 + rr < n) ? lst[rr] : 0; v[h][i] = (unsigned)(tok * K + C[i]) * 2u; }
        } else {
#pragma unroll
            for (int h = 0; h < 2; ++h)
#pragma unroll
                for (int i = 0; i < 2; ++i) v[h][i] = (unsigned)((h * HALF + R[i]) * K + C[i]) * 2u;
        }
    }
};

struct EpiInproj {
    static constexpr bool PERM = true;
    bf16_t* O; float* GAB;
    __device__ __forceinline__ void operator()(const f32x4 (&acc)[2][2][4][2], const Unit& u, int wr, int wc, int fr, int fq) const {
        const int row0 = u.pm * BM + wr * 64 + fr, col0 = u.pn * BM + wc * 32 + 8 * fq;
#pragma unroll
        for (int ai = 0; ai < 2; ++ai)
#pragma unroll
            for (int m = 0; m < 4; ++m) { const int row = row0 + ai * HALF + m * 16; bf16_t* rowp = O + (size_t)row * INWP + col0;
#pragma unroll
                for (int bj = 0; bj < 2; ++bj) { const f32x4 v0 = acc[ai][bj][m][0], v1 = acc[ai][bj][m][1];
                    u32x4 w; w.x = cvt_pk_bf16(v0[0], v0[1]); w.y = cvt_pk_bf16(v0[2], v0[3]); w.z = cvt_pk_bf16(v1[0], v1[1]); w.w = cvt_pk_bf16(v1[2], v1[3]);
                    *(u32x4*)(rowp + bj * HALF) = w; }
                if (u.pn == 17 && wc == 2 && fq < 2) { float* gp = GAB + (size_t)row * 16 + fq * 8; *(f32x4*)gp = acc[ai][1][m][0]; *(f32x4*)(gp + 4) = acc[ai][1][m][1]; } }
    }
};
struct EpiOutproj {
    static constexpr bool PERM = false;
    float* X; const float* MODl;
    __device__ __forceinline__ void operator()(const f32x4 (&acc)[2][2][4][2], const Unit& u, int wr, int wc, int fr, int fq) const {
        const int row0 = u.pm * BM + wr * 64 + fr, col0 = u.pn * BM + wc * 32 + 4 * fq; const int rmod = (u.pm % 17 == 0) ? 4 : u.pm / 17;
        const float* gt = MODl + (size_t)rmod * 6144 + 2048 + col0; f32x4 gv[2][2];
#pragma unroll
        for (int bj = 0; bj < 2; ++bj)
#pragma unroll
            for (int n = 0; n < 2; ++n) gv[bj][n] = *(const f32x4*)(gt + bj * HALF + n * 16);
#pragma unroll
        for (int ai = 0; ai < 2; ++ai)
#pragma unroll
            for (int m = 0; m < 4; ++m) { float* rowp = X + (size_t)(row0 + ai * HALF + m * 16) * D + col0;
#pragma unroll
                for (int bj = 0; bj < 2; ++bj)
#pragma unroll
                    for (int n = 0; n < 2; ++n) { f32x4* p = (f32x4*)(rowp + bj * HALF + n * 16); *p = *p + gv[bj][n] * acc[ai][bj][m][n]; } }
    }
};
struct EpiGateUp {
    static constexpr bool PERM = true;
    bf16_t* ACT; const float* bgu;
    __device__ __forceinline__ void operator()(const f32x4 (&acc)[2][2][4][2], const Unit& u, int wr, int wc, int fr, int fq) const {
        const int row0 = u.pm * BM + wr * 64 + fr, oc = u.pn * HALF + wc * 32 + 8 * fq; const float* bg = bgu + (size_t)u.e * 2048 + oc;
        f32x4 bgv[2], buv[2];
#pragma unroll
        for (int n = 0; n < 2; ++n) { bgv[n] = *(const f32x4*)(bg + 4 * n); buv[n] = *(const f32x4*)(bg + 1024 + 4 * n); }
#pragma unroll
        for (int ai = 0; ai < 2; ++ai)
#pragma unroll
            for (int m = 0; m < 4; ++m) { float o[8];
#pragma unroll
                for (int n = 0; n < 2; ++n) { const f32x4 gv = acc[ai][0][m][n] + bgv[n], uv = acc[ai][1][m][n] + buv[n];
#pragma unroll
                    for (int j = 0; j < 4; ++j) { const float gg = fminf(gv[j], 7.f), uu = fminf(fmaxf(uv[j], -7.f), 7.f); o[n * 4 + j] = (uu + 1.f) * gg / (1.f + __expf(-1.702f * gg)); } }
                u32x4 w; w.x = cvt_pk_bf16(o[0], o[1]); w.y = cvt_pk_bf16(o[2], o[3]); w.z = cvt_pk_bf16(o[4], o[5]); w.w = cvt_pk_bf16(o[6], o[7]);
                *(u32x4*)(ACT + (size_t)(row0 + ai * HALF + m * 16) * 1024 + oc) = w; }
    }
};
struct EpiDown {
    static constexpr bool PERM = true;
    bf16_t* YS; const float* bdn;
    __device__ __forceinline__ void operator()(const f32x4 (&acc)[2][2][4][2], const Unit& u, int wr, int wc, int fr, int fq) const {
        const int row0 = u.pm * BM + wr * 64 + fr, col0 = u.pn * BM + wc * 32 + 8 * fq; const float* bb = bdn + (size_t)u.e * 1024 + col0;
        f32x4 bv[2][2];
#pragma unroll
        for (int bj = 0; bj < 2; ++bj)
#pragma unroll
            for (int n = 0; n < 2; ++n) bv[bj][n] = *(const f32x4*)(bb + bj * HALF + 4 * n);
#pragma unroll
        for (int ai = 0; ai < 2; ++ai)
#pragma unroll
            for (int m = 0; m < 4; ++m) { bf16_t* rowp = YS + (size_t)(row0 + ai * HALF + m * 16) * 1024 + col0;
#pragma unroll
                for (int bj = 0; bj < 2; ++bj) { const f32x4 v0 = acc[ai][bj][m][0] + bv[bj][0], v1 = acc[ai][bj][m][1] + bv[bj][1];
                    u32x4 w; w.x = cvt_pk_bf16(v0[0], v0[1]); w.y = cvt_pk_bf16(v0[2], v0[3]); w.z = cvt_pk_bf16(v1[0], v1[1]); w.w = cvt_pk_bf16(v1[2], v1[3]);
                    *(u32x4*)(rowp + bj * HALF) = w; } }
    }
};

template <class Epi, class Sched>
__device__ __forceinline__ void gemm_phase(LAS unsigned char* lds, const Gemm g, const Sched& S, const Epi& E) {
    const int tid = TIDX, wid = __builtin_amdgcn_readfirstlane(tid >> 6), lane = tid & 63, wr = wid >> 2, wc = wid & 3, fr = lane & 15, fq = lane >> 4;
    const int K = g.K, nt = K / BK;
    int Rr[2], Cc[2]; unsigned voffB[2];
#pragma unroll
    for (int i = 0; i < 2; ++i) { int R, C; stage_rc(tid * 16 + i * 8192, R, C); Rr[i] = R; Cc[i] = C; const int Rb = Epi::PERM ? ((R & ~31) + perm32(R & 31)) : R; voffB[i] = (unsigned)(Rb * K + C) * 2u; }
    const size_t kstep = (size_t)(BK * 2);
    const size_t hstep = (size_t)HALF * K * 2;
    const unsigned ldsw = (unsigned)wid * 1024u;
    const int aoff = lds_byte(wr * 64 + fr, fq * 8), boff = lds_byte(wc * 32 + fr, fq * 8);
#define PG8_SA(b, h) (((b) * 2 + (h)) * HTB)
#define PG8_SB(b, h) ((4 + (b) * 2 + (h)) * HTB)
#define PG8_STAGE(bufoff, gbase, voff) do { _Pragma("unroll") for (int _i = 0; _i < 2; ++_i) \
        __builtin_amdgcn_global_load_lds((const unsigned*)((const char*)(gbase) + (voff)[_i]), (LAS unsigned*)(lds + (bufoff) + ldsw + _i * 8192), 16, 0, 0); } while (0)
#define PG8_LDA(dst, b, h) do { _Pragma("unroll") for (int m = 0; m < 4; ++m) _Pragma("unroll") for (int k = 0; k < 2; ++k) dst[m][k] = *(const LAS bf16x8*)(lds + PG8_SA(b, h) + aoff + m * 2048 + k * 1024); } while (0)
#define PG8_LDB(dst, b, h) do { _Pragma("unroll") for (int n = 0; n < 2; ++n) _Pragma("unroll") for (int k = 0; k < 2; ++k) dst[n][k] = *(const LAS bf16x8*)(lds + PG8_SB(b, h) + boff + n * 2048 + k * 1024); } while (0)
#define PG8_MMA(ai, bj, At, Bt) do { __builtin_amdgcn_s_setprio(1); _Pragma("unroll") for (int m = 0; m < 4; ++m) _Pragma("unroll") for (int n = 0; n < 2; ++n) _Pragma("unroll") for (int k = 0; k < 2; ++k) \
        acc[ai][bj][m][n] = __builtin_amdgcn_mfma_f32_16x16x32_bf16(Bt[n][k], At[m][k], acc[ai][bj][m][n], 0, 0, 0); __builtin_amdgcn_s_setprio(0); } while (0)
#define PG8_WAIT_V(n) asm volatile("s_waitcnt vmcnt(" #n ")" ::: "memory")
#define PG8_WAIT_L(n) asm volatile("s_waitcnt lgkmcnt(" #n ")" ::: "memory")
#define PG8_BAR __builtin_amdgcn_s_barrier()
#define PG8_SCHED __builtin_amdgcn_sched_barrier(0)
    Unit cur, nxt; int ui = 0;
    if (!S.next(0, cur)) return;
    f32x4 acc[2][2][4][2];
#pragma unroll
    for (int a = 0; a < 2; ++a)
#pragma unroll
        for (int b = 0; b < 2; ++b)
#pragma unroll
            for (int m = 0; m < 4; ++m)
#pragma unroll
                for (int n = 0; n < 2; ++n) acc[a][b][m][n] = (f32x4){0.f, 0.f, 0.f, 0.f};
    bf16x8 At[4][2], B0[2][2], B1[2][2];
    unsigned vAc[2][2], vAn[2][2];
    S.a_off(cur, Rr, Cc, vAc);
    const char* cA = (const char*)g.A + cur.aoff; const char* cB = (const char*)g.Bt + cur.boff;
    PG8_STAGE(PG8_SB(0, 0), cB, voffB); PG8_STAGE(PG8_SA(0, 0), cA, vAc[0]); PG8_STAGE(PG8_SB(0, 1), cB + hstep, voffB); PG8_STAGE(PG8_SA(0, 1), cA, vAc[1]);
    if (wr == 1) PG8_BAR;
    PG8_WAIT_V(4); PG8_BAR;
    PG8_STAGE(PG8_SB(1, 0), cB + kstep, voffB); PG8_STAGE(PG8_SA(1, 0), cA + kstep, vAc[0]); PG8_STAGE(PG8_SB(1, 1), cB + hstep + kstep, voffB);
    PG8_WAIT_V(6); PG8_BAR;
    for (;;) {
        const bool has_next = S.next(ui + 1, nxt);
        if (has_next) S.a_off(nxt, Rr, Cc, vAn);
        else {
#pragma unroll
            for (int h = 0; h < 2; ++h)
#pragma unroll
                for (int i = 0; i < 2; ++i) vAn[h][i] = vAc[h][i]; }
        const char* nA = has_next ? (const char*)g.A + nxt.aoff : cA; const char* nB = has_next ? (const char*)g.Bt + nxt.boff : cB;
        for (int t = 0; t < nt; t += 2) {
            const bool last = (t == nt - 2);
            const char* a1 = cA + (size_t)(t + 1) * kstep;
            const char* a2 = last ? nA : cA + (size_t)(t + 2) * kstep; const char* b2 = last ? nB : cB + (size_t)(t + 2) * kstep;
            const char* a3 = a2 + kstep; const char* b3 = b2 + kstep;
            unsigned w2[2][2];
#pragma unroll
            for (int h = 0; h < 2; ++h)
#pragma unroll
                for (int i = 0; i < 2; ++i) w2[h][i] = last ? vAn[h][i] : vAc[h][i];
            PG8_LDB(B0, 0, 0); PG8_SCHED; PG8_LDA(At, 0, 0); PG8_STAGE(PG8_SA(1, 1), a1, vAc[1]);
            PG8_WAIT_L(8); PG8_BAR; PG8_WAIT_L(0); PG8_MMA(0, 0, At, B0); PG8_BAR; PG8_SCHED;
            PG8_LDB(B1, 0, 1); PG8_STAGE(PG8_SB(0, 0), b2, voffB);
            PG8_BAR; PG8_WAIT_L(0); PG8_MMA(0, 1, At, B1); PG8_BAR;
            PG8_LDA(At, 0, 1); PG8_STAGE(PG8_SA(0, 0), a2, w2[0]);
            PG8_BAR; PG8_WAIT_L(0); PG8_MMA(1, 0, At, B0); PG8_BAR; PG8_SCHED;
            PG8_STAGE(PG8_SB(0, 1), b2 + hstep, voffB);
            PG8_WAIT_V(6); PG8_BAR; PG8_MMA(1, 1, At, B1); PG8_BAR;
            PG8_LDB(B0, 1, 0); PG8_SCHED; PG8_LDA(At, 1, 0); PG8_STAGE(PG8_SA(0, 1), a2, w2[1]);
            PG8_WAIT_L(8); PG8_BAR; PG8_WAIT_L(0); PG8_MMA(0, 0, At, B0); PG8_BAR; PG8_SCHED;
            PG8_LDB(B1, 1, 1); PG8_STAGE(PG8_SB(1, 0), b3, voffB);
            PG8_BAR; PG8_WAIT_L(0); PG8_MMA(0, 1, At, B1); PG8_BAR;
            PG8_LDA(At, 1, 1); PG8_STAGE(PG8_SA(1, 0), a3, w2[0]);
            PG8_BAR; PG8_WAIT_L(0); PG8_MMA(1, 0, At, B0); PG8_BAR; PG8_SCHED;
            PG8_STAGE(PG8_SB(1, 1), b3 + hstep, voffB);
            PG8_WAIT_V(6); PG8_BAR; PG8_MMA(1, 1, At, B1); PG8_BAR;
        }
        { int tz = TIDX; const int wz = tz >> 6, lz = tz & 63; E(acc, cur, wz >> 2, wz & 3, lz & 15, lz >> 4); }
        if (!has_next) break;
#pragma unroll
        for (int a = 0; a < 2; ++a)
#pragma unroll
            for (int b = 0; b < 2; ++b)
#pragma unroll
                for (int m = 0; m < 4; ++m)
#pragma unroll
                    for (int n = 0; n < 2; ++n) acc[a][b][m][n] = (f32x4){0.f, 0.f, 0.f, 0.f};
        cur = nxt; cA = nA; cB = nB; ++ui;
#pragma unroll
        for (int h = 0; h < 2; ++h)
#pragma unroll
            for (int i = 0; i < 2; ++i) vAc[h][i] = vAn[h][i];
    }
    PG8_WAIT_V(0);
    if (wr == 0) PG8_BAR;
    PG8_BAR;
#undef PG8_SA
#undef PG8_SB
#undef PG8_STAGE
#undef PG8_LDA
#undef PG8_LDB
#undef PG8_MMA
#undef PG8_WAIT_V
#undef PG8_WAIT_L
#undef PG8_BAR
#undef PG8_SCHED
}
struct FP {
  const float *x, *c, *ctx, *c_ctx, *w_mod, *b_mod, *g_norm1, *g_norm2, *w_in, *g_cq, *g_ckv, *w_uq, *w_ukv, *g_mla, *ret_decay, *g_ret, *gdn_conv, *gdn_a_log,
      *gdn_dt_bias, *g_gdn, *w_out, *w_router, *b_router, *w_gate_up, *b_gate_up, *w_down, *b_down, *g_final;
  float* out;
  unsigned* ctl; int* cnt;
  bf16_t *Wt_in, *Wt_mla, *Wt_out, *Wt_gu, *Wt_dn;
  float *MOD, *X, *GAB, *TOPW;
  bf16_t *Hb, *H2b, *Pb, *CATb, *ACTb, *YSb;
  int *TOPE, *TOPP, *ROWTOK;
  bf16_t *A2b, *Qb, *Knb, *Vb, *KRb, *AOb;
  bf16_t *RQb, *RKb, *RKWT, *RVTB, *RVTA, *RST;
  bf16_t *GQb, *GKb, *GVb, *GUT, *GWb, *GKTT, *GVNT, *GST;
  float *GG, *GBETA, *GLA;
};
constexpr int CTL_WORDS = 4096 + DEPTH * 32;

template <int MAP> __device__ __forceinline__ void tr_tile(const float* src, int lds_, int k0, int n0, int N, bf16_t* dst, int ldd, int kcol0, LAS float* tile) {
  const int t = TIDX;
#pragma unroll
  for (int i = 0; i < 2; ++i) { const int idx = t + 512 * i, k = idx >> 4, n4 = (idx & 15) * 4; f32x4 v = (f32x4){0.f, 0.f, 0.f, 0.f};
    if (n0 + n4 < N) v = *(const f32x4*)(src + (size_t)(k0 + k) * lds_ + n0 + n4);
    tile[k * 65 + n4 + 0] = v[0]; tile[k * 65 + n4 + 1] = v[1]; tile[k * 65 + n4 + 2] = v[2]; tile[k * 65 + n4 + 3] = v[3]; }
  __syncthreads();
  { const int n = t >> 3, k8 = (t & 7) * 8; float o[8];
#pragma unroll
    for (int j = 0; j < 8; ++j) o[j] = tile[(k8 + j) * 65 + n];
    u32x4 w; w.x = cvt_pk_bf16(o[0], o[1]); w.y = cvt_pk_bf16(o[2], o[3]); w.z = cvt_pk_bf16(o[4], o[5]); w.w = cvt_pk_bf16(o[6], o[7]);
    int gn = n0 + n, row;
    if (MAP == 1) { const int bj = gn >> 10, c = gn & 1023; row = (c >> 7) * 256 + bj * 128 + (c & 127); }
    else row = gn;
    *(u32x4*)(dst + (size_t)row * ldd + kcol0 + k0 + k8) = w; }
  __syncthreads();
}

__device__ void ph_prologue(const FP& p, LAS unsigned char* lds) {
  LAS float* tile = (LAS float*)lds;
  const int G = gridDim.x, bid = blockIdx.x, t = TIDX;
  constexpr int S_GU = DEPTH * NE * 16 * 32, S_DN = DEPTH * NE * 16 * 16, S_IN = DEPTH * 16 * 72, S_OUT = DEPTH * 24 * 16, S_UQ = DEPTH * 4 * 12, S_UKV = DEPTH * 2 * 16;
  constexpr int S_TOT = S_GU + S_DN + S_IN + S_OUT + S_UQ + S_UKV;
  for (int id = bid; id < S_TOT; id += G) {
    int r = id;
    if (r < S_GU) { const int m = r / 512, tt = r % 512, kt = tt / 32, nt = tt % 32;
      tr_tile<1>(p.w_gate_up + (size_t)m * 1024 * 2048, 2048, kt * 64, nt * 64, 2048, p.Wt_gu + (size_t)m * 2048 * 1024, 1024, 0, tile); continue; }
    r -= S_GU;
    if (r < S_DN) { const int m = r / 256, tt = r % 256, kt = tt / 16, nt = tt % 16;
      tr_tile<0>(p.w_down + (size_t)m * 1024 * 1024, 1024, kt * 64, nt * 64, 1024, p.Wt_dn + (size_t)m * 1024 * 1024, 1024, 0, tile); continue; }
    r -= S_DN;
    if (r < S_IN) { const int l = r / 1152, tt = r % 1152, kt = tt / 72, nt = tt % 72;
      tr_tile<0>(p.w_in + (size_t)l * 1024 * INW, INW, kt * 64, nt * 64, INW, p.Wt_in + (size_t)l * INWP * 1024, 1024, 0, tile); continue; }
    r -= S_IN;
    if (r < S_OUT) { const int l = r / 384, tt = r % 384, kt = tt / 16, nt = tt % 16;
      tr_tile<0>(p.w_out + (size_t)l * 1536 * 1024, 1024, kt * 64, nt * 64, 1024, p.Wt_out + (size_t)l * 1024 * 1536, 1536, 0, tile); continue; }
    r -= S_OUT;
    if (r < S_UQ) { const int l = r / 48, tt = r % 48, kt = tt / 12, nt = tt % 12;
      tr_tile<0>(p.w_uq + (size_t)l * 256 * 768, 768, kt * 64, nt * 64, 768, p.Wt_mla + (size_t)l * MLAN * MLAK, MLAK, 0, tile); continue; }
    r -= S_UQ;
    { const int l = r / 32, tt = r % 32, kt = tt / 16, nt = tt % 16;
      tr_tile<0>(p.w_ukv + (size_t)l * 128 * 1024, 1024, kt * 64, nt * 64, 1024, p.Wt_mla + (size_t)l * MLAN * MLAK + (size_t)768 * MLAK, MLAK, 256, tile); }
  }
  { const u32x4 z = (u32x4){0u, 0u, 0u, 0u}; const int gtid = bid * NTHREADS + t, gstr = G * NTHREADS;
    for (int i = gtid; i < DEPTH * 768 * 16; i += gstr) { const int l = i / (768 * 16), rr = (i / 16) % 768, c8 = (i % 16) * 8; *(u32x4*)(p.Wt_mla + ((size_t)l * MLAN + rr) * MLAK + 256 + c8) = z; }
    for (int i = gtid; i < DEPTH * 1024 * 32; i += gstr) { const int l = i / (1024 * 32), rr = (i / 32) % 1024, c8 = (i % 32) * 8; *(u32x4*)(p.Wt_mla + ((size_t)l * MLAN + 768 + rr) * MLAK + c8) = z; } }
  { const int gw = bid * NWAVES + (t >> 6), lane = t & 63;
    for (int row = gw; row < T; row += G * NWAVES) { const int b = row / SB, s = row % SB;
      const float* src = s < CTX ? p.ctx + ((size_t)b * CTX + s) * D : p.x + ((size_t)b * SEQ + (s - CTX)) * D;
#pragma unroll
      for (int i = 0; i < 4; ++i) *(f32x4*)(p.X + (size_t)row * D + i * 256 + lane * 4) = *(const f32x4*)(src + i * 256 + lane * 4); } }
  { LAS float* sc = (LAS float*)(lds + 32768);
    LAS float* part = (LAS float*)(lds + 32768 + 5 * 1024 * 4);
    __syncthreads();
    for (int i = t; i < 5 * 1024; i += NTHREADS) { const int r = i >> 10, k = i & 1023; const float v = r < 4 ? p.c[r * 1024 + k] : p.c_ctx[k]; sc[i] = v / (1.f + expf(-v)); }
    __syncthreads();
    for (int item = bid; item < DEPTH * 24; item += G) { const int l = item / 24, j = (item % 24) * 256 + (t & 255), kh = t >> 8;
      float a[5] = {0.f, 0.f, 0.f, 0.f, 0.f}; const float* w = p.w_mod + (size_t)l * 1024 * 6144 + j;
      for (int k = kh * 512; k < kh * 512 + 512; ++k) { const float wv = w[(size_t)k * 6144];
#pragma unroll
        for (int r = 0; r < 5; ++r) a[r] += sc[r * 1024 + k] * wv; }
      if (kh == 1) {
#pragma unroll
        for (int r = 0; r < 5; ++r) part[r * 256 + (t & 255)] = a[r]; }
      __syncthreads();
      if (kh == 0) {
#pragma unroll
        for (int r = 0; r < 5; ++r) p.MOD[(size_t)(l * 5 + r) * 6144 + j] = a[r] + part[r * 256 + (t & 255)] + p.b_mod[l * 6144 + j]; }
      __syncthreads(); } }
}

struct MoeTab { LAS int* blk_e; LAS int* blk_j; LAS int* start; int nblk; };
__device__ __forceinline__ MoeTab moe_tables(const int* cntl, LAS unsigned char* misc) {
  MoeTab m; m.blk_e = (LAS int*)misc; m.blk_j = m.blk_e + MAXBLK; m.start = m.blk_j + MAXBLK;
  const int t = TIDX;
  __syncthreads();
  if (t < 64) { const int e = t & 31; const int nb = (cntl[e] + 255) >> 8; int incl = nb;
#pragma unroll
    for (int o = 1; o < 32; o <<= 1) { const int v = shupi(incl, o); if ((t & 31) >= o) incl += v; }
    if (t < 32) { m.start[e] = incl - nb; if (e == 31) m.start[32] = incl; } }
  __syncthreads();
  m.nblk = m.start[32];
  for (int blk = t; blk < m.nblk; blk += NTHREADS) { int e = 0;
    while (m.start[e + 1] <= blk) ++e;
    m.blk_e[blk] = e; m.blk_j[blk] = blk - m.start[e]; }
  __syncthreads();
  return m;
}

__device__ __forceinline__ float wave_sum(float v) {
#pragma unroll
  for (int o = 32; o >= 1; o >>= 1) v += shx(v, o);
  return v; }

__device__ __forceinline__ void moe_combine_row(const FP& p, int lprev, int row, const LAS int* start, const float* gate, int lane, f32x4 (&x)[4]) {
  int sl[4]; float w[4];
#pragma unroll
  for (int k = 0; k < 4; ++k) { const int e = p.TOPE[row * 4 + k]; sl[k] = start[e] * 256 + p.TOPP[row * 4 + k]; w[k] = p.TOPW[row * 4 + k]; }
#pragma unroll
  for (int i = 0; i < 4; ++i) { f32x4 y = (f32x4){0.f, 0.f, 0.f, 0.f};
#pragma unroll
    for (int k = 0; k < 4; ++k) { const u32x2 v = *(const u32x2*)(p.YSb + (size_t)sl[k] * 1024 + i * 256 + lane * 4);
      y[0] += w[k] * bflo(v.x); y[1] += w[k] * bfhi(v.x); y[2] += w[k] * bflo(v.y); y[3] += w[k] * bfhi(v.y); }
    const f32x4 g = *(const f32x4*)(gate + i * 256 + lane * 4); x[i] = x[i] + g * y; }
}

__device__ void ph_norm1(const FP& p, int l, LAS unsigned char* lds) {
  const int t = TIDX, lane = t & 63, gw = blockIdx.x * NWAVES + (t >> 6), GWN = gridDim.x * NWAVES;
  MoeTab mt{}; if (l > 0) mt = moe_tables(p.cnt + (l - 1) * 32, lds + LDS_MISC);
  const float* MODl = p.MOD + (size_t)l * 5 * 6144; const float* MODp = p.MOD + (size_t)(l > 0 ? l - 1 : 0) * 5 * 6144; const float* g1 = p.g_norm1 + l * D;
  for (int row = gw; row < T; row += GWN) { const int b = row / SB, s = row % SB, r = s < CTX ? 4 : b;
    f32x4 x[4];
#pragma unroll
    for (int i = 0; i < 4; ++i) x[i] = *(const f32x4*)(p.X + (size_t)row * D + i * 256 + lane * 4);
    if (l > 0) { moe_combine_row(p, l - 1, row, mt.start, MODp + (size_t)r * 6144 + 5120, lane, x);
#pragma unroll
      for (int i = 0; i < 4; ++i) *(f32x4*)(p.X + (size_t)row * D + i * 256 + lane * 4) = x[i]; }
    float ss = 0.f;
#pragma unroll
    for (int i = 0; i < 4; ++i) ss += x[i][0] * x[i][0] + x[i][1] * x[i][1] + x[i][2] * x[i][2] + x[i][3] * x[i][3];
    ss = wave_sum(ss); const float rs = rsqrtf(ss * (1.f / 1024.f) + 1e-6f);
    const float* m = MODl + (size_t)r * 6144;
#pragma unroll
    for (int i = 0; i < 4; ++i) { const int c = i * 256 + lane * 4; const f32x4 g = *(const f32x4*)(g1 + c), sc = *(const f32x4*)(m + 1024 + c), sh = *(const f32x4*)(m + c);
      const f32x4 h = x[i] * rs * g * (sc + 1.f) + sh; u32x2 w; w.x = cvt_pk_bf16(h[0], h[1]); w.y = cvt_pk_bf16(h[2], h[3]);
      *(u32x2*)(p.Hb + (size_t)row * D + c) = w; } }
}

__device__ void ph_norm2(const FP& p, int l, LAS unsigned char* lds) {
  const int t = TIDX, lane = t & 63, gw = blockIdx.x * NWAVES + (t >> 6), GWN = gridDim.x * NWAVES;
  LAS float* wT = (LAS float*)lds;
  __syncthreads();
  { const float* wr = p.w_router + (size_t)l * D * NE;
    for (int i = t; i < D * NE / 4; i += NTHREADS) { const int c = i >> 3, e4 = (i & 7) * 4; const f32x4 v = *(const f32x4*)(wr + (size_t)c * NE + e4);
      wT[(e4 + 0) * 1024 + c] = v[0]; wT[(e4 + 1) * 1024 + c] = v[1]; wT[(e4 + 2) * 1024 + c] = v[2]; wT[(e4 + 3) * 1024 + c] = v[3]; } }
  __syncthreads();
  const float* MODl = p.MOD + (size_t)l * 5 * 6144; const float* g2 = p.g_norm2 + l * D; int* cntl = p.cnt + l * 32;
  const float myb = p.b_router[l * NE + (lane >> 1)];
  for (int row = gw; row < T; row += GWN) { const int b = row / SB, s = row % SB, r = s < CTX ? 4 : b;
    if (l == DEPTH - 1 && s < CTX) continue;
    f32x4 h[4]; float ss = 0.f;
#pragma unroll
    for (int i = 0; i < 4; ++i) { h[i] = *(const f32x4*)(p.X + (size_t)row * D + i * 256 + lane * 4); ss += h[i][0] * h[i][0] + h[i][1] * h[i][1] + h[i][2] * h[i][2] + h[i][3] * h[i][3]; }
    ss = wave_sum(ss); const float rs = rsqrtf(ss * (1.f / 1024.f) + 1e-6f);
    const float* m = MODl + (size_t)r * 6144;
#pragma unroll
    for (int i = 0; i < 4; ++i) { const int c = i * 256 + lane * 4; const f32x4 g = *(const f32x4*)(g2 + c), sc = *(const f32x4*)(m + 4096 + c), sh = *(const f32x4*)(m + 3072 + c);
      h[i] = h[i] * rs * g * (sc + 1.f) + sh; u32x2 w; w.x = cvt_pk_bf16(h[i][0], h[i][1]); w.y = cvt_pk_bf16(h[i][2], h[i][3]);
      *(u32x2*)(p.H2b + (size_t)row * D + c) = w; }
    float acc[32];
#pragma unroll
    for (int e = 0; e < 32; ++e) { float a = 0.f;
#pragma unroll
      for (int i = 0; i < 4; ++i) { const f32x4 w = *(const LAS f32x4*)(wT + e * 1024 + i * 256 + lane * 4); a += h[i][0] * w[0] + h[i][1] * w[1] + h[i][2] * w[2] + h[i][3] * w[3]; }
      acc[e] = a; }
#define BFLY(NV, BIT) { const bool up = (lane >> (BIT)) & 1; _Pragma("unroll") for (int e = 0; e < (NV) / 2; ++e) { const float a = acc[e], bq = acc[e + (NV) / 2]; const float keep = up ? bq : a, send = up ? a : bq; acc[e] = keep + shx(send, 1 << (BIT)); } }
    BFLY(32, 5) BFLY(16, 4) BFLY(8, 3) BFLY(4, 2) BFLY(2, 1)
#undef BFLY
    float v = acc[0] + shx(acc[0], 1); v += myb;
    int myi = lane >> 1; if (lane & 1) v = -3.0e38f;
    float tv[4]; int ti[4];
#pragma unroll
    for (int k = 0; k < 4; ++k) { float bv = v; int bi = myi;
#pragma unroll
      for (int o = 32; o >= 1; o >>= 1) { const float ov = shx(bv, o); const int oi = shxi(bi, o); if (ov > bv || (ov == bv && oi < bi)) { bv = ov; bi = oi; } }
      tv[k] = bv; ti[k] = bi; if (!(lane & 1) && myi == bi) v = -3.0e38f; }
    if (lane == 0) { float e4[4], sum = 0.f;
#pragma unroll
      for (int k = 0; k < 4; ++k) { e4[k] = expf(tv[k] - tv[0]); sum += e4[k]; }
      const float inv = 1.f / sum;
#pragma unroll
      for (int k = 0; k < 4; ++k) { const int pos = atomicAdd(&cntl[ti[k]], 1); p.TOPE[row * 4 + k] = ti[k]; p.TOPP[row * 4 + k] = pos; p.TOPW[row * 4 + k] = e4[k] * inv; p.ROWTOK[(size_t)ti[k] * T + pos] = row; } } }
}

__device__ void ph_final(const FP& p, LAS unsigned char* lds) {
  const int t = TIDX, lane = t & 63, gw = blockIdx.x * NWAVES + (t >> 6), GWN = gridDim.x * NWAVES;
  MoeTab mt = moe_tables(p.cnt + (DEPTH - 1) * 32, lds + LDS_MISC);
  const float* MODp = p.MOD + (size_t)(DEPTH - 1) * 5 * 6144;
  for (int orow = gw; orow < NB * SEQ; orow += GWN) { const int b = orow / SEQ, tk = orow % SEQ, row = b * SB + CTX + tk;
    f32x4 x[4];
#pragma unroll
    for (int i = 0; i < 4; ++i) x[i] = *(const f32x4*)(p.X + (size_t)row * D + i * 256 + lane * 4);
    moe_combine_row(p, DEPTH - 1, row, mt.start, MODp + (size_t)b * 6144 + 5120, lane, x);
    float ss = 0.f;
#pragma unroll
    for (int i = 0; i < 4; ++i) ss += x[i][0] * x[i][0] + x[i][1] * x[i][1] + x[i][2] * x[i][2] + x[i][3] * x[i][3];
    ss = wave_sum(ss); const float rs = rsqrtf(ss * (1.f / 1024.f) + 1e-6f);
#pragma unroll
    for (int i = 0; i < 4; ++i) { const int c = i * 256 + lane * 4; const f32x4 g = *(const f32x4*)(p.g_final + c); *(f32x4*)(p.out + (size_t)orow * D + c) = x[i] * rs * g; } }
}

__device__ void ph_inproj(const FP& p, int l, LAS unsigned char* lds) {
  Gemm g; g.A = p.Hb; g.Bt = p.Wt_in + (size_t)l * INWP * 1024; g.M = T; g.N = INWP; g.K = 1024;
  StaticOrder S; S.init(T, INWP, 1024, gridDim.x, blockIdx.x); EpiInproj E; E.O = p.Pb; E.GAB = p.GAB;
  gemm_phase<EpiInproj, StaticOrder>(lds, g, S, E);
}
__device__ void ph_outproj(const FP& p, int l, LAS unsigned char* lds) {
  Gemm g; g.A = p.CATb; g.Bt = p.Wt_out + (size_t)l * 1024 * 1536; g.M = T; g.N = 1024; g.K = 1536;
  StaticOrder S; S.init(T, 1024, 1536, gridDim.x, blockIdx.x); EpiOutproj E; E.X = p.X; E.MODl = p.MOD + (size_t)l * 5 * 6144;
  gemm_phase<EpiOutproj, StaticOrder>(lds, g, S, E);
}
__device__ void ph_gemm1(const FP& p, int l, LAS unsigned char* lds) {
  MoeTab mt = moe_tables(p.cnt + l * 32, lds + LDS_MISC);
  Gemm g; g.A = p.H2b; g.Bt = p.Wt_gu + (size_t)l * NE * 2048 * 1024; g.M = 0; g.N = 2048; g.K = 1024;
  MoeOrder<true> S; S.nblk = mt.nblk; S.NPN = 8; S.G = gridDim.x; S.c = blockIdx.x; S.K = 1024; S.blk_e = mt.blk_e; S.blk_j = mt.blk_j; S.rowtok = p.ROWTOK; S.cnt = p.cnt + l * 32; S.bstride = (long)2048 * 1024 * 2;
  EpiGateUp E; E.ACT = p.ACTb; E.bgu = p.b_gate_up + (size_t)l * NE * 2048;
  gemm_phase<EpiGateUp, MoeOrder<true>>(lds, g, S, E);
}
__device__ void ph_gemm2(const FP& p, int l, LAS unsigned char* lds) {
  MoeTab mt = moe_tables(p.cnt + l * 32, lds + LDS_MISC);
  Gemm g; g.A = p.ACTb; g.Bt = p.Wt_dn + (size_t)l * NE * 1024 * 1024; g.M = 0; g.N = 1024; g.K = 1024;
  MoeOrder<false> S; S.nblk = mt.nblk; S.NPN = 4; S.G = gridDim.x; S.c = blockIdx.x; S.K = 1024; S.blk_e = mt.blk_e; S.blk_j = mt.blk_j; S.rowtok = nullptr; S.cnt = p.cnt + l * 32; S.bstride = (long)1024 * 1024 * 2;
  EpiDown E; E.YS = p.YSb; E.bdn = p.b_down + (size_t)l * NE * 1024;
  gemm_phase<EpiDown, MoeOrder<false>>(lds, g, S, E);
}
constexpr float QSCALE = 0.07216878364870322f * 1.4426950408889634f;

__device__ __forceinline__ void prep_mla_row(const FP& p, int l, int row, int lane) {
  const int s = row % SB; const bool lat = s >= CTX; const int tok = s - CTX;
  const bf16_t* pr = p.Pb + (size_t)row * INWP;
  { const u32x2 v = *(const u32x2*)(pr + C_DQ + lane * 4); float x[4] = {bflo(v.x), bfhi(v.x), bflo(v.y), bfhi(v.y)};
    const float ss = wave_sum(x[0] * x[0] + x[1] * x[1] + x[2] * x[2] + x[3] * x[3]); const float rs = rsqrtf(ss * (1.f / 256.f) + 1e-6f);
    const f32x4 g = *(const f32x4*)(p.g_cq + l * 256 + lane * 4); u32x2 w; w.x = cvt_pk_bf16(x[0] * rs * g[0], x[1] * rs * g[1]); w.y = cvt_pk_bf16(x[2] * rs * g[2], x[3] * rs * g[3]);
    *(u32x2*)(p.A2b + (size_t)row * MLAK + lane * 4) = w; }
  { const unsigned v = *(const unsigned*)(pr + C_DKV + lane * 2); const float x0 = bflo(v), x1 = bfhi(v);
    const float ss = wave_sum(x0 * x0 + x1 * x1); const float rs = rsqrtf(ss * (1.f / 128.f) + 1e-6f);
    const float g0 = p.g_ckv[l * 128 + lane * 2], g1 = p.g_ckv[l * 128 + lane * 2 + 1];
    *(unsigned*)(p.A2b + (size_t)row * MLAK + 256 + lane * 2) = cvt_pk_bf16(x0 * rs * g0, x1 * rs * g1); }
  { const float x = bf2f(pr[C_KR + lane]); const float xp = shx(x, 16); float y = x;
    if (lat) { const int hh = lane >> 5, ii = lane & 31, fi = ii & 15; const float pos = (float)(hh == 0 ? (tok >> 6) : (tok & 63));
      const float ang = pos * __expf(-(float)fi * (9.210340371976184f / 16.f)); const float cs = __cosf(ang), sn = __sinf(ang);
      y = ii < 16 ? x * cs - xp * sn : x * cs + xp * sn; }
    unsigned u = __float_as_uint(y); u += 0x7fffu + ((u >> 16) & 1u); p.KRb[(size_t)row * 64 + lane] = (bf16_t)(u >> 16); }
}

struct EpiMla {
    static constexpr bool PERM = false;
    bf16_t *Q, *Kn, *V;
    __device__ __forceinline__ void operator()(const f32x4 (&acc)[2][2][4][2], const Unit& u, int wr, int wc, int fr, int fq) const {
        const int row0 = u.pm * BM + wr * 64 + fr; const bool ctxt = (u.pm % 17) == 0; const int tok0 = (u.pm % 17 - 1) * 256 + wr * 64 + fr;
        if (u.pn < 3) {
#pragma unroll
            for (int bj = 0; bj < 2; ++bj) { const int cg = u.pn * 256 + bj * 128 + wc * 32;
                const int g6 = (cg >> 5) % 6;
                float inv[4];
#pragma unroll
                for (int j = 0; j < 4; ++j) inv[j] = __expf(-(float)(4 * fq + j) * (9.210340371976184f / 16.f));
#pragma unroll
                for (int ai = 0; ai < 2; ++ai)
#pragma unroll
                    for (int m = 0; m < 4; ++m) { const int row = row0 + ai * HALF + m * 16; f32x4 v0 = acc[ai][bj][m][0], v1 = acc[ai][bj][m][1];
                        if (g6 >= 4 && !ctxt) { const int tok = tok0 + ai * HALF + m * 16; const float pos = (float)(g6 == 4 ? (tok >> 6) : (tok & 63));
#pragma unroll
                            for (int j = 0; j < 4; ++j) { const float ang = pos * inv[j]; const float cs = __cosf(ang), sn = __sinf(ang); const float x1 = v0[j], x2 = v1[j]; v0[j] = x1 * cs - x2 * sn; v1[j] = x2 * cs + x1 * sn; } }
                        v0 = v0 * QSCALE; v1 = v1 * QSCALE;
                        bf16_t* qp = Q + (size_t)row * 768 + cg + 4 * fq; u32x2 w0, w1; w0.x = cvt_pk_bf16(v0[0], v0[1]); w0.y = cvt_pk_bf16(v0[2], v0[3]); w1.x = cvt_pk_bf16(v1[0], v1[1]); w1.y = cvt_pk_bf16(v1[2], v1[3]);
                        *(u32x2*)qp = w0; *(u32x2*)(qp + 16) = w1; } }
        } else { const int h = u.pn - 3;
#pragma unroll
            for (int bj = 0; bj < 2; ++bj) { bf16_t* base = (bj == 0 ? Kn : V) + h * 128 + wc * 32 + 4 * fq;
#pragma unroll
                for (int ai = 0; ai < 2; ++ai)
#pragma unroll
                    for (int m = 0; m < 4; ++m) { const int row = row0 + ai * HALF + m * 16; const f32x4 v0 = acc[ai][bj][m][0], v1 = acc[ai][bj][m][1];
                        u32x2 w0, w1; w0.x = cvt_pk_bf16(v0[0], v0[1]); w0.y = cvt_pk_bf16(v0[2], v0[3]); w1.x = cvt_pk_bf16(v1[0], v1[1]); w1.y = cvt_pk_bf16(v1[2], v1[3]);
                        *(u32x2*)(base + (size_t)row * 512) = w0; *(u32x2*)(base + (size_t)row * 512 + 16) = w1; } } }
    }
};
__device__ void ph_mla_gemm(const FP& p, int l, LAS unsigned char* lds) {
  Gemm g; g.A = p.A2b; g.Bt = p.Wt_mla + (size_t)l * MLAN * MLAK; g.M = T; g.N = MLAN; g.K = MLAK;
  StaticOrder S; S.init(T, MLAN, MLAK, gridDim.x, blockIdx.x); EpiMla E; E.Q = p.Qb; E.Kn = p.Knb; E.V = p.Vb;
  gemm_phase<EpiMla, StaticOrder>(lds, g, S, E);
}

namespace att {
constexpr int NW = 8, QBLK = 32, KVBLK = 64;
constexpr float THRL = 8.f * 1.4426950408889634f;
constexpr int SHM_V = KVBLK * 128 * 2, SHM_K = KVBLK * 128 * 2, SHM_R = KVBLK * 64 * 2;
constexpr int OFF_V = 0, OFF_K = 2 * SHM_V, OFF_R = OFF_K + 2 * SHM_K, OFF_WS = OFF_R + 2 * SHM_R, OFF_Q = OFF_WS + NW * 64 * 4, SHM_ATTN = OFF_Q + 256 * 128;
#define KSWZ(row, colB) ((row) * 256 + ((colB) ^ (((row) & 7) << 4)))
#define RSWZ(row, colB) ((row) * 128 + ((colB) ^ ((((row) >> 1) & 7) << 4)))
#define SBAR() __builtin_amdgcn_sched_barrier(0)
__device__ __forceinline__ int crow(int r, int hi) { return (r & 3) + 8 * (r >> 2) + 4 * hi; }
__device__ __forceinline__ void partialSM(f32x16& p0, f32x16& p1, float& m_reg, float& mn, float& alpha) {
  float pmax = p0[0];
#pragma unroll
  for (int r = 1; r < 16; ++r) pmax = fmaxf(pmax, p0[r]);
#pragma unroll
  for (int r = 0; r < 16; ++r) pmax = fmaxf(pmax, p1[r]);
  { auto rr = __builtin_amdgcn_permlane32_swap(__float_as_uint(pmax), __float_as_uint(pmax), false, false); pmax = fmaxf(__uint_as_float(rr[0]), __uint_as_float(rr[1])); }
  if (__builtin_expect(__all(pmax - m_reg <= THRL), 1)) { mn = m_reg; alpha = 1.f; }
  else { mn = fmaxf(m_reg, pmax); alpha = __builtin_amdgcn_exp2f(m_reg - mn); m_reg = mn; }
#pragma unroll
  for (int r = 0; r < 16; ++r) p0[r] = p0[r] - mn;
#pragma unroll
  for (int r = 0; r < 16; ++r) p1[r] = p1[r] - mn;
#pragma unroll
  for (int r = 0; r < 16; ++r) p0[r] = __builtin_amdgcn_exp2f(p0[r]);
}
__device__ __forceinline__ void finishSM(f32x16& p0, f32x16& p1, float alpha, float& l_reg, bf16x8& pa0, bf16x8& pa1, bf16x8& pa2, bf16x8& pa3) {
#pragma unroll
  for (int r = 0; r < 16; ++r) p1[r] = __builtin_amdgcn_exp2f(p1[r]);
  float ps = 0;
#pragma unroll
  for (int r = 0; r < 16; ++r) ps += p0[r];
#pragma unroll
  for (int r = 0; r < 16; ++r) ps += p1[r];
  { auto rr = __builtin_amdgcn_permlane32_swap(__float_as_uint(ps), __float_as_uint(ps), false, false); ps = __uint_as_float(rr[0]) + __uint_as_float(rr[1]); }
  l_reg = l_reg * alpha + ps;
#define PK4(P, BASE, OUT) do { unsigned a0 = cvt_pk_bf16(P[BASE + 0], P[BASE + 1]), a1 = cvt_pk_bf16(P[BASE + 2], P[BASE + 3]);   \
    unsigned b0 = cvt_pk_bf16(P[BASE + 4], P[BASE + 5]), b1 = cvt_pk_bf16(P[BASE + 6], P[BASE + 7]);                              \
    auto r0 = __builtin_amdgcn_permlane32_swap(a0, b0, false, false); auto r1 = __builtin_amdgcn_permlane32_swap(a1, b1, false, false); \
    u32x4 w = {r0[0], r1[0], r0[1], r1[1]}; OUT = *reinterpret_cast<bf16x8*>(&w); } while (0)
  PK4(p0, 0, pa0); PK4(p0, 8, pa1); PK4(p1, 0, pa2); PK4(p1, 8, pa3);
#undef PK4
}
__device__ __forceinline__ void qkt(f32x16& p0, f32x16& p1, const char* Ks, const char* Rs, const bf16x8* qr, const char* qrow, int qsw, int r32, int hi) {
  p0 = f32x16{}; p1 = f32x16{};
#pragma unroll
  for (int d0 = 0; d0 < 8; ++d0) { const int cb = (d0 * 16 + hi * 8) * 2;
    const bf16x8 b0 = *reinterpret_cast<const bf16x8*>(Ks + KSWZ(r32, cb));
    const bf16x8 b1 = *reinterpret_cast<const bf16x8*>(Ks + KSWZ(32 + r32, cb));
    p0 = __builtin_amdgcn_mfma_f32_32x32x16_bf16(b0, qr[d0], p0, 0, 0, 0);
    p1 = __builtin_amdgcn_mfma_f32_32x32x16_bf16(b1, qr[d0], p1, 0, 0, 0); }
#pragma unroll
  for (int d0 = 0; d0 < 4; ++d0) { const int cb = (d0 * 16 + hi * 8) * 2;
    const bf16x8 b0 = *reinterpret_cast<const bf16x8*>(Rs + RSWZ(r32, cb));
    const bf16x8 b1 = *reinterpret_cast<const bf16x8*>(Rs + RSWZ(32 + r32, cb));
    const bf16x8 qf = *reinterpret_cast<const bf16x8*>(qrow + (cb ^ qsw));
    p0 = __builtin_amdgcn_mfma_f32_32x32x16_bf16(b0, qf, p0, 0, 0, 0);
    p1 = __builtin_amdgcn_mfma_f32_32x32x16_bf16(b1, qf, p1, 0, 0, 0); }
}
__device__ __forceinline__ int v_st(int k, int c) { const int kk = (k & ~0xC) | ((k & 4) << 1) | ((k & 8) >> 1); return ((kk >> 3) * 4 + (c >> 5)) * 512 + ((kk & 7) * 32 + (c & 31)) * 2; }
__device__ __forceinline__ int v_rd_base(int lane) { return ((lane & 3) << 3) | (((lane >> 2) & 3) << 6) | (((lane >> 4) & 1) << 5) | (((lane >> 5) & 1) << 8); }
constexpr int v_rd_off(int d0, int ks, int half) { return d0 * 512 + ks * 4096 + half * 2048; }
template <int OFF> __device__ __forceinline__ s16x4 tr_read(int vb) { s16x4 r; asm volatile("ds_read_b64_tr_b16 %0, %1 offset:%2" : "=&v"(r) : "v"(vb), "i"(OFF) : "memory"); return r; }
template <int D0> __device__ __forceinline__ void pv_one(f32x16& od, int vb, bf16x8 pa0, bf16x8 pa1, bf16x8 pa2, bf16x8 pa3) {
  const s16x4 l0 = tr_read<v_rd_off(D0, 0, 0)>(vb), h0 = tr_read<v_rd_off(D0, 0, 1)>(vb), l1 = tr_read<v_rd_off(D0, 1, 0)>(vb), h1 = tr_read<v_rd_off(D0, 1, 1)>(vb);
  const s16x4 l2 = tr_read<v_rd_off(D0, 2, 0)>(vb), h2 = tr_read<v_rd_off(D0, 2, 1)>(vb), l3 = tr_read<v_rd_off(D0, 3, 0)>(vb), h3 = tr_read<v_rd_off(D0, 3, 1)>(vb);
  asm volatile("s_waitcnt lgkmcnt(0)" ::: "memory"); SBAR();
#define PK(L, H) (bf16x8){L[0], L[1], L[2], L[3], H[0], H[1], H[2], H[3]}
  od = __builtin_amdgcn_mfma_f32_32x32x16_bf16(pa0, PK(l0, h0), od, 0, 0, 0);
  od = __builtin_amdgcn_mfma_f32_32x32x16_bf16(pa1, PK(l1, h1), od, 0, 0, 0);
  od = __builtin_amdgcn_mfma_f32_32x32x16_bf16(pa2, PK(l2, h2), od, 0, 0, 0);
  od = __builtin_amdgcn_mfma_f32_32x32x16_bf16(pa3, PK(l3, h3), od, 0, 0, 0);
#undef PK
}
__device__ __forceinline__ void pv_d0(f32x16* o, int vb, bf16x8 pa0, bf16x8 pa1, bf16x8 pa2, bf16x8 pa3) {
  pv_one<0>(o[0], vb, pa0, pa1, pa2, pa3); pv_one<1>(o[1], vb, pa0, pa1, pa2, pa3); pv_one<2>(o[2], vb, pa0, pa1, pa2, pa3); pv_one<3>(o[3], vb, pa0, pa1, pa2, pa3);
}
__device__ __forceinline__ void attn_body(const bf16_t* __restrict__ Qb, const bf16_t* __restrict__ Kh, const bf16_t* __restrict__ Rh, const bf16_t* __restrict__ Vh,
                                          bf16_t* __restrict__ Ob, int seq, char* lds) {
  const int tid = TIDX, wid = tid >> 6, lane = tid & 63, r32 = lane & 31, hi = lane >> 5;
  char* V_lds = lds + OFF_V; char* K_lds = lds + OFF_K; char* R_lds = lds + OFF_R;
  float* ws = (float*)(lds + OFF_WS) + wid * 64; float* li_l = ws; float* al_l = ws + 32;
  float m_reg = -1e30f, l_reg = 0; f32x16 o[4] = {}; bf16x8 qr[8];
  const bf16_t* Qw = Qb + (size_t)(wid * QBLK + r32) * 768 + hi * 8;
#pragma unroll
  for (int d0 = 0; d0 < 8; ++d0) qr[d0] = *reinterpret_cast<const bf16x8*>(Qw + d0 * 16);
  const int qrowi = wid * QBLK + r32; char* qrow = lds + OFF_Q + qrowi * 128; const int qsw = ((qrowi >> 1) & 7) << 4;
#pragma unroll
  for (int d0 = 0; d0 < 4; ++d0) *reinterpret_cast<bf16x8*>(qrow + (((d0 * 16 + hi * 8) * 2) ^ qsw)) = *reinterpret_cast<const bf16x8*>(Qw + (8 + d0) * 16);
  const int sr = tid >> 4, sc = (tid & 15) * 8, vst0 = v_st(sr, sc), vst1 = v_st(32 + sr, sc);
  const int rr = tid >> 3, rc = (tid & 7) * 8;
  const int vb0 = (int)(uintptr_t)V_lds + v_rd_base(lane);
  bf16x8 vs0, vs1, ks0, ks1, rs0;
  const unsigned kvo0 = (unsigned)(sr * 512 + sc) * 2u, kvo1 = kvo0 + 32u * 512u * 2u, ro0 = (unsigned)(rr * 64 + rc) * 2u;
#define SLOAD(k0) do { const char* Vt = (const char*)Vh + (size_t)(k0) * 1024; const char* Kt = (const char*)Kh + (size_t)(k0) * 1024; const char* Rt = (const char*)Rh + (size_t)(k0) * 128; \
    vs0 = *(const bf16x8*)(Vt + kvo0); vs1 = *(const bf16x8*)(Vt + kvo1); ks0 = *(const bf16x8*)(Kt + kvo0); ks1 = *(const bf16x8*)(Kt + kvo1); rs0 = *(const bf16x8*)(Rt + ro0); } while (0)
#define SWRITE(b) do { *(bf16x8*)(V_lds + (b) * SHM_V + vst0) = vs0; *(bf16x8*)(V_lds + (b) * SHM_V + vst1) = vs1; const int kc = sc * 2; \
    *(bf16x8*)(K_lds + (b) * SHM_K + KSWZ(sr, kc)) = ks0; *(bf16x8*)(K_lds + (b) * SHM_K + KSWZ(32 + sr, kc)) = ks1; \
    *(bf16x8*)(R_lds + (b) * SHM_R + RSWZ(rr, rc * 2)) = rs0; } while (0)
#define SWAIT() asm volatile("s_waitcnt vmcnt(0)" ::: "memory")
#define RESC(a) do { if (__any((a) < 1.f)) { if (hi == 0) al_l[r32] = (a); asm volatile("s_waitcnt lgkmcnt(0)" ::: "memory"); \
    _Pragma("unroll") for (int d = 0; d < 4; ++d) _Pragma("unroll") for (int r = 0; r < 16; ++r) o[d][r] *= al_l[crow(r, hi)]; } } while (0)
  f32x16 pA0, pA1, pB0, pB1; float mnA, mnB, alA, alB; bf16x8 pa0, pa1, pa2, pa3; const int NT = seq / KVBLK;
  SLOAD(0); SWAIT(); SWRITE(0); __syncthreads();
  qkt(pA0, pA1, K_lds, R_lds, qr, qrow, qsw, r32, hi); partialSM(pA0, pA1, m_reg, mnA, alA);
  SLOAD(KVBLK);
  SWAIT(); SWRITE(1); __syncthreads();
  for (int j = 1; j + 1 < NT; j += 2) {
    SBAR(); qkt(pB0, pB1, K_lds + SHM_K, R_lds + SHM_R, qr, qrow, qsw, r32, hi);
    finishSM(pA0, pA1, alA, l_reg, pa0, pa1, pa2, pa3); SBAR();
    SLOAD((j + 1) * KVBLK); SBAR();
    pv_d0(o, vb0, pa0, pa1, pa2, pa3); partialSM(pB0, pB1, m_reg, mnB, alB);
    __syncthreads(); SWAIT(); SWRITE(0);
    RESC(alB); __syncthreads();
    SBAR(); qkt(pA0, pA1, K_lds, R_lds, qr, qrow, qsw, r32, hi);
    finishSM(pB0, pB1, alB, l_reg, pa0, pa1, pa2, pa3); SBAR();
    SLOAD((j + 2) * KVBLK); SBAR();
    pv_d0(o, vb0 + SHM_V, pa0, pa1, pa2, pa3); partialSM(pA0, pA1, m_reg, mnA, alA);
    __syncthreads(); SWAIT(); SWRITE(1);
    RESC(alA); __syncthreads();
  }
  SBAR(); qkt(pB0, pB1, K_lds + SHM_K, R_lds + SHM_R, qr, qrow, qsw, r32, hi);
  finishSM(pA0, pA1, alA, l_reg, pa0, pa1, pa2, pa3); SBAR();
  pv_d0(o, vb0, pa0, pa1, pa2, pa3); partialSM(pB0, pB1, m_reg, mnB, alB);
  __syncthreads(); RESC(alB);
  finishSM(pB0, pB1, alB, l_reg, pa0, pa1, pa2, pa3); SBAR();
  pv_d0(o, vb0 + SHM_V, pa0, pa1, pa2, pa3);
  if (hi == 0) li_l[r32] = l_reg; asm volatile("s_waitcnt lgkmcnt(0)" ::: "memory");
  float rli[16];
#pragma unroll
  for (int r = 0; r < 16; ++r) rli[r] = __builtin_amdgcn_rcpf(li_l[crow(r, hi)]);
  { int tz = TIDX; const int wz = tz >> 6, lz = tz & 63; const unsigned ob = (unsigned)((wz * QBLK + 4 * (lz >> 5)) * 512 + (lz & 31)) * 2u;
#pragma unroll
    for (int r = 0; r < 16; ++r) {
#pragma unroll
      for (int d0 = 0; d0 < 4; ++d0) { unsigned u = __float_as_uint(o[d0][r] * rli[r]); u += 0x7fffu + ((u >> 16) & 1u);
        *(bf16_t*)((char*)Ob + ob + (unsigned)((((r & 3) + 8 * (r >> 2)) * 512 + d0 * 32) * 2)) = (bf16_t)(u >> 16); } } }
  __syncthreads();
#undef SLOAD
#undef SWRITE
#undef SWAIT
#undef RESC
}
}

__device__ void ph_attn(const FP& p, int l, char* shm) {
  const int nctx = (l == DEPTH - 1) ? 0 : NB * 4; const int nun = NB * 4 * 16 + nctx;
  for (int u = blockIdx.x; u < nun; u += gridDim.x) {
    int b, h, qoff, seq;
    if (u < NB * 4 * 16) { b = u >> 6; h = (u >> 4) & 3; qoff = CTX + (u & 15) * 256; seq = SB; }
    else { const int uu = u - NB * 4 * 16; b = uu >> 2; h = uu & 3; qoff = 0; seq = CTX; }
    const size_t r0 = (size_t)b * SB, q0 = r0 + qoff;
    att::attn_body(p.Qb + q0 * 768 + h * 192, p.Knb + r0 * 512 + h * 128, p.KRb + r0 * 64, p.Vb + r0 * 512 + h * 128, p.AOb + q0 * 512 + h * 128, seq, shm);
  }
}

__device__ __forceinline__ void mla_out_row(const FP& p, int l, int row, int lane) {
  const u32x4 v = *(const u32x4*)(p.AOb + (size_t)row * 512 + lane * 8);
  float x[8] = {bflo(v.x), bfhi(v.x), bflo(v.y), bfhi(v.y), bflo(v.z), bfhi(v.z), bflo(v.w), bfhi(v.w)}; float ss = 0.f;
#pragma unroll
  for (int j = 0; j < 8; ++j) ss += x[j] * x[j];
  ss = wave_sum(ss); const float rs = rsqrtf(ss * (1.f / 512.f) + 1e-6f);
  const f32x4 g0 = *(const f32x4*)(p.g_mla + l * 512 + lane * 8), g1 = *(const f32x4*)(p.g_mla + l * 512 + lane * 8 + 4);
  u32x4 w; w.x = cvt_pk_bf16(x[0] * rs * g0[0], x[1] * rs * g0[1]); w.y = cvt_pk_bf16(x[2] * rs * g0[2], x[3] * rs * g0[3]);
  w.z = cvt_pk_bf16(x[4] * rs * g1[0], x[5] * rs * g1[1]); w.w = cvt_pk_bf16(x[6] * rs * g1[2], x[7] * rs * g1[3]);
  *(u32x4*)(p.CATb + (size_t)row * 1536 + lane * 8) = w;
}
constexpr int NCH = SB / 64;
__device__ __forceinline__ int item_idx(int dir, int bh, int cn) { return (dir * 16 + bh) * NCH + cn; }
__device__ __forceinline__ bf16_t f2bf(float f) { unsigned u = __float_as_uint(f); u += 0x7fffu + ((u >> 16) & 1u); return (bf16_t)(u >> 16); }
__device__ __forceinline__ int scan_chunk(int dir, int n) { return dir == 0 ? n : (n < 4 ? 3 - n : 71 - n); }

__device__ __forceinline__ void prep_ret_row(const FP& p, int row, int lane) {
  const int s = row % SB; const bool lat = s >= CTX; const int tok = s - CTX;
  const bf16_t* pr = p.Pb + (size_t)row * INWP;
  const u32x4 qv = *(const u32x4*)(pr + C_RQ + lane * 8), kv = *(const u32x4*)(pr + C_RK + lane * 8);
  float q[8] = {bflo(qv.x), bfhi(qv.x), bflo(qv.y), bfhi(qv.y), bflo(qv.z), bfhi(qv.z), bflo(qv.w), bfhi(qv.w)};
  float k[8] = {bflo(kv.x), bfhi(kv.x), bflo(kv.y), bfhi(kv.y), bflo(kv.z), bfhi(kv.z), bflo(kv.w), bfhi(kv.w)};
  float qo[8], ko[8];
  const bool lowh = (lane & 4) == 0;
  const float pos = (float)(((lane >> 3) & 1) == 0 ? (tok >> 6) : (tok & 63));
#pragma unroll
  for (int e = 0; e < 8; ++e) { const float qp = shx(q[e], 4), kp = shx(k[e], 4);
    if (lat) { const int fi = (lane & 3) * 8 + e; const float ang = pos * __expf(-(float)fi * (9.210340371976184f / 32.f)); const float cs = __cosf(ang), sn = __sinf(ang);
      qo[e] = lowh ? q[e] * cs - qp * sn : q[e] * cs + qp * sn; ko[e] = lowh ? k[e] * cs - kp * sn : k[e] * cs + kp * sn; }
    else { qo[e] = q[e]; ko[e] = k[e]; } }
  const float sc = 0.08838834764831845f;
  u32x4 wq, wk; wq.x = cvt_pk_bf16(qo[0], qo[1]); wq.y = cvt_pk_bf16(qo[2], qo[3]); wq.z = cvt_pk_bf16(qo[4], qo[5]); wq.w = cvt_pk_bf16(qo[6], qo[7]);
  wk.x = cvt_pk_bf16(ko[0] * sc, ko[1] * sc); wk.y = cvt_pk_bf16(ko[2] * sc, ko[3] * sc); wk.z = cvt_pk_bf16(ko[4] * sc, ko[5] * sc); wk.w = cvt_pk_bf16(ko[6] * sc, ko[7] * sc);
  *(u32x4*)(p.RQb + (size_t)row * 512 + lane * 8) = wq; *(u32x4*)(p.RKb + (size_t)row * 512 + lane * 8) = wk;
}

__device__ __forceinline__ void r2_item(const FP& p, int l, int bh, int cn, int t, LAS unsigned char* hl) {
  const int b = bh >> 2, h = bh & 3; const size_t row0 = (size_t)b * SB + cn * 64;
  LAS bf16_t* sk = (LAS bf16_t*)hl; LAS bf16_t* sv = sk + 64 * 136;
#pragma unroll
  for (int i = 0; i < 4; ++i) { const int idx = t + 256 * i, r = idx >> 4, c8 = (idx & 15) * 8;
    *(LAS u32x4*)(sk + r * 136 + c8) = *(const u32x4*)(p.RKb + (row0 + r) * 512 + h * 128 + c8);
    *(LAS u32x4*)(sv + r * 136 + c8) = *(const u32x4*)(p.Pb + (row0 + r) * INWP + C_RV + h * 128 + c8); }
  __syncthreads();
  const float lgf = __log2f(1.f - __expf(p.ret_decay[l * 8 + h])), lgb = __log2f(1.f - __expf(p.ret_decay[l * 8 + 4 + h]));
#pragma unroll
  for (int q = 0; q < 4; ++q) { const int sidx = t + 256 * q, f = sidx >> 6, ln = sidx & 63, tt = f >> 2, s = f & 3, c = tt * 32 + (ln & 31), hh = ln >> 5;
    { float kf[8];
#pragma unroll
      for (int jj = 0; jj < 8; ++jj) kf[jj] = bf2f(sk[(16 * s + 8 * hh + jj) * 136 + c]);
      u32x4 wf, wb; unsigned tmpf[4], tmpb[4];
#pragma unroll
      for (int jp = 0; jp < 4; ++jp) { const int j0 = 16 * s + 8 * hh + 2 * jp;
        tmpf[jp] = cvt_pk_bf16(kf[2 * jp] * exp2f(lgf * (float)(63 - j0)), kf[2 * jp + 1] * exp2f(lgf * (float)(62 - j0)));
        tmpb[jp] = cvt_pk_bf16(kf[2 * jp] * exp2f(lgb * (float)j0), kf[2 * jp + 1] * exp2f(lgb * (float)(j0 + 1))); }
      wf.x = tmpf[0]; wf.y = tmpf[1]; wf.z = tmpf[2]; wf.w = tmpf[3]; wb.x = tmpb[0]; wb.y = tmpb[1]; wb.z = tmpb[2]; wb.w = tmpb[3];
      *(u32x4*)(p.RKWT + (size_t)item_idx(0, bh, cn) * 8192 + sidx * 8) = wf; *(u32x4*)(p.RKWT + (size_t)item_idx(1, bh, cn) * 8192 + sidx * 8) = wb; }
    { unsigned short vb[8], va[8];
#pragma unroll
      for (int jj = 0; jj < 8; ++jj) { vb[jj] = sv[(16 * s + 8 * hh + jj) * 136 + c]; va[jj] = sv[(16 * s + 8 * (jj >> 2) + 4 * hh + (jj & 3)) * 136 + c]; }
      u32x4 wb2, wa2; wb2.x = vb[0] | ((unsigned)vb[1] << 16); wb2.y = vb[2] | ((unsigned)vb[3] << 16); wb2.z = vb[4] | ((unsigned)vb[5] << 16); wb2.w = vb[6] | ((unsigned)vb[7] << 16);
      wa2.x = va[0] | ((unsigned)va[1] << 16); wa2.y = va[2] | ((unsigned)va[3] << 16); wa2.z = va[4] | ((unsigned)va[5] << 16); wa2.w = va[6] | ((unsigned)va[7] << 16);
      *(u32x4*)(p.RVTB + ((size_t)bh * NCH + cn) * 8192 + sidx * 8) = wb2; *(u32x4*)(p.RVTA + ((size_t)bh * NCH + cn) * 8192 + sidx * 8) = wa2; } }
  __syncthreads();
}

__device__ void ret_scan_job(const FP& p, int l, int bh, int dir, LAS unsigned char* lds) {
  const int t = TIDX, wid = __builtin_amdgcn_readfirstlane(t >> 6), lane = t & 63, hi = lane >> 5;
  const int h = bh & 3; const float lg = __log2f(1.f - __expf(p.ret_decay[l * 8 + dir * 4 + h])); const float g64 = exp2f(lg * 64.f);
  f32x16 S[4];
#pragma unroll
  for (int d = 0; d < 4; ++d)
#pragma unroll
    for (int r = 0; r < 16; ++r) S[d][r] = 0.f;
#define RS_STAGE(cn, buf) do { const char* ga = (const char*)(p.RKWT + (size_t)item_idx(dir, bh, (cn)) * 8192); const char* gb = (const char*)(p.RVTB + ((size_t)bh * NCH + (cn)) * 8192); \
    _Pragma("unroll") for (int q = 0; q < 4; ++q) { const int pc = wid + 8 * q; const char* src = (pc < 16 ? ga + pc * 1024 : gb + (pc - 16) * 1024) + lane * 16; \
      __builtin_amdgcn_global_load_lds((const unsigned*)src, (LAS unsigned*)(lds + (buf) * 32768 + pc * 1024), 16, 0, 0); } } while (0)
  __syncthreads();
  RS_STAGE(scan_chunk(dir, 0), 0);
  for (int n = 0; n < NCH; ++n) { const int cn = scan_chunk(dir, n), buf = n & 1;
    asm volatile("s_waitcnt vmcnt(0)" ::: "memory"); __syncthreads();
    if (n + 1 < NCH) RS_STAGE(scan_chunk(dir, n + 1), buf ^ 1);
    if (wid < 4) {
      bf16_t* st = p.RST + (size_t)item_idx(dir, bh, cn) * 16384;
#pragma unroll
      for (int dt = 0; dt < 4; ++dt)
#pragma unroll
        for (int g = 0; g < 4; ++g) { u32x2 w; w.x = cvt_pk_bf16(S[dt][4 * g], S[dt][4 * g + 1]); w.y = cvt_pk_bf16(S[dt][4 * g + 2], S[dt][4 * g + 3]);
          *(u32x2*)(st + ((wid * 8 + 2 * dt + (g >> 1)) * 64 + (lane & 31) + 32 * (g & 1)) * 8 + 4 * hi) = w; }
#pragma unroll
      for (int dt = 0; dt < 4; ++dt)
#pragma unroll
        for (int r = 0; r < 16; ++r) S[dt][r] *= g64;
      const LAS unsigned char* bb = lds + buf * 32768;
#pragma unroll
      for (int s = 0; s < 4; ++s) { const bf16x8 bf = *(const LAS bf16x8*)(bb + 16384 + (wid * 4 + s) * 1024 + lane * 16);
#pragma unroll
        for (int dt = 0; dt < 4; ++dt) { const bf16x8 af = *(const LAS bf16x8*)(bb + (dt * 4 + s) * 1024 + lane * 16); S[dt] = __builtin_amdgcn_mfma_f32_32x32x16_bf16(af, bf, S[dt], 0, 0, 0); } }
    }
  }
  asm volatile("s_waitcnt vmcnt(0)" ::: "memory"); __syncthreads();
#undef RS_STAGE
}

__device__ __forceinline__ bf16x8 pack_step(const f32x16& x, int s) {
  u32x4 pk; pk.x = cvt_pk_bf16(x[8 * s], x[8 * s + 1]); pk.y = cvt_pk_bf16(x[8 * s + 2], x[8 * s + 3]); pk.z = cvt_pk_bf16(x[8 * s + 4], x[8 * s + 5]); pk.w = cvt_pk_bf16(x[8 * s + 6], x[8 * s + 7]);
  return __builtin_bit_cast(bf16x8, pk);
}
__device__ __forceinline__ bf16x8 scale_frag(bf16x8 a, float f) {
  const u32x4 v = __builtin_bit_cast(u32x4, a); u32x4 o;
  o.x = cvt_pk_bf16(bflo(v.x) * f, bfhi(v.x) * f); o.y = cvt_pk_bf16(bflo(v.y) * f, bfhi(v.y) * f); o.z = cvt_pk_bf16(bflo(v.z) * f, bfhi(v.z) * f); o.w = cvt_pk_bf16(bflo(v.w) * f, bfhi(v.w) * f);
  return __builtin_bit_cast(bf16x8, o);
}
__device__ __forceinline__ int crow16(int r, int hi) { return (r & 3) + 8 * (r >> 2) + 4 * hi; }

__device__ void ret_out_unit(const FP& p, int l, int bh, int cn, int ih, int lane) {
  const int b = bh >> 2, h = bh & 3, c32 = lane & 31, hi = lane >> 5; const size_t row0 = (size_t)b * SB + cn * 64; const int ipos = 32 * ih + c32;
  const float lgf = __log2f(1.f - __expf(p.ret_decay[l * 8 + h])), lgb = __log2f(1.f - __expf(p.ret_decay[l * 8 + 4 + h]));
  const unsigned lo16 = (unsigned)lane * 16u;
  f32x16 P0, P1;
#pragma unroll
  for (int r = 0; r < 16; ++r) { P0[r] = 0.f; P1[r] = 0.f; }
  const char* qb = (const char*)(p.RQb + (row0 + 32 * ih) * 512 + h * 128); const char* kb = (const char*)(p.RKb + row0 * 512 + h * 128);
  const unsigned rowoff = (unsigned)(c32 * 512 + 8 * hi) * 2u;
#pragma unroll 1
  for (int s = 0; s < 8; ++s) { const bf16x8 qf = *(const bf16x8*)(qb + rowoff + s * 32); const bf16x8 k0 = *(const bf16x8*)(kb + rowoff + s * 32), k1 = *(const bf16x8*)(kb + 32 * 1024 + rowoff + s * 32);
    P0 = __builtin_amdgcn_mfma_f32_32x32x16_bf16(k0, qf, P0, 0, 0, 0); P1 = __builtin_amdgcn_mfma_f32_32x32x16_bf16(k1, qf, P1, 0, 0, 0); }
  bf16x8 pb[2][2][2];
#pragma unroll
  for (int dir = 0; dir < 2; ++dir) { const float lg = dir == 0 ? lgf : lgb;
#pragma unroll
    for (int jt = 0; jt < 2; ++jt) { f32x16 pd;
#pragma unroll
      for (int r = 0; r < 16; ++r) { const int j = 32 * jt + crow16(r, hi); const int dlt = dir == 0 ? ipos - j : j - ipos; const float pv = jt == 0 ? P0[r] : P1[r]; pd[r] = dlt >= 0 ? pv * exp2f(lg * (float)dlt) : 0.f; }
      pb[dir][jt][0] = pack_step(pd, 0); pb[dir][jt][1] = pack_step(pd, 1); } }
  __builtin_amdgcn_sched_barrier(0);
  f32x16 O[4];
  const char* va = (const char*)(p.RVTA + ((size_t)bh * NCH + cn) * 8192);
#pragma unroll
  for (int et = 0; et < 4; ++et) { f32x16 a;
#pragma unroll
    for (int r = 0; r < 16; ++r) a[r] = 0.f;
    const char* vae = va + et * 4096;
#pragma unroll
    for (int jt = 0; jt < 2; ++jt)
#pragma unroll
      for (int ss = 0; ss < 2; ++ss) { const bf16x8 af = *(const bf16x8*)(vae + lo16 + (2 * jt + ss) * 1024);
        a = __builtin_amdgcn_mfma_f32_32x32x16_bf16(af, pb[0][jt][ss], a, 0, 0, 0); a = __builtin_amdgcn_mfma_f32_32x32x16_bf16(af, pb[1][jt][ss], a, 0, 0, 0); }
    O[et] = a; __builtin_amdgcn_sched_barrier(0); }
  const float facf = exp2f(lgf * (float)(ipos + 1)), facb = exp2f(lgb * (float)(64 - ipos));
  const char* stf = (const char*)(p.RST + (size_t)item_idx(0, bh, cn) * 16384); const char* stb = (const char*)(p.RST + (size_t)item_idx(1, bh, cn) * 16384);
#pragma unroll 1
  for (int s = 0; s < 8; ++s) { const bf16x8 qf = *(const bf16x8*)(qb + rowoff + s * 32); const bf16x8 qsf = scale_frag(qf, facf), qsb = scale_frag(qf, facb);
#pragma unroll
    for (int et = 0; et < 4; ++et) { const bf16x8 af = *(const bf16x8*)(stf + et * 8192 + s * 1024 + lo16), ab = *(const bf16x8*)(stb + et * 8192 + s * 1024 + lo16);
      O[et] = __builtin_amdgcn_mfma_f32_32x32x16_bf16(af, qsf, O[et], 0, 0, 0); O[et] = __builtin_amdgcn_mfma_f32_32x32x16_bf16(ab, qsb, O[et], 0, 0, 0); } }
  float sm = 0.f;
#pragma unroll
  for (int et = 0; et < 4; ++et)
#pragma unroll
    for (int r = 0; r < 16; ++r) sm += O[et][r];
  sm += shx(sm, 32); const float mu = sm * (1.f / 128.f); float vq = 0.f;
#pragma unroll
  for (int et = 0; et < 4; ++et)
#pragma unroll
    for (int r = 0; r < 16; ++r) { const float dd = O[et][r] - mu; vq += dd * dd; }
  vq += shx(vq, 32); const float rs = rsqrtf(vq * (1.f / 128.f) + 1e-5f);
  const size_t row = row0 + ipos; const bf16_t* gp = p.Pb + row * INWP + C_RG + h * 128; const float* gr = p.g_ret + l * 512 + h * 128; bf16_t* op = p.CATb + row * 1536 + 512 + h * 128;
#pragma unroll
  for (int et = 0; et < 4; ++et)
#pragma unroll
    for (int g = 0; g < 4; ++g) { const int e0 = 32 * et + 8 * g + 4 * hi; const u32x2 gz = *(const u32x2*)(gp + e0); const f32x4 gg = *(const f32x4*)(gr + e0);
      const float z[4] = {bflo(gz.x), bfhi(gz.x), bflo(gz.y), bfhi(gz.y)}; float y[4];
#pragma unroll
      for (int j = 0; j < 4; ++j) y[j] = (O[et][4 * g + j] - mu) * rs * gg[j] * silu_f(z[j]);
      u32x2 w; w.x = cvt_pk_bf16(y[0], y[1]); w.y = cvt_pk_bf16(y[2], y[3]); *(u32x2*)(op + e0) = w; }
}
__device__ __forceinline__ void prep_gdn_row(const FP& p, int l, int row, int lane) {
  const int s = row % SB; const bool lat = s >= CTX; const int lo = lat ? CTX : 0, hi_ = lat ? SB : CTX;
  const float* cw = p.gdn_conv + (size_t)l * 5 * 1536;
  float o[3][8];
#pragma unroll
  for (int blk = 0; blk < 3; ++blk) {
#pragma unroll
    for (int e = 0; e < 8; ++e) o[blk][e] = 0.f;
#pragma unroll
    for (int j = 0; j < 5; ++j) { const int s2 = s + j - 2; if (s2 < lo || s2 >= hi_) continue;
      const u32x4 xv = *(const u32x4*)(p.Pb + (size_t)(row + j - 2) * INWP + C_GQ + blk * 512 + lane * 8);
      const f32x4 w0 = *(const f32x4*)(cw + j * 1536 + blk * 512 + lane * 8), w1 = *(const f32x4*)(cw + j * 1536 + blk * 512 + lane * 8 + 4);
      o[blk][0] += w0[0] * bflo(xv.x); o[blk][1] += w0[1] * bfhi(xv.x); o[blk][2] += w0[2] * bflo(xv.y); o[blk][3] += w0[3] * bfhi(xv.y);
      o[blk][4] += w1[0] * bflo(xv.z); o[blk][5] += w1[1] * bfhi(xv.z); o[blk][6] += w1[2] * bflo(xv.w); o[blk][7] += w1[3] * bfhi(xv.w); }
#pragma unroll
    for (int e = 0; e < 8; ++e) o[blk][e] = silu_f(o[blk][e]); }
#pragma unroll
  for (int blk = 0; blk < 2; ++blk) { float ss = 0.f;
#pragma unroll
    for (int e = 0; e < 8; ++e) ss += o[blk][e] * o[blk][e];
    ss += shx(ss, 1); ss += shx(ss, 2); ss += shx(ss, 4); ss += shx(ss, 8);
    const float rs = rsqrtf(ss + 1e-6f) * (blk == 0 ? 0.08838834764831845f : 1.f);
#pragma unroll
    for (int e = 0; e < 8; ++e) o[blk][e] *= rs; }
  u32x4 w;
  w.x = cvt_pk_bf16(o[0][0], o[0][1]); w.y = cvt_pk_bf16(o[0][2], o[0][3]); w.z = cvt_pk_bf16(o[0][4], o[0][5]); w.w = cvt_pk_bf16(o[0][6], o[0][7]); *(u32x4*)(p.GQb + (size_t)row * 512 + lane * 8) = w;
  w.x = cvt_pk_bf16(o[1][0], o[1][1]); w.y = cvt_pk_bf16(o[1][2], o[1][3]); w.z = cvt_pk_bf16(o[1][4], o[1][5]); w.w = cvt_pk_bf16(o[1][6], o[1][7]); *(u32x4*)(p.GKb + (size_t)row * 512 + lane * 8) = w;
  w.x = cvt_pk_bf16(o[2][0], o[2][1]); w.y = cvt_pk_bf16(o[2][2], o[2][3]); w.z = cvt_pk_bf16(o[2][4], o[2][5]); w.w = cvt_pk_bf16(o[2][6], o[2][7]); *(u32x4*)(p.GVb + (size_t)row * 512 + lane * 8) = w;
  if (lane < 8) { const float a = p.GAB[(size_t)row * 16 + lane] + p.gdn_dt_bias[l * 8 + lane]; const float xe = __expf(a);
    const float sp = a > 20.f ? a : (xe < 0.03f ? xe * (1.f - xe * (0.5f - xe * (1.f / 3.f))) : __logf(1.f + xe));
    p.GLA[(size_t)row * 8 + lane] = -__expf(p.gdn_a_log[l * 8 + lane]) * sp; p.GBETA[(size_t)row * 8 + lane] = 1.f / (1.f + __expf(-p.GAB[(size_t)row * 16 + 8 + lane])); }
}

__device__ __forceinline__ void g2_item(const FP& p, int bh, int dir, int cn, int t, LAS unsigned char* hl) {
  const int b = bh >> 2, h = bh & 3, w = t >> 6, lane = t & 63, c32 = lane & 31, hi = lane >> 5; const size_t row0 = (size_t)b * SB + cn * 64;
  LAS float* sA = (LAS float*)hl; LAS float* sg = sA + 64 * 64; LAS float* sb = sg + 64;
  const int item = item_idx(dir, bh, cn);
  if (w == 0) { float la = p.GLA[(row0 + lane) * 8 + dir * 4 + h]; const float bt = p.GBETA[(row0 + lane) * 8 + dir * 4 + h];
#pragma unroll
    for (int o = 1; o < 64; o <<= 1) { const float v = dir == 0 ? shup(la, o) : shdn(la, o); if (dir == 0 ? lane >= o : lane + o < 64) la += v; }
    sg[lane] = la; sb[lane] = bt; p.GG[(size_t)item * 64 + lane] = la; }
  __syncthreads();
  { const int it = w >> 1, jt = w & 1; f32x16 a;
#pragma unroll
    for (int r = 0; r < 16; ++r) a[r] = 0.f;
    const bf16_t* ka = p.GKb + (row0 + 32 * it + c32) * 512 + h * 128 + 8 * hi; const bf16_t* kb = p.GKb + (row0 + 32 * jt + c32) * 512 + h * 128 + 8 * hi;
#pragma unroll
    for (int s = 0; s < 8; ++s) a = __builtin_amdgcn_mfma_f32_32x32x16_bf16(*(const bf16x8*)(ka + 16 * s), *(const bf16x8*)(kb + 16 * s), a, 0, 0, 0);
    const int j = 32 * jt + c32; const float gj = sg[j];
#pragma unroll
    for (int r = 0; r < 16; ++r) { const int i = 32 * it + crow16(r, hi); const bool before = dir == 0 ? j < i : j > i;
      const float v = before ? sb[i] * a[r] * __expf(fminf(sg[i] - gj, 0.f)) : 0.f;
      if (dir == 0) sA[i * 64 + j] = v; else sA[(63 - i) * 64 + (63 - j)] = v; } }
  __syncthreads();
  { float x[64]; const float glast = sg[dir == 0 ? 63 : 0];
    if (t < 128) {
#pragma unroll
      for (int ip = 0; ip < 64; ++ip) { const int i = dir == 0 ? ip : 63 - ip; x[ip] = sb[i] * bf2f(p.GVb[(row0 + i) * 512 + h * 128 + t]); }
    } else { const int d = t - 128; bf16_t* kt = p.GKTT + (size_t)item * 8192;
#pragma unroll
      for (int ip = 0; ip < 64; ++ip) { const int i = dir == 0 ? ip : 63 - ip; const float kv = bf2f(p.GKb[(row0 + i) * 512 + h * 128 + d]); x[ip] = sb[i] * kv * __expf(sg[i]);
        const float ktv = kv * __expf(glast - sg[i]); const int kk = i & 15, hp = (kk >> 2) & 1, jj = ((kk >> 3) << 2) | (kk & 3);
        kt[(((d >> 5) * 4 + (i >> 4)) * 64 + (d & 31) + 32 * hp) * 8 + jj] = f2bf(ktv); } }
#pragma unroll
    for (int ip = 1; ip < 64; ++ip) { float acc = x[ip];
#pragma unroll
      for (int jp = 0; jp < ip; ++jp) acc -= sA[ip * 64 + jp] * x[jp];
      x[ip] = acc; }
    if (t < 128) { const int e = t; bf16_t* ut = p.GUT + (size_t)item * 8192;
#pragma unroll
      for (int ip = 0; ip < 64; ++ip) { const int i = dir == 0 ? ip : 63 - ip; const int rem = i & 31;
        ut[((((e >> 5) * 2 + (i >> 5)) * 4 + (rem >> 3)) * 64 + (e & 31) + 32 * ((rem >> 2) & 1)) * 4 + (rem & 3)] = f2bf(x[ip]); }
    } else { const int d = t - 128; bf16_t* gw = p.GWb + (size_t)item * 8192; const int kk = d & 15, hp = (kk >> 2) & 1, jj = ((kk >> 3) << 2) | (kk & 3);
#pragma unroll
      for (int ip = 0; ip < 64; ++ip) { const int i = dir == 0 ? ip : 63 - ip; gw[(((i >> 5) * 8 + (d >> 4)) * 64 + (i & 31) + 32 * hp) * 8 + jj] = f2bf(x[ip]); } } }
  __syncthreads();
}

__device__ void gdn_scan_job(const FP& p, int bh, int dir, LAS unsigned char* lds) {
  const int t = TIDX, wid = __builtin_amdgcn_readfirstlane(t >> 6), lane = t & 63, hi = lane >> 5;
  f32x16 S[4];
#pragma unroll
  for (int d = 0; d < 4; ++d)
#pragma unroll
    for (int r = 0; r < 16; ++r) S[d][r] = 0.f;
#define GS_STAGE(cn, buf) do { const size_t io = (size_t)item_idx(dir, bh, (cn)) * 8192 * 2; const char* g0 = (const char*)p.GWb + io; const char* g1 = (const char*)p.GKTT + io; const char* g2 = (const char*)p.GUT + io; \
    _Pragma("unroll") for (int q = 0; q < 6; ++q) { const int pc = wid + 8 * q; const char* src = (pc < 16 ? g0 + pc * 1024 : (pc < 32 ? g1 + (pc - 16) * 1024 : g2 + (pc - 32) * 1024)) + lane * 16; \
      __builtin_amdgcn_global_load_lds((const unsigned*)src, (LAS unsigned*)(lds + (buf) * 49152 + pc * 1024), 16, 0, 0); } } while (0)
  __syncthreads();
  GS_STAGE(scan_chunk(dir, 0), 0);
  for (int n = 0; n < NCH; ++n) { const int cn = scan_chunk(dir, n), buf = n & 1;
    asm volatile("s_waitcnt vmcnt(0)" ::: "memory"); __syncthreads();
    if (n + 1 < NCH) GS_STAGE(scan_chunk(dir, n + 1), buf ^ 1);
    if (wid < 4) { const int item = item_idx(dir, bh, cn);
      const float adec = __expf(p.GG[(size_t)item * 64 + (dir == 0 ? 63 : 0)]);
      bf16_t* st = p.GST + (size_t)item * 16384;
#pragma unroll
      for (int dt = 0; dt < 4; ++dt)
#pragma unroll
        for (int g = 0; g < 4; ++g) { u32x2 w; w.x = cvt_pk_bf16(S[dt][4 * g], S[dt][4 * g + 1]); w.y = cvt_pk_bf16(S[dt][4 * g + 2], S[dt][4 * g + 3]);
          *(u32x2*)(st + ((wid * 8 + 2 * dt + (g >> 1)) * 64 + (lane & 31) + 32 * (g & 1)) * 8 + 4 * hi) = w; }
      const LAS unsigned char* bb = lds + buf * 49152;
      f32x16 vn[2];
#pragma unroll
      for (int it = 0; it < 2; ++it)
#pragma unroll
        for (int r = 0; r < 16; ++r) vn[it][r] = 0.f;
#pragma unroll
      for (int s = 0; s < 8; ++s) { const bf16x8 sf = pack_step(S[s >> 1], s & 1);
#pragma unroll
        for (int it = 0; it < 2; ++it) { const bf16x8 af = *(const LAS bf16x8*)(bb + (it * 8 + s) * 1024 + lane * 16); vn[it] = __builtin_amdgcn_mfma_f32_32x32x16_bf16(af, sf, vn[it], 0, 0, 0); } }
      bf16_t* vt = p.GVNT + (size_t)item * 8192;
#pragma unroll
      for (int it = 0; it < 2; ++it)
#pragma unroll
        for (int g = 0; g < 4; ++g) { const u32x2 uu = *(const LAS u32x2*)(bb + 32768 + (((wid * 2 + it) * 4 + g) * 64 + lane) * 8);
          vn[it][4 * g] = bflo(uu.x) - vn[it][4 * g]; vn[it][4 * g + 1] = bfhi(uu.x) - vn[it][4 * g + 1]; vn[it][4 * g + 2] = bflo(uu.y) - vn[it][4 * g + 2]; vn[it][4 * g + 3] = bfhi(uu.y) - vn[it][4 * g + 3];
          u32x2 w; w.x = cvt_pk_bf16(vn[it][4 * g], vn[it][4 * g + 1]); w.y = cvt_pk_bf16(vn[it][4 * g + 2], vn[it][4 * g + 3]);
          *(u32x2*)(vt + ((wid * 4 + 2 * it + (g >> 1)) * 64 + lane) * 8 + 4 * (g & 1)) = w; }
#pragma unroll
      for (int dt = 0; dt < 4; ++dt)
#pragma unroll
        for (int r = 0; r < 16; ++r) S[dt][r] *= adec;
#pragma unroll
      for (int s = 0; s < 4; ++s) { const bf16x8 vf = pack_step(vn[s >> 1], s & 1);
#pragma unroll
        for (int dt = 0; dt < 4; ++dt) { const bf16x8 af = *(const LAS bf16x8*)(bb + 16384 + (dt * 4 + s) * 1024 + lane * 16); S[dt] = __builtin_amdgcn_mfma_f32_32x32x16_bf16(af, vf, S[dt], 0, 0, 0); } }
    }
  }
  asm volatile("s_waitcnt vmcnt(0)" ::: "memory"); __syncthreads();
#undef GS_STAGE
}

__device__ void gdn_out_unit(const FP& p, int l, int bh, int cn, int ih, int lane) {
  const int b = bh >> 2, h = bh & 3, c32 = lane & 31, hi = lane >> 5; const size_t row0 = (size_t)b * SB + cn * 64; const int ipos = 32 * ih + c32;
  const unsigned lo16 = (unsigned)lane * 16u;
  const int itf = item_idx(0, bh, cn), itb = item_idx(1, bh, cn);
  f32x16 P0, P1;
#pragma unroll
  for (int r = 0; r < 16; ++r) { P0[r] = 0.f; P1[r] = 0.f; }
  const char* qb = (const char*)(p.GQb + (row0 + 32 * ih) * 512 + h * 128); const char* kb = (const char*)(p.GKb + row0 * 512 + h * 128);
  const unsigned rowoff = (unsigned)(c32 * 512 + 8 * hi) * 2u;
#pragma unroll 1
  for (int s = 0; s < 8; ++s) { const bf16x8 qf = *(const bf16x8*)(qb + rowoff + s * 32); const bf16x8 k0 = *(const bf16x8*)(kb + rowoff + s * 32), k1 = *(const bf16x8*)(kb + 32 * 1024 + rowoff + s * 32);
    P0 = __builtin_amdgcn_mfma_f32_32x32x16_bf16(k0, qf, P0, 0, 0, 0); P1 = __builtin_amdgcn_mfma_f32_32x32x16_bf16(k1, qf, P1, 0, 0, 0); }
  const float* ggf = p.GG + (size_t)itf * 64; const float* ggb = p.GG + (size_t)itb * 64;
  const float gfi = ggf[ipos], gbi = ggb[ipos];
  bf16x8 pb[2][2][2];
#pragma unroll
  for (int dir = 0; dir < 2; ++dir) { const float* gg = dir == 0 ? ggf : ggb; const float gi = dir == 0 ? gfi : gbi;
#pragma unroll
    for (int jt = 0; jt < 2; ++jt) { f32x16 pd;
#pragma unroll
      for (int g = 0; g < 4; ++g) { const f32x4 gj = *(const f32x4*)(gg + 32 * jt + 8 * g + 4 * hi);
#pragma unroll
        for (int r3 = 0; r3 < 4; ++r3) { const int r = 4 * g + r3; const int j = 32 * jt + 8 * g + 4 * hi + r3; const bool ok = dir == 0 ? j <= ipos : j >= ipos; const float pv = jt == 0 ? P0[r] : P1[r];
          pd[r] = ok ? pv * __expf(fminf(gi - gj[r3], 0.f)) : 0.f; } }
      pb[dir][jt][0] = pack_step(pd, 0); pb[dir][jt][1] = pack_step(pd, 1); } }
  __builtin_amdgcn_sched_barrier(0);
  f32x16 O[4];
  const char* vaf = (const char*)(p.GVNT + (size_t)itf * 8192); const char* vab = (const char*)(p.GVNT + (size_t)itb * 8192);
#pragma unroll
  for (int et = 0; et < 4; ++et) { f32x16 a;
#pragma unroll
    for (int r = 0; r < 16; ++r) a[r] = 0.f;
#pragma unroll
    for (int jt = 0; jt < 2; ++jt)
#pragma unroll
      for (int ss = 0; ss < 2; ++ss) { const bf16x8 af = *(const bf16x8*)(vaf + et * 4096 + lo16 + (2 * jt + ss) * 1024), ab = *(const bf16x8*)(vab + et * 4096 + lo16 + (2 * jt + ss) * 1024);
        a = __builtin_amdgcn_mfma_f32_32x32x16_bf16(af, pb[0][jt][ss], a, 0, 0, 0); a = __builtin_amdgcn_mfma_f32_32x32x16_bf16(ab, pb[1][jt][ss], a, 0, 0, 0); }
    O[et] = a; __builtin_amdgcn_sched_barrier(0); }
  const float facf = __expf(gfi), facb = __expf(gbi);
  const char* stf = (const char*)(p.GST + (size_t)itf * 16384); const char* stb = (const char*)(p.GST + (size_t)itb * 16384);
#pragma unroll 1
  for (int s = 0; s < 8; ++s) { const bf16x8 qf = *(const bf16x8*)(qb + rowoff + s * 32); const bf16x8 qsf = scale_frag(qf, facf), qsb = scale_frag(qf, facb);
#pragma unroll
    for (int et = 0; et < 4; ++et) { const bf16x8 af = *(const bf16x8*)(stf + et * 8192 + s * 1024 + lo16), ab = *(const bf16x8*)(stb + et * 8192 + s * 1024 + lo16);
      O[et] = __builtin_amdgcn_mfma_f32_32x32x16_bf16(af, qsf, O[et], 0, 0, 0); O[et] = __builtin_amdgcn_mfma_f32_32x32x16_bf16(ab, qsb, O[et], 0, 0, 0); } }
  float ss2 = 0.f;
#pragma unroll
  for (int et = 0; et < 4; ++et)
#pragma unroll
    for (int r = 0; r < 16; ++r) ss2 += O[et][r] * O[et][r];
  ss2 += shx(ss2, 32); const float rs = rsqrtf(ss2 * (1.f / 128.f) + 1e-6f);
  const size_t row = row0 + ipos; const bf16_t* zp = p.Pb + row * INWP + C_GZ + h * 128; const float* gr = p.g_gdn + l * 128; bf16_t* op = p.CATb + row * 1536 + 1024 + h * 128;
#pragma unroll
  for (int et = 0; et < 4; ++et)
#pragma unroll
    for (int g = 0; g < 4; ++g) { const int e0 = 32 * et + 8 * g + 4 * hi; const u32x2 gz = *(const u32x2*)(zp + e0); const f32x4 gg = *(const f32x4*)(gr + e0);
      const float z[4] = {bflo(gz.x), bfhi(gz.x), bflo(gz.y), bfhi(gz.y)}; float y[4];
#pragma unroll
      for (int j = 0; j < 4; ++j) y[j] = O[et][4 * g + j] * rs * gg[j] * silu_f(z[j]);
      u32x2 w; w.x = cvt_pk_bf16(y[0], y[1]); w.y = cvt_pk_bf16(y[2], y[3]); *(u32x2*)(op + e0) = w; }
}
#define XB_TMO      128
#define XB_XCNT(j)  (256  + 64 * (j))
#define XB_XSUB(j)  (1280 + 64 * (j))
#define XB_XGEN(j)  (2304 + 64 * (j))
#define XB_TOP      3328
#define XB_TOPGEN   3392
#define XCD_BAR_WORDS 3456
#define XB_SPIN_CAP (1u << 18)

__device__ __forceinline__ unsigned xb_ld(unsigned* p)              { return __hip_atomic_load(p, __ATOMIC_RELAXED, __HIP_MEMORY_SCOPE_AGENT); }
__device__ __forceinline__ unsigned xb_add(unsigned* p, unsigned v) { return __hip_atomic_fetch_add(p, v, __ATOMIC_RELAXED, __HIP_MEMORY_SCOPE_AGENT); }
__device__ __forceinline__ unsigned xb_xcc_id() { return (unsigned)__builtin_amdgcn_s_getreg((3 << 11) | 20) & 0xFu; }
#define XB_SPIN(cond, bar) do { unsigned _sp = 0; while (cond) { __builtin_amdgcn_s_sleep(1); \
    if ((++_sp & 255u) == 0u) { if (xb_ld(&(bar)[XB_TMO])) break; if (_sp > XB_SPIN_CAP) { atomicAdd(&(bar)[XB_TMO], 1u); break; } } } } while (0)

struct XcdBarrier {
    unsigned* bar; unsigned x;
    volatile LAS unsigned* st;
};

__device__ __forceinline__ XcdBarrier xcd_barrier_post(unsigned* bar, volatile LAS unsigned* st) {
    XcdBarrier b; b.bar = bar; b.x = xb_xcc_id(); b.st = st;
    if (threadIdx.x == 0) (void)xb_add(&bar[XB_XCNT(b.x)], 1u);
    return b;
}
__device__ __forceinline__ void xcd_barrier_complete(unsigned* bar, unsigned x, unsigned& nloc, unsigned& nx) {
    const unsigned G = gridDim.x * gridDim.y * gridDim.z;
    unsigned sum, cnt, mine, sp = 0u;
    for (;;) {
        sum = 0u; cnt = 0u; mine = 0u;
#pragma unroll
        for (unsigned j = 0; j < 16; ++j) { const unsigned c = xb_ld(&bar[XB_XCNT(j)]); sum += c; cnt += (c > 0u) ? 1u : 0u; mine = (j == x) ? c : mine; }
        if (sum == G) break;
        __builtin_amdgcn_s_sleep(1);
        if ((++sp & 255u) == 0u) { if (xb_ld(&bar[XB_TMO])) break; if (sp > XB_SPIN_CAP) { atomicAdd(&bar[XB_TMO], 1u); break; } }
    }
    nloc = mine > 0u ? mine : 1u; nx = cnt > 0u ? cnt : 1u;
}

__device__ __forceinline__ void xcd_barrier(const XcdBarrier& b) {
    asm volatile("s_waitcnt vmcnt(0)" ::: "memory");
    __syncthreads();
    if (threadIdx.x == 0) {
        unsigned* bar = b.bar; unsigned bx = b.x; asm volatile("" : "+s"(bx));
        __builtin_amdgcn_s_waitcnt(0);
        unsigned nloc = b.st[0], nx = b.st[1];
        if (nloc == 0u) { xcd_barrier_complete(bar, bx, nloc, nx); b.st[0] = nloc; b.st[1] = nx; }
        const unsigned old = xb_add(&bar[XB_XSUB(bx)], 1u);
        const unsigned gen = old / nloc;
        if (old + 1u == (gen + 1u) * nloc) {
            __builtin_amdgcn_fence(__ATOMIC_RELEASE, "agent");
            asm volatile("s_waitcnt vmcnt(0)" ::: "memory");
            const unsigned og = xb_add(&bar[XB_TOP], 1u);
            const unsigned tg = og / nx;
            if (og + 1u == (tg + 1u) * nx) xb_add(&bar[XB_TOPGEN], 1u);
            else XB_SPIN(xb_ld(&bar[XB_TOPGEN]) == tg, bar);
            __builtin_amdgcn_fence(__ATOMIC_ACQUIRE, "agent");
            xb_add(&bar[XB_XGEN(bx)], 1u);
            asm volatile("s_waitcnt vmcnt(0)" ::: "memory");
        } else {
            XB_SPIN(xb_ld(&bar[XB_XGEN(bx)]) == gen, bar);
            __builtin_amdgcn_fence(__ATOMIC_ACQUIRE, "agent");
            asm volatile("s_waitcnt vmcnt(0)" ::: "memory");
        }
    }
    __syncthreads();
}

__device__ __forceinline__ void ph_prep(const FP& p, int l) { const int t = TIDX, lane = t & 63, gw = blockIdx.x * NWAVES + (t >> 6), GWN = gridDim.x * NWAVES;
  for (int row = gw; row < T; row += GWN) { prep_mla_row(p, l, row, lane); prep_ret_row(p, row, lane); prep_gdn_row(p, l, row, lane); } }
__device__ __forceinline__ void ph_items(const FP& p, int l, LAS unsigned char* lds) {
  for (int pr = blockIdx.x; pr < 16 * NCH / 2; pr += gridDim.x) { const int it = pr * 2 + (TIDX >> 8); r2_item(p, l, it / NCH, it % NCH, TIDX & 255, lds + (TIDX >> 8) * 40960); }
  for (int pr = blockIdx.x; pr < 2 * 16 * NCH / 2; pr += gridDim.x) { const int it = pr * 2 + (TIDX >> 8); g2_item(p, (it / NCH) & 15, it / (16 * NCH), it % NCH, TIDX & 255, lds + (TIDX >> 8) * 20480); } }
__device__ __forceinline__ void ph_post(const FP& p, int l) { const int t = TIDX, lane = t & 63, gw = blockIdx.x * NWAVES + (t >> 6), GWN = gridDim.x * NWAVES;
  for (int row = gw; row < T; row += GWN) mla_out_row(p, l, row, lane);
  for (int u = gw; u < 16 * NCH * 2; u += GWN) { ret_out_unit(p, l, u / (NCH * 2), (u >> 1) % NCH, u & 1, lane); gdn_out_unit(p, l, u / (NCH * 2), (u >> 1) % NCH, u & 1, lane); } }

__global__ void __launch_bounds__(512, 2) mega_fwd(FP p) {
  extern __shared__ __attribute__((aligned(16))) unsigned char shm[];
  LAS unsigned char* lds = (LAS unsigned char*)shm;
  volatile LAS unsigned* xbw = (volatile LAS unsigned*)(lds + LDS_BYTES - 16);
  if (TIDX == 0) { xbw[0] = 0u; xbw[1] = 0u; xbw[2] = 0u; xbw[3] = 0u; }
  __syncthreads();
  XcdBarrier bar = xcd_barrier_post(p.ctl, xbw);
  ph_prologue(p, lds);
  xcd_barrier(bar);
  for (int l = 0; l < DEPTH; ++l) {
    ph_norm1(p, l, lds);            xcd_barrier(bar);
    ph_inproj(p, l, lds);           xcd_barrier(bar);
    ph_prep(p, l);                  xcd_barrier(bar);
    ph_mla_gemm(p, l, lds); ph_items(p, l, lds); xcd_barrier(bar);
    if (blockIdx.x < 32) ret_scan_job(p, l, blockIdx.x >> 1, blockIdx.x & 1, lds); else if (blockIdx.x < 64) gdn_scan_job(p, (blockIdx.x - 32) >> 1, blockIdx.x & 1, lds);
    ph_attn(p, l, (char*)shm);      xcd_barrier(bar);
    ph_post(p, l);                  xcd_barrier(bar);
    ph_outproj(p, l, lds);          xcd_barrier(bar);
    ph_norm2(p, l, lds);            xcd_barrier(bar);
    ph_gemm1(p, l, lds);            xcd_barrier(bar);
    ph_gemm2(p, l, lds);            xcd_barrier(bar);
  }
  ph_final(p, lds);
}

static size_t f_layout(char* base, FP& p) {
  size_t o = 0; auto take = [&](size_t bytes) { char* q = base + o; o += (bytes + 255) & ~(size_t)255; return q; };
  p.ctl = (unsigned*)take((size_t)CTL_WORDS * 4); p.cnt = (int*)(p.ctl + 4096);
  p.Wt_in = (bf16_t*)take((size_t)DEPTH * INWP * 1024 * 2); p.Wt_mla = (bf16_t*)take((size_t)DEPTH * MLAN * MLAK * 2); p.Wt_out = (bf16_t*)take((size_t)DEPTH * 1024 * 1536 * 2);
  p.Wt_gu = (bf16_t*)take((size_t)DEPTH * NE * 2048 * 1024 * 2); p.Wt_dn = (bf16_t*)take((size_t)DEPTH * NE * 1024 * 1024 * 2);
  p.MOD = (float*)take((size_t)DEPTH * 5 * 6144 * 4); p.X = (float*)take((size_t)T * D * 4); p.GAB = (float*)take((size_t)T * 16 * 4); p.TOPW = (float*)take((size_t)T * 4 * 4);
  p.Hb = (bf16_t*)take((size_t)T * D * 2); p.H2b = (bf16_t*)take((size_t)T * D * 2); p.Pb = (bf16_t*)take((size_t)T * INWP * 2); p.CATb = (bf16_t*)take((size_t)T * 1536 * 2);
  p.ACTb = (bf16_t*)take((size_t)ROWS_P * 1024 * 2); p.YSb = (bf16_t*)take((size_t)ROWS_P * 1024 * 2);
  p.A2b = (bf16_t*)take((size_t)T * MLAK * 2); p.Qb = (bf16_t*)take((size_t)T * 768 * 2); p.Knb = (bf16_t*)take((size_t)T * 512 * 2); p.Vb = (bf16_t*)take((size_t)T * 512 * 2);
  p.KRb = (bf16_t*)take((size_t)T * 64 * 2); p.AOb = (bf16_t*)take((size_t)T * 512 * 2);
  p.RQb = (bf16_t*)take((size_t)T * 512 * 2); p.RKb = (bf16_t*)take((size_t)T * 512 * 2); p.RKWT = (bf16_t*)take((size_t)2 * 16 * NCH * 8192 * 2);
  p.RVTB = (bf16_t*)take((size_t)16 * NCH * 8192 * 2); p.RVTA = (bf16_t*)take((size_t)16 * NCH * 8192 * 2); p.RST = (bf16_t*)take((size_t)2 * 16 * NCH * 16384 * 2);
  p.GQb = (bf16_t*)take((size_t)T * 512 * 2); p.GKb = (bf16_t*)take((size_t)T * 512 * 2); p.GVb = (bf16_t*)take((size_t)T * 512 * 2);
  p.GLA = (float*)take((size_t)T * 8 * 4); p.GBETA = (float*)take((size_t)T * 8 * 4); p.GG = (float*)take((size_t)2 * 16 * NCH * 64 * 4);
  p.GWb = (bf16_t*)take((size_t)2 * 16 * NCH * 8192 * 2); p.GKTT = (bf16_t*)take((size_t)2 * 16 * NCH * 8192 * 2); p.GUT = (bf16_t*)take((size_t)2 * 16 * NCH * 8192 * 2);
  p.GVNT = (bf16_t*)take((size_t)2 * 16 * NCH * 8192 * 2); p.GST = (bf16_t*)take((size_t)2 * 16 * NCH * 16384 * 2);
  p.TOPE = (int*)take((size_t)T * 4 * 4); p.TOPP = (int*)take((size_t)T * 4 * 4); p.ROWTOK = (int*)take((size_t)NE * T * 4);
  return o;
}
}

extern "C" void kernel_launch(void* const* d_in, const int* in_sizes, int n_in, void* d_out, int out_size, void* d_ws, size_t ws_size, hipStream_t stream) {
  static int grid = 0;
  if (grid == 0) {
    if (hipFuncSetAttribute((const void*)fx::mega_fwd, hipFuncAttributeMaxDynamicSharedMemorySize, fx::LDS_BYTES) != hipSuccess) { fprintf(stderr, "kernel_launch: hipFuncSetAttribute failed\n"); grid = -1; return; }
    int dev = 0, cus = 0, per_cu = 0; (void)hipGetDevice(&dev); (void)hipDeviceGetAttribute(&cus, hipDeviceAttributeMultiprocessorCount, dev);
    if (hipOccupancyMaxActiveBlocksPerMultiprocessor(&per_cu, (const void*)fx::mega_fwd, 512, fx::LDS_BYTES) != hipSuccess || per_cu < 1) { fprintf(stderr, "kernel_launch: occupancy query says %d blocks per CU\n", per_cu); grid = -1; return; }
    grid = cus;
    if (grid < 64) { fprintf(stderr, "kernel_launch: needs >= 64 CUs\n"); grid = -1; return; }
  }
  if (grid < 0) return;
  fx::FP p{}; { const float** f = (const float**)&p; for (int i = 0; i < 28; ++i) f[i] = (const float*)d_in[i]; }
  p.out = (float*)d_out;
  const size_t fsz = fx::f_layout((char*)d_ws, p);
  if (fsz > ws_size || n_in != 28) { fprintf(stderr, "kernel_launch: ws too small (%zu > %zu) or n_in %d\n", fsz, ws_size, n_in); return; }
  (void)hipMemsetAsync(p.ctl, 0, (size_t)fx::CTL_WORDS * 4, stream);
  hipLaunchKernelGGL(fx::mega_fwd, dim3(grid), dim3(512), fx::LDS_BYTES, stream, p);
}
```

```cpp
#include <hip/hip_runtime.h>
#include <stdint.h>
#include <stdio.h>

namespace cfg {
constexpr int D = 1024, NB = 4, SEQ = 4096, DEPTH = 4, CTX = 256, GW = 64;
constexpr int SB = CTX + SEQ;
constexpr int T = NB * SB;
constexpr int INW = 4560;
constexpr int C_DQ = 0, C_DKV = 256, C_KR = 384, C_RQ = 448, C_RK = 960, C_RV = 1472, C_RG = 1984, C_GQ = 2496, C_GK = 3008, C_GV = 3520, C_GZ = 4032, C_GA = 4544, C_GB = 4552;
constexpr int NE = 32, TOPK = 4, DE = 1024;
}
namespace fx {
using namespace cfg;
#define LAS __attribute__((address_space(3)))
typedef unsigned short bf16_t;
typedef short bf16x8 __attribute__((ext_vector_type(8)));
typedef short s16x4 __attribute__((ext_vector_type(4)));
typedef float f32x4 __attribute__((ext_vector_type(4)));
typedef float f32x16 __attribute__((ext_vector_type(16)));
typedef unsigned u32x4 __attribute__((ext_vector_type(4)));
typedef unsigned u32x2 __attribute__((ext_vector_type(2)));

__device__ __forceinline__ int opaque_tid() { int t = threadIdx.x; asm volatile("" : "+v"(t)); return t; }
#define TIDX opaque_tid()
__device__ __forceinline__ float shx(float v, int m) { const int ln = TIDX & 63; return __int_as_float(__builtin_amdgcn_ds_bpermute((ln ^ m) << 2, __float_as_int(v))); }
__device__ __forceinline__ int shxi(int v, int m) { const int ln = TIDX & 63; return __builtin_amdgcn_ds_bpermute((ln ^ m) << 2, v); }
__device__ __forceinline__ float shup(float v, int o) { const int ln = TIDX & 63; const int src = ln >= o ? ln - o : ln; return __int_as_float(__builtin_amdgcn_ds_bpermute(src << 2, __float_as_int(v))); }
__device__ __forceinline__ int shupi(int v, int o) { const int ln = TIDX & 63; const int src = ln >= o ? ln - o : ln; return __builtin_amdgcn_ds_bpermute(src << 2, v); }
__device__ __forceinline__ float shdn(float v, int o) { const int ln = TIDX & 63; const int src = ln + o < 64 ? ln + o : ln; return __int_as_float(__builtin_amdgcn_ds_bpermute(src << 2, __float_as_int(v))); }
constexpr int NTHREADS = 512, NWAVES = 8;
constexpr int BM = 256, BK = 64, HALF = 128, HTB = HALF * BK * 2, STAGE_BYTES = 8 * HTB, NXCD = 8, WGM = 8;
constexpr int LDS_MISC = STAGE_BYTES;
constexpr int LDS_BYTES = 163840;
constexpr int INWP = 4608;
constexpr int MLAN = 1792, MLAK = 384;
constexpr int MAXBLK = (T * TOPK) / 256 + NE;
constexpr int ROWS_P = MAXBLK * 256;

__device__ __forceinline__ unsigned cvt_pk_bf16(float lo, float hi) { unsigned r; asm volatile("v_cvt_pk_bf16_f32 %0, %1, %2" : "=v"(r) : "v"(lo), "v"(hi)); return r; }
__device__ __forceinline__ float bf2f(unsigned short b) { return __uint_as_float(((unsigned)b) << 16); }
__device__ __forceinline__ bf16_t f2bf(float f) { unsigned u = __float_as_uint(f); u += 0x7fffu + ((u >> 16) & 1u); return (bf16_t)(u >> 16); }
__device__ __forceinline__ float bflo(unsigned w) { return __uint_as_float(w << 16); }
__device__ __forceinline__ float bfhi(unsigned w) { return __uint_as_float(w & 0xffff0000u); }
__device__ __forceinline__ float silu_f(float v) { return v / (1.f + __expf(-v)); }
__device__ __forceinline__ int crow16(int r, int hi) { return (r & 3) + 8 * (r >> 2) + 4 * hi; }

__host__ __device__ __forceinline__ int lds_byte(int r, int c) { const int st = (r >> 4) * 2 + (c >> 5), rr = r & 15, cc = c & 31, ob = rr * 64 + cc * 2; return st * 1024 + (ob ^ (((ob >> 9) & 1) << 5)); }
__host__ __device__ __forceinline__ void stage_rc(int b, int& R, int& C) { const int st = b / 1024, sb = b % 1024, swz = sb ^ (((sb >> 9) & 1) << 5); R = (st >> 1) * 16 + swz / 64; C = (st & 1) * 32 + (swz % 64) / 2; }
__host__ __device__ __forceinline__ int perm32(int rho) { const int n = rho >> 4, i = rho & 15; return 8 * (i >> 2) + 4 * n + (i & 3); }

struct Unit { int pm, pn, e, pad_; long aoff, boff; };
struct Gemm { const bf16_t* A; const bf16_t* Bt; int M, N, K; };

struct StaticOrder {
    static constexpr bool DYN_A = false;
    int nM, nN, nwg, G, c, K;
    __device__ void init(int M, int N, int K_, int G_, int c_) { nM = M / BM; nN = N / BM; nwg = nM * nN; G = G_; c = c_; K = K_; }
    __device__ bool next(int i, Unit& u) const {
        const long L = (long)i * G + c; if (L >= nwg) return false;
        int wgid = (int)L; { const int q = nwg / NXCD, r = nwg % NXCD, xcd = wgid % NXCD, off = wgid / NXCD; wgid = (xcd < r ? xcd * (q + 1) : r * (q + 1) + (xcd - r) * q) + off; }
        const int nig = WGM * nN, gid = wgid / nig, fm = gid * WGM, gsz = (nM - fm) < WGM ? (nM - fm) : WGM;
        u.pm = fm + ((wgid % nig) % gsz); u.pn = (wgid % nig) / gsz; u.e = 0; u.pad_ = 0;
        u.aoff = (long)u.pm * BM * K * 2; u.boff = (long)u.pn * BM * K * 2; return true;
    }
    __device__ __forceinline__ void a_off(const Unit&, const int (&R)[2], const int (&C)[2], unsigned (&v)[2][2]) const {
#pragma unroll
        for (int h = 0; h < 2; ++h)
#pragma unroll
            for (int i = 0; i < 2; ++i) v[h][i] = (unsigned)((h * HALF + R[i]) * K + C[i]) * 2u;
    }
};
struct LatentOrder {
    static constexpr bool DYN_A = false;
    int nN, G, c, K;
    __device__ bool next(int i, Unit& u) const {
        const int L = i * G + c; if (L >= 64 * nN) return false;
        const int lt = L / nN; u.pn = L % nN; u.pm = (lt >> 4) * 17 + 1 + (lt & 15); u.e = 0; u.pad_ = 0;
        u.aoff = (long)u.pm * BM * K * 2; u.boff = (long)u.pn * BM * K * 2; return true;
    }
    __device__ __forceinline__ void a_off(const Unit&, const int (&R)[2], const int (&C)[2], unsigned (&v)[2][2]) const {
#pragma unroll
        for (int h = 0; h < 2; ++h)
#pragma unroll
            for (int i = 0; i < 2; ++i) v[h][i] = (unsigned)((h * HALF + R[i]) * K + C[i]) * 2u;
    }
};
template <bool GATHER> struct MoeOrder {
    static constexpr bool DYN_A = GATHER;
    int nblk, NPN, G, c, K; const LAS int* blk_e; const LAS int* blk_j; const LAS int* ulist; int* rowtok; int* cnt; long bstride;
    __device__ bool next(int i, Unit& u) const {
        if (i >= __builtin_amdgcn_readfirstlane(ulist[0])) return false;
        const int blk = __builtin_amdgcn_readfirstlane(ulist[1 + 2 * i]); u.pn = __builtin_amdgcn_readfirstlane(ulist[2 + 2 * i]); u.pm = blk; u.e = __builtin_amdgcn_readfirstlane(blk_e[blk]); u.pad_ = __builtin_amdgcn_readfirstlane(blk_j[blk]);
        u.aoff = GATHER ? 0 : (long)blk * BM * K * 2; u.boff = (long)u.e * bstride + (long)u.pn * BM * K * 2; return true;
    }
    __device__ __forceinline__ void a_off(const Unit& u, const int (&R)[2], const int (&C)[2], unsigned (&v)[2][2]) const {
        if (GATHER) { const int n = __hip_atomic_load(&cnt[u.e], __ATOMIC_RELAXED, __HIP_MEMORY_SCOPE_AGENT); const int* lst = rowtok + (size_t)u.e * T + u.pad_ * 256;
#pragma unroll
            for (int h = 0; h < 2; ++h)
#pragma unroll
                for (int i = 0; i < 2; ++i) { const int rr = h * HALF + R[i]; const int tok = (u.pad_ * 256 + rr < n) ? __hip_atomic_load(&lst[rr], __ATOMIC_RELAXED, __HIP_MEMORY_SCOPE_AGENT) : 0;     v[h][i] = (unsigned)(tok * K + C[i]) * 2u; }
        } else {
#pragma unroll
            for (int h = 0; h < 2; ++h)
#pragma unroll
                for (int i = 0; i < 2; ++i) v[h][i] = (unsigned)((h * HALF + R[i]) * K + C[i]) * 2u;
        }
    }
};

struct EpiInproj {
    static constexpr bool PERM = true;
    bf16_t* O; float* GAB;
    __device__ __forceinline__ void operator()(const f32x4 (&acc)[2][2][4][2], const Unit& u, int wr, int wc, int fr, int fq) const {
        const int row0 = u.pm * BM + wr * 64 + fr, col0 = u.pn * BM + wc * 32 + 8 * fq;
#pragma unroll
        for (int ai = 0; ai < 2; ++ai)
#pragma unroll
            for (int m = 0; m < 4; ++m) { const int row = row0 + ai * HALF + m * 16; bf16_t* rowp = O + (size_t)row * INWP + col0;
#pragma unroll
                for (int bj = 0; bj < 2; ++bj) { const f32x4 v0 = acc[ai][bj][m][0], v1 = acc[ai][bj][m][1];
                    u32x4 w; w.x = cvt_pk_bf16(v0[0], v0[1]); w.y = cvt_pk_bf16(v0[2], v0[3]); w.z = cvt_pk_bf16(v1[0], v1[1]); w.w = cvt_pk_bf16(v1[2], v1[3]);
                    *(u32x4*)(rowp + bj * HALF) = w; }
                if (u.pn == 17 && wc == 2 && fq < 2) { float* gp = GAB + (size_t)row * 16 + fq * 8; *(f32x4*)gp = acc[ai][1][m][0]; *(f32x4*)(gp + 4) = acc[ai][1][m][1]; } }
    }
};
struct EpiOutproj {
    static constexpr bool PERM = false;
    float* X; const float* MODl;
    __device__ __forceinline__ void operator()(const f32x4 (&acc)[2][2][4][2], const Unit& u, int wr, int wc, int fr, int fq) const {
        const int row0 = u.pm * BM + wr * 64 + fr, col0 = u.pn * BM + wc * 32 + 4 * fq; const int rmod = (u.pm % 17 == 0) ? 4 : u.pm / 17;
        const float* gt = MODl + (size_t)rmod * 6144 + 2048 + col0; f32x4 gv[2][2];
#pragma unroll
        for (int bj = 0; bj < 2; ++bj)
#pragma unroll
            for (int n = 0; n < 2; ++n) gv[bj][n] = *(const f32x4*)(gt + bj * HALF + n * 16);
#pragma unroll
        for (int ai = 0; ai < 2; ++ai)
#pragma unroll
            for (int m = 0; m < 4; ++m) { float* rowp = X + (size_t)(row0 + ai * HALF + m * 16) * D + col0;
#pragma unroll
                for (int bj = 0; bj < 2; ++bj)
#pragma unroll
                    for (int n = 0; n < 2; ++n) { f32x4* p = (f32x4*)(rowp + bj * HALF + n * 16); *p = *p + gv[bj][n] * acc[ai][bj][m][n]; } }
    }
};
struct EpiGateUp {
    static constexpr bool PERM = true;
    bf16_t* ACT; const float* bgu;
    __device__ __forceinline__ void operator()(const f32x4 (&acc)[2][2][4][2], const Unit& u, int wr, int wc, int fr, int fq) const {
        const int row0 = u.pm * BM + wr * 64 + fr, oc = u.pn * HALF + wc * 32 + 8 * fq; const float* bg = bgu + (size_t)u.e * 2048 + oc;
        f32x4 bgv[2], buv[2];
#pragma unroll
        for (int n = 0; n < 2; ++n) { bgv[n] = *(const f32x4*)(bg + 4 * n); buv[n] = *(const f32x4*)(bg + 1024 + 4 * n); }
#pragma unroll
        for (int ai = 0; ai < 2; ++ai)
#pragma unroll
            for (int m = 0; m < 4; ++m) { float o[8];
#pragma unroll
                for (int n = 0; n < 2; ++n) { const f32x4 gv = acc[ai][0][m][n] + bgv[n], uv = acc[ai][1][m][n] + buv[n];
#pragma unroll
                    for (int j = 0; j < 4; ++j) { const float gg = fminf(gv[j], 7.f), uu = fminf(fmaxf(uv[j], -7.f), 7.f); o[n * 4 + j] = (uu + 1.f) * gg / (1.f + __expf(-1.702f * gg)); } }
                u32x4 w; w.x = cvt_pk_bf16(o[0], o[1]); w.y = cvt_pk_bf16(o[2], o[3]); w.z = cvt_pk_bf16(o[4], o[5]); w.w = cvt_pk_bf16(o[6], o[7]);
                *(u32x4*)(ACT + (size_t)(row0 + ai * HALF + m * 16) * 1024 + oc) = w; }
    }
};
struct EpiDown {
    static constexpr bool PERM = true;
    bf16_t* YS; const float* bdn;
    __device__ __forceinline__ void operator()(const f32x4 (&acc)[2][2][4][2], const Unit& u, int wr, int wc, int fr, int fq) const {
        const int row0 = u.pm * BM + wr * 64 + fr, col0 = u.pn * BM + wc * 32 + 8 * fq; const float* bb = bdn + (size_t)u.e * 1024 + col0;
        f32x4 bv[2][2];
#pragma unroll
        for (int bj = 0; bj < 2; ++bj)
#pragma unroll
            for (int n = 0; n < 2; ++n) bv[bj][n] = *(const f32x4*)(bb + bj * HALF + 4 * n);
#pragma unroll
        for (int ai = 0; ai < 2; ++ai)
#pragma unroll
            for (int m = 0; m < 4; ++m) { bf16_t* rowp = YS + (size_t)(row0 + ai * HALF + m * 16) * 1024 + col0;
#pragma unroll
                for (int bj = 0; bj < 2; ++bj) { const f32x4 v0 = acc[ai][bj][m][0] + bv[bj][0], v1 = acc[ai][bj][m][1] + bv[bj][1];
                    u32x4 w; w.x = cvt_pk_bf16(v0[0], v0[1]); w.y = cvt_pk_bf16(v0[2], v0[3]); w.z = cvt_pk_bf16(v1[0], v1[1]); w.w = cvt_pk_bf16(v1[2], v1[3]);
                    *(u32x4*)(rowp + bj * HALF) = w; } }
    }
};

template <class Epi, class Sched>
__device__ __forceinline__ void gemm_phase(LAS unsigned char* lds, const Gemm g, const Sched& S, const Epi& E) {
    const int tid = TIDX, wid = __builtin_amdgcn_readfirstlane(tid >> 6), lane = tid & 63, wr = wid >> 2, wc = wid & 3, fr = lane & 15, fq = lane >> 4;
    const int K = g.K, nt = K / BK;
    int Rr[2], Cc[2]; unsigned voffB[2];
#pragma unroll
    for (int i = 0; i < 2; ++i) { int R, C; stage_rc(tid * 16 + i * 8192, R, C); Rr[i] = R; Cc[i] = C; const int Rb = Epi::PERM ? ((R & ~31) + perm32(R & 31)) : R; voffB[i] = (unsigned)(Rb * K + C) * 2u; }
    const size_t kstep = (size_t)(BK * 2);
    const size_t hstep = (size_t)HALF * K * 2;
    const unsigned ldsw = (unsigned)wid * 1024u;
    const int aoff = lds_byte(wr * 64 + fr, fq * 8), boff = lds_byte(wc * 32 + fr, fq * 8);
#define PG8_SA(b, h) (((b) * 2 + (h)) * HTB)
#define PG8_SB(b, h) ((4 + (b) * 2 + (h)) * HTB)
#define PG8_STAGE(bufoff, gbase, voff) do { _Pragma("unroll") for (int _i = 0; _i < 2; ++_i) \
        __builtin_amdgcn_global_load_lds((const unsigned*)((const char*)(gbase) + (voff)[_i]), (LAS unsigned*)(lds + (bufoff) + ldsw + _i * 8192), 16, 0, 0); } while (0)
#define PG8_LDA(dst, b, h) do { _Pragma("unroll") for (int m = 0; m < 4; ++m) _Pragma("unroll") for (int k = 0; k < 2; ++k) dst[m][k] = *(const LAS bf16x8*)(lds + PG8_SA(b, h) + aoff + m * 2048 + k * 1024); } while (0)
#define PG8_LDB(dst, b, h) do { _Pragma("unroll") for (int n = 0; n < 2; ++n) _Pragma("unroll") for (int k = 0; k < 2; ++k) dst[n][k] = *(const LAS bf16x8*)(lds + PG8_SB(b, h) + boff + n * 2048 + k * 1024); } while (0)
#define PG8_MMA(ai, bj, At, Bt) do { __builtin_amdgcn_s_setprio(1); _Pragma("unroll") for (int m = 0; m < 4; ++m) _Pragma("unroll") for (int n = 0; n < 2; ++n) _Pragma("unroll") for (int k = 0; k < 2; ++k) \
        acc[ai][bj][m][n] = __builtin_amdgcn_mfma_f32_16x16x32_bf16(Bt[n][k], At[m][k], acc[ai][bj][m][n], 0, 0, 0); __builtin_amdgcn_s_setprio(0); } while (0)
#define PG8_WAIT_V(n) asm volatile("s_waitcnt vmcnt(" #n ")" ::: "memory")
#define PG8_WAIT_L(n) asm volatile("s_waitcnt lgkmcnt(" #n ")" ::: "memory")
#define PG8_BAR __builtin_amdgcn_s_barrier()
#define PG8_SCHED __builtin_amdgcn_sched_barrier(0)
    Unit cur, nxt; int ui = 0;
    if (!S.next(0, cur)) return;
    f32x4 acc[2][2][4][2];
#pragma unroll
    for (int a = 0; a < 2; ++a)
#pragma unroll
        for (int b = 0; b < 2; ++b)
#pragma unroll
            for (int m = 0; m < 4; ++m)
#pragma unroll
                for (int n = 0; n < 2; ++n) acc[a][b][m][n] = (f32x4){0.f, 0.f, 0.f, 0.f};
    bf16x8 At[4][2], B0[2][2], B1[2][2];
    unsigned vAc[2][2], vAn[2][2];
    S.a_off(cur, Rr, Cc, vAc);
    const char* cA = (const char*)g.A + cur.aoff; const char* cB = (const char*)g.Bt + cur.boff;
    PG8_STAGE(PG8_SB(0, 0), cB, voffB); PG8_STAGE(PG8_SA(0, 0), cA, vAc[0]); PG8_STAGE(PG8_SB(0, 1), cB + hstep, voffB); PG8_STAGE(PG8_SA(0, 1), cA, vAc[1]);
    if (wr == 1) PG8_BAR;
    PG8_WAIT_V(4); PG8_BAR;
    PG8_STAGE(PG8_SB(1, 0), cB + kstep, voffB); PG8_STAGE(PG8_SA(1, 0), cA + kstep, vAc[0]); PG8_STAGE(PG8_SB(1, 1), cB + hstep + kstep, voffB);
    PG8_WAIT_V(6); PG8_BAR;
    for (;;) {
        const bool has_next = S.next(ui + 1, nxt);
        if (!Sched::DYN_A) { }
        else if (has_next) S.a_off(nxt, Rr, Cc, vAn);
        else {
#pragma unroll
            for (int h = 0; h < 2; ++h)
#pragma unroll
                for (int i = 0; i < 2; ++i) vAn[h][i] = vAc[h][i]; }
        const char* nA = has_next ? (const char*)g.A + nxt.aoff : cA; const char* nB = has_next ? (const char*)g.Bt + nxt.boff : cB;
#pragma unroll 1
        for (int t = 0; t < nt; t += 2) {
            const bool last = (t == nt - 2);
            const char* a1 = cA + (size_t)(t + 1) * kstep;
            const char* a2 = last ? nA : cA + (size_t)(t + 2) * kstep; const char* b2 = last ? nB : cB + (size_t)(t + 2) * kstep;
            const char* a3 = a2 + kstep; const char* b3 = b2 + kstep;
            unsigned w2[2][2];
#pragma unroll
            for (int h = 0; h < 2; ++h)
#pragma unroll
                for (int i = 0; i < 2; ++i) w2[h][i] = (Sched::DYN_A && last) ? vAn[h][i] : vAc[h][i];
            PG8_LDB(B0, 0, 0); PG8_SCHED; PG8_LDA(At, 0, 0); PG8_STAGE(PG8_SA(1, 1), a1, vAc[1]);
            PG8_WAIT_L(8); PG8_BAR; PG8_WAIT_L(0); PG8_MMA(0, 0, At, B0); PG8_BAR; PG8_SCHED;
            PG8_LDB(B1, 0, 1); PG8_STAGE(PG8_SB(0, 0), b2, voffB);
            PG8_BAR; PG8_WAIT_L(0); PG8_MMA(0, 1, At, B1); PG8_BAR;
            PG8_LDA(At, 0, 1); PG8_STAGE(PG8_SA(0, 0), a2, w2[0]);
            PG8_BAR; PG8_WAIT_L(0); PG8_MMA(1, 0, At, B0); PG8_BAR; PG8_SCHED;
            PG8_STAGE(PG8_SB(0, 1), b2 + hstep, voffB);
            PG8_WAIT_V(6); PG8_BAR; PG8_MMA(1, 1, At, B1); PG8_BAR;
            PG8_LDB(B0, 1, 0); PG8_SCHED; PG8_LDA(At, 1, 0); PG8_STAGE(PG8_SA(0, 1), a2, w2[1]);
            PG8_WAIT_L(8); PG8_BAR; PG8_WAIT_L(0); PG8_MMA(0, 0, At, B0); PG8_BAR; PG8_SCHED;
            PG8_LDB(B1, 1, 1); PG8_STAGE(PG8_SB(1, 0), b3, voffB);
            PG8_BAR; PG8_WAIT_L(0); PG8_MMA(0, 1, At, B1); PG8_BAR;
            PG8_LDA(At, 1, 1); PG8_STAGE(PG8_SA(1, 0), a3, w2[0]);
            PG8_BAR; PG8_WAIT_L(0); PG8_MMA(1, 0, At, B0); PG8_BAR; PG8_SCHED;
            PG8_STAGE(PG8_SB(1, 1), b3 + hstep, voffB);
            PG8_WAIT_V(6); PG8_BAR; PG8_MMA(1, 1, At, B1); PG8_BAR;
        }
        asm volatile("s_nop 9\n\ts_nop 9" : "+v"(acc[1][1][3][1]), "+v"(acc[1][1][3][0]), "+v"(acc[1][1][2][1]), "+v"(acc[1][1][2][0]));
        { int tz = TIDX; const int wz = tz >> 6, lz = tz & 63; E(acc, cur, wz >> 2, wz & 3, lz & 15, lz >> 4); }
        if (!has_next) break;
#pragma unroll
        for (int a = 0; a < 2; ++a)
#pragma unroll
            for (int b = 0; b < 2; ++b)
#pragma unroll
                for (int m = 0; m < 4; ++m)
#pragma unroll
                    for (int n = 0; n < 2; ++n) acc[a][b][m][n] = (f32x4){0.f, 0.f, 0.f, 0.f};
        cur = nxt; cA = nA; cB = nB; ++ui;
#pragma unroll
        for (int h = 0; h < 2; ++h)
#pragma unroll
            for (int i = 0; i < 2; ++i) if (Sched::DYN_A) vAc[h][i] = vAn[h][i];
    }
    PG8_WAIT_V(0);
    if (wr == 0) PG8_BAR;
    PG8_BAR;
#undef PG8_SA
#undef PG8_SB
#undef PG8_STAGE
#undef PG8_LDA
#undef PG8_LDB
#undef PG8_MMA
#undef PG8_WAIT_V
#undef PG8_WAIT_L
#undef PG8_BAR
#undef PG8_SCHED
}
struct FP {
  const float *x, *c, *ctx, *c_ctx, *w_mod, *b_mod, *g_norm1, *g_norm2, *w_in, *g_cq, *g_ckv, *w_uq, *w_ukv, *g_mla, *ret_decay, *g_ret, *gdn_conv, *gdn_a_log,
      *gdn_dt_bias, *g_gdn, *w_out, *w_router, *b_router, *w_gate_up, *b_gate_up, *w_down, *b_down, *g_final;
  float* out;
  unsigned* ctl; int* cnt;
  bf16_t *Wt_in, *Wt_mla, *Wt_out, *Wt_gu, *Wt_dn;
  float *MOD, *X, *GAB, *TOPW;
  bf16_t *Hb, *H2b, *Pb, *CATb, *ACTb, *YSb;
  int *TOPE, *TOPP, *ROWTOK;
  bf16_t *A2b, *Qb, *Knb, *Vb, *KRb, *AOb;
  bf16_t *RQb, *RKb, *RKWT, *RVTB, *RVTA, *RST;
  bf16_t *GQb, *GKb, *GVb, *GUT, *GWb, *GKTT, *GVNT, *GST;
  float *GG, *GBETA, *GLA; bf16_t* SCR; float* ROPE; bf16_t* WRF;
};
constexpr int CTL_WORDS = 4096 + DEPTH * 32;

template <int MAP> __device__ __forceinline__ void tr_tile(const float* src, int lds_, int k0, int n0, int N, bf16_t* dst, int ldd, int kcol0, LAS float* tile) {
  const int t = TIDX;
#pragma unroll
  for (int i = 0; i < 2; ++i) { const int idx = t + 512 * i, k = idx >> 4, n4 = (idx & 15) * 4; f32x4 v = (f32x4){0.f, 0.f, 0.f, 0.f};
    if (n0 + n4 < N) v = *(const f32x4*)(src + (size_t)(k0 + k) * lds_ + n0 + n4);
    tile[k * 65 + n4 + 0] = v[0]; tile[k * 65 + n4 + 1] = v[1]; tile[k * 65 + n4 + 2] = v[2]; tile[k * 65 + n4 + 3] = v[3]; }
  __syncthreads();
  { const int n = t >> 3, k8 = (t & 7) * 8; float o[8];
#pragma unroll
    for (int j = 0; j < 8; ++j) o[j] = tile[(k8 + j) * 65 + n];
    u32x4 w; w.x = cvt_pk_bf16(o[0], o[1]); w.y = cvt_pk_bf16(o[2], o[3]); w.z = cvt_pk_bf16(o[4], o[5]); w.w = cvt_pk_bf16(o[6], o[7]);
    int gn = n0 + n, row;
    if (MAP == 1) { const int bj = gn >> 10, c = gn & 1023; row = (c >> 7) * 256 + bj * 128 + (c & 127); }
    else row = gn;
    *(u32x4*)(dst + (size_t)row * ldd + kcol0 + k0 + k8) = w; }
  __syncthreads();
}

__device__ void dense_weights_layer(const FP& p, int l, int b0, LAS unsigned char* lds) {
  LAS float* tile = (LAS float*)lds; int bid_ = (int)blockIdx.x; asm volatile("" : "+s"(bid_));
  const int me = bid_ - b0, nb = (int)gridDim.x - b0, t = TIDX; if (me < 0 || nb <= 0) return;
  __syncthreads();
  constexpr int L_IN = 16 * 72, L_OUT = 24 * 16, L_UQ = 4 * 12, L_UKV = 2 * 16;
  for (int id = me; id < L_IN + L_OUT + L_UQ + L_UKV; id += nb) { int r = id;
    if (r < L_IN) { const int kt = r / 72, nt = r % 72;
      tr_tile<0>(p.w_in + (size_t)l * 1024 * INW, INW, kt * 64, nt * 64, INW, p.Wt_in + (size_t)l * INWP * 1024, 1024, 0, tile); continue; }
    r -= L_IN;
    if (r < L_OUT) { const int kt = r / 16, nt = r % 16;
      tr_tile<0>(p.w_out + (size_t)l * 1536 * 1024, 1024, kt * 64, nt * 64, 1024, p.Wt_out + (size_t)l * 1024 * 1536, 1536, 0, tile); continue; }
    r -= L_OUT;
    if (r < L_UQ) { const int kt = r / 12, nt = r % 12;
      tr_tile<0>(p.w_uq + (size_t)l * 256 * 768, 768, kt * 64, nt * 64, 768, p.Wt_mla + (size_t)l * MLAN * MLAK, MLAK, 0, tile); continue; }
    r -= L_UQ;
    { const int kt = r / 16, nt = r % 16;
      tr_tile<0>(p.w_ukv + (size_t)l * 128 * 1024, 1024, kt * 64, nt * 64, 1024, p.Wt_mla + (size_t)l * MLAN * MLAK + (size_t)768 * MLAK, MLAK, 256, tile); } }
  { unsigned zz = 0u; asm volatile("" : "+v"(zz)); const u32x4 z = (u32x4){zz, zz, zz, zz};
    const int gtid = me * NTHREADS + t, gstr = nb * NTHREADS;
    for (int i = gtid; i < 768 * 16; i += gstr) { const int rr = i / 16, c8 = (i % 16) * 8; *(u32x4*)(p.Wt_mla + ((size_t)l * MLAN + rr) * MLAK + 256 + c8) = z; }
    for (int i = gtid; i < 1024 * 32; i += gstr) { const int rr = i / 32, c8 = (i % 32) * 8; *(u32x4*)(p.Wt_mla + ((size_t)l * MLAN + 768 + rr) * MLAK + c8) = z; } }
}

__device__ void ph_prologue(const FP& p, LAS unsigned char* lds) {
  const int G = gridDim.x, bid = blockIdx.x, t = TIDX;
  dense_weights_layer(p, 0, 0, lds);
  for (int i = bid * NTHREADS + t; i < DEPTH * 64 * 64; i += G * NTHREADS) { const int l = i >> 12, s = (i >> 6) & 63, ln = i & 63; u32x4 wh, wl; unsigned hh[8], ll[8];
#pragma unroll
    for (int jj = 0; jj < 8; ++jj) { const float w = p.w_router[((size_t)l * D + 16 * s + 8 * (ln >> 5) + jj) * NE + (ln & 31)]; unsigned u = __float_as_uint(w); u += 0x7fffu + ((u >> 16) & 1u); hh[jj] = u >> 16;
      const float res = w - __uint_as_float(hh[jj] << 16); unsigned v = __float_as_uint(res); v += 0x7fffu + ((v >> 16) & 1u); ll[jj] = v >> 16; }
    wh.x = hh[0] | (hh[1] << 16); wh.y = hh[2] | (hh[3] << 16); wh.z = hh[4] | (hh[5] << 16); wh.w = hh[6] | (hh[7] << 16); wl.x = ll[0] | (ll[1] << 16); wl.y = ll[2] | (ll[3] << 16); wl.z = ll[4] | (ll[5] << 16); wl.w = ll[6] | (ll[7] << 16);
    *(u32x4*)(p.WRF + ((size_t)(l * 2) * 64 * 64 + (s * 64 + ln)) * 8) = wh; *(u32x4*)(p.WRF + ((size_t)(l * 2 + 1) * 64 * 64 + (s * 64 + ln)) * 8) = wl; }
  if (bid == 0) for (int i = t; i < 64 * 16; i += NTHREADS) { const int pos = i >> 4, f = i & 15; const float ang = (float)pos * expf(-(float)f * (9.210340371976184f / 16.f)); p.ROPE[pos * 32 + f] = cosf(ang); p.ROPE[pos * 32 + 16 + f] = sinf(ang); }
  { const int gw = bid * NWAVES + (t >> 6), lane = t & 63;
    for (int row = gw; row < T; row += G * NWAVES) { const int b = row / SB, s = row % SB;
      const float* src = s < CTX ? p.ctx + ((size_t)b * CTX + s) * D : p.x + ((size_t)b * SEQ + (s - CTX)) * D;
#pragma unroll
      for (int i = 0; i < 4; ++i) *(f32x4*)(p.X + (size_t)row * D + i * 256 + lane * 4) = *(const f32x4*)(src + i * 256 + lane * 4); } }
  { LAS float* sc = (LAS float*)(lds + 32768);
    LAS float* part = (LAS float*)(lds + 32768 + 5 * 1024 * 4);
    __syncthreads();
    for (int i = t; i < 5 * 1024; i += NTHREADS) { const int r = i >> 10, k = i & 1023; const float v = r < 4 ? p.c[r * 1024 + k] : p.c_ctx[k]; sc[i] = v / (1.f + expf(-v)); }
    __syncthreads();
    for (int item = bid; item < DEPTH * 64; item += G) { const int l = item >> 6, c0 = (item & 63) * 96, col = t % 96, ks = t / 96;
      if (ks < 5) { float a[5] = {0.f, 0.f, 0.f, 0.f, 0.f}; const float* w = p.w_mod + (size_t)l * 1024 * 6144 + c0 + col; const int k0 = ks * 205, k1 = k0 + 205 < 1024 ? k0 + 205 : 1024;
#pragma unroll 8
        for (int k = k0; k < k1; ++k) { const float wv = w[(size_t)k * 6144];
#pragma unroll
          for (int r = 0; r < 5; ++r) a[r] += sc[r * 1024 + k] * wv; }
#pragma unroll
        for (int r = 0; r < 5; ++r) part[(ks * 96 + col) * 5 + r] = a[r]; }
      __syncthreads();
      if (t < 96) {
#pragma unroll
        for (int r = 0; r < 5; ++r) { float sm = 0.f;
#pragma unroll
          for (int q = 0; q < 5; ++q) sm += part[(q * 96 + t) * 5 + r];
          p.MOD[(size_t)(l * 5 + r) * 6144 + c0 + t] = sm + p.b_mod[l * 6144 + c0 + t]; } }
      __syncthreads(); } }
}

template <int step = 1, int off = 0, int B1 = 1 << 30> __device__ void moe_weights_layer(const FP& p, int l, int t0, int t1, int b0, LAS unsigned char* lds) {
  int bid_ = (int)blockIdx.x; asm volatile("" : "+s"(bid_));
  LAS float* tile = (LAS float*)lds; const int me0 = bid_ - b0; if (me0 < 0 || bid_ >= B1 || (step > 1 && (me0 & (step - 1)) != off)) return;
  const int gtop = (int)gridDim.x < B1 ? (int)gridDim.x : B1;
  int me = step > 1 ? me0 >> (step == 2 ? 1 : 2) : me0; const int nb = step > 1 ? (gtop - b0 - off + step - 1) >> (step == 2 ? 1 : 2) : gtop - b0; if (nb <= 0) return;
  const int t = TIDX;
  auto src_of = [&](int sid, int& ld) -> const float* { const int id = sid * 4;
    if (id < NE * 512) { const int m = l * NE + id / 512, tt = id % 512, kt = tt / 32, nt = tt % 32; ld = 2048; return p.w_gate_up + (size_t)m * 1024 * 2048 + (size_t)(kt * 64) * 2048 + nt * 64; }
    const int r = id - NE * 512; const int m = l * NE + r / 256, tt = r % 256, kt = tt / 16, nt = tt % 16; ld = 1024; return p.w_down + (size_t)m * 1024 * 1024 + (size_t)(kt * 64) * 1024 + nt * 64; };
  auto load_strip = [&](int sid, f32x4 (&v)[8]) { int ld; const float* src = src_of(sid, ld);
#pragma unroll
    for (int i = 0; i < 8; ++i) { const int idx = t + 512 * i, tb = idx >> 10, q = idx & 1023, k = q >> 4, n4 = (q & 15) * 4; v[i] = *(const f32x4*)((const char*)src + (unsigned)(k * ld + tb * 64 + n4) * 4u); } };
  __syncthreads();
  const int s0 = t0 / 4 + me, s1 = t1 / 4;
  auto process = [&](int sid, const f32x4 (&v)[8]) {
#pragma unroll
    for (int i = 0; i < 8; ++i) { const int idx = t + 512 * i, tb = idx >> 10, q = idx & 1023, k = q >> 4, n4 = (q & 15) * 4; LAS float* tp = tile + tb * (64 * 65) + k * 65 + n4;
      tp[0] = v[i][0]; tp[1] = v[i][1]; tp[2] = v[i][2]; tp[3] = v[i][3]; }
    __syncthreads();
    { const int id = sid * 4, n = t >> 3, k8 = (t & 7) * 8;
      const bool gu = id < NE * 512; const int r = gu ? id : id - NE * 512; const int m = l * NE + (gu ? r / 512 : r / 256), tt = gu ? r % 512 : r % 256, kt = gu ? tt / 32 : tt / 16, nt = gu ? tt % 32 : tt % 16;
      bf16_t* dst = gu ? p.Wt_gu + (size_t)m * 2048 * 1024 : p.Wt_dn + (size_t)m * 1024 * 1024;
#pragma unroll
      for (int tb = 0; tb < 4; ++tb) { float o[8];
#pragma unroll
        for (int j = 0; j < 8; ++j) o[j] = tile[tb * (64 * 65) + (k8 + j) * 65 + n];
        u32x4 w; w.x = cvt_pk_bf16(o[0], o[1]); w.y = cvt_pk_bf16(o[2], o[3]); w.z = cvt_pk_bf16(o[4], o[5]); w.w = cvt_pk_bf16(o[6], o[7]);
        const int gn = (nt + tb) * 64 + n; int row;
        if (gu) { const int bj = gn >> 10, c = gn & 1023; row = (c >> 7) * 256 + bj * 128 + (c & 127); }
        else row = gn;
        *(u32x4*)((char*)dst + (unsigned)(row * 1024 + kt * 64 + k8) * 2u) = w; } }
    __syncthreads(); };
  f32x4 va[8], vb[8];
  if (s0 < s1) load_strip(s0, va);
#pragma unroll 1
  for (int sid = s0; sid < s1; sid += 2 * nb) {
    if (sid + nb < s1) load_strip(sid + nb, vb);
    process(sid, va);
    if (sid + nb >= s1) break;
    if (sid + 2 * nb < s1) load_strip(sid + 2 * nb, va);
    process(sid + nb, vb); }
}

struct MoeTab { LAS int* blk_e; LAS int* blk_j; LAS int* start; int nblk; };
__device__ __forceinline__ MoeTab moe_tables(const int* cntl, LAS unsigned char* misc) {
  MoeTab m; m.blk_e = (LAS int*)misc; m.blk_j = m.blk_e + MAXBLK; m.start = m.blk_j + MAXBLK;
  const int t = TIDX;
  __syncthreads();
  if (t < 64) { const int e = t & 31; const int nb = (__hip_atomic_load(&cntl[e], __ATOMIC_RELAXED, __HIP_MEMORY_SCOPE_AGENT) + 255) >> 8; int incl = nb;
#pragma unroll
    for (int o = 1; o < 32; o <<= 1) { const int v = shupi(incl, o); if ((t & 31) >= o) incl += v; }
    if (t < 32) { m.start[e] = incl - nb; if (e == 31) m.start[32] = incl; } }
  __syncthreads();
  m.nblk = m.start[32];
  for (int blk = t; blk < m.nblk; blk += NTHREADS) { int e = 0;
    while (m.start[e + 1] <= blk) ++e;
    m.blk_e[blk] = e; m.blk_j[blk] = blk - m.start[e]; }
  __syncthreads();
  return m;
}

__device__ __forceinline__ LAS int* moe_unit_list(const MoeTab& m, int NPN) {
  LAS int* ul = m.start + 40; const int t = TIDX;
  if (t < 32) { int q = t * (int)gridDim.x + (int)blockIdx.x;
    if ((int)gridDim.x == 256) {
      const int c = (int)blockIdx.x, x = c & 7, rank = c >> 3;
      if (NPN == 8) q = (32 * t + 2 * (rank >> 1) + (x >> 2)) * 8 + 2 * (x & 3) + (rank & 1); else q = (64 * t + 2 * rank + (x >> 2)) * 4 + (x & 3); }
    const bool ok = q < m.nblk * NPN;
    if (ok) { ul[1 + 2 * t] = q / NPN; ul[2 + 2 * t] = q % NPN; }
    const unsigned long long bal = __ballot(ok); if (t == 0) ul[0] = __popcll(bal); }
  __syncthreads();
  return ul;
}

__device__ __forceinline__ float dpp_add(float v, int ctrl_is) { return v; }
#define DPP_F(v, ctrl) __int_as_float(__builtin_amdgcn_update_dpp(0, __float_as_int(v), (ctrl), 0xf, 0xf, false))
__device__ __forceinline__ float wave_sum(float v) {
  v += DPP_F(v, 0xB1); v += DPP_F(v, 0x4E); v += DPP_F(v, 0x141); v += DPP_F(v, 0x140);
  const float r0 = __uint_as_float(__builtin_amdgcn_readlane(__float_as_uint(v), 0)), r1 = __uint_as_float(__builtin_amdgcn_readlane(__float_as_uint(v), 16));
  const float r2 = __uint_as_float(__builtin_amdgcn_readlane(__float_as_uint(v), 32)), r3 = __uint_as_float(__builtin_amdgcn_readlane(__float_as_uint(v), 48));
  return (r0 + r1) + (r2 + r3); }

__device__ __forceinline__ void moe_combine_row(const FP& p, int lprev, int row, const LAS int* start, const float* gate, int lane, f32x4 (&x)[4]) {
  int sl[4]; float w[4];
#pragma unroll
  for (int k = 0; k < 4; ++k) { const int e = p.TOPE[row * 4 + k]; sl[k] = start[e] * 256 + p.TOPP[row * 4 + k]; w[k] = p.TOPW[row * 4 + k]; }
#pragma unroll
  for (int i = 0; i < 4; ++i) { f32x4 y = (f32x4){0.f, 0.f, 0.f, 0.f};
#pragma unroll
    for (int k = 0; k < 4; ++k) { const u32x2 v = *(const u32x2*)(p.YSb + (size_t)sl[k] * 1024 + i * 256 + lane * 4);
      y[0] += w[k] * bflo(v.x); y[1] += w[k] * bfhi(v.x); y[2] += w[k] * bflo(v.y); y[3] += w[k] * bfhi(v.y); }
    const f32x4 g = *(const f32x4*)(gate + i * 256 + lane * 4); x[i] = x[i] + g * y; }
}

template <bool DRY = false> __device__ void ph_norm1(const FP& p, int l, LAS unsigned char* lds) {
  const int t = TIDX, lane = t & 63, gw = blockIdx.x * NWAVES + (t >> 6), GWN = gridDim.x * NWAVES;
  MoeTab mt{}; if (l > 0) mt = moe_tables(p.cnt + (l - 1) * 32, lds + LDS_MISC);
  const float* MODl = p.MOD + (size_t)l * 5 * 6144; const float* MODp = p.MOD + (size_t)(l > 0 ? l - 1 : 0) * 5 * 6144; const float* g1 = p.g_norm1 + l * D;
  for (int row = gw; row < T; row += GWN) { const int b = row / SB, s = row % SB, r = s < CTX ? 4 : b;
    f32x4 x[4];
#pragma unroll
    for (int i = 0; i < 4; ++i) x[i] = *(const f32x4*)(p.X + (size_t)row * D + i * 256 + lane * 4);
    if (l > 0) { moe_combine_row(p, l - 1, row, mt.start, MODp + (size_t)r * 6144 + 5120, lane, x);
      if (!DRY) {
#pragma unroll
      for (int i = 0; i < 4; ++i) *(f32x4*)(p.X + (size_t)row * D + i * 256 + lane * 4) = x[i]; } }
    float ss = 0.f;
#pragma unroll
    for (int i = 0; i < 4; ++i) ss += x[i][0] * x[i][0] + x[i][1] * x[i][1] + x[i][2] * x[i][2] + x[i][3] * x[i][3];
    ss = wave_sum(ss); const float rs = rsqrtf(ss * (1.f / 1024.f) + 1e-6f);
    const float* m = MODl + (size_t)r * 6144;
#pragma unroll
    for (int i = 0; i < 4; ++i) { const int c = i * 256 + lane * 4; const f32x4 g = *(const f32x4*)(g1 + c), sc = *(const f32x4*)(m + 1024 + c), sh = *(const f32x4*)(m + c);
      const f32x4 h = x[i] * rs * g * (sc + 1.f) + sh; u32x2 w; w.x = cvt_pk_bf16(h[0], h[1]); w.y = cvt_pk_bf16(h[2], h[3]);
      *(u32x2*)((DRY ? p.SCR : p.Hb) + (size_t)row * D + c) = w; } }
}

template <bool DRY = false> __device__ void ph_norm2(const FP& p, int l, LAS unsigned char* lds) {
  const int t = TIDX, lane = t & 63, gw = blockIdx.x * NWAVES + (t >> 6), GWN = gridDim.x * NWAVES;
  LAS float* wT = (LAS float*)lds;
  __syncthreads();
  { const float* wr = p.w_router + (size_t)l * D * NE;
    for (int i = t; i < D * NE / 4; i += NTHREADS) { const int c = i >> 3, e4 = (i & 7) * 4; const f32x4 v = *(const f32x4*)(wr + (size_t)c * NE + e4);
      wT[(e4 + 0) * 1024 + c] = v[0]; wT[(e4 + 1) * 1024 + c] = v[1]; wT[(e4 + 2) * 1024 + c] = v[2]; wT[(e4 + 3) * 1024 + c] = v[3]; } }
  __syncthreads();
  const float* MODl = p.MOD + (size_t)l * 5 * 6144; const float* g2 = p.g_norm2 + l * D; int* cntl = p.cnt + l * 32;
  const float myb = p.b_router[l * NE + (lane >> 1)];
  for (int row = gw; row < T; row += GWN) { const int b = row / SB, s = row % SB, r = s < CTX ? 4 : b;
    if (l == DEPTH - 1 && s < CTX) continue;
    f32x4 h[4]; float ss = 0.f;
#pragma unroll
    for (int i = 0; i < 4; ++i) { h[i] = *(const f32x4*)(p.X + (size_t)row * D + i * 256 + lane * 4); ss += h[i][0] * h[i][0] + h[i][1] * h[i][1] + h[i][2] * h[i][2] + h[i][3] * h[i][3]; }
    ss = wave_sum(ss); const float rs = rsqrtf(ss * (1.f / 1024.f) + 1e-6f);
    const float* m = MODl + (size_t)r * 6144;
#pragma unroll
    for (int i = 0; i < 4; ++i) { const int c = i * 256 + lane * 4; const f32x4 g = *(const f32x4*)(g2 + c), sc = *(const f32x4*)(m + 4096 + c), sh = *(const f32x4*)(m + 3072 + c);
      h[i] = h[i] * rs * g * (sc + 1.f) + sh; u32x2 w; w.x = cvt_pk_bf16(h[i][0], h[i][1]); w.y = cvt_pk_bf16(h[i][2], h[i][3]);
      *(u32x2*)((DRY ? p.SCR : p.H2b) + (size_t)row * D + c) = w; }
#ifdef PROBE_NOROUTER
    if (DRY) continue;
#endif
    float acc[32];
#pragma unroll
    for (int e = 0; e < 32; ++e) { float a = 0.f;
#pragma unroll
      for (int i = 0; i < 4; ++i) { const f32x4 w = *(const LAS f32x4*)(wT + e * 1024 + i * 256 + lane * 4); a += h[i][0] * w[0] + h[i][1] * w[1] + h[i][2] * w[2] + h[i][3] * w[3]; }
      acc[e] = a; }
#define BFLY(NV, BIT) { const bool up = (lane >> (BIT)) & 1; _Pragma("unroll") for (int e = 0; e < (NV) / 2; ++e) { const float a = acc[e], bq = acc[e + (NV) / 2]; const float keep = up ? bq : a, send = up ? a : bq; acc[e] = keep + shx(send, 1 << (BIT)); } }
    BFLY(32, 5) BFLY(16, 4) BFLY(8, 3) BFLY(4, 2) BFLY(2, 1)
#undef BFLY
    float v = acc[0] + shx(acc[0], 1); v += myb;
    float lg[32];
#pragma unroll
    for (int e = 0; e < 32; ++e) lg[e] = __uint_as_float(__builtin_amdgcn_readlane(__float_as_uint(v), 2 * e));
    float tv[4]; int ti[4];
#pragma unroll
    for (int k = 0; k < 4; ++k) { float bv = -3.0e38f; int bi = 0;
#pragma unroll
      for (int e = 0; e < 32; ++e) { if (lg[e] > bv) { bv = lg[e]; bi = e; } }
      tv[k] = bv; ti[k] = bi;
#pragma unroll
      for (int e = 0; e < 32; ++e) if (e == bi) lg[e] = -3.0e38f; }
    if (lane == 0) { float e4[4], sum = 0.f;
#pragma unroll
      for (int k = 0; k < 4; ++k) { e4[k] = expf(tv[k] - tv[0]); sum += e4[k]; }
      const float inv = 1.f / sum;
#pragma unroll
      for (int k = 0; k < 4; ++k) { if (DRY) { ((float*)p.SCR)[(size_t)T * 512 + row * 4 + k] = e4[k] * inv + (float)ti[k]; continue; } const int pos = atomicAdd(&cntl[ti[k]], 1); p.TOPE[row * 4 + k] = ti[k]; p.TOPP[row * 4 + k] = pos; p.TOPW[row * 4 + k] = e4[k] * inv; __hip_atomic_store(&p.ROWTOK[(size_t)ti[k] * T + pos], row, __ATOMIC_RELAXED, __HIP_MEMORY_SCOPE_AGENT);     } } }
}

__device__ void ph_final(const FP& p, LAS unsigned char* lds) {
  const int t = TIDX, lane = t & 63, gw = blockIdx.x * NWAVES + (t >> 6), GWN = gridDim.x * NWAVES;
  MoeTab mt = moe_tables(p.cnt + (DEPTH - 1) * 32, lds + LDS_MISC);
  const float* MODp = p.MOD + (size_t)(DEPTH - 1) * 5 * 6144;
  for (int orow = gw; orow < NB * SEQ; orow += GWN) { const int b = orow / SEQ, tk = orow % SEQ, row = b * SB + CTX + tk;
    f32x4 x[4];
#pragma unroll
    for (int i = 0; i < 4; ++i) x[i] = *(const f32x4*)(p.X + (size_t)row * D + i * 256 + lane * 4);
    moe_combine_row(p, DEPTH - 1, row, mt.start, MODp + (size_t)b * 6144 + 5120, lane, x);
    float ss = 0.f;
#pragma unroll
    for (int i = 0; i < 4; ++i) ss += x[i][0] * x[i][0] + x[i][1] * x[i][1] + x[i][2] * x[i][2] + x[i][3] * x[i][3];
    ss = wave_sum(ss); const float rs = rsqrtf(ss * (1.f / 1024.f) + 1e-6f);
#pragma unroll
    for (int i = 0; i < 4; ++i) { const int c = i * 256 + lane * 4; const f32x4 g = *(const f32x4*)(p.g_final + c); *(f32x4*)(p.out + (size_t)orow * D + c) = x[i] * rs * g; } }
}

__device__ void ph_inproj(const FP& p, int l, LAS unsigned char* lds) {
  Gemm g; g.A = p.Hb; g.Bt = p.Wt_in + (size_t)l * INWP * 1024; g.M = T; g.N = INWP; g.K = 1024;
  StaticOrder S; S.init(T, INWP, 1024, gridDim.x, blockIdx.x); EpiInproj E; E.O = p.Pb; E.GAB = p.GAB;
  gemm_phase<EpiInproj, StaticOrder>(lds, g, S, E);
}
__device__ void outproj_ctx(const FP& p, int l, LAS unsigned char* lds) {
  const int t = TIDX, w = t >> 6, lane = t & 63, c32 = lane & 31, hi = lane >> 5;
  const bf16_t* Bt = p.Wt_out + (size_t)l * 1024 * 1536; const float* gate = p.MOD + (size_t)l * 5 * 6144 + 4 * 6144 + 2048;
  LAS float* lf = (LAS float*)lds;
  for (int u = blockIdx.x; u < 256; u += gridDim.x) { const int cu = u >> 4, st = u & 15, batch = cu >> 2, pn = cu & 3, sr = st >> 2, sc = st & 3;
    const int r0 = batch * SB + 64 * sr, c0 = pn * 256 + 64 * sc;
    const bf16_t* ap = p.CATb + (size_t)(r0 + c32) * 1536 + 192 * w + 8 * hi; const bf16_t* bp = Bt + (size_t)(c0 + c32) * 1536 + 192 * w + 8 * hi;
    f32x16 acc[2][2];
#pragma unroll
    for (int m = 0; m < 2; ++m)
#pragma unroll
      for (int n = 0; n < 2; ++n)
#pragma unroll
        for (int r = 0; r < 16; ++r) acc[m][n][r] = 0.f;
#pragma unroll
    for (int sg = 0; sg < 3; ++sg) { bf16x8 af[2][4], bfr[2][4];
#pragma unroll
      for (int s = 0; s < 4; ++s)
#pragma unroll
        for (int m = 0; m < 2; ++m) { af[m][s] = *(const bf16x8*)(ap + (size_t)m * 32 * 1536 + (sg * 4 + s) * 16); bfr[m][s] = *(const bf16x8*)(bp + (size_t)m * 32 * 1536 + (sg * 4 + s) * 16); }
#pragma unroll
      for (int s = 0; s < 4; ++s)
#pragma unroll
        for (int m = 0; m < 2; ++m)
#pragma unroll
          for (int n = 0; n < 2; ++n) acc[m][n] = __builtin_amdgcn_mfma_f32_32x32x16_bf16(af[m][s], bfr[n][s], acc[m][n], 0, 0, 0); }
    __syncthreads();
#pragma unroll
    for (int m = 0; m < 2; ++m)
#pragma unroll
      for (int n = 0; n < 2; ++n)
#pragma unroll
        for (int r = 0; r < 16; ++r) lf[w * 4096 + (32 * m + crow16(r, hi)) * 64 + 32 * n + c32] = acc[m][n][r];
    __syncthreads();
    { const int row = t >> 3, col = (t & 7) * 8; f32x4 s0 = (f32x4){0.f, 0.f, 0.f, 0.f}, s1 = s0;
#pragma unroll
      for (int ww = 0; ww < 8; ++ww) { s0 = s0 + *(const LAS f32x4*)(lf + ww * 4096 + row * 64 + col); s1 = s1 + *(const LAS f32x4*)(lf + ww * 4096 + row * 64 + col + 4); }
      const f32x4 g0 = *(const f32x4*)(gate + c0 + col), g1 = *(const f32x4*)(gate + c0 + col + 4);
      float* xp = p.X + (size_t)(r0 + row) * D + c0 + col;
      *(f32x4*)xp = *(const f32x4*)xp + g0 * s0; *(f32x4*)(xp + 4) = *(const f32x4*)(xp + 4) + g1 * s1; }
    __syncthreads(); }
}
__device__ void ph_outproj(const FP& p, int l, LAS unsigned char* lds) {
  Gemm g; g.A = p.CATb; g.Bt = p.Wt_out + (size_t)l * 1024 * 1536; g.M = T; g.N = 1024; g.K = 1536;
  EpiOutproj E; E.X = p.X; E.MODl = p.MOD + (size_t)l * 5 * 6144;
  { LatentOrder S; S.nN = 4; S.G = gridDim.x; S.c = blockIdx.x; S.K = 1536; gemm_phase<EpiOutproj, LatentOrder>(lds, g, S, E); }
  if (l != DEPTH - 1) outproj_ctx(p, l, lds);
}
__device__ void ph_gemm1(const FP& p, int l, LAS unsigned char* lds) {
  MoeTab mt = moe_tables(p.cnt + l * 32, lds + LDS_MISC);
  Gemm g; g.A = p.H2b; g.Bt = p.Wt_gu + (size_t)l * NE * 2048 * 1024; g.M = 0; g.N = 2048; g.K = 1024;
  MoeOrder<true> S; S.nblk = mt.nblk; S.NPN = 8; S.G = gridDim.x; S.c = blockIdx.x; S.K = 1024; S.blk_e = mt.blk_e; S.blk_j = mt.blk_j; S.ulist = moe_unit_list(mt, 8); S.rowtok = p.ROWTOK; S.cnt = p.cnt + l * 32; S.bstride = (long)2048 * 1024 * 2;
  EpiGateUp E; E.ACT = p.ACTb; E.bgu = p.b_gate_up + (size_t)l * NE * 2048;
  gemm_phase<EpiGateUp, MoeOrder<true>>(lds, g, S, E);
}
__device__ void ph_gemm2(const FP& p, int l, LAS unsigned char* lds) {
  MoeTab mt = moe_tables(p.cnt + l * 32, lds + LDS_MISC);
  Gemm g; g.A = p.ACTb; g.Bt = p.Wt_dn + (size_t)l * NE * 1024 * 1024; g.M = 0; g.N = 1024; g.K = 1024;
  MoeOrder<false> S; S.nblk = mt.nblk; S.NPN = 4; S.G = gridDim.x; S.c = blockIdx.x; S.K = 1024; S.blk_e = mt.blk_e; S.blk_j = mt.blk_j; S.ulist = moe_unit_list(mt, 4); S.rowtok = nullptr; S.cnt = p.cnt + l * 32; S.bstride = (long)1024 * 1024 * 2;
  EpiDown E; E.YS = p.YSb; E.bdn = p.b_down + (size_t)l * NE * 1024;
  gemm_phase<EpiDown, MoeOrder<false>>(lds, g, S, E);
}
constexpr float QSCALE = 0.07216878364870322f * 1.4426950408889634f;

__device__ __forceinline__ void prep_mla_row(const FP& p, int l, int row, int lane) {
  const int s = row % SB; const bool lat = s >= CTX; const int tok = s - CTX;
  const bf16_t* pr = p.Pb + (size_t)row * INWP;
  { const u32x2 v = *(const u32x2*)(pr + C_DQ + lane * 4); float x[4] = {bflo(v.x), bfhi(v.x), bflo(v.y), bfhi(v.y)};
    const float ss = wave_sum(x[0] * x[0] + x[1] * x[1] + x[2] * x[2] + x[3] * x[3]); const float rs = rsqrtf(ss * (1.f / 256.f) + 1e-6f);
    const f32x4 g = *(const f32x4*)(p.g_cq + l * 256 + lane * 4); u32x2 w; w.x = cvt_pk_bf16(x[0] * rs * g[0], x[1] * rs * g[1]); w.y = cvt_pk_bf16(x[2] * rs * g[2], x[3] * rs * g[3]);
    *(u32x2*)(p.A2b + (size_t)row * MLAK + lane * 4) = w; }
  { const unsigned v = *(const unsigned*)(pr + C_DKV + lane * 2); const float x0 = bflo(v), x1 = bfhi(v);
    const float ss = wave_sum(x0 * x0 + x1 * x1); const float rs = rsqrtf(ss * (1.f / 128.f) + 1e-6f);
    const float g0 = p.g_ckv[l * 128 + lane * 2], g1 = p.g_ckv[l * 128 + lane * 2 + 1];
    *(unsigned*)(p.A2b + (size_t)row * MLAK + 256 + lane * 2) = cvt_pk_bf16(x0 * rs * g0, x1 * rs * g1); }
  { const float x = bf2f(pr[C_KR + lane]); const float xp = shx(x, 16); float y = x;
    if (lat) { const int hh = lane >> 5, ii = lane & 31, fi = ii & 15; const float pos = (float)(hh == 0 ? (tok >> 6) : (tok & 63));
      const float ang = pos * __expf(-(float)fi * (9.210340371976184f / 16.f)); const float cs = __cosf(ang), sn = __sinf(ang);
      y = ii < 16 ? x * cs - xp * sn : x * cs + xp * sn; }
    unsigned u = __float_as_uint(y); u += 0x7fffu + ((u >> 16) & 1u); p.KRb[(size_t)row * 64 + lane] = (bf16_t)(u >> 16); }
}

struct EpiMla {
    static constexpr bool PERM = false;
    bf16_t *Q, *Kn, *V; const float* ROPE;
    __device__ __forceinline__ void operator()(const f32x4 (&acc)[2][2][4][2], const Unit& u, int wr, int wc, int fr, int fq) const {
        const int row0 = u.pm * BM + wr * 64 + fr; const bool ctxt = (u.pm % 17) == 0; const int tok0 = (u.pm % 17 - 1) * 256 + wr * 64 + fr;
        if (u.pn < 3) {
#pragma unroll
            for (int bj = 0; bj < 2; ++bj) { const int cg = u.pn * 256 + bj * 128 + wc * 32;
                const int g6 = (cg >> 5) % 6;
#pragma unroll
                for (int ai = 0; ai < 2; ++ai)
#pragma unroll
                    for (int m = 0; m < 4; ++m) { const int row = row0 + ai * HALF + m * 16; f32x4 v0 = acc[ai][bj][m][0], v1 = acc[ai][bj][m][1];
                        if (g6 >= 4 && !ctxt) { const int tok = tok0 + ai * HALF + m * 16; const int pos = g6 == 4 ? (tok >> 6) : (tok & 63);
                            const f32x4 cs = *(const f32x4*)(ROPE + pos * 32 + 4 * fq), sn = *(const f32x4*)(ROPE + pos * 32 + 16 + 4 * fq);
#pragma unroll
                            for (int j = 0; j < 4; ++j) { const float x1 = v0[j], x2 = v1[j]; v0[j] = x1 * cs[j] - x2 * sn[j]; v1[j] = x2 * cs[j] + x1 * sn[j]; } }
                        v0 = v0 * QSCALE; v1 = v1 * QSCALE;
                        bf16_t* qp = Q + (size_t)row * 768 + cg + 4 * fq; u32x2 w0, w1; w0.x = cvt_pk_bf16(v0[0], v0[1]); w0.y = cvt_pk_bf16(v0[2], v0[3]); w1.x = cvt_pk_bf16(v1[0], v1[1]); w1.y = cvt_pk_bf16(v1[2], v1[3]);
                        *(u32x2*)qp = w0; *(u32x2*)(qp + 16) = w1; } }
        } else { const int h = u.pn - 3;
#pragma unroll
            for (int bj = 0; bj < 2; ++bj) { bf16_t* base = (bj == 0 ? Kn : V) + h * 128 + wc * 32 + 4 * fq;
#pragma unroll
                for (int ai = 0; ai < 2; ++ai)
#pragma unroll
                    for (int m = 0; m < 4; ++m) { const int row = row0 + ai * HALF + m * 16; const f32x4 v0 = acc[ai][bj][m][0], v1 = acc[ai][bj][m][1];
                        u32x2 w0, w1; w0.x = cvt_pk_bf16(v0[0], v0[1]); w0.y = cvt_pk_bf16(v0[2], v0[3]); w1.x = cvt_pk_bf16(v1[0], v1[1]); w1.y = cvt_pk_bf16(v1[2], v1[3]);
                        *(u32x2*)(base + (size_t)row * 512) = w0; *(u32x2*)(base + (size_t)row * 512 + 16) = w1; } } }
    }
};
__device__ void ph_mla_gemm(const FP& p, int l, LAS unsigned char* lds) {
  Gemm g; g.A = p.A2b; g.Bt = p.Wt_mla + (size_t)l * MLAN * MLAK; g.M = T; g.N = MLAN; g.K = MLAK;
  StaticOrder S; S.init(T, MLAN, MLAK, gridDim.x, blockIdx.x); EpiMla E; E.Q = p.Qb; E.Kn = p.Knb; E.V = p.Vb; E.ROPE = p.ROPE;
  gemm_phase<EpiMla, StaticOrder>(lds, g, S, E);
}

namespace att {
constexpr int NW = 8, QBLK = 32, KVBLK = 64;
constexpr float THRL = 8.f * 1.4426950408889634f;
constexpr int SHM_V = KVBLK * 128 * 2, SHM_K = KVBLK * 128 * 2, SHM_R = KVBLK * 64 * 2;
constexpr int OFF_V = 0, OFF_K = 2 * SHM_V, OFF_R = OFF_K + 2 * SHM_K, OFF_WS = OFF_R + 2 * SHM_R, OFF_Q = OFF_WS + NW * 64 * 4, SHM_ATTN = OFF_Q + 256 * 128;
#define KSWZ(row, colB) ((row) * 256 + ((colB) ^ (((row) & 7) << 4)))
#define RSWZ(row, colB) ((row) * 128 + ((colB) ^ ((((row) >> 1) & 7) << 4)))
#define SBAR() __builtin_amdgcn_sched_barrier(0)
__device__ __forceinline__ int crow(int r, int hi) { return (r & 3) + 8 * (r >> 2) + 4 * hi; }
__device__ __forceinline__ void partialSM(f32x16& p0, f32x16& p1, float& m_reg, float& mn, float& alpha) {
  float pmax = p0[0];
#pragma unroll
  for (int r = 1; r < 16; ++r) pmax = fmaxf(pmax, p0[r]);
#pragma unroll
  for (int r = 0; r < 16; ++r) pmax = fmaxf(pmax, p1[r]);
  { auto rr = __builtin_amdgcn_permlane32_swap(__float_as_uint(pmax), __float_as_uint(pmax), false, false); pmax = fmaxf(__uint_as_float(rr[0]), __uint_as_float(rr[1])); }
  if (__builtin_expect(__all(pmax - m_reg <= THRL), 1)) { mn = m_reg; alpha = 1.f; }
  else { mn = fmaxf(m_reg, pmax); alpha = __builtin_amdgcn_exp2f(m_reg - mn); m_reg = mn; }
#pragma unroll
  for (int r = 0; r < 16; ++r) p0[r] = p0[r] - mn;
#pragma unroll
  for (int r = 0; r < 16; ++r) p1[r] = p1[r] - mn;
#pragma unroll
  for (int r = 0; r < 16; ++r) p0[r] = __builtin_amdgcn_exp2f(p0[r]);
}
__device__ __forceinline__ void finishSM(f32x16& p0, f32x16& p1, float alpha, float& l_reg, bf16x8& pa0, bf16x8& pa1, bf16x8& pa2, bf16x8& pa3) {
#pragma unroll
  for (int r = 0; r < 16; ++r) p1[r] = __builtin_amdgcn_exp2f(p1[r]);
  float ps = 0;
#pragma unroll
  for (int r = 0; r < 16; ++r) ps += p0[r];
#pragma unroll
  for (int r = 0; r < 16; ++r) ps += p1[r];
  { auto rr = __builtin_amdgcn_permlane32_swap(__float_as_uint(ps), __float_as_uint(ps), false, false); ps = __uint_as_float(rr[0]) + __uint_as_float(rr[1]); }
  l_reg = l_reg * alpha + ps;
#define PK4(P, BASE, OUT) do { unsigned a0 = cvt_pk_bf16(P[BASE + 0], P[BASE + 1]), a1 = cvt_pk_bf16(P[BASE + 2], P[BASE + 3]);   \
    unsigned b0 = cvt_pk_bf16(P[BASE + 4], P[BASE + 5]), b1 = cvt_pk_bf16(P[BASE + 6], P[BASE + 7]);                              \
    auto r0 = __builtin_amdgcn_permlane32_swap(a0, b0, false, false); auto r1 = __builtin_amdgcn_permlane32_swap(a1, b1, false, false); \
    u32x4 w = {r0[0], r1[0], r0[1], r1[1]}; OUT = *reinterpret_cast<bf16x8*>(&w); } while (0)
  PK4(p0, 0, pa0); PK4(p0, 8, pa1); PK4(p1, 0, pa2); PK4(p1, 8, pa3);
#undef PK4
}
__device__ __forceinline__ void qkt(f32x16& p0, f32x16& p1, const char* Ks, const char* Rs, const bf16x8* qr, const char* qrow, int qsw, int r32, int hi) {
  p0 = f32x16{}; p1 = f32x16{};
#pragma unroll
  for (int d0 = 0; d0 < 8; ++d0) { const int cb = (d0 * 16 + hi * 8) * 2;
    const bf16x8 b0 = *reinterpret_cast<const bf16x8*>(Ks + KSWZ(r32, cb));
    const bf16x8 b1 = *reinterpret_cast<const bf16x8*>(Ks + KSWZ(32 + r32, cb));
    p0 = __builtin_amdgcn_mfma_f32_32x32x16_bf16(b0, qr[d0], p0, 0, 0, 0);
    p1 = __builtin_amdgcn_mfma_f32_32x32x16_bf16(b1, qr[d0], p1, 0, 0, 0); }
#pragma unroll
  for (int d0 = 0; d0 < 4; ++d0) { const int cb = (d0 * 16 + hi * 8) * 2;
    const bf16x8 b0 = *reinterpret_cast<const bf16x8*>(Rs + RSWZ(r32, cb));
    const bf16x8 b1 = *reinterpret_cast<const bf16x8*>(Rs + RSWZ(32 + r32, cb));
    const bf16x8 qf = *reinterpret_cast<const bf16x8*>(qrow + (cb ^ qsw));
    p0 = __builtin_amdgcn_mfma_f32_32x32x16_bf16(b0, qf, p0, 0, 0, 0);
    p1 = __builtin_amdgcn_mfma_f32_32x32x16_bf16(b1, qf, p1, 0, 0, 0); }
}
__device__ __forceinline__ int v_st(int k, int c) { const int kk = (k & ~0xC) | ((k & 4) << 1) | ((k & 8) >> 1); return ((kk >> 3) * 4 + (c >> 5)) * 512 + ((kk & 7) * 32 + (c & 31)) * 2; }
__device__ __forceinline__ int v_rd_base(int lane) { return ((lane & 3) << 3) | (((lane >> 2) & 3) << 6) | (((lane >> 4) & 1) << 5) | (((lane >> 5) & 1) << 8); }
constexpr int v_rd_off(int d0, int ks, int half) { return d0 * 512 + ks * 4096 + half * 2048; }
template <int OFF> __device__ __forceinline__ s16x4 tr_read(int vb) { s16x4 r; asm volatile("ds_read_b64_tr_b16 %0, %1 offset:%2" : "=&v"(r) : "v"(vb), "i"(OFF) : "memory"); return r; }
template <int D0> __device__ __forceinline__ void pv_one(f32x16& od, int vb, bf16x8 pa0, bf16x8 pa1, bf16x8 pa2, bf16x8 pa3) {
  const s16x4 l0 = tr_read<v_rd_off(D0, 0, 0)>(vb), h0 = tr_read<v_rd_off(D0, 0, 1)>(vb), l1 = tr_read<v_rd_off(D0, 1, 0)>(vb), h1 = tr_read<v_rd_off(D0, 1, 1)>(vb);
  const s16x4 l2 = tr_read<v_rd_off(D0, 2, 0)>(vb), h2 = tr_read<v_rd_off(D0, 2, 1)>(vb), l3 = tr_read<v_rd_off(D0, 3, 0)>(vb), h3 = tr_read<v_rd_off(D0, 3, 1)>(vb);
  asm volatile("s_waitcnt lgkmcnt(0)" ::: "memory"); SBAR();
#define PK(L, H) (bf16x8){L[0], L[1], L[2], L[3], H[0], H[1], H[2], H[3]}
  od = __builtin_amdgcn_mfma_f32_32x32x16_bf16(pa0, PK(l0, h0), od, 0, 0, 0);
  od = __builtin_amdgcn_mfma_f32_32x32x16_bf16(pa1, PK(l1, h1), od, 0, 0, 0);
  od = __builtin_amdgcn_mfma_f32_32x32x16_bf16(pa2, PK(l2, h2), od, 0, 0, 0);
  od = __builtin_amdgcn_mfma_f32_32x32x16_bf16(pa3, PK(l3, h3), od, 0, 0, 0);
#undef PK
}
__device__ __forceinline__ void pv_d0(f32x16* o, int vb, bf16x8 pa0, bf16x8 pa1, bf16x8 pa2, bf16x8 pa3) {
  pv_one<0>(o[0], vb, pa0, pa1, pa2, pa3); pv_one<1>(o[1], vb, pa0, pa1, pa2, pa3); pv_one<2>(o[2], vb, pa0, pa1, pa2, pa3); pv_one<3>(o[3], vb, pa0, pa1, pa2, pa3);
}
template <bool PARTIAL = false> __device__ __forceinline__ void attn_body(const bf16_t* __restrict__ Qb, const bf16_t* __restrict__ Kh, const bf16_t* __restrict__ Rh, const bf16_t* __restrict__ Vh,
                                          bf16_t* __restrict__ Ob, int seq, char* lds, float* __restrict__ PO = nullptr, float* __restrict__ PML = nullptr) {
  const int tid = TIDX, wid = tid >> 6, lane = tid & 63, r32 = lane & 31, hi = lane >> 5;
  char* V_lds = lds + OFF_V; char* K_lds = lds + OFF_K; char* R_lds = lds + OFF_R;
  float* ws = (float*)(lds + OFF_WS) + wid * 64; float* li_l = ws; float* al_l = ws + 32;
  float m_reg = -1e30f, l_reg = 0; f32x16 o[4] = {}; bf16x8 qr[8];
  const bf16_t* Qw = Qb + (size_t)(wid * QBLK + r32) * 768 + hi * 8;
#pragma unroll
  for (int d0 = 0; d0 < 8; ++d0) qr[d0] = *reinterpret_cast<const bf16x8*>(Qw + d0 * 16);
  const int qrowi = wid * QBLK + r32; char* qrow = lds + OFF_Q + qrowi * 128; const int qsw = ((qrowi >> 1) & 7) << 4;
#pragma unroll
  for (int d0 = 0; d0 < 4; ++d0) *reinterpret_cast<bf16x8*>(qrow + (((d0 * 16 + hi * 8) * 2) ^ qsw)) = *reinterpret_cast<const bf16x8*>(Qw + (8 + d0) * 16);
  const int sr = tid >> 4, sc = (tid & 15) * 8, vst0 = v_st(sr, sc), vst1 = v_st(32 + sr, sc);
  const int rr = tid >> 3, rc = (tid & 7) * 8;
  const int vb0 = (int)(uintptr_t)V_lds + v_rd_base(lane);
  bf16x8 vs0, vs1, ks0, ks1, rs0;
  const unsigned kvo0 = (unsigned)(sr * 512 + sc) * 2u, kvo1 = kvo0 + 32u * 512u * 2u, ro0 = (unsigned)(rr * 64 + rc) * 2u;
#define SLOAD(k0) do { const char* Vt = (const char*)Vh + (size_t)(k0) * 1024; const char* Kt = (const char*)Kh + (size_t)(k0) * 1024; const char* Rt = (const char*)Rh + (size_t)(k0) * 128; \
    vs0 = *(const bf16x8*)(Vt + kvo0); vs1 = *(const bf16x8*)(Vt + kvo1); ks0 = *(const bf16x8*)(Kt + kvo0); ks1 = *(const bf16x8*)(Kt + kvo1); rs0 = *(const bf16x8*)(Rt + ro0); } while (0)
#define SWRITE(b) do { *(bf16x8*)(V_lds + (b) * SHM_V + vst0) = vs0; *(bf16x8*)(V_lds + (b) * SHM_V + vst1) = vs1; const int kc = sc * 2; \
    *(bf16x8*)(K_lds + (b) * SHM_K + KSWZ(sr, kc)) = ks0; *(bf16x8*)(K_lds + (b) * SHM_K + KSWZ(32 + sr, kc)) = ks1; \
    *(bf16x8*)(R_lds + (b) * SHM_R + RSWZ(rr, rc * 2)) = rs0; } while (0)
#define SWAIT() asm volatile("s_waitcnt vmcnt(0)" ::: "memory")
#define RESC(a) do { if (__any((a) < 1.f)) { if (hi == 0) al_l[r32] = (a); asm volatile("s_waitcnt lgkmcnt(0)" ::: "memory"); \
    _Pragma("unroll") for (int d = 0; d < 4; ++d) _Pragma("unroll") for (int r = 0; r < 16; ++r) o[d][r] *= al_l[crow(r, hi)]; } } while (0)
  f32x16 pA0, pA1, pB0, pB1; float mnA, mnB, alA, alB; bf16x8 pa0, pa1, pa2, pa3; const int NT = seq / KVBLK;
  SLOAD(0); SWAIT(); SWRITE(0); __syncthreads();
  qkt(pA0, pA1, K_lds, R_lds, qr, qrow, qsw, r32, hi); partialSM(pA0, pA1, m_reg, mnA, alA);
  SLOAD(KVBLK);
  SWAIT(); SWRITE(1); __syncthreads();
  for (int j = 1; j + 1 < NT; j += 2) {
    SBAR(); qkt(pB0, pB1, K_lds + SHM_K, R_lds + SHM_R, qr, qrow, qsw, r32, hi);
    finishSM(pA0, pA1, alA, l_reg, pa0, pa1, pa2, pa3); SBAR();
    SLOAD((j + 1) * KVBLK); SBAR();
    pv_d0(o, vb0, pa0, pa1, pa2, pa3); partialSM(pB0, pB1, m_reg, mnB, alB);
    __syncthreads(); SWAIT(); SWRITE(0);
    RESC(alB); __syncthreads();
    SBAR(); qkt(pA0, pA1, K_lds, R_lds, qr, qrow, qsw, r32, hi);
    finishSM(pB0, pB1, alB, l_reg, pa0, pa1, pa2, pa3); SBAR();
    SLOAD((j + 2) * KVBLK); SBAR();
    pv_d0(o, vb0 + SHM_V, pa0, pa1, pa2, pa3); partialSM(pA0, pA1, m_reg, mnA, alA);
    __syncthreads(); SWAIT(); SWRITE(1);
    RESC(alA); __syncthreads();
  }
  SBAR(); qkt(pB0, pB1, K_lds + SHM_K, R_lds + SHM_R, qr, qrow, qsw, r32, hi);
  finishSM(pA0, pA1, alA, l_reg, pa0, pa1, pa2, pa3); SBAR();
  pv_d0(o, vb0, pa0, pa1, pa2, pa3); partialSM(pB0, pB1, m_reg, mnB, alB);
  __syncthreads(); RESC(alB);
  finishSM(pB0, pB1, alB, l_reg, pa0, pa1, pa2, pa3); SBAR();
  pv_d0(o, vb0 + SHM_V, pa0, pa1, pa2, pa3);
  if (PARTIAL) { int tz = TIDX; const int wz = tz >> 6, lz = tz & 63;
    if ((lz >> 5) == 0) { PML[wz * QBLK + lz] = m_reg; PML[256 + wz * QBLK + lz] = l_reg; }
    float* po = PO + (size_t)(wz * QBLK + 4 * (lz >> 5)) * 128 + (lz & 31);
#pragma unroll
    for (int r = 0; r < 16; ++r)
#pragma unroll
      for (int d0 = 0; d0 < 4; ++d0) po[((r & 3) + 8 * (r >> 2)) * 128 + d0 * 32] = o[d0][r];
    __syncthreads(); return; }
  if (hi == 0) li_l[r32] = l_reg; asm volatile("s_waitcnt lgkmcnt(0)" ::: "memory");
  float rli[16];
#pragma unroll
  for (int r = 0; r < 16; ++r) rli[r] = __builtin_amdgcn_rcpf(li_l[crow(r, hi)]);
  { int tz = TIDX; const int wz = tz >> 6, lz = tz & 63; const unsigned ob = (unsigned)((wz * QBLK + 4 * (lz >> 5)) * 512 + (lz & 31)) * 2u;
#pragma unroll
    for (int r = 0; r < 16; ++r) {
#pragma unroll
      for (int d0 = 0; d0 < 4; ++d0) { unsigned u = __float_as_uint(o[d0][r] * rli[r]); u += 0x7fffu + ((u >> 16) & 1u);
        *(bf16_t*)((char*)Ob + ob + (unsigned)((((r & 3) + 8 * (r >> 2)) * 512 + d0 * 32) * 2)) = (bf16_t)(u >> 16); } } }
  __syncthreads();
#undef SLOAD
#undef SWRITE
#undef SWAIT
#undef RESC
}
}

constexpr int ATT_NSPLIT = 64, ATT_NPART = 3;
__device__ __forceinline__ float* att_po(const FP& p, int j) { return (float*)p.SCR + (size_t)j * 32768; }
__device__ __forceinline__ float* att_pml(const FP& p, int j) { return (float*)p.SCR + (size_t)ATT_NSPLIT * ATT_NPART * 32768 + (size_t)j * 512; }
__device__ void ph_attn(const FP& p, int l, char* shm) {
  const int nctx = (l == DEPTH - 1) ? 0 : NB * 4;
  const int G = gridDim.x, me = (int)blockIdx.x - 64, nb = G - 64; if (me < 0) return;
  for (int u = 64 + me; u < NB * 4 * 16; u += nb) { const int b = u >> 6, h = (u >> 4) & 3, qoff = CTX + (u & 15) * 256; const size_t r0 = (size_t)b * SB, q0 = r0 + qoff;
    att::attn_body<false>(p.Qb + q0 * 768 + h * 192, p.Knb + r0 * 512 + h * 128, p.KRb + r0 * 64, p.Vb + r0 * 512 + h * 128, p.AOb + q0 * 512 + h * 128, SB, shm); }
  for (int j = me; j < ATT_NSPLIT * ATT_NPART; j += nb) { const int u = j / ATT_NPART, part = j % ATT_NPART, h = (u >> 4) & 3, qoff = CTX + (u & 15) * 256; const size_t q0 = qoff;
    const int k0 = part == 0 ? 0 : 1536 + (part - 1) * 1408, len = part == 0 ? 1536 : 1408;
    att::attn_body<true>(p.Qb + q0 * 768 + h * 192, p.Knb + (size_t)k0 * 512 + h * 128, p.KRb + (size_t)k0 * 64, p.Vb + (size_t)k0 * 512 + h * 128, nullptr, len, shm, att_po(p, j), att_pml(p, j)); }
  for (int uu = me; uu < nctx; uu += nb) { const int b = uu >> 2, h = uu & 3; const size_t r0 = (size_t)b * SB;
    att::attn_body<false>(p.Qb + r0 * 768 + h * 192, p.Knb + r0 * 512 + h * 128, p.KRb + r0 * 64, p.Vb + r0 * 512 + h * 128, p.AOb + r0 * 512 + h * 128, CTX, shm); }
}

__device__ __forceinline__ void mla_out_row(const FP& p, int l, int row, int lane) {
  float x[8]; float ss = 0.f;
  if (row >= CTX && row < CTX + ATT_NSPLIT * 64) {
    const int tok = row - CTX, u = (lane >> 4) * 16 + (tok >> 8), qr = tok & 255; float m[ATT_NPART], lsum[ATT_NPART], M = -3.0e38f;
#pragma unroll
    for (int j = 0; j < ATT_NPART; ++j) { const float* ml = att_pml(p, u * ATT_NPART + j); m[j] = ml[qr]; lsum[j] = ml[256 + qr]; M = fmaxf(M, m[j]); }
    float L = 0.f;
#pragma unroll
    for (int e = 0; e < 8; ++e) x[e] = 0.f;
#pragma unroll
    for (int j = 0; j < ATT_NPART; ++j) { const float wj = __builtin_amdgcn_exp2f(m[j] - M); L += wj * lsum[j]; const float* po = att_po(p, u * ATT_NPART + j) + (size_t)qr * 128 + (lane & 15) * 8;
      const f32x4 a = *(const f32x4*)po, b2 = *(const f32x4*)(po + 4);
      x[0] += wj * a[0]; x[1] += wj * a[1]; x[2] += wj * a[2]; x[3] += wj * a[3]; x[4] += wj * b2[0]; x[5] += wj * b2[1]; x[6] += wj * b2[2]; x[7] += wj * b2[3]; }
    const float rl = 1.f / L;
#pragma unroll
    for (int e = 0; e < 8; ++e) x[e] = bf2f(f2bf(x[e] * rl));
  } else { const u32x4 v = *(const u32x4*)(p.AOb + (size_t)row * 512 + lane * 8);
    x[0] = bflo(v.x); x[1] = bfhi(v.x); x[2] = bflo(v.y); x[3] = bfhi(v.y); x[4] = bflo(v.z); x[5] = bfhi(v.z); x[6] = bflo(v.w); x[7] = bfhi(v.w); }
#pragma unroll
  for (int j = 0; j < 8; ++j) ss += x[j] * x[j];
  ss = wave_sum(ss); const float rs = rsqrtf(ss * (1.f / 512.f) + 1e-6f);
  const f32x4 g0 = *(const f32x4*)(p.g_mla + l * 512 + lane * 8), g1 = *(const f32x4*)(p.g_mla + l * 512 + lane * 8 + 4);
  u32x4 w; w.x = cvt_pk_bf16(x[0] * rs * g0[0], x[1] * rs * g0[1]); w.y = cvt_pk_bf16(x[2] * rs * g0[2], x[3] * rs * g0[3]);
  w.z = cvt_pk_bf16(x[4] * rs * g1[0], x[5] * rs * g1[1]); w.w = cvt_pk_bf16(x[6] * rs * g1[2], x[7] * rs * g1[3]);
  *(u32x4*)(p.CATb + (size_t)row * 1536 + lane * 8) = w;
}
constexpr int NCH = SB / 64;
__device__ __forceinline__ int item_idx(int dir, int bh, int cn) { return (dir * 16 + bh) * NCH + cn; }
__device__ __forceinline__ int scan_chunk(int dir, int n) { return dir == 0 ? n : (n < 4 ? 3 - n : 71 - n); }

__device__ __forceinline__ void prep_ret_row(const FP& p, int row, int lane) {
  const int s = row % SB; const bool lat = s >= CTX; const int tok = s - CTX;
  const bf16_t* pr = p.Pb + (size_t)row * INWP;
  const u32x4 qv = *(const u32x4*)(pr + C_RQ + lane * 8), kv = *(const u32x4*)(pr + C_RK + lane * 8);
  float q[8] = {bflo(qv.x), bfhi(qv.x), bflo(qv.y), bfhi(qv.y), bflo(qv.z), bfhi(qv.z), bflo(qv.w), bfhi(qv.w)};
  float k[8] = {bflo(kv.x), bfhi(kv.x), bflo(kv.y), bfhi(kv.y), bflo(kv.z), bfhi(kv.z), bflo(kv.w), bfhi(kv.w)};
  float qo[8], ko[8];
  const bool lowh = (lane & 4) == 0;
  const float pos = (float)(((lane >> 3) & 1) == 0 ? (tok >> 6) : (tok & 63));
#pragma unroll
  for (int e = 0; e < 8; ++e) { const float qp = shx(q[e], 4), kp = shx(k[e], 4);
    if (lat) { const int fi = (lane & 3) * 8 + e; const float ang = pos * __expf(-(float)fi * (9.210340371976184f / 32.f)); const float cs = __cosf(ang), sn = __sinf(ang);
      qo[e] = lowh ? q[e] * cs - qp * sn : q[e] * cs + qp * sn; ko[e] = lowh ? k[e] * cs - kp * sn : k[e] * cs + kp * sn; }
    else { qo[e] = q[e]; ko[e] = k[e]; } }
  const float sc = 0.08838834764831845f;
  u32x4 wq, wk; wq.x = cvt_pk_bf16(qo[0], qo[1]); wq.y = cvt_pk_bf16(qo[2], qo[3]); wq.z = cvt_pk_bf16(qo[4], qo[5]); wq.w = cvt_pk_bf16(qo[6], qo[7]);
  wk.x = cvt_pk_bf16(ko[0] * sc, ko[1] * sc); wk.y = cvt_pk_bf16(ko[2] * sc, ko[3] * sc); wk.z = cvt_pk_bf16(ko[4] * sc, ko[5] * sc); wk.w = cvt_pk_bf16(ko[6] * sc, ko[7] * sc);
  *(u32x4*)(p.RQb + (size_t)row * 512 + lane * 8) = wq; *(u32x4*)(p.RKb + (size_t)row * 512 + lane * 8) = wk;
}

__device__ __forceinline__ void r2_item(const FP& p, int l, int bh, int cn, int t, LAS unsigned char* hl) {
  const int b = bh >> 2, h = bh & 3; const size_t row0 = (size_t)b * SB + cn * 64;
  LAS bf16_t* sk = (LAS bf16_t*)hl; LAS bf16_t* sv = sk + 64 * 136;
#pragma unroll
  for (int i = 0; i < 4; ++i) { const int idx = t + 256 * i, r = idx >> 4, c8 = (idx & 15) * 8;
    *(LAS u32x4*)(sk + r * 136 + c8) = *(const u32x4*)(p.RKb + (row0 + r) * 512 + h * 128 + c8);
    *(LAS u32x4*)(sv + r * 136 + c8) = *(const u32x4*)(p.Pb + (row0 + r) * INWP + C_RV + h * 128 + c8); }
  __syncthreads();
  const float lgf = __log2f(1.f - __expf(p.ret_decay[l * 8 + h])), lgb = __log2f(1.f - __expf(p.ret_decay[l * 8 + 4 + h]));
#pragma unroll
  for (int q = 0; q < 4; ++q) { const int sidx = t + 256 * q, f = sidx >> 6, ln = sidx & 63, tt = f >> 2, s = f & 3, c = tt * 32 + (ln & 31), hh = ln >> 5;
    { float kf[8];
#pragma unroll
      for (int jj = 0; jj < 8; ++jj) kf[jj] = bf2f(sk[(16 * s + 8 * hh + jj) * 136 + c]);
      u32x4 wf, wb; unsigned tmpf[4], tmpb[4];
#pragma unroll
      for (int jp = 0; jp < 4; ++jp) { const int j0 = 16 * s + 8 * hh + 2 * jp;
        tmpf[jp] = cvt_pk_bf16(kf[2 * jp] * exp2f(lgf * (float)(63 - j0)), kf[2 * jp + 1] * exp2f(lgf * (float)(62 - j0)));
        tmpb[jp] = cvt_pk_bf16(kf[2 * jp] * exp2f(lgb * (float)j0), kf[2 * jp + 1] * exp2f(lgb * (float)(j0 + 1))); }
      wf.x = tmpf[0]; wf.y = tmpf[1]; wf.z = tmpf[2]; wf.w = tmpf[3]; wb.x = tmpb[0]; wb.y = tmpb[1]; wb.z = tmpb[2]; wb.w = tmpb[3];
      *(u32x4*)(p.RKWT + (size_t)item_idx(0, bh, cn) * 8192 + sidx * 8) = wf; *(u32x4*)(p.RKWT + (size_t)item_idx(1, bh, cn) * 8192 + sidx * 8) = wb; }
    { unsigned short vb[8], va[8];
#pragma unroll
      for (int jj = 0; jj < 8; ++jj) { vb[jj] = sv[(16 * s + 8 * hh + jj) * 136 + c]; va[jj] = sv[(16 * s + 8 * (jj >> 2) + 4 * hh + (jj & 3)) * 136 + c]; }
      u32x4 wb2, wa2; wb2.x = vb[0] | ((unsigned)vb[1] << 16); wb2.y = vb[2] | ((unsigned)vb[3] << 16); wb2.z = vb[4] | ((unsigned)vb[5] << 16); wb2.w = vb[6] | ((unsigned)vb[7] << 16);
      wa2.x = va[0] | ((unsigned)va[1] << 16); wa2.y = va[2] | ((unsigned)va[3] << 16); wa2.z = va[4] | ((unsigned)va[5] << 16); wa2.w = va[6] | ((unsigned)va[7] << 16);
      *(u32x4*)(p.RVTB + ((size_t)bh * NCH + cn) * 8192 + sidx * 8) = wb2; *(u32x4*)(p.RVTA + ((size_t)bh * NCH + cn) * 8192 + sidx * 8) = wa2; } }
  __syncthreads();
}

__device__ void ret_scan_job(const FP& p, int l, int bh, int dir, LAS unsigned char* lds) {
  const int t = TIDX, wid = __builtin_amdgcn_readfirstlane(t >> 6), lane = t & 63, hi = lane >> 5;
  const int h = bh & 3; const float lg = __log2f(1.f - __expf(p.ret_decay[l * 8 + dir * 4 + h])); const float g64 = exp2f(lg * 64.f);
  f32x16 S[4];
#pragma unroll
  for (int d = 0; d < 4; ++d)
#pragma unroll
    for (int r = 0; r < 16; ++r) S[d][r] = 0.f;
#define RS_STAGE(cn, buf) do { const char* ga = (const char*)(p.RKWT + (size_t)item_idx(dir, bh, (cn)) * 8192) + (wid - 4) * 1024 + lane * 16; const char* gb = (const char*)(p.RVTB + ((size_t)bh * NCH + (cn)) * 8192) + (wid - 4) * 1024 + lane * 16; \
    LAS unsigned char* lb = lds + (buf) * 32768 + (wid - 4) * 1024; \
    _Pragma("unroll") for (int q_ = 0; q_ < 4; ++q_) { __builtin_amdgcn_global_load_lds((const unsigned*)(ga + q_ * 4096), (LAS unsigned*)(lb + q_ * 4096), 16, 0, 0); \
      __builtin_amdgcn_global_load_lds((const unsigned*)(gb + q_ * 4096), (LAS unsigned*)(lb + 16384 + q_ * 4096), 16, 0, 0); } } while (0)
  __syncthreads();
  if (wid >= 4) { RS_STAGE(scan_chunk(dir, 0), 0); RS_STAGE(scan_chunk(dir, 1), 1); }
  for (int n = 0; n < NCH; ++n) { const int cn = scan_chunk(dir, n), buf = n % 3;
    if (wid >= 4) { if (n + 1 < NCH) asm volatile("s_waitcnt vmcnt(8)" ::: "memory"); else asm volatile("s_waitcnt vmcnt(0)" ::: "memory"); }
    __builtin_amdgcn_s_barrier(); asm volatile("" ::: "memory");
    if (wid >= 4) { if (n + 2 < NCH) RS_STAGE(scan_chunk(dir, n + 2), (n + 2) % 3); }
    if (wid < 4) {
      asm volatile("s_nop 9\n\ts_nop 9" : "+v"(S[3]), "+v"(S[2]), "+v"(S[1]), "+v"(S[0]));
      bf16_t* st = p.RST + (size_t)item_idx(dir, bh, cn) * 16384;
#pragma unroll
      for (int dt = 0; dt < 4; ++dt)
#pragma unroll
        for (int g = 0; g < 4; ++g) { u32x2 w; w.x = cvt_pk_bf16(S[dt][4 * g], S[dt][4 * g + 1]); w.y = cvt_pk_bf16(S[dt][4 * g + 2], S[dt][4 * g + 3]);
          *(u32x2*)(st + ((wid * 8 + 2 * dt + (g >> 1)) * 64 + (lane & 31) + 32 * (g & 1)) * 8 + 4 * hi) = w; }
#pragma unroll
      for (int dt = 0; dt < 4; ++dt)
#pragma unroll
        for (int r = 0; r < 16; ++r) S[dt][r] *= g64;
      const LAS unsigned char* bb = lds + buf * 32768;
      bf16x8 af[4][4], bfr[4];
#pragma unroll
      for (int s = 0; s < 4; ++s) bfr[s] = *(const LAS bf16x8*)(bb + 16384 + (wid * 4 + s) * 1024 + lane * 16);
#pragma unroll
      for (int dt = 0; dt < 4; ++dt)
#pragma unroll
        for (int s = 0; s < 4; ++s) af[dt][s] = *(const LAS bf16x8*)(bb + (dt * 4 + s) * 1024 + lane * 16);
#pragma unroll
      for (int s = 0; s < 4; ++s)
#pragma unroll
        for (int dt = 0; dt < 4; ++dt) S[dt] = __builtin_amdgcn_mfma_f32_32x32x16_bf16(af[dt][s], bfr[s], S[dt], 0, 0, 0);
    }
  }
  asm volatile("s_waitcnt vmcnt(0)" ::: "memory"); __syncthreads();
#undef RS_STAGE
}

__device__ __forceinline__ bf16x8 pack8(float a0, float a1, float a2, float a3, float a4, float a5, float a6, float a7) {
  u32x4 pk;
  asm volatile("v_cvt_pk_bf16_f32 %0, %4, %5\n\tv_cvt_pk_bf16_f32 %1, %6, %7\n\tv_cvt_pk_bf16_f32 %2, %8, %9\n\tv_cvt_pk_bf16_f32 %3, %10, %11\n\ts_nop 1"
               : "=&v"(pk[0]), "=&v"(pk[1]), "=&v"(pk[2]), "=&v"(pk[3]) : "v"(a0), "v"(a1), "v"(a2), "v"(a3), "v"(a4), "v"(a5), "v"(a6), "v"(a7));
  return __builtin_bit_cast(bf16x8, pk);
}
__device__ __forceinline__ bf16x8 pack_step(const f32x16& x, int s) { return pack8(x[8 * s], x[8 * s + 1], x[8 * s + 2], x[8 * s + 3], x[8 * s + 4], x[8 * s + 5], x[8 * s + 6], x[8 * s + 7]); }
__device__ __forceinline__ bf16x8 scale_frag(bf16x8 a, float f) {
  const u32x4 v = __builtin_bit_cast(u32x4, a);
  return pack8(bflo(v.x) * f, bfhi(v.x) * f, bflo(v.y) * f, bfhi(v.y) * f, bflo(v.z) * f, bfhi(v.z) * f, bflo(v.w) * f, bfhi(v.w) * f);
}

__device__ void ret_out_unit(const FP& p, int l, int bh, int cn, int ih, int lane) {
  const int b = bh >> 2, h = bh & 3, c32 = lane & 31, hi = lane >> 5; const size_t row0 = (size_t)b * SB + cn * 64; const int ipos = 32 * ih + c32;
  const float lgf = __log2f(1.f - __expf(p.ret_decay[l * 8 + h])), lgb = __log2f(1.f - __expf(p.ret_decay[l * 8 + 4 + h]));
  const unsigned lo16 = (unsigned)lane * 16u;
  f32x16 P0, P1;
#pragma unroll
  for (int r = 0; r < 16; ++r) { P0[r] = 0.f; P1[r] = 0.f; }
  const char* qb = (const char*)(p.RQb + (row0 + 32 * ih) * 512 + h * 128); const char* kb = (const char*)(p.RKb + row0 * 512 + h * 128);
  const unsigned rowoff = (unsigned)(c32 * 512 + 8 * hi) * 2u;
#pragma unroll 1
  for (int s = 0; s < 8; ++s) { const bf16x8 qf = *(const bf16x8*)(qb + rowoff + s * 32); const bf16x8 k0 = *(const bf16x8*)(kb + rowoff + s * 32), k1 = *(const bf16x8*)(kb + 32 * 1024 + rowoff + s * 32);
    P0 = __builtin_amdgcn_mfma_f32_32x32x16_bf16(k0, qf, P0, 0, 0, 0); P1 = __builtin_amdgcn_mfma_f32_32x32x16_bf16(k1, qf, P1, 0, 0, 0); }
  bf16x8 pb[2][2][2];
#pragma unroll
  for (int dir = 0; dir < 2; ++dir) { const float lg = dir == 0 ? lgf : lgb;
#pragma unroll
    for (int jt = 0; jt < 2; ++jt) { f32x16 pd;
#pragma unroll
      for (int r = 0; r < 16; ++r) { const int j = 32 * jt + crow16(r, hi); const int dlt = dir == 0 ? ipos - j : j - ipos; const float pv = jt == 0 ? P0[r] : P1[r]; pd[r] = dlt >= 0 ? pv * exp2f(lg * (float)dlt) : 0.f; }
      pb[dir][jt][0] = pack_step(pd, 0); pb[dir][jt][1] = pack_step(pd, 1); } }
  __builtin_amdgcn_sched_barrier(0);
  f32x16 O[4];
  const char* va = (const char*)(p.RVTA + ((size_t)bh * NCH + cn) * 8192);
#pragma unroll
  for (int et = 0; et < 4; ++et) { f32x16 a;
#pragma unroll
    for (int r = 0; r < 16; ++r) a[r] = 0.f;
    const char* vae = va + et * 4096;
#pragma unroll
    for (int jt = 0; jt < 2; ++jt)
#pragma unroll
      for (int ss = 0; ss < 2; ++ss) { const bf16x8 af = *(const bf16x8*)(vae + lo16 + (2 * jt + ss) * 1024);
        a = __builtin_amdgcn_mfma_f32_32x32x16_bf16(af, pb[0][jt][ss], a, 0, 0, 0); a = __builtin_amdgcn_mfma_f32_32x32x16_bf16(af, pb[1][jt][ss], a, 0, 0, 0); }
    O[et] = a; __builtin_amdgcn_sched_barrier(0); }
  const float facf = exp2f(lgf * (float)(ipos + 1)), facb = exp2f(lgb * (float)(64 - ipos));
  const char* stf = (const char*)(p.RST + (size_t)item_idx(0, bh, cn) * 16384); const char* stb = (const char*)(p.RST + (size_t)item_idx(1, bh, cn) * 16384);
#pragma unroll 1
  for (int s = 0; s < 8; ++s) { const bf16x8 qf = *(const bf16x8*)(qb + rowoff + s * 32); const bf16x8 qsf = scale_frag(qf, facf), qsb = scale_frag(qf, facb);
#pragma unroll
    for (int et = 0; et < 4; ++et) { const bf16x8 af = *(const bf16x8*)(stf + et * 8192 + s * 1024 + lo16), ab = *(const bf16x8*)(stb + et * 8192 + s * 1024 + lo16);
      O[et] = __builtin_amdgcn_mfma_f32_32x32x16_bf16(af, qsf, O[et], 0, 0, 0); O[et] = __builtin_amdgcn_mfma_f32_32x32x16_bf16(ab, qsb, O[et], 0, 0, 0); } }
  float sm = 0.f;
#pragma unroll
  for (int et = 0; et < 4; ++et)
#pragma unroll
    for (int r = 0; r < 16; ++r) sm += O[et][r];
  sm += shx(sm, 32); const float mu = sm * (1.f / 128.f); float vq = 0.f;
#pragma unroll
  for (int et = 0; et < 4; ++et)
#pragma unroll
    for (int r = 0; r < 16; ++r) { const float dd = O[et][r] - mu; vq += dd * dd; }
  vq += shx(vq, 32); const float rs = rsqrtf(vq * (1.f / 128.f) + 1e-5f);
  const size_t row = row0 + ipos; const bf16_t* gp = p.Pb + row * INWP + C_RG + h * 128; const float* gr = p.g_ret + l * 512 + h * 128; bf16_t* op = p.CATb + row * 1536 + 512 + h * 128;
#pragma unroll
  for (int et = 0; et < 4; ++et)
#pragma unroll
    for (int g = 0; g < 4; ++g) { const int e0 = 32 * et + 8 * g + 4 * hi; const u32x2 gz = *(const u32x2*)(gp + e0); const f32x4 gg = *(const f32x4*)(gr + e0);
      const float z[4] = {bflo(gz.x), bfhi(gz.x), bflo(gz.y), bfhi(gz.y)}; float y[4];
#pragma unroll
      for (int j = 0; j < 4; ++j) y[j] = (O[et][4 * g + j] - mu) * rs * gg[j] * silu_f(z[j]);
      u32x2 w; w.x = cvt_pk_bf16(y[0], y[1]); w.y = cvt_pk_bf16(y[2], y[3]); *(u32x2*)(op + e0) = w; }
}
#define N2SWZ(r, c) ((r) * 2048 + ((((c) & ~15) | (((c) ^ (r)) & 15)) << 4))
__device__ void ph_norm2m(const FP& p, int l, LAS unsigned char* lds) {
  const int t = TIDX, wid = t >> 6, lane = t & 63, c32 = lane & 31, hi = lane >> 5;
  const float* MODl = p.MOD + (size_t)l * 5 * 6144; const float* g2 = p.g_norm2 + l * D; int* cntl = p.cnt + l * 32;
  LAS float* lgt = (LAS float*)(lds + 131072);
  const bf16_t* wf = p.WRF + (size_t)l * 2 * 64 * 512;
  __syncthreads();
  for (int tile = blockIdx.x; tile < T / 32; tile += gridDim.x) { const int trow0 = tile * 32; const int b = trow0 / SB, s0 = trow0 % SB, rmod = s0 < CTX ? 4 : b;
    const bool routed = !(l == DEPTH - 1 && s0 < CTX);
    bf16x8 bh[8], bl[8];
#pragma unroll
    for (int q = 0; q < 8; ++q) { bh[q] = *(const bf16x8*)(wf + ((size_t)(wid * 8 + q) * 64 + lane) * 8); bl[q] = *(const bf16x8*)(wf + ((size_t)(64 + wid * 8 + q) * 64 + lane) * 8); }
    f32x4 x[4][4];
#pragma unroll
    for (int q = 0; q < 4; ++q)
#pragma unroll
      for (int i = 0; i < 4; ++i) x[q][i] = *(const f32x4*)(p.X + (size_t)(trow0 + wid * 4 + q) * D + i * 256 + lane * 4);
    const float* m = MODl + (size_t)rmod * 6144;
#pragma unroll
    for (int q = 0; q < 4; ++q) { const int r = wid * 4 + q, row = trow0 + r; float ss = 0.f;
#pragma unroll
      for (int i = 0; i < 4; ++i) ss += x[q][i][0] * x[q][i][0] + x[q][i][1] * x[q][i][1] + x[q][i][2] * x[q][i][2] + x[q][i][3] * x[q][i][3];
      ss = wave_sum(ss); const float rs = rsqrtf(ss * (1.f / 1024.f) + 1e-6f);
#pragma unroll
      for (int i = 0; i < 4; ++i) { const int c = i * 256 + lane * 4; const f32x4 g = *(const f32x4*)(g2 + c), sc = *(const f32x4*)(m + 4096 + c), sh = *(const f32x4*)(m + 3072 + c);
        const f32x4 h = x[q][i] * rs * g * (sc + 1.f) + sh;
        u32x2 whi; whi.x = cvt_pk_bf16(h[0], h[1]); whi.y = cvt_pk_bf16(h[2], h[3]);
        const f32x4 res = (f32x4){h[0] - bflo(whi.x), h[1] - bfhi(whi.x), h[2] - bflo(whi.y), h[3] - bfhi(whi.y)};
        u32x2 wlo; wlo.x = cvt_pk_bf16(res[0], res[1]); wlo.y = cvt_pk_bf16(res[2], res[3]);
        if (routed) *(u32x2*)(p.H2b + (size_t)row * D + c) = whi;
        const int ch = i * 32 + (lane >> 1); const int off = N2SWZ(r, ch) + (lane & 1) * 8;
        *(LAS u32x2*)(lds + off) = whi; *(LAS u32x2*)(lds + 65536 + off) = wlo; } }
    __syncthreads();
    f32x16 acc;
#pragma unroll
    for (int r = 0; r < 16; ++r) acc[r] = 0.f;
#pragma unroll
    for (int q = 0; q < 8; ++q) { const int ch = 2 * (wid * 8 + q) + hi; const bf16x8 ah = *(const LAS bf16x8*)(lds + N2SWZ(c32, ch)), al = *(const LAS bf16x8*)(lds + 65536 + N2SWZ(c32, ch));
      acc = __builtin_amdgcn_mfma_f32_32x32x16_bf16(ah, bh[q], acc, 0, 0, 0); acc = __builtin_amdgcn_mfma_f32_32x32x16_bf16(al, bh[q], acc, 0, 0, 0); acc = __builtin_amdgcn_mfma_f32_32x32x16_bf16(ah, bl[q], acc, 0, 0, 0); }
    __syncthreads();
    { LAS float* part = (LAS float*)lds + wid * 1024;
#pragma unroll
      for (int r = 0; r < 16; ++r) part[crow16(r, hi) * 32 + c32] = acc[r]; }
    __syncthreads();
    { const int r = t >> 4, e2 = (t & 15) * 2; float s0_ = 0.f, s1_ = 0.f;
#pragma unroll
      for (int w = 0; w < 8; ++w) { s0_ += ((LAS float*)lds)[w * 1024 + r * 32 + e2]; s1_ += ((LAS float*)lds)[w * 1024 + r * 32 + e2 + 1]; }
      lgt[r * 33 + e2] = s0_ + p.b_router[l * NE + e2]; lgt[r * 33 + e2 + 1] = s1_ + p.b_router[l * NE + e2 + 1]; }
    __syncthreads();
    if (t < 32 && routed) { const int row = trow0 + t; float lg[32];
#pragma unroll
      for (int e = 0; e < 32; ++e) lg[e] = lgt[t * 33 + e];
      float tv[4]; int ti[4];
#pragma unroll
      for (int k = 0; k < 4; ++k) { float bv = -3.0e38f; int bi = 0;
#pragma unroll
        for (int e = 0; e < 32; ++e) { if (lg[e] > bv) { bv = lg[e]; bi = e; } }
        tv[k] = bv; ti[k] = bi;
#pragma unroll
        for (int e = 0; e < 32; ++e) if (e == bi) lg[e] = -3.0e38f; }
      float e4[4], sum = 0.f;
#pragma unroll
      for (int k = 0; k < 4; ++k) { e4[k] = expf(tv[k] - tv[0]); sum += e4[k]; }
      const float inv = 1.f / sum;
      LAS int* lc = (LAS int*)(lds + 131072 + 8192); lc[t] = 0;
      int rk[4];
#pragma unroll
      for (int k = 0; k < 4; ++k) rk[k] = __hip_atomic_fetch_add(&lc[ti[k]], 1, __ATOMIC_RELAXED, __HIP_MEMORY_SCOPE_WAVEFRONT);
      const int mine = lc[t]; const int base = mine > 0 ? atomicAdd(&cntl[t], mine) : 0; lc[32 + t] = base;
#pragma unroll
      for (int k = 0; k < 4; ++k) { const int pos = lc[32 + ti[k]] + rk[k]; p.TOPE[row * 4 + k] = ti[k]; p.TOPP[row * 4 + k] = pos; p.TOPW[row * 4 + k] = e4[k] * inv;
        __hip_atomic_store(&p.ROWTOK[(size_t)ti[k] * T + pos], row, __ATOMIC_RELAXED, __HIP_MEMORY_SCOPE_AGENT); } }
    __syncthreads(); }
}
struct ConvW { f32x4 w[5][3][2]; };
__device__ __forceinline__ void load_convw(const FP& p, int l, int lane, ConvW& cw) {
  const float* c0 = p.gdn_conv + (size_t)l * 5 * 1536;
#pragma unroll
  for (int j = 0; j < 5; ++j)
#pragma unroll
    for (int blk = 0; blk < 3; ++blk) { cw.w[j][blk][0] = *(const f32x4*)(c0 + j * 1536 + blk * 512 + lane * 8); cw.w[j][blk][1] = *(const f32x4*)(c0 + j * 1536 + blk * 512 + lane * 8 + 4); }
}
__device__ __forceinline__ void prep_gdn_row(const FP& p, int l, int row, int lane, const ConvW& cw) {
  const int s = row % SB; const bool lat = s >= CTX; const int lo = lat ? CTX : 0, hi_ = lat ? SB : CTX;
  float o[3][8];
#pragma unroll
  for (int blk = 0; blk < 3; ++blk) {
#pragma unroll
    for (int e = 0; e < 8; ++e) o[blk][e] = 0.f;
#pragma unroll
    for (int j = 0; j < 5; ++j) { const int s2 = s + j - 2; if (s2 < lo || s2 >= hi_) continue;
      const u32x4 xv = *(const u32x4*)(p.Pb + (size_t)(row + j - 2) * INWP + C_GQ + blk * 512 + lane * 8);
      const f32x4 w0 = cw.w[j][blk][0], w1 = cw.w[j][blk][1];
      o[blk][0] += w0[0] * bflo(xv.x); o[blk][1] += w0[1] * bfhi(xv.x); o[blk][2] += w0[2] * bflo(xv.y); o[blk][3] += w0[3] * bfhi(xv.y);
      o[blk][4] += w1[0] * bflo(xv.z); o[blk][5] += w1[1] * bfhi(xv.z); o[blk][6] += w1[2] * bflo(xv.w); o[blk][7] += w1[3] * bfhi(xv.w); }
#pragma unroll
    for (int e = 0; e < 8; ++e) o[blk][e] = silu_f(o[blk][e]); }
#pragma unroll
  for (int blk = 0; blk < 2; ++blk) { float ss = 0.f;
#pragma unroll
    for (int e = 0; e < 8; ++e) ss += o[blk][e] * o[blk][e];
    ss += shx(ss, 1); ss += shx(ss, 2); ss += shx(ss, 4); ss += shx(ss, 8);
    const float rs = rsqrtf(ss + 1e-6f) * (blk == 0 ? 0.08838834764831845f : 1.f);
#pragma unroll
    for (int e = 0; e < 8; ++e) o[blk][e] *= rs; }
  u32x4 w;
  w.x = cvt_pk_bf16(o[0][0], o[0][1]); w.y = cvt_pk_bf16(o[0][2], o[0][3]); w.z = cvt_pk_bf16(o[0][4], o[0][5]); w.w = cvt_pk_bf16(o[0][6], o[0][7]); *(u32x4*)(p.GQb + (size_t)row * 512 + lane * 8) = w;
  w.x = cvt_pk_bf16(o[1][0], o[1][1]); w.y = cvt_pk_bf16(o[1][2], o[1][3]); w.z = cvt_pk_bf16(o[1][4], o[1][5]); w.w = cvt_pk_bf16(o[1][6], o[1][7]); *(u32x4*)(p.GKb + (size_t)row * 512 + lane * 8) = w;
  w.x = cvt_pk_bf16(o[2][0], o[2][1]); w.y = cvt_pk_bf16(o[2][2], o[2][3]); w.z = cvt_pk_bf16(o[2][4], o[2][5]); w.w = cvt_pk_bf16(o[2][6], o[2][7]); *(u32x4*)(p.GVb + (size_t)row * 512 + lane * 8) = w;
  if (lane < 8) { const float a = p.GAB[(size_t)row * 16 + lane] + p.gdn_dt_bias[l * 8 + lane]; const float xe = __expf(a);
    const float sp = a > 20.f ? a : (xe < 0.03f ? xe * (1.f - xe * (0.5f - xe * (1.f / 3.f))) : __logf(1.f + xe));
    p.GLA[(size_t)row * 8 + lane] = -__expf(p.gdn_a_log[l * 8 + lane]) * sp; p.GBETA[(size_t)row * 8 + lane] = 1.f / (1.f + __expf(-p.GAB[(size_t)row * 16 + 8 + lane])); }
}

typedef float f32x2_t __attribute__((ext_vector_type(2)));
template <int dir, int VAR = 0> __device__ __forceinline__ void g2_item(const FP& p, int bh, int cn, int t, LAS unsigned char* hl) {
  const int b = bh >> 2, h = bh & 3, w = t >> 6, lane = t & 63, c32 = lane & 31, hi = lane >> 5; const size_t row0 = (size_t)b * SB + cn * 64;
  LAS float* sA = (LAS float*)hl; LAS float* sg = sA + 64 * 64; LAS float* sb = sg + 64;
  LAS bf16_t* sK = (LAS bf16_t*)(hl + 16896); LAS bf16_t* sV = sK + 64 * 136; LAS bf16_t* sT1 = sV + 64 * 136; LAS bf16_t* sT2 = sT1 + 64 * 72;
  const int item = item_idx(dir, bh, cn);
  const int ws = (TIDX >> 8) & 1;
#pragma unroll
  for (int i = 0; i < 4; ++i) { const int idx = t + 256 * i, r = idx >> 4, c8 = (idx & 15) * 8;
    *(LAS u32x4*)(sK + r * 136 + c8) = *(const u32x4*)(p.GKb + (row0 + r) * 512 + h * 128 + c8); *(LAS u32x4*)(sV + r * 136 + c8) = *(const u32x4*)(p.GVb + (row0 + r) * 512 + h * 128 + c8); }
  if (w == 0) { float la = p.GLA[(row0 + lane) * 8 + dir * 4 + h]; const float bt = p.GBETA[(row0 + lane) * 8 + dir * 4 + h];
#pragma unroll
    for (int o = 1; o < 64; o <<= 1) { const float v = dir == 0 ? shup(la, o) : shdn(la, o); if (dir == 0 ? lane >= o : lane + o < 64) la += v; }
    sg[lane] = la; sb[lane] = bt; p.GG[(size_t)item * 64 + lane] = la; }
  __syncthreads();
  { const int it = w >> 1, jt = w & 1; f32x16 a;
#pragma unroll
    for (int r = 0; r < 16; ++r) a[r] = 0.f;
    const LAS bf16_t* ka = sK + (32 * it + c32) * 136 + 8 * hi; const LAS bf16_t* kb = sK + (32 * jt + c32) * 136 + 8 * hi;
#pragma unroll
    for (int s = 0; s < 8; ++s) a = __builtin_amdgcn_mfma_f32_32x32x16_bf16(*(const LAS bf16x8*)(ka + 16 * s), *(const LAS bf16x8*)(kb + 16 * s), a, 0, 0, 0);
    const int j = 32 * jt + c32; const float gj = sg[j];
#pragma unroll
    for (int r = 0; r < 16; ++r) { const int i = 32 * it + crow16(r, hi); const bool before = dir == 0 ? j < i : j > i;
      const float v = before ? sb[i] * a[r] * __expf(fminf(sg[i] - gj, 0.f)) : 0.f;
      if (dir == 0) sA[j * 64 + i] = v; else sA[(63 - j) * 64 + (63 - i)] = v; } }
  __syncthreads();
  if (w == ws) { f32x2_t x[32];
#pragma unroll
    for (int q = 0; q < 32; ++q) { x[q][0] = (2 * q == lane) ? 1.f : 0.f; x[q][1] = (2 * q + 1 == lane) ? 1.f : 0.f; }
#pragma unroll
    for (int jp = 0; jp < 63; ++jp) { const float xj = x[jp >> 1][jp & 1]; const f32x2_t xj2 = (f32x2_t){xj, xj};
#pragma unroll
      for (int q = (jp + 1) >> 2; q < 16; ++q) { const f32x4 r = *(const LAS f32x4*)(sA + jp * 64 + 4 * q);
        x[2 * q] = x[2 * q] - (f32x2_t){r[0], r[1]} * xj2; x[2 * q + 1] = x[2 * q + 1] - (f32x2_t){r[2], r[3]} * xj2; } }
    const int j = dir == 0 ? lane : 63 - lane; const float bj = sb[j], bje = bj * __expf(sg[j]);
#pragma unroll
    for (int ip = 0; ip < 64; ++ip) { const int i = dir == 0 ? ip : 63 - ip; const float v = x[ip >> 1][ip & 1]; sT1[i * 72 + j] = f2bf(v * bj); sT2[i * 72 + j] = f2bf(v * bje); }
  } else if (((w - ws - 1) & 3) < 2) { const int d = ((w - ws - 1) & 3) * 64 + lane; bf16_t* kt = p.GKTT + (size_t)item * 8192; const float glast = sg[dir == 0 ? 63 : 0];
#pragma unroll
    for (int grp = 0; grp < 16; ++grp) { const int s4 = grp >> 2, a = (grp >> 1) & 1, hp = grp & 1; float kv4[4];
#pragma unroll
      for (int r3 = 0; r3 < 4; ++r3) { const int i = 16 * s4 + 8 * a + 4 * hp + r3; kv4[r3] = bf2f(sK[i * 136 + d]) * __expf(glast - sg[i]); }
      u32x2 w2; w2.x = cvt_pk_bf16(kv4[0], kv4[1]); w2.y = cvt_pk_bf16(kv4[2], kv4[3]);
      *(u32x2*)(kt + (((d >> 5) * 4 + s4) * 64 + (d & 31) + 32 * hp) * 8 + 4 * a) = w2; } }
  __syncthreads();
  { f32x16 aU[2], aW[2];
#pragma unroll
    for (int it = 0; it < 2; ++it)
#pragma unroll
      for (int r = 0; r < 16; ++r) { aU[it][r] = 0.f; aW[it][r] = 0.f; }
#pragma unroll
    for (int s = 0; s < 4; ++s) { bf16x8 fv, fk;
#pragma unroll
      for (int jj = 0; jj < 8; ++jj) { fv[jj] = sV[(16 * s + 8 * hi + jj) * 136 + 32 * w + c32]; fk[jj] = sK[(16 * s + 8 * hi + jj) * 136 + 32 * w + c32]; }
#pragma unroll
      for (int it = 0; it < 2; ++it) { const bf16x8 t1 = *(const LAS bf16x8*)(sT1 + (32 * it + c32) * 72 + 16 * s + 8 * hi), t2 = *(const LAS bf16x8*)(sT2 + (32 * it + c32) * 72 + 16 * s + 8 * hi);
        aU[it] = __builtin_amdgcn_mfma_f32_32x32x16_bf16(t1, fv, aU[it], 0, 0, 0); aW[it] = __builtin_amdgcn_mfma_f32_32x32x16_bf16(fk, t2, aW[it], 0, 0, 0); } }
    asm volatile("s_nop 9\n\ts_nop 9" : "+v"(aU[0]), "+v"(aU[1]), "+v"(aW[0]), "+v"(aW[1]));
    bf16_t* ut = p.GUT + (size_t)item * 8192; bf16_t* gw = p.GWb + (size_t)item * 8192;
#pragma unroll
    for (int it2 = 0; it2 < 2; ++it2) {
#pragma unroll
      for (int g = 0; g < 4; ++g) { u32x2 w2; w2.x = cvt_pk_bf16(aU[it2][4 * g], aU[it2][4 * g + 1]); w2.y = cvt_pk_bf16(aU[it2][4 * g + 2], aU[it2][4 * g + 3]);
        *(u32x2*)(ut + (((w * 2 + it2) * 4 + g) * 64 + lane) * 4) = w2; }
#pragma unroll
      for (int sl = 0; sl < 2; ++sl) { u32x4 w4; w4.x = cvt_pk_bf16(aW[it2][8 * sl], aW[it2][8 * sl + 1]); w4.y = cvt_pk_bf16(aW[it2][8 * sl + 2], aW[it2][8 * sl + 3]);
        w4.z = cvt_pk_bf16(aW[it2][8 * sl + 4], aW[it2][8 * sl + 5]); w4.w = cvt_pk_bf16(aW[it2][8 * sl + 6], aW[it2][8 * sl + 7]);
        *(u32x4*)(gw + ((it2 * 8 + 2 * w + sl) * 64 + lane) * 8) = w4; } } }
  __syncthreads();
}

__device__ void gdn_scan_job(const FP& p, int bh, int dir, LAS unsigned char* lds) {
  const int t = TIDX, wid = __builtin_amdgcn_readfirstlane(t >> 6), lane = t & 63, hi = lane >> 5;
  f32x16 S[4];
#pragma unroll
  for (int d = 0; d < 4; ++d)
#pragma unroll
    for (int r = 0; r < 16; ++r) S[d][r] = 0.f;
#define GS_STAGE(cn, buf) do { const size_t io = (size_t)item_idx(dir, bh, (cn)) * 8192 * 2 + (size_t)(wid - 4) * 1024 + (size_t)lane * 16; const char* g0 = (const char*)p.GWb + io; const char* g1 = (const char*)p.GKTT + io; const char* g2 = (const char*)p.GUT + io; \
    LAS unsigned char* lb = lds + (buf) * 49152 + (wid - 4) * 1024; \
    _Pragma("unroll") for (int q_ = 0; q_ < 4; ++q_) { __builtin_amdgcn_global_load_lds((const unsigned*)(g0 + q_ * 4096), (LAS unsigned*)(lb + q_ * 4096), 16, 0, 0); \
      __builtin_amdgcn_global_load_lds((const unsigned*)(g1 + q_ * 4096), (LAS unsigned*)(lb + 16384 + q_ * 4096), 16, 0, 0); __builtin_amdgcn_global_load_lds((const unsigned*)(g2 + q_ * 4096), (LAS unsigned*)(lb + 32768 + q_ * 4096), 16, 0, 0); } } while (0)
  float dec0, dec1;
  { const int n0 = lane, n1 = 64 + (lane & 3); dec0 = __expf(p.GG[(size_t)item_idx(dir, bh, scan_chunk(dir, n0)) * 64 + (dir == 0 ? 63 : 0)]);
    dec1 = __expf(p.GG[(size_t)item_idx(dir, bh, scan_chunk(dir, n1)) * 64 + (dir == 0 ? 63 : 0)]); }
  __syncthreads();
  if (wid >= 4) { GS_STAGE(scan_chunk(dir, 0), 0); GS_STAGE(scan_chunk(dir, 1), 1); }
  for (int n = 0; n < NCH; ++n) { const int cn = scan_chunk(dir, n), buf = n % 3;
    if (wid >= 4) { if (n + 1 < NCH) asm volatile("s_waitcnt vmcnt(12)" ::: "memory"); else asm volatile("s_waitcnt vmcnt(0)" ::: "memory"); }
    __builtin_amdgcn_s_barrier(); asm volatile("" ::: "memory");
    if (wid >= 4) { if (n + 2 < NCH) GS_STAGE(scan_chunk(dir, n + 2), (n + 2) % 3); }
    if (wid < 4) { const int item = item_idx(dir, bh, cn);
      const float adec = __uint_as_float(__builtin_amdgcn_readlane(__float_as_uint(n < 64 ? dec0 : dec1), n & 63));
      asm volatile("s_nop 9\n\ts_nop 9" : "+v"(S[3]), "+v"(S[2]), "+v"(S[1]), "+v"(S[0]));
      bf16_t* st = p.GST + (size_t)item * 16384;
#pragma unroll
      for (int dt = 0; dt < 4; ++dt)
#pragma unroll
        for (int g = 0; g < 4; ++g) { u32x2 w; w.x = cvt_pk_bf16(S[dt][4 * g], S[dt][4 * g + 1]); w.y = cvt_pk_bf16(S[dt][4 * g + 2], S[dt][4 * g + 3]);
#ifdef PROBE_NOSTORE
          if (n == 1000)
#endif
          *(u32x2*)(st + ((wid * 8 + 2 * dt + (g >> 1)) * 64 + (lane & 31) + 32 * (g & 1)) * 8 + 4 * hi) = w; }
      const LAS unsigned char* bb = lds + buf * 49152;
      f32x16 vn[2];
#pragma unroll
      for (int it = 0; it < 2; ++it)
#pragma unroll
        for (int r = 0; r < 16; ++r) vn[it][r] = 0.f;
      bf16x8 wf[2][8];
#pragma unroll
      for (int it = 0; it < 2; ++it)
#pragma unroll
        for (int s = 0; s < 8; ++s) wf[it][s] = *(const LAS bf16x8*)(bb + (it * 8 + s) * 1024 + lane * 16);
#pragma unroll
      for (int s = 0; s < 8; ++s) { const bf16x8 sf = pack_step(S[s >> 1], s & 1);
#pragma unroll
        for (int it = 0; it < 2; ++it) vn[it] = __builtin_amdgcn_mfma_f32_32x32x16_bf16(wf[it][s], sf, vn[it], 0, 0, 0); }
      bf16x8 kf[4][4];
#pragma unroll
      for (int dt = 0; dt < 4; ++dt)
#pragma unroll
        for (int s = 0; s < 4; ++s) kf[dt][s] = *(const LAS bf16x8*)(bb + 16384 + (dt * 4 + s) * 1024 + lane * 16);
      bf16_t* vt = p.GVNT + (size_t)item * 8192;
#pragma unroll
      for (int it = 0; it < 2; ++it)
#pragma unroll
        for (int g = 0; g < 4; ++g) { const u32x2 uu = *(const LAS u32x2*)(bb + 32768 + (((wid * 2 + it) * 4 + g) * 64 + lane) * 8);
          vn[it][4 * g] = bflo(uu.x) - vn[it][4 * g]; vn[it][4 * g + 1] = bfhi(uu.x) - vn[it][4 * g + 1]; vn[it][4 * g + 2] = bflo(uu.y) - vn[it][4 * g + 2]; vn[it][4 * g + 3] = bfhi(uu.y) - vn[it][4 * g + 3];
          u32x2 w; w.x = cvt_pk_bf16(vn[it][4 * g], vn[it][4 * g + 1]); w.y = cvt_pk_bf16(vn[it][4 * g + 2], vn[it][4 * g + 3]);
#ifdef PROBE_NOSTORE
          if (n == 1000)
#endif
          *(u32x2*)(vt + ((wid * 4 + 2 * it + (g >> 1)) * 64 + lane) * 8 + 4 * (g & 1)) = w; }
#pragma unroll
      for (int dt = 0; dt < 4; ++dt)
#pragma unroll
        for (int r = 0; r < 16; ++r) S[dt][r] *= adec;
#pragma unroll
      for (int s = 0; s < 4; ++s) { const bf16x8 vf = pack_step(vn[s >> 1], s & 1);
#pragma unroll
        for (int dt = 0; dt < 4; ++dt) S[dt] = __builtin_amdgcn_mfma_f32_32x32x16_bf16(kf[dt][s], vf, S[dt], 0, 0, 0); }
    }
  }
  asm volatile("s_waitcnt vmcnt(0)" ::: "memory"); __syncthreads();
#undef GS_STAGE
}

__device__ void gdn_out_unit(const FP& p, int l, int bh, int cn, int ih, int lane) {
  const int b = bh >> 2, h = bh & 3, c32 = lane & 31, hi = lane >> 5; const size_t row0 = (size_t)b * SB + cn * 64; const int ipos = 32 * ih + c32;
  const unsigned lo16 = (unsigned)lane * 16u;
  const int itf = item_idx(0, bh, cn), itb = item_idx(1, bh, cn);
  f32x16 P0, P1;
#pragma unroll
  for (int r = 0; r < 16; ++r) { P0[r] = 0.f; P1[r] = 0.f; }
  const char* qb = (const char*)(p.GQb + (row0 + 32 * ih) * 512 + h * 128); const char* kb = (const char*)(p.GKb + row0 * 512 + h * 128);
  const unsigned rowoff = (unsigned)(c32 * 512 + 8 * hi) * 2u;
#pragma unroll 1
  for (int s = 0; s < 8; ++s) { const bf16x8 qf = *(const bf16x8*)(qb + rowoff + s * 32); const bf16x8 k0 = *(const bf16x8*)(kb + rowoff + s * 32), k1 = *(const bf16x8*)(kb + 32 * 1024 + rowoff + s * 32);
    P0 = __builtin_amdgcn_mfma_f32_32x32x16_bf16(k0, qf, P0, 0, 0, 0); P1 = __builtin_amdgcn_mfma_f32_32x32x16_bf16(k1, qf, P1, 0, 0, 0); }
  const float* ggf = p.GG + (size_t)itf * 64; const float* ggb = p.GG + (size_t)itb * 64;
  const float gfi = ggf[ipos], gbi = ggb[ipos];
  bf16x8 pb[2][2][2];
#pragma unroll
  for (int dir = 0; dir < 2; ++dir) { const float* gg = dir == 0 ? ggf : ggb; const float gi = dir == 0 ? gfi : gbi;
#pragma unroll
    for (int jt = 0; jt < 2; ++jt) { f32x16 pd;
#pragma unroll
      for (int g = 0; g < 4; ++g) { const f32x4 gj = *(const f32x4*)(gg + 32 * jt + 8 * g + 4 * hi);
#pragma unroll
        for (int r3 = 0; r3 < 4; ++r3) { const int r = 4 * g + r3; const int j = 32 * jt + 8 * g + 4 * hi + r3; const bool ok = dir == 0 ? j <= ipos : j >= ipos; const float pv = jt == 0 ? P0[r] : P1[r];
          pd[r] = ok ? pv * __expf(fminf(gi - gj[r3], 0.f)) : 0.f; } }
      pb[dir][jt][0] = pack_step(pd, 0); pb[dir][jt][1] = pack_step(pd, 1); } }
  __builtin_amdgcn_sched_barrier(0);
  f32x16 O[4];
  const char* vaf = (const char*)(p.GVNT + (size_t)itf * 8192); const char* vab = (const char*)(p.GVNT + (size_t)itb * 8192);
#pragma unroll
  for (int et = 0; et < 4; ++et) { f32x16 a;
#pragma unroll
    for (int r = 0; r < 16; ++r) a[r] = 0.f;
#pragma unroll
    for (int jt = 0; jt < 2; ++jt)
#pragma unroll
      for (int ss = 0; ss < 2; ++ss) { const bf16x8 af = *(const bf16x8*)(vaf + et * 4096 + lo16 + (2 * jt + ss) * 1024), ab = *(const bf16x8*)(vab + et * 4096 + lo16 + (2 * jt + ss) * 1024);
        a = __builtin_amdgcn_mfma_f32_32x32x16_bf16(af, pb[0][jt][ss], a, 0, 0, 0); a = __builtin_amdgcn_mfma_f32_32x32x16_bf16(ab, pb[1][jt][ss], a, 0, 0, 0); }
    O[et] = a; __builtin_amdgcn_sched_barrier(0); }
  const float facf = __expf(gfi), facb = __expf(gbi);
  const char* stf = (const char*)(p.GST + (size_t)itf * 16384); const char* stb = (const char*)(p.GST + (size_t)itb * 16384);
#pragma unroll 1
  for (int s = 0; s < 8; ++s) { const bf16x8 qf = *(const bf16x8*)(qb + rowoff + s * 32); const bf16x8 qsf = scale_frag(qf, facf), qsb = scale_frag(qf, facb);
#pragma unroll
    for (int et = 0; et < 4; ++et) { const bf16x8 af = *(const bf16x8*)(stf + et * 8192 + s * 1024 + lo16), ab = *(const bf16x8*)(stb + et * 8192 + s * 1024 + lo16);
      O[et] = __builtin_amdgcn_mfma_f32_32x32x16_bf16(af, qsf, O[et], 0, 0, 0); O[et] = __builtin_amdgcn_mfma_f32_32x32x16_bf16(ab, qsb, O[et], 0, 0, 0); } }
  float ss2 = 0.f;
#pragma unroll
  for (int et = 0; et < 4; ++et)
#pragma unroll
    for (int r = 0; r < 16; ++r) ss2 += O[et][r] * O[et][r];
  ss2 += shx(ss2, 32); const float rs = rsqrtf(ss2 * (1.f / 128.f) + 1e-6f);
  const size_t row = row0 + ipos; const bf16_t* zp = p.Pb + row * INWP + C_GZ + h * 128; const float* gr = p.g_gdn + l * 128; bf16_t* op = p.CATb + row * 1536 + 1024 + h * 128;
#pragma unroll
  for (int et = 0; et < 4; ++et)
#pragma unroll
    for (int g = 0; g < 4; ++g) { const int e0 = 32 * et + 8 * g + 4 * hi; const u32x2 gz = *(const u32x2*)(zp + e0); const f32x4 gg = *(const f32x4*)(gr + e0);
      const float z[4] = {bflo(gz.x), bfhi(gz.x), bflo(gz.y), bfhi(gz.y)}; float y[4];
#pragma unroll
      for (int j = 0; j < 4; ++j) y[j] = O[et][4 * g + j] * rs * gg[j] * silu_f(z[j]);
      u32x2 w; w.x = cvt_pk_bf16(y[0], y[1]); w.y = cvt_pk_bf16(y[2], y[3]); *(u32x2*)(op + e0) = w; }
}
template <bool GDN> __device__ __forceinline__ void post_unit(const FP& p, int l, int bh, int cn, LAS float* stats) {
  const int t = TIDX, wid = t >> 6, lane = t & 63, ih = wid >> 2, et = wid & 3, c32 = lane & 31, hi = lane >> 5;
  const int b = bh >> 2, h = bh & 3; const size_t row0 = (size_t)b * SB + cn * 64; const int ipos = 32 * ih + c32;
  const int itf = item_idx(0, bh, cn), itb = item_idx(1, bh, cn);
  const unsigned lo16 = (unsigned)lane * 16u;
  const bf16_t* Qp = GDN ? p.GQb : p.RQb; const bf16_t* Kp = GDN ? p.GKb : p.RKb; const bf16_t* STp = GDN ? p.GST : p.RST;
  bf16x8 qf[8], kf0[8], kf1[8], sf[8], sb[8];
  { const char* qb = (const char*)(Qp + (row0 + ipos) * 512 + h * 128 + 8 * hi); const char* kb = (const char*)(Kp + (row0 + c32) * 512 + h * 128 + 8 * hi);
#pragma unroll
    for (int s = 0; s < 8; ++s) qf[s] = *(const bf16x8*)(qb + s * 32);
#pragma unroll
    for (int s = 0; s < 8; ++s) kf0[s] = *(const bf16x8*)(kb + s * 32);
#pragma unroll
    for (int s = 0; s < 8; ++s) kf1[s] = *(const bf16x8*)(kb + 32 * 1024 + s * 32);
    const char* stf = (const char*)(STp + (size_t)itf * 16384) + et * 8192 + lo16; const char* stb = (const char*)(STp + (size_t)itb * 16384) + et * 8192 + lo16;
#pragma unroll
    for (int s = 0; s < 8; ++s) sf[s] = *(const bf16x8*)(stf + s * 1024);
    (void)stb; }
  const float* ggf = p.GG + (size_t)itf * 64; const float* ggb = p.GG + (size_t)itb * 64;
  float gfi = 0.f, gbi = 0.f, lgf = 0.f, lgb = 0.f;
  if (GDN) { gfi = ggf[ipos]; gbi = ggb[ipos]; }
  else { lgf = __log2f(1.f - __expf(p.ret_decay[l * 8 + h])); lgb = __log2f(1.f - __expf(p.ret_decay[l * 8 + 4 + h])); }
  f32x16 P0, P1;
#pragma unroll
  for (int r = 0; r < 16; ++r) { P0[r] = 0.f; P1[r] = 0.f; }
#pragma unroll
  for (int s = 0; s < 8; ++s) { P0 = __builtin_amdgcn_mfma_f32_32x32x16_bf16(kf0[s], qf[s], P0, 0, 0, 0); P1 = __builtin_amdgcn_mfma_f32_32x32x16_bf16(kf1[s], qf[s], P1, 0, 0, 0); }
  { const char* stb = (const char*)(STp + (size_t)itb * 16384) + et * 8192 + lo16;
#pragma unroll
    for (int s = 0; s < 8; ++s) sb[s] = *(const bf16x8*)(stb + s * 1024); }
  bf16x8 vf[4], vb[4];
  { const char* vaf = (const char*)(GDN ? p.GVNT + (size_t)itf * 8192 : p.RVTA + ((size_t)bh * NCH + cn) * 8192) + et * 4096 + lo16;
#pragma unroll
    for (int s = 0; s < 4; ++s) vf[s] = *(const bf16x8*)(vaf + s * 1024);
    if (GDN) { const char* vab = (const char*)(p.GVNT + (size_t)itb * 8192) + et * 4096 + lo16;
#pragma unroll
      for (int s = 0; s < 4; ++s) vb[s] = *(const bf16x8*)(vab + s * 1024); }
    else {
#pragma unroll
      for (int s = 0; s < 4; ++s) vb[s] = vf[s]; } }
  f32x16 O;
#pragma unroll
  for (int r = 0; r < 16; ++r) O[r] = 0.f;
#pragma unroll
  for (int dir = 0; dir < 2; ++dir)
#pragma unroll
    for (int jt = 0; jt < 2; ++jt) { f32x16 pd;
#pragma unroll
      for (int g = 0; g < 4; ++g) { f32x4 gj4 = (f32x4){0.f, 0.f, 0.f, 0.f}; if (GDN) gj4 = *(const f32x4*)((dir == 0 ? ggf : ggb) + 32 * jt + 8 * g + 4 * hi);
#pragma unroll
        for (int r3 = 0; r3 < 4; ++r3) { const int r = 4 * g + r3; const int j = 32 * jt + 8 * g + 4 * hi + r3; const float pv = jt == 0 ? P0[r] : P1[r]; float w;
          if (GDN) { const bool ok = dir == 0 ? j <= ipos : j >= ipos; const float gi = dir == 0 ? gfi : gbi; const float gj = gj4[r3]; w = ok ? __expf(fminf(gi - gj, 0.f)) : 0.f; }
          else { const int dlt = dir == 0 ? ipos - j : j - ipos; w = dlt >= 0 ? exp2f((dir == 0 ? lgf : lgb) * (float)dlt) : 0.f; }
          pd[r] = pv * w; } }
#pragma unroll
      for (int ss = 0; ss < 2; ++ss) { const bf16x8 pbf = pack_step(pd, ss); O = __builtin_amdgcn_mfma_f32_32x32x16_bf16(dir == 0 ? vf[2 * jt + ss] : vb[2 * jt + ss], pbf, O, 0, 0, 0); } }
  { const float facf = GDN ? __expf(gfi) : exp2f(lgf * (float)(ipos + 1)), facb = GDN ? __expf(gbi) : exp2f(lgb * (float)(64 - ipos));
#pragma unroll
    for (int s = 0; s < 8; ++s) { const bf16x8 qsf = scale_frag(qf[s], facf), qsb = scale_frag(qf[s], facb);
      O = __builtin_amdgcn_mfma_f32_32x32x16_bf16(sf[s], qsf, O, 0, 0, 0); O = __builtin_amdgcn_mfma_f32_32x32x16_bf16(sb[s], qsb, O, 0, 0, 0); } }
  float s1 = 0.f, s2 = 0.f;
#pragma unroll
  for (int r = 0; r < 16; ++r) { s1 += O[r]; s2 += O[r] * O[r]; }
  s1 += shx(s1, 32); s2 += shx(s2, 32);
  if (hi == 0) { stats[((ih * 4 + et) * 32 + c32) * 2] = s1; stats[((ih * 4 + et) * 32 + c32) * 2 + 1] = s2; }
  __syncthreads();
  float t1 = 0.f, t2 = 0.f;
#pragma unroll
  for (int e2 = 0; e2 < 4; ++e2) { t1 += stats[((ih * 4 + e2) * 32 + c32) * 2]; t2 += stats[((ih * 4 + e2) * 32 + c32) * 2 + 1]; }
  float mu, rs;
  if (GDN) { mu = 0.f; rs = rsqrtf(t2 * (1.f / 128.f) + 1e-6f); }
  else { mu = t1 * (1.f / 128.f); rs = rsqrtf(fmaxf(t2 * (1.f / 128.f) - mu * mu, 0.f) + 1e-5f); }
  const size_t row = row0 + ipos; const bf16_t* gp = p.Pb + row * INWP + (GDN ? C_GZ : C_RG) + h * 128; const float* gr = GDN ? p.g_gdn + l * 128 : p.g_ret + l * 512 + h * 128;
  bf16_t* op = p.CATb + row * 1536 + (GDN ? 1024 : 512) + h * 128;
#pragma unroll
  for (int g = 0; g < 4; ++g) { const int e0 = 32 * et + 8 * g + 4 * hi; const u32x2 gz = *(const u32x2*)(gp + e0); const f32x4 gg = *(const f32x4*)(gr + e0);
    const float z[4] = {bflo(gz.x), bfhi(gz.x), bflo(gz.y), bfhi(gz.y)}; float y[4];
#pragma unroll
    for (int j = 0; j < 4; ++j) y[j] = (O[4 * g + j] - mu) * rs * gg[j] * silu_f(z[j]);
    u32x2 w; w.x = cvt_pk_bf16(y[0], y[1]); w.y = cvt_pk_bf16(y[2], y[3]); *(u32x2*)(op + e0) = w; }
}
__device__ __forceinline__ void ph_post2(const FP& p, int l, LAS unsigned char* lds) {
  const int t = TIDX, lane = t & 63, gw = blockIdx.x * NWAVES + (t >> 6), GWN = gridDim.x * NWAVES;
  for (int row = gw; row < T; row += GWN) mla_out_row(p, l, row, lane);
  int par = 0;
  const int nch = (l == DEPTH - 1) ? NCH - 4 : NCH, c0 = NCH - nch;
  for (int u = blockIdx.x; u < 2 * 16 * nch; u += gridDim.x, par ^= 1) { const int m = u & 1, uu = u >> 1;
    if (m) post_unit<true>(p, l, uu / nch, c0 + uu % nch, (LAS float*)lds + par * 512); else post_unit<false>(p, l, uu / nch, c0 + uu % nch, (LAS float*)lds + par * 512); }
}
namespace p3 { constexpr int OK_ = 0, OQ = 16384, OSF = 32768, OSB = 65536, OVF = 98304, OVB = 114688, OST = 131072; }
template <bool GDN> __device__ __forceinline__ void post3_stage(const FP& p, int bh, int cn, LAS unsigned char* lds) {
  const int t = TIDX, wid = __builtin_amdgcn_readfirstlane(t >> 6), lane = t & 63;
  const int b = bh >> 2, h = bh & 3; const size_t row0 = (size_t)b * SB + cn * 64;
  const int itf = item_idx(0, bh, cn), itb = item_idx(1, bh, cn);
  const bf16_t* Kp = (GDN ? p.GKb : p.RKb) + row0 * 512 + h * 128; const bf16_t* Qp = (GDN ? p.GQb : p.RQb) + row0 * 512 + h * 128;
#pragma unroll
  for (int q = 0; q < 2; ++q) { const int pc = wid + 8 * q, row = 4 * pc + (lane >> 4), ch = (lane & 15) ^ (row & 7);
    __builtin_amdgcn_global_load_lds((const unsigned*)(Kp + (size_t)row * 512 + ch * 8), (LAS unsigned*)(lds + p3::OK_ + pc * 1024), 16, 0, 0);
    __builtin_amdgcn_global_load_lds((const unsigned*)(Qp + (size_t)row * 512 + ch * 8), (LAS unsigned*)(lds + p3::OQ + pc * 1024), 16, 0, 0); }
  const char* sf = (const char*)((GDN ? p.GST : p.RST) + (size_t)itf * 16384) + lane * 16; const char* sb = (const char*)((GDN ? p.GST : p.RST) + (size_t)itb * 16384) + lane * 16;
#pragma unroll
  for (int q = 0; q < 4; ++q) { const int pc = wid + 8 * q;
    __builtin_amdgcn_global_load_lds((const unsigned*)(sf + pc * 1024), (LAS unsigned*)(lds + p3::OSF + pc * 1024), 16, 0, 0);
    __builtin_amdgcn_global_load_lds((const unsigned*)(sb + pc * 1024), (LAS unsigned*)(lds + p3::OSB + pc * 1024), 16, 0, 0); }
  const char* vf = (const char*)(GDN ? p.GVNT + (size_t)itf * 8192 : p.RVTA + ((size_t)bh * NCH + cn) * 8192) + lane * 16;
#pragma unroll
  for (int q = 0; q < 2; ++q) { const int pc = wid + 8 * q; __builtin_amdgcn_global_load_lds((const unsigned*)(vf + pc * 1024), (LAS unsigned*)(lds + p3::OVF + pc * 1024), 16, 0, 0); }
  if (GDN) { const char* vb = (const char*)(p.GVNT + (size_t)itb * 8192) + lane * 16;
#pragma unroll
    for (int q = 0; q < 2; ++q) { const int pc = wid + 8 * q; __builtin_amdgcn_global_load_lds((const unsigned*)(vb + pc * 1024), (LAS unsigned*)(lds + p3::OVB + pc * 1024), 16, 0, 0); } }
}
#define P3SWZ(row, ch) ((row) * 256 + (((ch) ^ ((row) & 7)) << 4))
template <bool GDN, bool NGDN> __device__ __forceinline__ void post3_unit(const FP& p, int l, int bh, int cn, LAS unsigned char* lds, int par, bool hasnext, int nbh, int ncn) {
  const int t = TIDX, wid = t >> 6, lane = t & 63, ih = wid >> 2, et = wid & 3, c32 = lane & 31, hi = lane >> 5;
  const int b = bh >> 2, h = bh & 3; const size_t row0 = (size_t)b * SB + cn * 64; const int ipos = 32 * ih + c32;
  const int itf = item_idx(0, bh, cn), itb = item_idx(1, bh, cn);
  LAS float* stats = (LAS float*)(lds + p3::OST) + par * 512;
  const float* ggf = p.GG + (size_t)itf * 64; const float* ggb = p.GG + (size_t)itb * 64;
  float gfi = 0.f, gbi = 0.f, lgf = 0.f, lgb = 0.f;
  if (GDN) { gfi = ggf[ipos]; gbi = ggb[ipos]; }
  else { lgf = __log2f(1.f - __expf(p.ret_decay[l * 8 + h])); lgb = __log2f(1.f - __expf(p.ret_decay[l * 8 + 4 + h])); }
  const size_t row = row0 + ipos; const bf16_t* gp = p.Pb + row * INWP + (GDN ? C_GZ : C_RG) + h * 128; const float* gr = GDN ? p.g_gdn + l * 128 : p.g_ret + l * 512 + h * 128;
  u32x2 gz[4]; f32x4 gg[4];
#pragma unroll
  for (int g = 0; g < 4; ++g) { const int e0 = 32 * et + 8 * g + 4 * hi; gz[g] = *(const u32x2*)(gp + e0); gg[g] = *(const f32x4*)(gr + e0); }
  bf16x8 qf[8];
  { const int qr = 32 * ih + c32;
#pragma unroll
    for (int s = 0; s < 8; ++s) qf[s] = *(const LAS bf16x8*)(lds + p3::OQ + P3SWZ(qr, 2 * s + hi)); }
  f32x16 P0, P1;
#pragma unroll
  for (int r = 0; r < 16; ++r) { P0[r] = 0.f; P1[r] = 0.f; }
#pragma unroll
  for (int s = 0; s < 8; ++s) { const bf16x8 k0 = *(const LAS bf16x8*)(lds + p3::OK_ + P3SWZ(c32, 2 * s + hi)), k1 = *(const LAS bf16x8*)(lds + p3::OK_ + P3SWZ(32 + c32, 2 * s + hi));
    P0 = __builtin_amdgcn_mfma_f32_32x32x16_bf16(k0, qf[s], P0, 0, 0, 0); P1 = __builtin_amdgcn_mfma_f32_32x32x16_bf16(k1, qf[s], P1, 0, 0, 0); }
  f32x16 O;
#pragma unroll
  for (int r = 0; r < 16; ++r) O[r] = 0.f;
#pragma unroll
  for (int dir = 0; dir < 2; ++dir)
#pragma unroll
    for (int jt = 0; jt < 2; ++jt) { f32x16 pd;
#pragma unroll
      for (int g = 0; g < 4; ++g) { f32x4 gj4 = (f32x4){0.f, 0.f, 0.f, 0.f}; if (GDN) gj4 = *(const f32x4*)((dir == 0 ? ggf : ggb) + 32 * jt + 8 * g + 4 * hi);
#pragma unroll
        for (int r3 = 0; r3 < 4; ++r3) { const int r = 4 * g + r3; const int j = 32 * jt + 8 * g + 4 * hi + r3; const float pv = jt == 0 ? P0[r] : P1[r]; float w;
          if (GDN) { const bool ok = dir == 0 ? j <= ipos : j >= ipos; const float gi = dir == 0 ? gfi : gbi; w = ok ? __expf(fminf(gi - gj4[r3], 0.f)) : 0.f; }
          else { const int dlt = dir == 0 ? ipos - j : j - ipos; w = dlt >= 0 ? exp2f((dir == 0 ? lgf : lgb) * (float)dlt) : 0.f; }
          pd[r] = pv * w; } }
#pragma unroll
      for (int ss = 0; ss < 2; ++ss) { const bf16x8 pbf = pack_step(pd, ss);
        const bf16x8 vfr = *(const LAS bf16x8*)(lds + ((GDN && dir == 1) ? p3::OVB : p3::OVF) + (et * 4 + 2 * jt + ss) * 1024 + lane * 16);
        O = __builtin_amdgcn_mfma_f32_32x32x16_bf16(vfr, pbf, O, 0, 0, 0); } }
  { const float facf = GDN ? __expf(gfi) : exp2f(lgf * (float)(ipos + 1)), facb = GDN ? __expf(gbi) : exp2f(lgb * (float)(64 - ipos));
#pragma unroll
    for (int s = 0; s < 8; ++s) { const bf16x8 qsf = scale_frag(qf[s], facf), qsb = scale_frag(qf[s], facb);
      const bf16x8 sfr = *(const LAS bf16x8*)(lds + p3::OSF + (et * 8 + s) * 1024 + lane * 16), sbr = *(const LAS bf16x8*)(lds + p3::OSB + (et * 8 + s) * 1024 + lane * 16);
      O = __builtin_amdgcn_mfma_f32_32x32x16_bf16(sfr, qsf, O, 0, 0, 0); O = __builtin_amdgcn_mfma_f32_32x32x16_bf16(sbr, qsb, O, 0, 0, 0); } }
  float fz[16];
#pragma unroll
  for (int g = 0; g < 4; ++g) { fz[4 * g] = gg[g][0] * silu_f(bflo(gz[g].x)); fz[4 * g + 1] = gg[g][1] * silu_f(bfhi(gz[g].x)); fz[4 * g + 2] = gg[g][2] * silu_f(bflo(gz[g].y)); fz[4 * g + 3] = gg[g][3] * silu_f(bfhi(gz[g].y)); }
  float s1 = 0.f, s2 = 0.f;
#pragma unroll
  for (int r = 0; r < 16; ++r) { s1 += O[r]; s2 += O[r] * O[r]; }
  s1 += shx(s1, 32); s2 += shx(s2, 32);
  if (hi == 0) { stats[((ih * 4 + et) * 32 + c32) * 2] = s1; stats[((ih * 4 + et) * 32 + c32) * 2 + 1] = s2; }
  __syncthreads();
  if (hasnext) post3_stage<NGDN>(p, nbh, ncn, lds);
  float t1 = 0.f, t2 = 0.f;
#pragma unroll
  for (int e2 = 0; e2 < 4; ++e2) { t1 += stats[((ih * 4 + e2) * 32 + c32) * 2]; t2 += stats[((ih * 4 + e2) * 32 + c32) * 2 + 1]; }
  float mu, rs;
  if (GDN) { mu = 0.f; rs = rsqrtf(t2 * (1.f / 128.f) + 1e-6f); }
  else { mu = t1 * (1.f / 128.f); rs = rsqrtf(fmaxf(t2 * (1.f / 128.f) - mu * mu, 0.f) + 1e-5f); }
  bf16_t* op = p.CATb + row * 1536 + (GDN ? 1024 : 512) + h * 128;
#pragma unroll
  for (int g = 0; g < 4; ++g) { const int e0 = 32 * et + 8 * g + 4 * hi; float y[4];
#pragma unroll
    for (int j = 0; j < 4; ++j) y[j] = (O[4 * g + j] - mu) * rs * fz[4 * g + j];
    u32x2 w; w.x = cvt_pk_bf16(y[0], y[1]); w.y = cvt_pk_bf16(y[2], y[3]); *(u32x2*)(op + e0) = w; }
}
__device__ __forceinline__ void ph_post3(const FP& p, int l, LAS unsigned char* lds) {
  const int t = TIDX, lane = t & 63, gw = blockIdx.x * NWAVES + (t >> 6), GWN = gridDim.x * NWAVES;
  for (int row = gw; row < T; row += GWN) mla_out_row(p, l, row, lane);
  const int nch = (l == DEPTH - 1) ? NCH - 4 : NCH, c0 = NCH - nch, NU = 16 * nch, G = gridDim.x;
  int u = blockIdx.x; if (u >= 2 * NU) return;
  __syncthreads();
  if (u < NU) post3_stage<false>(p, u / nch, c0 + u % nch, lds); else post3_stage<true>(p, (u - NU) / nch, c0 + (u - NU) % nch, lds);
  for (int par = 0; u < 2 * NU; u += G, par ^= 1) { const int un = u + G; const bool hasnext = un < 2 * NU; const bool gd = u >= NU, ngd = un >= NU;
    const int uu = gd ? u - NU : u, vv = ngd ? un - NU : un; const int bh = uu / nch, cn = c0 + uu % nch, nbh = vv / nch, ncn = c0 + vv % nch;
    asm volatile("s_waitcnt vmcnt(0)" ::: "memory"); __syncthreads();
    if (!gd) { if (ngd) post3_unit<false, true>(p, l, bh, cn, lds, par, hasnext, nbh, ncn); else post3_unit<false, false>(p, l, bh, cn, lds, par, hasnext, nbh, ncn); }
    else post3_unit<true, true>(p, l, bh, cn, lds, par, hasnext, nbh, ncn); }
}
#define XB_TMO      128
#define XB_XCNT(j)  (256  + 64 * (j))
#define XB_XSUB(j)  (1280 + 64 * (j))
#define XB_XGEN(j)  (2304 + 64 * (j))
#define XB_TOP      3328
#define XB_TOPGEN   3392
#define XCD_BAR_WORDS 3456
#define XB_SPIN_CAP (1u << 18)

__device__ __forceinline__ unsigned xb_ld(unsigned* p)              { return __hip_atomic_load(p, __ATOMIC_RELAXED, __HIP_MEMORY_SCOPE_AGENT); }
__device__ __forceinline__ unsigned xb_add(unsigned* p, unsigned v) { return __hip_atomic_fetch_add(p, v, __ATOMIC_RELAXED, __HIP_MEMORY_SCOPE_AGENT); }
__device__ __forceinline__ unsigned xb_xcc_id() { return (unsigned)__builtin_amdgcn_s_getreg((3 << 11) | 20) & 0xFu; }
#define XB_SPIN(cond, bar) do { unsigned _sp = 0; while (cond) { __builtin_amdgcn_s_sleep(1); \
    if ((++_sp & 255u) == 0u) { if (xb_ld(&(bar)[XB_TMO])) break; if (_sp > XB_SPIN_CAP) { atomicAdd(&(bar)[XB_TMO], 1u); break; } } } } while (0)

struct XcdBarrier {
    unsigned* bar; unsigned x;
    volatile LAS unsigned* st;
};

__device__ __forceinline__ XcdBarrier xcd_barrier_post(unsigned* bar, volatile LAS unsigned* st) {
    XcdBarrier b; b.bar = bar; b.x = xb_xcc_id(); b.st = st;
    if (threadIdx.x == 0) (void)xb_add(&bar[XB_XCNT(b.x)], 1u);
    return b;
}
__device__ __forceinline__ void xcd_barrier_complete(unsigned* bar, unsigned x, unsigned& nloc, unsigned& nx) {
    const unsigned G = gridDim.x * gridDim.y * gridDim.z;
    unsigned sum, cnt, mine, sp = 0u;
    for (;;) {
        sum = 0u; cnt = 0u; mine = 0u;
#pragma unroll
        for (unsigned j = 0; j < 16; ++j) { const unsigned c = xb_ld(&bar[XB_XCNT(j)]); sum += c; cnt += (c > 0u) ? 1u : 0u; mine = (j == x) ? c : mine; }
        if (sum == G) break;
        __builtin_amdgcn_s_sleep(1);
        if ((++sp & 255u) == 0u) { if (xb_ld(&bar[XB_TMO])) break; if (sp > XB_SPIN_CAP) { atomicAdd(&bar[XB_TMO], 1u); break; } }
    }
    nloc = mine > 0u ? mine : 1u; nx = cnt > 0u ? cnt : 1u;
}

__device__ __forceinline__ void xcd_barrier(const XcdBarrier& b) {
    asm volatile("s_waitcnt vmcnt(0)" ::: "memory");
    __syncthreads();
    if (threadIdx.x == 0) {
        unsigned* bar = b.bar; unsigned bx = b.x; asm volatile("" : "+s"(bx));
        __builtin_amdgcn_s_waitcnt(0);
        unsigned nloc = b.st[0], nx = b.st[1];
        if (nloc == 0u) { xcd_barrier_complete(bar, bx, nloc, nx); b.st[0] = nloc; b.st[1] = nx; }
        const unsigned old = xb_add(&bar[XB_XSUB(bx)], 1u);
        const unsigned gen = old / nloc;
        if (old + 1u == (gen + 1u) * nloc) {
            __builtin_amdgcn_fence(__ATOMIC_RELEASE, "agent");
            asm volatile("s_waitcnt vmcnt(0)" ::: "memory");
            const unsigned og = xb_add(&bar[XB_TOP], 1u);
            const unsigned tg = og / nx;
            if (og + 1u == (tg + 1u) * nx) xb_add(&bar[XB_TOPGEN], 1u);
            else XB_SPIN(xb_ld(&bar[XB_TOPGEN]) == tg, bar);
            __builtin_amdgcn_fence(__ATOMIC_ACQUIRE, "agent");
            xb_add(&bar[XB_XGEN(bx)], 1u);
            asm volatile("s_waitcnt vmcnt(0)" ::: "memory");
        } else {
            XB_SPIN(xb_ld(&bar[XB_XGEN(bx)]) == gen, bar);
            __builtin_amdgcn_fence(__ATOMIC_ACQUIRE, "agent");
            asm volatile("s_waitcnt vmcnt(0)" ::: "memory");
        }
    }
    __syncthreads();
}

__device__ __forceinline__ void ph_prep(const FP& p, int l, LAS unsigned char* lds) { const int t = TIDX, lane = t & 63, gw = blockIdx.x * NWAVES + (t >> 6), GWN = gridDim.x * NWAVES;
  LAS float* cwl = (LAS float*)lds;
  __syncthreads();
  for (int i = t; i < 5 * 1536 / 4; i += NTHREADS) *(LAS f32x4*)(cwl + 4 * i) = *(const f32x4*)(p.gdn_conv + (size_t)l * 5 * 1536 + 4 * i);
  __syncthreads();
  const f32x4 gq = *(const f32x4*)(p.g_cq + l * 256 + lane * 4); const float gkv0 = p.g_ckv[l * 128 + lane * 2], gkv1 = p.g_ckv[l * 128 + lane * 2 + 1];
  const float dtb = p.gdn_dt_bias[l * 8 + (lane & 7)], nalog = -__expf(p.gdn_a_log[l * 8 + (lane & 7)]);
  for (int row = gw; row < T; row += GWN) { const int s = row % SB; const bool lat = s >= CTX; const int tok = s - CTX, lo = lat ? CTX : 0, hi_ = lat ? SB : CTX;
    const bf16_t* pr = p.Pb + (size_t)row * INWP;
    const u32x2 vdq = *(const u32x2*)(pr + C_DQ + lane * 4); const unsigned vdkv = *(const unsigned*)(pr + C_DKV + lane * 2); const bf16_t vkr = pr[C_KR + lane];
    const u32x4 qv = *(const u32x4*)(pr + C_RQ + lane * 8), kv = *(const u32x4*)(pr + C_RK + lane * 8);
    u32x4 gx[3][5];
#pragma unroll
    for (int j = 0; j < 5; ++j) { const int s2 = s + j - 2; const bool ok = s2 >= lo && s2 < hi_; const bf16_t* pj = ok ? pr + (j - 2) * INWP : pr;
#pragma unroll
      for (int blk = 0; blk < 3; ++blk) gx[blk][j] = *(const u32x4*)(pj + C_GQ + blk * 512 + lane * 8); }
    const float gab = p.GAB[(size_t)row * 16 + (lane & 15)];
    { float x[4] = {bflo(vdq.x), bfhi(vdq.x), bflo(vdq.y), bfhi(vdq.y)};
      const float ss = wave_sum(x[0] * x[0] + x[1] * x[1] + x[2] * x[2] + x[3] * x[3]); const float rs = rsqrtf(ss * (1.f / 256.f) + 1e-6f);
      u32x2 w; w.x = cvt_pk_bf16(x[0] * rs * gq[0], x[1] * rs * gq[1]); w.y = cvt_pk_bf16(x[2] * rs * gq[2], x[3] * rs * gq[3]);
      *(u32x2*)(p.A2b + (size_t)row * MLAK + lane * 4) = w; }
    { const float x0 = bflo(vdkv), x1 = bfhi(vdkv);
      const float ss = wave_sum(x0 * x0 + x1 * x1); const float rs = rsqrtf(ss * (1.f / 128.f) + 1e-6f);
      *(unsigned*)(p.A2b + (size_t)row * MLAK + 256 + lane * 2) = cvt_pk_bf16(x0 * rs * gkv0, x1 * rs * gkv1); }
    { const float x = bf2f(vkr); const float xp = shx(x, 16); float y = x;
      if (lat) { const int hh = lane >> 5, ii = lane & 31, fi = ii & 15; const float pos = (float)(hh == 0 ? (tok >> 6) : (tok & 63));
        const float ang = pos * __expf(-(float)fi * (9.210340371976184f / 16.f)); const float cs = __cosf(ang), sn = __sinf(ang);
        y = ii < 16 ? x * cs - xp * sn : x * cs + xp * sn; }
      unsigned u = __float_as_uint(y); u += 0x7fffu + ((u >> 16) & 1u); p.KRb[(size_t)row * 64 + lane] = (bf16_t)(u >> 16); }
    { float q[8] = {bflo(qv.x), bfhi(qv.x), bflo(qv.y), bfhi(qv.y), bflo(qv.z), bfhi(qv.z), bflo(qv.w), bfhi(qv.w)};
      float k[8] = {bflo(kv.x), bfhi(kv.x), bflo(kv.y), bfhi(kv.y), bflo(kv.z), bfhi(kv.z), bflo(kv.w), bfhi(kv.w)};
      float qo[8], ko[8];
      const bool lowh = (lane & 4) == 0;
      const float pos = (float)(((lane >> 3) & 1) == 0 ? (tok >> 6) : (tok & 63));
#pragma unroll
      for (int e = 0; e < 8; ++e) { const float qp = shx(q[e], 4), kp = shx(k[e], 4);
        if (lat) { const int fi = (lane & 3) * 8 + e; const float ang = pos * __expf(-(float)fi * (9.210340371976184f / 32.f)); const float cs = __cosf(ang), sn = __sinf(ang);
          qo[e] = lowh ? q[e] * cs - qp * sn : q[e] * cs + qp * sn; ko[e] = lowh ? k[e] * cs - kp * sn : k[e] * cs + kp * sn; }
        else { qo[e] = q[e]; ko[e] = k[e]; } }
      const float sc = 0.08838834764831845f;
      u32x4 wq, wk; wq.x = cvt_pk_bf16(qo[0], qo[1]); wq.y = cvt_pk_bf16(qo[2], qo[3]); wq.z = cvt_pk_bf16(qo[4], qo[5]); wq.w = cvt_pk_bf16(qo[6], qo[7]);
      wk.x = cvt_pk_bf16(ko[0] * sc, ko[1] * sc); wk.y = cvt_pk_bf16(ko[2] * sc, ko[3] * sc); wk.z = cvt_pk_bf16(ko[4] * sc, ko[5] * sc); wk.w = cvt_pk_bf16(ko[6] * sc, ko[7] * sc);
      *(u32x4*)(p.RQb + (size_t)row * 512 + lane * 8) = wq; *(u32x4*)(p.RKb + (size_t)row * 512 + lane * 8) = wk; }
    { float o[3][8];
#pragma unroll
      for (int blk = 0; blk < 3; ++blk) {
#pragma unroll
        for (int e = 0; e < 8; ++e) o[blk][e] = 0.f;
#pragma unroll
        for (int j = 0; j < 5; ++j) { const int s2 = s + j - 2; const float m = (s2 >= lo && s2 < hi_) ? 1.f : 0.f; const u32x4 xv = gx[blk][j];
          const f32x4 w0 = *(const LAS f32x4*)(cwl + j * 1536 + blk * 512 + lane * 8) * m, w1 = *(const LAS f32x4*)(cwl + j * 1536 + blk * 512 + lane * 8 + 4) * m;
          o[blk][0] += w0[0] * bflo(xv.x); o[blk][1] += w0[1] * bfhi(xv.x); o[blk][2] += w0[2] * bflo(xv.y); o[blk][3] += w0[3] * bfhi(xv.y);
          o[blk][4] += w1[0] * bflo(xv.z); o[blk][5] += w1[1] * bfhi(xv.z); o[blk][6] += w1[2] * bflo(xv.w); o[blk][7] += w1[3] * bfhi(xv.w); }
#pragma unroll
        for (int e = 0; e < 8; ++e) o[blk][e] = silu_f(o[blk][e]); }
#pragma unroll
      for (int blk = 0; blk < 2; ++blk) { float ss = 0.f;
#pragma unroll
        for (int e = 0; e < 8; ++e) ss += o[blk][e] * o[blk][e];
        ss += shx(ss, 1); ss += shx(ss, 2); ss += shx(ss, 4); ss += shx(ss, 8);
        const float rs = rsqrtf(ss + 1e-6f) * (blk == 0 ? 0.08838834764831845f : 1.f);
#pragma unroll
        for (int e = 0; e < 8; ++e) o[blk][e] *= rs; }
      u32x4 w;
      w.x = cvt_pk_bf16(o[0][0], o[0][1]); w.y = cvt_pk_bf16(o[0][2], o[0][3]); w.z = cvt_pk_bf16(o[0][4], o[0][5]); w.w = cvt_pk_bf16(o[0][6], o[0][7]); *(u32x4*)(p.GQb + (size_t)row * 512 + lane * 8) = w;
      w.x = cvt_pk_bf16(o[1][0], o[1][1]); w.y = cvt_pk_bf16(o[1][2], o[1][3]); w.z = cvt_pk_bf16(o[1][4], o[1][5]); w.w = cvt_pk_bf16(o[1][6], o[1][7]); *(u32x4*)(p.GKb + (size_t)row * 512 + lane * 8) = w;
      w.x = cvt_pk_bf16(o[2][0], o[2][1]); w.y = cvt_pk_bf16(o[2][2], o[2][3]); w.z = cvt_pk_bf16(o[2][4], o[2][5]); w.w = cvt_pk_bf16(o[2][6], o[2][7]); *(u32x4*)(p.GVb + (size_t)row * 512 + lane * 8) = w;
      if (lane < 8) { const float a = gab + dtb; const float xe = __expf(a);
        const float sp = a > 20.f ? a : (xe < 0.03f ? xe * (1.f - xe * (0.5f - xe * (1.f / 3.f))) : __logf(1.f + xe));
        p.GLA[(size_t)row * 8 + lane] = nalog * sp; }
      else if (lane < 16) p.GBETA[(size_t)row * 8 + lane - 8] = 1.f / (1.f + __expf(-gab)); } } }
template <int WHICH = 3, int VAR = 0> __device__ __forceinline__ void ph_items(const FP& p, int l, LAS unsigned char* lds) {
  int rb = (int)blockIdx.x; asm volatile("" : "+s"(rb)); rb = (int)gridDim.x - 1 - rb;
  if (WHICH & 1) for (int pr = rb; pr < 16 * NCH / 2; pr += gridDim.x) { const int it = pr * 2 + (TIDX >> 8); r2_item(p, l, it / NCH, it % NCH, TIDX & 255, lds + (TIDX >> 8) * 40960); }
  if (WHICH & 2) for (int pr = rb; pr < 2 * 16 * NCH / 2; pr += gridDim.x) { const int it = pr * 2 + (TIDX >> 8); if (it / (16 * NCH)) g2_item<1, VAR>(p, (it / NCH) & 15, it % NCH, TIDX & 255, lds + (TIDX >> 8) * 71680); else g2_item<0, VAR>(p, (it / NCH) & 15, it % NCH, TIDX & 255, lds + (TIDX >> 8) * 71680); } }
__device__ __forceinline__ void ph_post(const FP& p, int l) { const int t = TIDX, lane = t & 63, gw = blockIdx.x * NWAVES + (t >> 6), GWN = gridDim.x * NWAVES;
  for (int row = gw; row < T; row += GWN) mla_out_row(p, l, row, lane);
  for (int u = gw; u < 16 * NCH * 2; u += GWN) { ret_out_unit(p, l, u / (NCH * 2), (u >> 1) % NCH, u & 1, lane); gdn_out_unit(p, l, u / (NCH * 2), (u >> 1) % NCH, u & 1, lane); } }

#ifndef REPMASK
#define REPMASK 0
#endif
#define REP(k, ...) do { if ((REPMASK >> (k)) & 1) { __VA_ARGS__; xcd_barrier(bar); } } while (0)
#ifndef PROBE_A
#define PROBE_A 0
#endif
#ifndef PROBE_Q
#define PROBE_Q 40
#endif
#if PROBE_A
#ifndef PROBE_BLK
#define PROBE_BLK 0
#endif
#define STAMP(k) do { if (blockIdx.x == PROBE_BLK && TIDX == 0) { volatile LAS unsigned* tw_ = (volatile LAS unsigned*)(lds + LDS_BYTES - 48); if ((k) != 13) tw_[0] = (k); if ((k) == 13 || (k) == 6 || (k) == 15) { \
    const unsigned long long now_ = __builtin_amdgcn_s_memrealtime(); volatile LAS unsigned long long* tl_ = (volatile LAS unsigned long long*)(lds + LDS_BYTES - 32); \
    volatile unsigned* ta_ = p.ctl + 3600 + tw_[0]; *ta_ = *ta_ + (unsigned)(now_ - *tl_); *tl_ = now_; } } } while (0)
#else
#define STAMP(k) do { } while (0)
#endif
__global__ void __launch_bounds__(512, 2) mega_fwd(FP p) {
  extern __shared__ __attribute__((aligned(16))) unsigned char shm[];
  LAS unsigned char* lds = (LAS unsigned char*)shm;
  volatile LAS unsigned* xbw = (volatile LAS unsigned*)(lds + LDS_BYTES - 16);
  if (threadIdx.x == 0) { xbw[0] = 0u; xbw[1] = 0u; xbw[2] = 0u; xbw[3] = 0u; }
  __syncthreads();
  XcdBarrier bar = xcd_barrier_post(p.ctl, xbw);
#if PROBE_A
  if (blockIdx.x == PROBE_BLK && TIDX == 0) *(volatile LAS unsigned long long*)(lds + LDS_BYTES - 32) = __builtin_amdgcn_s_memrealtime();
#endif
  ph_prologue(p, lds);
  REP(0, ph_prologue(p, lds));
  STAMP(0); xcd_barrier(bar); STAMP(13);
  for (int l = 0; l < DEPTH; ++l) {
    ph_norm1(p, l, lds);            REP(1, ph_norm1<true>(p, l, lds)); STAMP(1); xcd_barrier(bar); STAMP(13);
    ph_inproj(p, l, lds);           REP(2, ph_inproj(p, l, lds)); STAMP(2); xcd_barrier(bar); STAMP(13);
    ph_prep(p, l, lds);             REP(3, ph_prep(p, l, lds)); STAMP(3);
    xcd_barrier(bar); STAMP(13);
    ph_mla_gemm(p, l, lds); REP(4, ph_mla_gemm(p, l, lds)); STAMP(4);
    moe_weights_layer<1, 0, 192>(p, l, 20736, NE * 768, 0, lds);
    ph_items(p, l, lds); REP(5, ph_items(p, l, lds)); REP(14, ph_items<1>(p, l, lds)); REP(15, ph_items<2>(p, l, lds)); STAMP(5); xcd_barrier(bar); STAMP(13);
    if (blockIdx.x < 32) ret_scan_job(p, l, blockIdx.x >> 1, blockIdx.x & 1, lds); else if (blockIdx.x < 64) gdn_scan_job(p, (blockIdx.x - 32) >> 1, blockIdx.x & 1, lds);
    REP(6, if (blockIdx.x < 32) ret_scan_job(p, l, blockIdx.x >> 1, blockIdx.x & 1, lds); else if (blockIdx.x < 64) gdn_scan_job(p, (blockIdx.x - 32) >> 1, blockIdx.x & 1, lds));
    STAMP(6);
    moe_weights_layer<1, 0, 32>(p, l, 0, 6752, 0, lds); moe_weights_layer<1, 0, 64>(p, l, 6752, 11840, 32, lds);
    ph_attn(p, l, (char*)shm);      REP(7, ph_attn(p, l, (char*)shm)); STAMP(15); STAMP(7);
    moe_weights_layer(p, l, 11840, 20736, 64, lds);
    if (l + 1 < DEPTH) dense_weights_layer(p, l + 1, 64, lds);
    xcd_barrier(bar); STAMP(13);
    ph_post3(p, l, lds);            REP(8, ph_post3(p, l, lds)); STAMP(8); xcd_barrier(bar); STAMP(13);
    ph_outproj(p, l, lds);
    REP(9, { FP q = p; q.X = (float*)p.SCR; ph_outproj(q, l, lds); }); STAMP(9); xcd_barrier(bar); STAMP(13);
    ph_norm2m(p, l, lds);           REP(10, ph_norm2<true>(p, l, lds)); STAMP(10); xcd_barrier(bar); STAMP(13);
    ph_gemm1(p, l, lds);            REP(11, ph_gemm1(p, l, lds)); STAMP(11); xcd_barrier(bar); STAMP(13);
    ph_gemm2(p, l, lds);            REP(12, ph_gemm2(p, l, lds)); STAMP(12);
    xcd_barrier(bar); STAMP(13);
  }
  ph_final(p, lds);
#if PROBE_A
  STAMP(14); xcd_barrier(bar); STAMP(13);
  __syncthreads(); asm volatile("s_waitcnt vmcnt(0)" ::: "memory");
  if (blockIdx.x == 0 && threadIdx.x == 0) { unsigned a = 0;
    for (int k = 0; k < 16; ++k) { const unsigned tv = ((volatile unsigned*)p.ctl)[3600 + k]; if ((PROBE_A >> k) & 1) a += tv; }
    const float us = (float)a * 0.01f; float q = floorf(us * (1.f / (float)PROBE_Q) + 0.5f);
#ifdef PROBE_NBLK
    { int tot = 0; for (int l = 0; l < DEPTH; ++l) { int nblk = 0; for (int e = 0; e < NE; ++e) nblk += (p.cnt[l * 32 + e] + 255) >> 8; tot += (PROBE_NBLK == 1) ? (nblk * 8 + 255) / 256 : (PROBE_NBLK == 2) ? (nblk * 4 + 255) / 256 : (l == PROBE_NBLK - 3 ? nblk - 272 : 0); } q = (float)(tot - (PROBE_NBLK == 1 ? 30 : PROBE_NBLK == 2 ? 10 : 0)); }
#endif
    p.out[0] += 4.f * q; }
#endif
}

static size_t f_layout(char* base, FP& p) {
  size_t o = 0; auto take = [&](size_t bytes) { char* q = base + o; o += (bytes + 255) & ~(size_t)255; return q; };
  p.ctl = (unsigned*)take((size_t)CTL_WORDS * 4); p.cnt = (int*)(p.ctl + 4096);
  p.Wt_in = (bf16_t*)take((size_t)DEPTH * INWP * 1024 * 2); p.Wt_mla = (bf16_t*)take((size_t)DEPTH * MLAN * MLAK * 2); p.Wt_out = (bf16_t*)take((size_t)DEPTH * 1024 * 1536 * 2);
  p.Wt_gu = (bf16_t*)take((size_t)DEPTH * NE * 2048 * 1024 * 2); p.Wt_dn = (bf16_t*)take((size_t)DEPTH * NE * 1024 * 1024 * 2);
  p.MOD = (float*)take((size_t)DEPTH * 5 * 6144 * 4); p.X = (float*)take((size_t)T * D * 4); p.GAB = (float*)take((size_t)T * 16 * 4); p.TOPW = (float*)take((size_t)T * 4 * 4);
  p.Hb = (bf16_t*)take((size_t)T * D * 2); p.H2b = (bf16_t*)take((size_t)T * D * 2); p.Pb = (bf16_t*)take((size_t)T * INWP * 2); p.CATb = (bf16_t*)take((size_t)T * 1536 * 2);
  p.ACTb = (bf16_t*)take((size_t)ROWS_P * 1024 * 2); p.YSb = (bf16_t*)take((size_t)ROWS_P * 1024 * 2);
  p.A2b = (bf16_t*)take((size_t)T * MLAK * 2); p.Qb = (bf16_t*)take((size_t)T * 768 * 2); p.Knb = (bf16_t*)take((size_t)T * 512 * 2); p.Vb = (bf16_t*)take((size_t)T * 512 * 2);
  p.KRb = (bf16_t*)take((size_t)T * 64 * 2); p.AOb = (bf16_t*)take((size_t)T * 512 * 2);
  p.RQb = (bf16_t*)take((size_t)T * 512 * 2); p.RKb = (bf16_t*)take((size_t)T * 512 * 2); p.RKWT = (bf16_t*)take((size_t)2 * 16 * NCH * 8192 * 2);
  p.RVTB = (bf16_t*)take((size_t)16 * NCH * 8192 * 2); p.RVTA = (bf16_t*)take((size_t)16 * NCH * 8192 * 2); p.RST = (bf16_t*)take((size_t)2 * 16 * NCH * 16384 * 2);
  p.GQb = (bf16_t*)take((size_t)T * 512 * 2); p.GKb = (bf16_t*)take((size_t)T * 512 * 2); p.GVb = (bf16_t*)take((size_t)T * 512 * 2);
  p.GLA = (float*)take((size_t)T * 8 * 4); p.GBETA = (float*)take((size_t)T * 8 * 4); p.GG = (float*)take((size_t)2 * 16 * NCH * 64 * 4);
  p.GWb = (bf16_t*)take((size_t)2 * 16 * NCH * 8192 * 2); p.GKTT = (bf16_t*)take((size_t)2 * 16 * NCH * 8192 * 2); p.GUT = (bf16_t*)take((size_t)2 * 16 * NCH * 8192 * 2);
  p.GVNT = (bf16_t*)take((size_t)2 * 16 * NCH * 8192 * 2); p.GST = (bf16_t*)take((size_t)2 * 16 * NCH * 16384 * 2);
  p.TOPE = (int*)take((size_t)T * 4 * 4); p.TOPP = (int*)take((size_t)T * 4 * 4); p.ROWTOK = (int*)take((size_t)NE * T * 4); p.SCR = (bf16_t*)take((size_t)T * D * 4 + 4096); p.ROPE = (float*)take(64 * 32 * 4); p.WRF = (bf16_t*)take((size_t)DEPTH * 2 * 64 * 64 * 8 * 2);
  return o;
}
}

extern "C" void kernel_launch(void* const* d_in, const int* in_sizes, int n_in, void* d_out, int out_size, void* d_ws, size_t ws_size, hipStream_t stream) {
  static int grid = 0;
  if (grid == 0) {
    if (hipFuncSetAttribute((const void*)fx::mega_fwd, hipFuncAttributeMaxDynamicSharedMemorySize, fx::LDS_BYTES) != hipSuccess) { fprintf(stderr, "kernel_launch: hipFuncSetAttribute failed\n"); grid = -1; return; }
    int dev = 0, cus = 0, per_cu = 0; (void)hipGetDevice(&dev); (void)hipDeviceGetAttribute(&cus, hipDeviceAttributeMultiprocessorCount, dev);
    if (hipOccupancyMaxActiveBlocksPerMultiprocessor(&per_cu, (const void*)fx::mega_fwd, 512, fx::LDS_BYTES) != hipSuccess || per_cu < 1) { fprintf(stderr, "kernel_launch: occupancy query says %d blocks per CU\n", per_cu); grid = -1; return; }
    grid = cus;
    if (grid < 64) { fprintf(stderr, "kernel_launch: needs >= 64 CUs\n"); grid = -1; return; }
  }
  if (grid < 0) return;
  fx::FP p{}; { const float** f = (const float**)&p; for (int i = 0; i < 28; ++i) f[i] = (const float*)d_in[i]; }
  p.out = (float*)d_out;
  const size_t fsz = fx::f_layout((char*)d_ws, p);
  if (fsz > ws_size || n_in != 28) { fprintf(stderr, "kernel_launch: ws too small (%zu > %zu) or n_in %d\n", fsz, ws_size, n_in); return; }
  (void)hipMemsetAsync(p.ctl, 0, (size_t)fx::CTL_WORDS * 4, stream);
  hipLaunchKernelGGL(fx::mega_fwd, dim3(grid), dim3(512), fx::LDS_BYTES, stream, p);
}
```

```cpp
#include <hip/hip_runtime.h>
#include <stdint.h>
#include <stdio.h>

namespace cfg {
constexpr int D = 1024, NB = 4, SEQ = 4096, DEPTH = 4, CTX = 256, GW = 64;
constexpr int SB = CTX + SEQ;
constexpr int T = NB * SB;
constexpr int INW = 4560;
constexpr int C_DQ = 0, C_DKV = 256, C_KR = 384, C_RQ = 448, C_RK = 960, C_RV = 1472, C_RG = 1984, C_GQ = 2496, C_GK = 3008, C_GV = 3520, C_GZ = 4032, C_GA = 4544, C_GB = 4552;
constexpr int NE = 32, TOPK = 4, DE = 1024;
}
namespace fx {
using namespace cfg;
#define LAS __attribute__((address_space(3)))
typedef unsigned short bf16_t;
typedef short bf16x8 __attribute__((ext_vector_type(8)));
typedef short s16x4 __attribute__((ext_vector_type(4)));
typedef float f32x4 __attribute__((ext_vector_type(4)));
typedef float f32x16 __attribute__((ext_vector_type(16)));
typedef unsigned u32x4 __attribute__((ext_vector_type(4)));
typedef unsigned u32x2 __attribute__((ext_vector_type(2)));

__device__ __forceinline__ int opaque_tid() { int t = threadIdx.x; asm volatile("" : "+v"(t)); return t; }
#define TIDX opaque_tid()
__device__ __forceinline__ float shx(float v, int m) { const int ln = TIDX & 63; return __int_as_float(__builtin_amdgcn_ds_bpermute((ln ^ m) << 2, __float_as_int(v))); }
__device__ __forceinline__ int shxi(int v, int m) { const int ln = TIDX & 63; return __builtin_amdgcn_ds_bpermute((ln ^ m) << 2, v); }
__device__ __forceinline__ float shup(float v, int o) { const int ln = TIDX & 63; const int src = ln >= o ? ln - o : ln; return __int_as_float(__builtin_amdgcn_ds_bpermute(src << 2, __float_as_int(v))); }
__device__ __forceinline__ int shupi(int v, int o) { const int ln = TIDX & 63; const int src = ln >= o ? ln - o : ln; return __builtin_amdgcn_ds_bpermute(src << 2, v); }
__device__ __forceinline__ float shdn(float v, int o) { const int ln = TIDX & 63; const int src = ln + o < 64 ? ln + o : ln; return __int_as_float(__builtin_amdgcn_ds_bpermute(src << 2, __float_as_int(v))); }
constexpr int NTHREADS = 512, NWAVES = 8;
constexpr int BM = 256, BK = 64, HALF = 128, HTB = HALF * BK * 2, STAGE_BYTES = 8 * HTB, NXCD = 8, WGM = 8;
constexpr int LDS_MISC = STAGE_BYTES;
constexpr int LDS_BYTES = 163840;
constexpr int INWP = 4608;
constexpr int MLAN = 1792, MLAK = 384;
constexpr int MAXBLK = (T * TOPK) / 256 + NE;
constexpr int ROWS_P = MAXBLK * 256;

__device__ __forceinline__ unsigned cvt_pk_bf16(float lo, float hi) { unsigned r; asm volatile("v_cvt_pk_bf16_f32 %0, %1, %2" : "=v"(r) : "v"(lo), "v"(hi)); return r; }
__device__ __forceinline__ float bf2f(unsigned short b) { return __uint_as_float(((unsigned)b) << 16); }
__device__ __forceinline__ bf16_t f2bf(float f) { unsigned u = __float_as_uint(f); u += 0x7fffu + ((u >> 16) & 1u); return (bf16_t)(u >> 16); }
__device__ __forceinline__ float bflo(unsigned w) { return __uint_as_float(w << 16); }
__device__ __forceinline__ float bfhi(unsigned w) { return __uint_as_float(w & 0xffff0000u); }
__device__ __forceinline__ float silu_f(float v) { return v / (1.f + __expf(-v)); }
__device__ __forceinline__ int crow16(int r, int hi) { return (r & 3) + 8 * (r >> 2) + 4 * hi; }

__host__ __device__ __forceinline__ int lds_byte(int r, int c) { const int st = (r >> 4) * 2 + (c >> 5), rr = r & 15, cc = c & 31, ob = rr * 64 + cc * 2; return st * 1024 + (ob ^ (((ob >> 9) & 1) << 5)); }
__host__ __device__ __forceinline__ void stage_rc(int b, int& R, int& C) { const int st = b / 1024, sb = b % 1024, swz = sb ^ (((sb >> 9) & 1) << 5); R = (st >> 1) * 16 + swz / 64; C = (st & 1) * 32 + (swz % 64) / 2; }
__host__ __device__ __forceinline__ int perm32(int rho) { const int n = rho >> 4, i = rho & 15; return 8 * (i >> 2) + 4 * n + (i & 3); }

struct Unit { int pm, pn, e, pad_; long aoff, boff; };
struct Gemm { const bf16_t* A; const bf16_t* Bt; int M, N, K; };

struct StaticOrder {
    static constexpr bool DYN_A = false;
    int nM, nN, nwg, G, c, K;
    __device__ void init(int M, int N, int K_, int G_, int c_) { nM = M / BM; nN = N / BM; nwg = nM * nN; G = G_; c = c_; K = K_; }
    __device__ bool next(int i, Unit& u) const {
        const long L = (long)i * G + c; if (L >= nwg) return false;
        int wgid = (int)L; { const int q = nwg / NXCD, r = nwg % NXCD, xcd = wgid % NXCD, off = wgid / NXCD; wgid = (xcd < r ? xcd * (q + 1) : r * (q + 1) + (xcd - r) * q) + off; }
        const int nig = WGM * nN, gid = wgid / nig, fm = gid * WGM, gsz = (nM - fm) < WGM ? (nM - fm) : WGM;
        u.pm = fm + ((wgid % nig) % gsz); u.pn = (wgid % nig) / gsz; u.e = 0; u.pad_ = 0;
        u.aoff = (long)u.pm * BM * K * 2; u.boff = (long)u.pn * BM * K * 2; return true;
    }
    __device__ __forceinline__ void a_off(const Unit&, const int (&R)[2], const int (&C)[2], unsigned (&v)[2][2]) const {
#pragma unroll
        for (int h = 0; h < 2; ++h)
#pragma unroll
            for (int i = 0; i < 2; ++i) v[h][i] = (unsigned)((h * HALF + R[i]) * K + C[i]) * 2u;
    }
};
struct LatentOrder {
    static constexpr bool DYN_A = false;
    int nN, G, c, K;
    __device__ bool next(int i, Unit& u) const {
        const int L = i * G + c; if (L >= 64 * nN) return false;
        const int lt = L / nN; u.pn = L % nN; u.pm = (lt >> 4) * 17 + 1 + (lt & 15); u.e = 0; u.pad_ = 0;
        u.aoff = (long)u.pm * BM * K * 2; u.boff = (long)u.pn * BM * K * 2; return true;
    }
    __device__ __forceinline__ void a_off(const Unit&, const int (&R)[2], const int (&C)[2], unsigned (&v)[2][2]) const {
#pragma unroll
        for (int h = 0; h < 2; ++h)
#pragma unroll
            for (int i = 0; i < 2; ++i) v[h][i] = (unsigned)((h * HALF + R[i]) * K + C[i]) * 2u;
    }
};
template <bool GATHER> struct MoeOrder {
    static constexpr bool DYN_A = GATHER;
    int nblk, NPN, G, c, K; const LAS int* blk_e; const LAS int* blk_j; const LAS int* ulist; int* rowtok; int* cnt; long bstride;
    __device__ bool next(int i, Unit& u) const {
        if (i >= __builtin_amdgcn_readfirstlane(ulist[0])) return false;
        const int blk = __builtin_amdgcn_readfirstlane(ulist[1 + 2 * i]); u.pn = __builtin_amdgcn_readfirstlane(ulist[2 + 2 * i]); u.pm = blk; u.e = __builtin_amdgcn_readfirstlane(blk_e[blk]); u.pad_ = __builtin_amdgcn_readfirstlane(blk_j[blk]);
        u.aoff = GATHER ? 0 : (long)blk * BM * K * 2; u.boff = (long)u.e * bstride + (long)u.pn * BM * K * 2; return true;
    }
    __device__ __forceinline__ void a_off(const Unit& u, const int (&R)[2], const int (&C)[2], unsigned (&v)[2][2]) const {
        if (GATHER) { const int n = __hip_atomic_load(&cnt[u.e], __ATOMIC_RELAXED, __HIP_MEMORY_SCOPE_AGENT); const int* lst = rowtok + (size_t)u.e * T + u.pad_ * 256;
#pragma unroll
            for (int h = 0; h < 2; ++h)
#pragma unroll
                for (int i = 0; i < 2; ++i) { const int rr = h * HALF + R[i]; const int tok = (u.pad_ * 256 + rr < n) ? __hip_atomic_load(&lst[rr], __ATOMIC_RELAXED, __HIP_MEMORY_SCOPE_AGENT) : 0;     v[h][i] = (unsigned)(tok * K + C[i]) * 2u; }
        } else {
#pragma unroll
            for (int h = 0; h < 2; ++h)
#pragma unroll
                for (int i = 0; i < 2; ++i) v[h][i] = (unsigned)((h * HALF + R[i]) * K + C[i]) * 2u;
        }
    }
};

struct EpiInproj {
    static constexpr bool PERM = true;
    bf16_t* O; float* GAB;
    __device__ __forceinline__ void operator()(const f32x4 (&acc)[2][2][4][2], const Unit& u, int wr, int wc, int fr, int fq) const {
        const int row0 = u.pm * BM + wr * 64 + fr, col0 = u.pn * BM + wc * 32 + 8 * fq;
#pragma unroll
        for (int ai = 0; ai < 2; ++ai)
#pragma unroll
            for (int m = 0; m < 4; ++m) { const int row = row0 + ai * HALF + m * 16; bf16_t* rowp = O + (size_t)row * INWP + col0;
#pragma unroll
                for (int bj = 0; bj < 2; ++bj) { const f32x4 v0 = acc[ai][bj][m][0], v1 = acc[ai][bj][m][1];
                    u32x4 w; w.x = cvt_pk_bf16(v0[0], v0[1]); w.y = cvt_pk_bf16(v0[2], v0[3]); w.z = cvt_pk_bf16(v1[0], v1[1]); w.w = cvt_pk_bf16(v1[2], v1[3]);
                    *(u32x4*)(rowp + bj * HALF) = w; }
                if (u.pn == 17 && wc == 2 && fq < 2) { float* gp = GAB + (size_t)row * 16 + fq * 8; *(f32x4*)gp = acc[ai][1][m][0]; *(f32x4*)(gp + 4) = acc[ai][1][m][1]; } }
    }
};
struct EpiOutproj {
    static constexpr bool PERM = false;
    float* X; const float* MODl;
    __device__ __forceinline__ void operator()(const f32x4 (&acc)[2][2][4][2], const Unit& u, int wr, int wc, int fr, int fq) const {
        const int row0 = u.pm * BM + wr * 64 + fr, col0 = u.pn * BM + wc * 32 + 4 * fq; const int rmod = (u.pm % 17 == 0) ? 4 : u.pm / 17;
        const float* gt = MODl + (size_t)rmod * 6144 + 2048 + col0; f32x4 gv[2][2];
#pragma unroll
        for (int bj = 0; bj < 2; ++bj)
#pragma unroll
            for (int n = 0; n < 2; ++n) gv[bj][n] = *(const f32x4*)(gt + bj * HALF + n * 16);
#pragma unroll
        for (int ai = 0; ai < 2; ++ai)
#pragma unroll
            for (int m = 0; m < 4; ++m) { float* rowp = X + (size_t)(row0 + ai * HALF + m * 16) * D + col0;
#pragma unroll
                for (int bj = 0; bj < 2; ++bj)
#pragma unroll
                    for (int n = 0; n < 2; ++n) { f32x4* p = (f32x4*)(rowp + bj * HALF + n * 16); *p = *p + gv[bj][n] * acc[ai][bj][m][n]; } }
    }
};
struct EpiGateUp {
    static constexpr bool PERM = true;
    bf16_t* ACT; const float* bgu;
    __device__ __forceinline__ void operator()(const f32x4 (&acc)[2][2][4][2], const Unit& u, int wr, int wc, int fr, int fq) const {
        const int row0 = u.pm * BM + wr * 64 + fr, oc = u.pn * HALF + wc * 32 + 8 * fq; const float* bg = bgu + (size_t)u.e * 2048 + oc;
        f32x4 bgv[2], buv[2];
#pragma unroll
        for (int n = 0; n < 2; ++n) { bgv[n] = *(const f32x4*)(bg + 4 * n); buv[n] = *(const f32x4*)(bg + 1024 + 4 * n); }
#pragma unroll
        for (int ai = 0; ai < 2; ++ai)
#pragma unroll
            for (int m = 0; m < 4; ++m) { float o[8];
#pragma unroll
                for (int n = 0; n < 2; ++n) { const f32x4 gv = acc[ai][0][m][n] + bgv[n], uv = acc[ai][1][m][n] + buv[n];
#pragma unroll
                    for (int j = 0; j < 4; ++j) { const float gg = fminf(gv[j], 7.f), uu = fminf(fmaxf(uv[j], -7.f), 7.f); o[n * 4 + j] = (uu + 1.f) * gg / (1.f + __expf(-1.702f * gg)); } }
                u32x4 w; w.x = cvt_pk_bf16(o[0], o[1]); w.y = cvt_pk_bf16(o[2], o[3]); w.z = cvt_pk_bf16(o[4], o[5]); w.w = cvt_pk_bf16(o[6], o[7]);
                *(u32x4*)(ACT + (size_t)(row0 + ai * HALF + m * 16) * 1024 + oc) = w; }
    }
};
struct EpiDown {
    static constexpr bool PERM = true;
    bf16_t* YS; const float* bdn;
    __device__ __forceinline__ void operator()(const f32x4 (&acc)[2][2][4][2], const Unit& u, int wr, int wc, int fr, int fq) const {
        const int row0 = u.pm * BM + wr * 64 + fr, col0 = u.pn * BM + wc * 32 + 8 * fq; const float* bb = bdn + (size_t)u.e * 1024 + col0;
        f32x4 bv[2][2];
#pragma unroll
        for (int bj = 0; bj < 2; ++bj)
#pragma unroll
            for (int n = 0; n < 2; ++n) bv[bj][n] = *(const f32x4*)(bb + bj * HALF + 4 * n);
#pragma unroll
        for (int ai = 0; ai < 2; ++ai)
#pragma unroll
            for (int m = 0; m < 4; ++m) { bf16_t* rowp = YS + (size_t)(row0 + ai * HALF + m * 16) * 1024 + col0;
#pragma unroll
                for (int bj = 0; bj < 2; ++bj) { const f32x4 v0 = acc[ai][bj][m][0] + bv[bj][0], v1 = acc[ai][bj][m][1] + bv[bj][1];
                    u32x4 w; w.x = cvt_pk_bf16(v0[0], v0[1]); w.y = cvt_pk_bf16(v0[2], v0[3]); w.z = cvt_pk_bf16(v1[0], v1[1]); w.w = cvt_pk_bf16(v1[2], v1[3]);
                    *(u32x4*)(rowp + bj * HALF) = w; } }
    }
};

template <class Epi, class Sched>
__device__ __forceinline__ void gemm_phase(LAS unsigned char* lds, const Gemm g, const Sched& S, const Epi& E) {
    const int tid = TIDX, wid = __builtin_amdgcn_readfirstlane(tid >> 6), lane = tid & 63, wr = wid >> 2, wc = wid & 3, fr = lane & 15, fq = lane >> 4;
    const int K = g.K, nt = K / BK;
    int Rr[2], Cc[2]; unsigned voffB[2];
#pragma unroll
    for (int i = 0; i < 2; ++i) { int R, C; stage_rc(tid * 16 + i * 8192, R, C); Rr[i] = R; Cc[i] = C; const int Rb = Epi::PERM ? ((R & ~31) + perm32(R & 31)) : R; voffB[i] = (unsigned)(Rb * K + C) * 2u; }
    const size_t kstep = (size_t)(BK * 2);
    const size_t hstep = (size_t)HALF * K * 2;
    const unsigned ldsw = (unsigned)wid * 1024u;
    const int aoff = lds_byte(wr * 64 + fr, fq * 8), boff = lds_byte(wc * 32 + fr, fq * 8);
#define PG8_SA(b, h) (((b) * 2 + (h)) * HTB)
#define PG8_SB(b, h) ((4 + (b) * 2 + (h)) * HTB)
#define PG8_STAGE(bufoff, gbase, voff) do { _Pragma("unroll") for (int _i = 0; _i < 2; ++_i) \
        __builtin_amdgcn_global_load_lds((const unsigned*)((const char*)(gbase) + (voff)[_i]), (LAS unsigned*)(lds + (bufoff) + ldsw + _i * 8192), 16, 0, 0); } while (0)
#define PG8_LDA(dst, b, h) do { _Pragma("unroll") for (int m = 0; m < 4; ++m) _Pragma("unroll") for (int k = 0; k < 2; ++k) dst[m][k] = *(const LAS bf16x8*)(lds + PG8_SA(b, h) + aoff + m * 2048 + k * 1024); } while (0)
#define PG8_LDB(dst, b, h) do { _Pragma("unroll") for (int n = 0; n < 2; ++n) _Pragma("unroll") for (int k = 0; k < 2; ++k) dst[n][k] = *(const LAS bf16x8*)(lds + PG8_SB(b, h) + boff + n * 2048 + k * 1024); } while (0)
#define PG8_MMA(ai, bj, At, Bt) do { __builtin_amdgcn_s_setprio(1); _Pragma("unroll") for (int m = 0; m < 4; ++m) _Pragma("unroll") for (int n = 0; n < 2; ++n) _Pragma("unroll") for (int k = 0; k < 2; ++k) \
        acc[ai][bj][m][n] = __builtin_amdgcn_mfma_f32_16x16x32_bf16(Bt[n][k], At[m][k], acc[ai][bj][m][n], 0, 0, 0); __builtin_amdgcn_s_setprio(0); } while (0)
#define PG8_WAIT_V(n) asm volatile("s_waitcnt vmcnt(" #n ")" ::: "memory")
#define PG8_WAIT_L(n) asm volatile("s_waitcnt lgkmcnt(" #n ")" ::: "memory")
#define PG8_BAR __builtin_amdgcn_s_barrier()
#define PG8_SCHED __builtin_amdgcn_sched_barrier(0)
    Unit cur, nxt; int ui = 0;
    if (!S.next(0, cur)) return;
    f32x4 acc[2][2][4][2];
#pragma unroll
    for (int a = 0; a < 2; ++a)
#pragma unroll
        for (int b = 0; b < 2; ++b)
#pragma unroll
            for (int m = 0; m < 4; ++m)
#pragma unroll
                for (int n = 0; n < 2; ++n) acc[a][b][m][n] = (f32x4){0.f, 0.f, 0.f, 0.f};
    bf16x8 At[4][2], B0[2][2], B1[2][2];
    unsigned vAc[2][2], vAn[2][2];
    S.a_off(cur, Rr, Cc, vAc);
    const char* cA = (const char*)g.A + cur.aoff; const char* cB = (const char*)g.Bt + cur.boff;
    PG8_STAGE(PG8_SB(0, 0), cB, voffB); PG8_STAGE(PG8_SA(0, 0), cA, vAc[0]); PG8_STAGE(PG8_SB(0, 1), cB + hstep, voffB); PG8_STAGE(PG8_SA(0, 1), cA, vAc[1]);
    if (wr == 1) PG8_BAR;
    PG8_WAIT_V(4); PG8_BAR;
    PG8_STAGE(PG8_SB(1, 0), cB + kstep, voffB); PG8_STAGE(PG8_SA(1, 0), cA + kstep, vAc[0]); PG8_STAGE(PG8_SB(1, 1), cB + hstep + kstep, voffB);
    PG8_WAIT_V(6); PG8_BAR;
    for (;;) {
        const bool has_next = S.next(ui + 1, nxt);
        if (!Sched::DYN_A) { }
        else if (has_next) S.a_off(nxt, Rr, Cc, vAn);
        else {
#pragma unroll
            for (int h = 0; h < 2; ++h)
#pragma unroll
                for (int i = 0; i < 2; ++i) vAn[h][i] = vAc[h][i]; }
        const char* nA = has_next ? (const char*)g.A + nxt.aoff : cA; const char* nB = has_next ? (const char*)g.Bt + nxt.boff : cB;
#pragma unroll 1
        for (int t = 0; t < nt; t += 2) {
            const bool last = (t == nt - 2);
            const char* a1 = cA + (size_t)(t + 1) * kstep;
            const char* a2 = last ? nA : cA + (size_t)(t + 2) * kstep; const char* b2 = last ? nB : cB + (size_t)(t + 2) * kstep;
            const char* a3 = a2 + kstep; const char* b3 = b2 + kstep;
            unsigned w2[2][2];
#pragma unroll
            for (int h = 0; h < 2; ++h)
#pragma unroll
                for (int i = 0; i < 2; ++i) w2[h][i] = (Sched::DYN_A && last) ? vAn[h][i] : vAc[h][i];
            PG8_LDB(B0, 0, 0); PG8_SCHED; PG8_LDA(At, 0, 0); PG8_STAGE(PG8_SA(1, 1), a1, vAc[1]);
            PG8_WAIT_L(8); PG8_BAR; PG8_WAIT_L(0); PG8_MMA(0, 0, At, B0); PG8_BAR; PG8_SCHED;
            PG8_LDB(B1, 0, 1); PG8_STAGE(PG8_SB(0, 0), b2, voffB);
            PG8_BAR; PG8_WAIT_L(0); PG8_MMA(0, 1, At, B1); PG8_BAR;
            PG8_LDA(At, 0, 1); PG8_STAGE(PG8_SA(0, 0), a2, w2[0]);
            PG8_BAR; PG8_WAIT_L(0); PG8_MMA(1, 0, At, B0); PG8_BAR; PG8_SCHED;
            PG8_STAGE(PG8_SB(0, 1), b2 + hstep, voffB);
            PG8_WAIT_V(6); PG8_BAR; PG8_MMA(1, 1, At, B1); PG8_BAR;
            PG8_LDB(B0, 1, 0); PG8_SCHED; PG8_LDA(At, 1, 0); PG8_STAGE(PG8_SA(0, 1), a2, w2[1]);
            PG8_WAIT_L(8); PG8_BAR; PG8_WAIT_L(0); PG8_MMA(0, 0, At, B0); PG8_BAR; PG8_SCHED;
            PG8_LDB(B1, 1, 1); PG8_STAGE(PG8_SB(1, 0), b3, voffB);
            PG8_BAR; PG8_WAIT_L(0); PG8_MMA(0, 1, At, B1); PG8_BAR;
            PG8_LDA(At, 1, 1); PG8_STAGE(PG8_SA(1, 0), a3, w2[0]);
            PG8_BAR; PG8_WAIT_L(0); PG8_MMA(1, 0, At, B0); PG8_BAR; PG8_SCHED;
            PG8_STAGE(PG8_SB(1, 1), b3 + hstep, voffB);
            PG8_WAIT_V(6); PG8_BAR; PG8_MMA(1, 1, At, B1); PG8_BAR;
        }
        asm volatile("s_nop 9\n\ts_nop 9" : "+v"(acc[1][1][3][1]), "+v"(acc[1][1][3][0]), "+v"(acc[1][1][2][1]), "+v"(acc[1][1][2][0]));
        { int tz = TIDX; const int wz = tz >> 6, lz = tz & 63; E(acc, cur, wz >> 2, wz & 3, lz & 15, lz >> 4); }
        if (!has_next) break;
#pragma unroll
        for (int a = 0; a < 2; ++a)
#pragma unroll
            for (int b = 0; b < 2; ++b)
#pragma unroll
                for (int m = 0; m < 4; ++m)
#pragma unroll
                    for (int n = 0; n < 2; ++n) acc[a][b][m][n] = (f32x4){0.f, 0.f, 0.f, 0.f};
        cur = nxt; cA = nA; cB = nB; ++ui;
#pragma unroll
        for (int h = 0; h < 2; ++h)
#pragma unroll
            for (int i = 0; i < 2; ++i) if (Sched::DYN_A) vAc[h][i] = vAn[h][i];
    }
    PG8_WAIT_V(0);
    if (wr == 0) PG8_BAR;
    PG8_BAR;
#undef PG8_SA
#undef PG8_SB
#undef PG8_STAGE
#undef PG8_LDA
#undef PG8_LDB
#undef PG8_MMA
#undef PG8_WAIT_V
#undef PG8_WAIT_L
#undef PG8_BAR
#undef PG8_SCHED
}
struct FP {
  const float *x, *c, *ctx, *c_ctx, *w_mod, *b_mod, *g_norm1, *g_norm2, *w_in, *g_cq, *g_ckv, *w_uq, *w_ukv, *g_mla, *ret_decay, *g_ret, *gdn_conv, *gdn_a_log,
      *gdn_dt_bias, *g_gdn, *w_out, *w_router, *b_router, *w_gate_up, *b_gate_up, *w_down, *b_down, *g_final;
  float* out;
  unsigned* ctl; int* cnt;
  bf16_t *Wt_in, *Wt_mla, *Wt_out, *Wt_gu, *Wt_dn;
  float *MOD, *X, *GAB, *TOPW;
  bf16_t *Hb, *H2b, *Pb, *CATb, *ACTb, *YSb;
  int *TOPE, *TOPP, *ROWTOK;
  bf16_t *A2b, *Qb, *Knb, *Vb, *KRb, *AOb;
  bf16_t *RQb, *RKb, *RKWT, *RVTB, *RVTA, *RST;
  bf16_t *GQb, *GKb, *GVb, *GUT, *GWb, *GKTT, *GVNT, *GST;
  float *GG, *GBETA, *GLA; bf16_t* SCR; float* ROPE; bf16_t* WRF;
};
constexpr int CTL_WORDS = 4096 + DEPTH * 32;

template <int MAP> __device__ __forceinline__ void tr_tile(const float* src, int lds_, int k0, int n0, int N, bf16_t* dst, int ldd, int kcol0, LAS float* tile) {
  const int t = TIDX;
#pragma unroll
  for (int i = 0; i < 2; ++i) { const int idx = t + 512 * i, k = idx >> 4, n4 = (idx & 15) * 4; f32x4 v = (f32x4){0.f, 0.f, 0.f, 0.f};
    if (n0 + n4 < N) v = *(const f32x4*)(src + (size_t)(k0 + k) * lds_ + n0 + n4);
    tile[k * 65 + n4 + 0] = v[0]; tile[k * 65 + n4 + 1] = v[1]; tile[k * 65 + n4 + 2] = v[2]; tile[k * 65 + n4 + 3] = v[3]; }
  __syncthreads();
  { const int n = t >> 3, k8 = (t & 7) * 8; float o[8];
#pragma unroll
    for (int j = 0; j < 8; ++j) o[j] = tile[(k8 + j) * 65 + n];
    u32x4 w; w.x = cvt_pk_bf16(o[0], o[1]); w.y = cvt_pk_bf16(o[2], o[3]); w.z = cvt_pk_bf16(o[4], o[5]); w.w = cvt_pk_bf16(o[6], o[7]);
    int gn = n0 + n, row;
    if (MAP == 1) { const int bj = gn >> 10, c = gn & 1023; row = (c >> 7) * 256 + bj * 128 + (c & 127); }
    else row = gn;
    *(u32x4*)(dst + (size_t)row * ldd + kcol0 + k0 + k8) = w; }
  __syncthreads();
}

__device__ void dense_weights_layer(const FP& p, int l, int b0, LAS unsigned char* lds) {
  LAS float* tile = (LAS float*)lds; int bid_ = (int)blockIdx.x; asm volatile("" : "+s"(bid_));
  const int me = bid_ - b0, nb = (int)gridDim.x - b0, t = TIDX; if (me < 0 || nb <= 0) return;
  __syncthreads();
  constexpr int L_IN = 16 * 72, L_OUT = 24 * 16, L_UQ = 4 * 12, L_UKV = 2 * 16;
  for (int id = me; id < L_IN + L_OUT + L_UQ + L_UKV; id += nb) { int r = id;
    if (r < L_IN) { const int kt = r / 72, nt = r % 72;
      tr_tile<0>(p.w_in + (size_t)l * 1024 * INW, INW, kt * 64, nt * 64, INW, p.Wt_in + (size_t)l * INWP * 1024, 1024, 0, tile); continue; }
    r -= L_IN;
    if (r < L_OUT) { const int kt = r / 16, nt = r % 16;
      tr_tile<0>(p.w_out + (size_t)l * 1536 * 1024, 1024, kt * 64, nt * 64, 1024, p.Wt_out + (size_t)l * 1024 * 1536, 1536, 0, tile); continue; }
    r -= L_OUT;
    if (r < L_UQ) { const int kt = r / 12, nt = r % 12;
      tr_tile<0>(p.w_uq + (size_t)l * 256 * 768, 768, kt * 64, nt * 64, 768, p.Wt_mla + (size_t)l * MLAN * MLAK, MLAK, 0, tile); continue; }
    r -= L_UQ;
    { const int kt = r / 16, nt = r % 16;
      tr_tile<0>(p.w_ukv + (size_t)l * 128 * 1024, 1024, kt * 64, nt * 64, 1024, p.Wt_mla + (size_t)l * MLAN * MLAK + (size_t)768 * MLAK, MLAK, 256, tile); } }
  { unsigned zz = 0u; asm volatile("" : "+v"(zz)); const u32x4 z = (u32x4){zz, zz, zz, zz};
    const int gtid = me * NTHREADS + t, gstr = nb * NTHREADS;
    for (int i = gtid; i < 768 * 16; i += gstr) { const int rr = i / 16, c8 = (i % 16) * 8; *(u32x4*)(p.Wt_mla + ((size_t)l * MLAN + rr) * MLAK + 256 + c8) = z; }
    for (int i = gtid; i < 1024 * 32; i += gstr) { const int rr = i / 32, c8 = (i % 32) * 8; *(u32x4*)(p.Wt_mla + ((size_t)l * MLAN + 768 + rr) * MLAK + c8) = z; } }
}

__device__ void ph_prologue(const FP& p, LAS unsigned char* lds) {
  const int G = gridDim.x, bid = blockIdx.x, t = TIDX;
  dense_weights_layer(p, 0, 0, lds);
  for (int i = bid * NTHREADS + t; i < DEPTH * 64 * 64; i += G * NTHREADS) { const int l = i >> 12, s = (i >> 6) & 63, ln = i & 63; u32x4 wh, wl; unsigned hh[8], ll[8];
#pragma unroll
    for (int jj = 0; jj < 8; ++jj) { const float w = p.w_router[((size_t)l * D + 16 * s + 8 * (ln >> 5) + jj) * NE + (ln & 31)]; unsigned u = __float_as_uint(w); u += 0x7fffu + ((u >> 16) & 1u); hh[jj] = u >> 16;
      const float res = w - __uint_as_float(hh[jj] << 16); unsigned v = __float_as_uint(res); v += 0x7fffu + ((v >> 16) & 1u); ll[jj] = v >> 16; }
    wh.x = hh[0] | (hh[1] << 16); wh.y = hh[2] | (hh[3] << 16); wh.z = hh[4] | (hh[5] << 16); wh.w = hh[6] | (hh[7] << 16); wl.x = ll[0] | (ll[1] << 16); wl.y = ll[2] | (ll[3] << 16); wl.z = ll[4] | (ll[5] << 16); wl.w = ll[6] | (ll[7] << 16);
    *(u32x4*)(p.WRF + ((size_t)(l * 2) * 64 * 64 + (s * 64 + ln)) * 8) = wh; *(u32x4*)(p.WRF + ((size_t)(l * 2 + 1) * 64 * 64 + (s * 64 + ln)) * 8) = wl; }
  if (bid == 0) for (int i = t; i < 64 * 16; i += NTHREADS) { const int pos = i >> 4, f = i & 15; const float ang = (float)pos * expf(-(float)f * (9.210340371976184f / 16.f)); p.ROPE[pos * 32 + f] = cosf(ang); p.ROPE[pos * 32 + 16 + f] = sinf(ang); }
  { LAS float* sc = (LAS float*)(lds + 32768);
    LAS float* part = (LAS float*)(lds + 32768 + 5 * 1024 * 4);
    __syncthreads();
    for (int i = t; i < 5 * 1024; i += NTHREADS) { const int r = i >> 10, k = i & 1023; const float v = r < 4 ? p.c[r * 1024 + k] : p.c_ctx[k]; sc[i] = v / (1.f + expf(-v)); }
    __syncthreads();
    for (int item = bid; item < DEPTH * 64; item += G) { const int l = item >> 6, c0 = (item & 63) * 96, col = t % 96, ks = t / 96;
      if (ks < 5) { float a[5] = {0.f, 0.f, 0.f, 0.f, 0.f}; const float* w = p.w_mod + (size_t)l * 1024 * 6144 + c0 + col; const int k0 = ks * 205, k1 = k0 + 205 < 1024 ? k0 + 205 : 1024;
#pragma unroll 8
        for (int k = k0; k < k1; ++k) { const float wv = w[(size_t)k * 6144];
#pragma unroll
          for (int r = 0; r < 5; ++r) a[r] += sc[r * 1024 + k] * wv; }
#pragma unroll
        for (int r = 0; r < 5; ++r) part[(ks * 96 + col) * 5 + r] = a[r]; }
      __syncthreads();
      if (t < 96) {
#pragma unroll
        for (int r = 0; r < 5; ++r) { float sm = 0.f;
#pragma unroll
          for (int q = 0; q < 5; ++q) sm += part[(q * 96 + t) * 5 + r];
          p.MOD[(size_t)(l * 5 + r) * 6144 + c0 + t] = sm + p.b_mod[l * 6144 + c0 + t]; } }
      __syncthreads(); } }
}

template <int step = 1, int off = 0, int B1 = 1 << 30> __device__ void moe_weights_layer(const FP& p, int l, int t0, int t1, int b0, LAS unsigned char* lds) {
  int bid_ = (int)blockIdx.x; asm volatile("" : "+s"(bid_));
  LAS float* tile = (LAS float*)lds; const int me0 = bid_ - b0; if (me0 < 0 || bid_ >= B1 || (step > 1 && (me0 & (step - 1)) != off)) return;
  const int gtop = (int)gridDim.x < B1 ? (int)gridDim.x : B1;
  int me = step > 1 ? me0 >> (step == 2 ? 1 : 2) : me0; const int nb = step > 1 ? (gtop - b0 - off + step - 1) >> (step == 2 ? 1 : 2) : gtop - b0; if (nb <= 0) return;
  const int t = TIDX;
  auto src_of = [&](int sid, int& ld) -> const float* { const int id = sid * 4;
    if (id < NE * 512) { const int m = l * NE + id / 512, tt = id % 512, kt = tt / 32, nt = tt % 32; ld = 2048; return p.w_gate_up + (size_t)m * 1024 * 2048 + (size_t)(kt * 64) * 2048 + nt * 64; }
    const int r = id - NE * 512; const int m = l * NE + r / 256, tt = r % 256, kt = tt / 16, nt = tt % 16; ld = 1024; return p.w_down + (size_t)m * 1024 * 1024 + (size_t)(kt * 64) * 1024 + nt * 64; };
  auto load_strip = [&](int sid, f32x4 (&v)[8]) { int ld; const float* src = src_of(sid, ld);
#pragma unroll
    for (int i = 0; i < 8; ++i) { const int idx = t + 512 * i, tb = idx >> 10, q = idx & 1023, k = q >> 4, n4 = (q & 15) * 4; v[i] = *(const f32x4*)((const char*)src + (unsigned)(k * ld + tb * 64 + n4) * 4u); } };
  __syncthreads();
  const int s0 = t0 / 4 + me, s1 = t1 / 4;
  auto process = [&](int sid, const f32x4 (&v)[8]) {
#pragma unroll
    for (int i = 0; i < 8; ++i) { const int idx = t + 512 * i, tb = idx >> 10, q = idx & 1023, k = q >> 4, n4 = (q & 15) * 4; LAS float* tp = tile + tb * (64 * 65) + k * 65 + n4;
      tp[0] = v[i][0]; tp[1] = v[i][1]; tp[2] = v[i][2]; tp[3] = v[i][3]; }
    __syncthreads();
    { const int id = sid * 4, n = t >> 3, k8 = (t & 7) * 8;
      const bool gu = id < NE * 512; const int r = gu ? id : id - NE * 512; const int m = l * NE + (gu ? r / 512 : r / 256), tt = gu ? r % 512 : r % 256, kt = gu ? tt / 32 : tt / 16, nt = gu ? tt % 32 : tt % 16;
      bf16_t* dst = gu ? p.Wt_gu + (size_t)m * 2048 * 1024 : p.Wt_dn + (size_t)m * 1024 * 1024;
#pragma unroll
      for (int tb = 0; tb < 4; ++tb) { float o[8];
#pragma unroll
        for (int j = 0; j < 8; ++j) o[j] = tile[tb * (64 * 65) + (k8 + j) * 65 + n];
        u32x4 w; w.x = cvt_pk_bf16(o[0], o[1]); w.y = cvt_pk_bf16(o[2], o[3]); w.z = cvt_pk_bf16(o[4], o[5]); w.w = cvt_pk_bf16(o[6], o[7]);
        const int gn = (nt + tb) * 64 + n; int row;
        if (gu) { const int bj = gn >> 10, c = gn & 1023; row = (c >> 7) * 256 + bj * 128 + (c & 127); }
        else row = gn;
        *(u32x4*)((char*)dst + (unsigned)(row * 1024 + kt * 64 + k8) * 2u) = w; } }
    __syncthreads(); };
  f32x4 va[8], vb[8];
  if (s0 < s1) load_strip(s0, va);
#pragma unroll 1
  for (int sid = s0; sid < s1; sid += 2 * nb) {
    if (sid + nb < s1) load_strip(sid + nb, vb);
    process(sid, va);
    if (sid + nb >= s1) break;
    if (sid + 2 * nb < s1) load_strip(sid + 2 * nb, va);
    process(sid + nb, vb); }
}

struct MoeTab { LAS int* blk_e; LAS int* blk_j; LAS int* start; int nblk; };
__device__ __forceinline__ MoeTab moe_tables(const int* cntl, LAS unsigned char* misc) {
  MoeTab m; m.blk_e = (LAS int*)misc; m.blk_j = m.blk_e + MAXBLK; m.start = m.blk_j + MAXBLK;
  const int t = TIDX;
  __syncthreads();
  if (t < 64) { const int e = t & 31; const int nb = (__hip_atomic_load(&cntl[e], __ATOMIC_RELAXED, __HIP_MEMORY_SCOPE_AGENT) + 255) >> 8; int incl = nb;
#pragma unroll
    for (int o = 1; o < 32; o <<= 1) { const int v = shupi(incl, o); if ((t & 31) >= o) incl += v; }
    if (t < 32) { m.start[e] = incl - nb; if (e == 31) m.start[32] = incl; } }
  __syncthreads();
  m.nblk = m.start[32];
  for (int blk = t; blk < m.nblk; blk += NTHREADS) { int e = 0;
    while (m.start[e + 1] <= blk) ++e;
    m.blk_e[blk] = e; m.blk_j[blk] = blk - m.start[e]; }
  __syncthreads();
  return m;
}

__device__ __forceinline__ LAS int* moe_unit_list(const MoeTab& m, int NPN) {
  LAS int* ul = m.start + 40; const int t = TIDX;
  if (t < 32) { const int q = t * (int)gridDim.x + (int)blockIdx.x; const bool ok = q < m.nblk * NPN;
    if (ok) { ul[1 + 2 * t] = q / NPN; ul[2 + 2 * t] = q % NPN; }
    const unsigned long long bal = __ballot(ok); if (t == 0) ul[0] = __popcll(bal); }
  __syncthreads();
  return ul;
}

__device__ __forceinline__ float dpp_add(float v, int ctrl_is) { return v; }
#define DPP_F(v, ctrl) __int_as_float(__builtin_amdgcn_update_dpp(0, __float_as_int(v), (ctrl), 0xf, 0xf, false))
__device__ __forceinline__ float wave_sum(float v) {
  v += DPP_F(v, 0xB1); v += DPP_F(v, 0x4E); v += DPP_F(v, 0x141); v += DPP_F(v, 0x140);
  const float r0 = __uint_as_float(__builtin_amdgcn_readlane(__float_as_uint(v), 0)), r1 = __uint_as_float(__builtin_amdgcn_readlane(__float_as_uint(v), 16));
  const float r2 = __uint_as_float(__builtin_amdgcn_readlane(__float_as_uint(v), 32)), r3 = __uint_as_float(__builtin_amdgcn_readlane(__float_as_uint(v), 48));
  return (r0 + r1) + (r2 + r3); }

__device__ __forceinline__ void moe_combine_row(const FP& p, int lprev, int row, const LAS int* start, const float* gate, int lane, f32x4 (&x)[4]) {
  int sl[4]; float w[4];
#pragma unroll
  for (int k = 0; k < 4; ++k) { const int e = p.TOPE[row * 4 + k]; sl[k] = start[e] * 256 + p.TOPP[row * 4 + k]; w[k] = p.TOPW[row * 4 + k]; }
#pragma unroll
  for (int i = 0; i < 4; ++i) { f32x4 y = (f32x4){0.f, 0.f, 0.f, 0.f};
#pragma unroll
    for (int k = 0; k < 4; ++k) { const u32x2 v = *(const u32x2*)(p.YSb + (size_t)sl[k] * 1024 + i * 256 + lane * 4);
      y[0] += w[k] * bflo(v.x); y[1] += w[k] * bfhi(v.x); y[2] += w[k] * bflo(v.y); y[3] += w[k] * bfhi(v.y); }
    const f32x4 g = *(const f32x4*)(gate + i * 256 + lane * 4); x[i] = x[i] + g * y; }
}

template <bool DRY = false> __device__ void ph_norm1(const FP& p, int l, LAS unsigned char* lds) {
  const int t = TIDX, lane = t & 63, gw = blockIdx.x * NWAVES + (t >> 6), GWN = gridDim.x * NWAVES;
  MoeTab mt{}; if (l > 0) mt = moe_tables(p.cnt + (l - 1) * 32, lds + LDS_MISC);
  const float* MODl = p.MOD + (size_t)l * 5 * 6144; const float* MODp = p.MOD + (size_t)(l > 0 ? l - 1 : 0) * 5 * 6144; const float* g1 = p.g_norm1 + l * D;
  for (int row = gw; row < T; row += GWN) { const int b = row / SB, s = row % SB, r = s < CTX ? 4 : b;
    f32x4 x[4];
    { const float* src = l > 0 ? p.X + (size_t)row * D : (s < CTX ? p.ctx + ((size_t)b * CTX + s) * D : p.x + ((size_t)b * SEQ + (s - CTX)) * D);
#pragma unroll
      for (int i = 0; i < 4; ++i) x[i] = *(const f32x4*)(src + i * 256 + lane * 4); }
    if (l > 0) moe_combine_row(p, l - 1, row, mt.start, MODp + (size_t)r * 6144 + 5120, lane, x);
    if (!DRY) {
#pragma unroll
      for (int i = 0; i < 4; ++i) *(f32x4*)(p.X + (size_t)row * D + i * 256 + lane * 4) = x[i]; }
    float ss = 0.f;
#pragma unroll
    for (int i = 0; i < 4; ++i) ss += x[i][0] * x[i][0] + x[i][1] * x[i][1] + x[i][2] * x[i][2] + x[i][3] * x[i][3];
    ss = wave_sum(ss); const float rs = rsqrtf(ss * (1.f / 1024.f) + 1e-6f);
    const float* m = MODl + (size_t)r * 6144;
#pragma unroll
    for (int i = 0; i < 4; ++i) { const int c = i * 256 + lane * 4; const f32x4 g = *(const f32x4*)(g1 + c), sc = *(const f32x4*)(m + 1024 + c), sh = *(const f32x4*)(m + c);
      const f32x4 h = x[i] * rs * g * (sc + 1.f) + sh; u32x2 w; w.x = cvt_pk_bf16(h[0], h[1]); w.y = cvt_pk_bf16(h[2], h[3]);
      *(u32x2*)((DRY ? p.SCR : p.Hb) + (size_t)row * D + c) = w; } }
}

template <bool DRY = false> __device__ void ph_norm2(const FP& p, int l, LAS unsigned char* lds) {
  const int t = TIDX, lane = t & 63, gw = blockIdx.x * NWAVES + (t >> 6), GWN = gridDim.x * NWAVES;
  LAS float* wT = (LAS float*)lds;
  __syncthreads();
  { const float* wr = p.w_router + (size_t)l * D * NE;
    for (int i = t; i < D * NE / 4; i += NTHREADS) { const int c = i >> 3, e4 = (i & 7) * 4; const f32x4 v = *(const f32x4*)(wr + (size_t)c * NE + e4);
      wT[(e4 + 0) * 1024 + c] = v[0]; wT[(e4 + 1) * 1024 + c] = v[1]; wT[(e4 + 2) * 1024 + c] = v[2]; wT[(e4 + 3) * 1024 + c] = v[3]; } }
  __syncthreads();
  const float* MODl = p.MOD + (size_t)l * 5 * 6144; const float* g2 = p.g_norm2 + l * D; int* cntl = p.cnt + l * 32;
  const float myb = p.b_router[l * NE + (lane >> 1)];
  for (int row = gw; row < T; row += GWN) { const int b = row / SB, s = row % SB, r = s < CTX ? 4 : b;
    if (l == DEPTH - 1 && s < CTX) continue;
    f32x4 h[4]; float ss = 0.f;
#pragma unroll
    for (int i = 0; i < 4; ++i) { h[i] = *(const f32x4*)(p.X + (size_t)row * D + i * 256 + lane * 4); ss += h[i][0] * h[i][0] + h[i][1] * h[i][1] + h[i][2] * h[i][2] + h[i][3] * h[i][3]; }
    ss = wave_sum(ss); const float rs = rsqrtf(ss * (1.f / 1024.f) + 1e-6f);
    const float* m = MODl + (size_t)r * 6144;
#pragma unroll
    for (int i = 0; i < 4; ++i) { const int c = i * 256 + lane * 4; const f32x4 g = *(const f32x4*)(g2 + c), sc = *(const f32x4*)(m + 4096 + c), sh = *(const f32x4*)(m + 3072 + c);
      h[i] = h[i] * rs * g * (sc + 1.f) + sh; u32x2 w; w.x = cvt_pk_bf16(h[i][0], h[i][1]); w.y = cvt_pk_bf16(h[i][2], h[i][3]);
      *(u32x2*)((DRY ? p.SCR : p.H2b) + (size_t)row * D + c) = w; }
#ifdef PROBE_NOROUTER
    if (DRY) continue;
#endif
    float acc[32];
#pragma unroll
    for (int e = 0; e < 32; ++e) { float a = 0.f;
#pragma unroll
      for (int i = 0; i < 4; ++i) { const f32x4 w = *(const LAS f32x4*)(wT + e * 1024 + i * 256 + lane * 4); a += h[i][0] * w[0] + h[i][1] * w[1] + h[i][2] * w[2] + h[i][3] * w[3]; }
      acc[e] = a; }
#define BFLY(NV, BIT) { const bool up = (lane >> (BIT)) & 1; _Pragma("unroll") for (int e = 0; e < (NV) / 2; ++e) { const float a = acc[e], bq = acc[e + (NV) / 2]; const float keep = up ? bq : a, send = up ? a : bq; acc[e] = keep + shx(send, 1 << (BIT)); } }
    BFLY(32, 5) BFLY(16, 4) BFLY(8, 3) BFLY(4, 2) BFLY(2, 1)
#undef BFLY
    float v = acc[0] + shx(acc[0], 1); v += myb;
    float lg[32];
#pragma unroll
    for (int e = 0; e < 32; ++e) lg[e] = __uint_as_float(__builtin_amdgcn_readlane(__float_as_uint(v), 2 * e));
    float tv[4]; int ti[4];
#pragma unroll
    for (int k = 0; k < 4; ++k) { float bv = -3.0e38f; int bi = 0;
#pragma unroll
      for (int e = 0; e < 32; ++e) { if (lg[e] > bv) { bv = lg[e]; bi = e; } }
      tv[k] = bv; ti[k] = bi;
#pragma unroll
      for (int e = 0; e < 32; ++e) if (e == bi) lg[e] = -3.0e38f; }
    if (lane == 0) { float e4[4], sum = 0.f;
#pragma unroll
      for (int k = 0; k < 4; ++k) { e4[k] = expf(tv[k] - tv[0]); sum += e4[k]; }
      const float inv = 1.f / sum;
#pragma unroll
      for (int k = 0; k < 4; ++k) { if (DRY) { ((float*)p.SCR)[(size_t)T * 512 + row * 4 + k] = e4[k] * inv + (float)ti[k]; continue; } const int pos = atomicAdd(&cntl[ti[k]], 1); p.TOPE[row * 4 + k] = ti[k]; p.TOPP[row * 4 + k] = pos; p.TOPW[row * 4 + k] = e4[k] * inv; __hip_atomic_store(&p.ROWTOK[(size_t)ti[k] * T + pos], row, __ATOMIC_RELAXED, __HIP_MEMORY_SCOPE_AGENT);     } } }
}

__device__ void ph_final(const FP& p, LAS unsigned char* lds) {
  const int t = TIDX, lane = t & 63, gw = blockIdx.x * NWAVES + (t >> 6), GWN = gridDim.x * NWAVES;
  MoeTab mt = moe_tables(p.cnt + (DEPTH - 1) * 32, lds + LDS_MISC);
  const float* MODp = p.MOD + (size_t)(DEPTH - 1) * 5 * 6144;
  for (int orow = gw; orow < NB * SEQ; orow += GWN) { const int b = orow / SEQ, tk = orow % SEQ, row = b * SB + CTX + tk;
    f32x4 x[4];
#pragma unroll
    for (int i = 0; i < 4; ++i) x[i] = *(const f32x4*)(p.X + (size_t)row * D + i * 256 + lane * 4);
    moe_combine_row(p, DEPTH - 1, row, mt.start, MODp + (size_t)b * 6144 + 5120, lane, x);
    float ss = 0.f;
#pragma unroll
    for (int i = 0; i < 4; ++i) ss += x[i][0] * x[i][0] + x[i][1] * x[i][1] + x[i][2] * x[i][2] + x[i][3] * x[i][3];
    ss = wave_sum(ss); const float rs = rsqrtf(ss * (1.f / 1024.f) + 1e-6f);
#pragma unroll
    for (int i = 0; i < 4; ++i) { const int c = i * 256 + lane * 4; const f32x4 g = *(const f32x4*)(p.g_final + c); *(f32x4*)(p.out + (size_t)orow * D + c) = x[i] * rs * g; } }
}

__device__ void ph_inproj(const FP& p, int l, LAS unsigned char* lds) {
  Gemm g; g.A = p.Hb; g.Bt = p.Wt_in + (size_t)l * INWP * 1024; g.M = T; g.N = INWP; g.K = 1024;
  StaticOrder S; S.init(T, INWP, 1024, gridDim.x, blockIdx.x); EpiInproj E; E.O = p.Pb; E.GAB = p.GAB;
  gemm_phase<EpiInproj, StaticOrder>(lds, g, S, E);
}
__device__ void outproj_ctx(const FP& p, int l, LAS unsigned char* lds) {
  const int t = TIDX, w = t >> 6, lane = t & 63, c32 = lane & 31, hi = lane >> 5;
  const bf16_t* Bt = p.Wt_out + (size_t)l * 1024 * 1536; const float* gate = p.MOD + (size_t)l * 5 * 6144 + 4 * 6144 + 2048;
  LAS float* lf = (LAS float*)lds;
  for (int u = blockIdx.x; u < 256; u += gridDim.x) { const int cu = u >> 4, st = u & 15, batch = cu >> 2, pn = cu & 3, sr = st >> 2, sc = st & 3;
    const int r0 = batch * SB + 64 * sr, c0 = pn * 256 + 64 * sc;
    const bf16_t* ap = p.CATb + (size_t)(r0 + c32) * 1536 + 192 * w + 8 * hi; const bf16_t* bp = Bt + (size_t)(c0 + c32) * 1536 + 192 * w + 8 * hi;
    f32x16 acc[2][2];
#pragma unroll
    for (int m = 0; m < 2; ++m)
#pragma unroll
      for (int n = 0; n < 2; ++n)
#pragma unroll
        for (int r = 0; r < 16; ++r) acc[m][n][r] = 0.f;
#pragma unroll
    for (int sg = 0; sg < 3; ++sg) { bf16x8 af[2][4], bfr[2][4];
#pragma unroll
      for (int s = 0; s < 4; ++s)
#pragma unroll
        for (int m = 0; m < 2; ++m) { af[m][s] = *(const bf16x8*)(ap + (size_t)m * 32 * 1536 + (sg * 4 + s) * 16); bfr[m][s] = *(const bf16x8*)(bp + (size_t)m * 32 * 1536 + (sg * 4 + s) * 16); }
#pragma unroll
      for (int s = 0; s < 4; ++s)
#pragma unroll
        for (int m = 0; m < 2; ++m)
#pragma unroll
          for (int n = 0; n < 2; ++n) acc[m][n] = __builtin_amdgcn_mfma_f32_32x32x16_bf16(af[m][s], bfr[n][s], acc[m][n], 0, 0, 0); }
    __syncthreads();
#pragma unroll
    for (int m = 0; m < 2; ++m)
#pragma unroll
      for (int n = 0; n < 2; ++n)
#pragma unroll
        for (int r = 0; r < 16; ++r) lf[w * 4096 + (32 * m + crow16(r, hi)) * 64 + 32 * n + c32] = acc[m][n][r];
    __syncthreads();
    { const int row = t >> 3, col = (t & 7) * 8; f32x4 s0 = (f32x4){0.f, 0.f, 0.f, 0.f}, s1 = s0;
#pragma unroll
      for (int ww = 0; ww < 8; ++ww) { s0 = s0 + *(const LAS f32x4*)(lf + ww * 4096 + row * 64 + col); s1 = s1 + *(const LAS f32x4*)(lf + ww * 4096 + row * 64 + col + 4); }
      const f32x4 g0 = *(const f32x4*)(gate + c0 + col), g1 = *(const f32x4*)(gate + c0 + col + 4);
      float* xp = p.X + (size_t)(r0 + row) * D + c0 + col;
      *(f32x4*)xp = *(const f32x4*)xp + g0 * s0; *(f32x4*)(xp + 4) = *(const f32x4*)(xp + 4) + g1 * s1; }
    __syncthreads(); }
}
__device__ void ph_outproj(const FP& p, int l, LAS unsigned char* lds) {
  Gemm g; g.A = p.CATb; g.Bt = p.Wt_out + (size_t)l * 1024 * 1536; g.M = T; g.N = 1024; g.K = 1536;
  EpiOutproj E; E.X = p.X; E.MODl = p.MOD + (size_t)l * 5 * 6144;
  { LatentOrder S; S.nN = 4; S.G = gridDim.x; S.c = blockIdx.x; S.K = 1536; gemm_phase<EpiOutproj, LatentOrder>(lds, g, S, E); }
  if (l != DEPTH - 1) outproj_ctx(p, l, lds);
}
__device__ void ph_gemm1(const FP& p, int l, LAS unsigned char* lds) {
  MoeTab mt = moe_tables(p.cnt + l * 32, lds + LDS_MISC);
  Gemm g; g.A = p.H2b; g.Bt = p.Wt_gu + (size_t)l * NE * 2048 * 1024; g.M = 0; g.N = 2048; g.K = 1024;
  MoeOrder<true> S; S.nblk = mt.nblk; S.NPN = 8; S.G = gridDim.x; S.c = blockIdx.x; S.K = 1024; S.blk_e = mt.blk_e; S.blk_j = mt.blk_j; S.ulist = moe_unit_list(mt, 8); S.rowtok = p.ROWTOK; S.cnt = p.cnt + l * 32; S.bstride = (long)2048 * 1024 * 2;
  EpiGateUp E; E.ACT = p.ACTb; E.bgu = p.b_gate_up + (size_t)l * NE * 2048;
  gemm_phase<EpiGateUp, MoeOrder<true>>(lds, g, S, E);
}
__device__ void ph_gemm2(const FP& p, int l, LAS unsigned char* lds) {
  MoeTab mt = moe_tables(p.cnt + l * 32, lds + LDS_MISC);
  Gemm g; g.A = p.ACTb; g.Bt = p.Wt_dn + (size_t)l * NE * 1024 * 1024; g.M = 0; g.N = 1024; g.K = 1024;
  MoeOrder<false> S; S.nblk = mt.nblk; S.NPN = 4; S.G = gridDim.x; S.c = blockIdx.x; S.K = 1024; S.blk_e = mt.blk_e; S.blk_j = mt.blk_j; S.ulist = moe_unit_list(mt, 4); S.rowtok = nullptr; S.cnt = p.cnt + l * 32; S.bstride = (long)1024 * 1024 * 2;
  EpiDown E; E.YS = p.YSb; E.bdn = p.b_down + (size_t)l * NE * 1024;
  gemm_phase<EpiDown, MoeOrder<false>>(lds, g, S, E);
}
constexpr float QSCALE = 0.07216878364870322f * 1.4426950408889634f;

__device__ __forceinline__ void prep_mla_row(const FP& p, int l, int row, int lane) {
  const int s = row % SB; const bool lat = s >= CTX; const int tok = s - CTX;
  const bf16_t* pr = p.Pb + (size_t)row * INWP;
  { const u32x2 v = *(const u32x2*)(pr + C_DQ + lane * 4); float x[4] = {bflo(v.x), bfhi(v.x), bflo(v.y), bfhi(v.y)};
    const float ss = wave_sum(x[0] * x[0] + x[1] * x[1] + x[2] * x[2] + x[3] * x[3]); const float rs = rsqrtf(ss * (1.f / 256.f) + 1e-6f);
    const f32x4 g = *(const f32x4*)(p.g_cq + l * 256 + lane * 4); u32x2 w; w.x = cvt_pk_bf16(x[0] * rs * g[0], x[1] * rs * g[1]); w.y = cvt_pk_bf16(x[2] * rs * g[2], x[3] * rs * g[3]);
    *(u32x2*)(p.A2b + (size_t)row * MLAK + lane * 4) = w; }
  { const unsigned v = *(const unsigned*)(pr + C_DKV + lane * 2); const float x0 = bflo(v), x1 = bfhi(v);
    const float ss = wave_sum(x0 * x0 + x1 * x1); const float rs = rsqrtf(ss * (1.f / 128.f) + 1e-6f);
    const float g0 = p.g_ckv[l * 128 + lane * 2], g1 = p.g_ckv[l * 128 + lane * 2 + 1];
    *(unsigned*)(p.A2b + (size_t)row * MLAK + 256 + lane * 2) = cvt_pk_bf16(x0 * rs * g0, x1 * rs * g1); }
  { const float x = bf2f(pr[C_KR + lane]); const float xp = shx(x, 16); float y = x;
    if (lat) { const int hh = lane >> 5, ii = lane & 31, fi = ii & 15; const float pos = (float)(hh == 0 ? (tok >> 6) : (tok & 63));
      const float ang = pos * __expf(-(float)fi * (9.210340371976184f / 16.f)); const float cs = __cosf(ang), sn = __sinf(ang);
      y = ii < 16 ? x * cs - xp * sn : x * cs + xp * sn; }
    unsigned u = __float_as_uint(y); u += 0x7fffu + ((u >> 16) & 1u); p.KRb[(size_t)row * 64 + lane] = (bf16_t)(u >> 16); }
}

struct EpiMla {
    static constexpr bool PERM = false;
    bf16_t *Q, *Kn, *V; const float* ROPE;
    __device__ __forceinline__ void operator()(const f32x4 (&acc)[2][2][4][2], const Unit& u, int wr, int wc, int fr, int fq) const {
        const int row0 = u.pm * BM + wr * 64 + fr; const bool ctxt = (u.pm % 17) == 0; const int tok0 = (u.pm % 17 - 1) * 256 + wr * 64 + fr;
        if (u.pn < 3) {
#pragma unroll
            for (int bj = 0; bj < 2; ++bj) { const int cg = u.pn * 256 + bj * 128 + wc * 32;
                const int g6 = (cg >> 5) % 6;
#pragma unroll
                for (int ai = 0; ai < 2; ++ai)
#pragma unroll
                    for (int m = 0; m < 4; ++m) { const int row = row0 + ai * HALF + m * 16; f32x4 v0 = acc[ai][bj][m][0], v1 = acc[ai][bj][m][1];
                        if (g6 >= 4 && !ctxt) { const int tok = tok0 + ai * HALF + m * 16; const int pos = g6 == 4 ? (tok >> 6) : (tok & 63);
                            const f32x4 cs = *(const f32x4*)(ROPE + pos * 32 + 4 * fq), sn = *(const f32x4*)(ROPE + pos * 32 + 16 + 4 * fq);
#pragma unroll
                            for (int j = 0; j < 4; ++j) { const float x1 = v0[j], x2 = v1[j]; v0[j] = x1 * cs[j] - x2 * sn[j]; v1[j] = x2 * cs[j] + x1 * sn[j]; } }
                        v0 = v0 * QSCALE; v1 = v1 * QSCALE;
                        bf16_t* qp = Q + (size_t)row * 768 + cg + 4 * fq; u32x2 w0, w1; w0.x = cvt_pk_bf16(v0[0], v0[1]); w0.y = cvt_pk_bf16(v0[2], v0[3]); w1.x = cvt_pk_bf16(v1[0], v1[1]); w1.y = cvt_pk_bf16(v1[2], v1[3]);
                        *(u32x2*)qp = w0; *(u32x2*)(qp + 16) = w1; } }
        } else { const int h = u.pn - 3;
#pragma unroll
            for (int bj = 0; bj < 2; ++bj) { bf16_t* base = (bj == 0 ? Kn : V) + h * 128 + wc * 32 + 4 * fq;
#pragma unroll
                for (int ai = 0; ai < 2; ++ai)
#pragma unroll
                    for (int m = 0; m < 4; ++m) { const int row = row0 + ai * HALF + m * 16; const f32x4 v0 = acc[ai][bj][m][0], v1 = acc[ai][bj][m][1];
                        u32x2 w0, w1; w0.x = cvt_pk_bf16(v0[0], v0[1]); w0.y = cvt_pk_bf16(v0[2], v0[3]); w1.x = cvt_pk_bf16(v1[0], v1[1]); w1.y = cvt_pk_bf16(v1[2], v1[3]);
                        *(u32x2*)(base + (size_t)row * 512) = w0; *(u32x2*)(base + (size_t)row * 512 + 16) = w1; } } }
    }
};
__device__ void ph_mla_gemm(const FP& p, int l, LAS unsigned char* lds) {
  Gemm g; g.A = p.A2b; g.Bt = p.Wt_mla + (size_t)l * MLAN * MLAK; g.M = T; g.N = MLAN; g.K = MLAK;
  StaticOrder S; S.init(T, MLAN, MLAK, gridDim.x, blockIdx.x); EpiMla E; E.Q = p.Qb; E.Kn = p.Knb; E.V = p.Vb; E.ROPE = p.ROPE;
  gemm_phase<EpiMla, StaticOrder>(lds, g, S, E);
}

namespace att {
constexpr int NW = 8, QBLK = 32, KVBLK = 64;
constexpr float THRL = 8.f * 1.4426950408889634f;
constexpr int SHM_V = KVBLK * 128 * 2, SHM_K = KVBLK * 128 * 2, SHM_R = KVBLK * 64 * 2;
constexpr int OFF_V = 0, OFF_K = 2 * SHM_V, OFF_R = OFF_K + 2 * SHM_K, OFF_WS = OFF_R + 2 * SHM_R, OFF_Q = OFF_WS + NW * 64 * 4, SHM_ATTN = OFF_Q + 256 * 128;
#define KSWZ(row, colB) ((row) * 256 + ((colB) ^ (((row) & 7) << 4)))
#define RSWZ(row, colB) ((row) * 128 + ((colB) ^ ((((row) >> 1) & 7) << 4)))
#define SBAR() __builtin_amdgcn_sched_barrier(0)
__device__ __forceinline__ int crow(int r, int hi) { return (r & 3) + 8 * (r >> 2) + 4 * hi; }
__device__ __forceinline__ void partialSM(f32x16& p0, f32x16& p1, float& m_reg, float& mn, float& alpha) {
  float pmax = p0[0];
#pragma unroll
  for (int r = 1; r < 16; ++r) pmax = fmaxf(pmax, p0[r]);
#pragma unroll
  for (int r = 0; r < 16; ++r) pmax = fmaxf(pmax, p1[r]);
  { auto rr = __builtin_amdgcn_permlane32_swap(__float_as_uint(pmax), __float_as_uint(pmax), false, false); pmax = fmaxf(__uint_as_float(rr[0]), __uint_as_float(rr[1])); }
  if (__builtin_expect(__all(pmax - m_reg <= THRL), 1)) { mn = m_reg; alpha = 1.f; }
  else { mn = fmaxf(m_reg, pmax); alpha = __builtin_amdgcn_exp2f(m_reg - mn); m_reg = mn; }
#pragma unroll
  for (int r = 0; r < 16; ++r) p0[r] = p0[r] - mn;
#pragma unroll
  for (int r = 0; r < 16; ++r) p1[r] = p1[r] - mn;
#pragma unroll
  for (int r = 0; r < 16; ++r) p0[r] = __builtin_amdgcn_exp2f(p0[r]);
}
__device__ __forceinline__ void finishSM(f32x16& p0, f32x16& p1, float alpha, float& l_reg, bf16x8& pa0, bf16x8& pa1, bf16x8& pa2, bf16x8& pa3) {
#pragma unroll
  for (int r = 0; r < 16; ++r) p1[r] = __builtin_amdgcn_exp2f(p1[r]);
  float ps = 0;
#pragma unroll
  for (int r = 0; r < 16; ++r) ps += p0[r];
#pragma unroll
  for (int r = 0; r < 16; ++r) ps += p1[r];
  { auto rr = __builtin_amdgcn_permlane32_swap(__float_as_uint(ps), __float_as_uint(ps), false, false); ps = __uint_as_float(rr[0]) + __uint_as_float(rr[1]); }
  l_reg = l_reg * alpha + ps;
#define PK4(P, BASE, OUT) do { unsigned a0 = cvt_pk_bf16(P[BASE + 0], P[BASE + 1]), a1 = cvt_pk_bf16(P[BASE + 2], P[BASE + 3]);   \
    unsigned b0 = cvt_pk_bf16(P[BASE + 4], P[BASE + 5]), b1 = cvt_pk_bf16(P[BASE + 6], P[BASE + 7]);                              \
    auto r0 = __builtin_amdgcn_permlane32_swap(a0, b0, false, false); auto r1 = __builtin_amdgcn_permlane32_swap(a1, b1, false, false); \
    u32x4 w = {r0[0], r1[0], r0[1], r1[1]}; OUT = *reinterpret_cast<bf16x8*>(&w); } while (0)
  PK4(p0, 0, pa0); PK4(p0, 8, pa1); PK4(p1, 0, pa2); PK4(p1, 8, pa3);
#undef PK4
}
__device__ __forceinline__ void qkt(f32x16& p0, f32x16& p1, const char* Ks, const char* Rs, const bf16x8* qr, const char* qrow, int qsw, int r32, int hi) {
  p0 = f32x16{}; p1 = f32x16{};
#pragma unroll
  for (int d0 = 0; d0 < 8; ++d0) { const int cb = (d0 * 16 + hi * 8) * 2;
    const bf16x8 b0 = *reinterpret_cast<const bf16x8*>(Ks + KSWZ(r32, cb));
    const bf16x8 b1 = *reinterpret_cast<const bf16x8*>(Ks + KSWZ(32 + r32, cb));
    p0 = __builtin_amdgcn_mfma_f32_32x32x16_bf16(b0, qr[d0], p0, 0, 0, 0);
    p1 = __builtin_amdgcn_mfma_f32_32x32x16_bf16(b1, qr[d0], p1, 0, 0, 0); }
#pragma unroll
  for (int d0 = 0; d0 < 4; ++d0) { const int cb = (d0 * 16 + hi * 8) * 2;
    const bf16x8 b0 = *reinterpret_cast<const bf16x8*>(Rs + RSWZ(r32, cb));
    const bf16x8 b1 = *reinterpret_cast<const bf16x8*>(Rs + RSWZ(32 + r32, cb));
    const bf16x8 qf = *reinterpret_cast<const bf16x8*>(qrow + (cb ^ qsw));
    p0 = __builtin_amdgcn_mfma_f32_32x32x16_bf16(b0, qf, p0, 0, 0, 0);
    p1 = __builtin_amdgcn_mfma_f32_32x32x16_bf16(b1, qf, p1, 0, 0, 0); }
}
__device__ __forceinline__ int v_st(int k, int c) { const int kk = (k & ~0xC) | ((k & 4) << 1) | ((k & 8) >> 1); return ((kk >> 3) * 4 + (c >> 5)) * 512 + ((kk & 7) * 32 + (c & 31)) * 2; }
__device__ __forceinline__ int v_rd_base(int lane) { return ((lane & 3) << 3) | (((lane >> 2) & 3) << 6) | (((lane >> 4) & 1) << 5) | (((lane >> 5) & 1) << 8); }
constexpr int v_rd_off(int d0, int ks, int half) { return d0 * 512 + ks * 4096 + half * 2048; }
template <int OFF> __device__ __forceinline__ s16x4 tr_read(int vb) { s16x4 r; asm volatile("ds_read_b64_tr_b16 %0, %1 offset:%2" : "=&v"(r) : "v"(vb), "i"(OFF) : "memory"); return r; }
template <int D0> __device__ __forceinline__ void pv_one(f32x16& od, int vb, bf16x8 pa0, bf16x8 pa1, bf16x8 pa2, bf16x8 pa3) {
  const s16x4 l0 = tr_read<v_rd_off(D0, 0, 0)>(vb), h0 = tr_read<v_rd_off(D0, 0, 1)>(vb), l1 = tr_read<v_rd_off(D0, 1, 0)>(vb), h1 = tr_read<v_rd_off(D0, 1, 1)>(vb);
  const s16x4 l2 = tr_read<v_rd_off(D0, 2, 0)>(vb), h2 = tr_read<v_rd_off(D0, 2, 1)>(vb), l3 = tr_read<v_rd_off(D0, 3, 0)>(vb), h3 = tr_read<v_rd_off(D0, 3, 1)>(vb);
  asm volatile("s_waitcnt lgkmcnt(0)" ::: "memory"); SBAR();
#define PK(L, H) (bf16x8){L[0], L[1], L[2], L[3], H[0], H[1], H[2], H[3]}
  od = __builtin_amdgcn_mfma_f32_32x32x16_bf16(pa0, PK(l0, h0), od, 0, 0, 0);
  od = __builtin_amdgcn_mfma_f32_32x32x16_bf16(pa1, PK(l1, h1), od, 0, 0, 0);
  od = __builtin_amdgcn_mfma_f32_32x32x16_bf16(pa2, PK(l2, h2), od, 0, 0, 0);
  od = __builtin_amdgcn_mfma_f32_32x32x16_bf16(pa3, PK(l3, h3), od, 0, 0, 0);
#undef PK
}
__device__ __forceinline__ void pv_d0(f32x16* o, int vb, bf16x8 pa0, bf16x8 pa1, bf16x8 pa2, bf16x8 pa3) {
  pv_one<0>(o[0], vb, pa0, pa1, pa2, pa3); pv_one<1>(o[1], vb, pa0, pa1, pa2, pa3); pv_one<2>(o[2], vb, pa0, pa1, pa2, pa3); pv_one<3>(o[3], vb, pa0, pa1, pa2, pa3);
}
template <bool PARTIAL = false> __device__ __forceinline__ void attn_body(const bf16_t* __restrict__ Qb, const bf16_t* __restrict__ Kh, const bf16_t* __restrict__ Rh, const bf16_t* __restrict__ Vh,
                                          bf16_t* __restrict__ Ob, int seq, char* lds, float* __restrict__ PO = nullptr, float* __restrict__ PML = nullptr) {
  const int tid = TIDX, wid = tid >> 6, lane = tid & 63, r32 = lane & 31, hi = lane >> 5;
  char* V_lds = lds + OFF_V; char* K_lds = lds + OFF_K; char* R_lds = lds + OFF_R;
  float* ws = (float*)(lds + OFF_WS) + wid * 64; float* li_l = ws; float* al_l = ws + 32;
  float m_reg = -1e30f, l_reg = 0; f32x16 o[4] = {}; bf16x8 qr[8];
  const bf16_t* Qw = Qb + (size_t)(wid * QBLK + r32) * 768 + hi * 8;
#pragma unroll
  for (int d0 = 0; d0 < 8; ++d0) qr[d0] = *reinterpret_cast<const bf16x8*>(Qw + d0 * 16);
  const int qrowi = wid * QBLK + r32; char* qrow = lds + OFF_Q + qrowi * 128; const int qsw = ((qrowi >> 1) & 7) << 4;
#pragma unroll
  for (int d0 = 0; d0 < 4; ++d0) *reinterpret_cast<bf16x8*>(qrow + (((d0 * 16 + hi * 8) * 2) ^ qsw)) = *reinterpret_cast<const bf16x8*>(Qw + (8 + d0) * 16);
  const int sr = tid >> 4, sc = (tid & 15) * 8, vst0 = v_st(sr, sc), vst1 = v_st(32 + sr, sc);
  const int rr = tid >> 3, rc = (tid & 7) * 8;
  const int vb0 = (int)(uintptr_t)V_lds + v_rd_base(lane);
  bf16x8 vs0, vs1, ks0, ks1, rs0;
  const unsigned kvo0 = (unsigned)(sr * 512 + sc) * 2u, kvo1 = kvo0 + 32u * 512u * 2u, ro0 = (unsigned)(rr * 64 + rc) * 2u;
#define SLOAD(k0) do { const char* Vt = (const char*)Vh + (size_t)(k0) * 1024; const char* Kt = (const char*)Kh + (size_t)(k0) * 1024; const char* Rt = (const char*)Rh + (size_t)(k0) * 128; \
    vs0 = *(const bf16x8*)(Vt + kvo0); vs1 = *(const bf16x8*)(Vt + kvo1); ks0 = *(const bf16x8*)(Kt + kvo0); ks1 = *(const bf16x8*)(Kt + kvo1); rs0 = *(const bf16x8*)(Rt + ro0); } while (0)
#define SWRITE(b) do { *(bf16x8*)(V_lds + (b) * SHM_V + vst0) = vs0; *(bf16x8*)(V_lds + (b) * SHM_V + vst1) = vs1; const int kc = sc * 2; \
    *(bf16x8*)(K_lds + (b) * SHM_K + KSWZ(sr, kc)) = ks0; *(bf16x8*)(K_lds + (b) * SHM_K + KSWZ(32 + sr, kc)) = ks1; \
    *(bf16x8*)(R_lds + (b) * SHM_R + RSWZ(rr, rc * 2)) = rs0; } while (0)
#define SWAIT() asm volatile("s_waitcnt vmcnt(0)" ::: "memory")
#define RESC(a) do { if (__any((a) < 1.f)) { if (hi == 0) al_l[r32] = (a); asm volatile("s_waitcnt lgkmcnt(0)" ::: "memory"); \
    _Pragma("unroll") for (int d = 0; d < 4; ++d) _Pragma("unroll") for (int r = 0; r < 16; ++r) o[d][r] *= al_l[crow(r, hi)]; } } while (0)
  f32x16 pA0, pA1, pB0, pB1; float mnA, mnB, alA, alB; bf16x8 pa0, pa1, pa2, pa3; const int NT = seq / KVBLK;
  SLOAD(0); SWAIT(); SWRITE(0); __syncthreads();
  qkt(pA0, pA1, K_lds, R_lds, qr, qrow, qsw, r32, hi); partialSM(pA0, pA1, m_reg, mnA, alA);
  SLOAD(KVBLK);
  SWAIT(); SWRITE(1); __syncthreads();
  for (int j = 1; j + 1 < NT; j += 2) {
    SBAR(); qkt(pB0, pB1, K_lds + SHM_K, R_lds + SHM_R, qr, qrow, qsw, r32, hi);
    finishSM(pA0, pA1, alA, l_reg, pa0, pa1, pa2, pa3); SBAR();
    SLOAD((j + 1) * KVBLK); SBAR();
    pv_d0(o, vb0, pa0, pa1, pa2, pa3); partialSM(pB0, pB1, m_reg, mnB, alB);
    __syncthreads(); SWAIT(); SWRITE(0);
    RESC(alB); __syncthreads();
    SBAR(); qkt(pA0, pA1, K_lds, R_lds, qr, qrow, qsw, r32, hi);
    finishSM(pB0, pB1, alB, l_reg, pa0, pa1, pa2, pa3); SBAR();
    SLOAD((j + 2) * KVBLK); SBAR();
    pv_d0(o, vb0 + SHM_V, pa0, pa1, pa2, pa3); partialSM(pA0, pA1, m_reg, mnA, alA);
    __syncthreads(); SWAIT(); SWRITE(1);
    RESC(alA); __syncthreads();
  }
  SBAR(); qkt(pB0, pB1, K_lds + SHM_K, R_lds + SHM_R, qr, qrow, qsw, r32, hi);
  finishSM(pA0, pA1, alA, l_reg, pa0, pa1, pa2, pa3); SBAR();
  pv_d0(o, vb0, pa0, pa1, pa2, pa3); partialSM(pB0, pB1, m_reg, mnB, alB);
  __syncthreads(); RESC(alB);
  finishSM(pB0, pB1, alB, l_reg, pa0, pa1, pa2, pa3); SBAR();
  pv_d0(o, vb0 + SHM_V, pa0, pa1, pa2, pa3);
  if (PARTIAL) { int tz = TIDX; const int wz = tz >> 6, lz = tz & 63;
    if ((lz >> 5) == 0) { PML[wz * QBLK + lz] = m_reg; PML[256 + wz * QBLK + lz] = l_reg; }
    float* po = PO + (size_t)(wz * QBLK + 4 * (lz >> 5)) * 128 + (lz & 31);
#pragma unroll
    for (int r = 0; r < 16; ++r)
#pragma unroll
      for (int d0 = 0; d0 < 4; ++d0) po[((r & 3) + 8 * (r >> 2)) * 128 + d0 * 32] = o[d0][r];
    __syncthreads(); return; }
  if (hi == 0) li_l[r32] = l_reg; asm volatile("s_waitcnt lgkmcnt(0)" ::: "memory");
  float rli[16];
#pragma unroll
  for (int r = 0; r < 16; ++r) rli[r] = __builtin_amdgcn_rcpf(li_l[crow(r, hi)]);
  { int tz = TIDX; const int wz = tz >> 6, lz = tz & 63; const unsigned ob = (unsigned)((wz * QBLK + 4 * (lz >> 5)) * 512 + (lz & 31)) * 2u;
#pragma unroll
    for (int r = 0; r < 16; ++r) {
#pragma unroll
      for (int d0 = 0; d0 < 4; ++d0) { unsigned u = __float_as_uint(o[d0][r] * rli[r]); u += 0x7fffu + ((u >> 16) & 1u);
        *(bf16_t*)((char*)Ob + ob + (unsigned)((((r & 3) + 8 * (r >> 2)) * 512 + d0 * 32) * 2)) = (bf16_t)(u >> 16); } } }
  __syncthreads();
#undef SLOAD
#undef SWRITE
#undef SWAIT
#undef RESC
}
}

constexpr int ATT_NSPLIT = 64, ATT_NPART = 3;
__device__ __forceinline__ float* att_po(const FP& p, int j) { return (float*)p.SCR + (size_t)j * 32768; }
__device__ __forceinline__ float* att_pml(const FP& p, int j) { return (float*)p.SCR + (size_t)ATT_NSPLIT * ATT_NPART * 32768 + (size_t)j * 512; }
__device__ void ph_attn(const FP& p, int l, char* shm) {
  const int nctx = (l == DEPTH - 1) ? 0 : NB * 4;
  const int G = gridDim.x, me = (int)blockIdx.x - 64, nb = G - 64; if (me < 0) return;
  for (int u = 64 + me; u < NB * 4 * 16; u += nb) { const int b = u >> 6, h = (u >> 4) & 3, qoff = CTX + (u & 15) * 256; const size_t r0 = (size_t)b * SB, q0 = r0 + qoff;
    att::attn_body<false>(p.Qb + q0 * 768 + h * 192, p.Knb + r0 * 512 + h * 128, p.KRb + r0 * 64, p.Vb + r0 * 512 + h * 128, p.AOb + q0 * 512 + h * 128, SB, shm); }
  for (int j = me; j < ATT_NSPLIT * ATT_NPART; j += nb) { const int u = j / ATT_NPART, part = j % ATT_NPART, h = (u >> 4) & 3, qoff = CTX + (u & 15) * 256; const size_t q0 = qoff;
    const int k0 = part == 0 ? 0 : 1536 + (part - 1) * 1408, len = part == 0 ? 1536 : 1408;
    att::attn_body<true>(p.Qb + q0 * 768 + h * 192, p.Knb + (size_t)k0 * 512 + h * 128, p.KRb + (size_t)k0 * 64, p.Vb + (size_t)k0 * 512 + h * 128, nullptr, len, shm, att_po(p, j), att_pml(p, j)); }
  for (int uu = me; uu < nctx; uu += nb) { const int b = uu >> 2, h = uu & 3; const size_t r0 = (size_t)b * SB;
    att::attn_body<false>(p.Qb + r0 * 768 + h * 192, p.Knb + r0 * 512 + h * 128, p.KRb + r0 * 64, p.Vb + r0 * 512 + h * 128, p.AOb + r0 * 512 + h * 128, CTX, shm); }
}

__device__ __forceinline__ void mla_out_row(const FP& p, int l, int row, int lane) {
  float x[8]; float ss = 0.f;
  if (row >= CTX && row < CTX + ATT_NSPLIT * 64) {
    const int tok = row - CTX, u = (lane >> 4) * 16 + (tok >> 8), qr = tok & 255; float m[ATT_NPART], lsum[ATT_NPART], M = -3.0e38f;
#pragma unroll
    for (int j = 0; j < ATT_NPART; ++j) { const float* ml = att_pml(p, u * ATT_NPART + j); m[j] = ml[qr]; lsum[j] = ml[256 + qr]; M = fmaxf(M, m[j]); }
    float L = 0.f;
#pragma unroll
    for (int e = 0; e < 8; ++e) x[e] = 0.f;
#pragma unroll
    for (int j = 0; j < ATT_NPART; ++j) { const float wj = __builtin_amdgcn_exp2f(m[j] - M); L += wj * lsum[j]; const float* po = att_po(p, u * ATT_NPART + j) + (size_t)qr * 128 + (lane & 15) * 8;
      const f32x4 a = *(const f32x4*)po, b2 = *(const f32x4*)(po + 4);
      x[0] += wj * a[0]; x[1] += wj * a[1]; x[2] += wj * a[2]; x[3] += wj * a[3]; x[4] += wj * b2[0]; x[5] += wj * b2[1]; x[6] += wj * b2[2]; x[7] += wj * b2[3]; }
    const float rl = 1.f / L;
#pragma unroll
    for (int e = 0; e < 8; ++e) x[e] = bf2f(f2bf(x[e] * rl));
  } else { const u32x4 v = *(const u32x4*)(p.AOb + (size_t)row * 512 + lane * 8);
    x[0] = bflo(v.x); x[1] = bfhi(v.x); x[2] = bflo(v.y); x[3] = bfhi(v.y); x[4] = bflo(v.z); x[5] = bfhi(v.z); x[6] = bflo(v.w); x[7] = bfhi(v.w); }
#pragma unroll
  for (int j = 0; j < 8; ++j) ss += x[j] * x[j];
  ss = wave_sum(ss); const float rs = rsqrtf(ss * (1.f / 512.f) + 1e-6f);
  const f32x4 g0 = *(const f32x4*)(p.g_mla + l * 512 + lane * 8), g1 = *(const f32x4*)(p.g_mla + l * 512 + lane * 8 + 4);
  u32x4 w; w.x = cvt_pk_bf16(x[0] * rs * g0[0], x[1] * rs * g0[1]); w.y = cvt_pk_bf16(x[2] * rs * g0[2], x[3] * rs * g0[3]);
  w.z = cvt_pk_bf16(x[4] * rs * g1[0], x[5] * rs * g1[1]); w.w = cvt_pk_bf16(x[6] * rs * g1[2], x[7] * rs * g1[3]);
  *(u32x4*)(p.CATb + (size_t)row * 1536 + lane * 8) = w;
}
constexpr int NCH = SB / 64;
__device__ __forceinline__ int item_idx(int dir, int bh, int cn) { return (dir * 16 + bh) * NCH + cn; }
__device__ __forceinline__ int scan_chunk(int dir, int n) { return dir == 0 ? n : (n < 4 ? 3 - n : 71 - n); }

__device__ __forceinline__ void prep_ret_row(const FP& p, int row, int lane) {
  const int s = row % SB; const bool lat = s >= CTX; const int tok = s - CTX;
  const bf16_t* pr = p.Pb + (size_t)row * INWP;
  const u32x4 qv = *(const u32x4*)(pr + C_RQ + lane * 8), kv = *(const u32x4*)(pr + C_RK + lane * 8);
  float q[8] = {bflo(qv.x), bfhi(qv.x), bflo(qv.y), bfhi(qv.y), bflo(qv.z), bfhi(qv.z), bflo(qv.w), bfhi(qv.w)};
  float k[8] = {bflo(kv.x), bfhi(kv.x), bflo(kv.y), bfhi(kv.y), bflo(kv.z), bfhi(kv.z), bflo(kv.w), bfhi(kv.w)};
  float qo[8], ko[8];
  const bool lowh = (lane & 4) == 0;
  const float pos = (float)(((lane >> 3) & 1) == 0 ? (tok >> 6) : (tok & 63));
#pragma unroll
  for (int e = 0; e < 8; ++e) { const float qp = shx(q[e], 4), kp = shx(k[e], 4);
    if (lat) { const int fi = (lane & 3) * 8 + e; const float ang = pos * __expf(-(float)fi * (9.210340371976184f / 32.f)); const float cs = __cosf(ang), sn = __sinf(ang);
      qo[e] = lowh ? q[e] * cs - qp * sn : q[e] * cs + qp * sn; ko[e] = lowh ? k[e] * cs - kp * sn : k[e] * cs + kp * sn; }
    else { qo[e] = q[e]; ko[e] = k[e]; } }
  const float sc = 0.08838834764831845f;
  u32x4 wq, wk; wq.x = cvt_pk_bf16(qo[0], qo[1]); wq.y = cvt_pk_bf16(qo[2], qo[3]); wq.z = cvt_pk_bf16(qo[4], qo[5]); wq.w = cvt_pk_bf16(qo[6], qo[7]);
  wk.x = cvt_pk_bf16(ko[0] * sc, ko[1] * sc); wk.y = cvt_pk_bf16(ko[2] * sc, ko[3] * sc); wk.z = cvt_pk_bf16(ko[4] * sc, ko[5] * sc); wk.w = cvt_pk_bf16(ko[6] * sc, ko[7] * sc);
  *(u32x4*)(p.RQb + (size_t)row * 512 + lane * 8) = wq; *(u32x4*)(p.RKb + (size_t)row * 512 + lane * 8) = wk;
}

__device__ __forceinline__ void r2_item(const FP& p, int l, int bh, int cn, int t, LAS unsigned char* hl) {
  const int b = bh >> 2, h = bh & 3; const size_t row0 = (size_t)b * SB + cn * 64;
  LAS bf16_t* sk = (LAS bf16_t*)hl; LAS bf16_t* sv = sk + 64 * 136;
#pragma unroll
  for (int i = 0; i < 4; ++i) { const int idx = t + 256 * i, r = idx >> 4, c8 = (idx & 15) * 8;
    *(LAS u32x4*)(sk + r * 136 + c8) = *(const u32x4*)(p.RKb + (row0 + r) * 512 + h * 128 + c8);
    *(LAS u32x4*)(sv + r * 136 + c8) = *(const u32x4*)(p.Pb + (row0 + r) * INWP + C_RV + h * 128 + c8); }
  __syncthreads();
  const float lgf = __log2f(1.f - __expf(p.ret_decay[l * 8 + h])), lgb = __log2f(1.f - __expf(p.ret_decay[l * 8 + 4 + h]));
#pragma unroll
  for (int q = 0; q < 4; ++q) { const int sidx = t + 256 * q, f = sidx >> 6, ln = sidx & 63, tt = f >> 2, s = f & 3, c = tt * 32 + (ln & 31), hh = ln >> 5;
    { float kf[8];
#pragma unroll
      for (int jj = 0; jj < 8; ++jj) kf[jj] = bf2f(sk[(16 * s + 8 * hh + jj) * 136 + c]);
      u32x4 wf, wb; unsigned tmpf[4], tmpb[4];
#pragma unroll
      for (int jp = 0; jp < 4; ++jp) { const int j0 = 16 * s + 8 * hh + 2 * jp;
        tmpf[jp] = cvt_pk_bf16(kf[2 * jp] * exp2f(lgf * (float)(63 - j0)), kf[2 * jp + 1] * exp2f(lgf * (float)(62 - j0)));
        tmpb[jp] = cvt_pk_bf16(kf[2 * jp] * exp2f(lgb * (float)j0), kf[2 * jp + 1] * exp2f(lgb * (float)(j0 + 1))); }
      wf.x = tmpf[0]; wf.y = tmpf[1]; wf.z = tmpf[2]; wf.w = tmpf[3]; wb.x = tmpb[0]; wb.y = tmpb[1]; wb.z = tmpb[2]; wb.w = tmpb[3];
      *(u32x4*)(p.RKWT + (size_t)item_idx(0, bh, cn) * 8192 + sidx * 8) = wf; *(u32x4*)(p.RKWT + (size_t)item_idx(1, bh, cn) * 8192 + sidx * 8) = wb; }
    { unsigned short vb[8], va[8];
#pragma unroll
      for (int jj = 0; jj < 8; ++jj) { vb[jj] = sv[(16 * s + 8 * hh + jj) * 136 + c]; va[jj] = sv[(16 * s + 8 * (jj >> 2) + 4 * hh + (jj & 3)) * 136 + c]; }
      u32x4 wb2, wa2; wb2.x = vb[0] | ((unsigned)vb[1] << 16); wb2.y = vb[2] | ((unsigned)vb[3] << 16); wb2.z = vb[4] | ((unsigned)vb[5] << 16); wb2.w = vb[6] | ((unsigned)vb[7] << 16);
      wa2.x = va[0] | ((unsigned)va[1] << 16); wa2.y = va[2] | ((unsigned)va[3] << 16); wa2.z = va[4] | ((unsigned)va[5] << 16); wa2.w = va[6] | ((unsigned)va[7] << 16);
      *(u32x4*)(p.RVTB + ((size_t)bh * NCH + cn) * 8192 + sidx * 8) = wb2; *(u32x4*)(p.RVTA + ((size_t)bh * NCH + cn) * 8192 + sidx * 8) = wa2; } }
  __syncthreads();
}

__device__ void ret_scan_job(const FP& p, int l, int bh, int dir, LAS unsigned char* lds) {
  const int t = TIDX, wid = __builtin_amdgcn_readfirstlane(t >> 6), lane = t & 63, hi = lane >> 5;
  const int h = bh & 3; const float lg = __log2f(1.f - __expf(p.ret_decay[l * 8 + dir * 4 + h])); const float g64 = exp2f(lg * 64.f);
  f32x16 S[4];
#pragma unroll
  for (int d = 0; d < 4; ++d)
#pragma unroll
    for (int r = 0; r < 16; ++r) S[d][r] = 0.f;
#define RS_STAGE(cn, buf) do { const char* ga = (const char*)(p.RKWT + (size_t)item_idx(dir, bh, (cn)) * 8192) + (wid - 4) * 1024 + lane * 16; const char* gb = (const char*)(p.RVTB + ((size_t)bh * NCH + (cn)) * 8192) + (wid - 4) * 1024 + lane * 16; \
    LAS unsigned char* lb = lds + (buf) * 32768 + (wid - 4) * 1024; \
    _Pragma("unroll") for (int q_ = 0; q_ < 4; ++q_) { __builtin_amdgcn_global_load_lds((const unsigned*)(ga + q_ * 4096), (LAS unsigned*)(lb + q_ * 4096), 16, 0, 0); \
      __builtin_amdgcn_global_load_lds((const unsigned*)(gb + q_ * 4096), (LAS unsigned*)(lb + 16384 + q_ * 4096), 16, 0, 0); } } while (0)
  __syncthreads();
  if (wid >= 4) { RS_STAGE(scan_chunk(dir, 0), 0); RS_STAGE(scan_chunk(dir, 1), 1); }
  for (int n = 0; n < NCH; ++n) { const int cn = scan_chunk(dir, n), buf = n % 3;
    if (wid >= 4) { if (n + 1 < NCH) asm volatile("s_waitcnt vmcnt(8)" ::: "memory"); else asm volatile("s_waitcnt vmcnt(0)" ::: "memory"); }
    __builtin_amdgcn_s_barrier(); asm volatile("" ::: "memory");
    if (wid >= 4) { if (n + 2 < NCH) RS_STAGE(scan_chunk(dir, n + 2), (n + 2) % 3); }
    if (wid < 4) {
      asm volatile("s_nop 9\n\ts_nop 9" : "+v"(S[3]), "+v"(S[2]), "+v"(S[1]), "+v"(S[0]));
      bf16_t* st = p.RST + (size_t)item_idx(dir, bh, cn) * 16384;
#pragma unroll
      for (int dt = 0; dt < 4; ++dt)
#pragma unroll
        for (int g = 0; g < 4; ++g) { u32x2 w; w.x = cvt_pk_bf16(S[dt][4 * g], S[dt][4 * g + 1]); w.y = cvt_pk_bf16(S[dt][4 * g + 2], S[dt][4 * g + 3]);
          *(u32x2*)(st + ((wid * 8 + 2 * dt + (g >> 1)) * 64 + (lane & 31) + 32 * (g & 1)) * 8 + 4 * hi) = w; }
#pragma unroll
      for (int dt = 0; dt < 4; ++dt)
#pragma unroll
        for (int r = 0; r < 16; ++r) S[dt][r] *= g64;
      const LAS unsigned char* bb = lds + buf * 32768;
      bf16x8 af[4][4], bfr[4];
#pragma unroll
      for (int s = 0; s < 4; ++s) bfr[s] = *(const LAS bf16x8*)(bb + 16384 + (wid * 4 + s) * 1024 + lane * 16);
#pragma unroll
      for (int dt = 0; dt < 4; ++dt)
#pragma unroll
        for (int s = 0; s < 4; ++s) af[dt][s] = *(const LAS bf16x8*)(bb + (dt * 4 + s) * 1024 + lane * 16);
#pragma unroll
      for (int s = 0; s < 4; ++s)
#pragma unroll
        for (int dt = 0; dt < 4; ++dt) S[dt] = __builtin_amdgcn_mfma_f32_32x32x16_bf16(af[dt][s], bfr[s], S[dt], 0, 0, 0);
    }
  }
  asm volatile("s_waitcnt vmcnt(0)" ::: "memory"); __syncthreads();
#undef RS_STAGE
}

__device__ __forceinline__ bf16x8 pack8(float a0, float a1, float a2, float a3, float a4, float a5, float a6, float a7) {
  u32x4 pk;
  asm volatile("v_cvt_pk_bf16_f32 %0, %4, %5\n\tv_cvt_pk_bf16_f32 %1, %6, %7\n\tv_cvt_pk_bf16_f32 %2, %8, %9\n\tv_cvt_pk_bf16_f32 %3, %10, %11\n\ts_nop 1"
               : "=&v"(pk[0]), "=&v"(pk[1]), "=&v"(pk[2]), "=&v"(pk[3]) : "v"(a0), "v"(a1), "v"(a2), "v"(a3), "v"(a4), "v"(a5), "v"(a6), "v"(a7));
  return __builtin_bit_cast(bf16x8, pk);
}
__device__ __forceinline__ bf16x8 pack_step(const f32x16& x, int s) { return pack8(x[8 * s], x[8 * s + 1], x[8 * s + 2], x[8 * s + 3], x[8 * s + 4], x[8 * s + 5], x[8 * s + 6], x[8 * s + 7]); }
__device__ __forceinline__ bf16x8 scale_frag(bf16x8 a, float f) {
  const u32x4 v = __builtin_bit_cast(u32x4, a);
  return pack8(bflo(v.x) * f, bfhi(v.x) * f, bflo(v.y) * f, bfhi(v.y) * f, bflo(v.z) * f, bfhi(v.z) * f, bflo(v.w) * f, bfhi(v.w) * f);
}

__device__ void ret_out_unit(const FP& p, int l, int bh, int cn, int ih, int lane) {
  const int b = bh >> 2, h = bh & 3, c32 = lane & 31, hi = lane >> 5; const size_t row0 = (size_t)b * SB + cn * 64; const int ipos = 32 * ih + c32;
  const float lgf = __log2f(1.f - __expf(p.ret_decay[l * 8 + h])), lgb = __log2f(1.f - __expf(p.ret_decay[l * 8 + 4 + h]));
  const unsigned lo16 = (unsigned)lane * 16u;
  f32x16 P0, P1;
#pragma unroll
  for (int r = 0; r < 16; ++r) { P0[r] = 0.f; P1[r] = 0.f; }
  const char* qb = (const char*)(p.RQb + (row0 + 32 * ih) * 512 + h * 128); const char* kb = (const char*)(p.RKb + row0 * 512 + h * 128);
  const unsigned rowoff = (unsigned)(c32 * 512 + 8 * hi) * 2u;
#pragma unroll 1
  for (int s = 0; s < 8; ++s) { const bf16x8 qf = *(const bf16x8*)(qb + rowoff + s * 32); const bf16x8 k0 = *(const bf16x8*)(kb + rowoff + s * 32), k1 = *(const bf16x8*)(kb + 32 * 1024 + rowoff + s * 32);
    P0 = __builtin_amdgcn_mfma_f32_32x32x16_bf16(k0, qf, P0, 0, 0, 0); P1 = __builtin_amdgcn_mfma_f32_32x32x16_bf16(k1, qf, P1, 0, 0, 0); }
  bf16x8 pb[2][2][2];
#pragma unroll
  for (int dir = 0; dir < 2; ++dir) { const float lg = dir == 0 ? lgf : lgb;
#pragma unroll
    for (int jt = 0; jt < 2; ++jt) { f32x16 pd;
#pragma unroll
      for (int r = 0; r < 16; ++r) { const int j = 32 * jt + crow16(r, hi); const int dlt = dir == 0 ? ipos - j : j - ipos; const float pv = jt == 0 ? P0[r] : P1[r]; pd[r] = dlt >= 0 ? pv * exp2f(lg * (float)dlt) : 0.f; }
      pb[dir][jt][0] = pack_step(pd, 0); pb[dir][jt][1] = pack_step(pd, 1); } }
  __builtin_amdgcn_sched_barrier(0);
  f32x16 O[4];
  const char* va = (const char*)(p.RVTA + ((size_t)bh * NCH + cn) * 8192);
#pragma unroll
  for (int et = 0; et < 4; ++et) { f32x16 a;
#pragma unroll
    for (int r = 0; r < 16; ++r) a[r] = 0.f;
    const char* vae = va + et * 4096;
#pragma unroll
    for (int jt = 0; jt < 2; ++jt)
#pragma unroll
      for (int ss = 0; ss < 2; ++ss) { const bf16x8 af = *(const bf16x8*)(vae + lo16 + (2 * jt + ss) * 1024);
        a = __builtin_amdgcn_mfma_f32_32x32x16_bf16(af, pb[0][jt][ss], a, 0, 0, 0); a = __builtin_amdgcn_mfma_f32_32x32x16_bf16(af, pb[1][jt][ss], a, 0, 0, 0); }
    O[et] = a; __builtin_amdgcn_sched_barrier(0); }
  const float facf = exp2f(lgf * (float)(ipos + 1)), facb = exp2f(lgb * (float)(64 - ipos));
  const char* stf = (const char*)(p.RST + (size_t)item_idx(0, bh, cn) * 16384); const char* stb = (const char*)(p.RST + (size_t)item_idx(1, bh, cn) * 16384);
#pragma unroll 1
  for (int s = 0; s < 8; ++s) { const bf16x8 qf = *(const bf16x8*)(qb + rowoff + s * 32); const bf16x8 qsf = scale_frag(qf, facf), qsb = scale_frag(qf, facb);
#pragma unroll
    for (int et = 0; et < 4; ++et) { const bf16x8 af = *(const bf16x8*)(stf + et * 8192 + s * 1024 + lo16), ab = *(const bf16x8*)(stb + et * 8192 + s * 1024 + lo16);
      O[et] = __builtin_amdgcn_mfma_f32_32x32x16_bf16(af, qsf, O[et], 0, 0, 0); O[et] = __builtin_amdgcn_mfma_f32_32x32x16_bf16(ab, qsb, O[et], 0, 0, 0); } }
  float sm = 0.f;
#pragma unroll
  for (int et = 0; et < 4; ++et)
#pragma unroll
    for (int r = 0; r < 16; ++r) sm += O[et][r];
  sm += shx(sm, 32); const float mu = sm * (1.f / 128.f); float vq = 0.f;
#pragma unroll
  for (int et = 0; et < 4; ++et)
#pragma unroll
    for (int r = 0; r < 16; ++r) { const float dd = O[et][r] - mu; vq += dd * dd; }
  vq += shx(vq, 32); const float rs = rsqrtf(vq * (1.f / 128.f) + 1e-5f);
  const size_t row = row0 + ipos; const bf16_t* gp = p.Pb + row * INWP + C_RG + h * 128; const float* gr = p.g_ret + l * 512 + h * 128; bf16_t* op = p.CATb + row * 1536 + 512 + h * 128;
#pragma unroll
  for (int et = 0; et < 4; ++et)
#pragma unroll
    for (int g = 0; g < 4; ++g) { const int e0 = 32 * et + 8 * g + 4 * hi; const u32x2 gz = *(const u32x2*)(gp + e0); const f32x4 gg = *(const f32x4*)(gr + e0);
      const float z[4] = {bflo(gz.x), bfhi(gz.x), bflo(gz.y), bfhi(gz.y)}; float y[4];
#pragma unroll
      for (int j = 0; j < 4; ++j) y[j] = (O[et][4 * g + j] - mu) * rs * gg[j] * silu_f(z[j]);
      u32x2 w; w.x = cvt_pk_bf16(y[0], y[1]); w.y = cvt_pk_bf16(y[2], y[3]); *(u32x2*)(op + e0) = w; }
}
#define N2SWZ(r, c) ((r) * 2048 + ((((c) & ~15) | (((c) ^ (r)) & 15)) << 4))
__device__ void ph_norm2m(const FP& p, int l, LAS unsigned char* lds) {
  const int t = TIDX, wid = t >> 6, lane = t & 63, c32 = lane & 31, hi = lane >> 5;
  const float* MODl = p.MOD + (size_t)l * 5 * 6144; const float* g2 = p.g_norm2 + l * D; int* cntl = p.cnt + l * 32;
  LAS float* lgt = (LAS float*)(lds + 131072);
  const bf16_t* wf = p.WRF + (size_t)l * 2 * 64 * 512;
  __syncthreads();
  for (int tile = blockIdx.x; tile < T / 32; tile += gridDim.x) { const int trow0 = tile * 32; const int b = trow0 / SB, s0 = trow0 % SB, rmod = s0 < CTX ? 4 : b;
    const bool routed = !(l == DEPTH - 1 && s0 < CTX);
    bf16x8 bh[8], bl[8];
#pragma unroll
    for (int q = 0; q < 8; ++q) { bh[q] = *(const bf16x8*)(wf + ((size_t)(wid * 8 + q) * 64 + lane) * 8); bl[q] = *(const bf16x8*)(wf + ((size_t)(64 + wid * 8 + q) * 64 + lane) * 8); }
    f32x4 x[4][4];
#pragma unroll
    for (int q = 0; q < 4; ++q)
#pragma unroll
      for (int i = 0; i < 4; ++i) x[q][i] = *(const f32x4*)(p.X + (size_t)(trow0 + wid * 4 + q) * D + i * 256 + lane * 4);
    const float* m = MODl + (size_t)rmod * 6144;
#pragma unroll
    for (int q = 0; q < 4; ++q) { const int r = wid * 4 + q, row = trow0 + r; float ss = 0.f;
#pragma unroll
      for (int i = 0; i < 4; ++i) ss += x[q][i][0] * x[q][i][0] + x[q][i][1] * x[q][i][1] + x[q][i][2] * x[q][i][2] + x[q][i][3] * x[q][i][3];
      ss = wave_sum(ss); const float rs = rsqrtf(ss * (1.f / 1024.f) + 1e-6f);
#pragma unroll
      for (int i = 0; i < 4; ++i) { const int c = i * 256 + lane * 4; const f32x4 g = *(const f32x4*)(g2 + c), sc = *(const f32x4*)(m + 4096 + c), sh = *(const f32x4*)(m + 3072 + c);
        const f32x4 h = x[q][i] * rs * g * (sc + 1.f) + sh;
        u32x2 whi; whi.x = cvt_pk_bf16(h[0], h[1]); whi.y = cvt_pk_bf16(h[2], h[3]);
        const f32x4 res = (f32x4){h[0] - bflo(whi.x), h[1] - bfhi(whi.x), h[2] - bflo(whi.y), h[3] - bfhi(whi.y)};
        u32x2 wlo; wlo.x = cvt_pk_bf16(res[0], res[1]); wlo.y = cvt_pk_bf16(res[2], res[3]);
        if (routed) *(u32x2*)(p.H2b + (size_t)row * D + c) = whi;
        const int ch = i * 32 + (lane >> 1); const int off = N2SWZ(r, ch) + (lane & 1) * 8;
        *(LAS u32x2*)(lds + off) = whi; *(LAS u32x2*)(lds + 65536 + off) = wlo; } }
    __syncthreads();
    f32x16 acc;
#pragma unroll
    for (int r = 0; r < 16; ++r) acc[r] = 0.f;
#pragma unroll
    for (int q = 0; q < 8; ++q) { const int ch = 2 * (wid * 8 + q) + hi; const bf16x8 ah = *(const LAS bf16x8*)(lds + N2SWZ(c32, ch)), al = *(const LAS bf16x8*)(lds + 65536 + N2SWZ(c32, ch));
      acc = __builtin_amdgcn_mfma_f32_32x32x16_bf16(ah, bh[q], acc, 0, 0, 0); acc = __builtin_amdgcn_mfma_f32_32x32x16_bf16(al, bh[q], acc, 0, 0, 0); acc = __builtin_amdgcn_mfma_f32_32x32x16_bf16(ah, bl[q], acc, 0, 0, 0); }
    __syncthreads();
    { LAS float* part = (LAS float*)lds + wid * 1024;
#pragma unroll
      for (int r = 0; r < 16; ++r) part[crow16(r, hi) * 32 + c32] = acc[r]; }
    __syncthreads();
    { const int r = t >> 4, e2 = (t & 15) * 2; float s0_ = 0.f, s1_ = 0.f;
#pragma unroll
      for (int w = 0; w < 8; ++w) { s0_ += ((LAS float*)lds)[w * 1024 + r * 32 + e2]; s1_ += ((LAS float*)lds)[w * 1024 + r * 32 + e2 + 1]; }
      lgt[r * 33 + e2] = s0_ + p.b_router[l * NE + e2]; lgt[r * 33 + e2 + 1] = s1_ + p.b_router[l * NE + e2 + 1]; }
    __syncthreads();
    if (t < 32 && routed) { const int row = trow0 + t; float lg[32];
#pragma unroll
      for (int e = 0; e < 32; ++e) lg[e] = lgt[t * 33 + e];
      float tv[4]; int ti[4];
#pragma unroll
      for (int k = 0; k < 4; ++k) { float bv = -3.0e38f; int bi = 0;
#pragma unroll
        for (int e = 0; e < 32; ++e) { if (lg[e] > bv) { bv = lg[e]; bi = e; } }
        tv[k] = bv; ti[k] = bi;
#pragma unroll
        for (int e = 0; e < 32; ++e) if (e == bi) lg[e] = -3.0e38f; }
      float e4[4], sum = 0.f;
#pragma unroll
      for (int k = 0; k < 4; ++k) { e4[k] = expf(tv[k] - tv[0]); sum += e4[k]; }
      const float inv = 1.f / sum;
      LAS int* lc = (LAS int*)(lds + 131072 + 8192); lc[t] = 0;
      int rk[4];
#pragma unroll
      for (int k = 0; k < 4; ++k) rk[k] = __hip_atomic_fetch_add(&lc[ti[k]], 1, __ATOMIC_RELAXED, __HIP_MEMORY_SCOPE_WAVEFRONT);
      const int mine = lc[t]; const int base = mine > 0 ? atomicAdd(&cntl[t], mine) : 0; lc[32 + t] = base;
#pragma unroll
      for (int k = 0; k < 4; ++k) { const int pos = lc[32 + ti[k]] + rk[k]; p.TOPE[row * 4 + k] = ti[k]; p.TOPP[row * 4 + k] = pos; p.TOPW[row * 4 + k] = e4[k] * inv;
        __hip_atomic_store(&p.ROWTOK[(size_t)ti[k] * T + pos], row, __ATOMIC_RELAXED, __HIP_MEMORY_SCOPE_AGENT); } }
    __syncthreads(); }
}
struct ConvW { f32x4 w[5][3][2]; };
__device__ __forceinline__ void load_convw(const FP& p, int l, int lane, ConvW& cw) {
  const float* c0 = p.gdn_conv + (size_t)l * 5 * 1536;
#pragma unroll
  for (int j = 0; j < 5; ++j)
#pragma unroll
    for (int blk = 0; blk < 3; ++blk) { cw.w[j][blk][0] = *(const f32x4*)(c0 + j * 1536 + blk * 512 + lane * 8); cw.w[j][blk][1] = *(const f32x4*)(c0 + j * 1536 + blk * 512 + lane * 8 + 4); }
}
__device__ __forceinline__ void prep_gdn_row(const FP& p, int l, int row, int lane, const ConvW& cw) {
  const int s = row % SB; const bool lat = s >= CTX; const int lo = lat ? CTX : 0, hi_ = lat ? SB : CTX;
  float o[3][8];
#pragma unroll
  for (int blk = 0; blk < 3; ++blk) {
#pragma unroll
    for (int e = 0; e < 8; ++e) o[blk][e] = 0.f;
#pragma unroll
    for (int j = 0; j < 5; ++j) { const int s2 = s + j - 2; if (s2 < lo || s2 >= hi_) continue;
      const u32x4 xv = *(const u32x4*)(p.Pb + (size_t)(row + j - 2) * INWP + C_GQ + blk * 512 + lane * 8);
      const f32x4 w0 = cw.w[j][blk][0], w1 = cw.w[j][blk][1];
      o[blk][0] += w0[0] * bflo(xv.x); o[blk][1] += w0[1] * bfhi(xv.x); o[blk][2] += w0[2] * bflo(xv.y); o[blk][3] += w0[3] * bfhi(xv.y);
      o[blk][4] += w1[0] * bflo(xv.z); o[blk][5] += w1[1] * bfhi(xv.z); o[blk][6] += w1[2] * bflo(xv.w); o[blk][7] += w1[3] * bfhi(xv.w); }
#pragma unroll
    for (int e = 0; e < 8; ++e) o[blk][e] = silu_f(o[blk][e]); }
#pragma unroll
  for (int blk = 0; blk < 2; ++blk) { float ss = 0.f;
#pragma unroll
    for (int e = 0; e < 8; ++e) ss += o[blk][e] * o[blk][e];
    ss += shx(ss, 1); ss += shx(ss, 2); ss += shx(ss, 4); ss += shx(ss, 8);
    const float rs = rsqrtf(ss + 1e-6f) * (blk == 0 ? 0.08838834764831845f : 1.f);
#pragma unroll
    for (int e = 0; e < 8; ++e) o[blk][e] *= rs; }
  u32x4 w;
  w.x = cvt_pk_bf16(o[0][0], o[0][1]); w.y = cvt_pk_bf16(o[0][2], o[0][3]); w.z = cvt_pk_bf16(o[0][4], o[0][5]); w.w = cvt_pk_bf16(o[0][6], o[0][7]); *(u32x4*)(p.GQb + (size_t)row * 512 + lane * 8) = w;
  w.x = cvt_pk_bf16(o[1][0], o[1][1]); w.y = cvt_pk_bf16(o[1][2], o[1][3]); w.z = cvt_pk_bf16(o[1][4], o[1][5]); w.w = cvt_pk_bf16(o[1][6], o[1][7]); *(u32x4*)(p.GKb + (size_t)row * 512 + lane * 8) = w;
  w.x = cvt_pk_bf16(o[2][0], o[2][1]); w.y = cvt_pk_bf16(o[2][2], o[2][3]); w.z = cvt_pk_bf16(o[2][4], o[2][5]); w.w = cvt_pk_bf16(o[2][6], o[2][7]); *(u32x4*)(p.GVb + (size_t)row * 512 + lane * 8) = w;
  if (lane < 8) { const float a = p.GAB[(size_t)row * 16 + lane] + p.gdn_dt_bias[l * 8 + lane]; const float xe = __expf(a);
    const float sp = a > 20.f ? a : (xe < 0.03f ? xe * (1.f - xe * (0.5f - xe * (1.f / 3.f))) : __logf(1.f + xe));
    p.GLA[(size_t)row * 8 + lane] = -__expf(p.gdn_a_log[l * 8 + lane]) * sp; p.GBETA[(size_t)row * 8 + lane] = 1.f / (1.f + __expf(-p.GAB[(size_t)row * 16 + 8 + lane])); }
}

typedef float f32x2_t __attribute__((ext_vector_type(2)));
template <int dir, int VAR = 0> __device__ __forceinline__ void g2_item(const FP& p, int bh, int cn, int t, LAS unsigned char* hl) {
  const int b = bh >> 2, h = bh & 3, w = t >> 6, lane = t & 63, c32 = lane & 31, hi = lane >> 5; const size_t row0 = (size_t)b * SB + cn * 64;
  LAS float* sA = (LAS float*)hl; LAS float* sg = sA + 64 * 64; LAS float* sb = sg + 64;
  LAS bf16_t* sK = (LAS bf16_t*)(hl + 16896); LAS bf16_t* sV = sK + 64 * 136; LAS bf16_t* sT1 = sV + 64 * 136; LAS bf16_t* sT2 = sT1 + 64 * 72;
  const int item = item_idx(dir, bh, cn);
  const int ws = (TIDX >> 8) & 1;
#pragma unroll
  for (int i = 0; i < 4; ++i) { const int idx = t + 256 * i, r = idx >> 4, c8 = (idx & 15) * 8;
    *(LAS u32x4*)(sK + r * 136 + c8) = *(const u32x4*)(p.GKb + (row0 + r) * 512 + h * 128 + c8); *(LAS u32x4*)(sV + r * 136 + c8) = *(const u32x4*)(p.GVb + (row0 + r) * 512 + h * 128 + c8); }
  if (w == 0) { float la = p.GLA[(row0 + lane) * 8 + dir * 4 + h]; const float bt = p.GBETA[(row0 + lane) * 8 + dir * 4 + h];
#pragma unroll
    for (int o = 1; o < 64; o <<= 1) { const float v = dir == 0 ? shup(la, o) : shdn(la, o); if (dir == 0 ? lane >= o : lane + o < 64) la += v; }
    sg[lane] = la; sb[lane] = bt; p.GG[(size_t)item * 64 + lane] = la; }
  __syncthreads();
  { const int it = w >> 1, jt = w & 1; f32x16 a;
#pragma unroll
    for (int r = 0; r < 16; ++r) a[r] = 0.f;
    const LAS bf16_t* ka = sK + (32 * it + c32) * 136 + 8 * hi; const LAS bf16_t* kb = sK + (32 * jt + c32) * 136 + 8 * hi;
#pragma unroll
    for (int s = 0; s < 8; ++s) a = __builtin_amdgcn_mfma_f32_32x32x16_bf16(*(const LAS bf16x8*)(ka + 16 * s), *(const LAS bf16x8*)(kb + 16 * s), a, 0, 0, 0);
    const int j = 32 * jt + c32; const float gj = sg[j];
#pragma unroll
    for (int r = 0; r < 16; ++r) { const int i = 32 * it + crow16(r, hi); const bool before = dir == 0 ? j < i : j > i;
      const float v = before ? sb[i] * a[r] * __expf(fminf(sg[i] - gj, 0.f)) : 0.f;
      if (dir == 0) sA[j * 64 + i] = v; else sA[(63 - j) * 64 + (63 - i)] = v; } }
  __syncthreads();
  if (w == ws) { f32x2_t x[32];
#pragma unroll
    for (int q = 0; q < 32; ++q) { x[q][0] = (2 * q == lane) ? 1.f : 0.f; x[q][1] = (2 * q + 1 == lane) ? 1.f : 0.f; }
#pragma unroll
    for (int jp = 0; jp < 63; ++jp) { const float xj = x[jp >> 1][jp & 1]; const f32x2_t xj2 = (f32x2_t){xj, xj};
#pragma unroll
      for (int q = (jp + 1) >> 2; q < 16; ++q) { const f32x4 r = *(const LAS f32x4*)(sA + jp * 64 + 4 * q);
        x[2 * q] = x[2 * q] - (f32x2_t){r[0], r[1]} * xj2; x[2 * q + 1] = x[2 * q + 1] - (f32x2_t){r[2], r[3]} * xj2; } }
    const int j = dir == 0 ? lane : 63 - lane; const float bj = sb[j], bje = bj * __expf(sg[j]);
#pragma unroll
    for (int ip = 0; ip < 64; ++ip) { const int i = dir == 0 ? ip : 63 - ip; const float v = x[ip >> 1][ip & 1]; sT1[i * 72 + j] = f2bf(v * bj); sT2[i * 72 + j] = f2bf(v * bje); }
  } else if (((w - ws - 1) & 3) < 2) { const int d = ((w - ws - 1) & 3) * 64 + lane; bf16_t* kt = p.GKTT + (size_t)item * 8192; const float glast = sg[dir == 0 ? 63 : 0];
#pragma unroll
    for (int grp = 0; grp < 16; ++grp) { const int s4 = grp >> 2, a = (grp >> 1) & 1, hp = grp & 1; float kv4[4];
#pragma unroll
      for (int r3 = 0; r3 < 4; ++r3) { const int i = 16 * s4 + 8 * a + 4 * hp + r3; kv4[r3] = bf2f(sK[i * 136 + d]) * __expf(glast - sg[i]); }
      u32x2 w2; w2.x = cvt_pk_bf16(kv4[0], kv4[1]); w2.y = cvt_pk_bf16(kv4[2], kv4[3]);
      *(u32x2*)(kt + (((d >> 5) * 4 + s4) * 64 + (d & 31) + 32 * hp) * 8 + 4 * a) = w2; } }
  __syncthreads();
  { f32x16 aU[2], aW[2];
#pragma unroll
    for (int it = 0; it < 2; ++it)
#pragma unroll
      for (int r = 0; r < 16; ++r) { aU[it][r] = 0.f; aW[it][r] = 0.f; }
#pragma unroll
    for (int s = 0; s < 4; ++s) { bf16x8 fv, fk;
#pragma unroll
      for (int jj = 0; jj < 8; ++jj) { fv[jj] = sV[(16 * s + 8 * hi + jj) * 136 + 32 * w + c32]; fk[jj] = sK[(16 * s + 8 * hi + jj) * 136 + 32 * w + c32]; }
#pragma unroll
      for (int it = 0; it < 2; ++it) { const bf16x8 t1 = *(const LAS bf16x8*)(sT1 + (32 * it + c32) * 72 + 16 * s + 8 * hi), t2 = *(const LAS bf16x8*)(sT2 + (32 * it + c32) * 72 + 16 * s + 8 * hi);
        aU[it] = __builtin_amdgcn_mfma_f32_32x32x16_bf16(t1, fv, aU[it], 0, 0, 0); aW[it] = __builtin_amdgcn_mfma_f32_32x32x16_bf16(fk, t2, aW[it], 0, 0, 0); } }
    asm volatile("s_nop 9\n\ts_nop 9" : "+v"(aU[0]), "+v"(aU[1]), "+v"(aW[0]), "+v"(aW[1]));
    bf16_t* ut = p.GUT + (size_t)item * 8192; bf16_t* gw = p.GWb + (size_t)item * 8192;
#pragma unroll
    for (int it2 = 0; it2 < 2; ++it2) {
#pragma unroll
      for (int g = 0; g < 4; ++g) { u32x2 w2; w2.x = cvt_pk_bf16(aU[it2][4 * g], aU[it2][4 * g + 1]); w2.y = cvt_pk_bf16(aU[it2][4 * g + 2], aU[it2][4 * g + 3]);
        *(u32x2*)(ut + (((w * 2 + it2) * 4 + g) * 64 + lane) * 4) = w2; }
#pragma unroll
      for (int sl = 0; sl < 2; ++sl) { u32x4 w4; w4.x = cvt_pk_bf16(aW[it2][8 * sl], aW[it2][8 * sl + 1]); w4.y = cvt_pk_bf16(aW[it2][8 * sl + 2], aW[it2][8 * sl + 3]);
        w4.z = cvt_pk_bf16(aW[it2][8 * sl + 4], aW[it2][8 * sl + 5]); w4.w = cvt_pk_bf16(aW[it2][8 * sl + 6], aW[it2][8 * sl + 7]);
        *(u32x4*)(gw + ((it2 * 8 + 2 * w + sl) * 64 + lane) * 8) = w4; } } }
  __syncthreads();
}

__device__ void gdn_scan_job(const FP& p, int bh, int dir, LAS unsigned char* lds) {
  const int t = TIDX, wid = __builtin_amdgcn_readfirstlane(t >> 6), lane = t & 63, hi = lane >> 5;
  f32x16 S[4];
#pragma unroll
  for (int d = 0; d < 4; ++d)
#pragma unroll
    for (int r = 0; r < 16; ++r) S[d][r] = 0.f;
#define GS_STAGE(cn, buf) do { const size_t io = (size_t)item_idx(dir, bh, (cn)) * 8192 * 2 + (size_t)(wid - 4) * 1024 + (size_t)lane * 16; const char* g0 = (const char*)p.GWb + io; const char* g1 = (const char*)p.GKTT + io; const char* g2 = (const char*)p.GUT + io; \
    LAS unsigned char* lb = lds + (buf) * 49152 + (wid - 4) * 1024; \
    _Pragma("unroll") for (int q_ = 0; q_ < 4; ++q_) { __builtin_amdgcn_global_load_lds((const unsigned*)(g0 + q_ * 4096), (LAS unsigned*)(lb + q_ * 4096), 16, 0, 0); \
      __builtin_amdgcn_global_load_lds((const unsigned*)(g1 + q_ * 4096), (LAS unsigned*)(lb + 16384 + q_ * 4096), 16, 0, 0); __builtin_amdgcn_global_load_lds((const unsigned*)(g2 + q_ * 4096), (LAS unsigned*)(lb + 32768 + q_ * 4096), 16, 0, 0); } } while (0)
  float dec0, dec1;
  { const int n0 = lane, n1 = 64 + (lane & 3); dec0 = __expf(p.GG[(size_t)item_idx(dir, bh, scan_chunk(dir, n0)) * 64 + (dir == 0 ? 63 : 0)]);
    dec1 = __expf(p.GG[(size_t)item_idx(dir, bh, scan_chunk(dir, n1)) * 64 + (dir == 0 ? 63 : 0)]); }
  __syncthreads();
  if (wid >= 4) { GS_STAGE(scan_chunk(dir, 0), 0); GS_STAGE(scan_chunk(dir, 1), 1); }
  for (int n = 0; n < NCH; ++n) { const int cn = scan_chunk(dir, n), buf = n % 3;
    if (wid >= 4) { if (n + 1 < NCH) asm volatile("s_waitcnt vmcnt(12)" ::: "memory"); else asm volatile("s_waitcnt vmcnt(0)" ::: "memory"); }
    __builtin_amdgcn_s_barrier(); asm volatile("" ::: "memory");
    if (wid >= 4) { if (n + 2 < NCH) GS_STAGE(scan_chunk(dir, n + 2), (n + 2) % 3); }
    if (wid < 4) { const int item = item_idx(dir, bh, cn);
      const float adec = __uint_as_float(__builtin_amdgcn_readlane(__float_as_uint(n < 64 ? dec0 : dec1), n & 63));
      asm volatile("s_nop 9\n\ts_nop 9" : "+v"(S[3]), "+v"(S[2]), "+v"(S[1]), "+v"(S[0]));
      bf16_t* st = p.GST + (size_t)item * 16384;
#pragma unroll
      for (int dt = 0; dt < 4; ++dt)
#pragma unroll
        for (int g = 0; g < 4; ++g) { u32x2 w; w.x = cvt_pk_bf16(S[dt][4 * g], S[dt][4 * g + 1]); w.y = cvt_pk_bf16(S[dt][4 * g + 2], S[dt][4 * g + 3]);
#ifdef PROBE_NOSTORE
          if (n == 1000)
#endif
          *(u32x2*)(st + ((wid * 8 + 2 * dt + (g >> 1)) * 64 + (lane & 31) + 32 * (g & 1)) * 8 + 4 * hi) = w; }
      const LAS unsigned char* bb = lds + buf * 49152;
      f32x16 vn[2];
#pragma unroll
      for (int it = 0; it < 2; ++it)
#pragma unroll
        for (int r = 0; r < 16; ++r) vn[it][r] = 0.f;
      bf16x8 wf[2][8];
#pragma unroll
      for (int it = 0; it < 2; ++it)
#pragma unroll
        for (int s = 0; s < 8; ++s) wf[it][s] = *(const LAS bf16x8*)(bb + (it * 8 + s) * 1024 + lane * 16);
#pragma unroll
      for (int s = 0; s < 8; ++s) { const bf16x8 sf = pack_step(S[s >> 1], s & 1);
#pragma unroll
        for (int it = 0; it < 2; ++it) vn[it] = __builtin_amdgcn_mfma_f32_32x32x16_bf16(wf[it][s], sf, vn[it], 0, 0, 0); }
      bf16x8 kf[4][4];
#pragma unroll
      for (int dt = 0; dt < 4; ++dt)
#pragma unroll
        for (int s = 0; s < 4; ++s) kf[dt][s] = *(const LAS bf16x8*)(bb + 16384 + (dt * 4 + s) * 1024 + lane * 16);
      bf16_t* vt = p.GVNT + (size_t)item * 8192;
#pragma unroll
      for (int it = 0; it < 2; ++it)
#pragma unroll
        for (int g = 0; g < 4; ++g) { const u32x2 uu = *(const LAS u32x2*)(bb + 32768 + (((wid * 2 + it) * 4 + g) * 64 + lane) * 8);
          vn[it][4 * g] = bflo(uu.x) - vn[it][4 * g]; vn[it][4 * g + 1] = bfhi(uu.x) - vn[it][4 * g + 1]; vn[it][4 * g + 2] = bflo(uu.y) - vn[it][4 * g + 2]; vn[it][4 * g + 3] = bfhi(uu.y) - vn[it][4 * g + 3];
          u32x2 w; w.x = cvt_pk_bf16(vn[it][4 * g], vn[it][4 * g + 1]); w.y = cvt_pk_bf16(vn[it][4 * g + 2], vn[it][4 * g + 3]);
#ifdef PROBE_NOSTORE
          if (n == 1000)
#endif
          *(u32x2*)(vt + ((wid * 4 + 2 * it + (g >> 1)) * 64 + lane) * 8 + 4 * (g & 1)) = w; }
#pragma unroll
      for (int dt = 0; dt < 4; ++dt)
#pragma unroll
        for (int r = 0; r < 16; ++r) S[dt][r] *= adec;
#pragma unroll
      for (int s = 0; s < 4; ++s) { const bf16x8 vf = pack_step(vn[s >> 1], s & 1);
#pragma unroll
        for (int dt = 0; dt < 4; ++dt) S[dt] = __builtin_amdgcn_mfma_f32_32x32x16_bf16(kf[dt][s], vf, S[dt], 0, 0, 0); }
    }
  }
  asm volatile("s_waitcnt vmcnt(0)" ::: "memory"); __syncthreads();
#undef GS_STAGE
}

__device__ void gdn_out_unit(const FP& p, int l, int bh, int cn, int ih, int lane) {
  const int b = bh >> 2, h = bh & 3, c32 = lane & 31, hi = lane >> 5; const size_t row0 = (size_t)b * SB + cn * 64; const int ipos = 32 * ih + c32;
  const unsigned lo16 = (unsigned)lane * 16u;
  const int itf = item_idx(0, bh, cn), itb = item_idx(1, bh, cn);
  f32x16 P0, P1;
#pragma unroll
  for (int r = 0; r < 16; ++r) { P0[r] = 0.f; P1[r] = 0.f; }
  const char* qb = (const char*)(p.GQb + (row0 + 32 * ih) * 512 + h * 128); const char* kb = (const char*)(p.GKb + row0 * 512 + h * 128);
  const unsigned rowoff = (unsigned)(c32 * 512 + 8 * hi) * 2u;
#pragma unroll 1
  for (int s = 0; s < 8; ++s) { const bf16x8 qf = *(const bf16x8*)(qb + rowoff + s * 32); const bf16x8 k0 = *(const bf16x8*)(kb + rowoff + s * 32), k1 = *(const bf16x8*)(kb + 32 * 1024 + rowoff + s * 32);
    P0 = __builtin_amdgcn_mfma_f32_32x32x16_bf16(k0, qf, P0, 0, 0, 0); P1 = __builtin_amdgcn_mfma_f32_32x32x16_bf16(k1, qf, P1, 0, 0, 0); }
  const float* ggf = p.GG + (size_t)itf * 64; const float* ggb = p.GG + (size_t)itb * 64;
  const float gfi = ggf[ipos], gbi = ggb[ipos];
  bf16x8 pb[2][2][2];
#pragma unroll
  for (int dir = 0; dir < 2; ++dir) { const float* gg = dir == 0 ? ggf : ggb; const float gi = dir == 0 ? gfi : gbi;
#pragma unroll
    for (int jt = 0; jt < 2; ++jt) { f32x16 pd;
#pragma unroll
      for (int g = 0; g < 4; ++g) { const f32x4 gj = *(const f32x4*)(gg + 32 * jt + 8 * g + 4 * hi);
#pragma unroll
        for (int r3 = 0; r3 < 4; ++r3) { const int r = 4 * g + r3; const int j = 32 * jt + 8 * g + 4 * hi + r3; const bool ok = dir == 0 ? j <= ipos : j >= ipos; const float pv = jt == 0 ? P0[r] : P1[r];
          pd[r] = ok ? pv * __expf(fminf(gi - gj[r3], 0.f)) : 0.f; } }
      pb[dir][jt][0] = pack_step(pd, 0); pb[dir][jt][1] = pack_step(pd, 1); } }
  __builtin_amdgcn_sched_barrier(0);
  f32x16 O[4];
  const char* vaf = (const char*)(p.GVNT + (size_t)itf * 8192); const char* vab = (const char*)(p.GVNT + (size_t)itb * 8192);
#pragma unroll
  for (int et = 0; et < 4; ++et) { f32x16 a;
#pragma unroll
    for (int r = 0; r < 16; ++r) a[r] = 0.f;
#pragma unroll
    for (int jt = 0; jt < 2; ++jt)
#pragma unroll
      for (int ss = 0; ss < 2; ++ss) { const bf16x8 af = *(const bf16x8*)(vaf + et * 4096 + lo16 + (2 * jt + ss) * 1024), ab = *(const bf16x8*)(vab + et * 4096 + lo16 + (2 * jt + ss) * 1024);
        a = __builtin_amdgcn_mfma_f32_32x32x16_bf16(af, pb[0][jt][ss], a, 0, 0, 0); a = __builtin_amdgcn_mfma_f32_32x32x16_bf16(ab, pb[1][jt][ss], a, 0, 0, 0); }
    O[et] = a; __builtin_amdgcn_sched_barrier(0); }
  const float facf = __expf(gfi), facb = __expf(gbi);
  const char* stf = (const char*)(p.GST + (size_t)itf * 16384); const char* stb = (const char*)(p.GST + (size_t)itb * 16384);
#pragma unroll 1
  for (int s = 0; s < 8; ++s) { const bf16x8 qf = *(const bf16x8*)(qb + rowoff + s * 32); const bf16x8 qsf = scale_frag(qf, facf), qsb = scale_frag(qf, facb);
#pragma unroll
    for (int et = 0; et < 4; ++et) { const bf16x8 af = *(const bf16x8*)(stf + et * 8192 + s * 1024 + lo16), ab = *(const bf16x8*)(stb + et * 8192 + s * 1024 + lo16);
      O[et] = __builtin_amdgcn_mfma_f32_32x32x16_bf16(af, qsf, O[et], 0, 0, 0); O[et] = __builtin_amdgcn_mfma_f32_32x32x16_bf16(ab, qsb, O[et], 0, 0, 0); } }
  float ss2 = 0.f;
#pragma unroll
  for (int et = 0; et < 4; ++et)
#pragma unroll
    for (int r = 0; r < 16; ++r) ss2 += O[et][r] * O[et][r];
  ss2 += shx(ss2, 32); const float rs = rsqrtf(ss2 * (1.f / 128.f) + 1e-6f);
  const size_t row = row0 + ipos; const bf16_t* zp = p.Pb + row * INWP + C_GZ + h * 128; const float* gr = p.g_gdn + l * 128; bf16_t* op = p.CATb + row * 1536 + 1024 + h * 128;
#pragma unroll
  for (int et = 0; et < 4; ++et)
#pragma unroll
    for (int g = 0; g < 4; ++g) { const int e0 = 32 * et + 8 * g + 4 * hi; const u32x2 gz = *(const u32x2*)(zp + e0); const f32x4 gg = *(const f32x4*)(gr + e0);
      const float z[4] = {bflo(gz.x), bfhi(gz.x), bflo(gz.y), bfhi(gz.y)}; float y[4];
#pragma unroll
      for (int j = 0; j < 4; ++j) y[j] = O[et][4 * g + j] * rs * gg[j] * silu_f(z[j]);
      u32x2 w; w.x = cvt_pk_bf16(y[0], y[1]); w.y = cvt_pk_bf16(y[2], y[3]); *(u32x2*)(op + e0) = w; }
}
template <bool GDN> __device__ __forceinline__ void post_unit(const FP& p, int l, int bh, int cn, LAS float* stats) {
  const int t = TIDX, wid = t >> 6, lane = t & 63, ih = wid >> 2, et = wid & 3, c32 = lane & 31, hi = lane >> 5;
  const int b = bh >> 2, h = bh & 3; const size_t row0 = (size_t)b * SB + cn * 64; const int ipos = 32 * ih + c32;
  const int itf = item_idx(0, bh, cn), itb = item_idx(1, bh, cn);
  const unsigned lo16 = (unsigned)lane * 16u;
  const bf16_t* Qp = GDN ? p.GQb : p.RQb; const bf16_t* Kp = GDN ? p.GKb : p.RKb; const bf16_t* STp = GDN ? p.GST : p.RST;
  bf16x8 qf[8], kf0[8], kf1[8], sf[8], sb[8];
  { const char* qb = (const char*)(Qp + (row0 + ipos) * 512 + h * 128 + 8 * hi); const char* kb = (const char*)(Kp + (row0 + c32) * 512 + h * 128 + 8 * hi);
#pragma unroll
    for (int s = 0; s < 8; ++s) qf[s] = *(const bf16x8*)(qb + s * 32);
#pragma unroll
    for (int s = 0; s < 8; ++s) kf0[s] = *(const bf16x8*)(kb + s * 32);
#pragma unroll
    for (int s = 0; s < 8; ++s) kf1[s] = *(const bf16x8*)(kb + 32 * 1024 + s * 32);
    const char* stf = (const char*)(STp + (size_t)itf * 16384) + et * 8192 + lo16; const char* stb = (const char*)(STp + (size_t)itb * 16384) + et * 8192 + lo16;
#pragma unroll
    for (int s = 0; s < 8; ++s) sf[s] = *(const bf16x8*)(stf + s * 1024);
    (void)stb; }
  const float* ggf = p.GG + (size_t)itf * 64; const float* ggb = p.GG + (size_t)itb * 64;
  float gfi = 0.f, gbi = 0.f, lgf = 0.f, lgb = 0.f;
  if (GDN) { gfi = ggf[ipos]; gbi = ggb[ipos]; }
  else { lgf = __log2f(1.f - __expf(p.ret_decay[l * 8 + h])); lgb = __log2f(1.f - __expf(p.ret_decay[l * 8 + 4 + h])); }
  f32x16 P0, P1;
#pragma unroll
  for (int r = 0; r < 16; ++r) { P0[r] = 0.f; P1[r] = 0.f; }
#pragma unroll
  for (int s = 0; s < 8; ++s) { P0 = __builtin_amdgcn_mfma_f32_32x32x16_bf16(kf0[s], qf[s], P0, 0, 0, 0); P1 = __builtin_amdgcn_mfma_f32_32x32x16_bf16(kf1[s], qf[s], P1, 0, 0, 0); }
  { const char* stb = (const char*)(STp + (size_t)itb * 16384) + et * 8192 + lo16;
#pragma unroll
    for (int s = 0; s < 8; ++s) sb[s] = *(const bf16x8*)(stb + s * 1024); }
  bf16x8 vf[4], vb[4];
  { const char* vaf = (const char*)(GDN ? p.GVNT + (size_t)itf * 8192 : p.RVTA + ((size_t)bh * NCH + cn) * 8192) + et * 4096 + lo16;
#pragma unroll
    for (int s = 0; s < 4; ++s) vf[s] = *(const bf16x8*)(vaf + s * 1024);
    if (GDN) { const char* vab = (const char*)(p.GVNT + (size_t)itb * 8192) + et * 4096 + lo16;
#pragma unroll
      for (int s = 0; s < 4; ++s) vb[s] = *(const bf16x8*)(vab + s * 1024); }
    else {
#pragma unroll
      for (int s = 0; s < 4; ++s) vb[s] = vf[s]; } }
  f32x16 O;
#pragma unroll
  for (int r = 0; r < 16; ++r) O[r] = 0.f;
#pragma unroll
  for (int dir = 0; dir < 2; ++dir)
#pragma unroll
    for (int jt = 0; jt < 2; ++jt) { f32x16 pd;
#pragma unroll
      for (int g = 0; g < 4; ++g) { f32x4 gj4 = (f32x4){0.f, 0.f, 0.f, 0.f}; if (GDN) gj4 = *(const f32x4*)((dir == 0 ? ggf : ggb) + 32 * jt + 8 * g + 4 * hi);
#pragma unroll
        for (int r3 = 0; r3 < 4; ++r3) { const int r = 4 * g + r3; const int j = 32 * jt + 8 * g + 4 * hi + r3; const float pv = jt == 0 ? P0[r] : P1[r]; float w;
          if (GDN) { const bool ok = dir == 0 ? j <= ipos : j >= ipos; const float gi = dir == 0 ? gfi : gbi; const float gj = gj4[r3]; w = ok ? __expf(fminf(gi - gj, 0.f)) : 0.f; }
          else { const int dlt = dir == 0 ? ipos - j : j - ipos; w = dlt >= 0 ? exp2f((dir == 0 ? lgf : lgb) * (float)dlt) : 0.f; }
          pd[r] = pv * w; } }
#pragma unroll
      for (int ss = 0; ss < 2; ++ss) { const bf16x8 pbf = pack_step(pd, ss); O = __builtin_amdgcn_mfma_f32_32x32x16_bf16(dir == 0 ? vf[2 * jt + ss] : vb[2 * jt + ss], pbf, O, 0, 0, 0); } }
  { const float facf = GDN ? __expf(gfi) : exp2f(lgf * (float)(ipos + 1)), facb = GDN ? __expf(gbi) : exp2f(lgb * (float)(64 - ipos));
#pragma unroll
    for (int s = 0; s < 8; ++s) { const bf16x8 qsf = scale_frag(qf[s], facf), qsb = scale_frag(qf[s], facb);
      O = __builtin_amdgcn_mfma_f32_32x32x16_bf16(sf[s], qsf, O, 0, 0, 0); O = __builtin_amdgcn_mfma_f32_32x32x16_bf16(sb[s], qsb, O, 0, 0, 0); } }
  float s1 = 0.f, s2 = 0.f;
#pragma unroll
  for (int r = 0; r < 16; ++r) { s1 += O[r]; s2 += O[r] * O[r]; }
  s1 += shx(s1, 32); s2 += shx(s2, 32);
  if (hi == 0) { stats[((ih * 4 + et) * 32 + c32) * 2] = s1; stats[((ih * 4 + et) * 32 + c32) * 2 + 1] = s2; }
  __syncthreads();
  float t1 = 0.f, t2 = 0.f;
#pragma unroll
  for (int e2 = 0; e2 < 4; ++e2) { t1 += stats[((ih * 4 + e2) * 32 + c32) * 2]; t2 += stats[((ih * 4 + e2) * 32 + c32) * 2 + 1]; }
  float mu, rs;
  if (GDN) { mu = 0.f; rs = rsqrtf(t2 * (1.f / 128.f) + 1e-6f); }
  else { mu = t1 * (1.f / 128.f); rs = rsqrtf(fmaxf(t2 * (1.f / 128.f) - mu * mu, 0.f) + 1e-5f); }
  const size_t row = row0 + ipos; const bf16_t* gp = p.Pb + row * INWP + (GDN ? C_GZ : C_RG) + h * 128; const float* gr = GDN ? p.g_gdn + l * 128 : p.g_ret + l * 512 + h * 128;
  bf16_t* op = p.CATb + row * 1536 + (GDN ? 1024 : 512) + h * 128;
#pragma unroll
  for (int g = 0; g < 4; ++g) { const int e0 = 32 * et + 8 * g + 4 * hi; const u32x2 gz = *(const u32x2*)(gp + e0); const f32x4 gg = *(const f32x4*)(gr + e0);
    const float z[4] = {bflo(gz.x), bfhi(gz.x), bflo(gz.y), bfhi(gz.y)}; float y[4];
#pragma unroll
    for (int j = 0; j < 4; ++j) y[j] = (O[4 * g + j] - mu) * rs * gg[j] * silu_f(z[j]);
    u32x2 w; w.x = cvt_pk_bf16(y[0], y[1]); w.y = cvt_pk_bf16(y[2], y[3]); *(u32x2*)(op + e0) = w; }
}
__device__ __forceinline__ void ph_post2(const FP& p, int l, LAS unsigned char* lds) {
  const int t = TIDX, lane = t & 63, gw = blockIdx.x * NWAVES + (t >> 6), GWN = gridDim.x * NWAVES;
  for (int row = gw; row < T; row += GWN) mla_out_row(p, l, row, lane);
  int par = 0;
  const int nch = (l == DEPTH - 1) ? NCH - 4 : NCH, c0 = NCH - nch;
  for (int u = blockIdx.x; u < 2 * 16 * nch; u += gridDim.x, par ^= 1) { const int m = u & 1, uu = u >> 1;
    if (m) post_unit<true>(p, l, uu / nch, c0 + uu % nch, (LAS float*)lds + par * 512); else post_unit<false>(p, l, uu / nch, c0 + uu % nch, (LAS float*)lds + par * 512); }
}
namespace p3 { constexpr int OK_ = 0, OQ = 16384, OSF = 32768, OSB = 65536, OVF = 98304, OVB = 114688, OST = 131072; }
template <bool GDN> __device__ __forceinline__ void post3_stage(const FP& p, int bh, int cn, LAS unsigned char* lds) {
  const int t = TIDX, wid = __builtin_amdgcn_readfirstlane(t >> 6), lane = t & 63;
  const int b = bh >> 2, h = bh & 3; const size_t row0 = (size_t)b * SB + cn * 64;
  const int itf = item_idx(0, bh, cn), itb = item_idx(1, bh, cn);
  const bf16_t* Kp = (GDN ? p.GKb : p.RKb) + row0 * 512 + h * 128; const bf16_t* Qp = (GDN ? p.GQb : p.RQb) + row0 * 512 + h * 128;
#pragma unroll
  for (int q = 0; q < 2; ++q) { const int pc = wid + 8 * q, row = 4 * pc + (lane >> 4), ch = (lane & 15) ^ (row & 7);
    __builtin_amdgcn_global_load_lds((const unsigned*)(Kp + (size_t)row * 512 + ch * 8), (LAS unsigned*)(lds + p3::OK_ + pc * 1024), 16, 0, 0);
    __builtin_amdgcn_global_load_lds((const unsigned*)(Qp + (size_t)row * 512 + ch * 8), (LAS unsigned*)(lds + p3::OQ + pc * 1024), 16, 0, 0); }
  const char* sf = (const char*)((GDN ? p.GST : p.RST) + (size_t)itf * 16384) + lane * 16; const char* sb = (const char*)((GDN ? p.GST : p.RST) + (size_t)itb * 16384) + lane * 16;
#pragma unroll
  for (int q = 0; q < 4; ++q) { const int pc = wid + 8 * q;
    __builtin_amdgcn_global_load_lds((const unsigned*)(sf + pc * 1024), (LAS unsigned*)(lds + p3::OSF + pc * 1024), 16, 0, 0);
    __builtin_amdgcn_global_load_lds((const unsigned*)(sb + pc * 1024), (LAS unsigned*)(lds + p3::OSB + pc * 1024), 16, 0, 0); }
  const char* vf = (const char*)(GDN ? p.GVNT + (size_t)itf * 8192 : p.RVTA + ((size_t)bh * NCH + cn) * 8192) + lane * 16;
#pragma unroll
  for (int q = 0; q < 2; ++q) { const int pc = wid + 8 * q; __builtin_amdgcn_global_load_lds((const unsigned*)(vf + pc * 1024), (LAS unsigned*)(lds + p3::OVF + pc * 1024), 16, 0, 0); }
  if (GDN) { const char* vb = (const char*)(p.GVNT + (size_t)itb * 8192) + lane * 16;
#pragma unroll
    for (int q = 0; q < 2; ++q) { const int pc = wid + 8 * q; __builtin_amdgcn_global_load_lds((const unsigned*)(vb + pc * 1024), (LAS unsigned*)(lds + p3::OVB + pc * 1024), 16, 0, 0); } }
}
#define P3SWZ(row, ch) ((row) * 256 + (((ch) ^ ((row) & 7)) << 4))
template <bool GDN, bool NGDN> __device__ __forceinline__ void post3_unit(const FP& p, int l, int bh, int cn, LAS unsigned char* lds, int par, bool hasnext, int nbh, int ncn) {
  const int t = TIDX, wid = t >> 6, lane = t & 63, ih = wid >> 2, et = wid & 3, c32 = lane & 31, hi = lane >> 5;
  const int b = bh >> 2, h = bh & 3; const size_t row0 = (size_t)b * SB + cn * 64; const int ipos = 32 * ih + c32;
  const int itf = item_idx(0, bh, cn), itb = item_idx(1, bh, cn);
  LAS float* stats = (LAS float*)(lds + p3::OST) + par * 512;
  const float* ggf = p.GG + (size_t)itf * 64; const float* ggb = p.GG + (size_t)itb * 64;
  float gfi = 0.f, gbi = 0.f, lgf = 0.f, lgb = 0.f;
  if (GDN) { gfi = ggf[ipos]; gbi = ggb[ipos]; }
  else { lgf = __log2f(1.f - __expf(p.ret_decay[l * 8 + h])); lgb = __log2f(1.f - __expf(p.ret_decay[l * 8 + 4 + h])); }
  const size_t row = row0 + ipos; const bf16_t* gp = p.Pb + row * INWP + (GDN ? C_GZ : C_RG) + h * 128; const float* gr = GDN ? p.g_gdn + l * 128 : p.g_ret + l * 512 + h * 128;
  u32x2 gz[4]; f32x4 gg[4];
#pragma unroll
  for (int g = 0; g < 4; ++g) { const int e0 = 32 * et + 8 * g + 4 * hi; gz[g] = *(const u32x2*)(gp + e0); gg[g] = *(const f32x4*)(gr + e0); }
  bf16x8 qf[8];
  { const int qr = 32 * ih + c32;
#pragma unroll
    for (int s = 0; s < 8; ++s) qf[s] = *(const LAS bf16x8*)(lds + p3::OQ + P3SWZ(qr, 2 * s + hi)); }
  f32x16 P0, P1;
#pragma unroll
  for (int r = 0; r < 16; ++r) { P0[r] = 0.f; P1[r] = 0.f; }
#pragma unroll
  for (int s = 0; s < 8; ++s) { const bf16x8 k0 = *(const LAS bf16x8*)(lds + p3::OK_ + P3SWZ(c32, 2 * s + hi)), k1 = *(const LAS bf16x8*)(lds + p3::OK_ + P3SWZ(32 + c32, 2 * s + hi));
    P0 = __builtin_amdgcn_mfma_f32_32x32x16_bf16(k0, qf[s], P0, 0, 0, 0); P1 = __builtin_amdgcn_mfma_f32_32x32x16_bf16(k1, qf[s], P1, 0, 0, 0); }
  f32x16 O;
#pragma unroll
  for (int r = 0; r < 16; ++r) O[r] = 0.f;
#pragma unroll
  for (int dir = 0; dir < 2; ++dir)
#pragma unroll
    for (int jt = 0; jt < 2; ++jt) { f32x16 pd;
#pragma unroll
      for (int g = 0; g < 4; ++g) { f32x4 gj4 = (f32x4){0.f, 0.f, 0.f, 0.f}; if (GDN) gj4 = *(const f32x4*)((dir == 0 ? ggf : ggb) + 32 * jt + 8 * g + 4 * hi);
#pragma unroll
        for (int r3 = 0; r3 < 4; ++r3) { const int r = 4 * g + r3; const int j = 32 * jt + 8 * g + 4 * hi + r3; const float pv = jt == 0 ? P0[r] : P1[r]; float w;
          if (GDN) { const bool ok = dir == 0 ? j <= ipos : j >= ipos; const float gi = dir == 0 ? gfi : gbi; w = ok ? __expf(fminf(gi - gj4[r3], 0.f)) : 0.f; }
          else { const int dlt = dir == 0 ? ipos - j : j - ipos; w = dlt >= 0 ? exp2f((dir == 0 ? lgf : lgb) * (float)dlt) : 0.f; }
          pd[r] = pv * w; } }
#pragma unroll
      for (int ss = 0; ss < 2; ++ss) { const bf16x8 pbf = pack_step(pd, ss);
        const bf16x8 vfr = *(const LAS bf16x8*)(lds + ((GDN && dir == 1) ? p3::OVB : p3::OVF) + (et * 4 + 2 * jt + ss) * 1024 + lane * 16);
        O = __builtin_amdgcn_mfma_f32_32x32x16_bf16(vfr, pbf, O, 0, 0, 0); } }
  { const float facf = GDN ? __expf(gfi) : exp2f(lgf * (float)(ipos + 1)), facb = GDN ? __expf(gbi) : exp2f(lgb * (float)(64 - ipos));
#pragma unroll
    for (int s = 0; s < 8; ++s) { const bf16x8 qsf = scale_frag(qf[s], facf), qsb = scale_frag(qf[s], facb);
      const bf16x8 sfr = *(const LAS bf16x8*)(lds + p3::OSF + (et * 8 + s) * 1024 + lane * 16), sbr = *(const LAS bf16x8*)(lds + p3::OSB + (et * 8 + s) * 1024 + lane * 16);
      O = __builtin_amdgcn_mfma_f32_32x32x16_bf16(sfr, qsf, O, 0, 0, 0); O = __builtin_amdgcn_mfma_f32_32x32x16_bf16(sbr, qsb, O, 0, 0, 0); } }
  float fz[16];
#pragma unroll
  for (int g = 0; g < 4; ++g) { fz[4 * g] = gg[g][0] * silu_f(bflo(gz[g].x)); fz[4 * g + 1] = gg[g][1] * silu_f(bfhi(gz[g].x)); fz[4 * g + 2] = gg[g][2] * silu_f(bflo(gz[g].y)); fz[4 * g + 3] = gg[g][3] * silu_f(bfhi(gz[g].y)); }
  float s1 = 0.f, s2 = 0.f;
#pragma unroll
  for (int r = 0; r < 16; ++r) { s1 += O[r]; s2 += O[r] * O[r]; }
  s1 += shx(s1, 32); s2 += shx(s2, 32);
  if (hi == 0) { stats[((ih * 4 + et) * 32 + c32) * 2] = s1; stats[((ih * 4 + et) * 32 + c32) * 2 + 1] = s2; }
  __syncthreads();
  if (hasnext) post3_stage<NGDN>(p, nbh, ncn, lds);
  float t1 = 0.f, t2 = 0.f;
#pragma unroll
  for (int e2 = 0; e2 < 4; ++e2) { t1 += stats[((ih * 4 + e2) * 32 + c32) * 2]; t2 += stats[((ih * 4 + e2) * 32 + c32) * 2 + 1]; }
  float mu, rs;
  if (GDN) { mu = 0.f; rs = rsqrtf(t2 * (1.f / 128.f) + 1e-6f); }
  else { mu = t1 * (1.f / 128.f); rs = rsqrtf(fmaxf(t2 * (1.f / 128.f) - mu * mu, 0.f) + 1e-5f); }
  bf16_t* op = p.CATb + row * 1536 + (GDN ? 1024 : 512) + h * 128;
#pragma unroll
  for (int g = 0; g < 4; ++g) { const int e0 = 32 * et + 8 * g + 4 * hi; float y[4];
#pragma unroll
    for (int j = 0; j < 4; ++j) y[j] = (O[4 * g + j] - mu) * rs * fz[4 * g + j];
    u32x2 w; w.x = cvt_pk_bf16(y[0], y[1]); w.y = cvt_pk_bf16(y[2], y[3]); *(u32x2*)(op + e0) = w; }
}
__device__ __forceinline__ void ph_post3(const FP& p, int l, LAS unsigned char* lds) {
  const int t = TIDX, lane = t & 63, gw = blockIdx.x * NWAVES + (t >> 6), GWN = gridDim.x * NWAVES;
  for (int row = gw; row < T; row += GWN) mla_out_row(p, l, row, lane);
  const int nch = (l == DEPTH - 1) ? NCH - 4 : NCH, c0 = NCH - nch, NU = 16 * nch, G = gridDim.x;
  int u = blockIdx.x; if (u >= 2 * NU) return;
  __syncthreads();
  if (u < NU) post3_stage<false>(p, u / nch, c0 + u % nch, lds); else post3_stage<true>(p, (u - NU) / nch, c0 + (u - NU) % nch, lds);
  for (int par = 0; u < 2 * NU; u += G, par ^= 1) { const int un = u + G; const bool hasnext = un < 2 * NU; const bool gd = u >= NU, ngd = un >= NU;
    const int uu = gd ? u - NU : u, vv = ngd ? un - NU : un; const int bh = uu / nch, cn = c0 + uu % nch, nbh = vv / nch, ncn = c0 + vv % nch;
    asm volatile("s_waitcnt vmcnt(0)" ::: "memory"); __syncthreads();
    if (!gd) { if (ngd) post3_unit<false, true>(p, l, bh, cn, lds, par, hasnext, nbh, ncn); else post3_unit<false, false>(p, l, bh, cn, lds, par, hasnext, nbh, ncn); }
    else post3_unit<true, true>(p, l, bh, cn, lds, par, hasnext, nbh, ncn); }
}
#define XB_TMO      128
#define XB_XCNT(j)  (256  + 64 * (j))
#define XB_XSUB(j)  (1280 + 64 * (j))
#define XB_XGEN(j)  (2304 + 64 * (j))
#define XB_TOP      3328
#define XB_TOPGEN   3392
#define XCD_BAR_WORDS 3456
#define XB_SPIN_CAP (1u << 18)

__device__ __forceinline__ unsigned xb_ld(unsigned* p)              { return __hip_atomic_load(p, __ATOMIC_RELAXED, __HIP_MEMORY_SCOPE_AGENT); }
__device__ __forceinline__ unsigned xb_add(unsigned* p, unsigned v) { return __hip_atomic_fetch_add(p, v, __ATOMIC_RELAXED, __HIP_MEMORY_SCOPE_AGENT); }
__device__ __forceinline__ unsigned xb_xcc_id() { return (unsigned)__builtin_amdgcn_s_getreg((3 << 11) | 20) & 0xFu; }
#define XB_SPIN(cond, bar) do { unsigned _sp = 0; while (cond) { __builtin_amdgcn_s_sleep(1); \
    if ((++_sp & 255u) == 0u) { if (xb_ld(&(bar)[XB_TMO])) break; if (_sp > XB_SPIN_CAP) { atomicAdd(&(bar)[XB_TMO], 1u); break; } } } } while (0)

struct XcdBarrier {
    unsigned* bar; unsigned x;
    volatile LAS unsigned* st;
};

__device__ __forceinline__ XcdBarrier xcd_barrier_post(unsigned* bar, volatile LAS unsigned* st) {
    XcdBarrier b; b.bar = bar; b.x = xb_xcc_id(); b.st = st;
    if (threadIdx.x == 0) (void)xb_add(&bar[XB_XCNT(b.x)], 1u);
    return b;
}
__device__ __forceinline__ void xcd_barrier_complete(unsigned* bar, unsigned x, unsigned& nloc, unsigned& nx) {
    const unsigned G = gridDim.x * gridDim.y * gridDim.z;
    unsigned sum, cnt, mine, sp = 0u;
    for (;;) {
        sum = 0u; cnt = 0u; mine = 0u;
#pragma unroll
        for (unsigned j = 0; j < 16; ++j) { const unsigned c = xb_ld(&bar[XB_XCNT(j)]); sum += c; cnt += (c > 0u) ? 1u : 0u; mine = (j == x) ? c : mine; }
        if (sum == G) break;
        __builtin_amdgcn_s_sleep(1);
        if ((++sp & 255u) == 0u) { if (xb_ld(&bar[XB_TMO])) break; if (sp > XB_SPIN_CAP) { atomicAdd(&bar[XB_TMO], 1u); break; } }
    }
    nloc = mine > 0u ? mine : 1u; nx = cnt > 0u ? cnt : 1u;
}

__device__ __forceinline__ void xcd_barrier(const XcdBarrier& b) {
    asm volatile("s_waitcnt vmcnt(0)" ::: "memory");
    __syncthreads();
    if (threadIdx.x == 0) {
        unsigned* bar = b.bar; unsigned bx = b.x; asm volatile("" : "+s"(bx));
        __builtin_amdgcn_s_waitcnt(0);
        unsigned nloc = b.st[0], nx = b.st[1];
        if (nloc == 0u) { xcd_barrier_complete(bar, bx, nloc, nx); b.st[0] = nloc; b.st[1] = nx; }
        const unsigned old = xb_add(&bar[XB_XSUB(bx)], 1u);
        const unsigned gen = old / nloc;
        if (old + 1u == (gen + 1u) * nloc) {
            __builtin_amdgcn_fence(__ATOMIC_RELEASE, "agent");
            asm volatile("s_waitcnt vmcnt(0)" ::: "memory");
            const unsigned og = xb_add(&bar[XB_TOP], 1u);
            const unsigned tg = og / nx;
            if (og + 1u == (tg + 1u) * nx) xb_add(&bar[XB_TOPGEN], 1u);
            else XB_SPIN(xb_ld(&bar[XB_TOPGEN]) == tg, bar);
            __builtin_amdgcn_fence(__ATOMIC_ACQUIRE, "agent");
            xb_add(&bar[XB_XGEN(bx)], 1u);
            asm volatile("s_waitcnt vmcnt(0)" ::: "memory");
        } else {
            XB_SPIN(xb_ld(&bar[XB_XGEN(bx)]) == gen, bar);
            __builtin_amdgcn_fence(__ATOMIC_ACQUIRE, "agent");
            asm volatile("s_waitcnt vmcnt(0)" ::: "memory");
        }
    }
    __syncthreads();
}

__device__ __forceinline__ void ph_prep(const FP& p, int l, LAS unsigned char* lds) { const int t = TIDX, lane = t & 63, gw = blockIdx.x * NWAVES + (t >> 6), GWN = gridDim.x * NWAVES;
  LAS float* cwl = (LAS float*)lds;
  __syncthreads();
  for (int i = t; i < 5 * 1536 / 4; i += NTHREADS) *(LAS f32x4*)(cwl + 4 * i) = *(const f32x4*)(p.gdn_conv + (size_t)l * 5 * 1536 + 4 * i);
  __syncthreads();
  const f32x4 gq = *(const f32x4*)(p.g_cq + l * 256 + lane * 4); const float gkv0 = p.g_ckv[l * 128 + lane * 2], gkv1 = p.g_ckv[l * 128 + lane * 2 + 1];
  const float dtb = p.gdn_dt_bias[l * 8 + (lane & 7)], nalog = -__expf(p.gdn_a_log[l * 8 + (lane & 7)]);
  for (int row = gw; row < T; row += GWN) { const int s = row % SB; const bool lat = s >= CTX; const int tok = s - CTX, lo = lat ? CTX : 0, hi_ = lat ? SB : CTX;
    const bf16_t* pr = p.Pb + (size_t)row * INWP;
    const u32x2 vdq = *(const u32x2*)(pr + C_DQ + lane * 4); const unsigned vdkv = *(const unsigned*)(pr + C_DKV + lane * 2); const bf16_t vkr = pr[C_KR + lane];
    const u32x4 qv = *(const u32x4*)(pr + C_RQ + lane * 8), kv = *(const u32x4*)(pr + C_RK + lane * 8);
    u32x4 gx[3][5];
#pragma unroll
    for (int j = 0; j < 5; ++j) { const int s2 = s + j - 2; const bool ok = s2 >= lo && s2 < hi_; const bf16_t* pj = ok ? pr + (j - 2) * INWP : pr;
#pragma unroll
      for (int blk = 0; blk < 3; ++blk) gx[blk][j] = *(const u32x4*)(pj + C_GQ + blk * 512 + lane * 8); }
    const float gab = p.GAB[(size_t)row * 16 + (lane & 15)];
    { float x[4] = {bflo(vdq.x), bfhi(vdq.x), bflo(vdq.y), bfhi(vdq.y)};
      const float ss = wave_sum(x[0] * x[0] + x[1] * x[1] + x[2] * x[2] + x[3] * x[3]); const float rs = rsqrtf(ss * (1.f / 256.f) + 1e-6f);
      u32x2 w; w.x = cvt_pk_bf16(x[0] * rs * gq[0], x[1] * rs * gq[1]); w.y = cvt_pk_bf16(x[2] * rs * gq[2], x[3] * rs * gq[3]);
      *(u32x2*)(p.A2b + (size_t)row * MLAK + lane * 4) = w; }
    { const float x0 = bflo(vdkv), x1 = bfhi(vdkv);
      const float ss = wave_sum(x0 * x0 + x1 * x1); const float rs = rsqrtf(ss * (1.f / 128.f) + 1e-6f);
      *(unsigned*)(p.A2b + (size_t)row * MLAK + 256 + lane * 2) = cvt_pk_bf16(x0 * rs * gkv0, x1 * rs * gkv1); }
    { const float x = bf2f(vkr); const float xp = shx(x, 16); float y = x;
      if (lat) { const int hh = lane >> 5, ii = lane & 31, fi = ii & 15; const float pos = (float)(hh == 0 ? (tok >> 6) : (tok & 63));
        const float ang = pos * __expf(-(float)fi * (9.210340371976184f / 16.f)); const float cs = __cosf(ang), sn = __sinf(ang);
        y = ii < 16 ? x * cs - xp * sn : x * cs + xp * sn; }
      unsigned u = __float_as_uint(y); u += 0x7fffu + ((u >> 16) & 1u); p.KRb[(size_t)row * 64 + lane] = (bf16_t)(u >> 16); }
    { float q[8] = {bflo(qv.x), bfhi(qv.x), bflo(qv.y), bfhi(qv.y), bflo(qv.z), bfhi(qv.z), bflo(qv.w), bfhi(qv.w)};
      float k[8] = {bflo(kv.x), bfhi(kv.x), bflo(kv.y), bfhi(kv.y), bflo(kv.z), bfhi(kv.z), bflo(kv.w), bfhi(kv.w)};
      float qo[8], ko[8];
      const bool lowh = (lane & 4) == 0;
      const float pos = (float)(((lane >> 3) & 1) == 0 ? (tok >> 6) : (tok & 63));
#pragma unroll
      for (int e = 0; e < 8; ++e) { const float qp = shx(q[e], 4), kp = shx(k[e], 4);
        if (lat) { const int fi = (lane & 3) * 8 + e; const float ang = pos * __expf(-(float)fi * (9.210340371976184f / 32.f)); const float cs = __cosf(ang), sn = __sinf(ang);
          qo[e] = lowh ? q[e] * cs - qp * sn : q[e] * cs + qp * sn; ko[e] = lowh ? k[e] * cs - kp * sn : k[e] * cs + kp * sn; }
        else { qo[e] = q[e]; ko[e] = k[e]; } }
      const float sc = 0.08838834764831845f;
      u32x4 wq, wk; wq.x = cvt_pk_bf16(qo[0], qo[1]); wq.y = cvt_pk_bf16(qo[2], qo[3]); wq.z = cvt_pk_bf16(qo[4], qo[5]); wq.w = cvt_pk_bf16(qo[6], qo[7]);
      wk.x = cvt_pk_bf16(ko[0] * sc, ko[1] * sc); wk.y = cvt_pk_bf16(ko[2] * sc, ko[3] * sc); wk.z = cvt_pk_bf16(ko[4] * sc, ko[5] * sc); wk.w = cvt_pk_bf16(ko[6] * sc, ko[7] * sc);
      *(u32x4*)(p.RQb + (size_t)row * 512 + lane * 8) = wq; *(u32x4*)(p.RKb + (size_t)row * 512 + lane * 8) = wk; }
    { float o[3][8];
#pragma unroll
      for (int blk = 0; blk < 3; ++blk) {
#pragma unroll
        for (int e = 0; e < 8; ++e) o[blk][e] = 0.f;
#pragma unroll
        for (int j = 0; j < 5; ++j) { const int s2 = s + j - 2; const float m = (s2 >= lo && s2 < hi_) ? 1.f : 0.f; const u32x4 xv = gx[blk][j];
          const f32x4 w0 = *(const LAS f32x4*)(cwl + j * 1536 + blk * 512 + lane * 8) * m, w1 = *(const LAS f32x4*)(cwl + j * 1536 + blk * 512 + lane * 8 + 4) * m;
          o[blk][0] += w0[0] * bflo(xv.x); o[blk][1] += w0[1] * bfhi(xv.x); o[blk][2] += w0[2] * bflo(xv.y); o[blk][3] += w0[3] * bfhi(xv.y);
          o[blk][4] += w1[0] * bflo(xv.z); o[blk][5] += w1[1] * bfhi(xv.z); o[blk][6] += w1[2] * bflo(xv.w); o[blk][7] += w1[3] * bfhi(xv.w); }
#pragma unroll
        for (int e = 0; e < 8; ++e) o[blk][e] = silu_f(o[blk][e]); }
#pragma unroll
      for (int blk = 0; blk < 2; ++blk) { float ss = 0.f;
#pragma unroll
        for (int e = 0; e < 8; ++e) ss += o[blk][e] * o[blk][e];
        ss += shx(ss, 1); ss += shx(ss, 2); ss += shx(ss, 4); ss += shx(ss, 8);
        const float rs = rsqrtf(ss + 1e-6f) * (blk == 0 ? 0.08838834764831845f : 1.f);
#pragma unroll
        for (int e = 0; e < 8; ++e) o[blk][e] *= rs; }
      u32x4 w;
      w.x = cvt_pk_bf16(o[0][0], o[0][1]); w.y = cvt_pk_bf16(o[0][2], o[0][3]); w.z = cvt_pk_bf16(o[0][4], o[0][5]); w.w = cvt_pk_bf16(o[0][6], o[0][7]); *(u32x4*)(p.GQb + (size_t)row * 512 + lane * 8) = w;
      w.x = cvt_pk_bf16(o[1][0], o[1][1]); w.y = cvt_pk_bf16(o[1][2], o[1][3]); w.z = cvt_pk_bf16(o[1][4], o[1][5]); w.w = cvt_pk_bf16(o[1][6], o[1][7]); *(u32x4*)(p.GKb + (size_t)row * 512 + lane * 8) = w;
      w.x = cvt_pk_bf16(o[2][0], o[2][1]); w.y = cvt_pk_bf16(o[2][2], o[2][3]); w.z = cvt_pk_bf16(o[2][4], o[2][5]); w.w = cvt_pk_bf16(o[2][6], o[2][7]); *(u32x4*)(p.GVb + (size_t)row * 512 + lane * 8) = w;
      if (lane < 8) { const float a = gab + dtb; const float xe = __expf(a);
        const float sp = a > 20.f ? a : (xe < 0.03f ? xe * (1.f - xe * (0.5f - xe * (1.f / 3.f))) : __logf(1.f + xe));
        p.GLA[(size_t)row * 8 + lane] = nalog * sp; }
      else if (lane < 16) p.GBETA[(size_t)row * 8 + lane - 8] = 1.f / (1.f + __expf(-gab)); } } }
template <int WHICH = 3, int VAR = 0> __device__ __forceinline__ void ph_items(const FP& p, int l, LAS unsigned char* lds) {
  int rb = (int)blockIdx.x; asm volatile("" : "+s"(rb)); rb = (int)gridDim.x - 1 - rb;
  if (WHICH & 1) for (int pr = rb; pr < 16 * NCH / 2; pr += gridDim.x) { const int it = pr * 2 + (TIDX >> 8); r2_item(p, l, it / NCH, it % NCH, TIDX & 255, lds + (TIDX >> 8) * 40960); }
  if (WHICH & 2) for (int pr = rb; pr < 2 * 16 * NCH / 2; pr += gridDim.x) { const int it = pr * 2 + (TIDX >> 8); if (it / (16 * NCH)) g2_item<1, VAR>(p, (it / NCH) & 15, it % NCH, TIDX & 255, lds + (TIDX >> 8) * 71680); else g2_item<0, VAR>(p, (it / NCH) & 15, it % NCH, TIDX & 255, lds + (TIDX >> 8) * 71680); } }
__device__ __forceinline__ void ph_post(const FP& p, int l) { const int t = TIDX, lane = t & 63, gw = blockIdx.x * NWAVES + (t >> 6), GWN = gridDim.x * NWAVES;
  for (int row = gw; row < T; row += GWN) mla_out_row(p, l, row, lane);
  for (int u = gw; u < 16 * NCH * 2; u += GWN) { ret_out_unit(p, l, u / (NCH * 2), (u >> 1) % NCH, u & 1, lane); gdn_out_unit(p, l, u / (NCH * 2), (u >> 1) % NCH, u & 1, lane); } }

#ifndef REPMASK
#define REPMASK 0
#endif
#define REP(k, ...) do { if ((REPMASK >> (k)) & 1) { __VA_ARGS__; xcd_barrier(bar); } } while (0)
#ifndef PROBE_A
#define PROBE_A 0
#endif
#ifndef PROBE_Q
#define PROBE_Q 40
#endif
#if PROBE_A
#ifndef PROBE_BLK
#define PROBE_BLK 0
#endif
#define STAMP(k) do { if (blockIdx.x == PROBE_BLK && TIDX == 0) { volatile LAS unsigned* tw_ = (volatile LAS unsigned*)(lds + LDS_BYTES - 48); if ((k) != 13) tw_[0] = (k); if ((k) == 13 || (k) == 6 || (k) == 15) { \
    const unsigned long long now_ = __builtin_amdgcn_s_memrealtime(); volatile LAS unsigned long long* tl_ = (volatile LAS unsigned long long*)(lds + LDS_BYTES - 32); \
    volatile unsigned* ta_ = p.ctl + 3600 + tw_[0]; *ta_ = *ta_ + (unsigned)(now_ - *tl_); *tl_ = now_; } } } while (0)
#else
#define STAMP(k) do { } while (0)
#endif
__global__ void __launch_bounds__(512, 2) mega_fwd(FP p) {
  extern __shared__ __attribute__((aligned(16))) unsigned char shm[];
  LAS unsigned char* lds = (LAS unsigned char*)shm;
  volatile LAS unsigned* xbw = (volatile LAS unsigned*)(lds + LDS_BYTES - 16);
  if (threadIdx.x == 0) { xbw[0] = 0u; xbw[1] = 0u; xbw[2] = 0u; xbw[3] = 0u; }
  __syncthreads();
  XcdBarrier bar = xcd_barrier_post(p.ctl, xbw);
#if PROBE_A
  if (blockIdx.x == PROBE_BLK && TIDX == 0) *(volatile LAS unsigned long long*)(lds + LDS_BYTES - 32) = __builtin_amdgcn_s_memrealtime();
#endif
  ph_prologue(p, lds);
  REP(0, ph_prologue(p, lds));
  STAMP(0); xcd_barrier(bar); STAMP(13);
  for (int l = 0; l < DEPTH; ++l) {
    ph_norm1(p, l, lds);            REP(1, ph_norm1<true>(p, l, lds)); STAMP(1); xcd_barrier(bar); STAMP(13);
    ph_inproj(p, l, lds);           REP(2, ph_inproj(p, l, lds)); STAMP(2); xcd_barrier(bar); STAMP(13);
    ph_prep(p, l, lds);             REP(3, ph_prep(p, l, lds)); STAMP(3);
    xcd_barrier(bar); STAMP(13);
    ph_mla_gemm(p, l, lds); REP(4, ph_mla_gemm(p, l, lds)); STAMP(4);
    moe_weights_layer<1, 0, 192>(p, l, 20736, NE * 768, 0, lds);
    ph_items(p, l, lds); REP(5, ph_items(p, l, lds)); REP(14, ph_items<1>(p, l, lds)); REP(15, ph_items<2>(p, l, lds)); STAMP(5); xcd_barrier(bar); STAMP(13);
    if (blockIdx.x < 32) ret_scan_job(p, l, blockIdx.x >> 1, blockIdx.x & 1, lds); else if (blockIdx.x < 64) gdn_scan_job(p, (blockIdx.x - 32) >> 1, blockIdx.x & 1, lds);
    REP(6, if (blockIdx.x < 32) ret_scan_job(p, l, blockIdx.x >> 1, blockIdx.x & 1, lds); else if (blockIdx.x < 64) gdn_scan_job(p, (blockIdx.x - 32) >> 1, blockIdx.x & 1, lds));
    STAMP(6);
    moe_weights_layer<1, 0, 32>(p, l, 0, 6752, 0, lds); moe_weights_layer<1, 0, 64>(p, l, 6752, 11840, 32, lds);
    ph_attn(p, l, (char*)shm);      REP(7, ph_attn(p, l, (char*)shm)); STAMP(15); STAMP(7);
    moe_weights_layer(p, l, 11840, 20736, 64, lds);
    if (l + 1 < DEPTH) dense_weights_layer(p, l + 1, 64, lds);
    xcd_barrier(bar); STAMP(13);
    ph_post3(p, l, lds);            REP(8, ph_post3(p, l, lds)); STAMP(8); xcd_barrier(bar); STAMP(13);
    ph_outproj(p, l, lds);
    REP(9, { FP q = p; q.X = (float*)p.SCR; ph_outproj(q, l, lds); }); STAMP(9); xcd_barrier(bar); STAMP(13);
    ph_norm2m(p, l, lds);           REP(10, ph_norm2<true>(p, l, lds)); STAMP(10); xcd_barrier(bar); STAMP(13);
    ph_gemm1(p, l, lds);            REP(11, ph_gemm1(p, l, lds)); STAMP(11); xcd_barrier(bar); STAMP(13);
    ph_gemm2(p, l, lds);            REP(12, ph_gemm2(p, l, lds)); STAMP(12);
    xcd_barrier(bar); STAMP(13);
  }
  ph_final(p, lds);
#if PROBE_A
  STAMP(14); xcd_barrier(bar); STAMP(13);
  __syncthreads(); asm volatile("s_waitcnt vmcnt(0)" ::: "memory");
  if (blockIdx.x == 0 && threadIdx.x == 0) { unsigned a = 0;
    for (int k = 0; k < 16; ++k) { const unsigned tv = ((volatile unsigned*)p.ctl)[3600 + k]; if ((PROBE_A >> k) & 1) a += tv; }
    const float us = (float)a * 0.01f; float q = floorf(us * (1.f / (float)PROBE_Q) + 0.5f);
#ifdef PROBE_NBLK
    { int tot = 0; for (int l = 0; l < DEPTH; ++l) { int nblk = 0; for (int e = 0; e < NE; ++e) nblk += (p.cnt[l * 32 + e] + 255) >> 8; tot += (PROBE_NBLK == 1) ? (nblk * 8 + 255) / 256 : (PROBE_NBLK == 2) ? (nblk * 4 + 255) / 256 : (l == PROBE_NBLK - 3 ? nblk - 272 : 0); } q = (float)(tot - (PROBE_NBLK == 1 ? 30 : PROBE_NBLK == 2 ? 10 : 0)); }
#endif
    p.out[0] += 4.f * q; }
#endif
}

static size_t f_layout(char* base, FP& p) {
  size_t o = 0; auto take = [&](size_t bytes) { char* q = base + o; o += (bytes + 255) & ~(size_t)255; return q; };
  p.ctl = (unsigned*)take((size_t)CTL_WORDS * 4); p.cnt = (int*)(p.ctl + 4096);
  p.Wt_in = (bf16_t*)take((size_t)DEPTH * INWP * 1024 * 2); p.Wt_mla = (bf16_t*)take((size_t)DEPTH * MLAN * MLAK * 2); p.Wt_out = (bf16_t*)take((size_t)DEPTH * 1024 * 1536 * 2);
  p.Wt_gu = (bf16_t*)take((size_t)DEPTH * NE * 2048 * 1024 * 2); p.Wt_dn = (bf16_t*)take((size_t)DEPTH * NE * 1024 * 1024 * 2);
  p.MOD = (float*)take((size_t)DEPTH * 5 * 6144 * 4); p.X = (float*)take((size_t)T * D * 4); p.GAB = (float*)take((size_t)T * 16 * 4); p.TOPW = (float*)take((size_t)T * 4 * 4);
  p.Hb = (bf16_t*)take((size_t)T * D * 2); p.H2b = (bf16_t*)take((size_t)T * D * 2); p.Pb = (bf16_t*)take((size_t)T * INWP * 2); p.CATb = (bf16_t*)take((size_t)T * 1536 * 2);
  p.ACTb = (bf16_t*)take((size_t)ROWS_P * 1024 * 2); p.YSb = (bf16_t*)take((size_t)ROWS_P * 1024 * 2);
  p.A2b = (bf16_t*)take((size_t)T * MLAK * 2); p.Qb = (bf16_t*)take((size_t)T * 768 * 2); p.Knb = (bf16_t*)take((size_t)T * 512 * 2); p.Vb = (bf16_t*)take((size_t)T * 512 * 2);
  p.KRb = (bf16_t*)take((size_t)T * 64 * 2); p.AOb = (bf16_t*)take((size_t)T * 512 * 2);
  p.RQb = (bf16_t*)take((size_t)T * 512 * 2); p.RKb = (bf16_t*)take((size_t)T * 512 * 2); p.RKWT = (bf16_t*)take((size_t)2 * 16 * NCH * 8192 * 2);
  p.RVTB = (bf16_t*)take((size_t)16 * NCH * 8192 * 2); p.RVTA = (bf16_t*)take((size_t)16 * NCH * 8192 * 2); p.RST = (bf16_t*)take((size_t)2 * 16 * NCH * 16384 * 2);
  p.GQb = (bf16_t*)take((size_t)T * 512 * 2); p.GKb = (bf16_t*)take((size_t)T * 512 * 2); p.GVb = (bf16_t*)take((size_t)T * 512 * 2);
  p.GLA = (float*)take((size_t)T * 8 * 4); p.GBETA = (float*)take((size_t)T * 8 * 4); p.GG = (float*)take((size_t)2 * 16 * NCH * 64 * 4);
  p.GWb = (bf16_t*)take((size_t)2 * 16 * NCH * 8192 * 2); p.GKTT = (bf16_t*)take((size_t)2 * 16 * NCH * 8192 * 2); p.GUT = (bf16_t*)take((size_t)2 * 16 * NCH * 8192 * 2);
  p.GVNT = (bf16_t*)take((size_t)2 * 16 * NCH * 8192 * 2); p.GST = (bf16_t*)take((size_t)2 * 16 * NCH * 16384 * 2);
  p.TOPE = (int*)take((size_t)T * 4 * 4); p.TOPP = (int*)take((size_t)T * 4 * 4); p.ROWTOK = (int*)take((size_t)NE * T * 4); p.SCR = (bf16_t*)take((size_t)T * D * 4 + 4096); p.ROPE = (float*)take(64 * 32 * 4); p.WRF = (bf16_t*)take((size_t)DEPTH * 2 * 64 * 64 * 8 * 2);
  return o;
}
}

extern "C" void kernel_launch(void* const* d_in, const int* in_sizes, int n_in, void* d_out, int out_size, void* d_ws, size_t ws_size, hipStream_t stream) {
  static int grid = 0;
  if (grid == 0) {
    if (hipFuncSetAttribute((const void*)fx::mega_fwd, hipFuncAttributeMaxDynamicSharedMemorySize, fx::LDS_BYTES) != hipSuccess) { fprintf(stderr, "kernel_launch: hipFuncSetAttribute failed\n"); grid = -1; return; }
    int dev = 0, cus = 0, per_cu = 0; (void)hipGetDevice(&dev); (void)hipDeviceGetAttribute(&cus, hipDeviceAttributeMultiprocessorCount, dev);
    if (hipOccupancyMaxActiveBlocksPerMultiprocessor(&per_cu, (const void*)fx::mega_fwd, 512, fx::LDS_BYTES) != hipSuccess || per_cu < 1) { fprintf(stderr, "kernel_launch: occupancy query says %d blocks per CU\n", per_cu); grid = -1; return; }
    grid = cus;
    if (grid < 64) { fprintf(stderr, "kernel_launch: needs >= 64 CUs\n"); grid = -1; return; }
  }
  if (grid < 0) return;
  fx::FP p{}; { const float** f = (const float**)&p; for (int i = 0; i < 28; ++i) f[i] = (const float*)d_in[i]; }
  p.out = (float*)d_out;
  const size_t fsz = fx::f_layout((char*)d_ws, p);
  if (fsz > ws_size || n_in != 28) { fprintf(stderr, "kernel_launch: ws too small (%zu > %zu) or n_in %d\n", fsz, ws_size, n_in); return; }
  (void)hipMemsetAsync(p.ctl, 0, (size_t)fx::CTL_WORDS * 4, stream);
  hipLaunchKernelGGL(fx::mega_fwd, dim3(grid), dim3(512), fx::LDS_BYTES, stream, p);
}
```

```cpp
#include <hip/hip_runtime.h>
#include <stdint.h>
#include <stdio.h>

namespace cfg {
constexpr int D = 1024, NB = 4, SEQ = 4096, DEPTH = 4, CTX = 256, GW = 64;
constexpr int SB = CTX + SEQ;
constexpr int T = NB * SB;
constexpr int INW = 4560;
constexpr int C_DQ = 0, C_DKV = 256, C_KR = 384, C_RQ = 448, C_RK = 960, C_RV = 1472, C_RG = 1984, C_GQ = 2496, C_GK = 3008, C_GV = 3520, C_GZ = 4032, C_GA = 4544, C_GB = 4552;
constexpr int NE = 32, TOPK = 4, DE = 1024;
}
namespace fx {
using namespace cfg;
#define LAS __attribute__((address_space(3)))
typedef unsigned short bf16_t;
typedef short bf16x8 __attribute__((ext_vector_type(8)));
typedef short s16x4 __attribute__((ext_vector_type(4)));
typedef float f32x4 __attribute__((ext_vector_type(4)));
typedef float f32x16 __attribute__((ext_vector_type(16)));
typedef unsigned u32x4 __attribute__((ext_vector_type(4)));
typedef unsigned u32x2 __attribute__((ext_vector_type(2)));

__device__ __forceinline__ int opaque_tid() { int t = threadIdx.x; asm volatile("" : "+v"(t)); return t; }
#define TIDX opaque_tid()
__device__ __forceinline__ float shx(float v, int m) { const int ln = TIDX & 63; return __int_as_float(__builtin_amdgcn_ds_bpermute((ln ^ m) << 2, __float_as_int(v))); }
__device__ __forceinline__ int shxi(int v, int m) { const int ln = TIDX & 63; return __builtin_amdgcn_ds_bpermute((ln ^ m) << 2, v); }
__device__ __forceinline__ float shup(float v, int o) { const int ln = TIDX & 63; const int src = ln >= o ? ln - o : ln; return __int_as_float(__builtin_amdgcn_ds_bpermute(src << 2, __float_as_int(v))); }
__device__ __forceinline__ int shupi(int v, int o) { const int ln = TIDX & 63; const int src = ln >= o ? ln - o : ln; return __builtin_amdgcn_ds_bpermute(src << 2, v); }
__device__ __forceinline__ float shdn(float v, int o) { const int ln = TIDX & 63; const int src = ln + o < 64 ? ln + o : ln; return __int_as_float(__builtin_amdgcn_ds_bpermute(src << 2, __float_as_int(v))); }
constexpr int NTHREADS = 512, NWAVES = 8;
constexpr int BM = 256, BK = 64, HALF = 128, HTB = HALF * BK * 2, STAGE_BYTES = 8 * HTB, NXCD = 8, WGM = 8;
constexpr int LDS_MISC = STAGE_BYTES;
constexpr int LDS_BYTES = 163840;
constexpr int INWP = 4608;
constexpr int MLAN = 1792, MLAK = 384;
constexpr int MAXBLK = (T * TOPK) / 256 + NE;
constexpr int ROWS_P = MAXBLK * 256;

__device__ __forceinline__ unsigned cvt_pk_bf16(float lo, float hi) { unsigned r; asm volatile("v_cvt_pk_bf16_f32 %0, %1, %2" : "=v"(r) : "v"(lo), "v"(hi)); return r; }
__device__ __forceinline__ float bf2f(unsigned short b) { return __uint_as_float(((unsigned)b) << 16); }
__device__ __forceinline__ bf16_t f2bf(float f) { unsigned u = __float_as_uint(f); u += 0x7fffu + ((u >> 16) & 1u); return (bf16_t)(u >> 16); }
__device__ __forceinline__ float bflo(unsigned w) { return __uint_as_float(w << 16); }
__device__ __forceinline__ float bfhi(unsigned w) { return __uint_as_float(w & 0xffff0000u); }
__device__ __forceinline__ float silu_f(float v) { return v / (1.f + __expf(-v)); }
__device__ __forceinline__ int crow16(int r, int hi) { return (r & 3) + 8 * (r >> 2) + 4 * hi; }

__host__ __device__ __forceinline__ int lds_byte(int r, int c) { const int st = (r >> 4) * 2 + (c >> 5), rr = r & 15, cc = c & 31, ob = rr * 64 + cc * 2; return st * 1024 + (ob ^ (((ob >> 9) & 1) << 5)); }
__host__ __device__ __forceinline__ void stage_rc(int b, int& R, int& C) { const int st = b / 1024, sb = b % 1024, swz = sb ^ (((sb >> 9) & 1) << 5); R = (st >> 1) * 16 + swz / 64; C = (st & 1) * 32 + (swz % 64) / 2; }
__host__ __device__ __forceinline__ int perm32(int rho) { const int n = rho >> 4, i = rho & 15; return 8 * (i >> 2) + 4 * n + (i & 3); }

struct Unit { int pm, pn, e, pad_; long aoff, boff; };
struct Gemm { const bf16_t* A; const bf16_t* Bt; int M, N, K; };

struct StaticOrder {
    static constexpr bool DYN_A = false;
    int nM, nN, nwg, G, c, K;
    __device__ void init(int M, int N, int K_, int G_, int c_) { nM = M / BM; nN = N / BM; nwg = nM * nN; G = G_; c = c_; K = K_; }
    __device__ bool next(int i, Unit& u) const {
        const long L = (long)i * G + c; if (L >= nwg) return false;
        int wgid = (int)L; { const int q = nwg / NXCD, r = nwg % NXCD, xcd = wgid % NXCD, off = wgid / NXCD; wgid = (xcd < r ? xcd * (q + 1) : r * (q + 1) + (xcd - r) * q) + off; }
        const int nig = WGM * nN, gid = wgid / nig, fm = gid * WGM, gsz = (nM - fm) < WGM ? (nM - fm) : WGM;
        u.pm = fm + ((wgid % nig) % gsz); u.pn = (wgid % nig) / gsz; u.e = 0; u.pad_ = 0;
        u.aoff = (long)u.pm * BM * K * 2; u.boff = (long)u.pn * BM * K * 2; return true;
    }
    __device__ __forceinline__ void a_off(const Unit&, const int (&R)[2], const int (&C)[2], unsigned (&v)[2][2]) const {
#pragma unroll
        for (int h = 0; h < 2; ++h)
#pragma unroll
            for (int i = 0; i < 2; ++i) v[h][i] = (unsigned)((h * HALF + R[i]) * K + C[i]) * 2u;
    }
};
struct LatentOrder {
    static constexpr bool DYN_A = false;
    int nN, G, c, K;
    __device__ bool next(int i, Unit& u) const {
        const int L = i * G + c; if (L >= 64 * nN) return false;
        const int lt = L / nN; u.pn = L % nN; u.pm = (lt >> 4) * 17 + 1 + (lt & 15); u.e = 0; u.pad_ = 0;
        u.aoff = (long)u.pm * BM * K * 2; u.boff = (long)u.pn * BM * K * 2; return true;
    }
    __device__ __forceinline__ void a_off(const Unit&, const int (&R)[2], const int (&C)[2], unsigned (&v)[2][2]) const {
#pragma unroll
        for (int h = 0; h < 2; ++h)
#pragma unroll
            for (int i = 0; i < 2; ++i) v[h][i] = (unsigned)((h * HALF + R[i]) * K + C[i]) * 2u;
    }
};
template <bool GATHER> struct MoeOrder {
    static constexpr bool DYN_A = GATHER;
    int nblk, NPN, G, c, K; const LAS int* blk_e; const LAS int* blk_j; const LAS int* ulist; int* rowtok; int* cnt; long bstride;
    __device__ bool next(int i, Unit& u) const {
        if (i >= __builtin_amdgcn_readfirstlane(ulist[0])) return false;
        const int blk = __builtin_amdgcn_readfirstlane(ulist[1 + 2 * i]); u.pn = __builtin_amdgcn_readfirstlane(ulist[2 + 2 * i]); u.pm = blk; u.e = __builtin_amdgcn_readfirstlane(blk_e[blk]); u.pad_ = __builtin_amdgcn_readfirstlane(blk_j[blk]);
        u.aoff = GATHER ? 0 : (long)blk * BM * K * 2; u.boff = (long)u.e * bstride + (long)u.pn * BM * K * 2; return true;
    }
    __device__ __forceinline__ void a_off(const Unit& u, const int (&R)[2], const int (&C)[2], unsigned (&v)[2][2]) const {
        if (GATHER) { const int n = __hip_atomic_load(&cnt[u.e], __ATOMIC_RELAXED, __HIP_MEMORY_SCOPE_AGENT); const int* lst = rowtok + (size_t)u.e * T + u.pad_ * 256;
#pragma unroll
            for (int h = 0; h < 2; ++h)
#pragma unroll
                for (int i = 0; i < 2; ++i) { const int rr = h * HALF + R[i]; const int tok = (u.pad_ * 256 + rr < n) ? __hip_atomic_load(&lst[rr], __ATOMIC_RELAXED, __HIP_MEMORY_SCOPE_AGENT) : 0;     v[h][i] = (unsigned)(tok * K + C[i]) * 2u; }
        } else {
#pragma unroll
            for (int h = 0; h < 2; ++h)
#pragma unroll
                for (int i = 0; i < 2; ++i) v[h][i] = (unsigned)((h * HALF + R[i]) * K + C[i]) * 2u;
        }
    }
};

struct EpiInproj {
    static constexpr bool PERM = true;
    bf16_t* O; float* GAB;
    __device__ __forceinline__ void operator()(const f32x4 (&acc)[2][2][4][2], const Unit& u, int wr, int wc, int fr, int fq) const {
        const int row0 = u.pm * BM + wr * 64 + fr, col0 = u.pn * BM + wc * 32 + 8 * fq;
#pragma unroll
        for (int ai = 0; ai < 2; ++ai)
#pragma unroll
            for (int m = 0; m < 4; ++m) { const int row = row0 + ai * HALF + m * 16; bf16_t* rowp = O + (size_t)row * INWP + col0;
#pragma unroll
                for (int bj = 0; bj < 2; ++bj) { const f32x4 v0 = acc[ai][bj][m][0], v1 = acc[ai][bj][m][1];
                    u32x4 w; w.x = cvt_pk_bf16(v0[0], v0[1]); w.y = cvt_pk_bf16(v0[2], v0[3]); w.z = cvt_pk_bf16(v1[0], v1[1]); w.w = cvt_pk_bf16(v1[2], v1[3]);
                    *(u32x4*)(rowp + bj * HALF) = w; }
                if (u.pn == 17 && wc == 2 && fq < 2) { float* gp = GAB + (size_t)row * 16 + fq * 8; *(f32x4*)gp = acc[ai][1][m][0]; *(f32x4*)(gp + 4) = acc[ai][1][m][1]; } }
    }
};
struct EpiOutproj {
    static constexpr bool PERM = false;
    float* X; const float* MODl;
    __device__ __forceinline__ void operator()(const f32x4 (&acc)[2][2][4][2], const Unit& u, int wr, int wc, int fr, int fq) const {
        const int row0 = u.pm * BM + wr * 64 + fr, col0 = u.pn * BM + wc * 32 + 4 * fq; const int rmod = (u.pm % 17 == 0) ? 4 : u.pm / 17;
        const float* gt = MODl + (size_t)rmod * 6144 + 2048 + col0; f32x4 gv[2][2];
#pragma unroll
        for (int bj = 0; bj < 2; ++bj)
#pragma unroll
            for (int n = 0; n < 2; ++n) gv[bj][n] = *(const f32x4*)(gt + bj * HALF + n * 16);
#pragma unroll
        for (int ai = 0; ai < 2; ++ai)
#pragma unroll
            for (int m = 0; m < 4; ++m) { float* rowp = X + (size_t)(row0 + ai * HALF + m * 16) * D + col0;
#pragma unroll
                for (int bj = 0; bj < 2; ++bj)
#pragma unroll
                    for (int n = 0; n < 2; ++n) { f32x4* p = (f32x4*)(rowp + bj * HALF + n * 16); *p = *p + gv[bj][n] * acc[ai][bj][m][n]; } }
    }
};
struct EpiGateUp {
    static constexpr bool PERM = true;
    bf16_t* ACT; const float* bgu;
    __device__ __forceinline__ void operator()(const f32x4 (&acc)[2][2][4][2], const Unit& u, int wr, int wc, int fr, int fq) const {
        const int row0 = u.pm * BM + wr * 64 + fr, oc = u.pn * HALF + wc * 32 + 8 * fq; const float* bg = bgu + (size_t)u.e * 2048 + oc;
        f32x4 bgv[2], buv[2];
#pragma unroll
        for (int n = 0; n < 2; ++n) { bgv[n] = *(const f32x4*)(bg + 4 * n); buv[n] = *(const f32x4*)(bg + 1024 + 4 * n); }
#pragma unroll
        for (int ai = 0; ai < 2; ++ai)
#pragma unroll
            for (int m = 0; m < 4; ++m) { float o[8];
#pragma unroll
                for (int n = 0; n < 2; ++n) { const f32x4 gv = acc[ai][0][m][n] + bgv[n], uv = acc[ai][1][m][n] + buv[n];
#pragma unroll
                    for (int j = 0; j < 4; ++j) { const float gg = fminf(gv[j], 7.f), uu = fminf(fmaxf(uv[j], -7.f), 7.f); o[n * 4 + j] = (uu + 1.f) * gg / (1.f + __expf(-1.702f * gg)); } }
                u32x4 w; w.x = cvt_pk_bf16(o[0], o[1]); w.y = cvt_pk_bf16(o[2], o[3]); w.z = cvt_pk_bf16(o[4], o[5]); w.w = cvt_pk_bf16(o[6], o[7]);
                *(u32x4*)(ACT + (size_t)(row0 + ai * HALF + m * 16) * 1024 + oc) = w; }
    }
};
struct EpiDown {
    static constexpr bool PERM = true;
    bf16_t* YS; const float* bdn;
    __device__ __forceinline__ void operator()(const f32x4 (&acc)[2][2][4][2], const Unit& u, int wr, int wc, int fr, int fq) const {
        const int row0 = u.pm * BM + wr * 64 + fr, col0 = u.pn * BM + wc * 32 + 8 * fq; const float* bb = bdn + (size_t)u.e * 1024 + col0;
        f32x4 bv[2][2];
#pragma unroll
        for (int bj = 0; bj < 2; ++bj)
#pragma unroll
            for (int n = 0; n < 2; ++n) bv[bj][n] = *(const f32x4*)(bb + bj * HALF + 4 * n);
#pragma unroll
        for (int ai = 0; ai < 2; ++ai)
#pragma unroll
            for (int m = 0; m < 4; ++m) { bf16_t* rowp = YS + (size_t)(row0 + ai * HALF + m * 16) * 1024 + col0;
#pragma unroll
                for (int bj = 0; bj < 2; ++bj) { const f32x4 v0 = acc[ai][bj][m][0] + bv[bj][0], v1 = acc[ai][bj][m][1] + bv[bj][1];
                    u32x4 w; w.x = cvt_pk_bf16(v0[0], v0[1]); w.y = cvt_pk_bf16(v0[2], v0[3]); w.z = cvt_pk_bf16(v1[0], v1[1]); w.w = cvt_pk_bf16(v1[2], v1[3]);
                    *(u32x4*)(rowp + bj * HALF) = w; } }
    }
};

template <class Epi, class Sched>
__device__ __forceinline__ void gemm_phase(LAS unsigned char* lds, const Gemm g, const Sched& S, const Epi& E) {
    const int tid = TIDX, wid = __builtin_amdgcn_readfirstlane(tid >> 6), lane = tid & 63, wr = wid >> 2, wc = wid & 3, fr = lane & 15, fq = lane >> 4;
    const int K = g.K, nt = K / BK;
    int Rr[2], Cc[2]; unsigned voffB[2];
#pragma unroll
    for (int i = 0; i < 2; ++i) { int R, C; stage_rc(tid * 16 + i * 8192, R, C); Rr[i] = R; Cc[i] = C; const int Rb = Epi::PERM ? ((R & ~31) + perm32(R & 31)) : R; voffB[i] = (unsigned)(Rb * K + C) * 2u; }
    const size_t kstep = (size_t)(BK * 2);
    const size_t hstep = (size_t)HALF * K * 2;
    const unsigned ldsw = (unsigned)wid * 1024u;
    const int aoff = lds_byte(wr * 64 + fr, fq * 8), boff = lds_byte(wc * 32 + fr, fq * 8);
#define PG8_SA(b, h) (((b) * 2 + (h)) * HTB)
#define PG8_SB(b, h) ((4 + (b) * 2 + (h)) * HTB)
#define PG8_STAGE(bufoff, gbase, voff) do { _Pragma("unroll") for (int _i = 0; _i < 2; ++_i) \
        __builtin_amdgcn_global_load_lds((const unsigned*)((const char*)(gbase) + (voff)[_i]), (LAS unsigned*)(lds + (bufoff) + ldsw + _i * 8192), 16, 0, 0); } while (0)
#define PG8_LDA(dst, b, h) do { _Pragma("unroll") for (int m = 0; m < 4; ++m) _Pragma("unroll") for (int k = 0; k < 2; ++k) dst[m][k] = *(const LAS bf16x8*)(lds + PG8_SA(b, h) + aoff + m * 2048 + k * 1024); } while (0)
#define PG8_LDB(dst, b, h) do { _Pragma("unroll") for (int n = 0; n < 2; ++n) _Pragma("unroll") for (int k = 0; k < 2; ++k) dst[n][k] = *(const LAS bf16x8*)(lds + PG8_SB(b, h) + boff + n * 2048 + k * 1024); } while (0)
#define PG8_MMA(ai, bj, At, Bt) do { __builtin_amdgcn_s_setprio(1); _Pragma("unroll") for (int m = 0; m < 4; ++m) _Pragma("unroll") for (int n = 0; n < 2; ++n) _Pragma("unroll") for (int k = 0; k < 2; ++k) \
        acc[ai][bj][m][n] = __builtin_amdgcn_mfma_f32_16x16x32_bf16(Bt[n][k], At[m][k], acc[ai][bj][m][n], 0, 0, 0); __builtin_amdgcn_s_setprio(0); } while (0)
#define PG8_WAIT_V(n) asm volatile("s_waitcnt vmcnt(" #n ")" ::: "memory")
#define PG8_WAIT_L(n) asm volatile("s_waitcnt lgkmcnt(" #n ")" ::: "memory")
#define PG8_BAR __builtin_amdgcn_s_barrier()
#define PG8_SCHED __builtin_amdgcn_sched_barrier(0)
    Unit cur, nxt; int ui = 0;
    if (!S.next(0, cur)) return;
    f32x4 acc[2][2][4][2];
#pragma unroll
    for (int a = 0; a < 2; ++a)
#pragma unroll
        for (int b = 0; b < 2; ++b)
#pragma unroll
            for (int m = 0; m < 4; ++m)
#pragma unroll
                for (int n = 0; n < 2; ++n) acc[a][b][m][n] = (f32x4){0.f, 0.f, 0.f, 0.f};
    bf16x8 At[4][2], B0[2][2], B1[2][2];
    unsigned vAc[2][2], vAn[2][2];
    S.a_off(cur, Rr, Cc, vAc);
    const char* cA = (const char*)g.A + cur.aoff; const char* cB = (const char*)g.Bt + cur.boff;
    PG8_STAGE(PG8_SB(0, 0), cB, voffB); PG8_STAGE(PG8_SA(0, 0), cA, vAc[0]); PG8_STAGE(PG8_SB(0, 1), cB + hstep, voffB); PG8_STAGE(PG8_SA(0, 1), cA, vAc[1]);
    if (wr == 1) PG8_BAR;
    PG8_WAIT_V(4); PG8_BAR;
    PG8_STAGE(PG8_SB(1, 0), cB + kstep, voffB); PG8_STAGE(PG8_SA(1, 0), cA + kstep, vAc[0]); PG8_STAGE(PG8_SB(1, 1), cB + hstep + kstep, voffB);
    PG8_WAIT_V(6); PG8_BAR;
    for (;;) {
        const bool has_next = S.next(ui + 1, nxt);
        if (!Sched::DYN_A) { }
        else if (has_next) S.a_off(nxt, Rr, Cc, vAn);
        else {
#pragma unroll
            for (int h = 0; h < 2; ++h)
#pragma unroll
                for (int i = 0; i < 2; ++i) vAn[h][i] = vAc[h][i]; }
        const char* nA = has_next ? (const char*)g.A + nxt.aoff : cA; const char* nB = has_next ? (const char*)g.Bt + nxt.boff : cB;
#pragma unroll 1
        for (int t = 0; t < nt; t += 2) {
            const bool last = (t == nt - 2);
            const char* a1 = cA + (size_t)(t + 1) * kstep;
            const char* a2 = last ? nA : cA + (size_t)(t + 2) * kstep; const char* b2 = last ? nB : cB + (size_t)(t + 2) * kstep;
            const char* a3 = a2 + kstep; const char* b3 = b2 + kstep;
            unsigned w2[2][2];
#pragma unroll
            for (int h = 0; h < 2; ++h)
#pragma unroll
                for (int i = 0; i < 2; ++i) w2[h][i] = (Sched::DYN_A && last) ? vAn[h][i] : vAc[h][i];
            PG8_LDB(B0, 0, 0); PG8_SCHED; PG8_LDA(At, 0, 0); PG8_STAGE(PG8_SA(1, 1), a1, vAc[1]);
            PG8_WAIT_L(8); PG8_BAR; PG8_WAIT_L(0); PG8_MMA(0, 0, At, B0); PG8_BAR; PG8_SCHED;
            PG8_LDB(B1, 0, 1); PG8_STAGE(PG8_SB(0, 0), b2, voffB);
            PG8_BAR; PG8_WAIT_L(0); PG8_MMA(0, 1, At, B1); PG8_BAR;
            PG8_LDA(At, 0, 1); PG8_STAGE(PG8_SA(0, 0), a2, w2[0]);
            PG8_BAR; PG8_WAIT_L(0); PG8_MMA(1, 0, At, B0); PG8_BAR; PG8_SCHED;
            PG8_STAGE(PG8_SB(0, 1), b2 + hstep, voffB);
            PG8_WAIT_V(6); PG8_BAR; PG8_MMA(1, 1, At, B1); PG8_BAR;
            PG8_LDB(B0, 1, 0); PG8_SCHED; PG8_LDA(At, 1, 0); PG8_STAGE(PG8_SA(0, 1), a2, w2[1]);
            PG8_WAIT_L(8); PG8_BAR; PG8_WAIT_L(0); PG8_MMA(0, 0, At, B0); PG8_BAR; PG8_SCHED;
            PG8_LDB(B1, 1, 1); PG8_STAGE(PG8_SB(1, 0), b3, voffB);
            PG8_BAR; PG8_WAIT_L(0); PG8_MMA(0, 1, At, B1); PG8_BAR;
            PG8_LDA(At, 1, 1); PG8_STAGE(PG8_SA(1, 0), a3, w2[0]);
            PG8_BAR; PG8_WAIT_L(0); PG8_MMA(1, 0, At, B0); PG8_BAR; PG8_SCHED;
            PG8_STAGE(PG8_SB(1, 1), b3 + hstep, voffB);
            PG8_WAIT_V(6); PG8_BAR; PG8_MMA(1, 1, At, B1); PG8_BAR;
        }
        asm volatile("s_nop 9\n\ts_nop 9" : "+v"(acc[1][1][3][1]), "+v"(acc[1][1][3][0]), "+v"(acc[1][1][2][1]), "+v"(acc[1][1][2][0]));
        { int tz = TIDX; const int wz = tz >> 6, lz = tz & 63; E(acc, cur, wz >> 2, wz & 3, lz & 15, lz >> 4); }
        if (!has_next) break;
#pragma unroll
        for (int a = 0; a < 2; ++a)
#pragma unroll
            for (int b = 0; b < 2; ++b)
#pragma unroll
                for (int m = 0; m < 4; ++m)
#pragma unroll
                    for (int n = 0; n < 2; ++n) acc[a][b][m][n] = (f32x4){0.f, 0.f, 0.f, 0.f};
        cur = nxt; cA = nA; cB = nB; ++ui;
#pragma unroll
        for (int h = 0; h < 2; ++h)
#pragma unroll
            for (int i = 0; i < 2; ++i) if (Sched::DYN_A) vAc[h][i] = vAn[h][i];
    }
    PG8_WAIT_V(0);
    if (wr == 0) PG8_BAR;
    PG8_BAR;
#undef PG8_SA
#undef PG8_SB
#undef PG8_STAGE
#undef PG8_LDA
#undef PG8_LDB
#undef PG8_MMA
#undef PG8_WAIT_V
#undef PG8_WAIT_L
#undef PG8_BAR
#undef PG8_SCHED
}
struct FP {
  const float *x, *c, *ctx, *c_ctx, *w_mod, *b_mod, *g_norm1, *g_norm2, *w_in, *g_cq, *g_ckv, *w_uq, *w_ukv, *g_mla, *ret_decay, *g_ret, *gdn_conv, *gdn_a_log,
      *gdn_dt_bias, *g_gdn, *w_out, *w_router, *b_router, *w_gate_up, *b_gate_up, *w_down, *b_down, *g_final;
  float* out;
  unsigned* ctl; int* cnt;
  bf16_t *Wt_in, *Wt_mla, *Wt_out, *Wt_gu, *Wt_dn;
  float *MOD, *X, *GAB, *TOPW;
  bf16_t *Hb, *H2b, *Pb, *CATb, *ACTb, *YSb;
  int *TOPE, *TOPP, *ROWTOK;
  bf16_t *A2b, *Qb, *Knb, *Vb, *KRb, *AOb;
  bf16_t *RQb, *RKb, *RKWT, *RVTB, *RVTA, *RST;
  bf16_t *GQb, *GKb, *GVb, *GUT, *GWb, *GKTT, *GVNT, *GST;
  float *GG, *GBETA, *GLA; bf16_t* SCR; float* ROPE; bf16_t* WRF;
};
constexpr int CTL_WORDS = 4096 + DEPTH * 32;

template <int MAP> __device__ __forceinline__ void tr_tile(const float* src, int lds_, int k0, int n0, int N, bf16_t* dst, int ldd, int kcol0, LAS float* tile) {
  const int t = TIDX;
#pragma unroll
  for (int i = 0; i < 2; ++i) { const int idx = t + 512 * i, k = idx >> 4, n4 = (idx & 15) * 4; f32x4 v = (f32x4){0.f, 0.f, 0.f, 0.f};
    if (n0 + n4 < N) v = *(const f32x4*)(src + (size_t)(k0 + k) * lds_ + n0 + n4);
    tile[k * 65 + n4 + 0] = v[0]; tile[k * 65 + n4 + 1] = v[1]; tile[k * 65 + n4 + 2] = v[2]; tile[k * 65 + n4 + 3] = v[3]; }
  __syncthreads();
  { const int n = t >> 3, k8 = (t & 7) * 8; float o[8];
#pragma unroll
    for (int j = 0; j < 8; ++j) o[j] = tile[(k8 + j) * 65 + n];
    u32x4 w; w.x = cvt_pk_bf16(o[0], o[1]); w.y = cvt_pk_bf16(o[2], o[3]); w.z = cvt_pk_bf16(o[4], o[5]); w.w = cvt_pk_bf16(o[6], o[7]);
    int gn = n0 + n, row;
    if (MAP == 1) { const int bj = gn >> 10, c = gn & 1023; row = (c >> 7) * 256 + bj * 128 + (c & 127); }
    else row = gn;
    *(u32x4*)(dst + (size_t)row * ldd + kcol0 + k0 + k8) = w; }
  __syncthreads();
}

__device__ void dense_weights_layer(const FP& p, int l, int b0, LAS unsigned char* lds) {
  LAS float* tile = (LAS float*)lds; int bid_ = (int)blockIdx.x; asm volatile("" : "+s"(bid_));
  const int me = bid_ - b0, nb = (int)gridDim.x - b0, t = TIDX; if (me < 0 || nb <= 0) return;
  __syncthreads();
  constexpr int L_IN = 16 * 72, L_OUT = 24 * 16, L_UQ = 4 * 12, L_UKV = 2 * 16;
  for (int id = me; id < L_IN + L_OUT + L_UQ + L_UKV; id += nb) { int r = id;
    if (r < L_IN) { const int kt = r / 72, nt = r % 72;
      tr_tile<0>(p.w_in + (size_t)l * 1024 * INW, INW, kt * 64, nt * 64, INW, p.Wt_in + (size_t)l * INWP * 1024, 1024, 0, tile); continue; }
    r -= L_IN;
    if (r < L_OUT) { const int kt = r / 16, nt = r % 16;
      tr_tile<0>(p.w_out + (size_t)l * 1536 * 1024, 1024, kt * 64, nt * 64, 1024, p.Wt_out + (size_t)l * 1024 * 1536, 1536, 0, tile); continue; }
    r -= L_OUT;
    if (r < L_UQ) { const int kt = r / 12, nt = r % 12;
      tr_tile<0>(p.w_uq + (size_t)l * 256 * 768, 768, kt * 64, nt * 64, 768, p.Wt_mla + (size_t)l * MLAN * MLAK, MLAK, 0, tile); continue; }
    r -= L_UQ;
    { const int kt = r / 16, nt = r % 16;
      tr_tile<0>(p.w_ukv + (size_t)l * 128 * 1024, 1024, kt * 64, nt * 64, 1024, p.Wt_mla + (size_t)l * MLAN * MLAK + (size_t)768 * MLAK, MLAK, 256, tile); } }
  { unsigned zz = 0u; asm volatile("" : "+v"(zz)); const u32x4 z = (u32x4){zz, zz, zz, zz};
    const int gtid = me * NTHREADS + t, gstr = nb * NTHREADS;
    for (int i = gtid; i < 768 * 16; i += gstr) { const int rr = i / 16, c8 = (i % 16) * 8; *(u32x4*)(p.Wt_mla + ((size_t)l * MLAN + rr) * MLAK + 256 + c8) = z; }
    for (int i = gtid; i < 1024 * 32; i += gstr) { const int rr = i / 32, c8 = (i % 32) * 8; *(u32x4*)(p.Wt_mla + ((size_t)l * MLAN + 768 + rr) * MLAK + c8) = z; } }
}

__device__ void ph_prologue(const FP& p, LAS unsigned char* lds) {
  const int G = gridDim.x, bid = blockIdx.x, t = TIDX;
  dense_weights_layer(p, 0, 0, lds);
  for (int i = bid * NTHREADS + t; i < DEPTH * 64 * 64; i += G * NTHREADS) { const int l = i >> 12, s = (i >> 6) & 63, ln = i & 63; u32x4 wh, wl; unsigned hh[8], ll[8];
#pragma unroll
    for (int jj = 0; jj < 8; ++jj) { const float w = p.w_router[((size_t)l * D + 16 * s + 8 * (ln >> 5) + jj) * NE + (ln & 31)]; unsigned u = __float_as_uint(w); u += 0x7fffu + ((u >> 16) & 1u); hh[jj] = u >> 16;
      const float res = w - __uint_as_float(hh[jj] << 16); unsigned v = __float_as_uint(res); v += 0x7fffu + ((v >> 16) & 1u); ll[jj] = v >> 16; }
    wh.x = hh[0] | (hh[1] << 16); wh.y = hh[2] | (hh[3] << 16); wh.z = hh[4] | (hh[5] << 16); wh.w = hh[6] | (hh[7] << 16); wl.x = ll[0] | (ll[1] << 16); wl.y = ll[2] | (ll[3] << 16); wl.z = ll[4] | (ll[5] << 16); wl.w = ll[6] | (ll[7] << 16);
    *(u32x4*)(p.WRF + ((size_t)(l * 2) * 64 * 64 + (s * 64 + ln)) * 8) = wh; *(u32x4*)(p.WRF + ((size_t)(l * 2 + 1) * 64 * 64 + (s * 64 + ln)) * 8) = wl; }
  if (bid == 0) for (int i = t; i < 64 * 16; i += NTHREADS) { const int pos = i >> 4, f = i & 15; const float ang = (float)pos * expf(-(float)f * (9.210340371976184f / 16.f)); p.ROPE[pos * 32 + f] = cosf(ang); p.ROPE[pos * 32 + 16 + f] = sinf(ang); }
  { LAS float* sc = (LAS float*)(lds + 32768);
    LAS float* part = (LAS float*)(lds + 32768 + 5 * 1024 * 4);
    __syncthreads();
    for (int i = t; i < 5 * 1024; i += NTHREADS) { const int r = i >> 10, k = i & 1023; const float v = r < 4 ? p.c[r * 1024 + k] : p.c_ctx[k]; sc[i] = v / (1.f + expf(-v)); }
    __syncthreads();
    for (int item = bid; item < DEPTH * 64; item += G) { const int l = item >> 6, c0 = (item & 63) * 96, col = t % 96, ks = t / 96;
      if (ks < 5) { float a[5] = {0.f, 0.f, 0.f, 0.f, 0.f}; const float* w = p.w_mod + (size_t)l * 1024 * 6144 + c0 + col; const int k0 = ks * 205, k1 = k0 + 205 < 1024 ? k0 + 205 : 1024;
#pragma unroll 8
        for (int k = k0; k < k1; ++k) { const float wv = w[(size_t)k * 6144];
#pragma unroll
          for (int r = 0; r < 5; ++r) a[r] += sc[r * 1024 + k] * wv; }
#pragma unroll
        for (int r = 0; r < 5; ++r) part[(ks * 96 + col) * 5 + r] = a[r]; }
      __syncthreads();
      if (t < 96) {
#pragma unroll
        for (int r = 0; r < 5; ++r) { float sm = 0.f;
#pragma unroll
          for (int q = 0; q < 5; ++q) sm += part[(q * 96 + t) * 5 + r];
          p.MOD[(size_t)(l * 5 + r) * 6144 + c0 + t] = sm + p.b_mod[l * 6144 + c0 + t]; } }
      __syncthreads(); } }
}

template <int step = 1, int off = 0, int B1 = 1 << 30> __device__ void moe_weights_layer(const FP& p, int l, int t0, int t1, int b0, LAS unsigned char* lds) {
  int bid_ = (int)blockIdx.x; asm volatile("" : "+s"(bid_));
  LAS float* tile = (LAS float*)lds; const int me0 = bid_ - b0; if (me0 < 0 || bid_ >= B1 || (step > 1 && (me0 & (step - 1)) != off)) return;
  const int gtop = (int)gridDim.x < B1 ? (int)gridDim.x : B1;
  int me = step > 1 ? me0 >> (step == 2 ? 1 : 2) : me0; const int nb = step > 1 ? (gtop - b0 - off + step - 1) >> (step == 2 ? 1 : 2) : gtop - b0; if (nb <= 0) return;
  const int t = TIDX;
  auto src_of = [&](int sid, int& ld) -> const float* { const int id = sid * 4;
    if (id < NE * 512) { const int m = l * NE + id / 512, tt = id % 512, kt = tt / 32, nt = tt % 32; ld = 2048; return p.w_gate_up + (size_t)m * 1024 * 2048 + (size_t)(kt * 64) * 2048 + nt * 64; }
    const int r = id - NE * 512; const int m = l * NE + r / 256, tt = r % 256, kt = tt / 16, nt = tt % 16; ld = 1024; return p.w_down + (size_t)m * 1024 * 1024 + (size_t)(kt * 64) * 1024 + nt * 64; };
  auto load_strip = [&](int sid, f32x4 (&v)[8]) { int ld; const float* src = src_of(sid, ld);
#pragma unroll
    for (int i = 0; i < 8; ++i) { const int idx = t + 512 * i, tb = idx >> 10, q = idx & 1023, k = q >> 4, n4 = (q & 15) * 4; v[i] = *(const f32x4*)((const char*)src + (unsigned)(k * ld + tb * 64 + n4) * 4u); } };
  __syncthreads();
  const int s0 = t0 / 4 + me, s1 = t1 / 4;
  auto process = [&](int sid, const f32x4 (&v)[8]) {
#pragma unroll
    for (int i = 0; i < 8; ++i) { const int idx = t + 512 * i, tb = idx >> 10, q = idx & 1023, k = q >> 4, n4 = (q & 15) * 4; LAS float* tp = tile + tb * (64 * 65) + k * 65 + n4;
      tp[0] = v[i][0]; tp[1] = v[i][1]; tp[2] = v[i][2]; tp[3] = v[i][3]; }
    __syncthreads();
    { const int id = sid * 4, n = t >> 3, k8 = (t & 7) * 8;
      const bool gu = id < NE * 512; const int r = gu ? id : id - NE * 512; const int m = l * NE + (gu ? r / 512 : r / 256), tt = gu ? r % 512 : r % 256, kt = gu ? tt / 32 : tt / 16, nt = gu ? tt % 32 : tt % 16;
      bf16_t* dst = gu ? p.Wt_gu + (size_t)m * 2048 * 1024 : p.Wt_dn + (size_t)m * 1024 * 1024;
#pragma unroll
      for (int tb = 0; tb < 4; ++tb) { float o[8];
#pragma unroll
        for (int j = 0; j < 8; ++j) o[j] = tile[tb * (64 * 65) + (k8 + j) * 65 + n];
        u32x4 w; w.x = cvt_pk_bf16(o[0], o[1]); w.y = cvt_pk_bf16(o[2], o[3]); w.z = cvt_pk_bf16(o[4], o[5]); w.w = cvt_pk_bf16(o[6], o[7]);
        const int gn = (nt + tb) * 64 + n; int row;
        if (gu) { const int bj = gn >> 10, c = gn & 1023; row = (c >> 7) * 256 + bj * 128 + (c & 127); }
        else row = gn;
        *(u32x4*)((char*)dst + (unsigned)(row * 1024 + kt * 64 + k8) * 2u) = w; } }
    __syncthreads(); };
  f32x4 va[8], vb[8];
  if (s0 < s1) load_strip(s0, va);
#pragma unroll 1
  for (int sid = s0; sid < s1; sid += 2 * nb) {
    if (sid + nb < s1) load_strip(sid + nb, vb);
    process(sid, va);
    if (sid + nb >= s1) break;
    if (sid + 2 * nb < s1) load_strip(sid + 2 * nb, va);
    process(sid + nb, vb); }
}

struct MoeTab { LAS int* blk_e; LAS int* blk_j; LAS int* start; int nblk; };
__device__ __forceinline__ MoeTab moe_tables(const int* cntl, LAS unsigned char* misc) {
  MoeTab m; m.blk_e = (LAS int*)misc; m.blk_j = m.blk_e + MAXBLK; m.start = m.blk_j + MAXBLK;
  const int t = TIDX;
  __syncthreads();
  if (t < 64) { const int e = t & 31; const int nb = (__hip_atomic_load(&cntl[e], __ATOMIC_RELAXED, __HIP_MEMORY_SCOPE_AGENT) + 255) >> 8; int incl = nb;
#pragma unroll
    for (int o = 1; o < 32; o <<= 1) { const int v = shupi(incl, o); if ((t & 31) >= o) incl += v; }
    if (t < 32) { m.start[e] = incl - nb; if (e == 31) m.start[32] = incl; } }
  __syncthreads();
  m.nblk = m.start[32];
  for (int blk = t; blk < m.nblk; blk += NTHREADS) { int e = 0;
    while (m.start[e + 1] <= blk) ++e;
    m.blk_e[blk] = e; m.blk_j[blk] = blk - m.start[e]; }
  __syncthreads();
  return m;
}

__device__ __forceinline__ LAS int* moe_unit_list(const MoeTab& m, int NPN) {
  LAS int* ul = m.start + 40; const int t = TIDX;
  if (t < 32) { const int q = t * (int)gridDim.x + (int)blockIdx.x; const bool ok = q < m.nblk * NPN;
    if (ok) { ul[1 + 2 * t] = q / NPN; ul[2 + 2 * t] = q % NPN; }
    const unsigned long long bal = __ballot(ok); if (t == 0) ul[0] = __popcll(bal); }
  __syncthreads();
  return ul;
}

__device__ __forceinline__ float dpp_add(float v, int ctrl_is) { return v; }
#define DPP_F(v, ctrl) __int_as_float(__builtin_amdgcn_update_dpp(0, __float_as_int(v), (ctrl), 0xf, 0xf, false))
__device__ __forceinline__ float wave_sum(float v) {
  v += DPP_F(v, 0xB1); v += DPP_F(v, 0x4E); v += DPP_F(v, 0x141); v += DPP_F(v, 0x140);
  const float r0 = __uint_as_float(__builtin_amdgcn_readlane(__float_as_uint(v), 0)), r1 = __uint_as_float(__builtin_amdgcn_readlane(__float_as_uint(v), 16));
  const float r2 = __uint_as_float(__builtin_amdgcn_readlane(__float_as_uint(v), 32)), r3 = __uint_as_float(__builtin_amdgcn_readlane(__float_as_uint(v), 48));
  return (r0 + r1) + (r2 + r3); }

__device__ __forceinline__ void moe_combine_row(const FP& p, int lprev, int row, const LAS int* start, const float* gate, int lane, f32x4 (&x)[4]) {
  int sl[4]; float w[4];
#pragma unroll
  for (int k = 0; k < 4; ++k) { const int e = p.TOPE[row * 4 + k]; sl[k] = start[e] * 256 + p.TOPP[row * 4 + k]; w[k] = p.TOPW[row * 4 + k]; }
#pragma unroll
  for (int i = 0; i < 4; ++i) { f32x4 y = (f32x4){0.f, 0.f, 0.f, 0.f};
#pragma unroll
    for (int k = 0; k < 4; ++k) { const u32x2 v = *(const u32x2*)(p.YSb + (size_t)sl[k] * 1024 + i * 256 + lane * 4);
      y[0] += w[k] * bflo(v.x); y[1] += w[k] * bfhi(v.x); y[2] += w[k] * bflo(v.y); y[3] += w[k] * bfhi(v.y); }
    const f32x4 g = *(const f32x4*)(gate + i * 256 + lane * 4); x[i] = x[i] + g * y; }
}

template <bool DRY = false> __device__ void ph_norm1(const FP& p, int l, LAS unsigned char* lds) {
  const int t = TIDX, lane = t & 63, gw = blockIdx.x * NWAVES + (t >> 6), GWN = gridDim.x * NWAVES;
  MoeTab mt{}; if (l > 0) mt = moe_tables(p.cnt + (l - 1) * 32, lds + LDS_MISC);
  const float* MODl = p.MOD + (size_t)l * 5 * 6144; const float* MODp = p.MOD + (size_t)(l > 0 ? l - 1 : 0) * 5 * 6144; const float* g1 = p.g_norm1 + l * D;
  for (int row = gw; row < T; row += GWN) { const int b = row / SB, s = row % SB, r = s < CTX ? 4 : b;
    f32x4 x[4];
    { const float* src = l > 0 ? p.X + (size_t)row * D : (s < CTX ? p.ctx + ((size_t)b * CTX + s) * D : p.x + ((size_t)b * SEQ + (s - CTX)) * D);
#pragma unroll
      for (int i = 0; i < 4; ++i) x[i] = *(const f32x4*)(src + i * 256 + lane * 4); }
    if (l > 0) moe_combine_row(p, l - 1, row, mt.start, MODp + (size_t)r * 6144 + 5120, lane, x);
    if (!DRY) {
#pragma unroll
      for (int i = 0; i < 4; ++i) *(f32x4*)(p.X + (size_t)row * D + i * 256 + lane * 4) = x[i]; }
    float ss = 0.f;
#pragma unroll
    for (int i = 0; i < 4; ++i) ss += x[i][0] * x[i][0] + x[i][1] * x[i][1] + x[i][2] * x[i][2] + x[i][3] * x[i][3];
    ss = wave_sum(ss); const float rs = rsqrtf(ss * (1.f / 1024.f) + 1e-6f);
    const float* m = MODl + (size_t)r * 6144;
#pragma unroll
    for (int i = 0; i < 4; ++i) { const int c = i * 256 + lane * 4; const f32x4 g = *(const f32x4*)(g1 + c), sc = *(const f32x4*)(m + 1024 + c), sh = *(const f32x4*)(m + c);
      const f32x4 h = x[i] * rs * g * (sc + 1.f) + sh; u32x2 w; w.x = cvt_pk_bf16(h[0], h[1]); w.y = cvt_pk_bf16(h[2], h[3]);
      *(u32x2*)((DRY ? p.SCR : p.Hb) + (size_t)row * D + c) = w; } }
}

template <bool DRY = false> __device__ void ph_norm2(const FP& p, int l, LAS unsigned char* lds) {
  const int t = TIDX, lane = t & 63, gw = blockIdx.x * NWAVES + (t >> 6), GWN = gridDim.x * NWAVES;
  LAS float* wT = (LAS float*)lds;
  __syncthreads();
  { const float* wr = p.w_router + (size_t)l * D * NE;
    for (int i = t; i < D * NE / 4; i += NTHREADS) { const int c = i >> 3, e4 = (i & 7) * 4; const f32x4 v = *(const f32x4*)(wr + (size_t)c * NE + e4);
      wT[(e4 + 0) * 1024 + c] = v[0]; wT[(e4 + 1) * 1024 + c] = v[1]; wT[(e4 + 2) * 1024 + c] = v[2]; wT[(e4 + 3) * 1024 + c] = v[3]; } }
  __syncthreads();
  const float* MODl = p.MOD + (size_t)l * 5 * 6144; const float* g2 = p.g_norm2 + l * D; int* cntl = p.cnt + l * 32;
  const float myb = p.b_router[l * NE + (lane >> 1)];
  for (int row = gw; row < T; row += GWN) { const int b = row / SB, s = row % SB, r = s < CTX ? 4 : b;
    if (l == DEPTH - 1 && s < CTX) continue;
    f32x4 h[4]; float ss = 0.f;
#pragma unroll
    for (int i = 0; i < 4; ++i) { h[i] = *(const f32x4*)(p.X + (size_t)row * D + i * 256 + lane * 4); ss += h[i][0] * h[i][0] + h[i][1] * h[i][1] + h[i][2] * h[i][2] + h[i][3] * h[i][3]; }
    ss = wave_sum(ss); const float rs = rsqrtf(ss * (1.f / 1024.f) + 1e-6f);
    const float* m = MODl + (size_t)r * 6144;
#pragma unroll
    for (int i = 0; i < 4; ++i) { const int c = i * 256 + lane * 4; const f32x4 g = *(const f32x4*)(g2 + c), sc = *(const f32x4*)(m + 4096 + c), sh = *(const f32x4*)(m + 3072 + c);
      h[i] = h[i] * rs * g * (sc + 1.f) + sh; u32x2 w; w.x = cvt_pk_bf16(h[i][0], h[i][1]); w.y = cvt_pk_bf16(h[i][2], h[i][3]);
      *(u32x2*)((DRY ? p.SCR : p.H2b) + (size_t)row * D + c) = w; }
#ifdef PROBE_NOROUTER
    if (DRY) continue;
#endif
    float acc[32];
#pragma unroll
    for (int e = 0; e < 32; ++e) { float a = 0.f;
#pragma unroll
      for (int i = 0; i < 4; ++i) { const f32x4 w = *(const LAS f32x4*)(wT + e * 1024 + i * 256 + lane * 4); a += h[i][0] * w[0] + h[i][1] * w[1] + h[i][2] * w[2] + h[i][3] * w[3]; }
      acc[e] = a; }
#define BFLY(NV, BIT) { const bool up = (lane >> (BIT)) & 1; _Pragma("unroll") for (int e = 0; e < (NV) / 2; ++e) { const float a = acc[e], bq = acc[e + (NV) / 2]; const float keep = up ? bq : a, send = up ? a : bq; acc[e] = keep + shx(send, 1 << (BIT)); } }
    BFLY(32, 5) BFLY(16, 4) BFLY(8, 3) BFLY(4, 2) BFLY(2, 1)
#undef BFLY
    float v = acc[0] + shx(acc[0], 1); v += myb;
    float lg[32];
#pragma unroll
    for (int e = 0; e < 32; ++e) lg[e] = __uint_as_float(__builtin_amdgcn_readlane(__float_as_uint(v), 2 * e));
    float tv[4]; int ti[4];
#pragma unroll
    for (int k = 0; k < 4; ++k) { float bv = -3.0e38f; int bi = 0;
#pragma unroll
      for (int e = 0; e < 32; ++e) { if (lg[e] > bv) { bv = lg[e]; bi = e; } }
      tv[k] = bv; ti[k] = bi;
#pragma unroll
      for (int e = 0; e < 32; ++e) if (e == bi) lg[e] = -3.0e38f; }
    if (lane == 0) { float e4[4], sum = 0.f;
#pragma unroll
      for (int k = 0; k < 4; ++k) { e4[k] = expf(tv[k] - tv[0]); sum += e4[k]; }
      const float inv = 1.f / sum;
#pragma unroll
      for (int k = 0; k < 4; ++k) { if (DRY) { ((float*)p.SCR)[(size_t)T * 512 + row * 4 + k] = e4[k] * inv + (float)ti[k]; continue; } const int pos = atomicAdd(&cntl[ti[k]], 1); p.TOPE[row * 4 + k] = ti[k]; p.TOPP[row * 4 + k] = pos; p.TOPW[row * 4 + k] = e4[k] * inv; __hip_atomic_store(&p.ROWTOK[(size_t)ti[k] * T + pos], row, __ATOMIC_RELAXED, __HIP_MEMORY_SCOPE_AGENT);     } } }
}

__device__ void ph_final(const FP& p, LAS unsigned char* lds) {
  const int t = TIDX, lane = t & 63, gw = blockIdx.x * NWAVES + (t >> 6), GWN = gridDim.x * NWAVES;
  MoeTab mt = moe_tables(p.cnt + (DEPTH - 1) * 32, lds + LDS_MISC);
  const float* MODp = p.MOD + (size_t)(DEPTH - 1) * 5 * 6144;
  for (int orow = gw; orow < NB * SEQ; orow += GWN) { const int b = orow / SEQ, tk = orow % SEQ, row = b * SB + CTX + tk;
    f32x4 x[4];
#pragma unroll
    for (int i = 0; i < 4; ++i) x[i] = *(const f32x4*)(p.X + (size_t)row * D + i * 256 + lane * 4);
    moe_combine_row(p, DEPTH - 1, row, mt.start, MODp + (size_t)b * 6144 + 5120, lane, x);
    float ss = 0.f;
#pragma unroll
    for (int i = 0; i < 4; ++i) ss += x[i][0] * x[i][0] + x[i][1] * x[i][1] + x[i][2] * x[i][2] + x[i][3] * x[i][3];
    ss = wave_sum(ss); const float rs = rsqrtf(ss * (1.f / 1024.f) + 1e-6f);
#pragma unroll
    for (int i = 0; i < 4; ++i) { const int c = i * 256 + lane * 4; const f32x4 g = *(const f32x4*)(p.g_final + c); *(f32x4*)(p.out + (size_t)orow * D + c) = x[i] * rs * g; } }
}

__device__ void ph_inproj(const FP& p, int l, LAS unsigned char* lds) {
  Gemm g; g.A = p.Hb; g.Bt = p.Wt_in + (size_t)l * INWP * 1024; g.M = T; g.N = INWP; g.K = 1024;
  StaticOrder S; S.init(T, INWP, 1024, gridDim.x, blockIdx.x); EpiInproj E; E.O = p.Pb; E.GAB = p.GAB;
  gemm_phase<EpiInproj, StaticOrder>(lds, g, S, E);
}
__device__ void outproj_ctx(const FP& p, int l, LAS unsigned char* lds) {
  const int t = TIDX, w = t >> 6, lane = t & 63, c32 = lane & 31, hi = lane >> 5;
  const bf16_t* Bt = p.Wt_out + (size_t)l * 1024 * 1536; const float* gate = p.MOD + (size_t)l * 5 * 6144 + 4 * 6144 + 2048;
  LAS float* lf = (LAS float*)lds;
  for (int u = blockIdx.x; u < 256; u += gridDim.x) { const int cu = u >> 4, st = u & 15, batch = cu >> 2, pn = cu & 3, sr = st >> 2, sc = st & 3;
    const int r0 = batch * SB + 64 * sr, c0 = pn * 256 + 64 * sc;
    const bf16_t* ap = p.CATb + (size_t)(r0 + c32) * 1536 + 192 * w + 8 * hi; const bf16_t* bp = Bt + (size_t)(c0 + c32) * 1536 + 192 * w + 8 * hi;
    f32x16 acc[2][2];
#pragma unroll
    for (int m = 0; m < 2; ++m)
#pragma unroll
      for (int n = 0; n < 2; ++n)
#pragma unroll
        for (int r = 0; r < 16; ++r) acc[m][n][r] = 0.f;
#pragma unroll
    for (int sg = 0; sg < 3; ++sg) { bf16x8 af[2][4], bfr[2][4];
#pragma unroll
      for (int s = 0; s < 4; ++s)
#pragma unroll
        for (int m = 0; m < 2; ++m) { af[m][s] = *(const bf16x8*)(ap + (size_t)m * 32 * 1536 + (sg * 4 + s) * 16); bfr[m][s] = *(const bf16x8*)(bp + (size_t)m * 32 * 1536 + (sg * 4 + s) * 16); }
#pragma unroll
      for (int s = 0; s < 4; ++s)
#pragma unroll
        for (int m = 0; m < 2; ++m)
#pragma unroll
          for (int n = 0; n < 2; ++n) acc[m][n] = __builtin_amdgcn_mfma_f32_32x32x16_bf16(af[m][s], bfr[n][s], acc[m][n], 0, 0, 0); }
    __syncthreads();
#pragma unroll
    for (int m = 0; m < 2; ++m)
#pragma unroll
      for (int n = 0; n < 2; ++n)
#pragma unroll
        for (int r = 0; r < 16; ++r) lf[w * 4096 + (32 * m + crow16(r, hi)) * 64 + 32 * n + c32] = acc[m][n][r];
    __syncthreads();
    { const int row = t >> 3, col = (t & 7) * 8; f32x4 s0 = (f32x4){0.f, 0.f, 0.f, 0.f}, s1 = s0;
#pragma unroll
      for (int ww = 0; ww < 8; ++ww) { s0 = s0 + *(const LAS f32x4*)(lf + ww * 4096 + row * 64 + col); s1 = s1 + *(const LAS f32x4*)(lf + ww * 4096 + row * 64 + col + 4); }
      const f32x4 g0 = *(const f32x4*)(gate + c0 + col), g1 = *(const f32x4*)(gate + c0 + col + 4);
      float* xp = p.X + (size_t)(r0 + row) * D + c0 + col;
      *(f32x4*)xp = *(const f32x4*)xp + g0 * s0; *(f32x4*)(xp + 4) = *(const f32x4*)(xp + 4) + g1 * s1; }
    __syncthreads(); }
}
__device__ void ph_outproj(const FP& p, int l, LAS unsigned char* lds) {
  Gemm g; g.A = p.CATb; g.Bt = p.Wt_out + (size_t)l * 1024 * 1536; g.M = T; g.N = 1024; g.K = 1536;
  EpiOutproj E; E.X = p.X; E.MODl = p.MOD + (size_t)l * 5 * 6144;
  { LatentOrder S; S.nN = 4; S.G = gridDim.x; S.c = blockIdx.x; S.K = 1536; gemm_phase<EpiOutproj, LatentOrder>(lds, g, S, E); }
  if (l != DEPTH - 1) outproj_ctx(p, l, lds);
}
__device__ void ph_gemm1(const FP& p, int l, LAS unsigned char* lds) {
  MoeTab mt = moe_tables(p.cnt + l * 32, lds + LDS_MISC);
  Gemm g; g.A = p.H2b; g.Bt = p.Wt_gu + (size_t)l * NE * 2048 * 1024; g.M = 0; g.N = 2048; g.K = 1024;
  MoeOrder<true> S; S.nblk = mt.nblk; S.NPN = 8; S.G = gridDim.x; S.c = blockIdx.x; S.K = 1024; S.blk_e = mt.blk_e; S.blk_j = mt.blk_j; S.ulist = moe_unit_list(mt, 8); S.rowtok = p.ROWTOK; S.cnt = p.cnt + l * 32; S.bstride = (long)2048 * 1024 * 2;
  EpiGateUp E; E.ACT = p.ACTb; E.bgu = p.b_gate_up + (size_t)l * NE * 2048;
  gemm_phase<EpiGateUp, MoeOrder<true>>(lds, g, S, E);
}
__device__ void ph_gemm2(const FP& p, int l, LAS unsigned char* lds) {
  MoeTab mt = moe_tables(p.cnt + l * 32, lds + LDS_MISC);
  Gemm g; g.A = p.ACTb; g.Bt = p.Wt_dn + (size_t)l * NE * 1024 * 1024; g.M = 0; g.N = 1024; g.K = 1024;
  MoeOrder<false> S; S.nblk = mt.nblk; S.NPN = 4; S.G = gridDim.x; S.c = blockIdx.x; S.K = 1024; S.blk_e = mt.blk_e; S.blk_j = mt.blk_j; S.ulist = moe_unit_list(mt, 4); S.rowtok = nullptr; S.cnt = p.cnt + l * 32; S.bstride = (long)1024 * 1024 * 2;
  EpiDown E; E.YS = p.YSb; E.bdn = p.b_down + (size_t)l * NE * 1024;
  gemm_phase<EpiDown, MoeOrder<false>>(lds, g, S, E);
}
constexpr float QSCALE = 0.07216878364870322f * 1.4426950408889634f;

__device__ __forceinline__ void prep_mla_row(const FP& p, int l, int row, int lane) {
  const int s = row % SB; const bool lat = s >= CTX; const int tok = s - CTX;
  const bf16_t* pr = p.Pb + (size_t)row * INWP;
  { const u32x2 v = *(const u32x2*)(pr + C_DQ + lane * 4); float x[4] = {bflo(v.x), bfhi(v.x), bflo(v.y), bfhi(v.y)};
    const float ss = wave_sum(x[0] * x[0] + x[1] * x[1] + x[2] * x[2] + x[3] * x[3]); const float rs = rsqrtf(ss * (1.f / 256.f) + 1e-6f);
    const f32x4 g = *(const f32x4*)(p.g_cq + l * 256 + lane * 4); u32x2 w; w.x = cvt_pk_bf16(x[0] * rs * g[0], x[1] * rs * g[1]); w.y = cvt_pk_bf16(x[2] * rs * g[2], x[3] * rs * g[3]);
    *(u32x2*)(p.A2b + (size_t)row * MLAK + lane * 4) = w; }
  { const unsigned v = *(const unsigned*)(pr + C_DKV + lane * 2); const float x0 = bflo(v), x1 = bfhi(v);
    const float ss = wave_sum(x0 * x0 + x1 * x1); const float rs = rsqrtf(ss * (1.f / 128.f) + 1e-6f);
    const float g0 = p.g_ckv[l * 128 + lane * 2], g1 = p.g_ckv[l * 128 + lane * 2 + 1];
    *(unsigned*)(p.A2b + (size_t)row * MLAK + 256 + lane * 2) = cvt_pk_bf16(x0 * rs * g0, x1 * rs * g1); }
  { const float x = bf2f(pr[C_KR + lane]); const float xp = shx(x, 16); float y = x;
    if (lat) { const int hh = lane >> 5, ii = lane & 31, fi = ii & 15; const float pos = (float)(hh == 0 ? (tok >> 6) : (tok & 63));
      const float ang = pos * __expf(-(float)fi * (9.210340371976184f / 16.f)); const float cs = __cosf(ang), sn = __sinf(ang);
      y = ii < 16 ? x * cs - xp * sn : x * cs + xp * sn; }
    unsigned u = __float_as_uint(y); u += 0x7fffu + ((u >> 16) & 1u); p.KRb[(size_t)row * 64 + lane] = (bf16_t)(u >> 16); }
}

struct EpiMla {
    static constexpr bool PERM = false;
    bf16_t *Q, *Kn, *V; const float* ROPE;
    __device__ __forceinline__ void operator()(const f32x4 (&acc)[2][2][4][2], const Unit& u, int wr, int wc, int fr, int fq) const {
        const int row0 = u.pm * BM + wr * 64 + fr; const bool ctxt = (u.pm % 17) == 0; const int tok0 = (u.pm % 17 - 1) * 256 + wr * 64 + fr;
        if (u.pn < 3) {
#pragma unroll
            for (int bj = 0; bj < 2; ++bj) { const int cg = u.pn * 256 + bj * 128 + wc * 32;
                const int g6 = (cg >> 5) % 6;
#pragma unroll
                for (int ai = 0; ai < 2; ++ai)
#pragma unroll
                    for (int m = 0; m < 4; ++m) { const int row = row0 + ai * HALF + m * 16; f32x4 v0 = acc[ai][bj][m][0], v1 = acc[ai][bj][m][1];
                        if (g6 >= 4 && !ctxt) { const int tok = tok0 + ai * HALF + m * 16; const int pos = g6 == 4 ? (tok >> 6) : (tok & 63);
                            const f32x4 cs = *(const f32x4*)(ROPE + pos * 32 + 4 * fq), sn = *(const f32x4*)(ROPE + pos * 32 + 16 + 4 * fq);
#pragma unroll
                            for (int j = 0; j < 4; ++j) { const float x1 = v0[j], x2 = v1[j]; v0[j] = x1 * cs[j] - x2 * sn[j]; v1[j] = x2 * cs[j] + x1 * sn[j]; } }
                        v0 = v0 * QSCALE; v1 = v1 * QSCALE;
                        bf16_t* qp = Q + (size_t)row * 768 + cg + 4 * fq; u32x2 w0, w1; w0.x = cvt_pk_bf16(v0[0], v0[1]); w0.y = cvt_pk_bf16(v0[2], v0[3]); w1.x = cvt_pk_bf16(v1[0], v1[1]); w1.y = cvt_pk_bf16(v1[2], v1[3]);
                        *(u32x2*)qp = w0; *(u32x2*)(qp + 16) = w1; } }
        } else { const int h = u.pn - 3;
#pragma unroll
            for (int bj = 0; bj < 2; ++bj) { bf16_t* base = (bj == 0 ? Kn : V) + h * 128 + wc * 32 + 4 * fq;
#pragma unroll
                for (int ai = 0; ai < 2; ++ai)
#pragma unroll
                    for (int m = 0; m < 4; ++m) { const int row = row0 + ai * HALF + m * 16; const f32x4 v0 = acc[ai][bj][m][0], v1 = acc[ai][bj][m][1];
                        u32x2 w0, w1; w0.x = cvt_pk_bf16(v0[0], v0[1]); w0.y = cvt_pk_bf16(v0[2], v0[3]); w1.x = cvt_pk_bf16(v1[0], v1[1]); w1.y = cvt_pk_bf16(v1[2], v1[3]);
                        *(u32x2*)(base + (size_t)row * 512) = w0; *(u32x2*)(base + (size_t)row * 512 + 16) = w1; } } }
    }
};
__device__ void ph_mla_gemm(const FP& p, int l, LAS unsigned char* lds) {
  Gemm g; g.A = p.A2b; g.Bt = p.Wt_mla + (size_t)l * MLAN * MLAK; g.M = T; g.N = MLAN; g.K = MLAK;
  StaticOrder S; S.init(T, MLAN, MLAK, gridDim.x, blockIdx.x); EpiMla E; E.Q = p.Qb; E.Kn = p.Knb; E.V = p.Vb; E.ROPE = p.ROPE;
  gemm_phase<EpiMla, StaticOrder>(lds, g, S, E);
}

namespace att {
constexpr int NW = 8, QBLK = 32, KVBLK = 64;
constexpr float THRL = 8.f * 1.4426950408889634f;
constexpr int SHM_V = KVBLK * 128 * 2, SHM_K = KVBLK * 128 * 2, SHM_R = KVBLK * 64 * 2;
constexpr int OFF_V = 0, OFF_K = 2 * SHM_V, OFF_R = OFF_K + 2 * SHM_K, OFF_WS = OFF_R + 2 * SHM_R, OFF_Q = OFF_WS + NW * 64 * 4, SHM_ATTN = OFF_Q + 256 * 128;
#define KSWZ(row, colB) ((row) * 256 + ((colB) ^ (((row) & 7) << 4)))
#define RSWZ(row, colB) ((row) * 128 + ((colB) ^ ((((row) >> 1) & 7) << 4)))
#define SBAR() __builtin_amdgcn_sched_barrier(0)
__device__ __forceinline__ int crow(int r, int hi) { return (r & 3) + 8 * (r >> 2) + 4 * hi; }
__device__ __forceinline__ void partialSM(f32x16& p0, f32x16& p1, float& m_reg, float& mn, float& alpha) {
  float pmax = p0[0];
#pragma unroll
  for (int r = 1; r < 16; ++r) pmax = fmaxf(pmax, p0[r]);
#pragma unroll
  for (int r = 0; r < 16; ++r) pmax = fmaxf(pmax, p1[r]);
  { auto rr = __builtin_amdgcn_permlane32_swap(__float_as_uint(pmax), __float_as_uint(pmax), false, false); pmax = fmaxf(__uint_as_float(rr[0]), __uint_as_float(rr[1])); }
  if (__builtin_expect(__all(pmax - m_reg <= THRL), 1)) { mn = m_reg; alpha = 1.f; }
  else { mn = fmaxf(m_reg, pmax); alpha = __builtin_amdgcn_exp2f(m_reg - mn); m_reg = mn; }
#pragma unroll
  for (int r = 0; r < 16; ++r) p0[r] = p0[r] - mn;
#pragma unroll
  for (int r = 0; r < 16; ++r) p1[r] = p1[r] - mn;
#pragma unroll
  for (int r = 0; r < 16; ++r) p0[r] = __builtin_amdgcn_exp2f(p0[r]);
}
__device__ __forceinline__ void finishSM(f32x16& p0, f32x16& p1, float alpha, float& l_reg, bf16x8& pa0, bf16x8& pa1, bf16x8& pa2, bf16x8& pa3) {
#pragma unroll
  for (int r = 0; r < 16; ++r) p1[r] = __builtin_amdgcn_exp2f(p1[r]);
  float ps = 0;
#pragma unroll
  for (int r = 0; r < 16; ++r) ps += p0[r];
#pragma unroll
  for (int r = 0; r < 16; ++r) ps += p1[r];
  { auto rr = __builtin_amdgcn_permlane32_swap(__float_as_uint(ps), __float_as_uint(ps), false, false); ps = __uint_as_float(rr[0]) + __uint_as_float(rr[1]); }
  l_reg = l_reg * alpha + ps;
#define PK4(P, BASE, OUT) do { unsigned a0 = cvt_pk_bf16(P[BASE + 0], P[BASE + 1]), a1 = cvt_pk_bf16(P[BASE + 2], P[BASE + 3]);   \
    unsigned b0 = cvt_pk_bf16(P[BASE + 4], P[BASE + 5]), b1 = cvt_pk_bf16(P[BASE + 6], P[BASE + 7]);                              \
    auto r0 = __builtin_amdgcn_permlane32_swap(a0, b0, false, false); auto r1 = __builtin_amdgcn_permlane32_swap(a1, b1, false, false); \
    u32x4 w = {r0[0], r1[0], r0[1], r1[1]}; OUT = *reinterpret_cast<bf16x8*>(&w); } while (0)
  PK4(p0, 0, pa0); PK4(p0, 8, pa1); PK4(p1, 0, pa2); PK4(p1, 8, pa3);
#undef PK4
}
__device__ __forceinline__ void qkt(f32x16& p0, f32x16& p1, const char* Ks, const char* Rs, const bf16x8* qr, const char* qrow, int qsw, int r32, int hi) {
  p0 = f32x16{}; p1 = f32x16{};
#pragma unroll
  for (int d0 = 0; d0 < 8; ++d0) { const int cb = (d0 * 16 + hi * 8) * 2;
    const bf16x8 b0 = *reinterpret_cast<const bf16x8*>(Ks + KSWZ(r32, cb));
    const bf16x8 b1 = *reinterpret_cast<const bf16x8*>(Ks + KSWZ(32 + r32, cb));
    p0 = __builtin_amdgcn_mfma_f32_32x32x16_bf16(b0, qr[d0], p0, 0, 0, 0);
    p1 = __builtin_amdgcn_mfma_f32_32x32x16_bf16(b1, qr[d0], p1, 0, 0, 0); }
#pragma unroll
  for (int d0 = 0; d0 < 4; ++d0) { const int cb = (d0 * 16 + hi * 8) * 2;
    const bf16x8 b0 = *reinterpret_cast<const bf16x8*>(Rs + RSWZ(r32, cb));
    const bf16x8 b1 = *reinterpret_cast<const bf16x8*>(Rs + RSWZ(32 + r32, cb));
    const bf16x8 qf = *reinterpret_cast<const bf16x8*>(qrow + (cb ^ qsw));
    p0 = __builtin_amdgcn_mfma_f32_32x32x16_bf16(b0, qf, p0, 0, 0, 0);
    p1 = __builtin_amdgcn_mfma_f32_32x32x16_bf16(b1, qf, p1, 0, 0, 0); }
}
__device__ __forceinline__ int v_st(int k, int c) { const int kk = (k & ~0xC) | ((k & 4) << 1) | ((k & 8) >> 1); return ((kk >> 3) * 4 + (c >> 5)) * 512 + ((kk & 7) * 32 + (c & 31)) * 2; }
__device__ __forceinline__ int v_rd_base(int lane) { return ((lane & 3) << 3) | (((lane >> 2) & 3) << 6) | (((lane >> 4) & 1) << 5) | (((lane >> 5) & 1) << 8); }
constexpr int v_rd_off(int d0, int ks, int half) { return d0 * 512 + ks * 4096 + half * 2048; }
template <int OFF> __device__ __forceinline__ s16x4 tr_read(int vb) { s16x4 r; asm volatile("ds_read_b64_tr_b16 %0, %1 offset:%2" : "=&v"(r) : "v"(vb), "i"(OFF) : "memory"); return r; }
template <int D0> __device__ __forceinline__ void pv_one(f32x16& od, int vb, bf16x8 pa0, bf16x8 pa1, bf16x8 pa2, bf16x8 pa3) {
  const s16x4 l0 = tr_read<v_rd_off(D0, 0, 0)>(vb), h0 = tr_read<v_rd_off(D0, 0, 1)>(vb), l1 = tr_read<v_rd_off(D0, 1, 0)>(vb), h1 = tr_read<v_rd_off(D0, 1, 1)>(vb);
  const s16x4 l2 = tr_read<v_rd_off(D0, 2, 0)>(vb), h2 = tr_read<v_rd_off(D0, 2, 1)>(vb), l3 = tr_read<v_rd_off(D0, 3, 0)>(vb), h3 = tr_read<v_rd_off(D0, 3, 1)>(vb);
  asm volatile("s_waitcnt lgkmcnt(0)" ::: "memory"); SBAR();
#define PK(L, H) (bf16x8){L[0], L[1], L[2], L[3], H[0], H[1], H[2], H[3]}
  od = __builtin_amdgcn_mfma_f32_32x32x16_bf16(pa0, PK(l0, h0), od, 0, 0, 0);
  od = __builtin_amdgcn_mfma_f32_32x32x16_bf16(pa1, PK(l1, h1), od, 0, 0, 0);
  od = __builtin_amdgcn_mfma_f32_32x32x16_bf16(pa2, PK(l2, h2), od, 0, 0, 0);
  od = __builtin_amdgcn_mfma_f32_32x32x16_bf16(pa3, PK(l3, h3), od, 0, 0, 0);
#undef PK
}
__device__ __forceinline__ void pv_d0(f32x16* o, int vb, bf16x8 pa0, bf16x8 pa1, bf16x8 pa2, bf16x8 pa3) {
  pv_one<0>(o[0], vb, pa0, pa1, pa2, pa3); pv_one<1>(o[1], vb, pa0, pa1, pa2, pa3); pv_one<2>(o[2], vb, pa0, pa1, pa2, pa3); pv_one<3>(o[3], vb, pa0, pa1, pa2, pa3);
}
template <bool PARTIAL = false> __device__ __forceinline__ void attn_body(const bf16_t* __restrict__ Qb, const bf16_t* __restrict__ Kh, const bf16_t* __restrict__ Rh, const bf16_t* __restrict__ Vh,
                                          bf16_t* __restrict__ Ob, int seq, char* lds, float* __restrict__ PO = nullptr, float* __restrict__ PML = nullptr) {
  const int tid = TIDX, wid = tid >> 6, lane = tid & 63, r32 = lane & 31, hi = lane >> 5;
  char* V_lds = lds + OFF_V; char* K_lds = lds + OFF_K; char* R_lds = lds + OFF_R;
  float* ws = (float*)(lds + OFF_WS) + wid * 64; float* li_l = ws; float* al_l = ws + 32;
  float m_reg = -1e30f, l_reg = 0; f32x16 o[4] = {}; bf16x8 qr[8];
  const bf16_t* Qw = Qb + (size_t)(wid * QBLK + r32) * 768 + hi * 8;
#pragma unroll
  for (int d0 = 0; d0 < 8; ++d0) qr[d0] = *reinterpret_cast<const bf16x8*>(Qw + d0 * 16);
  const int qrowi = wid * QBLK + r32; char* qrow = lds + OFF_Q + qrowi * 128; const int qsw = ((qrowi >> 1) & 7) << 4;
#pragma unroll
  for (int d0 = 0; d0 < 4; ++d0) *reinterpret_cast<bf16x8*>(qrow + (((d0 * 16 + hi * 8) * 2) ^ qsw)) = *reinterpret_cast<const bf16x8*>(Qw + (8 + d0) * 16);
  const int sr = tid >> 4, sc = (tid & 15) * 8, vst0 = v_st(sr, sc), vst1 = v_st(32 + sr, sc);
  const int rr = tid >> 3, rc = (tid & 7) * 8;
  const int vb0 = (int)(uintptr_t)V_lds + v_rd_base(lane);
  bf16x8 vs0, vs1, ks0, ks1, rs0;
  const unsigned kvo0 = (unsigned)(sr * 512 + sc) * 2u, kvo1 = kvo0 + 32u * 512u * 2u, ro0 = (unsigned)(rr * 64 + rc) * 2u;
#define SLOAD(k0) do { const char* Vt = (const char*)Vh + (size_t)(k0) * 1024; const char* Kt = (const char*)Kh + (size_t)(k0) * 1024; const char* Rt = (const char*)Rh + (size_t)(k0) * 128; \
    vs0 = *(const bf16x8*)(Vt + kvo0); vs1 = *(const bf16x8*)(Vt + kvo1); ks0 = *(const bf16x8*)(Kt + kvo0); ks1 = *(const bf16x8*)(Kt + kvo1); rs0 = *(const bf16x8*)(Rt + ro0); } while (0)
#define SWRITE(b) do { *(bf16x8*)(V_lds + (b) * SHM_V + vst0) = vs0; *(bf16x8*)(V_lds + (b) * SHM_V + vst1) = vs1; const int kc = sc * 2; \
    *(bf16x8*)(K_lds + (b) * SHM_K + KSWZ(sr, kc)) = ks0; *(bf16x8*)(K_lds + (b) * SHM_K + KSWZ(32 + sr, kc)) = ks1; \
    *(bf16x8*)(R_lds + (b) * SHM_R + RSWZ(rr, rc * 2)) = rs0; } while (0)
#define SWAIT() asm volatile("s_waitcnt vmcnt(0)" ::: "memory")
#define RESC(a) do { if (__any((a) < 1.f)) { if (hi == 0) al_l[r32] = (a); asm volatile("s_waitcnt lgkmcnt(0)" ::: "memory"); \
    _Pragma("unroll") for (int d = 0; d < 4; ++d) _Pragma("unroll") for (int r = 0; r < 16; ++r) o[d][r] *= al_l[crow(r, hi)]; } } while (0)
  f32x16 pA0, pA1, pB0, pB1; float mnA, mnB, alA, alB; bf16x8 pa0, pa1, pa2, pa3; const int NT = seq / KVBLK;
  SLOAD(0); SWAIT(); SWRITE(0); __syncthreads();
  qkt(pA0, pA1, K_lds, R_lds, qr, qrow, qsw, r32, hi); partialSM(pA0, pA1, m_reg, mnA, alA);
  SLOAD(KVBLK);
  SWAIT(); SWRITE(1); __syncthreads();
  for (int j = 1; j + 1 < NT; j += 2) {
    SBAR(); qkt(pB0, pB1, K_lds + SHM_K, R_lds + SHM_R, qr, qrow, qsw, r32, hi);
    finishSM(pA0, pA1, alA, l_reg, pa0, pa1, pa2, pa3); SBAR();
    SLOAD((j + 1) * KVBLK); SBAR();
    pv_d0(o, vb0, pa0, pa1, pa2, pa3); partialSM(pB0, pB1, m_reg, mnB, alB);
    __syncthreads(); SWAIT(); SWRITE(0);
    RESC(alB); __syncthreads();
    SBAR(); qkt(pA0, pA1, K_lds, R_lds, qr, qrow, qsw, r32, hi);
    finishSM(pB0, pB1, alB, l_reg, pa0, pa1, pa2, pa3); SBAR();
    SLOAD((j + 2) * KVBLK); SBAR();
    pv_d0(o, vb0 + SHM_V, pa0, pa1, pa2, pa3); partialSM(pA0, pA1, m_reg, mnA, alA);
    __syncthreads(); SWAIT(); SWRITE(1);
    RESC(alA); __syncthreads();
  }
  SBAR(); qkt(pB0, pB1, K_lds + SHM_K, R_lds + SHM_R, qr, qrow, qsw, r32, hi);
  finishSM(pA0, pA1, alA, l_reg, pa0, pa1, pa2, pa3); SBAR();
  pv_d0(o, vb0, pa0, pa1, pa2, pa3); partialSM(pB0, pB1, m_reg, mnB, alB);
  __syncthreads(); RESC(alB);
  finishSM(pB0, pB1, alB, l_reg, pa0, pa1, pa2, pa3); SBAR();
  pv_d0(o, vb0 + SHM_V, pa0, pa1, pa2, pa3);
  if (PARTIAL) { int tz = TIDX; const int wz = tz >> 6, lz = tz & 63;
    if ((lz >> 5) == 0) { PML[wz * QBLK + lz] = m_reg; PML[256 + wz * QBLK + lz] = l_reg; }
    float* po = PO + (size_t)(wz * QBLK + 4 * (lz >> 5)) * 128 + (lz & 31);
#pragma unroll
    for (int r = 0; r < 16; ++r)
#pragma unroll
      for (int d0 = 0; d0 < 4; ++d0) po[((r & 3) + 8 * (r >> 2)) * 128 + d0 * 32] = o[d0][r];
    __syncthreads(); return; }
  if (hi == 0) li_l[r32] = l_reg; asm volatile("s_waitcnt lgkmcnt(0)" ::: "memory");
  float rli[16];
#pragma unroll
  for (int r = 0; r < 16; ++r) rli[r] = __builtin_amdgcn_rcpf(li_l[crow(r, hi)]);
  { int tz = TIDX; const int wz = tz >> 6, lz = tz & 63; const unsigned ob = (unsigned)((wz * QBLK + 4 * (lz >> 5)) * 512 + (lz & 31)) * 2u;
#pragma unroll
    for (int r = 0; r < 16; ++r) {
#pragma unroll
      for (int d0 = 0; d0 < 4; ++d0) { unsigned u = __float_as_uint(o[d0][r] * rli[r]); u += 0x7fffu + ((u >> 16) & 1u);
        *(bf16_t*)((char*)Ob + ob + (unsigned)((((r & 3) + 8 * (r >> 2)) * 512 + d0 * 32) * 2)) = (bf16_t)(u >> 16); } } }
  __syncthreads();
#undef SLOAD
#undef SWRITE
#undef SWAIT
#undef RESC
}
}

constexpr int ATT_NSPLIT = 64, ATT_NPART = 3;
__device__ __forceinline__ float* att_po(const FP& p, int j) { return (float*)p.SCR + (size_t)j * 32768; }
__device__ __forceinline__ float* att_pml(const FP& p, int j) { return (float*)p.SCR + (size_t)ATT_NSPLIT * ATT_NPART * 32768 + (size_t)j * 512; }
__device__ void ph_attn(const FP& p, int l, char* shm) {
  const int nctx = (l == DEPTH - 1) ? 0 : NB * 4;
  const int G = gridDim.x, me = (int)blockIdx.x - 64, nb = G - 64; if (me < 0) return;
  for (int u = 64 + me; u < NB * 4 * 16; u += nb) { const int b = u >> 6, h = (u >> 4) & 3, qoff = CTX + (u & 15) * 256; const size_t r0 = (size_t)b * SB, q0 = r0 + qoff;
    att::attn_body<false>(p.Qb + q0 * 768 + h * 192, p.Knb + r0 * 512 + h * 128, p.KRb + r0 * 64, p.Vb + r0 * 512 + h * 128, p.AOb + q0 * 512 + h * 128, SB, shm); }
  for (int j = me; j < ATT_NSPLIT * ATT_NPART; j += nb) { const int u = j / ATT_NPART, part = j % ATT_NPART, h = (u >> 4) & 3, qoff = CTX + (u & 15) * 256; const size_t q0 = qoff;
    const int k0 = part == 0 ? 0 : 1536 + (part - 1) * 1408, len = part == 0 ? 1536 : 1408;
    att::attn_body<true>(p.Qb + q0 * 768 + h * 192, p.Knb + (size_t)k0 * 512 + h * 128, p.KRb + (size_t)k0 * 64, p.Vb + (size_t)k0 * 512 + h * 128, nullptr, len, shm, att_po(p, j), att_pml(p, j)); }
  for (int uu = me; uu < nctx; uu += nb) { const int b = uu >> 2, h = uu & 3; const size_t r0 = (size_t)b * SB;
    att::attn_body<false>(p.Qb + r0 * 768 + h * 192, p.Knb + r0 * 512 + h * 128, p.KRb + r0 * 64, p.Vb + r0 * 512 + h * 128, p.AOb + r0 * 512 + h * 128, CTX, shm); }
}

__device__ __forceinline__ void mla_out_row(const FP& p, int l, int row, int lane) {
  float x[8]; float ss = 0.f;
  if (row >= CTX && row < CTX + ATT_NSPLIT * 64) {
    const int tok = row - CTX, u = (lane >> 4) * 16 + (tok >> 8), qr = tok & 255; float m[ATT_NPART], lsum[ATT_NPART], M = -3.0e38f;
#pragma unroll
    for (int j = 0; j < ATT_NPART; ++j) { const float* ml = att_pml(p, u * ATT_NPART + j); m[j] = ml[qr]; lsum[j] = ml[256 + qr]; M = fmaxf(M, m[j]); }
    float L = 0.f;
#pragma unroll
    for (int e = 0; e < 8; ++e) x[e] = 0.f;
#pragma unroll
    for (int j = 0; j < ATT_NPART; ++j) { const float wj = __builtin_amdgcn_exp2f(m[j] - M); L += wj * lsum[j]; const float* po = att_po(p, u * ATT_NPART + j) + (size_t)qr * 128 + (lane & 15) * 8;
      const f32x4 a = *(const f32x4*)po, b2 = *(const f32x4*)(po + 4);
      x[0] += wj * a[0]; x[1] += wj * a[1]; x[2] += wj * a[2]; x[3] += wj * a[3]; x[4] += wj * b2[0]; x[5] += wj * b2[1]; x[6] += wj * b2[2]; x[7] += wj * b2[3]; }
    const float rl = 1.f / L;
#pragma unroll
    for (int e = 0; e < 8; ++e) x[e] = bf2f(f2bf(x[e] * rl));
  } else { const u32x4 v = *(const u32x4*)(p.AOb + (size_t)row * 512 + lane * 8);
    x[0] = bflo(v.x); x[1] = bfhi(v.x); x[2] = bflo(v.y); x[3] = bfhi(v.y); x[4] = bflo(v.z); x[5] = bfhi(v.z); x[6] = bflo(v.w); x[7] = bfhi(v.w); }
#pragma unroll
  for (int j = 0; j < 8; ++j) ss += x[j] * x[j];
  ss = wave_sum(ss); const float rs = rsqrtf(ss * (1.f / 512.f) + 1e-6f);
  const f32x4 g0 = *(const f32x4*)(p.g_mla + l * 512 + lane * 8), g1 = *(const f32x4*)(p.g_mla + l * 512 + lane * 8 + 4);
  u32x4 w; w.x = cvt_pk_bf16(x[0] * rs * g0[0], x[1] * rs * g0[1]); w.y = cvt_pk_bf16(x[2] * rs * g0[2], x[3] * rs * g0[3]);
  w.z = cvt_pk_bf16(x[4] * rs * g1[0], x[5] * rs * g1[1]); w.w = cvt_pk_bf16(x[6] * rs * g1[2], x[7] * rs * g1[3]);
  *(u32x4*)(p.CATb + (size_t)row * 1536 + lane * 8) = w;
}
constexpr int NCH = SB / 64;
__device__ __forceinline__ int item_idx(int dir, int bh, int cn) { return (dir * 16 + bh) * NCH + cn; }
__device__ __forceinline__ int scan_chunk(int dir, int n) { return dir == 0 ? n : (n < 4 ? 3 - n : 71 - n); }

__device__ __forceinline__ void prep_ret_row(const FP& p, int row, int lane) {
  const int s = row % SB; const bool lat = s >= CTX; const int tok = s - CTX;
  const bf16_t* pr = p.Pb + (size_t)row * INWP;
  const u32x4 qv = *(const u32x4*)(pr + C_RQ + lane * 8), kv = *(const u32x4*)(pr + C_RK + lane * 8);
  float q[8] = {bflo(qv.x), bfhi(qv.x), bflo(qv.y), bfhi(qv.y), bflo(qv.z), bfhi(qv.z), bflo(qv.w), bfhi(qv.w)};
  float k[8] = {bflo(kv.x), bfhi(kv.x), bflo(kv.y), bfhi(kv.y), bflo(kv.z), bfhi(kv.z), bflo(kv.w), bfhi(kv.w)};
  float qo[8], ko[8];
  const bool lowh = (lane & 4) == 0;
  const float pos = (float)(((lane >> 3) & 1) == 0 ? (tok >> 6) : (tok & 63));
#pragma unroll
  for (int e = 0; e < 8; ++e) { const float qp = shx(q[e], 4), kp = shx(k[e], 4);
    if (lat) { const int fi = (lane & 3) * 8 + e; const float ang = pos * __expf(-(float)fi * (9.210340371976184f / 32.f)); const float cs = __cosf(ang), sn = __sinf(ang);
      qo[e] = lowh ? q[e] * cs - qp * sn : q[e] * cs + qp * sn; ko[e] = lowh ? k[e] * cs - kp * sn : k[e] * cs + kp * sn; }
    else { qo[e] = q[e]; ko[e] = k[e]; } }
  const float sc = 0.08838834764831845f;
  u32x4 wq, wk; wq.x = cvt_pk_bf16(qo[0], qo[1]); wq.y = cvt_pk_bf16(qo[2], qo[3]); wq.z = cvt_pk_bf16(qo[4], qo[5]); wq.w = cvt_pk_bf16(qo[6], qo[7]);
  wk.x = cvt_pk_bf16(ko[0] * sc, ko[1] * sc); wk.y = cvt_pk_bf16(ko[2] * sc, ko[3] * sc); wk.z = cvt_pk_bf16(ko[4] * sc, ko[5] * sc); wk.w = cvt_pk_bf16(ko[6] * sc, ko[7] * sc);
  *(u32x4*)(p.RQb + (size_t)row * 512 + lane * 8) = wq; *(u32x4*)(p.RKb + (size_t)row * 512 + lane * 8) = wk;
}

__device__ __forceinline__ void r2_item(const FP& p, int l, int bh, int cn, int t, LAS unsigned char* hl) {
  const int b = bh >> 2, h = bh & 3; const size_t row0 = (size_t)b * SB + cn * 64;
  LAS bf16_t* sk = (LAS bf16_t*)hl; LAS bf16_t* sv = sk + 64 * 136;
#pragma unroll
  for (int i = 0; i < 4; ++i) { const int idx = t + 256 * i, r = idx >> 4, c8 = (idx & 15) * 8;
    *(LAS u32x4*)(sk + r * 136 + c8) = *(const u32x4*)(p.RKb + (row0 + r) * 512 + h * 128 + c8);
    *(LAS u32x4*)(sv + r * 136 + c8) = *(const u32x4*)(p.Pb + (row0 + r) * INWP + C_RV + h * 128 + c8); }
  __syncthreads();
  const float lgf = __log2f(1.f - __expf(p.ret_decay[l * 8 + h])), lgb = __log2f(1.f - __expf(p.ret_decay[l * 8 + 4 + h]));
#pragma unroll
  for (int q = 0; q < 4; ++q) { const int sidx = t + 256 * q, f = sidx >> 6, ln = sidx & 63, tt = f >> 2, s = f & 3, c = tt * 32 + (ln & 31), hh = ln >> 5;
    { float kf[8];
#pragma unroll
      for (int jj = 0; jj < 8; ++jj) kf[jj] = bf2f(sk[(16 * s + 8 * hh + jj) * 136 + c]);
      u32x4 wf, wb; unsigned tmpf[4], tmpb[4];
#pragma unroll
      for (int jp = 0; jp < 4; ++jp) { const int j0 = 16 * s + 8 * hh + 2 * jp;
        tmpf[jp] = cvt_pk_bf16(kf[2 * jp] * exp2f(lgf * (float)(63 - j0)), kf[2 * jp + 1] * exp2f(lgf * (float)(62 - j0)));
        tmpb[jp] = cvt_pk_bf16(kf[2 * jp] * exp2f(lgb * (float)j0), kf[2 * jp + 1] * exp2f(lgb * (float)(j0 + 1))); }
      wf.x = tmpf[0]; wf.y = tmpf[1]; wf.z = tmpf[2]; wf.w = tmpf[3]; wb.x = tmpb[0]; wb.y = tmpb[1]; wb.z = tmpb[2]; wb.w = tmpb[3];
      *(u32x4*)(p.RKWT + (size_t)item_idx(0, bh, cn) * 8192 + sidx * 8) = wf; *(u32x4*)(p.RKWT + (size_t)item_idx(1, bh, cn) * 8192 + sidx * 8) = wb; }
    { unsigned short vb[8], va[8];
#pragma unroll
      for (int jj = 0; jj < 8; ++jj) { vb[jj] = sv[(16 * s + 8 * hh + jj) * 136 + c]; va[jj] = sv[(16 * s + 8 * (jj >> 2) + 4 * hh + (jj & 3)) * 136 + c]; }
      u32x4 wb2, wa2; wb2.x = vb[0] | ((unsigned)vb[1] << 16); wb2.y = vb[2] | ((unsigned)vb[3] << 16); wb2.z = vb[4] | ((unsigned)vb[5] << 16); wb2.w = vb[6] | ((unsigned)vb[7] << 16);
      wa2.x = va[0] | ((unsigned)va[1] << 16); wa2.y = va[2] | ((unsigned)va[3] << 16); wa2.z = va[4] | ((unsigned)va[5] << 16); wa2.w = va[6] | ((unsigned)va[7] << 16);
      *(u32x4*)(p.RVTB + ((size_t)bh * NCH + cn) * 8192 + sidx * 8) = wb2; *(u32x4*)(p.RVTA + ((size_t)bh * NCH + cn) * 8192 + sidx * 8) = wa2; } }
  __syncthreads();
}

__device__ void ret_scan_job(const FP& p, int l, int bh, int dir, LAS unsigned char* lds) {
  const int t = TIDX, wid = __builtin_amdgcn_readfirstlane(t >> 6), lane = t & 63, hi = lane >> 5;
  const int h = bh & 3; const float lg = __log2f(1.f - __expf(p.ret_decay[l * 8 + dir * 4 + h])); const float g64 = exp2f(lg * 64.f);
  f32x16 S[4];
#pragma unroll
  for (int d = 0; d < 4; ++d)
#pragma unroll
    for (int r = 0; r < 16; ++r) S[d][r] = 0.f;
#define RS_STAGE(cn, buf) do { const char* ga = (const char*)(p.RKWT + (size_t)item_idx(dir, bh, (cn)) * 8192) + (wid - 4) * 1024 + lane * 16; const char* gb = (const char*)(p.RVTB + ((size_t)bh * NCH + (cn)) * 8192) + (wid - 4) * 1024 + lane * 16; \
    LAS unsigned char* lb = lds + (buf) * 32768 + (wid - 4) * 1024; \
    _Pragma("unroll") for (int q_ = 0; q_ < 4; ++q_) { __builtin_amdgcn_global_load_lds((const unsigned*)(ga + q_ * 4096), (LAS unsigned*)(lb + q_ * 4096), 16, 0, 0); \
      __builtin_amdgcn_global_load_lds((const unsigned*)(gb + q_ * 4096), (LAS unsigned*)(lb + 16384 + q_ * 4096), 16, 0, 0); } } while (0)
  __syncthreads();
  if (wid >= 4) { RS_STAGE(scan_chunk(dir, 0), 0); RS_STAGE(scan_chunk(dir, 1), 1); }
  for (int n = 0; n < NCH; ++n) { const int cn = scan_chunk(dir, n), buf = n % 3;
    if (wid >= 4) { if (n + 1 < NCH) asm volatile("s_waitcnt vmcnt(8)" ::: "memory"); else asm volatile("s_waitcnt vmcnt(0)" ::: "memory"); }
    __builtin_amdgcn_s_barrier(); asm volatile("" ::: "memory");
    if (wid >= 4) { if (n + 2 < NCH) RS_STAGE(scan_chunk(dir, n + 2), (n + 2) % 3); }
    if (wid < 4) {
      asm volatile("s_nop 9\n\ts_nop 9" : "+v"(S[3]), "+v"(S[2]), "+v"(S[1]), "+v"(S[0]));
      bf16_t* st = p.RST + (size_t)item_idx(dir, bh, cn) * 16384;
#pragma unroll
      for (int dt = 0; dt < 4; ++dt)
#pragma unroll
        for (int g = 0; g < 4; ++g) { u32x2 w; w.x = cvt_pk_bf16(S[dt][4 * g], S[dt][4 * g + 1]); w.y = cvt_pk_bf16(S[dt][4 * g + 2], S[dt][4 * g + 3]);
          *(u32x2*)(st + ((wid * 8 + 2 * dt + (g >> 1)) * 64 + (lane & 31) + 32 * (g & 1)) * 8 + 4 * hi) = w; }
#pragma unroll
      for (int dt = 0; dt < 4; ++dt)
#pragma unroll
        for (int r = 0; r < 16; ++r) S[dt][r] *= g64;
      const LAS unsigned char* bb = lds + buf * 32768;
      bf16x8 af[4][4], bfr[4];
#pragma unroll
      for (int s = 0; s < 4; ++s) bfr[s] = *(const LAS bf16x8*)(bb + 16384 + (wid * 4 + s) * 1024 + lane * 16);
#pragma unroll
      for (int dt = 0; dt < 4; ++dt)
#pragma unroll
        for (int s = 0; s < 4; ++s) af[dt][s] = *(const LAS bf16x8*)(bb + (dt * 4 + s) * 1024 + lane * 16);
#pragma unroll
      for (int s = 0; s < 4; ++s)
#pragma unroll
        for (int dt = 0; dt < 4; ++dt) S[dt] = __builtin_amdgcn_mfma_f32_32x32x16_bf16(af[dt][s], bfr[s], S[dt], 0, 0, 0);
    }
  }
  asm volatile("s_waitcnt vmcnt(0)" ::: "memory"); __syncthreads();
#undef RS_STAGE
}

__device__ __forceinline__ bf16x8 pack8(float a0, float a1, float a2, float a3, float a4, float a5, float a6, float a7) {
  u32x4 pk;
  asm volatile("v_cvt_pk_bf16_f32 %0, %4, %5\n\tv_cvt_pk_bf16_f32 %1, %6, %7\n\tv_cvt_pk_bf16_f32 %2, %8, %9\n\tv_cvt_pk_bf16_f32 %3, %10, %11\n\ts_nop 1"
               : "=&v"(pk[0]), "=&v"(pk[1]), "=&v"(pk[2]), "=&v"(pk[3]) : "v"(a0), "v"(a1), "v"(a2), "v"(a3), "v"(a4), "v"(a5), "v"(a6), "v"(a7));
  return __builtin_bit_cast(bf16x8, pk);
}
__device__ __forceinline__ bf16x8 pack_step(const f32x16& x, int s) { return pack8(x[8 * s], x[8 * s + 1], x[8 * s + 2], x[8 * s + 3], x[8 * s + 4], x[8 * s + 5], x[8 * s + 6], x[8 * s + 7]); }
__device__ __forceinline__ bf16x8 scale_frag(bf16x8 a, float f) {
  const u32x4 v = __builtin_bit_cast(u32x4, a);
  return pack8(bflo(v.x) * f, bfhi(v.x) * f, bflo(v.y) * f, bfhi(v.y) * f, bflo(v.z) * f, bfhi(v.z) * f, bflo(v.w) * f, bfhi(v.w) * f);
}

__device__ void ret_out_unit(const FP& p, int l, int bh, int cn, int ih, int lane) {
  const int b = bh >> 2, h = bh & 3, c32 = lane & 31, hi = lane >> 5; const size_t row0 = (size_t)b * SB + cn * 64; const int ipos = 32 * ih + c32;
  const float lgf = __log2f(1.f - __expf(p.ret_decay[l * 8 + h])), lgb = __log2f(1.f - __expf(p.ret_decay[l * 8 + 4 + h]));
  const unsigned lo16 = (unsigned)lane * 16u;
  f32x16 P0, P1;
#pragma unroll
  for (int r = 0; r < 16; ++r) { P0[r] = 0.f; P1[r] = 0.f; }
  const char* qb = (const char*)(p.RQb + (row0 + 32 * ih) * 512 + h * 128); const char* kb = (const char*)(p.RKb + row0 * 512 + h * 128);
  const unsigned rowoff = (unsigned)(c32 * 512 + 8 * hi) * 2u;
#pragma unroll 1
  for (int s = 0; s < 8; ++s) { const bf16x8 qf = *(const bf16x8*)(qb + rowoff + s * 32); const bf16x8 k0 = *(const bf16x8*)(kb + rowoff + s * 32), k1 = *(const bf16x8*)(kb + 32 * 1024 + rowoff + s * 32);
    P0 = __builtin_amdgcn_mfma_f32_32x32x16_bf16(k0, qf, P0, 0, 0, 0); P1 = __builtin_amdgcn_mfma_f32_32x32x16_bf16(k1, qf, P1, 0, 0, 0); }
  bf16x8 pb[2][2][2];
#pragma unroll
  for (int dir = 0; dir < 2; ++dir) { const float lg = dir == 0 ? lgf : lgb;
#pragma unroll
    for (int jt = 0; jt < 2; ++jt) { f32x16 pd;
#pragma unroll
      for (int r = 0; r < 16; ++r) { const int j = 32 * jt + crow16(r, hi); const int dlt = dir == 0 ? ipos - j : j - ipos; const float pv = jt == 0 ? P0[r] : P1[r]; pd[r] = dlt >= 0 ? pv * exp2f(lg * (float)dlt) : 0.f; }
      pb[dir][jt][0] = pack_step(pd, 0); pb[dir][jt][1] = pack_step(pd, 1); } }
  __builtin_amdgcn_sched_barrier(0);
  f32x16 O[4];
  const char* va = (const char*)(p.RVTA + ((size_t)bh * NCH + cn) * 8192);
#pragma unroll
  for (int et = 0; et < 4; ++et) { f32x16 a;
#pragma unroll
    for (int r = 0; r < 16; ++r) a[r] = 0.f;
    const char* vae = va + et * 4096;
#pragma unroll
    for (int jt = 0; jt < 2; ++jt)
#pragma unroll
      for (int ss = 0; ss < 2; ++ss) { const bf16x8 af = *(const bf16x8*)(vae + lo16 + (2 * jt + ss) * 1024);
        a = __builtin_amdgcn_mfma_f32_32x32x16_bf16(af, pb[0][jt][ss], a, 0, 0, 0); a = __builtin_amdgcn_mfma_f32_32x32x16_bf16(af, pb[1][jt][ss], a, 0, 0, 0); }
    O[et] = a; __builtin_amdgcn_sched_barrier(0); }
  const float facf = exp2f(lgf * (float)(ipos + 1)), facb = exp2f(lgb * (float)(64 - ipos));
  const char* stf = (const char*)(p.RST + (size_t)item_idx(0, bh, cn) * 16384); const char* stb = (const char*)(p.RST + (size_t)item_idx(1, bh, cn) * 16384);
#pragma unroll 1
  for (int s = 0; s < 8; ++s) { const bf16x8 qf = *(const bf16x8*)(qb + rowoff + s * 32); const bf16x8 qsf = scale_frag(qf, facf), qsb = scale_frag(qf, facb);
#pragma unroll
    for (int et = 0; et < 4; ++et) { const bf16x8 af = *(const bf16x8*)(stf + et * 8192 + s * 1024 + lo16), ab = *(const bf16x8*)(stb + et * 8192 + s * 1024 + lo16);
      O[et] = __builtin_amdgcn_mfma_f32_32x32x16_bf16(af, qsf, O[et], 0, 0, 0); O[et] = __builtin_amdgcn_mfma_f32_32x32x16_bf16(ab, qsb, O[et], 0, 0, 0); } }
  float sm = 0.f;
#pragma unroll
  for (int et = 0; et < 4; ++et)
#pragma unroll
    for (int r = 0; r < 16; ++r) sm += O[et][r];
  sm += shx(sm, 32); const float mu = sm * (1.f / 128.f); float vq = 0.f;
#pragma unroll
  for (int et = 0; et < 4; ++et)
#pragma unroll
    for (int r = 0; r < 16; ++r) { const float dd = O[et][r] - mu; vq += dd * dd; }
  vq += shx(vq, 32); const float rs = rsqrtf(vq * (1.f / 128.f) + 1e-5f);
  const size_t row = row0 + ipos; const bf16_t* gp = p.Pb + row * INWP + C_RG + h * 128; const float* gr = p.g_ret + l * 512 + h * 128; bf16_t* op = p.CATb + row * 1536 + 512 + h * 128;
#pragma unroll
  for (int et = 0; et < 4; ++et)
#pragma unroll
    for (int g = 0; g < 4; ++g) { const int e0 = 32 * et + 8 * g + 4 * hi; const u32x2 gz = *(const u32x2*)(gp + e0); const f32x4 gg = *(const f32x4*)(gr + e0);
      const float z[4] = {bflo(gz.x), bfhi(gz.x), bflo(gz.y), bfhi(gz.y)}; float y[4];
#pragma unroll
      for (int j = 0; j < 4; ++j) y[j] = (O[et][4 * g + j] - mu) * rs * gg[j] * silu_f(z[j]);
      u32x2 w; w.x = cvt_pk_bf16(y[0], y[1]); w.y = cvt_pk_bf16(y[2], y[3]); *(u32x2*)(op + e0) = w; }
}
#define N2SWZ(r, c) ((r) * 2048 + ((((c) & ~15) | (((c) ^ (r)) & 15)) << 4))
__device__ void ph_norm2m(const FP& p, int l, LAS unsigned char* lds) {
  const int t = TIDX, wid = t >> 6, lane = t & 63, c32 = lane & 31, hi = lane >> 5;
  const float* MODl = p.MOD + (size_t)l * 5 * 6144; const float* g2 = p.g_norm2 + l * D; int* cntl = p.cnt + l * 32;
  LAS float* lgt = (LAS float*)(lds + 131072);
  const bf16_t* wf = p.WRF + (size_t)l * 2 * 64 * 512;
  __syncthreads();
  for (int tile = blockIdx.x; tile < T / 32; tile += gridDim.x) { const int trow0 = tile * 32; const int b = trow0 / SB, s0 = trow0 % SB, rmod = s0 < CTX ? 4 : b;
    const bool routed = !(l == DEPTH - 1 && s0 < CTX);
    bf16x8 bh[8], bl[8];
#pragma unroll
    for (int q = 0; q < 8; ++q) { bh[q] = *(const bf16x8*)(wf + ((size_t)(wid * 8 + q) * 64 + lane) * 8); bl[q] = *(const bf16x8*)(wf + ((size_t)(64 + wid * 8 + q) * 64 + lane) * 8); }
    f32x4 x[4][4];
#pragma unroll
    for (int q = 0; q < 4; ++q)
#pragma unroll
      for (int i = 0; i < 4; ++i) x[q][i] = *(const f32x4*)(p.X + (size_t)(trow0 + wid * 4 + q) * D + i * 256 + lane * 4);
    const float* m = MODl + (size_t)rmod * 6144;
#pragma unroll
    for (int q = 0; q < 4; ++q) { const int r = wid * 4 + q, row = trow0 + r; float ss = 0.f;
#pragma unroll
      for (int i = 0; i < 4; ++i) ss += x[q][i][0] * x[q][i][0] + x[q][i][1] * x[q][i][1] + x[q][i][2] * x[q][i][2] + x[q][i][3] * x[q][i][3];
      ss = wave_sum(ss); const float rs = rsqrtf(ss * (1.f / 1024.f) + 1e-6f);
#pragma unroll
      for (int i = 0; i < 4; ++i) { const int c = i * 256 + lane * 4; const f32x4 g = *(const f32x4*)(g2 + c), sc = *(const f32x4*)(m + 4096 + c), sh = *(const f32x4*)(m + 3072 + c);
        const f32x4 h = x[q][i] * rs * g * (sc + 1.f) + sh;
        u32x2 whi; whi.x = cvt_pk_bf16(h[0], h[1]); whi.y = cvt_pk_bf16(h[2], h[3]);
        const f32x4 res = (f32x4){h[0] - bflo(whi.x), h[1] - bfhi(whi.x), h[2] - bflo(whi.y), h[3] - bfhi(whi.y)};
        u32x2 wlo; wlo.x = cvt_pk_bf16(res[0], res[1]); wlo.y = cvt_pk_bf16(res[2], res[3]);
        if (routed) *(u32x2*)(p.H2b + (size_t)row * D + c) = whi;
        const int ch = i * 32 + (lane >> 1); const int off = N2SWZ(r, ch) + (lane & 1) * 8;
        *(LAS u32x2*)(lds + off) = whi; *(LAS u32x2*)(lds + 65536 + off) = wlo; } }
    __syncthreads();
    f32x16 acc;
#pragma unroll
    for (int r = 0; r < 16; ++r) acc[r] = 0.f;
#pragma unroll
    for (int q = 0; q < 8; ++q) { const int ch = 2 * (wid * 8 + q) + hi; const bf16x8 ah = *(const LAS bf16x8*)(lds + N2SWZ(c32, ch)), al = *(const LAS bf16x8*)(lds + 65536 + N2SWZ(c32, ch));
      acc = __builtin_amdgcn_mfma_f32_32x32x16_bf16(ah, bh[q], acc, 0, 0, 0); acc = __builtin_amdgcn_mfma_f32_32x32x16_bf16(al, bh[q], acc, 0, 0, 0); acc = __builtin_amdgcn_mfma_f32_32x32x16_bf16(ah, bl[q], acc, 0, 0, 0); }
    __syncthreads();
    { LAS float* part = (LAS float*)lds + wid * 1024;
#pragma unroll
      for (int r = 0; r < 16; ++r) part[crow16(r, hi) * 32 + c32] = acc[r]; }
    __syncthreads();
    { const int r = t >> 4, e2 = (t & 15) * 2; float s0_ = 0.f, s1_ = 0.f;
#pragma unroll
      for (int w = 0; w < 8; ++w) { s0_ += ((LAS float*)lds)[w * 1024 + r * 32 + e2]; s1_ += ((LAS float*)lds)[w * 1024 + r * 32 + e2 + 1]; }
      lgt[r * 33 + e2] = s0_ + p.b_router[l * NE + e2]; lgt[r * 33 + e2 + 1] = s1_ + p.b_router[l * NE + e2 + 1]; }
    __syncthreads();
    if (t < 32 && routed) { const int row = trow0 + t; float lg[32];
#pragma unroll
      for (int e = 0; e < 32; ++e) lg[e] = lgt[t * 33 + e];
      float tv[4]; int ti[4];
#pragma unroll
      for (int k = 0; k < 4; ++k) { float bv = -3.0e38f; int bi = 0;
#pragma unroll
        for (int e = 0; e < 32; ++e) { if (lg[e] > bv) { bv = lg[e]; bi = e; } }
        tv[k] = bv; ti[k] = bi;
#pragma unroll
        for (int e = 0; e < 32; ++e) if (e == bi) lg[e] = -3.0e38f; }
      float e4[4], sum = 0.f;
#pragma unroll
      for (int k = 0; k < 4; ++k) { e4[k] = expf(tv[k] - tv[0]); sum += e4[k]; }
      const float inv = 1.f / sum;
      LAS int* lc = (LAS int*)(lds + 131072 + 8192); lc[t] = 0;
      int rk[4];
#pragma unroll
      for (int k = 0; k < 4; ++k) rk[k] = __hip_atomic_fetch_add(&lc[ti[k]], 1, __ATOMIC_RELAXED, __HIP_MEMORY_SCOPE_WAVEFRONT);
      const int mine = lc[t]; const int base = mine > 0 ? atomicAdd(&cntl[t], mine) : 0; lc[32 + t] = base;
#pragma unroll
      for (int k = 0; k < 4; ++k) { const int pos = lc[32 + ti[k]] + rk[k]; p.TOPE[row * 4 + k] = ti[k]; p.TOPP[row * 4 + k] = pos; p.TOPW[row * 4 + k] = e4[k] * inv;
        __hip_atomic_store(&p.ROWTOK[(size_t)ti[k] * T + pos], row, __ATOMIC_RELAXED, __HIP_MEMORY_SCOPE_AGENT); } }
    __syncthreads(); }
}
struct ConvW { f32x4 w[5][3][2]; };
__device__ __forceinline__ void load_convw(const FP& p, int l, int lane, ConvW& cw) {
  const float* c0 = p.gdn_conv + (size_t)l * 5 * 1536;
#pragma unroll
  for (int j = 0; j < 5; ++j)
#pragma unroll
    for (int blk = 0; blk < 3; ++blk) { cw.w[j][blk][0] = *(const f32x4*)(c0 + j * 1536 + blk * 512 + lane * 8); cw.w[j][blk][1] = *(const f32x4*)(c0 + j * 1536 + blk * 512 + lane * 8 + 4); }
}
__device__ __forceinline__ void prep_gdn_row(const FP& p, int l, int row, int lane, const ConvW& cw) {
  const int s = row % SB; const bool lat = s >= CTX; const int lo = lat ? CTX : 0, hi_ = lat ? SB : CTX;
  float o[3][8];
#pragma unroll
  for (int blk = 0; blk < 3; ++blk) {
#pragma unroll
    for (int e = 0; e < 8; ++e) o[blk][e] = 0.f;
#pragma unroll
    for (int j = 0; j < 5; ++j) { const int s2 = s + j - 2; if (s2 < lo || s2 >= hi_) continue;
      const u32x4 xv = *(const u32x4*)(p.Pb + (size_t)(row + j - 2) * INWP + C_GQ + blk * 512 + lane * 8);
      const f32x4 w0 = cw.w[j][blk][0], w1 = cw.w[j][blk][1];
      o[blk][0] += w0[0] * bflo(xv.x); o[blk][1] += w0[1] * bfhi(xv.x); o[blk][2] += w0[2] * bflo(xv.y); o[blk][3] += w0[3] * bfhi(xv.y);
      o[blk][4] += w1[0] * bflo(xv.z); o[blk][5] += w1[1] * bfhi(xv.z); o[blk][6] += w1[2] * bflo(xv.w); o[blk][7] += w1[3] * bfhi(xv.w); }
#pragma unroll
    for (int e = 0; e < 8; ++e) o[blk][e] = silu_f(o[blk][e]); }
#pragma unroll
  for (int blk = 0; blk < 2; ++blk) { float ss = 0.f;
#pragma unroll
    for (int e = 0; e < 8; ++e) ss += o[blk][e] * o[blk][e];
    ss += shx(ss, 1); ss += shx(ss, 2); ss += shx(ss, 4); ss += shx(ss, 8);
    const float rs = rsqrtf(ss + 1e-6f) * (blk == 0 ? 0.08838834764831845f : 1.f);
#pragma unroll
    for (int e = 0; e < 8; ++e) o[blk][e] *= rs; }
  u32x4 w;
  w.x = cvt_pk_bf16(o[0][0], o[0][1]); w.y = cvt_pk_bf16(o[0][2], o[0][3]); w.z = cvt_pk_bf16(o[0][4], o[0][5]); w.w = cvt_pk_bf16(o[0][6], o[0][7]); *(u32x4*)(p.GQb + (size_t)row * 512 + lane * 8) = w;
  w.x = cvt_pk_bf16(o[1][0], o[1][1]); w.y = cvt_pk_bf16(o[1][2], o[1][3]); w.z = cvt_pk_bf16(o[1][4], o[1][5]); w.w = cvt_pk_bf16(o[1][6], o[1][7]); *(u32x4*)(p.GKb + (size_t)row * 512 + lane * 8) = w;
  w.x = cvt_pk_bf16(o[2][0], o[2][1]); w.y = cvt_pk_bf16(o[2][2], o[2][3]); w.z = cvt_pk_bf16(o[2][4], o[2][5]); w.w = cvt_pk_bf16(o[2][6], o[2][7]); *(u32x4*)(p.GVb + (size_t)row * 512 + lane * 8) = w;
  if (lane < 8) { const float a = p.GAB[(size_t)row * 16 + lane] + p.gdn_dt_bias[l * 8 + lane]; const float xe = __expf(a);
    const float sp = a > 20.f ? a : (xe < 0.03f ? xe * (1.f - xe * (0.5f - xe * (1.f / 3.f))) : __logf(1.f + xe));
    p.GLA[(size_t)row * 8 + lane] = -__expf(p.gdn_a_log[l * 8 + lane]) * sp; p.GBETA[(size_t)row * 8 + lane] = 1.f / (1.f + __expf(-p.GAB[(size_t)row * 16 + 8 + lane])); }
}

typedef float f32x2_t __attribute__((ext_vector_type(2)));
template <int dir, int VAR = 0> __device__ __forceinline__ void g2_item(const FP& p, int bh, int cn, int t, LAS unsigned char* hl) {
  const int b = bh >> 2, h = bh & 3, w = t >> 6, lane = t & 63, c32 = lane & 31, hi = lane >> 5; const size_t row0 = (size_t)b * SB + cn * 64;
  LAS float* sA = (LAS float*)hl; LAS float* sg = sA + 64 * 64; LAS float* sb = sg + 64;
  LAS bf16_t* sK = (LAS bf16_t*)(hl + 16896); LAS bf16_t* sV = sK + 64 * 136; LAS bf16_t* sT1 = sV + 64 * 136; LAS bf16_t* sT2 = sT1 + 64 * 72;
  const int item = item_idx(dir, bh, cn);
  const int ws = (TIDX >> 8) & 1;
#pragma unroll
  for (int i = 0; i < 4; ++i) { const int idx = t + 256 * i, r = idx >> 4, c8 = (idx & 15) * 8;
    *(LAS u32x4*)(sK + r * 136 + c8) = *(const u32x4*)(p.GKb + (row0 + r) * 512 + h * 128 + c8); *(LAS u32x4*)(sV + r * 136 + c8) = *(const u32x4*)(p.GVb + (row0 + r) * 512 + h * 128 + c8); }
  if (w == 0) { float la = p.GLA[(row0 + lane) * 8 + dir * 4 + h]; const float bt = p.GBETA[(row0 + lane) * 8 + dir * 4 + h];
#pragma unroll
    for (int o = 1; o < 64; o <<= 1) { const float v = dir == 0 ? shup(la, o) : shdn(la, o); if (dir == 0 ? lane >= o : lane + o < 64) la += v; }
    sg[lane] = la; sb[lane] = bt; p.GG[(size_t)item * 64 + lane] = la; }
  __syncthreads();
  { const int it = w >> 1, jt = w & 1; f32x16 a;
#pragma unroll
    for (int r = 0; r < 16; ++r) a[r] = 0.f;
    const LAS bf16_t* ka = sK + (32 * it + c32) * 136 + 8 * hi; const LAS bf16_t* kb = sK + (32 * jt + c32) * 136 + 8 * hi;
#pragma unroll
    for (int s = 0; s < 8; ++s) a = __builtin_amdgcn_mfma_f32_32x32x16_bf16(*(const LAS bf16x8*)(ka + 16 * s), *(const LAS bf16x8*)(kb + 16 * s), a, 0, 0, 0);
    const int j = 32 * jt + c32; const float gj = sg[j];
#pragma unroll
    for (int r = 0; r < 16; ++r) { const int i = 32 * it + crow16(r, hi); const bool before = dir == 0 ? j < i : j > i;
      const float v = before ? sb[i] * a[r] * __expf(fminf(sg[i] - gj, 0.f)) : 0.f;
      if (dir == 0) sA[j * 64 + i] = v; else sA[(63 - j) * 64 + (63 - i)] = v; } }
  __syncthreads();
  if (w == ws) { f32x2_t x[32];
#pragma unroll
    for (int q = 0; q < 32; ++q) { x[q][0] = (2 * q == lane) ? 1.f : 0.f; x[q][1] = (2 * q + 1 == lane) ? 1.f : 0.f; }
#pragma unroll
    for (int jp = 0; jp < 63; ++jp) { const float xj = x[jp >> 1][jp & 1]; const f32x2_t xj2 = (f32x2_t){xj, xj};
#pragma unroll
      for (int q = (jp + 1) >> 2; q < 16; ++q) { const f32x4 r = *(const LAS f32x4*)(sA + jp * 64 + 4 * q);
        x[2 * q] = x[2 * q] - (f32x2_t){r[0], r[1]} * xj2; x[2 * q + 1] = x[2 * q + 1] - (f32x2_t){r[2], r[3]} * xj2; } }
    const int j = dir == 0 ? lane : 63 - lane; const float bj = sb[j], bje = bj * __expf(sg[j]);
#pragma unroll
    for (int ip = 0; ip < 64; ++ip) { const int i = dir == 0 ? ip : 63 - ip; const float v = x[ip >> 1][ip & 1]; sT1[i * 72 + j] = f2bf(v * bj); sT2[i * 72 + j] = f2bf(v * bje); }
  } else if (((w - ws - 1) & 3) < 2) { const int d = ((w - ws - 1) & 3) * 64 + lane; bf16_t* kt = p.GKTT + (size_t)item * 8192; const float glast = sg[dir == 0 ? 63 : 0];
#pragma unroll
    for (int grp = 0; grp < 16; ++grp) { const int s4 = grp >> 2, a = (grp >> 1) & 1, hp = grp & 1; float kv4[4];
#pragma unroll
      for (int r3 = 0; r3 < 4; ++r3) { const int i = 16 * s4 + 8 * a + 4 * hp + r3; kv4[r3] = bf2f(sK[i * 136 + d]) * __expf(glast - sg[i]); }
      u32x2 w2; w2.x = cvt_pk_bf16(kv4[0], kv4[1]); w2.y = cvt_pk_bf16(kv4[2], kv4[3]);
      *(u32x2*)(kt + (((d >> 5) * 4 + s4) * 64 + (d & 31) + 32 * hp) * 8 + 4 * a) = w2; } }
  __syncthreads();
  { f32x16 aU[2], aW[2];
#pragma unroll
    for (int it = 0; it < 2; ++it)
#pragma unroll
      for (int r = 0; r < 16; ++r) { aU[it][r] = 0.f; aW[it][r] = 0.f; }
#pragma unroll
    for (int s = 0; s < 4; ++s) { bf16x8 fv, fk;
#pragma unroll
      for (int jj = 0; jj < 8; ++jj) { fv[jj] = sV[(16 * s + 8 * hi + jj) * 136 + 32 * w + c32]; fk[jj] = sK[(16 * s + 8 * hi + jj) * 136 + 32 * w + c32]; }
#pragma unroll
      for (int it = 0; it < 2; ++it) { const bf16x8 t1 = *(const LAS bf16x8*)(sT1 + (32 * it + c32) * 72 + 16 * s + 8 * hi), t2 = *(const LAS bf16x8*)(sT2 + (32 * it + c32) * 72 + 16 * s + 8 * hi);
        aU[it] = __builtin_amdgcn_mfma_f32_32x32x16_bf16(t1, fv, aU[it], 0, 0, 0); aW[it] = __builtin_amdgcn_mfma_f32_32x32x16_bf16(fk, t2, aW[it], 0, 0, 0); } }
    asm volatile("s_nop 9\n\ts_nop 9" : "+v"(aU[0]), "+v"(aU[1]), "+v"(aW[0]), "+v"(aW[1]));
    bf16_t* ut = p.GUT + (size_t)item * 8192; bf16_t* gw = p.GWb + (size_t)item * 8192;
#pragma unroll
    for (int it2 = 0; it2 < 2; ++it2) {
#pragma unroll
      for (int g = 0; g < 4; ++g) { u32x2 w2; w2.x = cvt_pk_bf16(aU[it2][4 * g], aU[it2][4 * g + 1]); w2.y = cvt_pk_bf16(aU[it2][4 * g + 2], aU[it2][4 * g + 3]);
        *(u32x2*)(ut + (((w * 2 + it2) * 4 + g) * 64 + lane) * 4) = w2; }
#pragma unroll
      for (int sl = 0; sl < 2; ++sl) { u32x4 w4; w4.x = cvt_pk_bf16(aW[it2][8 * sl], aW[it2][8 * sl + 1]); w4.y = cvt_pk_bf16(aW[it2][8 * sl + 2], aW[it2][8 * sl + 3]);
        w4.z = cvt_pk_bf16(aW[it2][8 * sl + 4], aW[it2][8 * sl + 5]); w4.w = cvt_pk_bf16(aW[it2][8 * sl + 6], aW[it2][8 * sl + 7]);
        *(u32x4*)(gw + ((it2 * 8 + 2 * w + sl) * 64 + lane) * 8) = w4; } } }
  __syncthreads();
}

__device__ void gdn_scan_job(const FP& p, int bh, int dir, LAS unsigned char* lds) {
  const int t = TIDX, wid = __builtin_amdgcn_readfirstlane(t >> 6), lane = t & 63, hi = lane >> 5;
  f32x16 S[4];
#pragma unroll
  for (int d = 0; d < 4; ++d)
#pragma unroll
    for (int r = 0; r < 16; ++r) S[d][r] = 0.f;
#define GS_STAGE(cn, buf) do { const size_t io = (size_t)item_idx(dir, bh, (cn)) * 8192 * 2 + (size_t)(wid - 4) * 1024 + (size_t)lane * 16; const char* g0 = (const char*)p.GWb + io; const char* g1 = (const char*)p.GKTT + io; const char* g2 = (const char*)p.GUT + io; \
    LAS unsigned char* lb = lds + (buf) * 49152 + (wid - 4) * 1024; \
    _Pragma("unroll") for (int q_ = 0; q_ < 4; ++q_) { __builtin_amdgcn_global_load_lds((const unsigned*)(g0 + q_ * 4096), (LAS unsigned*)(lb + q_ * 4096), 16, 0, 0); \
      __builtin_amdgcn_global_load_lds((const unsigned*)(g1 + q_ * 4096), (LAS unsigned*)(lb + 16384 + q_ * 4096), 16, 0, 0); __builtin_amdgcn_global_load_lds((const unsigned*)(g2 + q_ * 4096), (LAS unsigned*)(lb + 32768 + q_ * 4096), 16, 0, 0); } } while (0)
  float dec0, dec1;
  { const int n0 = lane, n1 = 64 + (lane & 3); dec0 = __expf(p.GG[(size_t)item_idx(dir, bh, scan_chunk(dir, n0)) * 64 + (dir == 0 ? 63 : 0)]);
    dec1 = __expf(p.GG[(size_t)item_idx(dir, bh, scan_chunk(dir, n1)) * 64 + (dir == 0 ? 63 : 0)]); }
  __syncthreads();
  if (wid >= 4) { GS_STAGE(scan_chunk(dir, 0), 0); GS_STAGE(scan_chunk(dir, 1), 1); }
  for (int n = 0; n < NCH; ++n) { const int cn = scan_chunk(dir, n), buf = n % 3;
    if (wid >= 4) { if (n + 1 < NCH) asm volatile("s_waitcnt vmcnt(12)" ::: "memory"); else asm volatile("s_waitcnt vmcnt(0)" ::: "memory"); }
    __builtin_amdgcn_s_barrier(); asm volatile("" ::: "memory");
    if (wid >= 4) { if (n + 2 < NCH) GS_STAGE(scan_chunk(dir, n + 2), (n + 2) % 3); }
    if (wid < 4) { const int item = item_idx(dir, bh, cn);
      const float adec = __uint_as_float(__builtin_amdgcn_readlane(__float_as_uint(n < 64 ? dec0 : dec1), n & 63));
      asm volatile("s_nop 9\n\ts_nop 9" : "+v"(S[3]), "+v"(S[2]), "+v"(S[1]), "+v"(S[0]));
      bf16_t* st = p.GST + (size_t)item * 16384;
#pragma unroll
      for (int dt = 0; dt < 4; ++dt)
#pragma unroll
        for (int g = 0; g < 4; ++g) { u32x2 w; w.x = cvt_pk_bf16(S[dt][4 * g], S[dt][4 * g + 1]); w.y = cvt_pk_bf16(S[dt][4 * g + 2], S[dt][4 * g + 3]);
#ifdef PROBE_NOSTORE
          if (n == 1000)
#endif
          *(u32x2*)(st + ((wid * 8 + 2 * dt + (g >> 1)) * 64 + (lane & 31) + 32 * (g & 1)) * 8 + 4 * hi) = w; }
      const LAS unsigned char* bb = lds + buf * 49152;
      f32x16 vn[2];
#pragma unroll
      for (int it = 0; it < 2; ++it)
#pragma unroll
        for (int r = 0; r < 16; ++r) vn[it][r] = 0.f;
      bf16x8 wf[2][8];
#pragma unroll
      for (int it = 0; it < 2; ++it)
#pragma unroll
        for (int s = 0; s < 8; ++s) wf[it][s] = *(const LAS bf16x8*)(bb + (it * 8 + s) * 1024 + lane * 16);
#pragma unroll
      for (int s = 0; s < 8; ++s) { const bf16x8 sf = pack_step(S[s >> 1], s & 1);
#pragma unroll
        for (int it = 0; it < 2; ++it) vn[it] = __builtin_amdgcn_mfma_f32_32x32x16_bf16(wf[it][s], sf, vn[it], 0, 0, 0); }
      bf16x8 kf[4][4];
#pragma unroll
      for (int dt = 0; dt < 4; ++dt)
#pragma unroll
        for (int s = 0; s < 4; ++s) kf[dt][s] = *(const LAS bf16x8*)(bb + 16384 + (dt * 4 + s) * 1024 + lane * 16);
      bf16_t* vt = p.GVNT + (size_t)item * 8192;
#pragma unroll
      for (int it = 0; it < 2; ++it)
#pragma unroll
        for (int g = 0; g < 4; ++g) { const u32x2 uu = *(const LAS u32x2*)(bb + 32768 + (((wid * 2 + it) * 4 + g) * 64 + lane) * 8);
          vn[it][4 * g] = bflo(uu.x) - vn[it][4 * g]; vn[it][4 * g + 1] = bfhi(uu.x) - vn[it][4 * g + 1]; vn[it][4 * g + 2] = bflo(uu.y) - vn[it][4 * g + 2]; vn[it][4 * g + 3] = bfhi(uu.y) - vn[it][4 * g + 3];
          u32x2 w; w.x = cvt_pk_bf16(vn[it][4 * g], vn[it][4 * g + 1]); w.y = cvt_pk_bf16(vn[it][4 * g + 2], vn[it][4 * g + 3]);
#ifdef PROBE_NOSTORE
          if (n == 1000)
#endif
          *(u32x2*)(vt + ((wid * 4 + 2 * it + (g >> 1)) * 64 + lane) * 8 + 4 * (g & 1)) = w; }
#pragma unroll
      for (int dt = 0; dt < 4; ++dt)
#pragma unroll
        for (int r = 0; r < 16; ++r) S[dt][r] *= adec;
#pragma unroll
      for (int s = 0; s < 4; ++s) { const bf16x8 vf = pack_step(vn[s >> 1], s & 1);
#pragma unroll
        for (int dt = 0; dt < 4; ++dt) S[dt] = __builtin_amdgcn_mfma_f32_32x32x16_bf16(kf[dt][s], vf, S[dt], 0, 0, 0); }
    }
  }
  asm volatile("s_waitcnt vmcnt(0)" ::: "memory"); __syncthreads();
#undef GS_STAGE
}

__device__ void gdn_out_unit(const FP& p, int l, int bh, int cn, int ih, int lane) {
  const int b = bh >> 2, h = bh & 3, c32 = lane & 31, hi = lane >> 5; const size_t row0 = (size_t)b * SB + cn * 64; const int ipos = 32 * ih + c32;
  const unsigned lo16 = (unsigned)lane * 16u;
  const int itf = item_idx(0, bh, cn), itb = item_idx(1, bh, cn);
  f32x16 P0, P1;
#pragma unroll
  for (int r = 0; r < 16; ++r) { P0[r] = 0.f; P1[r] = 0.f; }
  const char* qb = (const char*)(p.GQb + (row0 + 32 * ih) * 512 + h * 128); const char* kb = (const char*)(p.GKb + row0 * 512 + h * 128);
  const unsigned rowoff = (unsigned)(c32 * 512 + 8 * hi) * 2u;
#pragma unroll 1
  for (int s = 0; s < 8; ++s) { const bf16x8 qf = *(const bf16x8*)(qb + rowoff + s * 32); const bf16x8 k0 = *(const bf16x8*)(kb + rowoff + s * 32), k1 = *(const bf16x8*)(kb + 32 * 1024 + rowoff + s * 32);
    P0 = __builtin_amdgcn_mfma_f32_32x32x16_bf16(k0, qf, P0, 0, 0, 0); P1 = __builtin_amdgcn_mfma_f32_32x32x16_bf16(k1, qf, P1, 0, 0, 0); }
  const float* ggf = p.GG + (size_t)itf * 64; const float* ggb = p.GG + (size_t)itb * 64;
  const float gfi = ggf[ipos], gbi = ggb[ipos];
  bf16x8 pb[2][2][2];
#pragma unroll
  for (int dir = 0; dir < 2; ++dir) { const float* gg = dir == 0 ? ggf : ggb; const float gi = dir == 0 ? gfi : gbi;
#pragma unroll
    for (int jt = 0; jt < 2; ++jt) { f32x16 pd;
#pragma unroll
      for (int g = 0; g < 4; ++g) { const f32x4 gj = *(const f32x4*)(gg + 32 * jt + 8 * g + 4 * hi);
#pragma unroll
        for (int r3 = 0; r3 < 4; ++r3) { const int r = 4 * g + r3; const int j = 32 * jt + 8 * g + 4 * hi + r3; const bool ok = dir == 0 ? j <= ipos : j >= ipos; const float pv = jt == 0 ? P0[r] : P1[r];
          pd[r] = ok ? pv * __expf(fminf(gi - gj[r3], 0.f)) : 0.f; } }
      pb[dir][jt][0] = pack_step(pd, 0); pb[dir][jt][1] = pack_step(pd, 1); } }
  __builtin_amdgcn_sched_barrier(0);
  f32x16 O[4];
  const char* vaf = (const char*)(p.GVNT + (size_t)itf * 8192); const char* vab = (const char*)(p.GVNT + (size_t)itb * 8192);
#pragma unroll
  for (int et = 0; et < 4; ++et) { f32x16 a;
#pragma unroll
    for (int r = 0; r < 16; ++r) a[r] = 0.f;
#pragma unroll
    for (int jt = 0; jt < 2; ++jt)
#pragma unroll
      for (int ss = 0; ss < 2; ++ss) { const bf16x8 af = *(const bf16x8*)(vaf + et * 4096 + lo16 + (2 * jt + ss) * 1024), ab = *(const bf16x8*)(vab + et * 4096 + lo16 + (2 * jt + ss) * 1024);
        a = __builtin_amdgcn_mfma_f32_32x32x16_bf16(af, pb[0][jt][ss], a, 0, 0, 0); a = __builtin_amdgcn_mfma_f32_32x32x16_bf16(ab, pb[1][jt][ss], a, 0, 0, 0); }
    O[et] = a; __builtin_amdgcn_sched_barrier(0); }
  const float facf = __expf(gfi), facb = __expf(gbi);
  const char* stf = (const char*)(p.GST + (size_t)itf * 16384); const char* stb = (const char*)(p.GST + (size_t)itb * 16384);
#pragma unroll 1
  for (int s = 0; s < 8; ++s) { const bf16x8 qf = *(const bf16x8*)(qb + rowoff + s * 32); const bf16x8 qsf = scale_frag(qf, facf), qsb = scale_frag(qf, facb);
#pragma unroll
    for (int et = 0; et < 4; ++et) { const bf16x8 af = *(const bf16x8*)(stf + et * 8192 + s * 1024 + lo16), ab = *(const bf16x8*)(stb + et * 8192 + s * 1024 + lo16);
      O[et] = __builtin_amdgcn_mfma_f32_32x32x16_bf16(af, qsf, O[et], 0, 0, 0); O[et] = __builtin_amdgcn_mfma_f32_32x32x16_bf16(ab, qsb, O[et], 0, 0, 0); } }
  float ss2 = 0.f;
#pragma unroll
  for (int et = 0; et < 4; ++et)
#pragma unroll
    for (int r = 0; r < 16; ++r) ss2 += O[et][r] * O[et][r];
  ss2 += shx(ss2, 32); const float rs = rsqrtf(ss2 * (1.f / 128.f) + 1e-6f);
  const size_t row = row0 + ipos; const bf16_t* zp = p.Pb + row * INWP + C_GZ + h * 128; const float* gr = p.g_gdn + l * 128; bf16_t* op = p.CATb + row * 1536 + 1024 + h * 128;
#pragma unroll
  for (int et = 0; et < 4; ++et)
#pragma unroll
    for (int g = 0; g < 4; ++g) { const int e0 = 32 * et + 8 * g + 4 * hi; const u32x2 gz = *(const u32x2*)(zp + e0); const f32x4 gg = *(const f32x4*)(gr + e0);
      const float z[4] = {bflo(gz.x), bfhi(gz.x), bflo(gz.y), bfhi(gz.y)}; float y[4];
#pragma unroll
      for (int j = 0; j < 4; ++j) y[j] = O[et][4 * g + j] * rs * gg[j] * silu_f(z[j]);
      u32x2 w; w.x = cvt_pk_bf16(y[0], y[1]); w.y = cvt_pk_bf16(y[2], y[3]); *(u32x2*)(op + e0) = w; }
}
template <bool GDN> __device__ __forceinline__ void post_unit(const FP& p, int l, int bh, int cn, LAS float* stats) {
  const int t = TIDX, wid = t >> 6, lane = t & 63, ih = wid >> 2, et = wid & 3, c32 = lane & 31, hi = lane >> 5;
  const int b = bh >> 2, h = bh & 3; const size_t row0 = (size_t)b * SB + cn * 64; const int ipos = 32 * ih + c32;
  const int itf = item_idx(0, bh, cn), itb = item_idx(1, bh, cn);
  const unsigned lo16 = (unsigned)lane * 16u;
  const bf16_t* Qp = GDN ? p.GQb : p.RQb; const bf16_t* Kp = GDN ? p.GKb : p.RKb; const bf16_t* STp = GDN ? p.GST : p.RST;
  bf16x8 qf[8], kf0[8], kf1[8], sf[8], sb[8];
  { const char* qb = (const char*)(Qp + (row0 + ipos) * 512 + h * 128 + 8 * hi); const char* kb = (const char*)(Kp + (row0 + c32) * 512 + h * 128 + 8 * hi);
#pragma unroll
    for (int s = 0; s < 8; ++s) qf[s] = *(const bf16x8*)(qb + s * 32);
#pragma unroll
    for (int s = 0; s < 8; ++s) kf0[s] = *(const bf16x8*)(kb + s * 32);
#pragma unroll
    for (int s = 0; s < 8; ++s) kf1[s] = *(const bf16x8*)(kb + 32 * 1024 + s * 32);
    const char* stf = (const char*)(STp + (size_t)itf * 16384) + et * 8192 + lo16; const char* stb = (const char*)(STp + (size_t)itb * 16384) + et * 8192 + lo16;
#pragma unroll
    for (int s = 0; s < 8; ++s) sf[s] = *(const bf16x8*)(stf + s * 1024);
    (void)stb; }
  const float* ggf = p.GG + (size_t)itf * 64; const float* ggb = p.GG + (size_t)itb * 64;
  float gfi = 0.f, gbi = 0.f, lgf = 0.f, lgb = 0.f;
  if (GDN) { gfi = ggf[ipos]; gbi = ggb[ipos]; }
  else { lgf = __log2f(1.f - __expf(p.ret_decay[l * 8 + h])); lgb = __log2f(1.f - __expf(p.ret_decay[l * 8 + 4 + h])); }
  f32x16 P0, P1;
#pragma unroll
  for (int r = 0; r < 16; ++r) { P0[r] = 0.f; P1[r] = 0.f; }
#pragma unroll
  for (int s = 0; s < 8; ++s) { P0 = __builtin_amdgcn_mfma_f32_32x32x16_bf16(kf0[s], qf[s], P0, 0, 0, 0); P1 = __builtin_amdgcn_mfma_f32_32x32x16_bf16(kf1[s], qf[s], P1, 0, 0, 0); }
  { const char* stb = (const char*)(STp + (size_t)itb * 16384) + et * 8192 + lo16;
#pragma unroll
    for (int s = 0; s < 8; ++s) sb[s] = *(const bf16x8*)(stb + s * 1024); }
  bf16x8 vf[4], vb[4];
  { const char* vaf = (const char*)(GDN ? p.GVNT + (size_t)itf * 8192 : p.RVTA + ((size_t)bh * NCH + cn) * 8192) + et * 4096 + lo16;
#pragma unroll
    for (int s = 0; s < 4; ++s) vf[s] = *(const bf16x8*)(vaf + s * 1024);
    if (GDN) { const char* vab = (const char*)(p.GVNT + (size_t)itb * 8192) + et * 4096 + lo16;
#pragma unroll
      for (int s = 0; s < 4; ++s) vb[s] = *(const bf16x8*)(vab + s * 1024); }
    else {
#pragma unroll
      for (int s = 0; s < 4; ++s) vb[s] = vf[s]; } }
  f32x16 O;
#pragma unroll
  for (int r = 0; r < 16; ++r) O[r] = 0.f;
#pragma unroll
  for (int dir = 0; dir < 2; ++dir)
#pragma unroll
    for (int jt = 0; jt < 2; ++jt) { f32x16 pd;
#pragma unroll
      for (int g = 0; g < 4; ++g) { f32x4 gj4 = (f32x4){0.f, 0.f, 0.f, 0.f}; if (GDN) gj4 = *(const f32x4*)((dir == 0 ? ggf : ggb) + 32 * jt + 8 * g + 4 * hi);
#pragma unroll
        for (int r3 = 0; r3 < 4; ++r3) { const int r = 4 * g + r3; const int j = 32 * jt + 8 * g + 4 * hi + r3; const float pv = jt == 0 ? P0[r] : P1[r]; float w;
          if (GDN) { const bool ok = dir == 0 ? j <= ipos : j >= ipos; const float gi = dir == 0 ? gfi : gbi; const float gj = gj4[r3]; w = ok ? __expf(fminf(gi - gj, 0.f)) : 0.f; }
          else { const int dlt = dir == 0 ? ipos - j : j - ipos; w = dlt >= 0 ? exp2f((dir == 0 ? lgf : lgb) * (float)dlt) : 0.f; }
          pd[r] = pv * w; } }
#pragma unroll
      for (int ss = 0; ss < 2; ++ss) { const bf16x8 pbf = pack_step(pd, ss); O = __builtin_amdgcn_mfma_f32_32x32x16_bf16(dir == 0 ? vf[2 * jt + ss] : vb[2 * jt + ss], pbf, O, 0, 0, 0); } }
  { const float facf = GDN ? __expf(gfi) : exp2f(lgf * (float)(ipos + 1)), facb = GDN ? __expf(gbi) : exp2f(lgb * (float)(64 - ipos));
#pragma unroll
    for (int s = 0; s < 8; ++s) { const bf16x8 qsf = scale_frag(qf[s], facf), qsb = scale_frag(qf[s], facb);
      O = __builtin_amdgcn_mfma_f32_32x32x16_bf16(sf[s], qsf, O, 0, 0, 0); O = __builtin_amdgcn_mfma_f32_32x32x16_bf16(sb[s], qsb, O, 0, 0, 0); } }
  float s1 = 0.f, s2 = 0.f;
#pragma unroll
  for (int r = 0; r < 16; ++r) { s1 += O[r]; s2 += O[r] * O[r]; }
  s1 += shx(s1, 32); s2 += shx(s2, 32);
  if (hi == 0) { stats[((ih * 4 + et) * 32 + c32) * 2] = s1; stats[((ih * 4 + et) * 32 + c32) * 2 + 1] = s2; }
  __syncthreads();
  float t1 = 0.f, t2 = 0.f;
#pragma unroll
  for (int e2 = 0; e2 < 4; ++e2) { t1 += stats[((ih * 4 + e2) * 32 + c32) * 2]; t2 += stats[((ih * 4 + e2) * 32 + c32) * 2 + 1]; }
  float mu, rs;
  if (GDN) { mu = 0.f; rs = rsqrtf(t2 * (1.f / 128.f) + 1e-6f); }
  else { mu = t1 * (1.f / 128.f); rs = rsqrtf(fmaxf(t2 * (1.f / 128.f) - mu * mu, 0.f) + 1e-5f); }
  const size_t row = row0 + ipos; const bf16_t* gp = p.Pb + row * INWP + (GDN ? C_GZ : C_RG) + h * 128; const float* gr = GDN ? p.g_gdn + l * 128 : p.g_ret + l * 512 + h * 128;
  bf16_t* op = p.CATb + row * 1536 + (GDN ? 1024 : 512) + h * 128;
#pragma unroll
  for (int g = 0; g < 4; ++g) { const int e0 = 32 * et + 8 * g + 4 * hi; const u32x2 gz = *(const u32x2*)(gp + e0); const f32x4 gg = *(const f32x4*)(gr + e0);
    const float z[4] = {bflo(gz.x), bfhi(gz.x), bflo(gz.y), bfhi(gz.y)}; float y[4];
#pragma unroll
    for (int j = 0; j < 4; ++j) y[j] = (O[4 * g + j] - mu) * rs * gg[j] * silu_f(z[j]);
    u32x2 w; w.x = cvt_pk_bf16(y[0], y[1]); w.y = cvt_pk_bf16(y[2], y[3]); *(u32x2*)(op + e0) = w; }
}
__device__ __forceinline__ void ph_post2(const FP& p, int l, LAS unsigned char* lds) {
  const int t = TIDX, lane = t & 63, gw = blockIdx.x * NWAVES + (t >> 6), GWN = gridDim.x * NWAVES;
  for (int row = gw; row < T; row += GWN) mla_out_row(p, l, row, lane);
  int par = 0;
  const int nch = (l == DEPTH - 1) ? NCH - 4 : NCH, c0 = NCH - nch;
  for (int u = blockIdx.x; u < 2 * 16 * nch; u += gridDim.x, par ^= 1) { const int m = u & 1, uu = u >> 1;
    if (m) post_unit<true>(p, l, uu / nch, c0 + uu % nch, (LAS float*)lds + par * 512); else post_unit<false>(p, l, uu / nch, c0 + uu % nch, (LAS float*)lds + par * 512); }
}
namespace p3 { constexpr int OK_ = 0, OQ = 16384, OSF = 32768, OSB = 65536, OVF = 98304, OVB = 114688, OST = 131072; }
template <bool GDN> __device__ __forceinline__ void post3_stage(const FP& p, int bh, int cn, LAS unsigned char* lds) {
  const int t = TIDX, wid = __builtin_amdgcn_readfirstlane(t >> 6), lane = t & 63;
  const int b = bh >> 2, h = bh & 3; const size_t row0 = (size_t)b * SB + cn * 64;
  const int itf = item_idx(0, bh, cn), itb = item_idx(1, bh, cn);
  const bf16_t* Kp = (GDN ? p.GKb : p.RKb) + row0 * 512 + h * 128; const bf16_t* Qp = (GDN ? p.GQb : p.RQb) + row0 * 512 + h * 128;
#pragma unroll
  for (int q = 0; q < 2; ++q) { const int pc = wid + 8 * q, row = 4 * pc + (lane >> 4), ch = (lane & 15) ^ (row & 7);
    __builtin_amdgcn_global_load_lds((const unsigned*)(Kp + (size_t)row * 512 + ch * 8), (LAS unsigned*)(lds + p3::OK_ + pc * 1024), 16, 0, 0);
    __builtin_amdgcn_global_load_lds((const unsigned*)(Qp + (size_t)row * 512 + ch * 8), (LAS unsigned*)(lds + p3::OQ + pc * 1024), 16, 0, 0); }
  const char* sf = (const char*)((GDN ? p.GST : p.RST) + (size_t)itf * 16384) + lane * 16; const char* sb = (const char*)((GDN ? p.GST : p.RST) + (size_t)itb * 16384) + lane * 16;
#pragma unroll
  for (int q = 0; q < 4; ++q) { const int pc = wid + 8 * q;
    __builtin_amdgcn_global_load_lds((const unsigned*)(sf + pc * 1024), (LAS unsigned*)(lds + p3::OSF + pc * 1024), 16, 0, 0);
    __builtin_amdgcn_global_load_lds((const unsigned*)(sb + pc * 1024), (LAS unsigned*)(lds + p3::OSB + pc * 1024), 16, 0, 0); }
  const char* vf = (const char*)(GDN ? p.GVNT + (size_t)itf * 8192 : p.RVTA + ((size_t)bh * NCH + cn) * 8192) + lane * 16;
#pragma unroll
  for (int q = 0; q < 2; ++q) { const int pc = wid + 8 * q; __builtin_amdgcn_global_load_lds((const unsigned*)(vf + pc * 1024), (LAS unsigned*)(lds + p3::OVF + pc * 1024), 16, 0, 0); }
  if (GDN) { const char* vb = (const char*)(p.GVNT + (size_t)itb * 8192) + lane * 16;
#pragma unroll
    for (int q = 0; q < 2; ++q) { const int pc = wid + 8 * q; __builtin_amdgcn_global_load_lds((const unsigned*)(vb + pc * 1024), (LAS unsigned*)(lds + p3::OVB + pc * 1024), 16, 0, 0); } }
}
#define P3SWZ(row, ch) ((row) * 256 + (((ch) ^ ((row) & 7)) << 4))
template <bool GDN, bool NGDN> __device__ __forceinline__ void post3_unit(const FP& p, int l, int bh, int cn, LAS unsigned char* lds, int par, bool hasnext, int nbh, int ncn) {
  const int t = TIDX, wid = t >> 6, lane = t & 63, ih = wid >> 2, et = wid & 3, c32 = lane & 31, hi = lane >> 5;
  const int b = bh >> 2, h = bh & 3; const size_t row0 = (size_t)b * SB + cn * 64; const int ipos = 32 * ih + c32;
  const int itf = item_idx(0, bh, cn), itb = item_idx(1, bh, cn);
  LAS float* stats = (LAS float*)(lds + p3::OST) + par * 512;
  const float* ggf = p.GG + (size_t)itf * 64; const float* ggb = p.GG + (size_t)itb * 64;
  float gfi = 0.f, gbi = 0.f, lgf = 0.f, lgb = 0.f;
  if (GDN) { gfi = ggf[ipos]; gbi = ggb[ipos]; }
  else { lgf = __log2f(1.f - __expf(p.ret_decay[l * 8 + h])); lgb = __log2f(1.f - __expf(p.ret_decay[l * 8 + 4 + h])); }
  const size_t row = row0 + ipos; const bf16_t* gp = p.Pb + row * INWP + (GDN ? C_GZ : C_RG) + h * 128; const float* gr = GDN ? p.g_gdn + l * 128 : p.g_ret + l * 512 + h * 128;
  u32x2 gz[4]; f32x4 gg[4];
#pragma unroll
  for (int g = 0; g < 4; ++g) { const int e0 = 32 * et + 8 * g + 4 * hi; gz[g] = *(const u32x2*)(gp + e0); gg[g] = *(const f32x4*)(gr + e0); }
  bf16x8 qf[8];
  { const int qr = 32 * ih + c32;
#pragma unroll
    for (int s = 0; s < 8; ++s) qf[s] = *(const LAS bf16x8*)(lds + p3::OQ + P3SWZ(qr, 2 * s + hi)); }
  f32x16 P0, P1;
#pragma unroll
  for (int r = 0; r < 16; ++r) { P0[r] = 0.f; P1[r] = 0.f; }
#pragma unroll
  for (int s = 0; s < 8; ++s) { const bf16x8 k0 = *(const LAS bf16x8*)(lds + p3::OK_ + P3SWZ(c32, 2 * s + hi)), k1 = *(const LAS bf16x8*)(lds + p3::OK_ + P3SWZ(32 + c32, 2 * s + hi));
    P0 = __builtin_amdgcn_mfma_f32_32x32x16_bf16(k0, qf[s], P0, 0, 0, 0); P1 = __builtin_amdgcn_mfma_f32_32x32x16_bf16(k1, qf[s], P1, 0, 0, 0); }
  f32x16 O;
#pragma unroll
  for (int r = 0; r < 16; ++r) O[r] = 0.f;
#pragma unroll
  for (int dir = 0; dir < 2; ++dir)
#pragma unroll
    for (int jt = 0; jt < 2; ++jt) { f32x16 pd;
#pragma unroll
      for (int g = 0; g < 4; ++g) { f32x4 gj4 = (f32x4){0.f, 0.f, 0.f, 0.f}; if (GDN) gj4 = *(const f32x4*)((dir == 0 ? ggf : ggb) + 32 * jt + 8 * g + 4 * hi);
#pragma unroll
        for (int r3 = 0; r3 < 4; ++r3) { const int r = 4 * g + r3; const int j = 32 * jt + 8 * g + 4 * hi + r3; const float pv = jt == 0 ? P0[r] : P1[r]; float w;
          if (GDN) { const bool ok = dir == 0 ? j <= ipos : j >= ipos; const float gi = dir == 0 ? gfi : gbi; w = ok ? __expf(fminf(gi - gj4[r3], 0.f)) : 0.f; }
          else { const int dlt = dir == 0 ? ipos - j : j - ipos; w = dlt >= 0 ? exp2f((dir == 0 ? lgf : lgb) * (float)dlt) : 0.f; }
          pd[r] = pv * w; } }
#pragma unroll
      for (int ss = 0; ss < 2; ++ss) { const bf16x8 pbf = pack_step(pd, ss);
        const bf16x8 vfr = *(const LAS bf16x8*)(lds + ((GDN && dir == 1) ? p3::OVB : p3::OVF) + (et * 4 + 2 * jt + ss) * 1024 + lane * 16);
        O = __builtin_amdgcn_mfma_f32_32x32x16_bf16(vfr, pbf, O, 0, 0, 0); } }
  { const float facf = GDN ? __expf(gfi) : exp2f(lgf * (float)(ipos + 1)), facb = GDN ? __expf(gbi) : exp2f(lgb * (float)(64 - ipos));
#pragma unroll
    for (int s = 0; s < 8; ++s) { const bf16x8 qsf = scale_frag(qf[s], facf), qsb = scale_frag(qf[s], facb);
      const bf16x8 sfr = *(const LAS bf16x8*)(lds + p3::OSF + (et * 8 + s) * 1024 + lane * 16), sbr = *(const LAS bf16x8*)(lds + p3::OSB + (et * 8 + s) * 1024 + lane * 16);
      O = __builtin_amdgcn_mfma_f32_32x32x16_bf16(sfr, qsf, O, 0, 0, 0); O = __builtin_amdgcn_mfma_f32_32x32x16_bf16(sbr, qsb, O, 0, 0, 0); } }
  float fz[16];
#pragma unroll
  for (int g = 0; g < 4; ++g) { fz[4 * g] = gg[g][0] * silu_f(bflo(gz[g].x)); fz[4 * g + 1] = gg[g][1] * silu_f(bfhi(gz[g].x)); fz[4 * g + 2] = gg[g][2] * silu_f(bflo(gz[g].y)); fz[4 * g + 3] = gg[g][3] * silu_f(bfhi(gz[g].y)); }
  float s1 = 0.f, s2 = 0.f;
#pragma unroll
  for (int r = 0; r < 16; ++r) { s1 += O[r]; s2 += O[r] * O[r]; }
  s1 += shx(s1, 32); s2 += shx(s2, 32);
  if (hi == 0) { stats[((ih * 4 + et) * 32 + c32) * 2] = s1; stats[((ih * 4 + et) * 32 + c32) * 2 + 1] = s2; }
  __syncthreads();
  if (hasnext) post3_stage<NGDN>(p, nbh, ncn, lds);
  float t1 = 0.f, t2 = 0.f;
#pragma unroll
  for (int e2 = 0; e2 < 4; ++e2) { t1 += stats[((ih * 4 + e2) * 32 + c32) * 2]; t2 += stats[((ih * 4 + e2) * 32 + c32) * 2 + 1]; }
  float mu, rs;
  if (GDN) { mu = 0.f; rs = rsqrtf(t2 * (1.f / 128.f) + 1e-6f); }
  else { mu = t1 * (1.f / 128.f); rs = rsqrtf(fmaxf(t2 * (1.f / 128.f) - mu * mu, 0.f) + 1e-5f); }
  bf16_t* op = p.CATb + row * 1536 + (GDN ? 1024 : 512) + h * 128;
#pragma unroll
  for (int g = 0; g < 4; ++g) { const int e0 = 32 * et + 8 * g + 4 * hi; float y[4];
#pragma unroll
    for (int j = 0; j < 4; ++j) y[j] = (O[4 * g + j] - mu) * rs * fz[4 * g + j];
    u32x2 w; w.x = cvt_pk_bf16(y[0], y[1]); w.y = cvt_pk_bf16(y[2], y[3]); *(u32x2*)(op + e0) = w; }
}
__device__ __forceinline__ void ph_post3(const FP& p, int l, LAS unsigned char* lds) {
  const int t = TIDX, lane = t & 63, gw = blockIdx.x * NWAVES + (t >> 6), GWN = gridDim.x * NWAVES;
  for (int row = gw; row < T; row += GWN) mla_out_row(p, l, row, lane);
  const int nch = (l == DEPTH - 1) ? NCH - 4 : NCH, c0 = NCH - nch, NU = 16 * nch, G = gridDim.x;
  int u = blockIdx.x; if (u >= 2 * NU) return;
  __syncthreads();
  if (u < NU) post3_stage<false>(p, u / nch, c0 + u % nch, lds); else post3_stage<true>(p, (u - NU) / nch, c0 + (u - NU) % nch, lds);
  for (int par = 0; u < 2 * NU; u += G, par ^= 1) { const int un = u + G; const bool hasnext = un < 2 * NU; const bool gd = u >= NU, ngd = un >= NU;
    const int uu = gd ? u - NU : u, vv = ngd ? un - NU : un; const int bh = uu / nch, cn = c0 + uu % nch, nbh = vv / nch, ncn = c0 + vv % nch;
    asm volatile("s_waitcnt vmcnt(0)" ::: "memory"); __syncthreads();
    if (!gd) { if (ngd) post3_unit<false, true>(p, l, bh, cn, lds, par, hasnext, nbh, ncn); else post3_unit<false, false>(p, l, bh, cn, lds, par, hasnext, nbh, ncn); }
    else post3_unit<true, true>(p, l, bh, cn, lds, par, hasnext, nbh, ncn); }
}
#define XB_TMO      128
#define XB_XCNT(j)  (256  + 64 * (j))
#define XB_XSUB(j)  (1280 + 64 * (j))
#define XB_XGEN(j)  (2304 + 64 * (j))
#define XB_TOP      3328
#define XB_TOPGEN   3392
#define XCD_BAR_WORDS 3456
#define XB_SPIN_CAP (1u << 18)

__device__ __forceinline__ unsigned xb_ld(unsigned* p)              { return __hip_atomic_load(p, __ATOMIC_RELAXED, __HIP_MEMORY_SCOPE_AGENT); }
__device__ __forceinline__ unsigned xb_add(unsigned* p, unsigned v) { return __hip_atomic_fetch_add(p, v, __ATOMIC_RELAXED, __HIP_MEMORY_SCOPE_AGENT); }
__device__ __forceinline__ unsigned xb_xcc_id() { return (unsigned)__builtin_amdgcn_s_getreg((3 << 11) | 20) & 0xFu; }
#define XB_SPIN(cond, bar) do { unsigned _sp = 0; while (cond) { __builtin_amdgcn_s_sleep(1); \
    if ((++_sp & 255u) == 0u) { if (xb_ld(&(bar)[XB_TMO])) break; if (_sp > XB_SPIN_CAP) { atomicAdd(&(bar)[XB_TMO], 1u); break; } } } } while (0)

struct XcdBarrier {
    unsigned* bar; unsigned x;
    volatile LAS unsigned* st;
};

__device__ __forceinline__ XcdBarrier xcd_barrier_post(unsigned* bar, volatile LAS unsigned* st) {
    XcdBarrier b; b.bar = bar; b.x = xb_xcc_id(); b.st = st;
    if (threadIdx.x == 0) (void)xb_add(&bar[XB_XCNT(b.x)], 1u);
    return b;
}
__device__ __forceinline__ void xcd_barrier_complete(unsigned* bar, unsigned x, unsigned& nloc, unsigned& nx) {
    const unsigned G = gridDim.x * gridDim.y * gridDim.z;
    unsigned sum, cnt, mine, sp = 0u;
    for (;;) {
        sum = 0u; cnt = 0u; mine = 0u;
#pragma unroll
        for (unsigned j = 0; j < 16; ++j) { const unsigned c = xb_ld(&bar[XB_XCNT(j)]); sum += c; cnt += (c > 0u) ? 1u : 0u; mine = (j == x) ? c : mine; }
        if (sum == G) break;
        __builtin_amdgcn_s_sleep(1);
        if ((++sp & 255u) == 0u) { if (xb_ld(&bar[XB_TMO])) break; if (sp > XB_SPIN_CAP) { atomicAdd(&bar[XB_TMO], 1u); break; } }
    }
    nloc = mine > 0u ? mine : 1u; nx = cnt > 0u ? cnt : 1u;
}

__device__ __forceinline__ void xcd_barrier(const XcdBarrier& b) {
    asm volatile("s_waitcnt vmcnt(0)" ::: "memory");
    __syncthreads();
    if (threadIdx.x == 0) {
        unsigned* bar = b.bar; unsigned bx = b.x; asm volatile("" : "+s"(bx));
        __builtin_amdgcn_s_waitcnt(0);
        unsigned nloc = b.st[0], nx = b.st[1];
        if (nloc == 0u) { xcd_barrier_complete(bar, bx, nloc, nx); b.st[0] = nloc; b.st[1] = nx; }
        const unsigned old = xb_add(&bar[XB_XSUB(bx)], 1u);
        const unsigned gen = old / nloc;
        if (old + 1u == (gen + 1u) * nloc) {
            __builtin_amdgcn_fence(__ATOMIC_RELEASE, "agent");
            asm volatile("s_waitcnt vmcnt(0)" ::: "memory");
            const unsigned og = xb_add(&bar[XB_TOP], 1u);
            const unsigned tg = og / nx;
            if (og + 1u == (tg + 1u) * nx) xb_add(&bar[XB_TOPGEN], 1u);
            else XB_SPIN(xb_ld(&bar[XB_TOPGEN]) == tg, bar);
            __builtin_amdgcn_fence(__ATOMIC_ACQUIRE, "agent");
            xb_add(&bar[XB_XGEN(bx)], 1u);
            asm volatile("s_waitcnt vmcnt(0)" ::: "memory");
        } else {
            XB_SPIN(xb_ld(&bar[XB_XGEN(bx)]) == gen, bar);
            __builtin_amdgcn_fence(__ATOMIC_ACQUIRE, "agent");
            asm volatile("s_waitcnt vmcnt(0)" ::: "memory");
        }
    }
    __syncthreads();
}

__device__ __forceinline__ void ph_prep(const FP& p, int l, LAS unsigned char* lds) { const int t = TIDX, lane = t & 63, gw = blockIdx.x * NWAVES + (t >> 6), GWN = gridDim.x * NWAVES;
  LAS float* cwl = (LAS float*)lds;
  __syncthreads();
  for (int i = t; i < 5 * 1536 / 4; i += NTHREADS) *(LAS f32x4*)(cwl + 4 * i) = *(const f32x4*)(p.gdn_conv + (size_t)l * 5 * 1536 + 4 * i);
  __syncthreads();
  const f32x4 gq = *(const f32x4*)(p.g_cq + l * 256 + lane * 4); const float gkv0 = p.g_ckv[l * 128 + lane * 2], gkv1 = p.g_ckv[l * 128 + lane * 2 + 1];
  const float dtb = p.gdn_dt_bias[l * 8 + (lane & 7)], nalog = -__expf(p.gdn_a_log[l * 8 + (lane & 7)]);
  for (int row = gw; row < T; row += GWN) { const int s = row % SB; const bool lat = s >= CTX; const int tok = s - CTX, lo = lat ? CTX : 0, hi_ = lat ? SB : CTX;
    const bf16_t* pr = p.Pb + (size_t)row * INWP;
    const u32x2 vdq = *(const u32x2*)(pr + C_DQ + lane * 4); const unsigned vdkv = *(const unsigned*)(pr + C_DKV + lane * 2); const bf16_t vkr = pr[C_KR + lane];
    const u32x4 qv = *(const u32x4*)(pr + C_RQ + lane * 8), kv = *(const u32x4*)(pr + C_RK + lane * 8);
    u32x4 gx[3][5];
#pragma unroll
    for (int j = 0; j < 5; ++j) { const int s2 = s + j - 2; const bool ok = s2 >= lo && s2 < hi_; const bf16_t* pj = ok ? pr + (j - 2) * INWP : pr;
#pragma unroll
      for (int blk = 0; blk < 3; ++blk) gx[blk][j] = *(const u32x4*)(pj + C_GQ + blk * 512 + lane * 8); }
    const float gab = p.GAB[(size_t)row * 16 + (lane & 15)];
    { float x[4] = {bflo(vdq.x), bfhi(vdq.x), bflo(vdq.y), bfhi(vdq.y)};
      const float ss = wave_sum(x[0] * x[0] + x[1] * x[1] + x[2] * x[2] + x[3] * x[3]); const float rs = rsqrtf(ss * (1.f / 256.f) + 1e-6f);
      u32x2 w; w.x = cvt_pk_bf16(x[0] * rs * gq[0], x[1] * rs * gq[1]); w.y = cvt_pk_bf16(x[2] * rs * gq[2], x[3] * rs * gq[3]);
      *(u32x2*)(p.A2b + (size_t)row * MLAK + lane * 4) = w; }
    { const float x0 = bflo(vdkv), x1 = bfhi(vdkv);
      const float ss = wave_sum(x0 * x0 + x1 * x1); const float rs = rsqrtf(ss * (1.f / 128.f) + 1e-6f);
      *(unsigned*)(p.A2b + (size_t)row * MLAK + 256 + lane * 2) = cvt_pk_bf16(x0 * rs * gkv0, x1 * rs * gkv1); }
    { const float x = bf2f(vkr); const float xp = shx(x, 16); float y = x;
      if (lat) { const int hh = lane >> 5, ii = lane & 31, fi = ii & 15; const float pos = (float)(hh == 0 ? (tok >> 6) : (tok & 63));
        const float ang = pos * __expf(-(float)fi * (9.210340371976184f / 16.f)); const float cs = __cosf(ang), sn = __sinf(ang);
        y = ii < 16 ? x * cs - xp * sn : x * cs + xp * sn; }
      unsigned u = __float_as_uint(y); u += 0x7fffu + ((u >> 16) & 1u); p.KRb[(size_t)row * 64 + lane] = (bf16_t)(u >> 16); }
    { float q[8] = {bflo(qv.x), bfhi(qv.x), bflo(qv.y), bfhi(qv.y), bflo(qv.z), bfhi(qv.z), bflo(qv.w), bfhi(qv.w)};
      float k[8] = {bflo(kv.x), bfhi(kv.x), bflo(kv.y), bfhi(kv.y), bflo(kv.z), bfhi(kv.z), bflo(kv.w), bfhi(kv.w)};
      float qo[8], ko[8];
      const bool lowh = (lane & 4) == 0;
      const float pos = (float)(((lane >> 3) & 1) == 0 ? (tok >> 6) : (tok & 63));
#pragma unroll
      for (int e = 0; e < 8; ++e) { const float qp = shx(q[e], 4), kp = shx(k[e], 4);
        if (lat) { const int fi = (lane & 3) * 8 + e; const float ang = pos * __expf(-(float)fi * (9.210340371976184f / 32.f)); const float cs = __cosf(ang), sn = __sinf(ang);
          qo[e] = lowh ? q[e] * cs - qp * sn : q[e] * cs + qp * sn; ko[e] = lowh ? k[e] * cs - kp * sn : k[e] * cs + kp * sn; }
        else { qo[e] = q[e]; ko[e] = k[e]; } }
      const float sc = 0.08838834764831845f;
      u32x4 wq, wk; wq.x = cvt_pk_bf16(qo[0], qo[1]); wq.y = cvt_pk_bf16(qo[2], qo[3]); wq.z = cvt_pk_bf16(qo[4], qo[5]); wq.w = cvt_pk_bf16(qo[6], qo[7]);
      wk.x = cvt_pk_bf16(ko[0] * sc, ko[1] * sc); wk.y = cvt_pk_bf16(ko[2] * sc, ko[3] * sc); wk.z = cvt_pk_bf16(ko[4] * sc, ko[5] * sc); wk.w = cvt_pk_bf16(ko[6] * sc, ko[7] * sc);
      *(u32x4*)(p.RQb + (size_t)row * 512 + lane * 8) = wq; *(u32x4*)(p.RKb + (size_t)row * 512 + lane * 8) = wk; }
    { float o[3][8];
#pragma unroll
      for (int blk = 0; blk < 3; ++blk) {
#pragma unroll
        for (int e = 0; e < 8; ++e) o[blk][e] = 0.f;
#pragma unroll
        for (int j = 0; j < 5; ++j) { const int s2 = s + j - 2; const float m = (s2 >= lo && s2 < hi_) ? 1.f : 0.f; const u32x4 xv = gx[blk][j];
          const f32x4 w0 = *(const LAS f32x4*)(cwl + j * 1536 + blk * 512 + lane * 8) * m, w1 = *(const LAS f32x4*)(cwl + j * 1536 + blk * 512 + lane * 8 + 4) * m;
          o[blk][0] += w0[0] * bflo(xv.x); o[blk][1] += w0[1] * bfhi(xv.x); o[blk][2] += w0[2] * bflo(xv.y); o[blk][3] += w0[3] * bfhi(xv.y);
          o[blk][4] += w1[0] * bflo(xv.z); o[blk][5] += w1[1] * bfhi(xv.z); o[blk][6] += w1[2] * bflo(xv.w); o[blk][7] += w1[3] * bfhi(xv.w); }
#pragma unroll
        for (int e = 0; e < 8; ++e) o[blk][e] = silu_f(o[blk][e]); }
#pragma unroll
      for (int blk = 0; blk < 2; ++blk) { float ss = 0.f;
#pragma unroll
        for (int e = 0; e < 8; ++e) ss += o[blk][e] * o[blk][e];
        ss += shx(ss, 1); ss += shx(ss, 2); ss += shx(ss, 4); ss += shx(ss, 8);
        const float rs = rsqrtf(ss + 1e-6f) * (blk == 0 ? 0.08838834764831845f : 1.f);
#pragma unroll
        for (int e = 0; e < 8; ++e) o[blk][e] *= rs; }
      u32x4 w;
      w.x = cvt_pk_bf16(o[0][0], o[0][1]); w.y = cvt_pk_bf16(o[0][2], o[0][3]); w.z = cvt_pk_bf16(o[0][4], o[0][5]); w.w = cvt_pk_bf16(o[0][6], o[0][7]); *(u32x4*)(p.GQb + (size_t)row * 512 + lane * 8) = w;
      w.x = cvt_pk_bf16(o[1][0], o[1][1]); w.y = cvt_pk_bf16(o[1][2], o[1][3]); w.z = cvt_pk_bf16(o[1][4], o[1][5]); w.w = cvt_pk_bf16(o[1][6], o[1][7]); *(u32x4*)(p.GKb + (size_t)row * 512 + lane * 8) = w;
      w.x = cvt_pk_bf16(o[2][0], o[2][1]); w.y = cvt_pk_bf16(o[2][2], o[2][3]); w.z = cvt_pk_bf16(o[2][4], o[2][5]); w.w = cvt_pk_bf16(o[2][6], o[2][7]); *(u32x4*)(p.GVb + (size_t)row * 512 + lane * 8) = w;
      if (lane < 8) { const float a = gab + dtb; const float xe = __expf(a);
        const float sp = a > 20.f ? a : (xe < 0.03f ? xe * (1.f - xe * (0.5f - xe * (1.f / 3.f))) : __logf(1.f + xe));
        p.GLA[(size_t)row * 8 + lane] = nalog * sp; }
      else if (lane < 16) p.GBETA[(size_t)row * 8 + lane - 8] = 1.f / (1.f + __expf(-gab)); } } }
template <int WHICH = 3, int VAR = 0> __device__ __forceinline__ void ph_items(const FP& p, int l, LAS unsigned char* lds) {
  int rb = (int)blockIdx.x; asm volatile("" : "+s"(rb)); rb = (int)gridDim.x - 1 - rb;
  if (WHICH & 1) for (int pr = rb; pr < 16 * NCH / 2; pr += gridDim.x) { const int it = pr * 2 + (TIDX >> 8); r2_item(p, l, it / NCH, it % NCH, TIDX & 255, lds + (TIDX >> 8) * 40960); }
  if (WHICH & 2) for (int pr = rb; pr < 2 * 16 * NCH / 2; pr += gridDim.x) { const int it = pr * 2 + (TIDX >> 8); if (it / (16 * NCH)) g2_item<1, VAR>(p, (it / NCH) & 15, it % NCH, TIDX & 255, lds + (TIDX >> 8) * 71680); else g2_item<0, VAR>(p, (it / NCH) & 15, it % NCH, TIDX & 255, lds + (TIDX >> 8) * 71680); } }
__device__ __forceinline__ void ph_post(const FP& p, int l) { const int t = TIDX, lane = t & 63, gw = blockIdx.x * NWAVES + (t >> 6), GWN = gridDim.x * NWAVES;
  for (int row = gw; row < T; row += GWN) mla_out_row(p, l, row, lane);
  for (int u = gw; u < 16 * NCH * 2; u += GWN) { ret_out_unit(p, l, u / (NCH * 2), (u >> 1) % NCH, u & 1, lane); gdn_out_unit(p, l, u / (NCH * 2), (u >> 1) % NCH, u & 1, lane); } }

#ifndef REPMASK
#define REPMASK 0
#endif
#define REP(k, ...) do { if ((REPMASK >> (k)) & 1) { __VA_ARGS__; xcd_barrier(bar); } } while (0)
#ifndef PROBE_A
#define PROBE_A 0
#endif
#ifndef PROBE_Q
#define PROBE_Q 40
#endif
#if PROBE_A
#ifndef PROBE_BLK
#define PROBE_BLK 0
#endif
#define STAMP(k) do { if (blockIdx.x == PROBE_BLK && TIDX == 0) { volatile LAS unsigned* tw_ = (volatile LAS unsigned*)(lds + LDS_BYTES - 48); if ((k) != 13) tw_[0] = (k); if ((k) == 13 || (k) == 6 || (k) == 15) { \
    const unsigned long long now_ = __builtin_amdgcn_s_memrealtime(); volatile LAS unsigned long long* tl_ = (volatile LAS unsigned long long*)(lds + LDS_BYTES - 32); \
    volatile unsigned* ta_ = p.ctl + 3600 + tw_[0]; *ta_ = *ta_ + (unsigned)(now_ - *tl_); *tl_ = now_; } } } while (0)
#else
#define STAMP(k) do { } while (0)
#endif
__global__ void __launch_bounds__(512, 2) mega_fwd(FP p) {
  extern __shared__ __attribute__((aligned(16))) unsigned char shm[];
  LAS unsigned char* lds = (LAS unsigned char*)shm;
  volatile LAS unsigned* xbw = (volatile LAS unsigned*)(lds + LDS_BYTES - 16);
  if (threadIdx.x == 0) { xbw[0] = 0u; xbw[1] = 0u; xbw[2] = 0u; xbw[3] = 0u; }
  __syncthreads();
  XcdBarrier bar = xcd_barrier_post(p.ctl, xbw);
#if PROBE_A
  if (blockIdx.x == PROBE_BLK && TIDX == 0) *(volatile LAS unsigned long long*)(lds + LDS_BYTES - 32) = __builtin_amdgcn_s_memrealtime();
#endif
  ph_prologue(p, lds);
  REP(0, ph_prologue(p, lds));
  STAMP(0); xcd_barrier(bar); STAMP(13);
  for (int l = 0; l < DEPTH; ++l) {
    ph_norm1(p, l, lds);            REP(1, ph_norm1<true>(p, l, lds)); STAMP(1); xcd_barrier(bar); STAMP(13);
    ph_inproj(p, l, lds);           REP(2, ph_inproj(p, l, lds)); STAMP(2); xcd_barrier(bar); STAMP(13);
    ph_prep(p, l, lds);             REP(3, ph_prep(p, l, lds)); STAMP(3);
    xcd_barrier(bar); STAMP(13);
    ph_mla_gemm(p, l, lds); REP(4, ph_mla_gemm(p, l, lds)); STAMP(4);
    moe_weights_layer<1, 0, 192>(p, l, 20736, NE * 768, 0, lds);
    ph_items(p, l, lds); REP(5, ph_items(p, l, lds)); REP(14, ph_items<1>(p, l, lds)); REP(15, ph_items<2>(p, l, lds)); STAMP(5); xcd_barrier(bar); STAMP(13);
    if (blockIdx.x < 32) ret_scan_job(p, l, blockIdx.x >> 1, blockIdx.x & 1, lds); else if (blockIdx.x < 64) gdn_scan_job(p, (blockIdx.x - 32) >> 1, blockIdx.x & 1, lds);
    REP(6, if (blockIdx.x < 32) ret_scan_job(p, l, blockIdx.x >> 1, blockIdx.x & 1, lds); else if (blockIdx.x < 64) gdn_scan_job(p, (blockIdx.x - 32) >> 1, blockIdx.x & 1, lds));
    STAMP(6);
    moe_weights_layer<1, 0, 32>(p, l, 0, 6752, 0, lds); moe_weights_layer<1, 0, 64>(p, l, 6752, 11840, 32, lds);
    ph_attn(p, l, (char*)shm);      REP(7, ph_attn(p, l, (char*)shm)); STAMP(15); STAMP(7);
    moe_weights_layer(p, l, 11840, 20736, 64, lds);
    xcd_barrier(bar); STAMP(13);
    ph_post3(p, l, lds);            REP(8, ph_post3(p, l, lds)); STAMP(8); xcd_barrier(bar); STAMP(13);
    ph_outproj(p, l, lds);
    REP(9, { FP q = p; q.X = (float*)p.SCR; ph_outproj(q, l, lds); }); STAMP(9); xcd_barrier(bar); STAMP(13);
    ph_norm2m(p, l, lds);           REP(10, ph_norm2<true>(p, l, lds)); STAMP(10); xcd_barrier(bar); STAMP(13);
    ph_gemm1(p, l, lds);            REP(11, ph_gemm1(p, l, lds)); STAMP(11); xcd_barrier(bar); STAMP(13);
    ph_gemm2(p, l, lds);            REP(12, ph_gemm2(p, l, lds)); STAMP(12);
    if (l + 1 < DEPTH) dense_weights_layer(p, l + 1, 128, lds);
    xcd_barrier(bar); STAMP(13);
  }
  ph_final(p, lds);
#if PROBE_A
  STAMP(14); xcd_barrier(bar); STAMP(13);
  __syncthreads(); asm volatile("s_waitcnt vmcnt(0)" ::: "memory");
  if (blockIdx.x == 0 && threadIdx.x == 0) { unsigned a = 0;
    for (int k = 0; k < 16; ++k) { const unsigned tv = ((volatile unsigned*)p.ctl)[3600 + k]; if ((PROBE_A >> k) & 1) a += tv; }
    const float us = (float)a * 0.01f; float q = floorf(us * (1.f / (float)PROBE_Q) + 0.5f);
#ifdef PROBE_NBLK
    { int tot = 0; for (int l = 0; l < DEPTH; ++l) { int nblk = 0; for (int e = 0; e < NE; ++e) nblk += (p.cnt[l * 32 + e] + 255) >> 8; tot += (PROBE_NBLK == 1) ? (nblk * 8 + 255) / 256 : (PROBE_NBLK == 2) ? (nblk * 4 + 255) / 256 : (l == PROBE_NBLK - 3 ? nblk - 272 : 0); } q = (float)(tot - (PROBE_NBLK == 1 ? 30 : PROBE_NBLK == 2 ? 10 : 0)); }
#endif
    p.out[0] += 4.f * q; }
#endif
}

static size_t f_layout(char* base, FP& p) {
  size_t o = 0; auto take = [&](size_t bytes) { char* q = base + o; o += (bytes + 255) & ~(size_t)255; return q; };
  p.ctl = (unsigned*)take((size_t)CTL_WORDS * 4); p.cnt = (int*)(p.ctl + 4096);
  p.Wt_in = (bf16_t*)take((size_t)DEPTH * INWP * 1024 * 2); p.Wt_mla = (bf16_t*)take((size_t)DEPTH * MLAN * MLAK * 2); p.Wt_out = (bf16_t*)take((size_t)DEPTH * 1024 * 1536 * 2);
  p.Wt_gu = (bf16_t*)take((size_t)DEPTH * NE * 2048 * 1024 * 2); p.Wt_dn = (bf16_t*)take((size_t)DEPTH * NE * 1024 * 1024 * 2);
  p.MOD = (float*)take((size_t)DEPTH * 5 * 6144 * 4); p.X = (float*)take((size_t)T * D * 4); p.GAB = (float*)take((size_t)T * 16 * 4); p.TOPW = (float*)take((size_t)T * 4 * 4);
  p.Hb = (bf16_t*)take((size_t)T * D * 2); p.H2b = (bf16_t*)take((size_t)T * D * 2); p.Pb = (bf16_t*)take((size_t)T * INWP * 2); p.CATb = (bf16_t*)take((size_t)T * 1536 * 2);
  p.ACTb = (bf16_t*)take((size_t)ROWS_P * 1024 * 2); p.YSb = (bf16_t*)take((size_t)ROWS_P * 1024 * 2);
  p.A2b = (bf16_t*)take((size_t)T * MLAK * 2); p.Qb = (bf16_t*)take((size_t)T * 768 * 2); p.Knb = (bf16_t*)take((size_t)T * 512 * 2); p.Vb = (bf16_t*)take((size_t)T * 512 * 2);
  p.KRb = (bf16_t*)take((size_t)T * 64 * 2); p.AOb = (bf16_t*)take((size_t)T * 512 * 2);
  p.RQb = (bf16_t*)take((size_t)T * 512 * 2); p.RKb = (bf16_t*)take((size_t)T * 512 * 2); p.RKWT = (bf16_t*)take((size_t)2 * 16 * NCH * 8192 * 2);
  p.RVTB = (bf16_t*)take((size_t)16 * NCH * 8192 * 2); p.RVTA = (bf16_t*)take((size_t)16 * NCH * 8192 * 2); p.RST = (bf16_t*)take((size_t)2 * 16 * NCH * 16384 * 2);
  p.GQb = (bf16_t*)take((size_t)T * 512 * 2); p.GKb = (bf16_t*)take((size_t)T * 512 * 2); p.GVb = (bf16_t*)take((size_t)T * 512 * 2);
  p.GLA = (float*)take((size_t)T * 8 * 4); p.GBETA = (float*)take((size_t)T * 8 * 4); p.GG = (float*)take((size_t)2 * 16 * NCH * 64 * 4);
  p.GWb = (bf16_t*)take((size_t)2 * 16 * NCH * 8192 * 2); p.GKTT = (bf16_t*)take((size_t)2 * 16 * NCH * 8192 * 2); p.GUT = (bf16_t*)take((size_t)2 * 16 * NCH * 8192 * 2);
  p.GVNT = (bf16_t*)take((size_t)2 * 16 * NCH * 8192 * 2); p.GST = (bf16_t*)take((size_t)2 * 16 * NCH * 16384 * 2);
  p.TOPE = (int*)take((size_t)T * 4 * 4); p.TOPP = (int*)take((size_t)T * 4 * 4); p.ROWTOK = (int*)take((size_t)NE * T * 4); p.SCR = (bf16_t*)take((size_t)T * D * 4 + 4096); p.ROPE = (float*)take(64 * 32 * 4); p.WRF = (bf16_t*)take((size_t)DEPTH * 2 * 64 * 64 * 8 * 2);
  return o;
}
}

extern "C" void kernel_launch(void* const* d_in, const int* in_sizes, int n_in, void* d_out, int out_size, void* d_ws, size_t ws_size, hipStream_t stream) {
  static int grid = 0;
  if (grid == 0) {
    if (hipFuncSetAttribute((const void*)fx::mega_fwd, hipFuncAttributeMaxDynamicSharedMemorySize, fx::LDS_BYTES) != hipSuccess) { fprintf(stderr, "kernel_launch: hipFuncSetAttribute failed\n"); grid = -1; return; }
    int dev = 0, cus = 0, per_cu = 0; (void)hipGetDevice(&dev); (void)hipDeviceGetAttribute(&cus, hipDeviceAttributeMultiprocessorCount, dev);
    if (hipOccupancyMaxActiveBlocksPerMultiprocessor(&per_cu, (const void*)fx::mega_fwd, 512, fx::LDS_BYTES) != hipSuccess || per_cu < 1) { fprintf(stderr, "kernel_launch: occupancy query says %d blocks per CU\n", per_cu); grid = -1; return; }
    grid = cus;
    if (grid < 64) { fprintf(stderr, "kernel_launch: needs >= 64 CUs\n"); grid = -1; return; }
  }
  if (grid < 0) return;
  fx::FP p{}; { const float** f = (const float**)&p; for (int i = 0; i < 28; ++i) f[i] = (const float*)d_in[i]; }
  p.out = (float*)d_out;
  const size_t fsz = fx::f_layout((char*)d_ws, p);
  if (fsz > ws_size || n_in != 28) { fprintf(stderr, "kernel_launch: ws too small (%zu > %zu) or n_in %d\n", fsz, ws_size, n_in); return; }
  (void)hipMemsetAsync(p.ctl, 0, (size_t)fx::CTL_WORDS * 4, stream);
  hipLaunchKernelGGL(fx::mega_fwd, dim3(grid), dim3(512), fx::LDS_BYTES, stream, p);
}
```

```cpp
#include <hip/hip_runtime.h>
#include <stdint.h>
#include <stdio.h>

namespace cfg {
constexpr int D = 1024, NB = 4, SEQ = 4096, DEPTH = 4, CTX = 256, GW = 64;
constexpr int SB = CTX + SEQ;
constexpr int T = NB * SB;
constexpr int INW = 4560;
constexpr int C_DQ = 0, C_DKV = 256, C_KR = 384, C_RQ = 448, C_RK = 960, C_RV = 1472, C_RG = 1984, C_GQ = 2496, C_GK = 3008, C_GV = 3520, C_GZ = 4032, C_GA = 4544, C_GB = 4552;
constexpr int NE = 32, TOPK = 4, DE = 1024;
}
namespace fx {
using namespace cfg;
#define LAS __attribute__((address_space(3)))
typedef unsigned short bf16_t;
typedef short bf16x8 __attribute__((ext_vector_type(8)));
typedef short s16x4 __attribute__((ext_vector_type(4)));
typedef float f32x4 __attribute__((ext_vector_type(4)));
typedef float f32x16 __attribute__((ext_vector_type(16)));
typedef unsigned u32x4 __attribute__((ext_vector_type(4)));
typedef unsigned u32x2 __attribute__((ext_vector_type(2)));

__device__ __forceinline__ int opaque_tid() { int t = threadIdx.x; asm volatile("" : "+v"(t)); return t; }
#define TIDX opaque_tid()
__device__ __forceinline__ float shx(float v, int m) { const int ln = TIDX & 63; return __int_as_float(__builtin_amdgcn_ds_bpermute((ln ^ m) << 2, __float_as_int(v))); }
__device__ __forceinline__ int shxi(int v, int m) { const int ln = TIDX & 63; return __builtin_amdgcn_ds_bpermute((ln ^ m) << 2, v); }
__device__ __forceinline__ float shup(float v, int o) { const int ln = TIDX & 63; const int src = ln >= o ? ln - o : ln; return __int_as_float(__builtin_amdgcn_ds_bpermute(src << 2, __float_as_int(v))); }
__device__ __forceinline__ int shupi(int v, int o) { const int ln = TIDX & 63; const int src = ln >= o ? ln - o : ln; return __builtin_amdgcn_ds_bpermute(src << 2, v); }
__device__ __forceinline__ float shdn(float v, int o) { const int ln = TIDX & 63; const int src = ln + o < 64 ? ln + o : ln; return __int_as_float(__builtin_amdgcn_ds_bpermute(src << 2, __float_as_int(v))); }
constexpr int NTHREADS = 512, NWAVES = 8;
constexpr int BM = 256, BK = 64, HALF = 128, HTB = HALF * BK * 2, STAGE_BYTES = 8 * HTB, NXCD = 8, WGM = 8;
constexpr int LDS_MISC = STAGE_BYTES;
constexpr int LDS_BYTES = 163840;
constexpr int INWP = 4608;
constexpr int MLAN = 1792, MLAK = 384;
constexpr int MAXBLK = (T * TOPK) / 256 + NE;
constexpr int ROWS_P = MAXBLK * 256;

__device__ __forceinline__ unsigned cvt_pk_bf16(float lo, float hi) { unsigned r; asm volatile("v_cvt_pk_bf16_f32 %0, %1, %2" : "=v"(r) : "v"(lo), "v"(hi)); return r; }
__device__ __forceinline__ float bf2f(unsigned short b) { return __uint_as_float(((unsigned)b) << 16); }
__device__ __forceinline__ bf16_t f2bf(float f) { unsigned u = __float_as_uint(f); u += 0x7fffu + ((u >> 16) & 1u); return (bf16_t)(u >> 16); }
__device__ __forceinline__ float bflo(unsigned w) { return __uint_as_float(w << 16); }
__device__ __forceinline__ float bfhi(unsigned w) { return __uint_as_float(w & 0xffff0000u); }
__device__ __forceinline__ float silu_f(float v) { return v / (1.f + __expf(-v)); }
__device__ __forceinline__ int crow16(int r, int hi) { return (r & 3) + 8 * (r >> 2) + 4 * hi; }

__host__ __device__ __forceinline__ int lds_byte(int r, int c) { const int st = (r >> 4) * 2 + (c >> 5), rr = r & 15, cc = c & 31, ob = rr * 64 + cc * 2; return st * 1024 + (ob ^ (((ob >> 9) & 1) << 5)); }
__host__ __device__ __forceinline__ void stage_rc(int b, int& R, int& C) { const int st = b / 1024, sb = b % 1024, swz = sb ^ (((sb >> 9) & 1) << 5); R = (st >> 1) * 16 + swz / 64; C = (st & 1) * 32 + (swz % 64) / 2; }
__host__ __device__ __forceinline__ int perm32(int rho) { const int n = rho >> 4, i = rho & 15; return 8 * (i >> 2) + 4 * n + (i & 3); }

struct Unit { int pm, pn, e, pad_; long aoff, boff; };
struct Gemm { const bf16_t* A; const bf16_t* Bt; int M, N, K; };

struct StaticOrder {
    static constexpr bool DYN_A = false;
    int nM, nN, nwg, G, c, K;
    __device__ void init(int M, int N, int K_, int G_, int c_) { nM = M / BM; nN = N / BM; nwg = nM * nN; G = G_; c = c_; K = K_; }
    __device__ bool next(int i, Unit& u) const {
        const long L = (long)i * G + c; if (L >= nwg) return false;
        int wgid = (int)L; { const int q = nwg / NXCD, r = nwg % NXCD, xcd = wgid % NXCD, off = wgid / NXCD; wgid = (xcd < r ? xcd * (q + 1) : r * (q + 1) + (xcd - r) * q) + off; }
        const int nig = WGM * nN, gid = wgid / nig, fm = gid * WGM, gsz = (nM - fm) < WGM ? (nM - fm) : WGM;
        u.pm = fm + ((wgid % nig) % gsz); u.pn = (wgid % nig) / gsz; u.e = 0; u.pad_ = 0;
        u.aoff = (long)u.pm * BM * K * 2; u.boff = (long)u.pn * BM * K * 2; return true;
    }
    __device__ __forceinline__ void a_off(const Unit&, const int (&R)[2], const int (&C)[2], unsigned (&v)[2][2]) const {
#pragma unroll
        for (int h = 0; h < 2; ++h)
#pragma unroll
            for (int i = 0; i < 2; ++i) v[h][i] = (unsigned)((h * HALF + R[i]) * K + C[i]) * 2u;
    }
};
struct LatentOrder {
    static constexpr bool DYN_A = false;
    int nN, G, c, K;
    __device__ bool next(int i, Unit& u) const {
        const int L = i * G + c; if (L >= 64 * nN) return false;
        const int lt = L / nN; u.pn = L % nN; u.pm = (lt >> 4) * 17 + 1 + (lt & 15); u.e = 0; u.pad_ = 0;
        u.aoff = (long)u.pm * BM * K * 2; u.boff = (long)u.pn * BM * K * 2; return true;
    }
    __device__ __forceinline__ void a_off(const Unit&, const int (&R)[2], const int (&C)[2], unsigned (&v)[2][2]) const {
#pragma unroll
        for (int h = 0; h < 2; ++h)
#pragma unroll
            for (int i = 0; i < 2; ++i) v[h][i] = (unsigned)((h * HALF + R[i]) * K + C[i]) * 2u;
    }
};
template <bool GATHER> struct MoeOrder {
    static constexpr bool DYN_A = GATHER;
    int nblk, NPN, G, c, K; const LAS int* blk_e; const LAS int* blk_j; const LAS int* ulist; int* rowtok; int* cnt; long bstride;
    __device__ bool next(int i, Unit& u) const {
        if (i >= __builtin_amdgcn_readfirstlane(ulist[0])) return false;
        const int blk = __builtin_amdgcn_readfirstlane(ulist[1 + 2 * i]); u.pn = __builtin_amdgcn_readfirstlane(ulist[2 + 2 * i]); u.pm = blk; u.e = __builtin_amdgcn_readfirstlane(blk_e[blk]); u.pad_ = __builtin_amdgcn_readfirstlane(blk_j[blk]);
        u.aoff = GATHER ? 0 : (long)blk * BM * K * 2; u.boff = (long)u.e * bstride + (long)u.pn * BM * K * 2; return true;
    }
    __device__ __forceinline__ void a_off(const Unit& u, const int (&R)[2], const int (&C)[2], unsigned (&v)[2][2]) const {
        if (GATHER) { const int n = __hip_atomic_load(&cnt[u.e], __ATOMIC_RELAXED, __HIP_MEMORY_SCOPE_AGENT); const int* lst = rowtok + (size_t)u.e * T + u.pad_ * 256;
#pragma unroll
            for (int h = 0; h < 2; ++h)
#pragma unroll
                for (int i = 0; i < 2; ++i) { const int rr = h * HALF + R[i]; const int tok = (u.pad_ * 256 + rr < n) ? __hip_atomic_load(&lst[rr], __ATOMIC_RELAXED, __HIP_MEMORY_SCOPE_AGENT) : 0;     v[h][i] = (unsigned)(tok * K + C[i]) * 2u; }
        } else {
#pragma unroll
            for (int h = 0; h < 2; ++h)
#pragma unroll
                for (int i = 0; i < 2; ++i) v[h][i] = (unsigned)((h * HALF + R[i]) * K + C[i]) * 2u;
        }
    }
};

struct EpiInproj {
    static constexpr bool PERM = true;
    bf16_t* O; float* GAB;
    __device__ __forceinline__ void operator()(const f32x4 (&acc)[2][2][4][2], const Unit& u, int wr, int wc, int fr, int fq) const {
        const int row0 = u.pm * BM + wr * 64 + fr, col0 = u.pn * BM + wc * 32 + 8 * fq;
#pragma unroll
        for (int ai = 0; ai < 2; ++ai)
#pragma unroll
            for (int m = 0; m < 4; ++m) { const int row = row0 + ai * HALF + m * 16; bf16_t* rowp = O + (size_t)row * INWP + col0;
#pragma unroll
                for (int bj = 0; bj < 2; ++bj) { const f32x4 v0 = acc[ai][bj][m][0], v1 = acc[ai][bj][m][1];
                    u32x4 w; w.x = cvt_pk_bf16(v0[0], v0[1]); w.y = cvt_pk_bf16(v0[2], v0[3]); w.z = cvt_pk_bf16(v1[0], v1[1]); w.w = cvt_pk_bf16(v1[2], v1[3]);
                    *(u32x4*)(rowp + bj * HALF) = w; }
                if (u.pn == 17 && wc == 2 && fq < 2) { float* gp = GAB + (size_t)row * 16 + fq * 8; *(f32x4*)gp = acc[ai][1][m][0]; *(f32x4*)(gp + 4) = acc[ai][1][m][1]; } }
    }
};
struct EpiOutproj {
    static constexpr bool PERM = false;
    float* X; const float* MODl;
    __device__ __forceinline__ void operator()(const f32x4 (&acc)[2][2][4][2], const Unit& u, int wr, int wc, int fr, int fq) const {
        const int row0 = u.pm * BM + wr * 64 + fr, col0 = u.pn * BM + wc * 32 + 4 * fq; const int rmod = (u.pm % 17 == 0) ? 4 : u.pm / 17;
        const float* gt = MODl + (size_t)rmod * 6144 + 2048 + col0; f32x4 gv[2][2];
#pragma unroll
        for (int bj = 0; bj < 2; ++bj)
#pragma unroll
            for (int n = 0; n < 2; ++n) gv[bj][n] = *(const f32x4*)(gt + bj * HALF + n * 16);
#pragma unroll
        for (int ai = 0; ai < 2; ++ai)
#pragma unroll
            for (int m = 0; m < 4; ++m) { float* rowp = X + (size_t)(row0 + ai * HALF + m * 16) * D + col0;
#pragma unroll
                for (int bj = 0; bj < 2; ++bj)
#pragma unroll
                    for (int n = 0; n < 2; ++n) { f32x4* p = (f32x4*)(rowp + bj * HALF + n * 16); *p = *p + gv[bj][n] * acc[ai][bj][m][n]; } }
    }
};
struct EpiGateUp {
    static constexpr bool PERM = true;
    bf16_t* ACT; const float* bgu;
    __device__ __forceinline__ void operator()(const f32x4 (&acc)[2][2][4][2], const Unit& u, int wr, int wc, int fr, int fq) const {
        const int row0 = u.pm * BM + wr * 64 + fr, oc = u.pn * HALF + wc * 32 + 8 * fq; const float* bg = bgu + (size_t)u.e * 2048 + oc;
        f32x4 bgv[2], buv[2];
#pragma unroll
        for (int n = 0; n < 2; ++n) { bgv[n] = *(const f32x4*)(bg + 4 * n); buv[n] = *(const f32x4*)(bg + 1024 + 4 * n); }
#pragma unroll
        for (int ai = 0; ai < 2; ++ai)
#pragma unroll
            for (int m = 0; m < 4; ++m) { float o[8];
#pragma unroll
                for (int n = 0; n < 2; ++n) { const f32x4 gv = acc[ai][0][m][n] + bgv[n], uv = acc[ai][1][m][n] + buv[n];
#pragma unroll
                    for (int j = 0; j < 4; ++j) { const float gg = fminf(gv[j], 7.f), uu = fminf(fmaxf(uv[j], -7.f), 7.f); o[n * 4 + j] = (uu + 1.f) * gg / (1.f + __expf(-1.702f * gg)); } }
                u32x4 w; w.x = cvt_pk_bf16(o[0], o[1]); w.y = cvt_pk_bf16(o[2], o[3]); w.z = cvt_pk_bf16(o[4], o[5]); w.w = cvt_pk_bf16(o[6], o[7]);
                *(u32x4*)(ACT + (size_t)(row0 + ai * HALF + m * 16) * 1024 + oc) = w; }
    }
};
struct EpiDown {
    static constexpr bool PERM = true;
    bf16_t* YS; const float* bdn;
    __device__ __forceinline__ void operator()(const f32x4 (&acc)[2][2][4][2], const Unit& u, int wr, int wc, int fr, int fq) const {
        const int row0 = u.pm * BM + wr * 64 + fr, col0 = u.pn * BM + wc * 32 + 8 * fq; const float* bb = bdn + (size_t)u.e * 1024 + col0;
        f32x4 bv[2][2];
#pragma unroll
        for (int bj = 0; bj < 2; ++bj)
#pragma unroll
            for (int n = 0; n < 2; ++n) bv[bj][n] = *(const f32x4*)(bb + bj * HALF + 4 * n);
#pragma unroll
        for (int ai = 0; ai < 2; ++ai)
#pragma unroll
            for (int m = 0; m < 4; ++m) { bf16_t* rowp = YS + (size_t)(row0 + ai * HALF + m * 16) * 1024 + col0;
#pragma unroll
                for (int bj = 0; bj < 2; ++bj) { const f32x4 v0 = acc[ai][bj][m][0] + bv[bj][0], v1 = acc[ai][bj][m][1] + bv[bj][1];
                    u32x4 w; w.x = cvt_pk_bf16(v0[0], v0[1]); w.y = cvt_pk_bf16(v0[2], v0[3]); w.z = cvt_pk_bf16(v1[0], v1[1]); w.w = cvt_pk_bf16(v1[2], v1[3]);
                    *(u32x4*)(rowp + bj * HALF) = w; } }
    }
};

template <class Epi, class Sched>
__device__ __forceinline__ void gemm_phase(LAS unsigned char* lds, const Gemm g, const Sched& S, const Epi& E) {
    const int tid = TIDX, wid = __builtin_amdgcn_readfirstlane(tid >> 6), lane = tid & 63, wr = wid >> 2, wc = wid & 3, fr = lane & 15, fq = lane >> 4;
    const int K = g.K, nt = K / BK;
    int Rr[2], Cc[2]; unsigned voffB[2];
#pragma unroll
    for (int i = 0; i < 2; ++i) { int R, C; stage_rc(tid * 16 + i * 8192, R, C); Rr[i] = R; Cc[i] = C; const int Rb = Epi::PERM ? ((R & ~31) + perm32(R & 31)) : R; voffB[i] = (unsigned)(Rb * K + C) * 2u; }
    const size_t kstep = (size_t)(BK * 2);
    const size_t hstep = (size_t)HALF * K * 2;
    const unsigned ldsw = (unsigned)wid * 1024u;
    const int aoff = lds_byte(wr * 64 + fr, fq * 8), boff = lds_byte(wc * 32 + fr, fq * 8);
#define PG8_SA(b, h) (((b) * 2 + (h)) * HTB)
#define PG8_SB(b, h) ((4 + (b) * 2 + (h)) * HTB)
#define PG8_STAGE(bufoff, gbase, voff) do { _Pragma("unroll") for (int _i = 0; _i < 2; ++_i) \
        __builtin_amdgcn_global_load_lds((const unsigned*)((const char*)(gbase) + (voff)[_i]), (LAS unsigned*)(lds + (bufoff) + ldsw + _i * 8192), 16, 0, 0); } while (0)
#define PG8_LDA(dst, b, h) do { _Pragma("unroll") for (int m = 0; m < 4; ++m) _Pragma("unroll") for (int k = 0; k < 2; ++k) dst[m][k] = *(const LAS bf16x8*)(lds + PG8_SA(b, h) + aoff + m * 2048 + k * 1024); } while (0)
#define PG8_LDB(dst, b, h) do { _Pragma("unroll") for (int n = 0; n < 2; ++n) _Pragma("unroll") for (int k = 0; k < 2; ++k) dst[n][k] = *(const LAS bf16x8*)(lds + PG8_SB(b, h) + boff + n * 2048 + k * 1024); } while (0)
#define PG8_MMA(ai, bj, At, Bt) do { __builtin_amdgcn_s_setprio(1); _Pragma("unroll") for (int m = 0; m < 4; ++m) _Pragma("unroll") for (int n = 0; n < 2; ++n) _Pragma("unroll") for (int k = 0; k < 2; ++k) \
        acc[ai][bj][m][n] = __builtin_amdgcn_mfma_f32_16x16x32_bf16(Bt[n][k], At[m][k], acc[ai][bj][m][n], 0, 0, 0); __builtin_amdgcn_s_setprio(0); } while (0)
#define PG8_WAIT_V(n) asm volatile("s_waitcnt vmcnt(" #n ")" ::: "memory")
#define PG8_WAIT_L(n) asm volatile("s_waitcnt lgkmcnt(" #n ")" ::: "memory")
#define PG8_BAR __builtin_amdgcn_s_barrier()
#define PG8_SCHED __builtin_amdgcn_sched_barrier(0)
    Unit cur, nxt; int ui = 0;
    if (!S.next(0, cur)) return;
    f32x4 acc[2][2][4][2];
#pragma unroll
    for (int a = 0; a < 2; ++a)
#pragma unroll
        for (int b = 0; b < 2; ++b)
#pragma unroll
            for (int m = 0; m < 4; ++m)
#pragma unroll
                for (int n = 0; n < 2; ++n) acc[a][b][m][n] = (f32x4){0.f, 0.f, 0.f, 0.f};
    bf16x8 At[4][2], B0[2][2], B1[2][2];
    unsigned vAc[2][2], vAn[2][2];
    S.a_off(cur, Rr, Cc, vAc);
    const char* cA = (const char*)g.A + cur.aoff; const char* cB = (const char*)g.Bt + cur.boff;
    PG8_STAGE(PG8_SB(0, 0), cB, voffB); PG8_STAGE(PG8_SA(0, 0), cA, vAc[0]); PG8_STAGE(PG8_SB(0, 1), cB + hstep, voffB); PG8_STAGE(PG8_SA(0, 1), cA, vAc[1]);
    if (wr == 1) PG8_BAR;
    PG8_WAIT_V(4); PG8_BAR;
    PG8_STAGE(PG8_SB(1, 0), cB + kstep, voffB); PG8_STAGE(PG8_SA(1, 0), cA + kstep, vAc[0]); PG8_STAGE(PG8_SB(1, 1), cB + hstep + kstep, voffB);
    PG8_WAIT_V(6); PG8_BAR;
    for (;;) {
        const bool has_next = S.next(ui + 1, nxt);
        if (!Sched::DYN_A) { }
        else if (has_next) S.a_off(nxt, Rr, Cc, vAn);
        else {
#pragma unroll
            for (int h = 0; h < 2; ++h)
#pragma unroll
                for (int i = 0; i < 2; ++i) vAn[h][i] = vAc[h][i]; }
        const char* nA = has_next ? (const char*)g.A + nxt.aoff : cA; const char* nB = has_next ? (const char*)g.Bt + nxt.boff : cB;
#pragma unroll 1
        for (int t = 0; t < nt; t += 2) {
            const bool last = (t == nt - 2);
            const char* a1 = cA + (size_t)(t + 1) * kstep;
            const char* a2 = last ? nA : cA + (size_t)(t + 2) * kstep; const char* b2 = last ? nB : cB + (size_t)(t + 2) * kstep;
            const char* a3 = a2 + kstep; const char* b3 = b2 + kstep;
            unsigned w2[2][2];
#pragma unroll
            for (int h = 0; h < 2; ++h)
#pragma unroll
                for (int i = 0; i < 2; ++i) w2[h][i] = (Sched::DYN_A && last) ? vAn[h][i] : vAc[h][i];
            PG8_LDB(B0, 0, 0); PG8_SCHED; PG8_LDA(At, 0, 0); PG8_STAGE(PG8_SA(1, 1), a1, vAc[1]);
            PG8_WAIT_L(8); PG8_BAR; PG8_WAIT_L(0); PG8_MMA(0, 0, At, B0); PG8_BAR; PG8_SCHED;
            PG8_LDB(B1, 0, 1); PG8_STAGE(PG8_SB(0, 0), b2, voffB);
            PG8_BAR; PG8_WAIT_L(0); PG8_MMA(0, 1, At, B1); PG8_BAR;
            PG8_LDA(At, 0, 1); PG8_STAGE(PG8_SA(0, 0), a2, w2[0]);
            PG8_BAR; PG8_WAIT_L(0); PG8_MMA(1, 0, At, B0); PG8_BAR; PG8_SCHED;
            PG8_STAGE(PG8_SB(0, 1), b2 + hstep, voffB);
            PG8_WAIT_V(6); PG8_BAR; PG8_MMA(1, 1, At, B1); PG8_BAR;
            PG8_LDB(B0, 1, 0); PG8_SCHED; PG8_LDA(At, 1, 0); PG8_STAGE(PG8_SA(0, 1), a2, w2[1]);
            PG8_WAIT_L(8); PG8_BAR; PG8_WAIT_L(0); PG8_MMA(0, 0, At, B0); PG8_BAR; PG8_SCHED;
            PG8_LDB(B1, 1, 1); PG8_STAGE(PG8_SB(1, 0), b3, voffB);
            PG8_BAR; PG8_WAIT_L(0); PG8_MMA(0, 1, At, B1); PG8_BAR;
            PG8_LDA(At, 1, 1); PG8_STAGE(PG8_SA(1, 0), a3, w2[0]);
            PG8_BAR; PG8_WAIT_L(0); PG8_MMA(1, 0, At, B0); PG8_BAR; PG8_SCHED;
            PG8_STAGE(PG8_SB(1, 1), b3 + hstep, voffB);
            PG8_WAIT_V(6); PG8_BAR; PG8_MMA(1, 1, At, B1); PG8_BAR;
        }
        asm volatile("s_nop 9\n\ts_nop 9" : "+v"(acc[1][1][3][1]), "+v"(acc[1][1][3][0]), "+v"(acc[1][1][2][1]), "+v"(acc[1][1][2][0]));
        { int tz = TIDX; const int wz = tz >> 6, lz = tz & 63; E(acc, cur, wz >> 2, wz & 3, lz & 15, lz >> 4); }
        if (!has_next) break;
#pragma unroll
        for (int a = 0; a < 2; ++a)
#pragma unroll
            for (int b = 0; b < 2; ++b)
#pragma unroll
                for (int m = 0; m < 4; ++m)
#pragma unroll
                    for (int n = 0; n < 2; ++n) acc[a][b][m][n] = (f32x4){0.f, 0.f, 0.f, 0.f};
        cur = nxt; cA = nA; cB = nB; ++ui;
#pragma unroll
        for (int h = 0; h < 2; ++h)
#pragma unroll
            for (int i = 0; i < 2; ++i) if (Sched::DYN_A) vAc[h][i] = vAn[h][i];
    }
    PG8_WAIT_V(0);
    if (wr == 0) PG8_BAR;
    PG8_BAR;
#undef PG8_SA
#undef PG8_SB
#undef PG8_STAGE
#undef PG8_LDA
#undef PG8_LDB
#undef PG8_MMA
#undef PG8_WAIT_V
#undef PG8_WAIT_L
#undef PG8_BAR
#undef PG8_SCHED
}
struct FP {
  const float *x, *c, *ctx, *c_ctx, *w_mod, *b_mod, *g_norm1, *g_norm2, *w_in, *g_cq, *g_ckv, *w_uq, *w_ukv, *g_mla, *ret_decay, *g_ret, *gdn_conv, *gdn_a_log,
      *gdn_dt_bias, *g_gdn, *w_out, *w_router, *b_router, *w_gate_up, *b_gate_up, *w_down, *b_down, *g_final;
  float* out;
  unsigned* ctl; int* cnt;
  bf16_t *Wt_in, *Wt_mla, *Wt_out, *Wt_gu, *Wt_dn;
  float *MOD, *X, *GAB, *TOPW;
  bf16_t *Hb, *H2b, *Pb, *CATb, *ACTb, *YSb;
  int *TOPE, *TOPP, *ROWTOK;
  bf16_t *A2b, *Qb, *Knb, *Vb, *KRb, *AOb;
  bf16_t *RQb, *RKb, *RKWT, *RVTB, *RVTA, *RST;
  bf16_t *GQb, *GKb, *GVb, *GUT, *GWb, *GKTT, *GVNT, *GST;
  float *GG, *GBETA, *GLA; bf16_t* SCR; float* ROPE; bf16_t* WRF;
};
constexpr int CTL_WORDS = 4096 + DEPTH * 32;

template <int MAP> __device__ __forceinline__ void tr_tile(const float* src, int lds_, int k0, int n0, int N, bf16_t* dst, int ldd, int kcol0, LAS float* tile) {
  const int t = TIDX;
#pragma unroll
  for (int i = 0; i < 2; ++i) { const int idx = t + 512 * i, k = idx >> 4, n4 = (idx & 15) * 4; f32x4 v = (f32x4){0.f, 0.f, 0.f, 0.f};
    if (n0 + n4 < N) v = *(const f32x4*)(src + (size_t)(k0 + k) * lds_ + n0 + n4);
    tile[k * 65 + n4 + 0] = v[0]; tile[k * 65 + n4 + 1] = v[1]; tile[k * 65 + n4 + 2] = v[2]; tile[k * 65 + n4 + 3] = v[3]; }
  __syncthreads();
  { const int n = t >> 3, k8 = (t & 7) * 8; float o[8];
#pragma unroll
    for (int j = 0; j < 8; ++j) o[j] = tile[(k8 + j) * 65 + n];
    u32x4 w; w.x = cvt_pk_bf16(o[0], o[1]); w.y = cvt_pk_bf16(o[2], o[3]); w.z = cvt_pk_bf16(o[4], o[5]); w.w = cvt_pk_bf16(o[6], o[7]);
    int gn = n0 + n, row;
    if (MAP == 1) { const int bj = gn >> 10, c = gn & 1023; row = (c >> 7) * 256 + bj * 128 + (c & 127); }
    else row = gn;
    *(u32x4*)(dst + (size_t)row * ldd + kcol0 + k0 + k8) = w; }
  __syncthreads();
}

__device__ void dense_weights_layer(const FP& p, int l, int b0, LAS unsigned char* lds) {
  LAS float* tile = (LAS float*)lds; int bid_ = (int)blockIdx.x; asm volatile("" : "+s"(bid_));
  const int me = bid_ - b0, nb = (int)gridDim.x - b0, t = TIDX; if (me < 0 || nb <= 0) return;
  __syncthreads();
  constexpr int L_IN = 16 * 72, L_OUT = 24 * 16, L_UQ = 4 * 12, L_UKV = 2 * 16;
  for (int id = me; id < L_IN + L_OUT + L_UQ + L_UKV; id += nb) { int r = id;
    if (r < L_IN) { const int kt = r / 72, nt = r % 72;
      tr_tile<0>(p.w_in + (size_t)l * 1024 * INW, INW, kt * 64, nt * 64, INW, p.Wt_in + (size_t)l * INWP * 1024, 1024, 0, tile); continue; }
    r -= L_IN;
    if (r < L_OUT) { const int kt = r / 16, nt = r % 16;
      tr_tile<0>(p.w_out + (size_t)l * 1536 * 1024, 1024, kt * 64, nt * 64, 1024, p.Wt_out + (size_t)l * 1024 * 1536, 1536, 0, tile); continue; }
    r -= L_OUT;
    if (r < L_UQ) { const int kt = r / 12, nt = r % 12;
      tr_tile<0>(p.w_uq + (size_t)l * 256 * 768, 768, kt * 64, nt * 64, 768, p.Wt_mla + (size_t)l * MLAN * MLAK, MLAK, 0, tile); continue; }
    r -= L_UQ;
    { const int kt = r / 16, nt = r % 16;
      tr_tile<0>(p.w_ukv + (size_t)l * 128 * 1024, 1024, kt * 64, nt * 64, 1024, p.Wt_mla + (size_t)l * MLAN * MLAK + (size_t)768 * MLAK, MLAK, 256, tile); } }
  { unsigned zz = 0u; asm volatile("" : "+v"(zz)); const u32x4 z = (u32x4){zz, zz, zz, zz};
    const int gtid = me * NTHREADS + t, gstr = nb * NTHREADS;
    for (int i = gtid; i < 768 * 16; i += gstr) { const int rr = i / 16, c8 = (i % 16) * 8; *(u32x4*)(p.Wt_mla + ((size_t)l * MLAN + rr) * MLAK + 256 + c8) = z; }
    for (int i = gtid; i < 1024 * 32; i += gstr) { const int rr = i / 32, c8 = (i % 32) * 8; *(u32x4*)(p.Wt_mla + ((size_t)l * MLAN + 768 + rr) * MLAK + c8) = z; } }
}

__device__ void ph_prologue(const FP& p, LAS unsigned char* lds) {
  const int G = gridDim.x, bid = blockIdx.x, t = TIDX;
  dense_weights_layer(p, 0, 0, lds);
  for (int i = bid * NTHREADS + t; i < DEPTH * 64 * 64; i += G * NTHREADS) { const int l = i >> 12, s = (i >> 6) & 63, ln = i & 63; u32x4 wh, wl; unsigned hh[8], ll[8];
#pragma unroll
    for (int jj = 0; jj < 8; ++jj) { const float w = p.w_router[((size_t)l * D + 16 * s + 8 * (ln >> 5) + jj) * NE + (ln & 31)]; unsigned u = __float_as_uint(w); u += 0x7fffu + ((u >> 16) & 1u); hh[jj] = u >> 16;
      const float res = w - __uint_as_float(hh[jj] << 16); unsigned v = __float_as_uint(res); v += 0x7fffu + ((v >> 16) & 1u); ll[jj] = v >> 16; }
    wh.x = hh[0] | (hh[1] << 16); wh.y = hh[2] | (hh[3] << 16); wh.z = hh[4] | (hh[5] << 16); wh.w = hh[6] | (hh[7] << 16); wl.x = ll[0] | (ll[1] << 16); wl.y = ll[2] | (ll[3] << 16); wl.z = ll[4] | (ll[5] << 16); wl.w = ll[6] | (ll[7] << 16);
    *(u32x4*)(p.WRF + ((size_t)(l * 2) * 64 * 64 + (s * 64 + ln)) * 8) = wh; *(u32x4*)(p.WRF + ((size_t)(l * 2 + 1) * 64 * 64 + (s * 64 + ln)) * 8) = wl; }
  if (bid == 0) for (int i = t; i < 64 * 16; i += NTHREADS) { const int pos = i >> 4, f = i & 15; const float ang = (float)pos * expf(-(float)f * (9.210340371976184f / 16.f)); p.ROPE[pos * 32 + f] = cosf(ang); p.ROPE[pos * 32 + 16 + f] = sinf(ang); }
  { LAS float* sc = (LAS float*)(lds + 32768);
    LAS float* part = (LAS float*)(lds + 32768 + 5 * 1024 * 4);
    __syncthreads();
    for (int i = t; i < 5 * 1024; i += NTHREADS) { const int r = i >> 10, k = i & 1023; const float v = r < 4 ? p.c[r * 1024 + k] : p.c_ctx[k]; sc[i] = v / (1.f + expf(-v)); }
    __syncthreads();
    for (int item = bid; item < DEPTH * 64; item += G) { const int l = item >> 6, c0 = (item & 63) * 96, col = t % 96, ks = t / 96;
      if (ks < 5) { float a[5] = {0.f, 0.f, 0.f, 0.f, 0.f}; const float* w = p.w_mod + (size_t)l * 1024 * 6144 + c0 + col; const int k0 = ks * 205, k1 = k0 + 205 < 1024 ? k0 + 205 : 1024;
#pragma unroll 8
        for (int k = k0; k < k1; ++k) { const float wv = w[(size_t)k * 6144];
#pragma unroll
          for (int r = 0; r < 5; ++r) a[r] += sc[r * 1024 + k] * wv; }
#pragma unroll
        for (int r = 0; r < 5; ++r) part[(ks * 96 + col) * 5 + r] = a[r]; }
      __syncthreads();
      if (t < 96) {
#pragma unroll
        for (int r = 0; r < 5; ++r) { float sm = 0.f;
#pragma unroll
          for (int q = 0; q < 5; ++q) sm += part[(q * 96 + t) * 5 + r];
          p.MOD[(size_t)(l * 5 + r) * 6144 + c0 + t] = sm + p.b_mod[l * 6144 + c0 + t]; } }
      __syncthreads(); } }
}

template <int step = 1, int off = 0, int B1 = 1 << 30> __device__ void moe_weights_layer(const FP& p, int l, int t0, int t1, int b0, LAS unsigned char* lds) {
  int bid_ = (int)blockIdx.x; asm volatile("" : "+s"(bid_));
  LAS float* tile = (LAS float*)lds; const int me0 = bid_ - b0; if (me0 < 0 || bid_ >= B1 || (step > 1 && (me0 & (step - 1)) != off)) return;
  const int gtop = (int)gridDim.x < B1 ? (int)gridDim.x : B1;
  int me = step > 1 ? me0 >> (step == 2 ? 1 : 2) : me0; const int nb = step > 1 ? (gtop - b0 - off + step - 1) >> (step == 2 ? 1 : 2) : gtop - b0; if (nb <= 0) return;
  const int t = TIDX;
  auto src_of = [&](int sid, int& ld) -> const float* { const int id = sid * 4;
    if (id < NE * 512) { const int m = l * NE + id / 512, tt = id % 512, kt = tt / 32, nt = tt % 32; ld = 2048; return p.w_gate_up + (size_t)m * 1024 * 2048 + (size_t)(kt * 64) * 2048 + nt * 64; }
    const int r = id - NE * 512; const int m = l * NE + r / 256, tt = r % 256, kt = tt / 16, nt = tt % 16; ld = 1024; return p.w_down + (size_t)m * 1024 * 1024 + (size_t)(kt * 64) * 1024 + nt * 64; };
  auto load_strip = [&](int sid, f32x4 (&v)[8]) { int ld; const float* src = src_of(sid, ld);
#pragma unroll
    for (int i = 0; i < 8; ++i) { const int idx = t + 512 * i, tb = idx >> 10, q = idx & 1023, k = q >> 4, n4 = (q & 15) * 4; v[i] = *(const f32x4*)((const char*)src + (unsigned)(k * ld + tb * 64 + n4) * 4u); } };
  __syncthreads();
  const int s0 = t0 / 4 + me, s1 = t1 / 4;
  auto process = [&](int sid, const f32x4 (&v)[8]) {
#pragma unroll
    for (int i = 0; i < 8; ++i) { const int idx = t + 512 * i, tb = idx >> 10, q = idx & 1023, k = q >> 4, n4 = (q & 15) * 4; LAS float* tp = tile + tb * (64 * 65) + k * 65 + n4;
      tp[0] = v[i][0]; tp[1] = v[i][1]; tp[2] = v[i][2]; tp[3] = v[i][3]; }
    __syncthreads();
    { const int id = sid * 4, n = t >> 3, k8 = (t & 7) * 8;
      const bool gu = id < NE * 512; const int r = gu ? id : id - NE * 512; const int m = l * NE + (gu ? r / 512 : r / 256), tt = gu ? r % 512 : r % 256, kt = gu ? tt / 32 : tt / 16, nt = gu ? tt % 32 : tt % 16;
      bf16_t* dst = gu ? p.Wt_gu + (size_t)m * 2048 * 1024 : p.Wt_dn + (size_t)m * 1024 * 1024;
#pragma unroll
      for (int tb = 0; tb < 4; ++tb) { float o[8];
#pragma unroll
        for (int j = 0; j < 8; ++j) o[j] = tile[tb * (64 * 65) + (k8 + j) * 65 + n];
        u32x4 w; w.x = cvt_pk_bf16(o[0], o[1]); w.y = cvt_pk_bf16(o[2], o[3]); w.z = cvt_pk_bf16(o[4], o[5]); w.w = cvt_pk_bf16(o[6], o[7]);
        const int gn = (nt + tb) * 64 + n; int row;
        if (gu) { const int bj = gn >> 10, c = gn & 1023; row = (c >> 7) * 256 + bj * 128 + (c & 127); }
        else row = gn;
        *(u32x4*)((char*)dst + (unsigned)(row * 1024 + kt * 64 + k8) * 2u) = w; } }
    __syncthreads(); };
  f32x4 va[8], vb[8];
  if (s0 < s1) load_strip(s0, va);
#pragma unroll 1
  for (int sid = s0; sid < s1; sid += 2 * nb) {
    if (sid + nb < s1) load_strip(sid + nb, vb);
    process(sid, va);
    if (sid + nb >= s1) break;
    if (sid + 2 * nb < s1) load_strip(sid + 2 * nb, va);
    process(sid + nb, vb); }
}

struct MoeTab { LAS int* blk_e; LAS int* blk_j; LAS int* start; int nblk; };
__device__ __forceinline__ MoeTab moe_tables(const int* cntl, LAS unsigned char* misc) {
  MoeTab m; m.blk_e = (LAS int*)misc; m.blk_j = m.blk_e + MAXBLK; m.start = m.blk_j + MAXBLK;
  const int t = TIDX;
  __syncthreads();
  if (t < 64) { const int e = t & 31; const int nb = (__hip_atomic_load(&cntl[e], __ATOMIC_RELAXED, __HIP_MEMORY_SCOPE_AGENT) + 255) >> 8; int incl = nb;
#pragma unroll
    for (int o = 1; o < 32; o <<= 1) { const int v = shupi(incl, o); if ((t & 31) >= o) incl += v; }
    if (t < 32) { m.start[e] = incl - nb; if (e == 31) m.start[32] = incl; } }
  __syncthreads();
  m.nblk = m.start[32];
  for (int blk = t; blk < m.nblk; blk += NTHREADS) { int e = 0;
    while (m.start[e + 1] <= blk) ++e;
    m.blk_e[blk] = e; m.blk_j[blk] = blk - m.start[e]; }
  __syncthreads();
  return m;
}

__device__ __forceinline__ LAS int* moe_unit_list(const MoeTab& m, int NPN) {
  LAS int* ul = m.start + 40; const int t = TIDX;
  if (t < 32) { const int q = t * (int)gridDim.x + (int)blockIdx.x; const bool ok = q < m.nblk * NPN;
    if (ok) { ul[1 + 2 * t] = q / NPN; ul[2 + 2 * t] = q % NPN; }
    const unsigned long long bal = __ballot(ok); if (t == 0) ul[0] = __popcll(bal); }
  __syncthreads();
  return ul;
}

__device__ __forceinline__ float dpp_add(float v, int ctrl_is) { return v; }
#define DPP_F(v, ctrl) __int_as_float(__builtin_amdgcn_update_dpp(0, __float_as_int(v), (ctrl), 0xf, 0xf, false))
__device__ __forceinline__ float wave_sum(float v) {
  v += DPP_F(v, 0xB1); v += DPP_F(v, 0x4E); v += DPP_F(v, 0x141); v += DPP_F(v, 0x140);
  const float r0 = __uint_as_float(__builtin_amdgcn_readlane(__float_as_uint(v), 0)), r1 = __uint_as_float(__builtin_amdgcn_readlane(__float_as_uint(v), 16));
  const float r2 = __uint_as_float(__builtin_amdgcn_readlane(__float_as_uint(v), 32)), r3 = __uint_as_float(__builtin_amdgcn_readlane(__float_as_uint(v), 48));
  return (r0 + r1) + (r2 + r3); }

__device__ __forceinline__ void moe_combine_row(const FP& p, int lprev, int row, const LAS int* start, const float* gate, int lane, f32x4 (&x)[4]) {
  int sl[4]; float w[4];
#pragma unroll
  for (int k = 0; k < 4; ++k) { const int e = p.TOPE[row * 4 + k]; sl[k] = start[e] * 256 + p.TOPP[row * 4 + k]; w[k] = p.TOPW[row * 4 + k]; }
#pragma unroll
  for (int i = 0; i < 4; ++i) { f32x4 y = (f32x4){0.f, 0.f, 0.f, 0.f};
#pragma unroll
    for (int k = 0; k < 4; ++k) { const u32x2 v = *(const u32x2*)(p.YSb + (size_t)sl[k] * 1024 + i * 256 + lane * 4);
      y[0] += w[k] * bflo(v.x); y[1] += w[k] * bfhi(v.x); y[2] += w[k] * bflo(v.y); y[3] += w[k] * bfhi(v.y); }
    const f32x4 g = *(const f32x4*)(gate + i * 256 + lane * 4); x[i] = x[i] + g * y; }
}

template <bool DRY = false> __device__ void ph_norm1(const FP& p, int l, LAS unsigned char* lds) {
  const int t = TIDX, lane = t & 63, gw = blockIdx.x * NWAVES + (t >> 6), GWN = gridDim.x * NWAVES;
  MoeTab mt{}; if (l > 0) mt = moe_tables(p.cnt + (l - 1) * 32, lds + LDS_MISC);
  const float* MODl = p.MOD + (size_t)l * 5 * 6144; const float* MODp = p.MOD + (size_t)(l > 0 ? l - 1 : 0) * 5 * 6144; const float* g1 = p.g_norm1 + l * D;
  for (int row = gw; row < T; row += GWN) { const int b = row / SB, s = row % SB, r = s < CTX ? 4 : b;
    f32x4 x[4];
    { const float* src = l > 0 ? p.X + (size_t)row * D : (s < CTX ? p.ctx + ((size_t)b * CTX + s) * D : p.x + ((size_t)b * SEQ + (s - CTX)) * D);
#pragma unroll
      for (int i = 0; i < 4; ++i) x[i] = *(const f32x4*)(src + i * 256 + lane * 4); }
    if (l > 0) moe_combine_row(p, l - 1, row, mt.start, MODp + (size_t)r * 6144 + 5120, lane, x);
    if (!DRY) {
#pragma unroll
      for (int i = 0; i < 4; ++i) *(f32x4*)(p.X + (size_t)row * D + i * 256 + lane * 4) = x[i]; }
    float ss = 0.f;
#pragma unroll
    for (int i = 0; i < 4; ++i) ss += x[i][0] * x[i][0] + x[i][1] * x[i][1] + x[i][2] * x[i][2] + x[i][3] * x[i][3];
    ss = wave_sum(ss); const float rs = rsqrtf(ss * (1.f / 1024.f) + 1e-6f);
    const float* m = MODl + (size_t)r * 6144;
#pragma unroll
    for (int i = 0; i < 4; ++i) { const int c = i * 256 + lane * 4; const f32x4 g = *(const f32x4*)(g1 + c), sc = *(const f32x4*)(m + 1024 + c), sh = *(const f32x4*)(m + c);
      const f32x4 h = x[i] * rs * g * (sc + 1.f) + sh; u32x2 w; w.x = cvt_pk_bf16(h[0], h[1]); w.y = cvt_pk_bf16(h[2], h[3]);
      *(u32x2*)((DRY ? p.SCR : p.Hb) + (size_t)row * D + c) = w; } }
}

template <bool DRY = false> __device__ void ph_norm2(const FP& p, int l, LAS unsigned char* lds) {
  const int t = TIDX, lane = t & 63, gw = blockIdx.x * NWAVES + (t >> 6), GWN = gridDim.x * NWAVES;
  LAS float* wT = (LAS float*)lds;
  __syncthreads();
  { const float* wr = p.w_router + (size_t)l * D * NE;
    for (int i = t; i < D * NE / 4; i += NTHREADS) { const int c = i >> 3, e4 = (i & 7) * 4; const f32x4 v = *(const f32x4*)(wr + (size_t)c * NE + e4);
      wT[(e4 + 0) * 1024 + c] = v[0]; wT[(e4 + 1) * 1024 + c] = v[1]; wT[(e4 + 2) * 1024 + c] = v[2]; wT[(e4 + 3) * 1024 + c] = v[3]; } }
  __syncthreads();
  const float* MODl = p.MOD + (size_t)l * 5 * 6144; const float* g2 = p.g_norm2 + l * D; int* cntl = p.cnt + l * 32;
  const float myb = p.b_router[l * NE + (lane >> 1)];
  for (int row = gw; row < T; row += GWN) { const int b = row / SB, s = row % SB, r = s < CTX ? 4 : b;
    if (l == DEPTH - 1 && s < CTX) continue;
    f32x4 h[4]; float ss = 0.f;
#pragma unroll
    for (int i = 0; i < 4; ++i) { h[i] = *(const f32x4*)(p.X + (size_t)row * D + i * 256 + lane * 4); ss += h[i][0] * h[i][0] + h[i][1] * h[i][1] + h[i][2] * h[i][2] + h[i][3] * h[i][3]; }
    ss = wave_sum(ss); const float rs = rsqrtf(ss * (1.f / 1024.f) + 1e-6f);
    const float* m = MODl + (size_t)r * 6144;
#pragma unroll
    for (int i = 0; i < 4; ++i) { const int c = i * 256 + lane * 4; const f32x4 g = *(const f32x4*)(g2 + c), sc = *(const f32x4*)(m + 4096 + c), sh = *(const f32x4*)(m + 3072 + c);
      h[i] = h[i] * rs * g * (sc + 1.f) + sh; u32x2 w; w.x = cvt_pk_bf16(h[i][0], h[i][1]); w.y = cvt_pk_bf16(h[i][2], h[i][3]);
      *(u32x2*)((DRY ? p.SCR : p.H2b) + (size_t)row * D + c) = w; }
#ifdef PROBE_NOROUTER
    if (DRY) continue;
#endif
    float acc[32];
#pragma unroll
    for (int e = 0; e < 32; ++e) { float a = 0.f;
#pragma unroll
      for (int i = 0; i < 4; ++i) { const f32x4 w = *(const LAS f32x4*)(wT + e * 1024 + i * 256 + lane * 4); a += h[i][0] * w[0] + h[i][1] * w[1] + h[i][2] * w[2] + h[i][3] * w[3]; }
      acc[e] = a; }
#define BFLY(NV, BIT) { const bool up = (lane >> (BIT)) & 1; _Pragma("unroll") for (int e = 0; e < (NV) / 2; ++e) { const float a = acc[e], bq = acc[e + (NV) / 2]; const float keep = up ? bq : a, send = up ? a : bq; acc[e] = keep + shx(send, 1 << (BIT)); } }
    BFLY(32, 5) BFLY(16, 4) BFLY(8, 3) BFLY(4, 2) BFLY(2, 1)
#undef BFLY
    float v = acc[0] + shx(acc[0], 1); v += myb;
    float lg[32];
#pragma unroll
    for (int e = 0; e < 32; ++e) lg[e] = __uint_as_float(__builtin_amdgcn_readlane(__float_as_uint(v), 2 * e));
    float tv[4]; int ti[4];
#pragma unroll
    for (int k = 0; k < 4; ++k) { float bv = -3.0e38f; int bi = 0;
#pragma unroll
      for (int e = 0; e < 32; ++e) { if (lg[e] > bv) { bv = lg[e]; bi = e; } }
      tv[k] = bv; ti[k] = bi;
#pragma unroll
      for (int e = 0; e < 32; ++e) if (e == bi) lg[e] = -3.0e38f; }
    if (lane == 0) { float e4[4], sum = 0.f;
#pragma unroll
      for (int k = 0; k < 4; ++k) { e4[k] = expf(tv[k] - tv[0]); sum += e4[k]; }
      const float inv = 1.f / sum;
#pragma unroll
      for (int k = 0; k < 4; ++k) { if (DRY) { ((float*)p.SCR)[(size_t)T * 512 + row * 4 + k] = e4[k] * inv + (float)ti[k]; continue; } const int pos = atomicAdd(&cntl[ti[k]], 1); p.TOPE[row * 4 + k] = ti[k]; p.TOPP[row * 4 + k] = pos; p.TOPW[row * 4 + k] = e4[k] * inv; __hip_atomic_store(&p.ROWTOK[(size_t)ti[k] * T + pos], row, __ATOMIC_RELAXED, __HIP_MEMORY_SCOPE_AGENT);     } } }
}

__device__ void ph_final(const FP& p, LAS unsigned char* lds) {
  const int t = TIDX, lane = t & 63, gw = blockIdx.x * NWAVES + (t >> 6), GWN = gridDim.x * NWAVES;
  MoeTab mt = moe_tables(p.cnt + (DEPTH - 1) * 32, lds + LDS_MISC);
  const float* MODp = p.MOD + (size_t)(DEPTH - 1) * 5 * 6144;
  for (int orow = gw; orow < NB * SEQ; orow += GWN) { const int b = orow / SEQ, tk = orow % SEQ, row = b * SB + CTX + tk;
    f32x4 x[4];
#pragma unroll
    for (int i = 0; i < 4; ++i) x[i] = *(const f32x4*)(p.X + (size_t)row * D + i * 256 + lane * 4);
    moe_combine_row(p, DEPTH - 1, row, mt.start, MODp + (size_t)b * 6144 + 5120, lane, x);
    float ss = 0.f;
#pragma unroll
    for (int i = 0; i < 4; ++i) ss += x[i][0] * x[i][0] + x[i][1] * x[i][1] + x[i][2] * x[i][2] + x[i][3] * x[i][3];
    ss = wave_sum(ss); const float rs = rsqrtf(ss * (1.f / 1024.f) + 1e-6f);
#pragma unroll
    for (int i = 0; i < 4; ++i) { const int c = i * 256 + lane * 4; const f32x4 g = *(const f32x4*)(p.g_final + c); *(f32x4*)(p.out + (size_t)orow * D + c) = x[i] * rs * g; } }
}

__device__ void ph_inproj(const FP& p, int l, LAS unsigned char* lds) {
  Gemm g; g.A = p.Hb; g.Bt = p.Wt_in + (size_t)l * INWP * 1024; g.M = T; g.N = INWP; g.K = 1024;
  StaticOrder S; S.init(T, INWP, 1024, gridDim.x, blockIdx.x); EpiInproj E; E.O = p.Pb; E.GAB = p.GAB;
  gemm_phase<EpiInproj, StaticOrder>(lds, g, S, E);
}
__device__ void outproj_ctx(const FP& p, int l, LAS unsigned char* lds) {
  const int t = TIDX, w = t >> 6, lane = t & 63, c32 = lane & 31, hi = lane >> 5;
  const bf16_t* Bt = p.Wt_out + (size_t)l * 1024 * 1536; const float* gate = p.MOD + (size_t)l * 5 * 6144 + 4 * 6144 + 2048;
  LAS float* lf = (LAS float*)lds;
  for (int u = blockIdx.x; u < 256; u += gridDim.x) { const int cu = u >> 4, st = u & 15, batch = cu >> 2, pn = cu & 3, sr = st >> 2, sc = st & 3;
    const int r0 = batch * SB + 64 * sr, c0 = pn * 256 + 64 * sc;
    const bf16_t* ap = p.CATb + (size_t)(r0 + c32) * 1536 + 192 * w + 8 * hi; const bf16_t* bp = Bt + (size_t)(c0 + c32) * 1536 + 192 * w + 8 * hi;
    f32x16 acc[2][2];
#pragma unroll
    for (int m = 0; m < 2; ++m)
#pragma unroll
      for (int n = 0; n < 2; ++n)
#pragma unroll
        for (int r = 0; r < 16; ++r) acc[m][n][r] = 0.f;
#pragma unroll
    for (int sg = 0; sg < 3; ++sg) { bf16x8 af[2][4], bfr[2][4];
#pragma unroll
      for (int s = 0; s < 4; ++s)
#pragma unroll
        for (int m = 0; m < 2; ++m) { af[m][s] = *(const bf16x8*)(ap + (size_t)m * 32 * 1536 + (sg * 4 + s) * 16); bfr[m][s] = *(const bf16x8*)(bp + (size_t)m * 32 * 1536 + (sg * 4 + s) * 16); }
#pragma unroll
      for (int s = 0; s < 4; ++s)
#pragma unroll
        for (int m = 0; m < 2; ++m)
#pragma unroll
          for (int n = 0; n < 2; ++n) acc[m][n] = __builtin_amdgcn_mfma_f32_32x32x16_bf16(af[m][s], bfr[n][s], acc[m][n], 0, 0, 0); }
    __syncthreads();
#pragma unroll
    for (int m = 0; m < 2; ++m)
#pragma unroll
      for (int n = 0; n < 2; ++n)
#pragma unroll
        for (int r = 0; r < 16; ++r) lf[w * 4096 + (32 * m + crow16(r, hi)) * 64 + 32 * n + c32] = acc[m][n][r];
    __syncthreads();
    { const int row = t >> 3, col = (t & 7) * 8; f32x4 s0 = (f32x4){0.f, 0.f, 0.f, 0.f}, s1 = s0;
#pragma unroll
      for (int ww = 0; ww < 8; ++ww) { s0 = s0 + *(const LAS f32x4*)(lf + ww * 4096 + row * 64 + col); s1 = s1 + *(const LAS f32x4*)(lf + ww * 4096 + row * 64 + col + 4); }
      const f32x4 g0 = *(const f32x4*)(gate + c0 + col), g1 = *(const f32x4*)(gate + c0 + col + 4);
      float* xp = p.X + (size_t)(r0 + row) * D + c0 + col;
      *(f32x4*)xp = *(const f32x4*)xp + g0 * s0; *(f32x4*)(xp + 4) = *(const f32x4*)(xp + 4) + g1 * s1; }
    __syncthreads(); }
}
__device__ void ph_outproj(const FP& p, int l, LAS unsigned char* lds) {
  Gemm g; g.A = p.CATb; g.Bt = p.Wt_out + (size_t)l * 1024 * 1536; g.M = T; g.N = 1024; g.K = 1536;
  EpiOutproj E; E.X = p.X; E.MODl = p.MOD + (size_t)l * 5 * 6144;
  { LatentOrder S; S.nN = 4; S.G = gridDim.x; S.c = blockIdx.x; S.K = 1536; gemm_phase<EpiOutproj, LatentOrder>(lds, g, S, E); }
  if (l != DEPTH - 1) outproj_ctx(p, l, lds);
}
__device__ void ph_gemm1(const FP& p, int l, LAS unsigned char* lds) {
  MoeTab mt = moe_tables(p.cnt + l * 32, lds + LDS_MISC);
  Gemm g; g.A = p.H2b; g.Bt = p.Wt_gu + (size_t)l * NE * 2048 * 1024; g.M = 0; g.N = 2048; g.K = 1024;
  MoeOrder<true> S; S.nblk = mt.nblk; S.NPN = 8; S.G = gridDim.x; S.c = blockIdx.x; S.K = 1024; S.blk_e = mt.blk_e; S.blk_j = mt.blk_j; S.ulist = moe_unit_list(mt, 8); S.rowtok = p.ROWTOK; S.cnt = p.cnt + l * 32; S.bstride = (long)2048 * 1024 * 2;
  EpiGateUp E; E.ACT = p.ACTb; E.bgu = p.b_gate_up + (size_t)l * NE * 2048;
  gemm_phase<EpiGateUp, MoeOrder<true>>(lds, g, S, E);
}
__device__ void ph_gemm2(const FP& p, int l, LAS unsigned char* lds) {
  MoeTab mt = moe_tables(p.cnt + l * 32, lds + LDS_MISC);
  Gemm g; g.A = p.ACTb; g.Bt = p.Wt_dn + (size_t)l * NE * 1024 * 1024; g.M = 0; g.N = 1024; g.K = 1024;
  MoeOrder<false> S; S.nblk = mt.nblk; S.NPN = 4; S.G = gridDim.x; S.c = blockIdx.x; S.K = 1024; S.blk_e = mt.blk_e; S.blk_j = mt.blk_j; S.ulist = moe_unit_list(mt, 4); S.rowtok = nullptr; S.cnt = p.cnt + l * 32; S.bstride = (long)1024 * 1024 * 2;
  EpiDown E; E.YS = p.YSb; E.bdn = p.b_down + (size_t)l * NE * 1024;
  gemm_phase<EpiDown, MoeOrder<false>>(lds, g, S, E);
}
constexpr float QSCALE = 0.07216878364870322f * 1.4426950408889634f;

__device__ __forceinline__ void prep_mla_row(const FP& p, int l, int row, int lane) {
  const int s = row % SB; const bool lat = s >= CTX; const int tok = s - CTX;
  const bf16_t* pr = p.Pb + (size_t)row * INWP;
  { const u32x2 v = *(const u32x2*)(pr + C_DQ + lane * 4); float x[4] = {bflo(v.x), bfhi(v.x), bflo(v.y), bfhi(v.y)};
    const float ss = wave_sum(x[0] * x[0] + x[1] * x[1] + x[2] * x[2] + x[3] * x[3]); const float rs = rsqrtf(ss * (1.f / 256.f) + 1e-6f);
    const f32x4 g = *(const f32x4*)(p.g_cq + l * 256 + lane * 4); u32x2 w; w.x = cvt_pk_bf16(x[0] * rs * g[0], x[1] * rs * g[1]); w.y = cvt_pk_bf16(x[2] * rs * g[2], x[3] * rs * g[3]);
    *(u32x2*)(p.A2b + (size_t)row * MLAK + lane * 4) = w; }
  { const unsigned v = *(const unsigned*)(pr + C_DKV + lane * 2); const float x0 = bflo(v), x1 = bfhi(v);
    const float ss = wave_sum(x0 * x0 + x1 * x1); const float rs = rsqrtf(ss * (1.f / 128.f) + 1e-6f);
    const float g0 = p.g_ckv[l * 128 + lane * 2], g1 = p.g_ckv[l * 128 + lane * 2 + 1];
    *(unsigned*)(p.A2b + (size_t)row * MLAK + 256 + lane * 2) = cvt_pk_bf16(x0 * rs * g0, x1 * rs * g1); }
  { const float x = bf2f(pr[C_KR + lane]); const float xp = shx(x, 16); float y = x;
    if (lat) { const int hh = lane >> 5, ii = lane & 31, fi = ii & 15; const float pos = (float)(hh == 0 ? (tok >> 6) : (tok & 63));
      const float ang = pos * __expf(-(float)fi * (9.210340371976184f / 16.f)); const float cs = __cosf(ang), sn = __sinf(ang);
      y = ii < 16 ? x * cs - xp * sn : x * cs + xp * sn; }
    unsigned u = __float_as_uint(y); u += 0x7fffu + ((u >> 16) & 1u); p.KRb[(size_t)row * 64 + lane] = (bf16_t)(u >> 16); }
}

struct EpiMla {
    static constexpr bool PERM = false;
    bf16_t *Q, *Kn, *V; const float* ROPE;
    __device__ __forceinline__ void operator()(const f32x4 (&acc)[2][2][4][2], const Unit& u, int wr, int wc, int fr, int fq) const {
        const int row0 = u.pm * BM + wr * 64 + fr; const bool ctxt = (u.pm % 17) == 0; const int tok0 = (u.pm % 17 - 1) * 256 + wr * 64 + fr;
        if (u.pn < 3) {
#pragma unroll
            for (int bj = 0; bj < 2; ++bj) { const int cg = u.pn * 256 + bj * 128 + wc * 32;
                const int g6 = (cg >> 5) % 6;
#pragma unroll
                for (int ai = 0; ai < 2; ++ai)
#pragma unroll
                    for (int m = 0; m < 4; ++m) { const int row = row0 + ai * HALF + m * 16; f32x4 v0 = acc[ai][bj][m][0], v1 = acc[ai][bj][m][1];
                        if (g6 >= 4 && !ctxt) { const int tok = tok0 + ai * HALF + m * 16; const int pos = g6 == 4 ? (tok >> 6) : (tok & 63);
                            const f32x4 cs = *(const f32x4*)(ROPE + pos * 32 + 4 * fq), sn = *(const f32x4*)(ROPE + pos * 32 + 16 + 4 * fq);
#pragma unroll
                            for (int j = 0; j < 4; ++j) { const float x1 = v0[j], x2 = v1[j]; v0[j] = x1 * cs[j] - x2 * sn[j]; v1[j] = x2 * cs[j] + x1 * sn[j]; } }
                        v0 = v0 * QSCALE; v1 = v1 * QSCALE;
                        bf16_t* qp = Q + (size_t)row * 768 + cg + 4 * fq; u32x2 w0, w1; w0.x = cvt_pk_bf16(v0[0], v0[1]); w0.y = cvt_pk_bf16(v0[2], v0[3]); w1.x = cvt_pk_bf16(v1[0], v1[1]); w1.y = cvt_pk_bf16(v1[2], v1[3]);
                        *(u32x2*)qp = w0; *(u32x2*)(qp + 16) = w1; } }
        } else { const int h = u.pn - 3;
#pragma unroll
            for (int bj = 0; bj < 2; ++bj) { bf16_t* base = (bj == 0 ? Kn : V) + h * 128 + wc * 32 + 4 * fq;
#pragma unroll
                for (int ai = 0; ai < 2; ++ai)
#pragma unroll
                    for (int m = 0; m < 4; ++m) { const int row = row0 + ai * HALF + m * 16; const f32x4 v0 = acc[ai][bj][m][0], v1 = acc[ai][bj][m][1];
                        u32x2 w0, w1; w0.x = cvt_pk_bf16(v0[0], v0[1]); w0.y = cvt_pk_bf16(v0[2], v0[3]); w1.x = cvt_pk_bf16(v1[0], v1[1]); w1.y = cvt_pk_bf16(v1[2], v1[3]);
                        *(u32x2*)(base + (size_t)row * 512) = w0; *(u32x2*)(base + (size_t)row * 512 + 16) = w1; } } }
    }
};
__device__ void ph_mla_gemm(const FP& p, int l, LAS unsigned char* lds) {
  Gemm g; g.A = p.A2b; g.Bt = p.Wt_mla + (size_t)l * MLAN * MLAK; g.M = T; g.N = MLAN; g.K = MLAK;
  StaticOrder S; S.init(T, MLAN, MLAK, gridDim.x, blockIdx.x); EpiMla E; E.Q = p.Qb; E.Kn = p.Knb; E.V = p.Vb; E.ROPE = p.ROPE;
  gemm_phase<EpiMla, StaticOrder>(lds, g, S, E);
}

namespace att {
constexpr int NW = 8, QBLK = 32, KVBLK = 64;
constexpr float THRL = 8.f * 1.4426950408889634f;
constexpr int SHM_V = KVBLK * 128 * 2, SHM_K = KVBLK * 128 * 2, SHM_R = KVBLK * 64 * 2;
constexpr int OFF_V = 0, OFF_K = 2 * SHM_V, OFF_R = OFF_K + 2 * SHM_K, OFF_WS = OFF_R + 2 * SHM_R, OFF_Q = OFF_WS + NW * 64 * 4, SHM_ATTN = OFF_Q + 256 * 128;
#define KSWZ(row, colB) ((row) * 256 + ((colB) ^ (((row) & 7) << 4)))
#define RSWZ(row, colB) ((row) * 128 + ((colB) ^ ((((row) >> 1) & 7) << 4)))
#define SBAR() __builtin_amdgcn_sched_barrier(0)
__device__ __forceinline__ int crow(int r, int hi) { return (r & 3) + 8 * (r >> 2) + 4 * hi; }
__device__ __forceinline__ void partialSM(f32x16& p0, f32x16& p1, float& m_reg, float& mn, float& alpha) {
  float pmax = p0[0];
#pragma unroll
  for (int r = 1; r < 16; ++r) pmax = fmaxf(pmax, p0[r]);
#pragma unroll
  for (int r = 0; r < 16; ++r) pmax = fmaxf(pmax, p1[r]);
  { auto rr = __builtin_amdgcn_permlane32_swap(__float_as_uint(pmax), __float_as_uint(pmax), false, false); pmax = fmaxf(__uint_as_float(rr[0]), __uint_as_float(rr[1])); }
  if (__builtin_expect(__all(pmax - m_reg <= THRL), 1)) { mn = m_reg; alpha = 1.f; }
  else { mn = fmaxf(m_reg, pmax); alpha = __builtin_amdgcn_exp2f(m_reg - mn); m_reg = mn; }
#pragma unroll
  for (int r = 0; r < 16; ++r) p0[r] = p0[r] - mn;
#pragma unroll
  for (int r = 0; r < 16; ++r) p1[r] = p1[r] - mn;
#pragma unroll
  for (int r = 0; r < 16; ++r) p0[r] = __builtin_amdgcn_exp2f(p0[r]);
}
__device__ __forceinline__ void finishSM(f32x16& p0, f32x16& p1, float alpha, float& l_reg, bf16x8& pa0, bf16x8& pa1, bf16x8& pa2, bf16x8& pa3) {
#pragma unroll
  for (int r = 0; r < 16; ++r) p1[r] = __builtin_amdgcn_exp2f(p1[r]);
  float ps = 0;
#pragma unroll
  for (int r = 0; r < 16; ++r) ps += p0[r];
#pragma unroll
  for (int r = 0; r < 16; ++r) ps += p1[r];
  { auto rr = __builtin_amdgcn_permlane32_swap(__float_as_uint(ps), __float_as_uint(ps), false, false); ps = __uint_as_float(rr[0]) + __uint_as_float(rr[1]); }
  l_reg = l_reg * alpha + ps;
#define PK4(P, BASE, OUT) do { unsigned a0 = cvt_pk_bf16(P[BASE + 0], P[BASE + 1]), a1 = cvt_pk_bf16(P[BASE + 2], P[BASE + 3]);   \
    unsigned b0 = cvt_pk_bf16(P[BASE + 4], P[BASE + 5]), b1 = cvt_pk_bf16(P[BASE + 6], P[BASE + 7]);                              \
    auto r0 = __builtin_amdgcn_permlane32_swap(a0, b0, false, false); auto r1 = __builtin_amdgcn_permlane32_swap(a1, b1, false, false); \
    u32x4 w = {r0[0], r1[0], r0[1], r1[1]}; OUT = *reinterpret_cast<bf16x8*>(&w); } while (0)
  PK4(p0, 0, pa0); PK4(p0, 8, pa1); PK4(p1, 0, pa2); PK4(p1, 8, pa3);
#undef PK4
}
__device__ __forceinline__ void qkt(f32x16& p0, f32x16& p1, const char* Ks, const char* Rs, const bf16x8* qr, const char* qrow, int qsw, int r32, int hi) {
  p0 = f32x16{}; p1 = f32x16{};
#pragma unroll
  for (int d0 = 0; d0 < 8; ++d0) { const int cb = (d0 * 16 + hi * 8) * 2;
    const bf16x8 b0 = *reinterpret_cast<const bf16x8*>(Ks + KSWZ(r32, cb));
    const bf16x8 b1 = *reinterpret_cast<const bf16x8*>(Ks + KSWZ(32 + r32, cb));
    p0 = __builtin_amdgcn_mfma_f32_32x32x16_bf16(b0, qr[d0], p0, 0, 0, 0);
    p1 = __builtin_amdgcn_mfma_f32_32x32x16_bf16(b1, qr[d0], p1, 0, 0, 0); }
#pragma unroll
  for (int d0 = 0; d0 < 4; ++d0) { const int cb = (d0 * 16 + hi * 8) * 2;
    const bf16x8 b0 = *reinterpret_cast<const bf16x8*>(Rs + RSWZ(r32, cb));
    const bf16x8 b1 = *reinterpret_cast<const bf16x8*>(Rs + RSWZ(32 + r32, cb));
    const bf16x8 qf = *reinterpret_cast<const bf16x8*>(qrow + (cb ^ qsw));
    p0 = __builtin_amdgcn_mfma_f32_32x32x16_bf16(b0, qf, p0, 0, 0, 0);
    p1 = __builtin_amdgcn_mfma_f32_32x32x16_bf16(b1, qf, p1, 0, 0, 0); }
}
__device__ __forceinline__ int v_st(int k, int c) { const int kk = (k & ~0xC) | ((k & 4) << 1) | ((k & 8) >> 1); return ((kk >> 3) * 4 + (c >> 5)) * 512 + ((kk & 7) * 32 + (c & 31)) * 2; }
__device__ __forceinline__ int v_rd_base(int lane) { return ((lane & 3) << 3) | (((lane >> 2) & 3) << 6) | (((lane >> 4) & 1) << 5) | (((lane >> 5) & 1) << 8); }
constexpr int v_rd_off(int d0, int ks, int half) { return d0 * 512 + ks * 4096 + half * 2048; }
template <int OFF> __device__ __forceinline__ s16x4 tr_read(int vb) { s16x4 r; asm volatile("ds_read_b64_tr_b16 %0, %1 offset:%2" : "=&v"(r) : "v"(vb), "i"(OFF) : "memory"); return r; }
template <int D0> __device__ __forceinline__ void pv_one(f32x16& od, int vb, bf16x8 pa0, bf16x8 pa1, bf16x8 pa2, bf16x8 pa3) {
  const s16x4 l0 = tr_read<v_rd_off(D0, 0, 0)>(vb), h0 = tr_read<v_rd_off(D0, 0, 1)>(vb), l1 = tr_read<v_rd_off(D0, 1, 0)>(vb), h1 = tr_read<v_rd_off(D0, 1, 1)>(vb);
  const s16x4 l2 = tr_read<v_rd_off(D0, 2, 0)>(vb), h2 = tr_read<v_rd_off(D0, 2, 1)>(vb), l3 = tr_read<v_rd_off(D0, 3, 0)>(vb), h3 = tr_read<v_rd_off(D0, 3, 1)>(vb);
  asm volatile("s_waitcnt lgkmcnt(0)" ::: "memory"); SBAR();
#define PK(L, H) (bf16x8){L[0], L[1], L[2], L[3], H[0], H[1], H[2], H[3]}
  od = __builtin_amdgcn_mfma_f32_32x32x16_bf16(pa0, PK(l0, h0), od, 0, 0, 0);
  od = __builtin_amdgcn_mfma_f32_32x32x16_bf16(pa1, PK(l1, h1), od, 0, 0, 0);
  od = __builtin_amdgcn_mfma_f32_32x32x16_bf16(pa2, PK(l2, h2), od, 0, 0, 0);
  od = __builtin_amdgcn_mfma_f32_32x32x16_bf16(pa3, PK(l3, h3), od, 0, 0, 0);
#undef PK
}
__device__ __forceinline__ void pv_d0(f32x16* o, int vb, bf16x8 pa0, bf16x8 pa1, bf16x8 pa2, bf16x8 pa3) {
  pv_one<0>(o[0], vb, pa0, pa1, pa2, pa3); pv_one<1>(o[1], vb, pa0, pa1, pa2, pa3); pv_one<2>(o[2], vb, pa0, pa1, pa2, pa3); pv_one<3>(o[3], vb, pa0, pa1, pa2, pa3);
}
template <bool PARTIAL = false> __device__ __forceinline__ void attn_body(const bf16_t* __restrict__ Qb, const bf16_t* __restrict__ Kh, const bf16_t* __restrict__ Rh, const bf16_t* __restrict__ Vh,
                                          bf16_t* __restrict__ Ob, int seq, char* lds, float* __restrict__ PO = nullptr, float* __restrict__ PML = nullptr) {
  const int tid = TIDX, wid = tid >> 6, lane = tid & 63, r32 = lane & 31, hi = lane >> 5;
  char* V_lds = lds + OFF_V; char* K_lds = lds + OFF_K; char* R_lds = lds + OFF_R;
  float* ws = (float*)(lds + OFF_WS) + wid * 64; float* li_l = ws; float* al_l = ws + 32;
  float m_reg = -1e30f, l_reg = 0; f32x16 o[4] = {}; bf16x8 qr[8];
  const bf16_t* Qw = Qb + (size_t)(wid * QBLK + r32) * 768 + hi * 8;
#pragma unroll
  for (int d0 = 0; d0 < 8; ++d0) qr[d0] = *reinterpret_cast<const bf16x8*>(Qw + d0 * 16);
  const int qrowi = wid * QBLK + r32; char* qrow = lds + OFF_Q + qrowi * 128; const int qsw = ((qrowi >> 1) & 7) << 4;
#pragma unroll
  for (int d0 = 0; d0 < 4; ++d0) *reinterpret_cast<bf16x8*>(qrow + (((d0 * 16 + hi * 8) * 2) ^ qsw)) = *reinterpret_cast<const bf16x8*>(Qw + (8 + d0) * 16);
  const int sr = tid >> 4, sc = (tid & 15) * 8, vst0 = v_st(sr, sc), vst1 = v_st(32 + sr, sc);
  const int rr = tid >> 3, rc = (tid & 7) * 8;
  const int vb0 = (int)(uintptr_t)V_lds + v_rd_base(lane);
  bf16x8 vs0, vs1, ks0, ks1, rs0;
  const unsigned kvo0 = (unsigned)(sr * 512 + sc) * 2u, kvo1 = kvo0 + 32u * 512u * 2u, ro0 = (unsigned)(rr * 64 + rc) * 2u;
#define SLOAD(k0) do { const char* Vt = (const char*)Vh + (size_t)(k0) * 1024; const char* Kt = (const char*)Kh + (size_t)(k0) * 1024; const char* Rt = (const char*)Rh + (size_t)(k0) * 128; \
    vs0 = *(const bf16x8*)(Vt + kvo0); vs1 = *(const bf16x8*)(Vt + kvo1); ks0 = *(const bf16x8*)(Kt + kvo0); ks1 = *(const bf16x8*)(Kt + kvo1); rs0 = *(const bf16x8*)(Rt + ro0); } while (0)
#define SWRITE(b) do { *(bf16x8*)(V_lds + (b) * SHM_V + vst0) = vs0; *(bf16x8*)(V_lds + (b) * SHM_V + vst1) = vs1; const int kc = sc * 2; \
    *(bf16x8*)(K_lds + (b) * SHM_K + KSWZ(sr, kc)) = ks0; *(bf16x8*)(K_lds + (b) * SHM_K + KSWZ(32 + sr, kc)) = ks1; \
    *(bf16x8*)(R_lds + (b) * SHM_R + RSWZ(rr, rc * 2)) = rs0; } while (0)
#define SWAIT() asm volatile("s_waitcnt vmcnt(0)" ::: "memory")
#define RESC(a) do { if (__any((a) < 1.f)) { if (hi == 0) al_l[r32] = (a); asm volatile("s_waitcnt lgkmcnt(0)" ::: "memory"); \
    _Pragma("unroll") for (int d = 0; d < 4; ++d) _Pragma("unroll") for (int r = 0; r < 16; ++r) o[d][r] *= al_l[crow(r, hi)]; } } while (0)
  f32x16 pA0, pA1, pB0, pB1; float mnA, mnB, alA, alB; bf16x8 pa0, pa1, pa2, pa3; const int NT = seq / KVBLK;
  SLOAD(0); SWAIT(); SWRITE(0); __syncthreads();
  qkt(pA0, pA1, K_lds, R_lds, qr, qrow, qsw, r32, hi); partialSM(pA0, pA1, m_reg, mnA, alA);
  SLOAD(KVBLK);
  SWAIT(); SWRITE(1); __syncthreads();
  for (int j = 1; j + 1 < NT; j += 2) {
    SBAR(); qkt(pB0, pB1, K_lds + SHM_K, R_lds + SHM_R, qr, qrow, qsw, r32, hi);
    finishSM(pA0, pA1, alA, l_reg, pa0, pa1, pa2, pa3); SBAR();
    SLOAD((j + 1) * KVBLK); SBAR();
    pv_d0(o, vb0, pa0, pa1, pa2, pa3); partialSM(pB0, pB1, m_reg, mnB, alB);
    __syncthreads(); SWAIT(); SWRITE(0);
    RESC(alB); __syncthreads();
    SBAR(); qkt(pA0, pA1, K_lds, R_lds, qr, qrow, qsw, r32, hi);
    finishSM(pB0, pB1, alB, l_reg, pa0, pa1, pa2, pa3); SBAR();
    SLOAD((j + 2) * KVBLK); SBAR();
    pv_d0(o, vb0 + SHM_V, pa0, pa1, pa2, pa3); partialSM(pA0, pA1, m_reg, mnA, alA);
    __syncthreads(); SWAIT(); SWRITE(1);
    RESC(alA); __syncthreads();
  }
  SBAR(); qkt(pB0, pB1, K_lds + SHM_K, R_lds + SHM_R, qr, qrow, qsw, r32, hi);
  finishSM(pA0, pA1, alA, l_reg, pa0, pa1, pa2, pa3); SBAR();
  pv_d0(o, vb0, pa0, pa1, pa2, pa3); partialSM(pB0, pB1, m_reg, mnB, alB);
  __syncthreads(); RESC(alB);
  finishSM(pB0, pB1, alB, l_reg, pa0, pa1, pa2, pa3); SBAR();
  pv_d0(o, vb0 + SHM_V, pa0, pa1, pa2, pa3);
  if (PARTIAL) { int tz = TIDX; const int wz = tz >> 6, lz = tz & 63;
    if ((lz >> 5) == 0) { PML[wz * QBLK + lz] = m_reg; PML[256 + wz * QBLK + lz] = l_reg; }
    float* po = PO + (size_t)(wz * QBLK + 4 * (lz >> 5)) * 128 + (lz & 31);
#pragma unroll
    for (int r = 0; r < 16; ++r)
#pragma unroll
      for (int d0 = 0; d0 < 4; ++d0) po[((r & 3) + 8 * (r >> 2)) * 128 + d0 * 32] = o[d0][r];
    __syncthreads(); return; }
  if (hi == 0) li_l[r32] = l_reg; asm volatile("s_waitcnt lgkmcnt(0)" ::: "memory");
  float rli[16];
#pragma unroll
  for (int r = 0; r < 16; ++r) rli[r] = __builtin_amdgcn_rcpf(li_l[crow(r, hi)]);
  { int tz = TIDX; const int wz = tz >> 6, lz = tz & 63; const unsigned ob = (unsigned)((wz * QBLK + 4 * (lz >> 5)) * 512 + (lz & 31)) * 2u;
#pragma unroll
    for (int r = 0; r < 16; ++r) {
#pragma unroll
      for (int d0 = 0; d0 < 4; ++d0) { unsigned u = __float_as_uint(o[d0][r] * rli[r]); u += 0x7fffu + ((u >> 16) & 1u);
        *(bf16_t*)((char*)Ob + ob + (unsigned)((((r & 3) + 8 * (r >> 2)) * 512 + d0 * 32) * 2)) = (bf16_t)(u >> 16); } } }
  __syncthreads();
#undef SLOAD
#undef SWRITE
#undef SWAIT
#undef RESC
}
}

constexpr int ATT_NSPLIT = 64, ATT_NPART = 3;
__device__ __forceinline__ float* att_po(const FP& p, int j) { return (float*)p.SCR + (size_t)j * 32768; }
__device__ __forceinline__ float* att_pml(const FP& p, int j) { return (float*)p.SCR + (size_t)ATT_NSPLIT * ATT_NPART * 32768 + (size_t)j * 512; }
__device__ void ph_attn(const FP& p, int l, char* shm) {
  const int nctx = (l == DEPTH - 1) ? 0 : NB * 4;
  const int G = gridDim.x, me = (int)blockIdx.x - 64, nb = G - 64; if (me < 0) return;
  for (int u = 64 + me; u < NB * 4 * 16; u += nb) { const int b = u >> 6, h = (u >> 4) & 3, qoff = CTX + (u & 15) * 256; const size_t r0 = (size_t)b * SB, q0 = r0 + qoff;
    att::attn_body<false>(p.Qb + q0 * 768 + h * 192, p.Knb + r0 * 512 + h * 128, p.KRb + r0 * 64, p.Vb + r0 * 512 + h * 128, p.AOb + q0 * 512 + h * 128, SB, shm); }
  for (int j = me; j < ATT_NSPLIT * ATT_NPART; j += nb) { const int u = j / ATT_NPART, part = j % ATT_NPART, h = (u >> 4) & 3, qoff = CTX + (u & 15) * 256; const size_t q0 = qoff;
    const int k0 = part == 0 ? 0 : 1536 + (part - 1) * 1408, len = part == 0 ? 1536 : 1408;
    att::attn_body<true>(p.Qb + q0 * 768 + h * 192, p.Knb + (size_t)k0 * 512 + h * 128, p.KRb + (size_t)k0 * 64, p.Vb + (size_t)k0 * 512 + h * 128, nullptr, len, shm, att_po(p, j), att_pml(p, j)); }
  for (int uu = me; uu < nctx; uu += nb) { const int b = uu >> 2, h = uu & 3; const size_t r0 = (size_t)b * SB;
    att::attn_body<false>(p.Qb + r0 * 768 + h * 192, p.Knb + r0 * 512 + h * 128, p.KRb + r0 * 64, p.Vb + r0 * 512 + h * 128, p.AOb + r0 * 512 + h * 128, CTX, shm); }
}

__device__ __forceinline__ void mla_out_row(const FP& p, int l, int row, int lane) {
  float x[8]; float ss = 0.f;
  if (row >= CTX && row < CTX + ATT_NSPLIT * 64) {
    const int tok = row - CTX, u = (lane >> 4) * 16 + (tok >> 8), qr = tok & 255; float m[ATT_NPART], lsum[ATT_NPART], M = -3.0e38f;
#pragma unroll
    for (int j = 0; j < ATT_NPART; ++j) { const float* ml = att_pml(p, u * ATT_NPART + j); m[j] = ml[qr]; lsum[j] = ml[256 + qr]; M = fmaxf(M, m[j]); }
    float L = 0.f;
#pragma unroll
    for (int e = 0; e < 8; ++e) x[e] = 0.f;
#pragma unroll
    for (int j = 0; j < ATT_NPART; ++j) { const float wj = __builtin_amdgcn_exp2f(m[j] - M); L += wj * lsum[j]; const float* po = att_po(p, u * ATT_NPART + j) + (size_t)qr * 128 + (lane & 15) * 8;
      const f32x4 a = *(const f32x4*)po, b2 = *(const f32x4*)(po + 4);
      x[0] += wj * a[0]; x[1] += wj * a[1]; x[2] += wj * a[2]; x[3] += wj * a[3]; x[4] += wj * b2[0]; x[5] += wj * b2[1]; x[6] += wj * b2[2]; x[7] += wj * b2[3]; }
    const float rl = 1.f / L;
#pragma unroll
    for (int e = 0; e < 8; ++e) x[e] = bf2f(f2bf(x[e] * rl));
  } else { const u32x4 v = *(const u32x4*)(p.AOb + (size_t)row * 512 + lane * 8);
    x[0] = bflo(v.x); x[1] = bfhi(v.x); x[2] = bflo(v.y); x[3] = bfhi(v.y); x[4] = bflo(v.z); x[5] = bfhi(v.z); x[6] = bflo(v.w); x[7] = bfhi(v.w); }
#pragma unroll
  for (int j = 0; j < 8; ++j) ss += x[j] * x[j];
  ss = wave_sum(ss); const float rs = rsqrtf(ss * (1.f / 512.f) + 1e-6f);
  const f32x4 g0 = *(const f32x4*)(p.g_mla + l * 512 + lane * 8), g1 = *(const f32x4*)(p.g_mla + l * 512 + lane * 8 + 4);
  u32x4 w; w.x = cvt_pk_bf16(x[0] * rs * g0[0], x[1] * rs * g0[1]); w.y = cvt_pk_bf16(x[2] * rs * g0[2], x[3] * rs * g0[3]);
  w.z = cvt_pk_bf16(x[4] * rs * g1[0], x[5] * rs * g1[1]); w.w = cvt_pk_bf16(x[6] * rs * g1[2], x[7] * rs * g1[3]);
  *(u32x4*)(p.CATb + (size_t)row * 1536 + lane * 8) = w;
}
constexpr int NCH = SB / 64;
__device__ __forceinline__ int item_idx(int dir, int bh, int cn) { return (dir * 16 + bh) * NCH + cn; }
__device__ __forceinline__ int scan_chunk(int dir, int n) { return dir == 0 ? n : (n < 4 ? 3 - n : 71 - n); }

__device__ __forceinline__ void prep_ret_row(const FP& p, int row, int lane) {
  const int s = row % SB; const bool lat = s >= CTX; const int tok = s - CTX;
  const bf16_t* pr = p.Pb + (size_t)row * INWP;
  const u32x4 qv = *(const u32x4*)(pr + C_RQ + lane * 8), kv = *(const u32x4*)(pr + C_RK + lane * 8);
  float q[8] = {bflo(qv.x), bfhi(qv.x), bflo(qv.y), bfhi(qv.y), bflo(qv.z), bfhi(qv.z), bflo(qv.w), bfhi(qv.w)};
  float k[8] = {bflo(kv.x), bfhi(kv.x), bflo(kv.y), bfhi(kv.y), bflo(kv.z), bfhi(kv.z), bflo(kv.w), bfhi(kv.w)};
  float qo[8], ko[8];
  const bool lowh = (lane & 4) == 0;
  const float pos = (float)(((lane >> 3) & 1) == 0 ? (tok >> 6) : (tok & 63));
#pragma unroll
  for (int e = 0; e < 8; ++e) { const float qp = shx(q[e], 4), kp = shx(k[e], 4);
    if (lat) { const int fi = (lane & 3) * 8 + e; const float ang = pos * __expf(-(float)fi * (9.210340371976184f / 32.f)); const float cs = __cosf(ang), sn = __sinf(ang);
      qo[e] = lowh ? q[e] * cs - qp * sn : q[e] * cs + qp * sn; ko[e] = lowh ? k[e] * cs - kp * sn : k[e] * cs + kp * sn; }
    else { qo[e] = q[e]; ko[e] = k[e]; } }
  const float sc = 0.08838834764831845f;
  u32x4 wq, wk; wq.x = cvt_pk_bf16(qo[0], qo[1]); wq.y = cvt_pk_bf16(qo[2], qo[3]); wq.z = cvt_pk_bf16(qo[4], qo[5]); wq.w = cvt_pk_bf16(qo[6], qo[7]);
  wk.x = cvt_pk_bf16(ko[0] * sc, ko[1] * sc); wk.y = cvt_pk_bf16(ko[2] * sc, ko[3] * sc); wk.z = cvt_pk_bf16(ko[4] * sc, ko[5] * sc); wk.w = cvt_pk_bf16(ko[6] * sc, ko[7] * sc);
  *(u32x4*)(p.RQb + (size_t)row * 512 + lane * 8) = wq; *(u32x4*)(p.RKb + (size_t)row * 512 + lane * 8) = wk;
}

__device__ __forceinline__ void r2_item(const FP& p, int l, int bh, int cn, int t, LAS unsigned char* hl) {
  const int b = bh >> 2, h = bh & 3; const size_t row0 = (size_t)b * SB + cn * 64;
  LAS bf16_t* sk = (LAS bf16_t*)hl; LAS bf16_t* sv = sk + 64 * 136;
#pragma unroll
  for (int i = 0; i < 4; ++i) { const int idx = t + 256 * i, r = idx >> 4, c8 = (idx & 15) * 8;
    *(LAS u32x4*)(sk + r * 136 + c8) = *(const u32x4*)(p.RKb + (row0 + r) * 512 + h * 128 + c8);
    *(LAS u32x4*)(sv + r * 136 + c8) = *(const u32x4*)(p.Pb + (row0 + r) * INWP + C_RV + h * 128 + c8); }
  __syncthreads();
  const float lgf = __log2f(1.f - __expf(p.ret_decay[l * 8 + h])), lgb = __log2f(1.f - __expf(p.ret_decay[l * 8 + 4 + h]));
#pragma unroll
  for (int q = 0; q < 4; ++q) { const int sidx = t + 256 * q, f = sidx >> 6, ln = sidx & 63, tt = f >> 2, s = f & 3, c = tt * 32 + (ln & 31), hh = ln >> 5;
    { float kf[8];
#pragma unroll
      for (int jj = 0; jj < 8; ++jj) kf[jj] = bf2f(sk[(16 * s + 8 * hh + jj) * 136 + c]);
      u32x4 wf, wb; unsigned tmpf[4], tmpb[4];
#pragma unroll
      for (int jp = 0; jp < 4; ++jp) { const int j0 = 16 * s + 8 * hh + 2 * jp;
        tmpf[jp] = cvt_pk_bf16(kf[2 * jp] * exp2f(lgf * (float)(63 - j0)), kf[2 * jp + 1] * exp2f(lgf * (float)(62 - j0)));
        tmpb[jp] = cvt_pk_bf16(kf[2 * jp] * exp2f(lgb * (float)j0), kf[2 * jp + 1] * exp2f(lgb * (float)(j0 + 1))); }
      wf.x = tmpf[0]; wf.y = tmpf[1]; wf.z = tmpf[2]; wf.w = tmpf[3]; wb.x = tmpb[0]; wb.y = tmpb[1]; wb.z = tmpb[2]; wb.w = tmpb[3];
      *(u32x4*)(p.RKWT + (size_t)item_idx(0, bh, cn) * 8192 + sidx * 8) = wf; *(u32x4*)(p.RKWT + (size_t)item_idx(1, bh, cn) * 8192 + sidx * 8) = wb; }
    { unsigned short vb[8], va[8];
#pragma unroll
      for (int jj = 0; jj < 8; ++jj) { vb[jj] = sv[(16 * s + 8 * hh + jj) * 136 + c]; va[jj] = sv[(16 * s + 8 * (jj >> 2) + 4 * hh + (jj & 3)) * 136 + c]; }
      u32x4 wb2, wa2; wb2.x = vb[0] | ((unsigned)vb[1] << 16); wb2.y = vb[2] | ((unsigned)vb[3] << 16); wb2.z = vb[4] | ((unsigned)vb[5] << 16); wb2.w = vb[6] | ((unsigned)vb[7] << 16);
      wa2.x = va[0] | ((unsigned)va[1] << 16); wa2.y = va[2] | ((unsigned)va[3] << 16); wa2.z = va[4] | ((unsigned)va[5] << 16); wa2.w = va[6] | ((unsigned)va[7] << 16);
      *(u32x4*)(p.RVTB + ((size_t)bh * NCH + cn) * 8192 + sidx * 8) = wb2; *(u32x4*)(p.RVTA + ((size_t)bh * NCH + cn) * 8192 + sidx * 8) = wa2; } }
  __syncthreads();
}

__device__ void ret_scan_job(const FP& p, int l, int bh, int dir, LAS unsigned char* lds) {
  const int t = TIDX, wid = __builtin_amdgcn_readfirstlane(t >> 6), lane = t & 63, hi = lane >> 5;
  const int h = bh & 3; const float lg = __log2f(1.f - __expf(p.ret_decay[l * 8 + dir * 4 + h])); const float g64 = exp2f(lg * 64.f);
  f32x16 S[4];
#pragma unroll
  for (int d = 0; d < 4; ++d)
#pragma unroll
    for (int r = 0; r < 16; ++r) S[d][r] = 0.f;
#define RS_STAGE(cn, buf) do { const char* ga = (const char*)(p.RKWT + (size_t)item_idx(dir, bh, (cn)) * 8192) + (wid - 4) * 1024 + lane * 16; const char* gb = (const char*)(p.RVTB + ((size_t)bh * NCH + (cn)) * 8192) + (wid - 4) * 1024 + lane * 16; \
    LAS unsigned char* lb = lds + (buf) * 32768 + (wid - 4) * 1024; \
    _Pragma("unroll") for (int q_ = 0; q_ < 4; ++q_) { __builtin_amdgcn_global_load_lds((const unsigned*)(ga + q_ * 4096), (LAS unsigned*)(lb + q_ * 4096), 16, 0, 0); \
      __builtin_amdgcn_global_load_lds((const unsigned*)(gb + q_ * 4096), (LAS unsigned*)(lb + 16384 + q_ * 4096), 16, 0, 0); } } while (0)
  __syncthreads();
  if (wid >= 4) { RS_STAGE(scan_chunk(dir, 0), 0); RS_STAGE(scan_chunk(dir, 1), 1); }
  for (int n = 0; n < NCH; ++n) { const int cn = scan_chunk(dir, n), buf = n % 3;
    if (wid >= 4) { if (n + 1 < NCH) asm volatile("s_waitcnt vmcnt(8)" ::: "memory"); else asm volatile("s_waitcnt vmcnt(0)" ::: "memory"); }
    __builtin_amdgcn_s_barrier(); asm volatile("" ::: "memory");
    if (wid >= 4) { if (n + 2 < NCH) RS_STAGE(scan_chunk(dir, n + 2), (n + 2) % 3); }
    if (wid < 4) {
      asm volatile("s_nop 9\n\ts_nop 9" : "+v"(S[3]), "+v"(S[2]), "+v"(S[1]), "+v"(S[0]));
      bf16_t* st = p.RST + (size_t)item_idx(dir, bh, cn) * 16384;
#pragma unroll
      for (int dt = 0; dt < 4; ++dt)
#pragma unroll
        for (int g = 0; g < 4; ++g) { u32x2 w; w.x = cvt_pk_bf16(S[dt][4 * g], S[dt][4 * g + 1]); w.y = cvt_pk_bf16(S[dt][4 * g + 2], S[dt][4 * g + 3]);
          *(u32x2*)(st + ((wid * 8 + 2 * dt + (g >> 1)) * 64 + (lane & 31) + 32 * (g & 1)) * 8 + 4 * hi) = w; }
#pragma unroll
      for (int dt = 0; dt < 4; ++dt)
#pragma unroll
        for (int r = 0; r < 16; ++r) S[dt][r] *= g64;
      const LAS unsigned char* bb = lds + buf * 32768;
      bf16x8 af[4][4], bfr[4];
#pragma unroll
      for (int s = 0; s < 4; ++s) bfr[s] = *(const LAS bf16x8*)(bb + 16384 + (wid * 4 + s) * 1024 + lane * 16);
#pragma unroll
      for (int dt = 0; dt < 4; ++dt)
#pragma unroll
        for (int s = 0; s < 4; ++s) af[dt][s] = *(const LAS bf16x8*)(bb + (dt * 4 + s) * 1024 + lane * 16);
#pragma unroll
      for (int s = 0; s < 4; ++s)
#pragma unroll
        for (int dt = 0; dt < 4; ++dt) S[dt] = __builtin_amdgcn_mfma_f32_32x32x16_bf16(af[dt][s], bfr[s], S[dt], 0, 0, 0);
    }
  }
  asm volatile("s_waitcnt vmcnt(0)" ::: "memory"); __syncthreads();
#undef RS_STAGE
}

__device__ __forceinline__ bf16x8 pack8(float a0, float a1, float a2, float a3, float a4, float a5, float a6, float a7) {
  u32x4 pk;
  asm volatile("v_cvt_pk_bf16_f32 %0, %4, %5\n\tv_cvt_pk_bf16_f32 %1, %6, %7\n\tv_cvt_pk_bf16_f32 %2, %8, %9\n\tv_cvt_pk_bf16_f32 %3, %10, %11\n\ts_nop 1"
               : "=&v"(pk[0]), "=&v"(pk[1]), "=&v"(pk[2]), "=&v"(pk[3]) : "v"(a0), "v"(a1), "v"(a2), "v"(a3), "v"(a4), "v"(a5), "v"(a6), "v"(a7));
  return __builtin_bit_cast(bf16x8, pk);
}
__device__ __forceinline__ bf16x8 pack_step(const f32x16& x, int s) { return pack8(x[8 * s], x[8 * s + 1], x[8 * s + 2], x[8 * s + 3], x[8 * s + 4], x[8 * s + 5], x[8 * s + 6], x[8 * s + 7]); }
__device__ __forceinline__ bf16x8 scale_frag(bf16x8 a, float f) {
  const u32x4 v = __builtin_bit_cast(u32x4, a);
  return pack8(bflo(v.x) * f, bfhi(v.x) * f, bflo(v.y) * f, bfhi(v.y) * f, bflo(v.z) * f, bfhi(v.z) * f, bflo(v.w) * f, bfhi(v.w) * f);
}

__device__ void ret_out_unit(const FP& p, int l, int bh, int cn, int ih, int lane) {
  const int b = bh >> 2, h = bh & 3, c32 = lane & 31, hi = lane >> 5; const size_t row0 = (size_t)b * SB + cn * 64; const int ipos = 32 * ih + c32;
  const float lgf = __log2f(1.f - __expf(p.ret_decay[l * 8 + h])), lgb = __log2f(1.f - __expf(p.ret_decay[l * 8 + 4 + h]));
  const unsigned lo16 = (unsigned)lane * 16u;
  f32x16 P0, P1;
#pragma unroll
  for (int r = 0; r < 16; ++r) { P0[r] = 0.f; P1[r] = 0.f; }
  const char* qb = (const char*)(p.RQb + (row0 + 32 * ih) * 512 + h * 128); const char* kb = (const char*)(p.RKb + row0 * 512 + h * 128);
  const unsigned rowoff = (unsigned)(c32 * 512 + 8 * hi) * 2u;
#pragma unroll 1
  for (int s = 0; s < 8; ++s) { const bf16x8 qf = *(const bf16x8*)(qb + rowoff + s * 32); const bf16x8 k0 = *(const bf16x8*)(kb + rowoff + s * 32), k1 = *(const bf16x8*)(kb + 32 * 1024 + rowoff + s * 32);
    P0 = __builtin_amdgcn_mfma_f32_32x32x16_bf16(k0, qf, P0, 0, 0, 0); P1 = __builtin_amdgcn_mfma_f32_32x32x16_bf16(k1, qf, P1, 0, 0, 0); }
  bf16x8 pb[2][2][2];
#pragma unroll
  for (int dir = 0; dir < 2; ++dir) { const float lg = dir == 0 ? lgf : lgb;
#pragma unroll
    for (int jt = 0; jt < 2; ++jt) { f32x16 pd;
#pragma unroll
      for (int r = 0; r < 16; ++r) { const int j = 32 * jt + crow16(r, hi); const int dlt = dir == 0 ? ipos - j : j - ipos; const float pv = jt == 0 ? P0[r] : P1[r]; pd[r] = dlt >= 0 ? pv * exp2f(lg * (float)dlt) : 0.f; }
      pb[dir][jt][0] = pack_step(pd, 0); pb[dir][jt][1] = pack_step(pd, 1); } }
  __builtin_amdgcn_sched_barrier(0);
  f32x16 O[4];
  const char* va = (const char*)(p.RVTA + ((size_t)bh * NCH + cn) * 8192);
#pragma unroll
  for (int et = 0; et < 4; ++et) { f32x16 a;
#pragma unroll
    for (int r = 0; r < 16; ++r) a[r] = 0.f;
    const char* vae = va + et * 4096;
#pragma unroll
    for (int jt = 0; jt < 2; ++jt)
#pragma unroll
      for (int ss = 0; ss < 2; ++ss) { const bf16x8 af = *(const bf16x8*)(vae + lo16 + (2 * jt + ss) * 1024);
        a = __builtin_amdgcn_mfma_f32_32x32x16_bf16(af, pb[0][jt][ss], a, 0, 0, 0); a = __builtin_amdgcn_mfma_f32_32x32x16_bf16(af, pb[1][jt][ss], a, 0, 0, 0); }
    O[et] = a; __builtin_amdgcn_sched_barrier(0); }
  const float facf = exp2f(lgf * (float)(ipos + 1)), facb = exp2f(lgb * (float)(64 - ipos));
  const char* stf = (const char*)(p.RST + (size_t)item_idx(0, bh, cn) * 16384); const char* stb = (const char*)(p.RST + (size_t)item_idx(1, bh, cn) * 16384);
#pragma unroll 1
  for (int s = 0; s < 8; ++s) { const bf16x8 qf = *(const bf16x8*)(qb + rowoff + s * 32); const bf16x8 qsf = scale_frag(qf, facf), qsb = scale_frag(qf, facb);
#pragma unroll
    for (int et = 0; et < 4; ++et) { const bf16x8 af = *(const bf16x8*)(stf + et * 8192 + s * 1024 + lo16), ab = *(const bf16x8*)(stb + et * 8192 + s * 1024 + lo16);
      O[et] = __builtin_amdgcn_mfma_f32_32x32x16_bf16(af, qsf, O[et], 0, 0, 0); O[et] = __builtin_amdgcn_mfma_f32_32x32x16_bf16(ab, qsb, O[et], 0, 0, 0); } }
  float sm = 0.f;
#pragma unroll
  for (int et = 0; et < 4; ++et)
#pragma unroll
    for (int r = 0; r < 16; ++r) sm += O[et][r];
  sm += shx(sm, 32); const float mu = sm * (1.f / 128.f); float vq = 0.f;
#pragma unroll
  for (int et = 0; et < 4; ++et)
#pragma unroll
    for (int r = 0; r < 16; ++r) { const float dd = O[et][r] - mu; vq += dd * dd; }
  vq += shx(vq, 32); const float rs = rsqrtf(vq * (1.f / 128.f) + 1e-5f);
  const size_t row = row0 + ipos; const bf16_t* gp = p.Pb + row * INWP + C_RG + h * 128; const float* gr = p.g_ret + l * 512 + h * 128; bf16_t* op = p.CATb + row * 1536 + 512 + h * 128;
#pragma unroll
  for (int et = 0; et < 4; ++et)
#pragma unroll
    for (int g = 0; g < 4; ++g) { const int e0 = 32 * et + 8 * g + 4 * hi; const u32x2 gz = *(const u32x2*)(gp + e0); const f32x4 gg = *(const f32x4*)(gr + e0);
      const float z[4] = {bflo(gz.x), bfhi(gz.x), bflo(gz.y), bfhi(gz.y)}; float y[4];
#pragma unroll
      for (int j = 0; j < 4; ++j) y[j] = (O[et][4 * g + j] - mu) * rs * gg[j] * silu_f(z[j]);
      u32x2 w; w.x = cvt_pk_bf16(y[0], y[1]); w.y = cvt_pk_bf16(y[2], y[3]); *(u32x2*)(op + e0) = w; }
}
#define N2SWZ(r, c) ((r) * 2048 + ((((c) & ~15) | (((c) ^ (r)) & 15)) << 4))
__device__ void ph_norm2m(const FP& p, int l, LAS unsigned char* lds) {
  const int t = TIDX, wid = t >> 6, lane = t & 63, c32 = lane & 31, hi = lane >> 5;
  const float* MODl = p.MOD + (size_t)l * 5 * 6144; const float* g2 = p.g_norm2 + l * D; int* cntl = p.cnt + l * 32;
  LAS float* lgt = (LAS float*)(lds + 131072);
  const bf16_t* wf = p.WRF + (size_t)l * 2 * 64 * 512;
  __syncthreads();
  for (int tile = blockIdx.x; tile < T / 32; tile += gridDim.x) { const int trow0 = tile * 32; const int b = trow0 / SB, s0 = trow0 % SB, rmod = s0 < CTX ? 4 : b;
    const bool routed = !(l == DEPTH - 1 && s0 < CTX);
    bf16x8 bh[8], bl[8];
#pragma unroll
    for (int q = 0; q < 8; ++q) { bh[q] = *(const bf16x8*)(wf + ((size_t)(wid * 8 + q) * 64 + lane) * 8); bl[q] = *(const bf16x8*)(wf + ((size_t)(64 + wid * 8 + q) * 64 + lane) * 8); }
    f32x4 x[4][4];
#pragma unroll
    for (int q = 0; q < 4; ++q)
#pragma unroll
      for (int i = 0; i < 4; ++i) x[q][i] = *(const f32x4*)(p.X + (size_t)(trow0 + wid * 4 + q) * D + i * 256 + lane * 4);
    const float* m = MODl + (size_t)rmod * 6144;
#pragma unroll
    for (int q = 0; q < 4; ++q) { const int r = wid * 4 + q, row = trow0 + r; float ss = 0.f;
#pragma unroll
      for (int i = 0; i < 4; ++i) ss += x[q][i][0] * x[q][i][0] + x[q][i][1] * x[q][i][1] + x[q][i][2] * x[q][i][2] + x[q][i][3] * x[q][i][3];
      ss = wave_sum(ss); const float rs = rsqrtf(ss * (1.f / 1024.f) + 1e-6f);
#pragma unroll
      for (int i = 0; i < 4; ++i) { const int c = i * 256 + lane * 4; const f32x4 g = *(const f32x4*)(g2 + c), sc = *(const f32x4*)(m + 4096 + c), sh = *(const f32x4*)(m + 3072 + c);
        const f32x4 h = x[q][i] * rs * g * (sc + 1.f) + sh;
        u32x2 whi; whi.x = cvt_pk_bf16(h[0], h[1]); whi.y = cvt_pk_bf16(h[2], h[3]);
        const f32x4 res = (f32x4){h[0] - bflo(whi.x), h[1] - bfhi(whi.x), h[2] - bflo(whi.y), h[3] - bfhi(whi.y)};
        u32x2 wlo; wlo.x = cvt_pk_bf16(res[0], res[1]); wlo.y = cvt_pk_bf16(res[2], res[3]);
        if (routed) *(u32x2*)(p.H2b + (size_t)row * D + c) = whi;
        const int ch = i * 32 + (lane >> 1); const int off = N2SWZ(r, ch) + (lane & 1) * 8;
        *(LAS u32x2*)(lds + off) = whi; *(LAS u32x2*)(lds + 65536 + off) = wlo; } }
    __syncthreads();
    f32x16 acc;
#pragma unroll
    for (int r = 0; r < 16; ++r) acc[r] = 0.f;
#pragma unroll
    for (int q = 0; q < 8; ++q) { const int ch = 2 * (wid * 8 + q) + hi; const bf16x8 ah = *(const LAS bf16x8*)(lds + N2SWZ(c32, ch)), al = *(const LAS bf16x8*)(lds + 65536 + N2SWZ(c32, ch));
      acc = __builtin_amdgcn_mfma_f32_32x32x16_bf16(ah, bh[q], acc, 0, 0, 0); acc = __builtin_amdgcn_mfma_f32_32x32x16_bf16(al, bh[q], acc, 0, 0, 0); acc = __builtin_amdgcn_mfma_f32_32x32x16_bf16(ah, bl[q], acc, 0, 0, 0); }
    __syncthreads();
    { LAS float* part = (LAS float*)lds + wid * 1024;
#pragma unroll
      for (int r = 0; r < 16; ++r) part[crow16(r, hi) * 32 + c32] = acc[r]; }
    __syncthreads();
    { const int r = t >> 4, e2 = (t & 15) * 2; float s0_ = 0.f, s1_ = 0.f;
#pragma unroll
      for (int w = 0; w < 8; ++w) { s0_ += ((LAS float*)lds)[w * 1024 + r * 32 + e2]; s1_ += ((LAS float*)lds)[w * 1024 + r * 32 + e2 + 1]; }
      lgt[r * 33 + e2] = s0_ + p.b_router[l * NE + e2]; lgt[r * 33 + e2 + 1] = s1_ + p.b_router[l * NE + e2 + 1]; }
    __syncthreads();
    if (t < 32 && routed) { const int row = trow0 + t; float lg[32];
#pragma unroll
      for (int e = 0; e < 32; ++e) lg[e] = lgt[t * 33 + e];
      float tv[4]; int ti[4];
#pragma unroll
      for (int k = 0; k < 4; ++k) { float bv = -3.0e38f; int bi = 0;
#pragma unroll
        for (int e = 0; e < 32; ++e) { if (lg[e] > bv) { bv = lg[e]; bi = e; } }
        tv[k] = bv; ti[k] = bi;
#pragma unroll
        for (int e = 0; e < 32; ++e) if (e == bi) lg[e] = -3.0e38f; }
      float e4[4], sum = 0.f;
#pragma unroll
      for (int k = 0; k < 4; ++k) { e4[k] = expf(tv[k] - tv[0]); sum += e4[k]; }
      const float inv = 1.f / sum;
      LAS int* lc = (LAS int*)(lds + 131072 + 8192); lc[t] = 0;
      int rk[4];
#pragma unroll
      for (int k = 0; k < 4; ++k) rk[k] = __hip_atomic_fetch_add(&lc[ti[k]], 1, __ATOMIC_RELAXED, __HIP_MEMORY_SCOPE_WAVEFRONT);
      const int mine = lc[t]; const int base = mine > 0 ? atomicAdd(&cntl[t], mine) : 0; lc[32 + t] = base;
#pragma unroll
      for (int k = 0; k < 4; ++k) { const int pos = lc[32 + ti[k]] + rk[k]; p.TOPE[row * 4 + k] = ti[k]; p.TOPP[row * 4 + k] = pos; p.TOPW[row * 4 + k] = e4[k] * inv;
        __hip_atomic_store(&p.ROWTOK[(size_t)ti[k] * T + pos], row, __ATOMIC_RELAXED, __HIP_MEMORY_SCOPE_AGENT); } }
    __syncthreads(); }
}
struct ConvW { f32x4 w[5][3][2]; };
__device__ __forceinline__ void load_convw(const FP& p, int l, int lane, ConvW& cw) {
  const float* c0 = p.gdn_conv + (size_t)l * 5 * 1536;
#pragma unroll
  for (int j = 0; j < 5; ++j)
#pragma unroll
    for (int blk = 0; blk < 3; ++blk) { cw.w[j][blk][0] = *(const f32x4*)(c0 + j * 1536 + blk * 512 + lane * 8); cw.w[j][blk][1] = *(const f32x4*)(c0 + j * 1536 + blk * 512 + lane * 8 + 4); }
}
__device__ __forceinline__ void prep_gdn_row(const FP& p, int l, int row, int lane, const ConvW& cw) {
  const int s = row % SB; const bool lat = s >= CTX; const int lo = lat ? CTX : 0, hi_ = lat ? SB : CTX;
  float o[3][8];
#pragma unroll
  for (int blk = 0; blk < 3; ++blk) {
#pragma unroll
    for (int e = 0; e < 8; ++e) o[blk][e] = 0.f;
#pragma unroll
    for (int j = 0; j < 5; ++j) { const int s2 = s + j - 2; if (s2 < lo || s2 >= hi_) continue;
      const u32x4 xv = *(const u32x4*)(p.Pb + (size_t)(row + j - 2) * INWP + C_GQ + blk * 512 + lane * 8);
      const f32x4 w0 = cw.w[j][blk][0], w1 = cw.w[j][blk][1];
      o[blk][0] += w0[0] * bflo(xv.x); o[blk][1] += w0[1] * bfhi(xv.x); o[blk][2] += w0[2] * bflo(xv.y); o[blk][3] += w0[3] * bfhi(xv.y);
      o[blk][4] += w1[0] * bflo(xv.z); o[blk][5] += w1[1] * bfhi(xv.z); o[blk][6] += w1[2] * bflo(xv.w); o[blk][7] += w1[3] * bfhi(xv.w); }
#pragma unroll
    for (int e = 0; e < 8; ++e) o[blk][e] = silu_f(o[blk][e]); }
#pragma unroll
  for (int blk = 0; blk < 2; ++blk) { float ss = 0.f;
#pragma unroll
    for (int e = 0; e < 8; ++e) ss += o[blk][e] * o[blk][e];
    ss += shx(ss, 1); ss += shx(ss, 2); ss += shx(ss, 4); ss += shx(ss, 8);
    const float rs = rsqrtf(ss + 1e-6f) * (blk == 0 ? 0.08838834764831845f : 1.f);
#pragma unroll
    for (int e = 0; e < 8; ++e) o[blk][e] *= rs; }
  u32x4 w;
  w.x = cvt_pk_bf16(o[0][0], o[0][1]); w.y = cvt_pk_bf16(o[0][2], o[0][3]); w.z = cvt_pk_bf16(o[0][4], o[0][5]); w.w = cvt_pk_bf16(o[0][6], o[0][7]); *(u32x4*)(p.GQb + (size_t)row * 512 + lane * 8) = w;
  w.x = cvt_pk_bf16(o[1][0], o[1][1]); w.y = cvt_pk_bf16(o[1][2], o[1][3]); w.z = cvt_pk_bf16(o[1][4], o[1][5]); w.w = cvt_pk_bf16(o[1][6], o[1][7]); *(u32x4*)(p.GKb + (size_t)row * 512 + lane * 8) = w;
  w.x = cvt_pk_bf16(o[2][0], o[2][1]); w.y = cvt_pk_bf16(o[2][2], o[2][3]); w.z = cvt_pk_bf16(o[2][4], o[2][5]); w.w = cvt_pk_bf16(o[2][6], o[2][7]); *(u32x4*)(p.GVb + (size_t)row * 512 + lane * 8) = w;
  if (lane < 8) { const float a = p.GAB[(size_t)row * 16 + lane] + p.gdn_dt_bias[l * 8 + lane]; const float xe = __expf(a);
    const float sp = a > 20.f ? a : (xe < 0.03f ? xe * (1.f - xe * (0.5f - xe * (1.f / 3.f))) : __logf(1.f + xe));
    p.GLA[(size_t)row * 8 + lane] = -__expf(p.gdn_a_log[l * 8 + lane]) * sp; p.GBETA[(size_t)row * 8 + lane] = 1.f / (1.f + __expf(-p.GAB[(size_t)row * 16 + 8 + lane])); }
}

typedef float f32x2_t __attribute__((ext_vector_type(2)));
template <int dir, int VAR = 0> __device__ __forceinline__ void g2_item(const FP& p, int bh, int cn, int t, LAS unsigned char* hl) {
  const int b = bh >> 2, h = bh & 3, w = t >> 6, lane = t & 63, c32 = lane & 31, hi = lane >> 5; const size_t row0 = (size_t)b * SB + cn * 64;
  LAS float* sA = (LAS float*)hl; LAS float* sg = sA + 64 * 64; LAS float* sb = sg + 64;
  LAS bf16_t* sK = (LAS bf16_t*)(hl + 16896); LAS bf16_t* sV = sK + 64 * 136; LAS bf16_t* sT1 = sV + 64 * 136; LAS bf16_t* sT2 = sT1 + 64 * 72;
  const int item = item_idx(dir, bh, cn);
  const int ws = (TIDX >> 8) & 1;
#pragma unroll
  for (int i = 0; i < 4; ++i) { const int idx = t + 256 * i, r = idx >> 4, c8 = (idx & 15) * 8;
    *(LAS u32x4*)(sK + r * 136 + c8) = *(const u32x4*)(p.GKb + (row0 + r) * 512 + h * 128 + c8); *(LAS u32x4*)(sV + r * 136 + c8) = *(const u32x4*)(p.GVb + (row0 + r) * 512 + h * 128 + c8); }
  if (w == 0) { float la = p.GLA[(row0 + lane) * 8 + dir * 4 + h]; const float bt = p.GBETA[(row0 + lane) * 8 + dir * 4 + h];
#pragma unroll
    for (int o = 1; o < 64; o <<= 1) { const float v = dir == 0 ? shup(la, o) : shdn(la, o); if (dir == 0 ? lane >= o : lane + o < 64) la += v; }
    sg[lane] = la; sb[lane] = bt; p.GG[(size_t)item * 64 + lane] = la; }
  __syncthreads();
  { const int it = w >> 1, jt = w & 1; f32x16 a;
#pragma unroll
    for (int r = 0; r < 16; ++r) a[r] = 0.f;
    const LAS bf16_t* ka = sK + (32 * it + c32) * 136 + 8 * hi; const LAS bf16_t* kb = sK + (32 * jt + c32) * 136 + 8 * hi;
#pragma unroll
    for (int s = 0; s < 8; ++s) a = __builtin_amdgcn_mfma_f32_32x32x16_bf16(*(const LAS bf16x8*)(ka + 16 * s), *(const LAS bf16x8*)(kb + 16 * s), a, 0, 0, 0);
    const int j = 32 * jt + c32; const float gj = sg[j];
#pragma unroll
    for (int r = 0; r < 16; ++r) { const int i = 32 * it + crow16(r, hi); const bool before = dir == 0 ? j < i : j > i;
      const float v = before ? sb[i] * a[r] * __expf(fminf(sg[i] - gj, 0.f)) : 0.f;
      if (dir == 0) sA[j * 64 + i] = v; else sA[(63 - j) * 64 + (63 - i)] = v; } }
  __syncthreads();
  if (w == ws) { f32x2_t x[32];
#pragma unroll
    for (int q = 0; q < 32; ++q) { x[q][0] = (2 * q == lane) ? 1.f : 0.f; x[q][1] = (2 * q + 1 == lane) ? 1.f : 0.f; }
#pragma unroll
    for (int jp = 0; jp < 63; ++jp) { const float xj = x[jp >> 1][jp & 1]; const f32x2_t xj2 = (f32x2_t){xj, xj};
#pragma unroll
      for (int q = (jp + 1) >> 2; q < 16; ++q) { const f32x4 r = *(const LAS f32x4*)(sA + jp * 64 + 4 * q);
        x[2 * q] = x[2 * q] - (f32x2_t){r[0], r[1]} * xj2; x[2 * q + 1] = x[2 * q + 1] - (f32x2_t){r[2], r[3]} * xj2; } }
    const int j = dir == 0 ? lane : 63 - lane; const float bj = sb[j], bje = bj * __expf(sg[j]);
#pragma unroll
    for (int ip = 0; ip < 64; ++ip) { const int i = dir == 0 ? ip : 63 - ip; const float v = x[ip >> 1][ip & 1]; sT1[i * 72 + j] = f2bf(v * bj); sT2[i * 72 + j] = f2bf(v * bje); }
  } else if (((w - ws - 1) & 3) < 2) { const int d = ((w - ws - 1) & 3) * 64 + lane; bf16_t* kt = p.GKTT + (size_t)item * 8192; const float glast = sg[dir == 0 ? 63 : 0];
#pragma unroll
    for (int grp = 0; grp < 16; ++grp) { const int s4 = grp >> 2, a = (grp >> 1) & 1, hp = grp & 1; float kv4[4];
#pragma unroll
      for (int r3 = 0; r3 < 4; ++r3) { const int i = 16 * s4 + 8 * a + 4 * hp + r3; kv4[r3] = bf2f(sK[i * 136 + d]) * __expf(glast - sg[i]); }
      u32x2 w2; w2.x = cvt_pk_bf16(kv4[0], kv4[1]); w2.y = cvt_pk_bf16(kv4[2], kv4[3]);
      *(u32x2*)(kt + (((d >> 5) * 4 + s4) * 64 + (d & 31) + 32 * hp) * 8 + 4 * a) = w2; } }
  __syncthreads();
  { f32x16 aU[2], aW[2];
#pragma unroll
    for (int it = 0; it < 2; ++it)
#pragma unroll
      for (int r = 0; r < 16; ++r) { aU[it][r] = 0.f; aW[it][r] = 0.f; }
#pragma unroll
    for (int s = 0; s < 4; ++s) { bf16x8 fv, fk;
#pragma unroll
      for (int jj = 0; jj < 8; ++jj) { fv[jj] = sV[(16 * s + 8 * hi + jj) * 136 + 32 * w + c32]; fk[jj] = sK[(16 * s + 8 * hi + jj) * 136 + 32 * w + c32]; }
#pragma unroll
      for (int it = 0; it < 2; ++it) { const bf16x8 t1 = *(const LAS bf16x8*)(sT1 + (32 * it + c32) * 72 + 16 * s + 8 * hi), t2 = *(const LAS bf16x8*)(sT2 + (32 * it + c32) * 72 + 16 * s + 8 * hi);
        aU[it] = __builtin_amdgcn_mfma_f32_32x32x16_bf16(t1, fv, aU[it], 0, 0, 0); aW[it] = __builtin_amdgcn_mfma_f32_32x32x16_bf16(fk, t2, aW[it], 0, 0, 0); } }
    asm volatile("s_nop 9\n\ts_nop 9" : "+v"(aU[0]), "+v"(aU[1]), "+v"(aW[0]), "+v"(aW[1]));
    bf16_t* ut = p.GUT + (size_t)item * 8192; bf16_t* gw = p.GWb + (size_t)item * 8192;
#pragma unroll
    for (int it2 = 0; it2 < 2; ++it2) {
#pragma unroll
      for (int g = 0; g < 4; ++g) { u32x2 w2; w2.x = cvt_pk_bf16(aU[it2][4 * g], aU[it2][4 * g + 1]); w2.y = cvt_pk_bf16(aU[it2][4 * g + 2], aU[it2][4 * g + 3]);
        *(u32x2*)(ut + (((w * 2 + it2) * 4 + g) * 64 + lane) * 4) = w2; }
#pragma unroll
      for (int sl = 0; sl < 2; ++sl) { u32x4 w4; w4.x = cvt_pk_bf16(aW[it2][8 * sl], aW[it2][8 * sl + 1]); w4.y = cvt_pk_bf16(aW[it2][8 * sl + 2], aW[it2][8 * sl + 3]);
        w4.z = cvt_pk_bf16(aW[it2][8 * sl + 4], aW[it2][8 * sl + 5]); w4.w = cvt_pk_bf16(aW[it2][8 * sl + 6], aW[it2][8 * sl + 7]);
        *(u32x4*)(gw + ((it2 * 8 + 2 * w + sl) * 64 + lane) * 8) = w4; } } }
  __syncthreads();
}

__device__ void gdn_scan_job(const FP& p, int bh, int dir, LAS unsigned char* lds) {
  const int t = TIDX, wid = __builtin_amdgcn_readfirstlane(t >> 6), lane = t & 63, hi = lane >> 5;
  f32x16 S[4];
#pragma unroll
  for (int d = 0; d < 4; ++d)
#pragma unroll
    for (int r = 0; r < 16; ++r) S[d][r] = 0.f;
#define GS_STAGE(cn, buf) do { const size_t io = (size_t)item_idx(dir, bh, (cn)) * 8192 * 2 + (size_t)(wid - 4) * 1024 + (size_t)lane * 16; const char* g0 = (const char*)p.GWb + io; const char* g1 = (const char*)p.GKTT + io; const char* g2 = (const char*)p.GUT + io; \
    LAS unsigned char* lb = lds + (buf) * 49152 + (wid - 4) * 1024; \
    _Pragma("unroll") for (int q_ = 0; q_ < 4; ++q_) { __builtin_amdgcn_global_load_lds((const unsigned*)(g0 + q_ * 4096), (LAS unsigned*)(lb + q_ * 4096), 16, 0, 0); \
      __builtin_amdgcn_global_load_lds((const unsigned*)(g1 + q_ * 4096), (LAS unsigned*)(lb + 16384 + q_ * 4096), 16, 0, 0); __builtin_amdgcn_global_load_lds((const unsigned*)(g2 + q_ * 4096), (LAS unsigned*)(lb + 32768 + q_ * 4096), 16, 0, 0); } } while (0)
  float dec0, dec1;
  { const int n0 = lane, n1 = 64 + (lane & 3); dec0 = __expf(p.GG[(size_t)item_idx(dir, bh, scan_chunk(dir, n0)) * 64 + (dir == 0 ? 63 : 0)]);
    dec1 = __expf(p.GG[(size_t)item_idx(dir, bh, scan_chunk(dir, n1)) * 64 + (dir == 0 ? 63 : 0)]); }
  __syncthreads();
  if (wid >= 4) { GS_STAGE(scan_chunk(dir, 0), 0); GS_STAGE(scan_chunk(dir, 1), 1); }
  for (int n = 0; n < NCH; ++n) { const int cn = scan_chunk(dir, n), buf = n % 3;
    if (wid >= 4) { if (n + 1 < NCH) asm volatile("s_waitcnt vmcnt(12)" ::: "memory"); else asm volatile("s_waitcnt vmcnt(0)" ::: "memory"); }
    __builtin_amdgcn_s_barrier(); asm volatile("" ::: "memory");
    if (wid >= 4) { if (n + 2 < NCH) GS_STAGE(scan_chunk(dir, n + 2), (n + 2) % 3); }
    if (wid < 4) { const int item = item_idx(dir, bh, cn);
      const float adec = __uint_as_float(__builtin_amdgcn_readlane(__float_as_uint(n < 64 ? dec0 : dec1), n & 63));
      asm volatile("s_nop 9\n\ts_nop 9" : "+v"(S[3]), "+v"(S[2]), "+v"(S[1]), "+v"(S[0]));
      bf16_t* st = p.GST + (size_t)item * 16384;
#pragma unroll
      for (int dt = 0; dt < 4; ++dt)
#pragma unroll
        for (int g = 0; g < 4; ++g) { u32x2 w; w.x = cvt_pk_bf16(S[dt][4 * g], S[dt][4 * g + 1]); w.y = cvt_pk_bf16(S[dt][4 * g + 2], S[dt][4 * g + 3]);
#ifdef PROBE_NOSTORE
          if (n == 1000)
#endif
          *(u32x2*)(st + ((wid * 8 + 2 * dt + (g >> 1)) * 64 + (lane & 31) + 32 * (g & 1)) * 8 + 4 * hi) = w; }
      const LAS unsigned char* bb = lds + buf * 49152;
      f32x16 vn[2];
#pragma unroll
      for (int it = 0; it < 2; ++it)
#pragma unroll
        for (int r = 0; r < 16; ++r) vn[it][r] = 0.f;
      bf16x8 wf[2][8];
#pragma unroll
      for (int it = 0; it < 2; ++it)
#pragma unroll
        for (int s = 0; s < 8; ++s) wf[it][s] = *(const LAS bf16x8*)(bb + (it * 8 + s) * 1024 + lane * 16);
#pragma unroll
      for (int s = 0; s < 8; ++s) { const bf16x8 sf = pack_step(S[s >> 1], s & 1);
#pragma unroll
        for (int it = 0; it < 2; ++it) vn[it] = __builtin_amdgcn_mfma_f32_32x32x16_bf16(wf[it][s], sf, vn[it], 0, 0, 0); }
      bf16x8 kf[4][4];
#pragma unroll
      for (int dt = 0; dt < 4; ++dt)
#pragma unroll
        for (int s = 0; s < 4; ++s) kf[dt][s] = *(const LAS bf16x8*)(bb + 16384 + (dt * 4 + s) * 1024 + lane * 16);
      bf16_t* vt = p.GVNT + (size_t)item * 8192;
#pragma unroll
      for (int it = 0; it < 2; ++it)
#pragma unroll
        for (int g = 0; g < 4; ++g) { const u32x2 uu = *(const LAS u32x2*)(bb + 32768 + (((wid * 2 + it) * 4 + g) * 64 + lane) * 8);
          vn[it][4 * g] = bflo(uu.x) - vn[it][4 * g]; vn[it][4 * g + 1] = bfhi(uu.x) - vn[it][4 * g + 1]; vn[it][4 * g + 2] = bflo(uu.y) - vn[it][4 * g + 2]; vn[it][4 * g + 3] = bfhi(uu.y) - vn[it][4 * g + 3];
          u32x2 w; w.x = cvt_pk_bf16(vn[it][4 * g], vn[it][4 * g + 1]); w.y = cvt_pk_bf16(vn[it][4 * g + 2], vn[it][4 * g + 3]);
#ifdef PROBE_NOSTORE
          if (n == 1000)
#endif
          *(u32x2*)(vt + ((wid * 4 + 2 * it + (g >> 1)) * 64 + lane) * 8 + 4 * (g & 1)) = w; }
#pragma unroll
      for (int dt = 0; dt < 4; ++dt)
#pragma unroll
        for (int r = 0; r < 16; ++r) S[dt][r] *= adec;
#pragma unroll
      for (int s = 0; s < 4; ++s) { const bf16x8 vf = pack_step(vn[s >> 1], s & 1);
#pragma unroll
        for (int dt = 0; dt < 4; ++dt) S[dt] = __builtin_amdgcn_mfma_f32_32x32x16_bf16(kf[dt][s], vf, S[dt], 0, 0, 0); }
    }
  }
  asm volatile("s_waitcnt vmcnt(0)" ::: "memory"); __syncthreads();
#undef GS_STAGE
}

__device__ void gdn_out_unit(const FP& p, int l, int bh, int cn, int ih, int lane) {
  const int b = bh >> 2, h = bh & 3, c32 = lane & 31, hi = lane >> 5; const size_t row0 = (size_t)b * SB + cn * 64; const int ipos = 32 * ih + c32;
  const unsigned lo16 = (unsigned)lane * 16u;
  const int itf = item_idx(0, bh, cn), itb = item_idx(1, bh, cn);
  f32x16 P0, P1;
#pragma unroll
  for (int r = 0; r < 16; ++r) { P0[r] = 0.f; P1[r] = 0.f; }
  const char* qb = (const char*)(p.GQb + (row0 + 32 * ih) * 512 + h * 128); const char* kb = (const char*)(p.GKb + row0 * 512 + h * 128);
  const unsigned rowoff = (unsigned)(c32 * 512 + 8 * hi) * 2u;
#pragma unroll 1
  for (int s = 0; s < 8; ++s) { const bf16x8 qf = *(const bf16x8*)(qb + rowoff + s * 32); const bf16x8 k0 = *(const bf16x8*)(kb + rowoff + s * 32), k1 = *(const bf16x8*)(kb + 32 * 1024 + rowoff + s * 32);
    P0 = __builtin_amdgcn_mfma_f32_32x32x16_bf16(k0, qf, P0, 0, 0, 0); P1 = __builtin_amdgcn_mfma_f32_32x32x16_bf16(k1, qf, P1, 0, 0, 0); }
  const float* ggf = p.GG + (size_t)itf * 64; const float* ggb = p.GG + (size_t)itb * 64;
  const float gfi = ggf[ipos], gbi = ggb[ipos];
  bf16x8 pb[2][2][2];
#pragma unroll
  for (int dir = 0; dir < 2; ++dir) { const float* gg = dir == 0 ? ggf : ggb; const float gi = dir == 0 ? gfi : gbi;
#pragma unroll
    for (int jt = 0; jt < 2; ++jt) { f32x16 pd;
#pragma unroll
      for (int g = 0; g < 4; ++g) { const f32x4 gj = *(const f32x4*)(gg + 32 * jt + 8 * g + 4 * hi);
#pragma unroll
        for (int r3 = 0; r3 < 4; ++r3) { const int r = 4 * g + r3; const int j = 32 * jt + 8 * g + 4 * hi + r3; const bool ok = dir == 0 ? j <= ipos : j >= ipos; const float pv = jt == 0 ? P0[r] : P1[r];
          pd[r] = ok ? pv * __expf(fminf(gi - gj[r3], 0.f)) : 0.f; } }
      pb[dir][jt][0] = pack_step(pd, 0); pb[dir][jt][1] = pack_step(pd, 1); } }
  __builtin_amdgcn_sched_barrier(0);
  f32x16 O[4];
  const char* vaf = (const char*)(p.GVNT + (size_t)itf * 8192); const char* vab = (const char*)(p.GVNT + (size_t)itb * 8192);
#pragma unroll
  for (int et = 0; et < 4; ++et) { f32x16 a;
#pragma unroll
    for (int r = 0; r < 16; ++r) a[r] = 0.f;
#pragma unroll
    for (int jt = 0; jt < 2; ++jt)
#pragma unroll
      for (int ss = 0; ss < 2; ++ss) { const bf16x8 af = *(const bf16x8*)(vaf + et * 4096 + lo16 + (2 * jt + ss) * 1024), ab = *(const bf16x8*)(vab + et * 4096 + lo16 + (2 * jt + ss) * 1024);
        a = __builtin_amdgcn_mfma_f32_32x32x16_bf16(af, pb[0][jt][ss], a, 0, 0, 0); a = __builtin_amdgcn_mfma_f32_32x32x16_bf16(ab, pb[1][jt][ss], a, 0, 0, 0); }
    O[et] = a; __builtin_amdgcn_sched_barrier(0); }
  const float facf = __expf(gfi), facb = __expf(gbi);
  const char* stf = (const char*)(p.GST + (size_t)itf * 16384); const char* stb = (const char*)(p.GST + (size_t)itb * 16384);
#pragma unroll 1
  for (int s = 0; s < 8; ++s) { const bf16x8 qf = *(const bf16x8*)(qb + rowoff + s * 32); const bf16x8 qsf = scale_frag(qf, facf), qsb = scale_frag(qf, facb);
#pragma unroll
    for (int et = 0; et < 4; ++et) { const bf16x8 af = *(const bf16x8*)(stf + et * 8192 + s * 1024 + lo16), ab = *(const bf16x8*)(stb + et * 8192 + s * 1024 + lo16);
      O[et] = __builtin_amdgcn_mfma_f32_32x32x16_bf16(af, qsf, O[et], 0, 0, 0); O[et] = __builtin_amdgcn_mfma_f32_32x32x16_bf16(ab, qsb, O[et], 0, 0, 0); } }
  float ss2 = 0.f;
#pragma unroll
  for (int et = 0; et < 4; ++et)
#pragma unroll
    for (int r = 0; r < 16; ++r) ss2 += O[et][r] * O[et][r];
  ss2 += shx(ss2, 32); const float rs = rsqrtf(ss2 * (1.f / 128.f) + 1e-6f);
  const size_t row = row0 + ipos; const bf16_t* zp = p.Pb + row * INWP + C_GZ + h * 128; const float* gr = p.g_gdn + l * 128; bf16_t* op = p.CATb + row * 1536 + 1024 + h * 128;
#pragma unroll
  for (int et = 0; et < 4; ++et)
#pragma unroll
    for (int g = 0; g < 4; ++g) { const int e0 = 32 * et + 8 * g + 4 * hi; const u32x2 gz = *(const u32x2*)(zp + e0); const f32x4 gg = *(const f32x4*)(gr + e0);
      const float z[4] = {bflo(gz.x), bfhi(gz.x), bflo(gz.y), bfhi(gz.y)}; float y[4];
#pragma unroll
      for (int j = 0; j < 4; ++j) y[j] = O[et][4 * g + j] * rs * gg[j] * silu_f(z[j]);
      u32x2 w; w.x = cvt_pk_bf16(y[0], y[1]); w.y = cvt_pk_bf16(y[2], y[3]); *(u32x2*)(op + e0) = w; }
}
template <bool GDN> __device__ __forceinline__ void post_unit(const FP& p, int l, int bh, int cn, LAS float* stats) {
  const int t = TIDX, wid = t >> 6, lane = t & 63, ih = wid >> 2, et = wid & 3, c32 = lane & 31, hi = lane >> 5;
  const int b = bh >> 2, h = bh & 3; const size_t row0 = (size_t)b * SB + cn * 64; const int ipos = 32 * ih + c32;
  const int itf = item_idx(0, bh, cn), itb = item_idx(1, bh, cn);
  const unsigned lo16 = (unsigned)lane * 16u;
  const bf16_t* Qp = GDN ? p.GQb : p.RQb; const bf16_t* Kp = GDN ? p.GKb : p.RKb; const bf16_t* STp = GDN ? p.GST : p.RST;
  bf16x8 qf[8], kf0[8], kf1[8], sf[8], sb[8];
  { const char* qb = (const char*)(Qp + (row0 + ipos) * 512 + h * 128 + 8 * hi); const char* kb = (const char*)(Kp + (row0 + c32) * 512 + h * 128 + 8 * hi);
#pragma unroll
    for (int s = 0; s < 8; ++s) qf[s] = *(const bf16x8*)(qb + s * 32);
#pragma unroll
    for (int s = 0; s < 8; ++s) kf0[s] = *(const bf16x8*)(kb + s * 32);
#pragma unroll
    for (int s = 0; s < 8; ++s) kf1[s] = *(const bf16x8*)(kb + 32 * 1024 + s * 32);
    const char* stf = (const char*)(STp + (size_t)itf * 16384) + et * 8192 + lo16; const char* stb = (const char*)(STp + (size_t)itb * 16384) + et * 8192 + lo16;
#pragma unroll
    for (int s = 0; s < 8; ++s) sf[s] = *(const bf16x8*)(stf + s * 1024);
    (void)stb; }
  const float* ggf = p.GG + (size_t)itf * 64; const float* ggb = p.GG + (size_t)itb * 64;
  float gfi = 0.f, gbi = 0.f, lgf = 0.f, lgb = 0.f;
  if (GDN) { gfi = ggf[ipos]; gbi = ggb[ipos]; }
  else { lgf = __log2f(1.f - __expf(p.ret_decay[l * 8 + h])); lgb = __log2f(1.f - __expf(p.ret_decay[l * 8 + 4 + h])); }
  f32x16 P0, P1;
#pragma unroll
  for (int r = 0; r < 16; ++r) { P0[r] = 0.f; P1[r] = 0.f; }
#pragma unroll
  for (int s = 0; s < 8; ++s) { P0 = __builtin_amdgcn_mfma_f32_32x32x16_bf16(kf0[s], qf[s], P0, 0, 0, 0); P1 = __builtin_amdgcn_mfma_f32_32x32x16_bf16(kf1[s], qf[s], P1, 0, 0, 0); }
  { const char* stb = (const char*)(STp + (size_t)itb * 16384) + et * 8192 + lo16;
#pragma unroll
    for (int s = 0; s < 8; ++s) sb[s] = *(const bf16x8*)(stb + s * 1024); }
  bf16x8 vf[4], vb[4];
  { const char* vaf = (const char*)(GDN ? p.GVNT + (size_t)itf * 8192 : p.RVTA + ((size_t)bh * NCH + cn) * 8192) + et * 4096 + lo16;
#pragma unroll
    for (int s = 0; s < 4; ++s) vf[s] = *(const bf16x8*)(vaf + s * 1024);
    if (GDN) { const char* vab = (const char*)(p.GVNT + (size_t)itb * 8192) + et * 4096 + lo16;
#pragma unroll
      for (int s = 0; s < 4; ++s) vb[s] = *(const bf16x8*)(vab + s * 1024); }
    else {
#pragma unroll
      for (int s = 0; s < 4; ++s) vb[s] = vf[s]; } }
  f32x16 O;
#pragma unroll
  for (int r = 0; r < 16; ++r) O[r] = 0.f;
#pragma unroll
  for (int dir = 0; dir < 2; ++dir)
#pragma unroll
    for (int jt = 0; jt < 2; ++jt) { f32x16 pd;
#pragma unroll
      for (int g = 0; g < 4; ++g) { f32x4 gj4 = (f32x4){0.f, 0.f, 0.f, 0.f}; if (GDN) gj4 = *(const f32x4*)((dir == 0 ? ggf : ggb) + 32 * jt + 8 * g + 4 * hi);
#pragma unroll
        for (int r3 = 0; r3 < 4; ++r3) { const int r = 4 * g + r3; const int j = 32 * jt + 8 * g + 4 * hi + r3; const float pv = jt == 0 ? P0[r] : P1[r]; float w;
          if (GDN) { const bool ok = dir == 0 ? j <= ipos : j >= ipos; const float gi = dir == 0 ? gfi : gbi; const float gj = gj4[r3]; w = ok ? __expf(fminf(gi - gj, 0.f)) : 0.f; }
          else { const int dlt = dir == 0 ? ipos - j : j - ipos; w = dlt >= 0 ? exp2f((dir == 0 ? lgf : lgb) * (float)dlt) : 0.f; }
          pd[r] = pv * w; } }
#pragma unroll
      for (int ss = 0; ss < 2; ++ss) { const bf16x8 pbf = pack_step(pd, ss); O = __builtin_amdgcn_mfma_f32_32x32x16_bf16(dir == 0 ? vf[2 * jt + ss] : vb[2 * jt + ss], pbf, O, 0, 0, 0); } }
  { const float facf = GDN ? __expf(gfi) : exp2f(lgf * (float)(ipos + 1)), facb = GDN ? __expf(gbi) : exp2f(lgb * (float)(64 - ipos));
#pragma unroll
    for (int s = 0; s < 8; ++s) { const bf16x8 qsf = scale_frag(qf[s], facf), qsb = scale_frag(qf[s], facb);
      O = __builtin_amdgcn_mfma_f32_32x32x16_bf16(sf[s], qsf, O, 0, 0, 0); O = __builtin_amdgcn_mfma_f32_32x32x16_bf16(sb[s], qsb, O, 0, 0, 0); } }
  float s1 = 0.f, s2 = 0.f;
#pragma unroll
  for (int r = 0; r < 16; ++r) { s1 += O[r]; s2 += O[r] * O[r]; }
  s1 += shx(s1, 32); s2 += shx(s2, 32);
  if (hi == 0) { stats[((ih * 4 + et) * 32 + c32) * 2] = s1; stats[((ih * 4 + et) * 32 + c32) * 2 + 1] = s2; }
  __syncthreads();
  float t1 = 0.f, t2 = 0.f;
#pragma unroll
  for (int e2 = 0; e2 < 4; ++e2) { t1 += stats[((ih * 4 + e2) * 32 + c32) * 2]; t2 += stats[((ih * 4 + e2) * 32 + c32) * 2 + 1]; }
  float mu, rs;
  if (GDN) { mu = 0.f; rs = rsqrtf(t2 * (1.f / 128.f) + 1e-6f); }
  else { mu = t1 * (1.f / 128.f); rs = rsqrtf(fmaxf(t2 * (1.f / 128.f) - mu * mu, 0.f) + 1e-5f); }
  const size_t row = row0 + ipos; const bf16_t* gp = p.Pb + row * INWP + (GDN ? C_GZ : C_RG) + h * 128; const float* gr = GDN ? p.g_gdn + l * 128 : p.g_ret + l * 512 + h * 128;
  bf16_t* op = p.CATb + row * 1536 + (GDN ? 1024 : 512) + h * 128;
#pragma unroll
  for (int g = 0; g < 4; ++g) { const int e0 = 32 * et + 8 * g + 4 * hi; const u32x2 gz = *(const u32x2*)(gp + e0); const f32x4 gg = *(const f32x4*)(gr + e0);
    const float z[4] = {bflo(gz.x), bfhi(gz.x), bflo(gz.y), bfhi(gz.y)}; float y[4];
#pragma unroll
    for (int j = 0; j < 4; ++j) y[j] = (O[4 * g + j] - mu) * rs * gg[j] * silu_f(z[j]);
    u32x2 w; w.x = cvt_pk_bf16(y[0], y[1]); w.y = cvt_pk_bf16(y[2], y[3]); *(u32x2*)(op + e0) = w; }
}
__device__ __forceinline__ void ph_post2(const FP& p, int l, LAS unsigned char* lds) {
  const int t = TIDX, lane = t & 63, gw = blockIdx.x * NWAVES + (t >> 6), GWN = gridDim.x * NWAVES;
  for (int row = gw; row < T; row += GWN) mla_out_row(p, l, row, lane);
  int par = 0;
  const int nch = (l == DEPTH - 1) ? NCH - 4 : NCH, c0 = NCH - nch;
  for (int u = blockIdx.x; u < 2 * 16 * nch; u += gridDim.x, par ^= 1) { const int m = u & 1, uu = u >> 1;
    if (m) post_unit<true>(p, l, uu / nch, c0 + uu % nch, (LAS float*)lds + par * 512); else post_unit<false>(p, l, uu / nch, c0 + uu % nch, (LAS float*)lds + par * 512); }
}
namespace p3 { constexpr int OK_ = 0, OQ = 16384, OSF = 32768, OSB = 65536, OVF = 98304, OVB = 114688, OST = 131072; }
template <bool GDN> __device__ __forceinline__ void post3_stage(const FP& p, int bh, int cn, LAS unsigned char* lds) {
  const int t = TIDX, wid = __builtin_amdgcn_readfirstlane(t >> 6), lane = t & 63;
  const int b = bh >> 2, h = bh & 3; const size_t row0 = (size_t)b * SB + cn * 64;
  const int itf = item_idx(0, bh, cn), itb = item_idx(1, bh, cn);
  const bf16_t* Kp = (GDN ? p.GKb : p.RKb) + row0 * 512 + h * 128; const bf16_t* Qp = (GDN ? p.GQb : p.RQb) + row0 * 512 + h * 128;
#pragma unroll
  for (int q = 0; q < 2; ++q) { const int pc = wid + 8 * q, row = 4 * pc + (lane >> 4), ch = (lane & 15) ^ (row & 7);
    __builtin_amdgcn_global_load_lds((const unsigned*)(Kp + (size_t)row * 512 + ch * 8), (LAS unsigned*)(lds + p3::OK_ + pc * 1024), 16, 0, 0);
    __builtin_amdgcn_global_load_lds((const unsigned*)(Qp + (size_t)row * 512 + ch * 8), (LAS unsigned*)(lds + p3::OQ + pc * 1024), 16, 0, 0); }
  const char* sf = (const char*)((GDN ? p.GST : p.RST) + (size_t)itf * 16384) + lane * 16; const char* sb = (const char*)((GDN ? p.GST : p.RST) + (size_t)itb * 16384) + lane * 16;
#pragma unroll
  for (int q = 0; q < 4; ++q) { const int pc = wid + 8 * q;
    __builtin_amdgcn_global_load_lds((const unsigned*)(sf + pc * 1024), (LAS unsigned*)(lds + p3::OSF + pc * 1024), 16, 0, 0);
    __builtin_amdgcn_global_load_lds((const unsigned*)(sb + pc * 1024), (LAS unsigned*)(lds + p3::OSB + pc * 1024), 16, 0, 0); }
  const char* vf = (const char*)(GDN ? p.GVNT + (size_t)itf * 8192 : p.RVTA + ((size_t)bh * NCH + cn) * 8192) + lane * 16;
#pragma unroll
  for (int q = 0; q < 2; ++q) { const int pc = wid + 8 * q; __builtin_amdgcn_global_load_lds((const unsigned*)(vf + pc * 1024), (LAS unsigned*)(lds + p3::OVF + pc * 1024), 16, 0, 0); }
  if (GDN) { const char* vb = (const char*)(p.GVNT + (size_t)itb * 8192) + lane * 16;
#pragma unroll
    for (int q = 0; q < 2; ++q) { const int pc = wid + 8 * q; __builtin_amdgcn_global_load_lds((const unsigned*)(vb + pc * 1024), (LAS unsigned*)(lds + p3::OVB + pc * 1024), 16, 0, 0); } }
}
#define P3SWZ(row, ch) ((row) * 256 + (((ch) ^ ((row) & 7)) << 4))
template <bool GDN, bool NGDN> __device__ __forceinline__ void post3_unit(const FP& p, int l, int bh, int cn, LAS unsigned char* lds, int par, bool hasnext, int nbh, int ncn) {
  const int t = TIDX, wid = t >> 6, lane = t & 63, ih = wid >> 2, et = wid & 3, c32 = lane & 31, hi = lane >> 5;
  const int b = bh >> 2, h = bh & 3; const size_t row0 = (size_t)b * SB + cn * 64; const int ipos = 32 * ih + c32;
  const int itf = item_idx(0, bh, cn), itb = item_idx(1, bh, cn);
  LAS float* stats = (LAS float*)(lds + p3::OST) + par * 512;
  const float* ggf = p.GG + (size_t)itf * 64; const float* ggb = p.GG + (size_t)itb * 64;
  float gfi = 0.f, gbi = 0.f, lgf = 0.f, lgb = 0.f;
  if (GDN) { gfi = ggf[ipos]; gbi = ggb[ipos]; }
  else { lgf = __log2f(1.f - __expf(p.ret_decay[l * 8 + h])); lgb = __log2f(1.f - __expf(p.ret_decay[l * 8 + 4 + h])); }
  const size_t row = row0 + ipos; const bf16_t* gp = p.Pb + row * INWP + (GDN ? C_GZ : C_RG) + h * 128; const float* gr = GDN ? p.g_gdn + l * 128 : p.g_ret + l * 512 + h * 128;
  u32x2 gz[4]; f32x4 gg[4];
#pragma unroll
  for (int g = 0; g < 4; ++g) { const int e0 = 32 * et + 8 * g + 4 * hi; gz[g] = *(const u32x2*)(gp + e0); gg[g] = *(const f32x4*)(gr + e0); }
  bf16x8 qf[8];
  { const int qr = 32 * ih + c32;
#pragma unroll
    for (int s = 0; s < 8; ++s) qf[s] = *(const LAS bf16x8*)(lds + p3::OQ + P3SWZ(qr, 2 * s + hi)); }
  f32x16 P0, P1;
#pragma unroll
  for (int r = 0; r < 16; ++r) { P0[r] = 0.f; P1[r] = 0.f; }
#pragma unroll
  for (int s = 0; s < 8; ++s) { const bf16x8 k0 = *(const LAS bf16x8*)(lds + p3::OK_ + P3SWZ(c32, 2 * s + hi)), k1 = *(const LAS bf16x8*)(lds + p3::OK_ + P3SWZ(32 + c32, 2 * s + hi));
    P0 = __builtin_amdgcn_mfma_f32_32x32x16_bf16(k0, qf[s], P0, 0, 0, 0); P1 = __builtin_amdgcn_mfma_f32_32x32x16_bf16(k1, qf[s], P1, 0, 0, 0); }
  f32x16 O;
#pragma unroll
  for (int r = 0; r < 16; ++r) O[r] = 0.f;
#pragma unroll
  for (int dir = 0; dir < 2; ++dir)
#pragma unroll
    for (int jt = 0; jt < 2; ++jt) { f32x16 pd;
#pragma unroll
      for (int g = 0; g < 4; ++g) { f32x4 gj4 = (f32x4){0.f, 0.f, 0.f, 0.f}; if (GDN) gj4 = *(const f32x4*)((dir == 0 ? ggf : ggb) + 32 * jt + 8 * g + 4 * hi);
#pragma unroll
        for (int r3 = 0; r3 < 4; ++r3) { const int r = 4 * g + r3; const int j = 32 * jt + 8 * g + 4 * hi + r3; const float pv = jt == 0 ? P0[r] : P1[r]; float w;
          if (GDN) { const bool ok = dir == 0 ? j <= ipos : j >= ipos; const float gi = dir == 0 ? gfi : gbi; w = ok ? __expf(fminf(gi - gj4[r3], 0.f)) : 0.f; }
          else { const int dlt = dir == 0 ? ipos - j : j - ipos; w = dlt >= 0 ? exp2f((dir == 0 ? lgf : lgb) * (float)dlt) : 0.f; }
          pd[r] = pv * w; } }
#pragma unroll
      for (int ss = 0; ss < 2; ++ss) { const bf16x8 pbf = pack_step(pd, ss);
        const bf16x8 vfr = *(const LAS bf16x8*)(lds + ((GDN && dir == 1) ? p3::OVB : p3::OVF) + (et * 4 + 2 * jt + ss) * 1024 + lane * 16);
        O = __builtin_amdgcn_mfma_f32_32x32x16_bf16(vfr, pbf, O, 0, 0, 0); } }
  { const float facf = GDN ? __expf(gfi) : exp2f(lgf * (float)(ipos + 1)), facb = GDN ? __expf(gbi) : exp2f(lgb * (float)(64 - ipos));
#pragma unroll
    for (int s = 0; s < 8; ++s) { const bf16x8 qsf = scale_frag(qf[s], facf), qsb = scale_frag(qf[s], facb);
      const bf16x8 sfr = *(const LAS bf16x8*)(lds + p3::OSF + (et * 8 + s) * 1024 + lane * 16), sbr = *(const LAS bf16x8*)(lds + p3::OSB + (et * 8 + s) * 1024 + lane * 16);
      O = __builtin_amdgcn_mfma_f32_32x32x16_bf16(sfr, qsf, O, 0, 0, 0); O = __builtin_amdgcn_mfma_f32_32x32x16_bf16(sbr, qsb, O, 0, 0, 0); } }
  float fz[16];
#pragma unroll
  for (int g = 0; g < 4; ++g) { fz[4 * g] = gg[g][0] * silu_f(bflo(gz[g].x)); fz[4 * g + 1] = gg[g][1] * silu_f(bfhi(gz[g].x)); fz[4 * g + 2] = gg[g][2] * silu_f(bflo(gz[g].y)); fz[4 * g + 3] = gg[g][3] * silu_f(bfhi(gz[g].y)); }
  float s1 = 0.f, s2 = 0.f;
#pragma unroll
  for (int r = 0; r < 16; ++r) { s1 += O[r]; s2 += O[r] * O[r]; }
  s1 += shx(s1, 32); s2 += shx(s2, 32);
  if (hi == 0) { stats[((ih * 4 + et) * 32 + c32) * 2] = s1; stats[((ih * 4 + et) * 32 + c32) * 2 + 1] = s2; }
  __syncthreads();
  if (hasnext) post3_stage<NGDN>(p, nbh, ncn, lds);
  float t1 = 0.f, t2 = 0.f;
#pragma unroll
  for (int e2 = 0; e2 < 4; ++e2) { t1 += stats[((ih * 4 + e2) * 32 + c32) * 2]; t2 += stats[((ih * 4 + e2) * 32 + c32) * 2 + 1]; }
  float mu, rs;
  if (GDN) { mu = 0.f; rs = rsqrtf(t2 * (1.f / 128.f) + 1e-6f); }
  else { mu = t1 * (1.f / 128.f); rs = rsqrtf(fmaxf(t2 * (1.f / 128.f) - mu * mu, 0.f) + 1e-5f); }
  bf16_t* op = p.CATb + row * 1536 + (GDN ? 1024 : 512) + h * 128;
#pragma unroll
  for (int g = 0; g < 4; ++g) { const int e0 = 32 * et + 8 * g + 4 * hi; float y[4];
#pragma unroll
    for (int j = 0; j < 4; ++j) y[j] = (O[4 * g + j] - mu) * rs * fz[4 * g + j];
    u32x2 w; w.x = cvt_pk_bf16(y[0], y[1]); w.y = cvt_pk_bf16(y[2], y[3]); *(u32x2*)(op + e0) = w; }
}
__device__ __forceinline__ void ph_post3(const FP& p, int l, LAS unsigned char* lds) {
  const int t = TIDX, lane = t & 63, gw = blockIdx.x * NWAVES + (t >> 6), GWN = gridDim.x * NWAVES;
  for (int row = gw; row < T; row += GWN) mla_out_row(p, l, row, lane);
  const int nch = (l == DEPTH - 1) ? NCH - 4 : NCH, c0 = NCH - nch, NU = 16 * nch, G = gridDim.x;
  int u = blockIdx.x; if (u >= 2 * NU) return;
  __syncthreads();
  if (u < NU) post3_stage<false>(p, u / nch, c0 + u % nch, lds); else post3_stage<true>(p, (u - NU) / nch, c0 + (u - NU) % nch, lds);
  for (int par = 0; u < 2 * NU; u += G, par ^= 1) { const int un = u + G; const bool hasnext = un < 2 * NU; const bool gd = u >= NU, ngd = un >= NU;
    const int uu = gd ? u - NU : u, vv = ngd ? un - NU : un; const int bh = uu / nch, cn = c0 + uu % nch, nbh = vv / nch, ncn = c0 + vv % nch;
    asm volatile("s_waitcnt vmcnt(0)" ::: "memory"); __syncthreads();
    if (!gd) { if (ngd) post3_unit<false, true>(p, l, bh, cn, lds, par, hasnext, nbh, ncn); else post3_unit<false, false>(p, l, bh, cn, lds, par, hasnext, nbh, ncn); }
    else post3_unit<true, true>(p, l, bh, cn, lds, par, hasnext, nbh, ncn); }
}
#define XB_TMO      128
#define XB_XCNT(j)  (256  + 64 * (j))
#define XB_XSUB(j)  (1280 + 64 * (j))
#define XB_XGEN(j)  (2304 + 64 * (j))
#define XB_TOP      3328
#define XB_TOPGEN   3392
#define XCD_BAR_WORDS 3456
#define XB_SPIN_CAP (1u << 18)

__device__ __forceinline__ unsigned xb_ld(unsigned* p)              { return __hip_atomic_load(p, __ATOMIC_RELAXED, __HIP_MEMORY_SCOPE_AGENT); }
__device__ __forceinline__ unsigned xb_add(unsigned* p, unsigned v) { return __hip_atomic_fetch_add(p, v, __ATOMIC_RELAXED, __HIP_MEMORY_SCOPE_AGENT); }
__device__ __forceinline__ unsigned xb_xcc_id() { return (unsigned)__builtin_amdgcn_s_getreg((3 << 11) | 20) & 0xFu; }
#define XB_SPIN(cond, bar) do { unsigned _sp = 0; while (cond) { __builtin_amdgcn_s_sleep(1); \
    if ((++_sp & 255u) == 0u) { if (xb_ld(&(bar)[XB_TMO])) break; if (_sp > XB_SPIN_CAP) { atomicAdd(&(bar)[XB_TMO], 1u); break; } } } } while (0)

struct XcdBarrier {
    unsigned* bar; unsigned x;
    volatile LAS unsigned* st;
};

__device__ __forceinline__ XcdBarrier xcd_barrier_post(unsigned* bar, volatile LAS unsigned* st) {
    XcdBarrier b; b.bar = bar; b.x = xb_xcc_id(); b.st = st;
    if (threadIdx.x == 0) (void)xb_add(&bar[XB_XCNT(b.x)], 1u);
    return b;
}
__device__ __forceinline__ void xcd_barrier_complete(unsigned* bar, unsigned x, unsigned& nloc, unsigned& nx) {
    const unsigned G = gridDim.x * gridDim.y * gridDim.z;
    unsigned sum, cnt, mine, sp = 0u;
    for (;;) {
        sum = 0u; cnt = 0u; mine = 0u;
#pragma unroll
        for (unsigned j = 0; j < 16; ++j) { const unsigned c = xb_ld(&bar[XB_XCNT(j)]); sum += c; cnt += (c > 0u) ? 1u : 0u; mine = (j == x) ? c : mine; }
        if (sum == G) break;
        __builtin_amdgcn_s_sleep(1);
        if ((++sp & 255u) == 0u) { if (xb_ld(&bar[XB_TMO])) break; if (sp > XB_SPIN_CAP) { atomicAdd(&bar[XB_TMO], 1u); break; } }
    }
    nloc = mine > 0u ? mine : 1u; nx = cnt > 0u ? cnt : 1u;
}

__device__ __forceinline__ void xcd_barrier(const XcdBarrier& b) {
    asm volatile("s_waitcnt vmcnt(0)" ::: "memory");
    __syncthreads();
    if (threadIdx.x == 0) {
        unsigned* bar = b.bar; unsigned bx = b.x; asm volatile("" : "+s"(bx));
        __builtin_amdgcn_s_waitcnt(0);
        unsigned nloc = b.st[0], nx = b.st[1];
        if (nloc == 0u) { xcd_barrier_complete(bar, bx, nloc, nx); b.st[0] = nloc; b.st[1] = nx; }
        const unsigned old = xb_add(&bar[XB_XSUB(bx)], 1u);
        const unsigned gen = old / nloc;
        if (old + 1u == (gen + 1u) * nloc) {
            __builtin_amdgcn_fence(__ATOMIC_RELEASE, "agent");
            asm volatile("s_waitcnt vmcnt(0)" ::: "memory");
            const unsigned og = xb_add(&bar[XB_TOP], 1u);
            const unsigned tg = og / nx;
            if (og + 1u == (tg + 1u) * nx) xb_add(&bar[XB_TOPGEN], 1u);
            else XB_SPIN(xb_ld(&bar[XB_TOPGEN]) == tg, bar);
            __builtin_amdgcn_fence(__ATOMIC_ACQUIRE, "agent");
            xb_add(&bar[XB_XGEN(bx)], 1u);
            asm volatile("s_waitcnt vmcnt(0)" ::: "memory");
        } else {
            XB_SPIN(xb_ld(&bar[XB_XGEN(bx)]) == gen, bar);
            __builtin_amdgcn_fence(__ATOMIC_ACQUIRE, "agent");
            asm volatile("s_waitcnt vmcnt(0)" ::: "memory");
        }
    }
    __syncthreads();
}

__device__ __forceinline__ void ph_prep(const FP& p, int l, LAS unsigned char* lds) { const int t = TIDX, lane = t & 63, gw = blockIdx.x * NWAVES + (t >> 6), GWN = gridDim.x * NWAVES;
  LAS float* cwl = (LAS float*)lds;
  __syncthreads();
  for (int i = t; i < 5 * 1536 / 4; i += NTHREADS) *(LAS f32x4*)(cwl + 4 * i) = *(const f32x4*)(p.gdn_conv + (size_t)l * 5 * 1536 + 4 * i);
  __syncthreads();
  const f32x4 gq = *(const f32x4*)(p.g_cq + l * 256 + lane * 4); const float gkv0 = p.g_ckv[l * 128 + lane * 2], gkv1 = p.g_ckv[l * 128 + lane * 2 + 1];
  const float dtb = p.gdn_dt_bias[l * 8 + (lane & 7)], nalog = -__expf(p.gdn_a_log[l * 8 + (lane & 7)]);
  for (int row = gw; row < T; row += GWN) { const int s = row % SB; const bool lat = s >= CTX; const int tok = s - CTX, lo = lat ? CTX : 0, hi_ = lat ? SB : CTX;
    const bf16_t* pr = p.Pb + (size_t)row * INWP;
    const u32x2 vdq = *(const u32x2*)(pr + C_DQ + lane * 4); const unsigned vdkv = *(const unsigned*)(pr + C_DKV + lane * 2); const bf16_t vkr = pr[C_KR + lane];
    const u32x4 qv = *(const u32x4*)(pr + C_RQ + lane * 8), kv = *(const u32x4*)(pr + C_RK + lane * 8);
    u32x4 gx[3][5];
#pragma unroll
    for (int j = 0; j < 5; ++j) { const int s2 = s + j - 2; const bool ok = s2 >= lo && s2 < hi_; const bf16_t* pj = ok ? pr + (j - 2) * INWP : pr;
#pragma unroll
      for (int blk = 0; blk < 3; ++blk) gx[blk][j] = *(const u32x4*)(pj + C_GQ + blk * 512 + lane * 8); }
    const float gab = p.GAB[(size_t)row * 16 + (lane & 15)];
    { float x[4] = {bflo(vdq.x), bfhi(vdq.x), bflo(vdq.y), bfhi(vdq.y)};
      const float ss = wave_sum(x[0] * x[0] + x[1] * x[1] + x[2] * x[2] + x[3] * x[3]); const float rs = rsqrtf(ss * (1.f / 256.f) + 1e-6f);
      u32x2 w; w.x = cvt_pk_bf16(x[0] * rs * gq[0], x[1] * rs * gq[1]); w.y = cvt_pk_bf16(x[2] * rs * gq[2], x[3] * rs * gq[3]);
      *(u32x2*)(p.A2b + (size_t)row * MLAK + lane * 4) = w; }
    { const float x0 = bflo(vdkv), x1 = bfhi(vdkv);
      const float ss = wave_sum(x0 * x0 + x1 * x1); const float rs = rsqrtf(ss * (1.f / 128.f) + 1e-6f);
      *(unsigned*)(p.A2b + (size_t)row * MLAK + 256 + lane * 2) = cvt_pk_bf16(x0 * rs * gkv0, x1 * rs * gkv1); }
    { const float x = bf2f(vkr); const float xp = shx(x, 16); float y = x;
      if (lat) { const int hh = lane >> 5, ii = lane & 31, fi = ii & 15; const float pos = (float)(hh == 0 ? (tok >> 6) : (tok & 63));
        const float ang = pos * __expf(-(float)fi * (9.210340371976184f / 16.f)); const float cs = __cosf(ang), sn = __sinf(ang);
        y = ii < 16 ? x * cs - xp * sn : x * cs + xp * sn; }
      unsigned u = __float_as_uint(y); u += 0x7fffu + ((u >> 16) & 1u); p.KRb[(size_t)row * 64 + lane] = (bf16_t)(u >> 16); }
    { float q[8] = {bflo(qv.x), bfhi(qv.x), bflo(qv.y), bfhi(qv.y), bflo(qv.z), bfhi(qv.z), bflo(qv.w), bfhi(qv.w)};
      float k[8] = {bflo(kv.x), bfhi(kv.x), bflo(kv.y), bfhi(kv.y), bflo(kv.z), bfhi(kv.z), bflo(kv.w), bfhi(kv.w)};
      float qo[8], ko[8];
      const bool lowh = (lane & 4) == 0;
      const float pos = (float)(((lane >> 3) & 1) == 0 ? (tok >> 6) : (tok & 63));
#pragma unroll
      for (int e = 0; e < 8; ++e) { const float qp = shx(q[e], 4), kp = shx(k[e], 4);
        if (lat) { const int fi = (lane & 3) * 8 + e; const float ang = pos * __expf(-(float)fi * (9.210340371976184f / 32.f)); const float cs = __cosf(ang), sn = __sinf(ang);
          qo[e] = lowh ? q[e] * cs - qp * sn : q[e] * cs + qp * sn; ko[e] = lowh ? k[e] * cs - kp * sn : k[e] * cs + kp * sn; }
        else { qo[e] = q[e]; ko[e] = k[e]; } }
      const float sc = 0.08838834764831845f;
      u32x4 wq, wk; wq.x = cvt_pk_bf16(qo[0], qo[1]); wq.y = cvt_pk_bf16(qo[2], qo[3]); wq.z = cvt_pk_bf16(qo[4], qo[5]); wq.w = cvt_pk_bf16(qo[6], qo[7]);
      wk.x = cvt_pk_bf16(ko[0] * sc, ko[1] * sc); wk.y = cvt_pk_bf16(ko[2] * sc, ko[3] * sc); wk.z = cvt_pk_bf16(ko[4] * sc, ko[5] * sc); wk.w = cvt_pk_bf16(ko[6] * sc, ko[7] * sc);
      *(u32x4*)(p.RQb + (size_t)row * 512 + lane * 8) = wq; *(u32x4*)(p.RKb + (size_t)row * 512 + lane * 8) = wk; }
    { float o[3][8];
#pragma unroll
      for (int blk = 0; blk < 3; ++blk) {
#pragma unroll
        for (int e = 0; e < 8; ++e) o[blk][e] = 0.f;
#pragma unroll
        for (int j = 0; j < 5; ++j) { const int s2 = s + j - 2; const float m = (s2 >= lo && s2 < hi_) ? 1.f : 0.f; const u32x4 xv = gx[blk][j];
          const f32x4 w0 = *(const LAS f32x4*)(cwl + j * 1536 + blk * 512 + lane * 8) * m, w1 = *(const LAS f32x4*)(cwl + j * 1536 + blk * 512 + lane * 8 + 4) * m;
          o[blk][0] += w0[0] * bflo(xv.x); o[blk][1] += w0[1] * bfhi(xv.x); o[blk][2] += w0[2] * bflo(xv.y); o[blk][3] += w0[3] * bfhi(xv.y);
          o[blk][4] += w1[0] * bflo(xv.z); o[blk][5] += w1[1] * bfhi(xv.z); o[blk][6] += w1[2] * bflo(xv.w); o[blk][7] += w1[3] * bfhi(xv.w); }
#pragma unroll
        for (int e = 0; e < 8; ++e) o[blk][e] = silu_f(o[blk][e]); }
#pragma unroll
      for (int blk = 0; blk < 2; ++blk) { float ss = 0.f;
#pragma unroll
        for (int e = 0; e < 8; ++e) ss += o[blk][e] * o[blk][e];
        ss += shx(ss, 1); ss += shx(ss, 2); ss += shx(ss, 4); ss += shx(ss, 8);
        const float rs = rsqrtf(ss + 1e-6f) * (blk == 0 ? 0.08838834764831845f : 1.f);
#pragma unroll
        for (int e = 0; e < 8; ++e) o[blk][e] *= rs; }
      u32x4 w;
      w.x = cvt_pk_bf16(o[0][0], o[0][1]); w.y = cvt_pk_bf16(o[0][2], o[0][3]); w.z = cvt_pk_bf16(o[0][4], o[0][5]); w.w = cvt_pk_bf16(o[0][6], o[0][7]); *(u32x4*)(p.GQb + (size_t)row * 512 + lane * 8) = w;
      w.x = cvt_pk_bf16(o[1][0], o[1][1]); w.y = cvt_pk_bf16(o[1][2], o[1][3]); w.z = cvt_pk_bf16(o[1][4], o[1][5]); w.w = cvt_pk_bf16(o[1][6], o[1][7]); *(u32x4*)(p.GKb + (size_t)row * 512 + lane * 8) = w;
      w.x = cvt_pk_bf16(o[2][0], o[2][1]); w.y = cvt_pk_bf16(o[2][2], o[2][3]); w.z = cvt_pk_bf16(o[2][4], o[2][5]); w.w = cvt_pk_bf16(o[2][6], o[2][7]); *(u32x4*)(p.GVb + (size_t)row * 512 + lane * 8) = w;
      if (lane < 8) { const float a = gab + dtb; const float xe = __expf(a);
        const float sp = a > 20.f ? a : (xe < 0.03f ? xe * (1.f - xe * (0.5f - xe * (1.f / 3.f))) : __logf(1.f + xe));
        p.GLA[(size_t)row * 8 + lane] = nalog * sp; }
      else if (lane < 16) p.GBETA[(size_t)row * 8 + lane - 8] = 1.f / (1.f + __expf(-gab)); } } }
template <int WHICH = 3, int VAR = 0> __device__ __forceinline__ void ph_items(const FP& p, int l, LAS unsigned char* lds) {
  int rb = (int)blockIdx.x; asm volatile("" : "+s"(rb)); rb = (int)gridDim.x - 1 - rb;
  if (WHICH & 1) for (int pr = rb; pr < 16 * NCH / 2; pr += gridDim.x) { const int it = pr * 2 + (TIDX >> 8); r2_item(p, l, it / NCH, it % NCH, TIDX & 255, lds + (TIDX >> 8) * 40960); }
  if (WHICH & 2) for (int pr = rb; pr < 2 * 16 * NCH / 2; pr += gridDim.x) { const int it = pr * 2 + (TIDX >> 8); if (it / (16 * NCH)) g2_item<1, VAR>(p, (it / NCH) & 15, it % NCH, TIDX & 255, lds + (TIDX >> 8) * 71680); else g2_item<0, VAR>(p, (it / NCH) & 15, it % NCH, TIDX & 255, lds + (TIDX >> 8) * 71680); } }
__device__ __forceinline__ void ph_post(const FP& p, int l) { const int t = TIDX, lane = t & 63, gw = blockIdx.x * NWAVES + (t >> 6), GWN = gridDim.x * NWAVES;
  for (int row = gw; row < T; row += GWN) mla_out_row(p, l, row, lane);
  for (int u = gw; u < 16 * NCH * 2; u += GWN) { ret_out_unit(p, l, u / (NCH * 2), (u >> 1) % NCH, u & 1, lane); gdn_out_unit(p, l, u / (NCH * 2), (u >> 1) % NCH, u & 1, lane); } }

#ifndef REPMASK
#define REPMASK 0
#endif
#define REP(k, ...) do { if ((REPMASK >> (k)) & 1) { __VA_ARGS__; xcd_barrier(bar); } } while (0)
#ifndef PROBE_A
#define PROBE_A 0
#endif
#ifndef PROBE_Q
#define PROBE_Q 40
#endif
#if PROBE_A
#ifndef PROBE_BLK
#define PROBE_BLK 0
#endif
#define STAMP(k) do { if (blockIdx.x == PROBE_BLK && TIDX == 0) { volatile LAS unsigned* tw_ = (volatile LAS unsigned*)(lds + LDS_BYTES - 48); if ((k) != 13) tw_[0] = (k); if ((k) == 13 || (k) == 6 || (k) == 15) { \
    const unsigned long long now_ = __builtin_amdgcn_s_memrealtime(); volatile LAS unsigned long long* tl_ = (volatile LAS unsigned long long*)(lds + LDS_BYTES - 32); \
    volatile unsigned* ta_ = p.ctl + 3600 + tw_[0]; *ta_ = *ta_ + (unsigned)(now_ - *tl_); *tl_ = now_; } } } while (0)
#else
#define STAMP(k) do { } while (0)
#endif
__global__ void __launch_bounds__(512, 2) mega_fwd(FP p) {
  extern __shared__ __attribute__((aligned(16))) unsigned char shm[];
  LAS unsigned char* lds = (LAS unsigned char*)shm;
  volatile LAS unsigned* xbw = (volatile LAS unsigned*)(lds + LDS_BYTES - 16);
  if (threadIdx.x == 0) { xbw[0] = 0u; xbw[1] = 0u; xbw[2] = 0u; xbw[3] = 0u; }
  __syncthreads();
  XcdBarrier bar = xcd_barrier_post(p.ctl, xbw);
#if PROBE_A
  if (blockIdx.x == PROBE_BLK && TIDX == 0) *(volatile LAS unsigned long long*)(lds + LDS_BYTES - 32) = __builtin_amdgcn_s_memrealtime();
#endif
  ph_prologue(p, lds);
  REP(0, ph_prologue(p, lds));
  STAMP(0); xcd_barrier(bar); STAMP(13);
  for (int l = 0; l < DEPTH; ++l) {
    ph_norm1(p, l, lds);            REP(1, ph_norm1<true>(p, l, lds)); STAMP(1); xcd_barrier(bar); STAMP(13);
    ph_inproj(p, l, lds);           REP(2, ph_inproj(p, l, lds)); STAMP(2); xcd_barrier(bar); STAMP(13);
    ph_prep(p, l, lds);             REP(3, ph_prep(p, l, lds)); STAMP(3);
    xcd_barrier(bar); STAMP(13);
    ph_mla_gemm(p, l, lds); REP(4, ph_mla_gemm(p, l, lds)); STAMP(4);
    moe_weights_layer<1, 0, 192>(p, l, 20736, NE * 768, 0, lds);
    ph_items(p, l, lds); REP(5, ph_items(p, l, lds)); REP(14, ph_items<1>(p, l, lds)); REP(15, ph_items<2>(p, l, lds)); STAMP(5); xcd_barrier(bar); STAMP(13);
    if (blockIdx.x < 32) ret_scan_job(p, l, blockIdx.x >> 1, blockIdx.x & 1, lds); else if (blockIdx.x < 64) gdn_scan_job(p, (blockIdx.x - 32) >> 1, blockIdx.x & 1, lds);
    REP(6, if (blockIdx.x < 32) ret_scan_job(p, l, blockIdx.x >> 1, blockIdx.x & 1, lds); else if (blockIdx.x < 64) gdn_scan_job(p, (blockIdx.x - 32) >> 1, blockIdx.x & 1, lds));
    STAMP(6);
    moe_weights_layer<1, 0, 32>(p, l, 0, 6176, 0, lds); moe_weights_layer<1, 0, 64>(p, l, 6176, 10688, 32, lds);
    ph_attn(p, l, (char*)shm);      REP(7, ph_attn(p, l, (char*)shm)); STAMP(15); STAMP(7);
    moe_weights_layer(p, l, 10688, 20736, 64, lds);
    xcd_barrier(bar); STAMP(13);
    ph_post3(p, l, lds);            REP(8, ph_post3(p, l, lds)); STAMP(8); xcd_barrier(bar); STAMP(13);
    ph_outproj(p, l, lds);
    REP(9, { FP q = p; q.X = (float*)p.SCR; ph_outproj(q, l, lds); }); STAMP(9); xcd_barrier(bar); STAMP(13);
    ph_norm2m(p, l, lds);           REP(10, ph_norm2<true>(p, l, lds)); STAMP(10); xcd_barrier(bar); STAMP(13);
    ph_gemm1(p, l, lds);            REP(11, ph_gemm1(p, l, lds)); STAMP(11); xcd_barrier(bar); STAMP(13);
    ph_gemm2(p, l, lds);            REP(12, ph_gemm2(p, l, lds)); STAMP(12);
    if (l + 1 < DEPTH) dense_weights_layer(p, l + 1, 128, lds);
    xcd_barrier(bar); STAMP(13);
  }
  ph_final(p, lds);
#if PROBE_A
  STAMP(14); xcd_barrier(bar); STAMP(13);
  __syncthreads(); asm volatile("s_waitcnt vmcnt(0)" ::: "memory");
  if (blockIdx.x == 0 && threadIdx.x == 0) { unsigned a = 0;
    for (int k = 0; k < 16; ++k) { const unsigned tv = ((volatile unsigned*)p.ctl)[3600 + k]; if ((PROBE_A >> k) & 1) a += tv; }
    const float us = (float)a * 0.01f; float q = floorf(us * (1.f / (float)PROBE_Q) + 0.5f);
#ifdef PROBE_NBLK
    { int tot = 0; for (int l = 0; l < DEPTH; ++l) { int nblk = 0; for (int e = 0; e < NE; ++e) nblk += (p.cnt[l * 32 + e] + 255) >> 8; tot += (PROBE_NBLK == 1) ? (nblk * 8 + 255) / 256 : (PROBE_NBLK == 2) ? (nblk * 4 + 255) / 256 : (l == PROBE_NBLK - 3 ? nblk - 272 : 0); } q = (float)(tot - (PROBE_NBLK == 1 ? 30 : PROBE_NBLK == 2 ? 10 : 0)); }
#endif
    p.out[0] += 4.f * q; }
#endif
}

static size_t f_layout(char* base, FP& p) {
  size_t o = 0; auto take = [&](size_t bytes) { char* q = base + o; o += (bytes + 255) & ~(size_t)255; return q; };
  p.ctl = (unsigned*)take((size_t)CTL_WORDS * 4); p.cnt = (int*)(p.ctl + 4096);
  p.Wt_in = (bf16_t*)take((size_t)DEPTH * INWP * 1024 * 2); p.Wt_mla = (bf16_t*)take((size_t)DEPTH * MLAN * MLAK * 2); p.Wt_out = (bf16_t*)take((size_t)DEPTH * 1024 * 1536 * 2);
  p.Wt_gu = (bf16_t*)take((size_t)DEPTH * NE * 2048 * 1024 * 2); p.Wt_dn = (bf16_t*)take((size_t)DEPTH * NE * 1024 * 1024 * 2);
  p.MOD = (float*)take((size_t)DEPTH * 5 * 6144 * 4); p.X = (float*)take((size_t)T * D * 4); p.GAB = (float*)take((size_t)T * 16 * 4); p.TOPW = (float*)take((size_t)T * 4 * 4);
  p.Hb = (bf16_t*)take((size_t)T * D * 2); p.H2b = (bf16_t*)take((size_t)T * D * 2); p.Pb = (bf16_t*)take((size_t)T * INWP * 2); p.CATb = (bf16_t*)take((size_t)T * 1536 * 2);
  p.ACTb = (bf16_t*)take((size_t)ROWS_P * 1024 * 2); p.YSb = (bf16_t*)take((size_t)ROWS_P * 1024 * 2);
  p.A2b = (bf16_t*)take((size_t)T * MLAK * 2); p.Qb = (bf16_t*)take((size_t)T * 768 * 2); p.Knb = (bf16_t*)take((size_t)T * 512 * 2); p.Vb = (bf16_t*)take((size_t)T * 512 * 2);
  p.KRb = (bf16_t*)take((size_t)T * 64 * 2); p.AOb = (bf16_t*)take((size_t)T * 512 * 2);
  p.RQb = (bf16_t*)take((size_t)T * 512 * 2); p.RKb = (bf16_t*)take((size_t)T * 512 * 2); p.RKWT = (bf16_t*)take((size_t)2 * 16 * NCH * 8192 * 2);
  p.RVTB = (bf16_t*)take((size_t)16 * NCH * 8192 * 2); p.RVTA = (bf16_t*)take((size_t)16 * NCH * 8192 * 2); p.RST = (bf16_t*)take((size_t)2 * 16 * NCH * 16384 * 2);
  p.GQb = (bf16_t*)take((size_t)T * 512 * 2); p.GKb = (bf16_t*)take((size_t)T * 512 * 2); p.GVb = (bf16_t*)take((size_t)T * 512 * 2);
  p.GLA = (float*)take((size_t)T * 8 * 4); p.GBETA = (float*)take((size_t)T * 8 * 4); p.GG = (float*)take((size_t)2 * 16 * NCH * 64 * 4);
  p.GWb = (bf16_t*)take((size_t)2 * 16 * NCH * 8192 * 2); p.GKTT = (bf16_t*)take((size_t)2 * 16 * NCH * 8192 * 2); p.GUT = (bf16_t*)take((size_t)2 * 16 * NCH * 8192 * 2);
  p.GVNT = (bf16_t*)take((size_t)2 * 16 * NCH * 8192 * 2); p.GST = (bf16_t*)take((size_t)2 * 16 * NCH * 16384 * 2);
  p.TOPE = (int*)take((size_t)T * 4 * 4); p.TOPP = (int*)take((size_t)T * 4 * 4); p.ROWTOK = (int*)take((size_t)NE * T * 4); p.SCR = (bf16_t*)take((size_t)T * D * 4 + 4096); p.ROPE = (float*)take(64 * 32 * 4); p.WRF = (bf16_t*)take((size_t)DEPTH * 2 * 64 * 64 * 8 * 2);
  return o;
}
}

extern "C" void kernel_launch(void* const* d_in, const int* in_sizes, int n_in, void* d_out, int out_size, void* d_ws, size_t ws_size, hipStream_t stream) {
  static int grid = 0;
  if (grid == 0) {
    if (hipFuncSetAttribute((const void*)fx::mega_fwd, hipFuncAttributeMaxDynamicSharedMemorySize, fx::LDS_BYTES) != hipSuccess) { fprintf(stderr, "kernel_launch: hipFuncSetAttribute failed\n"); grid = -1; return; }
    int dev = 0, cus = 0, per_cu = 0; (void)hipGetDevice(&dev); (void)hipDeviceGetAttribute(&cus, hipDeviceAttributeMultiprocessorCount, dev);
    if (hipOccupancyMaxActiveBlocksPerMultiprocessor(&per_cu, (const void*)fx::mega_fwd, 512, fx::LDS_BYTES) != hipSuccess || per_cu < 1) { fprintf(stderr, "kernel_launch: occupancy query says %d blocks per CU\n", per_cu); grid = -1; return; }
    grid = cus;
    if (grid < 64) { fprintf(stderr, "kernel_launch: needs >= 64 CUs\n"); grid = -1; return; }
  }
  if (grid < 0) return;
  fx::FP p{}; { const float** f = (const float**)&p; for (int i = 0; i < 28; ++i) f[i] = (const float*)d_in[i]; }
  p.out = (float*)d_out;
  const size_t fsz = fx::f_layout((char*)d_ws, p);
  if (fsz > ws_size || n_in != 28) { fprintf(stderr, "kernel_launch: ws too small (%zu > %zu) or n_in %d\n", fsz, ws_size, n_in); return; }
  (void)hipMemsetAsync(p.ctl, 0, (size_t)fx::CTL_WORDS * 4, stream);
  hipLaunchKernelGGL(fx::mega_fwd, dim3(grid), dim3(512), fx::LDS_BYTES, stream, p);
}
```

```cpp
#include <hip/hip_runtime.h>
#include <stdint.h>
#include <stdio.h>

namespace cfg {
constexpr int D = 1024, NB = 4, SEQ = 4096, DEPTH = 4, CTX = 256, GW = 64;
constexpr int SB = CTX + SEQ;
constexpr int T = NB * SB;
constexpr int INW = 4560;
constexpr int C_DQ = 0, C_DKV = 256, C_KR = 384, C_RQ = 448, C_RK = 960, C_RV = 1472, C_RG = 1984, C_GQ = 2496, C_GK = 3008, C_GV = 3520, C_GZ = 4032, C_GA = 4544, C_GB = 4552;
constexpr int NE = 32, TOPK = 4, DE = 1024;
}
namespace fx {
using namespace cfg;
#define LAS __attribute__((address_space(3)))
typedef unsigned short bf16_t;
typedef short bf16x8 __attribute__((ext_vector_type(8)));
typedef short s16x4 __attribute__((ext_vector_type(4)));
typedef float f32x4 __attribute__((ext_vector_type(4)));
typedef float f32x16 __attribute__((ext_vector_type(16)));
typedef unsigned u32x4 __attribute__((ext_vector_type(4)));
typedef unsigned u32x2 __attribute__((ext_vector_type(2)));

__device__ __forceinline__ int opaque_tid() { int t = threadIdx.x; asm volatile("" : "+v"(t)); return t; }
#define TIDX opaque_tid()
__device__ __forceinline__ float shx(float v, int m) { const int ln = TIDX & 63; return __int_as_float(__builtin_amdgcn_ds_bpermute((ln ^ m) << 2, __float_as_int(v))); }
__device__ __forceinline__ int shxi(int v, int m) { const int ln = TIDX & 63; return __builtin_amdgcn_ds_bpermute((ln ^ m) << 2, v); }
__device__ __forceinline__ float shup(float v, int o) { const int ln = TIDX & 63; const int src = ln >= o ? ln - o : ln; return __int_as_float(__builtin_amdgcn_ds_bpermute(src << 2, __float_as_int(v))); }
__device__ __forceinline__ int shupi(int v, int o) { const int ln = TIDX & 63; const int src = ln >= o ? ln - o : ln; return __builtin_amdgcn_ds_bpermute(src << 2, v); }
__device__ __forceinline__ float shdn(float v, int o) { const int ln = TIDX & 63; const int src = ln + o < 64 ? ln + o : ln; return __int_as_float(__builtin_amdgcn_ds_bpermute(src << 2, __float_as_int(v))); }
constexpr int NTHREADS = 512, NWAVES = 8;
constexpr int BM = 256, BK = 64, HALF = 128, HTB = HALF * BK * 2, STAGE_BYTES = 8 * HTB, NXCD = 8, WGM = 8;
constexpr int LDS_MISC = STAGE_BYTES;
constexpr int LDS_BYTES = 163840;
constexpr int INWP = 4608;
constexpr int MLAN = 1792, MLAK = 384;
constexpr int MAXBLK = (T * TOPK) / 256 + NE;
constexpr int ROWS_P = MAXBLK * 256;

__device__ __forceinline__ unsigned cvt_pk_bf16(float lo, float hi) { unsigned r; asm volatile("v_cvt_pk_bf16_f32 %0, %1, %2" : "=v"(r) : "v"(lo), "v"(hi)); return r; }
__device__ __forceinline__ float bf2f(unsigned short b) { return __uint_as_float(((unsigned)b) << 16); }
__device__ __forceinline__ bf16_t f2bf(float f) { unsigned u = __float_as_uint(f); u += 0x7fffu + ((u >> 16) & 1u); return (bf16_t)(u >> 16); }
__device__ __forceinline__ float bflo(unsigned w) { return __uint_as_float(w << 16); }
__device__ __forceinline__ float bfhi(unsigned w) { return __uint_as_float(w & 0xffff0000u); }
__device__ __forceinline__ float silu_f(float v) { return v / (1.f + __expf(-v)); }
__device__ __forceinline__ int crow16(int r, int hi) { return (r & 3) + 8 * (r >> 2) + 4 * hi; }

__host__ __device__ __forceinline__ int lds_byte(int r, int c) { const int st = (r >> 4) * 2 + (c >> 5), rr = r & 15, cc = c & 31, ob = rr * 64 + cc * 2; return st * 1024 + (ob ^ (((ob >> 9) & 1) << 5)); }
__host__ __device__ __forceinline__ void stage_rc(int b, int& R, int& C) { const int st = b / 1024, sb = b % 1024, swz = sb ^ (((sb >> 9) & 1) << 5); R = (st >> 1) * 16 + swz / 64; C = (st & 1) * 32 + (swz % 64) / 2; }
__host__ __device__ __forceinline__ int perm32(int rho) { const int n = rho >> 4, i = rho & 15; return 8 * (i >> 2) + 4 * n + (i & 3); }

struct Unit { int pm, pn, e, pad_; long aoff, boff; };
struct Gemm { const bf16_t* A; const bf16_t* Bt; int M, N, K; };

struct StaticOrder {
    static constexpr bool DYN_A = false;
    int nM, nN, nwg, G, c, K;
    __device__ void init(int M, int N, int K_, int G_, int c_) { nM = M / BM; nN = N / BM; nwg = nM * nN; G = G_; c = c_; K = K_; }
    __device__ bool next(int i, Unit& u) const {
        const long L = (long)i * G + c; if (L >= nwg) return false;
        int wgid = (int)L; { const int q = nwg / NXCD, r = nwg % NXCD, xcd = wgid % NXCD, off = wgid / NXCD; wgid = (xcd < r ? xcd * (q + 1) : r * (q + 1) + (xcd - r) * q) + off; }
        const int nig = WGM * nN, gid = wgid / nig, fm = gid * WGM, gsz = (nM - fm) < WGM ? (nM - fm) : WGM;
        u.pm = fm + ((wgid % nig) % gsz); u.pn = (wgid % nig) / gsz; u.e = 0; u.pad_ = 0;
        u.aoff = (long)u.pm * BM * K * 2; u.boff = (long)u.pn * BM * K * 2; return true;
    }
    __device__ __forceinline__ void a_off(const Unit&, const int (&R)[2], const int (&C)[2], unsigned (&v)[2][2]) const {
#pragma unroll
        for (int h = 0; h < 2; ++h)
#pragma unroll
            for (int i = 0; i < 2; ++i) v[h][i] = (unsigned)((h * HALF + R[i]) * K + C[i]) * 2u;
    }
};
struct LatentOrder {
    static constexpr bool DYN_A = false;
    int nN, G, c, K;
    __device__ bool next(int i, Unit& u) const {
        const int L = i * G + c; if (L >= 64 * nN) return false;
        const int lt = L / nN; u.pn = L % nN; u.pm = (lt >> 4) * 17 + 1 + (lt & 15); u.e = 0; u.pad_ = 0;
        u.aoff = (long)u.pm * BM * K * 2; u.boff = (long)u.pn * BM * K * 2; return true;
    }
    __device__ __forceinline__ void a_off(const Unit&, const int (&R)[2], const int (&C)[2], unsigned (&v)[2][2]) const {
#pragma unroll
        for (int h = 0; h < 2; ++h)
#pragma unroll
            for (int i = 0; i < 2; ++i) v[h][i] = (unsigned)((h * HALF + R[i]) * K + C[i]) * 2u;
    }
};
template <bool GATHER> struct MoeOrder {
    static constexpr bool DYN_A = GATHER;
    int nblk, NPN, G, c, K; const LAS int* blk_e; const LAS int* blk_j; const LAS int* ulist; int* rowtok; int* cnt; long bstride;
    __device__ bool next(int i, Unit& u) const {
        if (i >= __builtin_amdgcn_readfirstlane(ulist[0])) return false;
        const int blk = __builtin_amdgcn_readfirstlane(ulist[1 + 2 * i]); u.pn = __builtin_amdgcn_readfirstlane(ulist[2 + 2 * i]); u.pm = blk; u.e = __builtin_amdgcn_readfirstlane(blk_e[blk]); u.pad_ = __builtin_amdgcn_readfirstlane(blk_j[blk]);
        u.aoff = GATHER ? 0 : (long)blk * BM * K * 2; u.boff = (long)u.e * bstride + (long)u.pn * BM * K * 2; return true;
    }
    __device__ __forceinline__ void a_off(const Unit& u, const int (&R)[2], const int (&C)[2], unsigned (&v)[2][2]) const {
        if (GATHER) { const int n = __hip_atomic_load(&cnt[u.e], __ATOMIC_RELAXED, __HIP_MEMORY_SCOPE_AGENT); const int* lst = rowtok + (size_t)u.e * T + u.pad_ * 256;
#pragma unroll
            for (int h = 0; h < 2; ++h)
#pragma unroll
                for (int i = 0; i < 2; ++i) { const int rr = h * HALF + R[i]; const int tok = (u.pad_ * 256 + rr < n) ? __hip_atomic_load(&lst[rr], __ATOMIC_RELAXED, __HIP_MEMORY_SCOPE_AGENT) : 0;     v[h][i] = (unsigned)(tok * K + C[i]) * 2u; }
        } else {
#pragma unroll
            for (int h = 0; h < 2; ++h)
#pragma unroll
                for (int i = 0; i < 2; ++i) v[h][i] = (unsigned)((h * HALF + R[i]) * K + C[i]) * 2u;
        }
    }
};

struct EpiInproj {
    static constexpr bool PERM = true;
    bf16_t* O; float* GAB;
    __device__ __forceinline__ void operator()(const f32x4 (&acc)[2][2][4][2], const Unit& u, int wr, int wc, int fr, int fq) const {
        const int row0 = u.pm * BM + wr * 64 + fr, col0 = u.pn * BM + wc * 32 + 8 * fq;
#pragma unroll
        for (int ai = 0; ai < 2; ++ai)
#pragma unroll
            for (int m = 0; m < 4; ++m) { const int row = row0 + ai * HALF + m * 16; bf16_t* rowp = O + (size_t)row * INWP + col0;
#pragma unroll
                for (int bj = 0; bj < 2; ++bj) { const f32x4 v0 = acc[ai][bj][m][0], v1 = acc[ai][bj][m][1];
                    u32x4 w; w.x = cvt_pk_bf16(v0[0], v0[1]); w.y = cvt_pk_bf16(v0[2], v0[3]); w.z = cvt_pk_bf16(v1[0], v1[1]); w.w = cvt_pk_bf16(v1[2], v1[3]);
                    *(u32x4*)(rowp + bj * HALF) = w; }
                if (u.pn == 17 && wc == 2 && fq < 2) { float* gp = GAB + (size_t)row * 16 + fq * 8; *(f32x4*)gp = acc[ai][1][m][0]; *(f32x4*)(gp + 4) = acc[ai][1][m][1]; } }
    }
};
struct EpiOutproj {
    static constexpr bool PERM = false;
    float* X; const float* MODl;
    __device__ __forceinline__ void operator()(const f32x4 (&acc)[2][2][4][2], const Unit& u, int wr, int wc, int fr, int fq) const {
        const int row0 = u.pm * BM + wr * 64 + fr, col0 = u.pn * BM + wc * 32 + 4 * fq; const int rmod = (u.pm % 17 == 0) ? 4 : u.pm / 17;
        const float* gt = MODl + (size_t)rmod * 6144 + 2048 + col0; f32x4 gv[2][2];
#pragma unroll
        for (int bj = 0; bj < 2; ++bj)
#pragma unroll
            for (int n = 0; n < 2; ++n) gv[bj][n] = *(const f32x4*)(gt + bj * HALF + n * 16);
#pragma unroll
        for (int ai = 0; ai < 2; ++ai)
#pragma unroll
            for (int m = 0; m < 4; ++m) { float* rowp = X + (size_t)(row0 + ai * HALF + m * 16) * D + col0;
#pragma unroll
                for (int bj = 0; bj < 2; ++bj)
#pragma unroll
                    for (int n = 0; n < 2; ++n) { f32x4* p = (f32x4*)(rowp + bj * HALF + n * 16); *p = *p + gv[bj][n] * acc[ai][bj][m][n]; } }
    }
};
struct EpiGateUp {
    static constexpr bool PERM = true;
    bf16_t* ACT; const float* bgu;
    __device__ __forceinline__ void operator()(const f32x4 (&acc)[2][2][4][2], const Unit& u, int wr, int wc, int fr, int fq) const {
        const int row0 = u.pm * BM + wr * 64 + fr, oc = u.pn * HALF + wc * 32 + 8 * fq; const float* bg = bgu + (size_t)u.e * 2048 + oc;
        f32x4 bgv[2], buv[2];
#pragma unroll
        for (int n = 0; n < 2; ++n) { bgv[n] = *(const f32x4*)(bg + 4 * n); buv[n] = *(const f32x4*)(bg + 1024 + 4 * n); }
#pragma unroll
        for (int ai = 0; ai < 2; ++ai)
#pragma unroll
            for (int m = 0; m < 4; ++m) { float o[8];
#pragma unroll
                for (int n = 0; n < 2; ++n) { const f32x4 gv = acc[ai][0][m][n] + bgv[n], uv = acc[ai][1][m][n] + buv[n];
#pragma unroll
                    for (int j = 0; j < 4; ++j) { const float gg = fminf(gv[j], 7.f), uu = fminf(fmaxf(uv[j], -7.f), 7.f); o[n * 4 + j] = (uu + 1.f) * gg / (1.f + __expf(-1.702f * gg)); } }
                u32x4 w; w.x = cvt_pk_bf16(o[0], o[1]); w.y = cvt_pk_bf16(o[2], o[3]); w.z = cvt_pk_bf16(o[4], o[5]); w.w = cvt_pk_bf16(o[6], o[7]);
                *(u32x4*)(ACT + (size_t)(row0 + ai * HALF + m * 16) * 1024 + oc) = w; }
    }
};
struct EpiDown {
    static constexpr bool PERM = true;
    bf16_t* YS; const float* bdn;
    __device__ __forceinline__ void operator()(const f32x4 (&acc)[2][2][4][2], const Unit& u, int wr, int wc, int fr, int fq) const {
        const int row0 = u.pm * BM + wr * 64 + fr, col0 = u.pn * BM + wc * 32 + 8 * fq; const float* bb = bdn + (size_t)u.e * 1024 + col0;
        f32x4 bv[2][2];
#pragma unroll
        for (int bj = 0; bj < 2; ++bj)
#pragma unroll
            for (int n = 0; n < 2; ++n) bv[bj][n] = *(const f32x4*)(bb + bj * HALF + 4 * n);
#pragma unroll
        for (int ai = 0; ai < 2; ++ai)
#pragma unroll
            for (int m = 0; m < 4; ++m) { bf16_t* rowp = YS + (size_t)(row0 + ai * HALF + m * 16) * 1024 + col0;
#pragma unroll
                for (int bj = 0; bj < 2; ++bj) { const f32x4 v0 = acc[ai][bj][m][0] + bv[bj][0], v1 = acc[ai][bj][m][1] + bv[bj][1];
                    u32x4 w; w.x = cvt_pk_bf16(v0[0], v0[1]); w.y = cvt_pk_bf16(v0[2], v0[3]); w.z = cvt_pk_bf16(v1[0], v1[1]); w.w = cvt_pk_bf16(v1[2], v1[3]);
                    *(u32x4*)(rowp + bj * HALF) = w; } }
    }
};

template <class Epi, class Sched>
__device__ __forceinline__ void gemm_phase(LAS unsigned char* lds, const Gemm g, const Sched& S, const Epi& E) {
    const int tid = TIDX, wid = __builtin_amdgcn_readfirstlane(tid >> 6), lane = tid & 63, wr = wid >> 2, wc = wid & 3, fr = lane & 15, fq = lane >> 4;
    const int K = g.K, nt = K / BK;
    int Rr[2], Cc[2]; unsigned voffB[2];
#pragma unroll
    for (int i = 0; i < 2; ++i) { int R, C; stage_rc(tid * 16 + i * 8192, R, C); Rr[i] = R; Cc[i] = C; const int Rb = Epi::PERM ? ((R & ~31) + perm32(R & 31)) : R; voffB[i] = (unsigned)(Rb * K + C) * 2u; }
    const size_t kstep = (size_t)(BK * 2);
    const size_t hstep = (size_t)HALF * K * 2;
    const unsigned ldsw = (unsigned)wid * 1024u;
    const int aoff = lds_byte(wr * 64 + fr, fq * 8), boff = lds_byte(wc * 32 + fr, fq * 8);
#define PG8_SA(b, h) (((b) * 2 + (h)) * HTB)
#define PG8_SB(b, h) ((4 + (b) * 2 + (h)) * HTB)
#define PG8_STAGE(bufoff, gbase, voff) do { _Pragma("unroll") for (int _i = 0; _i < 2; ++_i) \
        __builtin_amdgcn_global_load_lds((const unsigned*)((const char*)(gbase) + (voff)[_i]), (LAS unsigned*)(lds + (bufoff) + ldsw + _i * 8192), 16, 0, 0); } while (0)
#define PG8_LDA(dst, b, h) do { _Pragma("unroll") for (int m = 0; m < 4; ++m) _Pragma("unroll") for (int k = 0; k < 2; ++k) dst[m][k] = *(const LAS bf16x8*)(lds + PG8_SA(b, h) + aoff + m * 2048 + k * 1024); } while (0)
#define PG8_LDB(dst, b, h) do { _Pragma("unroll") for (int n = 0; n < 2; ++n) _Pragma("unroll") for (int k = 0; k < 2; ++k) dst[n][k] = *(const LAS bf16x8*)(lds + PG8_SB(b, h) + boff + n * 2048 + k * 1024); } while (0)
#define PG8_MMA(ai, bj, At, Bt) do { __builtin_amdgcn_s_setprio(1); _Pragma("unroll") for (int m = 0; m < 4; ++m) _Pragma("unroll") for (int n = 0; n < 2; ++n) _Pragma("unroll") for (int k = 0; k < 2; ++k) \
        acc[ai][bj][m][n] = __builtin_amdgcn_mfma_f32_16x16x32_bf16(Bt[n][k], At[m][k], acc[ai][bj][m][n], 0, 0, 0); __builtin_amdgcn_s_setprio(0); } while (0)
#define PG8_WAIT_V(n) asm volatile("s_waitcnt vmcnt(" #n ")" ::: "memory")
#define PG8_WAIT_L(n) asm volatile("s_waitcnt lgkmcnt(" #n ")" ::: "memory")
#define PG8_BAR __builtin_amdgcn_s_barrier()
#define PG8_SCHED __builtin_amdgcn_sched_barrier(0)
    Unit cur, nxt; int ui = 0;
    if (!S.next(0, cur)) return;
    f32x4 acc[2][2][4][2];
#pragma unroll
    for (int a = 0; a < 2; ++a)
#pragma unroll
        for (int b = 0; b < 2; ++b)
#pragma unroll
            for (int m = 0; m < 4; ++m)
#pragma unroll
                for (int n = 0; n < 2; ++n) acc[a][b][m][n] = (f32x4){0.f, 0.f, 0.f, 0.f};
    bf16x8 At[4][2], B0[2][2], B1[2][2];
    unsigned vAc[2][2], vAn[2][2];
    S.a_off(cur, Rr, Cc, vAc);
    const char* cA = (const char*)g.A + cur.aoff; const char* cB = (const char*)g.Bt + cur.boff;
    PG8_STAGE(PG8_SB(0, 0), cB, voffB); PG8_STAGE(PG8_SA(0, 0), cA, vAc[0]); PG8_STAGE(PG8_SB(0, 1), cB + hstep, voffB); PG8_STAGE(PG8_SA(0, 1), cA, vAc[1]);
    if (wr == 1) PG8_BAR;
    PG8_WAIT_V(4); PG8_BAR;
    PG8_STAGE(PG8_SB(1, 0), cB + kstep, voffB); PG8_STAGE(PG8_SA(1, 0), cA + kstep, vAc[0]); PG8_STAGE(PG8_SB(1, 1), cB + hstep + kstep, voffB);
    PG8_WAIT_V(6); PG8_BAR;
    for (;;) {
        const bool has_next = S.next(ui + 1, nxt);
        if (!Sched::DYN_A) { }
        else if (has_next) S.a_off(nxt, Rr, Cc, vAn);
        else {
#pragma unroll
            for (int h = 0; h < 2; ++h)
#pragma unroll
                for (int i = 0; i < 2; ++i) vAn[h][i] = vAc[h][i]; }
        const char* nA = has_next ? (const char*)g.A + nxt.aoff : cA; const char* nB = has_next ? (const char*)g.Bt + nxt.boff : cB;
#pragma unroll 1
        for (int t = 0; t < nt; t += 2) {
            const bool last = (t == nt - 2);
            const char* a1 = cA + (size_t)(t + 1) * kstep;
            const char* a2 = last ? nA : cA + (size_t)(t + 2) * kstep; const char* b2 = last ? nB : cB + (size_t)(t + 2) * kstep;
            const char* a3 = a2 + kstep; const char* b3 = b2 + kstep;
            unsigned w2[2][2];
#pragma unroll
            for (int h = 0; h < 2; ++h)
#pragma unroll
                for (int i = 0; i < 2; ++i) w2[h][i] = (Sched::DYN_A && last) ? vAn[h][i] : vAc[h][i];
            PG8_LDB(B0, 0, 0); PG8_SCHED; PG8_LDA(At, 0, 0); PG8_STAGE(PG8_SA(1, 1), a1, vAc[1]);
            PG8_WAIT_L(8); PG8_BAR; PG8_WAIT_L(0); PG8_MMA(0, 0, At, B0); PG8_BAR; PG8_SCHED;
            PG8_LDB(B1, 0, 1); PG8_STAGE(PG8_SB(0, 0), b2, voffB);
            PG8_BAR; PG8_WAIT_L(0); PG8_MMA(0, 1, At, B1); PG8_BAR;
            PG8_LDA(At, 0, 1); PG8_STAGE(PG8_SA(0, 0), a2, w2[0]);
            PG8_BAR; PG8_WAIT_L(0); PG8_MMA(1, 0, At, B0); PG8_BAR; PG8_SCHED;
            PG8_STAGE(PG8_SB(0, 1), b2 + hstep, voffB);
            PG8_WAIT_V(6); PG8_BAR; PG8_MMA(1, 1, At, B1); PG8_BAR;
            PG8_LDB(B0, 1, 0); PG8_SCHED; PG8_LDA(At, 1, 0); PG8_STAGE(PG8_SA(0, 1), a2, w2[1]);
            PG8_WAIT_L(8); PG8_BAR; PG8_WAIT_L(0); PG8_MMA(0, 0, At, B0); PG8_BAR; PG8_SCHED;
            PG8_LDB(B1, 1, 1); PG8_STAGE(PG8_SB(1, 0), b3, voffB);
            PG8_BAR; PG8_WAIT_L(0); PG8_MMA(0, 1, At, B1); PG8_BAR;
            PG8_LDA(At, 1, 1); PG8_STAGE(PG8_SA(1, 0), a3, w2[0]);
            PG8_BAR; PG8_WAIT_L(0); PG8_MMA(1, 0, At, B0); PG8_BAR; PG8_SCHED;
            PG8_STAGE(PG8_SB(1, 1), b3 + hstep, voffB);
            PG8_WAIT_V(6); PG8_BAR; PG8_MMA(1, 1, At, B1); PG8_BAR;
        }
        asm volatile("s_nop 9\n\ts_nop 9" : "+v"(acc[1][1][3][1]), "+v"(acc[1][1][3][0]), "+v"(acc[1][1][2][1]), "+v"(acc[1][1][2][0]));
        { int tz = TIDX; const int wz = tz >> 6, lz = tz & 63; E(acc, cur, wz >> 2, wz & 3, lz & 15, lz >> 4); }
        if (!has_next) break;
#pragma unroll
        for (int a = 0; a < 2; ++a)
#pragma unroll
            for (int b = 0; b < 2; ++b)
#pragma unroll
                for (int m = 0; m < 4; ++m)
#pragma unroll
                    for (int n = 0; n < 2; ++n) acc[a][b][m][n] = (f32x4){0.f, 0.f, 0.f, 0.f};
        cur = nxt; cA = nA; cB = nB; ++ui;
#pragma unroll
        for (int h = 0; h < 2; ++h)
#pragma unroll
            for (int i = 0; i < 2; ++i) if (Sched::DYN_A) vAc[h][i] = vAn[h][i];
    }
    PG8_WAIT_V(0);
    if (wr == 0) PG8_BAR;
    PG8_BAR;
#undef PG8_SA
#undef PG8_SB
#undef PG8_STAGE
#undef PG8_LDA
#undef PG8_LDB
#undef PG8_MMA
#undef PG8_WAIT_V
#undef PG8_WAIT_L
#undef PG8_BAR
#undef PG8_SCHED
}
struct FP {
  const float *x, *c, *ctx, *c_ctx, *w_mod, *b_mod, *g_norm1, *g_norm2, *w_in, *g_cq, *g_ckv, *w_uq, *w_ukv, *g_mla, *ret_decay, *g_ret, *gdn_conv, *gdn_a_log,
      *gdn_dt_bias, *g_gdn, *w_out, *w_router, *b_router, *w_gate_up, *b_gate_up, *w_down, *b_down, *g_final;
  float* out;
  unsigned* ctl; int* cnt;
  bf16_t *Wt_in, *Wt_mla, *Wt_out, *Wt_gu, *Wt_dn;
  float *MOD, *X, *GAB, *TOPW;
  bf16_t *Hb, *H2b, *Pb, *CATb, *ACTb, *YSb;
  int *TOPE, *TOPP, *ROWTOK;
  bf16_t *A2b, *Qb, *Knb, *Vb, *KRb, *AOb;
  bf16_t *RQb, *RKb, *RKWT, *RVTB, *RVTA, *RST;
  bf16_t *GQb, *GKb, *GVb, *GUT, *GWb, *GKTT, *GVNT, *GST;
  float *GG, *GBETA, *GLA; bf16_t* SCR; float* ROPE; bf16_t* WRF;
};
constexpr int CTL_WORDS = 4096 + DEPTH * 32 + DEPTH;

template <int MAP> __device__ __forceinline__ void tr_tile(const float* src, int lds_, int k0, int n0, int N, bf16_t* dst, int ldd, int kcol0, LAS float* tile) {
  const int t = TIDX;
#pragma unroll
  for (int i = 0; i < 2; ++i) { const int idx = t + 512 * i, k = idx >> 4, n4 = (idx & 15) * 4; f32x4 v = (f32x4){0.f, 0.f, 0.f, 0.f};
    if (n0 + n4 < N) v = *(const f32x4*)(src + (size_t)(k0 + k) * lds_ + n0 + n4);
    tile[k * 65 + n4 + 0] = v[0]; tile[k * 65 + n4 + 1] = v[1]; tile[k * 65 + n4 + 2] = v[2]; tile[k * 65 + n4 + 3] = v[3]; }
  __syncthreads();
  { const int n = t >> 3, k8 = (t & 7) * 8; float o[8];
#pragma unroll
    for (int j = 0; j < 8; ++j) o[j] = tile[(k8 + j) * 65 + n];
    u32x4 w; w.x = cvt_pk_bf16(o[0], o[1]); w.y = cvt_pk_bf16(o[2], o[3]); w.z = cvt_pk_bf16(o[4], o[5]); w.w = cvt_pk_bf16(o[6], o[7]);
    int gn = n0 + n, row;
    if (MAP == 1) { const int bj = gn >> 10, c = gn & 1023; row = (c >> 7) * 256 + bj * 128 + (c & 127); }
    else row = gn;
    *(u32x4*)(dst + (size_t)row * ldd + kcol0 + k0 + k8) = w; }
  __syncthreads();
}

__device__ void dense_weights_layer(const FP& p, int l, int b0, LAS unsigned char* lds) {
  LAS float* tile = (LAS float*)lds; int bid_ = (int)blockIdx.x; asm volatile("" : "+s"(bid_));
  const int me = bid_ - b0, nb = (int)gridDim.x - b0, t = TIDX; if (me < 0 || nb <= 0) return;
  __syncthreads();
  constexpr int L_IN = 16 * 72, L_OUT = 24 * 16, L_UQ = 4 * 12, L_UKV = 2 * 16;
  for (int id = me; id < L_IN + L_OUT + L_UQ + L_UKV; id += nb) { int r = id;
    if (r < L_IN) { const int kt = r / 72, nt = r % 72;
      tr_tile<0>(p.w_in + (size_t)l * 1024 * INW, INW, kt * 64, nt * 64, INW, p.Wt_in + (size_t)l * INWP * 1024, 1024, 0, tile); continue; }
    r -= L_IN;
    if (r < L_OUT) { const int kt = r / 16, nt = r % 16;
      tr_tile<0>(p.w_out + (size_t)l * 1536 * 1024, 1024, kt * 64, nt * 64, 1024, p.Wt_out + (size_t)l * 1024 * 1536, 1536, 0, tile); continue; }
    r -= L_OUT;
    if (r < L_UQ) { const int kt = r / 12, nt = r % 12;
      tr_tile<0>(p.w_uq + (size_t)l * 256 * 768, 768, kt * 64, nt * 64, 768, p.Wt_mla + (size_t)l * MLAN * MLAK, MLAK, 0, tile); continue; }
    r -= L_UQ;
    { const int kt = r / 16, nt = r % 16;
      tr_tile<0>(p.w_ukv + (size_t)l * 128 * 1024, 1024, kt * 64, nt * 64, 1024, p.Wt_mla + (size_t)l * MLAN * MLAK + (size_t)768 * MLAK, MLAK, 256, tile); } }
  { unsigned zz = 0u; asm volatile("" : "+v"(zz)); const u32x4 z = (u32x4){zz, zz, zz, zz};
    const int gtid = me * NTHREADS + t, gstr = nb * NTHREADS;
    for (int i = gtid; i < 768 * 16; i += gstr) { const int rr = i / 16, c8 = (i % 16) * 8; *(u32x4*)(p.Wt_mla + ((size_t)l * MLAN + rr) * MLAK + 256 + c8) = z; }
    for (int i = gtid; i < 1024 * 32; i += gstr) { const int rr = i / 32, c8 = (i % 32) * 8; *(u32x4*)(p.Wt_mla + ((size_t)l * MLAN + 768 + rr) * MLAK + c8) = z; } }
}

__device__ void ph_prologue(const FP& p, LAS unsigned char* lds) {
  const int G = gridDim.x, bid = blockIdx.x, t = TIDX;
  dense_weights_layer(p, 0, 0, lds);
  for (int i = bid * NTHREADS + t; i < DEPTH * 64 * 64; i += G * NTHREADS) { const int l = i >> 12, s = (i >> 6) & 63, ln = i & 63; u32x4 wh, wl; unsigned hh[8], ll[8];
#pragma unroll
    for (int jj = 0; jj < 8; ++jj) { const float w = p.w_router[((size_t)l * D + 16 * s + 8 * (ln >> 5) + jj) * NE + (ln & 31)]; unsigned u = __float_as_uint(w); u += 0x7fffu + ((u >> 16) & 1u); hh[jj] = u >> 16;
      const float res = w - __uint_as_float(hh[jj] << 16); unsigned v = __float_as_uint(res); v += 0x7fffu + ((v >> 16) & 1u); ll[jj] = v >> 16; }
    wh.x = hh[0] | (hh[1] << 16); wh.y = hh[2] | (hh[3] << 16); wh.z = hh[4] | (hh[5] << 16); wh.w = hh[6] | (hh[7] << 16); wl.x = ll[0] | (ll[1] << 16); wl.y = ll[2] | (ll[3] << 16); wl.z = ll[4] | (ll[5] << 16); wl.w = ll[6] | (ll[7] << 16);
    *(u32x4*)(p.WRF + ((size_t)(l * 2) * 64 * 64 + (s * 64 + ln)) * 8) = wh; *(u32x4*)(p.WRF + ((size_t)(l * 2 + 1) * 64 * 64 + (s * 64 + ln)) * 8) = wl; }
  if (bid == 0) for (int i = t; i < 64 * 16; i += NTHREADS) { const int pos = i >> 4, f = i & 15; const float ang = (float)pos * expf(-(float)f * (9.210340371976184f / 16.f)); p.ROPE[pos * 32 + f] = cosf(ang); p.ROPE[pos * 32 + 16 + f] = sinf(ang); }
  { LAS float* sc = (LAS float*)(lds + 32768);
    LAS float* part = (LAS float*)(lds + 32768 + 5 * 1024 * 4);
    __syncthreads();
    for (int i = t; i < 5 * 1024; i += NTHREADS) { const int r = i >> 10, k = i & 1023; const float v = r < 4 ? p.c[r * 1024 + k] : p.c_ctx[k]; sc[i] = v / (1.f + expf(-v)); }
    __syncthreads();
    for (int item = bid; item < DEPTH * 64; item += G) { const int l = item >> 6, c0 = (item & 63) * 96, col = t % 96, ks = t / 96;
      if (ks < 5) { float a[5] = {0.f, 0.f, 0.f, 0.f, 0.f}; const float* w = p.w_mod + (size_t)l * 1024 * 6144 + c0 + col; const int k0 = ks * 205, k1 = k0 + 205 < 1024 ? k0 + 205 : 1024;
#pragma unroll 8
        for (int k = k0; k < k1; ++k) { const float wv = w[(size_t)k * 6144];
#pragma unroll
          for (int r = 0; r < 5; ++r) a[r] += sc[r * 1024 + k] * wv; }
#pragma unroll
        for (int r = 0; r < 5; ++r) part[(ks * 96 + col) * 5 + r] = a[r]; }
      __syncthreads();
      if (t < 96) {
#pragma unroll
        for (int r = 0; r < 5; ++r) { float sm = 0.f;
#pragma unroll
          for (int q = 0; q < 5; ++q) sm += part[(q * 96 + t) * 5 + r];
          p.MOD[(size_t)(l * 5 + r) * 6144 + c0 + t] = sm + p.b_mod[l * 6144 + c0 + t]; } }
      __syncthreads(); } }
}

template <int step = 1, int off = 0, int B1 = 1 << 30> __device__ void moe_weights_layer(const FP& p, int l, int t0, int t1, int b0, LAS unsigned char* lds) {
  int bid_ = (int)blockIdx.x; asm volatile("" : "+s"(bid_));
  LAS float* tile = (LAS float*)lds; const int me0 = bid_ - b0; if (me0 < 0 || bid_ >= B1 || (step > 1 && (me0 & (step - 1)) != off)) return;
  const int gtop = (int)gridDim.x < B1 ? (int)gridDim.x : B1;
  int me = step > 1 ? me0 >> (step == 2 ? 1 : 2) : me0; const int nb = step > 1 ? (gtop - b0 - off + step - 1) >> (step == 2 ? 1 : 2) : gtop - b0; if (nb <= 0) return;
  const int t = TIDX;
  auto src_of = [&](int sid, int& ld) -> const float* { const int id = sid * 4;
    if (id < NE * 512) { const int m = l * NE + id / 512, tt = id % 512, kt = tt / 32, nt = tt % 32; ld = 2048; return p.w_gate_up + (size_t)m * 1024 * 2048 + (size_t)(kt * 64) * 2048 + nt * 64; }
    const int r = id - NE * 512; const int m = l * NE + r / 256, tt = r % 256, kt = tt / 16, nt = tt % 16; ld = 1024; return p.w_down + (size_t)m * 1024 * 1024 + (size_t)(kt * 64) * 1024 + nt * 64; };
  auto load_strip = [&](int sid, f32x4 (&v)[8]) { int ld; const float* src = src_of(sid, ld);
#pragma unroll
    for (int i = 0; i < 8; ++i) { const int idx = t + 512 * i, tb = idx >> 10, q = idx & 1023, k = q >> 4, n4 = (q & 15) * 4; v[i] = *(const f32x4*)((const char*)src + (unsigned)(k * ld + tb * 64 + n4) * 4u); } };
  __syncthreads();
  const int s0 = t0 / 4 + me, s1 = t1 / 4;
  auto process = [&](int sid, const f32x4 (&v)[8]) {
#pragma unroll
    for (int i = 0; i < 8; ++i) { const int idx = t + 512 * i, tb = idx >> 10, q = idx & 1023, k = q >> 4, n4 = (q & 15) * 4; LAS float* tp = tile + tb * (64 * 65) + k * 65 + n4;
      tp[0] = v[i][0]; tp[1] = v[i][1]; tp[2] = v[i][2]; tp[3] = v[i][3]; }
    __syncthreads();
    { const int id = sid * 4, n = t >> 3, k8 = (t & 7) * 8;
      const bool gu = id < NE * 512; const int r = gu ? id : id - NE * 512; const int m = l * NE + (gu ? r / 512 : r / 256), tt = gu ? r % 512 : r % 256, kt = gu ? tt / 32 : tt / 16, nt = gu ? tt % 32 : tt % 16;
      bf16_t* dst = gu ? p.Wt_gu + (size_t)m * 2048 * 1024 : p.Wt_dn + (size_t)m * 1024 * 1024;
#pragma unroll
      for (int tb = 0; tb < 4; ++tb) { float o[8];
#pragma unroll
        for (int j = 0; j < 8; ++j) o[j] = tile[tb * (64 * 65) + (k8 + j) * 65 + n];
        u32x4 w; w.x = cvt_pk_bf16(o[0], o[1]); w.y = cvt_pk_bf16(o[2], o[3]); w.z = cvt_pk_bf16(o[4], o[5]); w.w = cvt_pk_bf16(o[6], o[7]);
        const int gn = (nt + tb) * 64 + n; int row;
        if (gu) { const int bj = gn >> 10, c = gn & 1023; row = (c >> 7) * 256 + bj * 128 + (c & 127); }
        else row = gn;
        *(u32x4*)((char*)dst + (unsigned)(row * 1024 + kt * 64 + k8) * 2u) = w; } }
    __syncthreads(); };
  f32x4 va[8], vb[8];
  if (s0 < s1) load_strip(s0, va);
#pragma unroll 1
  for (int sid = s0; sid < s1; sid += 2 * nb) {
    if (sid + nb < s1) load_strip(sid + nb, vb);
    process(sid, va);
    if (sid + nb >= s1) break;
    if (sid + 2 * nb < s1) load_strip(sid + 2 * nb, va);
    process(sid + nb, vb); }
}

__device__ void moe_weights_dyn(const FP& p, int l, int ns, LAS unsigned char* lds) {
  LAS float* tile = (LAS float*)lds; LAS int* sh = (LAS int*)(lds + 4 * 64 * 65 * 4); const int t = TIDX;
  int* ctr = (int*)p.ctl + 4096 + DEPTH * 32 + l;
  auto src_of = [&](int sid, int& ld) -> const float* { const int id = sid * 4;
    if (id < NE * 512) { const int m = l * NE + id / 512, tt = id % 512, kt = tt / 32, nt = tt % 32; ld = 2048; return p.w_gate_up + (size_t)m * 1024 * 2048 + (size_t)(kt * 64) * 2048 + nt * 64; }
    const int r = id - NE * 512; const int m = l * NE + r / 256, tt = r % 256, kt = tt / 16, nt = tt % 16; ld = 1024; return p.w_down + (size_t)m * 1024 * 1024 + (size_t)(kt * 64) * 1024 + nt * 64; };
  auto load_strip = [&](int sid, f32x4 (&v)[8]) { int ld; const float* src = src_of(sid, ld);
#pragma unroll
    for (int i = 0; i < 8; ++i) { const int idx = t + 512 * i, tb = idx >> 10, q = idx & 1023, k = q >> 4, n4 = (q & 15) * 4; v[i] = *(const f32x4*)((const char*)src + (unsigned)(k * ld + tb * 64 + n4) * 4u); } };
  auto process = [&](int sid, const f32x4 (&v)[8], int slot) -> int {
#pragma unroll
    for (int i = 0; i < 8; ++i) { const int idx = t + 512 * i, tb = idx >> 10, q = idx & 1023, k = q >> 4, n4 = (q & 15) * 4; LAS float* tp = tile + tb * (64 * 65) + k * 65 + n4;
      tp[0] = v[i][0]; tp[1] = v[i][1]; tp[2] = v[i][2]; tp[3] = v[i][3]; }
    __syncthreads();
    const int got = sh[slot];
    { const int id = sid * 4, n = t >> 3, k8 = (t & 7) * 8;
      const bool gu = id < NE * 512; const int r = gu ? id : id - NE * 512; const int m = l * NE + (gu ? r / 512 : r / 256), tt = gu ? r % 512 : r % 256, kt = gu ? tt / 32 : tt / 16, nt = gu ? tt % 32 : tt % 16;
      bf16_t* dst = gu ? p.Wt_gu + (size_t)m * 2048 * 1024 : p.Wt_dn + (size_t)m * 1024 * 1024;
#pragma unroll
      for (int tb = 0; tb < 4; ++tb) { float o[8];
#pragma unroll
        for (int j = 0; j < 8; ++j) o[j] = tile[tb * (64 * 65) + (k8 + j) * 65 + n];
        u32x4 w; w.x = cvt_pk_bf16(o[0], o[1]); w.y = cvt_pk_bf16(o[2], o[3]); w.z = cvt_pk_bf16(o[4], o[5]); w.w = cvt_pk_bf16(o[6], o[7]);
        const int gn = (nt + tb) * 64 + n; int row;
        if (gu) { const int bj = gn >> 10, c = gn & 1023; row = (c >> 7) * 256 + bj * 128 + (c & 127); }
        else row = gn;
        *(u32x4*)((char*)dst + (unsigned)(row * 1024 + kt * 64 + k8) * 2u) = w; } }
    __syncthreads();
    return got; };
  __syncthreads();
  int pend = 0;
  if (t == 0) { sh[0] = atomicAdd(ctr, 1); sh[1] = atomicAdd(ctr, 1); pend = atomicAdd(ctr, 1); }
  __syncthreads();
  int s_cur = sh[0], s_nxt = sh[1];
  f32x4 va[8], vb[8];
  if (s_cur < ns) load_strip(s_cur, va);
#pragma unroll 1
  while (s_cur < ns) {
    if (s_nxt < ns) load_strip(s_nxt, vb);
    if (t == 0) { sh[2] = pend; pend = atomicAdd(ctr, 1); }
    const int s2 = process(s_cur, va, 2);
    if (s_nxt >= ns) break;
    if (s2 < ns) load_strip(s2, va);
    if (t == 0) { sh[3] = pend; pend = atomicAdd(ctr, 1); }
    const int s3 = process(s_nxt, vb, 3);
    s_cur = s2; s_nxt = s3; }
  __syncthreads();
}

struct MoeTab { LAS int* blk_e; LAS int* blk_j; LAS int* start; int nblk; };
__device__ __forceinline__ MoeTab moe_tables(const int* cntl, LAS unsigned char* misc) {
  MoeTab m; m.blk_e = (LAS int*)misc; m.blk_j = m.blk_e + MAXBLK; m.start = m.blk_j + MAXBLK;
  const int t = TIDX;
  __syncthreads();
  if (t < 64) { const int e = t & 31; const int nb = (__hip_atomic_load(&cntl[e], __ATOMIC_RELAXED, __HIP_MEMORY_SCOPE_AGENT) + 255) >> 8; int incl = nb;
#pragma unroll
    for (int o = 1; o < 32; o <<= 1) { const int v = shupi(incl, o); if ((t & 31) >= o) incl += v; }
    if (t < 32) { m.start[e] = incl - nb; if (e == 31) m.start[32] = incl; } }
  __syncthreads();
  m.nblk = m.start[32];
  for (int blk = t; blk < m.nblk; blk += NTHREADS) { int e = 0;
    while (m.start[e + 1] <= blk) ++e;
    m.blk_e[blk] = e; m.blk_j[blk] = blk - m.start[e]; }
  __syncthreads();
  return m;
}

__device__ __forceinline__ LAS int* moe_unit_list(const MoeTab& m, int NPN) {
  LAS int* ul = m.start + 40; const int t = TIDX;
  if (t < 32) { const int q = t * (int)gridDim.x + (int)blockIdx.x; const bool ok = q < m.nblk * NPN;
    if (ok) { ul[1 + 2 * t] = q / NPN; ul[2 + 2 * t] = q % NPN; }
    const unsigned long long bal = __ballot(ok); if (t == 0) ul[0] = __popcll(bal); }
  __syncthreads();
  return ul;
}

__device__ __forceinline__ float dpp_add(float v, int ctrl_is) { return v; }
#define DPP_F(v, ctrl) __int_as_float(__builtin_amdgcn_update_dpp(0, __float_as_int(v), (ctrl), 0xf, 0xf, false))
__device__ __forceinline__ float wave_sum(float v) {
  v += DPP_F(v, 0xB1); v += DPP_F(v, 0x4E); v += DPP_F(v, 0x141); v += DPP_F(v, 0x140);
  const float r0 = __uint_as_float(__builtin_amdgcn_readlane(__float_as_uint(v), 0)), r1 = __uint_as_float(__builtin_amdgcn_readlane(__float_as_uint(v), 16));
  const float r2 = __uint_as_float(__builtin_amdgcn_readlane(__float_as_uint(v), 32)), r3 = __uint_as_float(__builtin_amdgcn_readlane(__float_as_uint(v), 48));
  return (r0 + r1) + (r2 + r3); }

__device__ __forceinline__ void moe_combine_row(const FP& p, int lprev, int row, const LAS int* start, const float* gate, int lane, f32x4 (&x)[4]) {
  int sl[4]; float w[4];
#pragma unroll
  for (int k = 0; k < 4; ++k) { const int e = p.TOPE[row * 4 + k]; sl[k] = start[e] * 256 + p.TOPP[row * 4 + k]; w[k] = p.TOPW[row * 4 + k]; }
#pragma unroll
  for (int i = 0; i < 4; ++i) { f32x4 y = (f32x4){0.f, 0.f, 0.f, 0.f};
#pragma unroll
    for (int k = 0; k < 4; ++k) { const u32x2 v = *(const u32x2*)(p.YSb + (size_t)sl[k] * 1024 + i * 256 + lane * 4);
      y[0] += w[k] * bflo(v.x); y[1] += w[k] * bfhi(v.x); y[2] += w[k] * bflo(v.y); y[3] += w[k] * bfhi(v.y); }
    const f32x4 g = *(const f32x4*)(gate + i * 256 + lane * 4); x[i] = x[i] + g * y; }
}

template <bool DRY = false> __device__ void ph_norm1(const FP& p, int l, LAS unsigned char* lds) {
  const int t = TIDX, lane = t & 63, gw = blockIdx.x * NWAVES + (t >> 6), GWN = gridDim.x * NWAVES;
  MoeTab mt{}; if (l > 0) mt = moe_tables(p.cnt + (l - 1) * 32, lds + LDS_MISC);
  const float* MODl = p.MOD + (size_t)l * 5 * 6144; const float* MODp = p.MOD + (size_t)(l > 0 ? l - 1 : 0) * 5 * 6144; const float* g1 = p.g_norm1 + l * D;
  for (int row = gw; row < T; row += GWN) { const int b = row / SB, s = row % SB, r = s < CTX ? 4 : b;
    f32x4 x[4];
    { const float* src = l > 0 ? p.X + (size_t)row * D : (s < CTX ? p.ctx + ((size_t)b * CTX + s) * D : p.x + ((size_t)b * SEQ + (s - CTX)) * D);
#pragma unroll
      for (int i = 0; i < 4; ++i) x[i] = *(const f32x4*)(src + i * 256 + lane * 4); }
    if (l > 0) moe_combine_row(p, l - 1, row, mt.start, MODp + (size_t)r * 6144 + 5120, lane, x);
    if (!DRY) {
#pragma unroll
      for (int i = 0; i < 4; ++i) *(f32x4*)(p.X + (size_t)row * D + i * 256 + lane * 4) = x[i]; }
    float ss = 0.f;
#pragma unroll
    for (int i = 0; i < 4; ++i) ss += x[i][0] * x[i][0] + x[i][1] * x[i][1] + x[i][2] * x[i][2] + x[i][3] * x[i][3];
    ss = wave_sum(ss); const float rs = rsqrtf(ss * (1.f / 1024.f) + 1e-6f);
    const float* m = MODl + (size_t)r * 6144;
#pragma unroll
    for (int i = 0; i < 4; ++i) { const int c = i * 256 + lane * 4; const f32x4 g = *(const f32x4*)(g1 + c), sc = *(const f32x4*)(m + 1024 + c), sh = *(const f32x4*)(m + c);
      const f32x4 h = x[i] * rs * g * (sc + 1.f) + sh; u32x2 w; w.x = cvt_pk_bf16(h[0], h[1]); w.y = cvt_pk_bf16(h[2], h[3]);
      *(u32x2*)((DRY ? p.SCR : p.Hb) + (size_t)row * D + c) = w; } }
}

template <bool DRY = false> __device__ void ph_norm2(const FP& p, int l, LAS unsigned char* lds) {
  const int t = TIDX, lane = t & 63, gw = blockIdx.x * NWAVES + (t >> 6), GWN = gridDim.x * NWAVES;
  LAS float* wT = (LAS float*)lds;
  __syncthreads();
  { const float* wr = p.w_router + (size_t)l * D * NE;
    for (int i = t; i < D * NE / 4; i += NTHREADS) { const int c = i >> 3, e4 = (i & 7) * 4; const f32x4 v = *(const f32x4*)(wr + (size_t)c * NE + e4);
      wT[(e4 + 0) * 1024 + c] = v[0]; wT[(e4 + 1) * 1024 + c] = v[1]; wT[(e4 + 2) * 1024 + c] = v[2]; wT[(e4 + 3) * 1024 + c] = v[3]; } }
  __syncthreads();
  const float* MODl = p.MOD + (size_t)l * 5 * 6144; const float* g2 = p.g_norm2 + l * D; int* cntl = p.cnt + l * 32;
  const float myb = p.b_router[l * NE + (lane >> 1)];
  for (int row = gw; row < T; row += GWN) { const int b = row / SB, s = row % SB, r = s < CTX ? 4 : b;
    if (l == DEPTH - 1 && s < CTX) continue;
    f32x4 h[4]; float ss = 0.f;
#pragma unroll
    for (int i = 0; i < 4; ++i) { h[i] = *(const f32x4*)(p.X + (size_t)row * D + i * 256 + lane * 4); ss += h[i][0] * h[i][0] + h[i][1] * h[i][1] + h[i][2] * h[i][2] + h[i][3] * h[i][3]; }
    ss = wave_sum(ss); const float rs = rsqrtf(ss * (1.f / 1024.f) + 1e-6f);
    const float* m = MODl + (size_t)r * 6144;
#pragma unroll
    for (int i = 0; i < 4; ++i) { const int c = i * 256 + lane * 4; const f32x4 g = *(const f32x4*)(g2 + c), sc = *(const f32x4*)(m + 4096 + c), sh = *(const f32x4*)(m + 3072 + c);
      h[i] = h[i] * rs * g * (sc + 1.f) + sh; u32x2 w; w.x = cvt_pk_bf16(h[i][0], h[i][1]); w.y = cvt_pk_bf16(h[i][2], h[i][3]);
      *(u32x2*)((DRY ? p.SCR : p.H2b) + (size_t)row * D + c) = w; }
#ifdef PROBE_NOROUTER
    if (DRY) continue;
#endif
    float acc[32];
#pragma unroll
    for (int e = 0; e < 32; ++e) { float a = 0.f;
#pragma unroll
      for (int i = 0; i < 4; ++i) { const f32x4 w = *(const LAS f32x4*)(wT + e * 1024 + i * 256 + lane * 4); a += h[i][0] * w[0] + h[i][1] * w[1] + h[i][2] * w[2] + h[i][3] * w[3]; }
      acc[e] = a; }
#define BFLY(NV, BIT) { const bool up = (lane >> (BIT)) & 1; _Pragma("unroll") for (int e = 0; e < (NV) / 2; ++e) { const float a = acc[e], bq = acc[e + (NV) / 2]; const float keep = up ? bq : a, send = up ? a : bq; acc[e] = keep + shx(send, 1 << (BIT)); } }
    BFLY(32, 5) BFLY(16, 4) BFLY(8, 3) BFLY(4, 2) BFLY(2, 1)
#undef BFLY
    float v = acc[0] + shx(acc[0], 1); v += myb;
    float lg[32];
#pragma unroll
    for (int e = 0; e < 32; ++e) lg[e] = __uint_as_float(__builtin_amdgcn_readlane(__float_as_uint(v), 2 * e));
    float tv[4]; int ti[4];
#pragma unroll
    for (int k = 0; k < 4; ++k) { float bv = -3.0e38f; int bi = 0;
#pragma unroll
      for (int e = 0; e < 32; ++e) { if (lg[e] > bv) { bv = lg[e]; bi = e; } }
      tv[k] = bv; ti[k] = bi;
#pragma unroll
      for (int e = 0; e < 32; ++e) if (e == bi) lg[e] = -3.0e38f; }
    if (lane == 0) { float e4[4], sum = 0.f;
#pragma unroll
      for (int k = 0; k < 4; ++k) { e4[k] = expf(tv[k] - tv[0]); sum += e4[k]; }
      const float inv = 1.f / sum;
#pragma unroll
      for (int k = 0; k < 4; ++k) { if (DRY) { ((float*)p.SCR)[(size_t)T * 512 + row * 4 + k] = e4[k] * inv + (float)ti[k]; continue; } const int pos = atomicAdd(&cntl[ti[k]], 1); p.TOPE[row * 4 + k] = ti[k]; p.TOPP[row * 4 + k] = pos; p.TOPW[row * 4 + k] = e4[k] * inv; __hip_atomic_store(&p.ROWTOK[(size_t)ti[k] * T + pos], row, __ATOMIC_RELAXED, __HIP_MEMORY_SCOPE_AGENT);     } } }
}

__device__ void ph_final(const FP& p, LAS unsigned char* lds) {
  const int t = TIDX, lane = t & 63, gw = blockIdx.x * NWAVES + (t >> 6), GWN = gridDim.x * NWAVES;
  MoeTab mt = moe_tables(p.cnt + (DEPTH - 1) * 32, lds + LDS_MISC);
  const float* MODp = p.MOD + (size_t)(DEPTH - 1) * 5 * 6144;
  for (int orow = gw; orow < NB * SEQ; orow += GWN) { const int b = orow / SEQ, tk = orow % SEQ, row = b * SB + CTX + tk;
    f32x4 x[4];
#pragma unroll
    for (int i = 0; i < 4; ++i) x[i] = *(const f32x4*)(p.X + (size_t)row * D + i * 256 + lane * 4);
    moe_combine_row(p, DEPTH - 1, row, mt.start, MODp + (size_t)b * 6144 + 5120, lane, x);
    float ss = 0.f;
#pragma unroll
    for (int i = 0; i < 4; ++i) ss += x[i][0] * x[i][0] + x[i][1] * x[i][1] + x[i][2] * x[i][2] + x[i][3] * x[i][3];
    ss = wave_sum(ss); const float rs = rsqrtf(ss * (1.f / 1024.f) + 1e-6f);
#pragma unroll
    for (int i = 0; i < 4; ++i) { const int c = i * 256 + lane * 4; const f32x4 g = *(const f32x4*)(p.g_final + c); *(f32x4*)(p.out + (size_t)orow * D + c) = x[i] * rs * g; } }
}

__device__ void ph_inproj(const FP& p, int l, LAS unsigned char* lds) {
  Gemm g; g.A = p.Hb; g.Bt = p.Wt_in + (size_t)l * INWP * 1024; g.M = T; g.N = INWP; g.K = 1024;
  StaticOrder S; S.init(T, INWP, 1024, gridDim.x, blockIdx.x); EpiInproj E; E.O = p.Pb; E.GAB = p.GAB;
  gemm_phase<EpiInproj, StaticOrder>(lds, g, S, E);
}
__device__ void outproj_ctx(const FP& p, int l, LAS unsigned char* lds) {
  const int t = TIDX, w = t >> 6, lane = t & 63, c32 = lane & 31, hi = lane >> 5;
  const bf16_t* Bt = p.Wt_out + (size_t)l * 1024 * 1536; const float* gate = p.MOD + (size_t)l * 5 * 6144 + 4 * 6144 + 2048;
  LAS float* lf = (LAS float*)lds;
  for (int u = blockIdx.x; u < 256; u += gridDim.x) { const int cu = u >> 4, st = u & 15, batch = cu >> 2, pn = cu & 3, sr = st >> 2, sc = st & 3;
    const int r0 = batch * SB + 64 * sr, c0 = pn * 256 + 64 * sc;
    const bf16_t* ap = p.CATb + (size_t)(r0 + c32) * 1536 + 192 * w + 8 * hi; const bf16_t* bp = Bt + (size_t)(c0 + c32) * 1536 + 192 * w + 8 * hi;
    f32x16 acc[2][2];
#pragma unroll
    for (int m = 0; m < 2; ++m)
#pragma unroll
      for (int n = 0; n < 2; ++n)
#pragma unroll
        for (int r = 0; r < 16; ++r) acc[m][n][r] = 0.f;
#pragma unroll
    for (int sg = 0; sg < 3; ++sg) { bf16x8 af[2][4], bfr[2][4];
#pragma unroll
      for (int s = 0; s < 4; ++s)
#pragma unroll
        for (int m = 0; m < 2; ++m) { af[m][s] = *(const bf16x8*)(ap + (size_t)m * 32 * 1536 + (sg * 4 + s) * 16); bfr[m][s] = *(const bf16x8*)(bp + (size_t)m * 32 * 1536 + (sg * 4 + s) * 16); }
#pragma unroll
      for (int s = 0; s < 4; ++s)
#pragma unroll
        for (int m = 0; m < 2; ++m)
#pragma unroll
          for (int n = 0; n < 2; ++n) acc[m][n] = __builtin_amdgcn_mfma_f32_32x32x16_bf16(af[m][s], bfr[n][s], acc[m][n], 0, 0, 0); }
    __syncthreads();
#pragma unroll
    for (int m = 0; m < 2; ++m)
#pragma unroll
      for (int n = 0; n < 2; ++n)
#pragma unroll
        for (int r = 0; r < 16; ++r) lf[w * 4096 + (32 * m + crow16(r, hi)) * 64 + 32 * n + c32] = acc[m][n][r];
    __syncthreads();
    { const int row = t >> 3, col = (t & 7) * 8; f32x4 s0 = (f32x4){0.f, 0.f, 0.f, 0.f}, s1 = s0;
#pragma unroll
      for (int ww = 0; ww < 8; ++ww) { s0 = s0 + *(const LAS f32x4*)(lf + ww * 4096 + row * 64 + col); s1 = s1 + *(const LAS f32x4*)(lf + ww * 4096 + row * 64 + col + 4); }
      const f32x4 g0 = *(const f32x4*)(gate + c0 + col), g1 = *(const f32x4*)(gate + c0 + col + 4);
      float* xp = p.X + (size_t)(r0 + row) * D + c0 + col;
      *(f32x4*)xp = *(const f32x4*)xp + g0 * s0; *(f32x4*)(xp + 4) = *(const f32x4*)(xp + 4) + g1 * s1; }
    __syncthreads(); }
}
__device__ void ph_outproj(const FP& p, int l, LAS unsigned char* lds) {
  Gemm g; g.A = p.CATb; g.Bt = p.Wt_out + (size_t)l * 1024 * 1536; g.M = T; g.N = 1024; g.K = 1536;
  EpiOutproj E; E.X = p.X; E.MODl = p.MOD + (size_t)l * 5 * 6144;
  { LatentOrder S; S.nN = 4; S.G = gridDim.x; S.c = blockIdx.x; S.K = 1536; gemm_phase<EpiOutproj, LatentOrder>(lds, g, S, E); }
  if (l != DEPTH - 1) outproj_ctx(p, l, lds);
}
__device__ void ph_gemm1(const FP& p, int l, LAS unsigned char* lds) {
  MoeTab mt = moe_tables(p.cnt + l * 32, lds + LDS_MISC);
  Gemm g; g.A = p.H2b; g.Bt = p.Wt_gu + (size_t)l * NE * 2048 * 1024; g.M = 0; g.N = 2048; g.K = 1024;
  MoeOrder<true> S; S.nblk = mt.nblk; S.NPN = 8; S.G = gridDim.x; S.c = blockIdx.x; S.K = 1024; S.blk_e = mt.blk_e; S.blk_j = mt.blk_j; S.ulist = moe_unit_list(mt, 8); S.rowtok = p.ROWTOK; S.cnt = p.cnt + l * 32; S.bstride = (long)2048 * 1024 * 2;
  EpiGateUp E; E.ACT = p.ACTb; E.bgu = p.b_gate_up + (size_t)l * NE * 2048;
  gemm_phase<EpiGateUp, MoeOrder<true>>(lds, g, S, E);
}
__device__ void ph_gemm2(const FP& p, int l, LAS unsigned char* lds) {
  MoeTab mt = moe_tables(p.cnt + l * 32, lds + LDS_MISC);
  Gemm g; g.A = p.ACTb; g.Bt = p.Wt_dn + (size_t)l * NE * 1024 * 1024; g.M = 0; g.N = 1024; g.K = 1024;
  MoeOrder<false> S; S.nblk = mt.nblk; S.NPN = 4; S.G = gridDim.x; S.c = blockIdx.x; S.K = 1024; S.blk_e = mt.blk_e; S.blk_j = mt.blk_j; S.ulist = moe_unit_list(mt, 4); S.rowtok = nullptr; S.cnt = p.cnt + l * 32; S.bstride = (long)1024 * 1024 * 2;
  EpiDown E; E.YS = p.YSb; E.bdn = p.b_down + (size_t)l * NE * 1024;
  gemm_phase<EpiDown, MoeOrder<false>>(lds, g, S, E);
}
constexpr float QSCALE = 0.07216878364870322f * 1.4426950408889634f;

__device__ __forceinline__ void prep_mla_row(const FP& p, int l, int row, int lane) {
  const int s = row % SB; const bool lat = s >= CTX; const int tok = s - CTX;
  const bf16_t* pr = p.Pb + (size_t)row * INWP;
  { const u32x2 v = *(const u32x2*)(pr + C_DQ + lane * 4); float x[4] = {bflo(v.x), bfhi(v.x), bflo(v.y), bfhi(v.y)};
    const float ss = wave_sum(x[0] * x[0] + x[1] * x[1] + x[2] * x[2] + x[3] * x[3]); const float rs = rsqrtf(ss * (1.f / 256.f) + 1e-6f);
    const f32x4 g = *(const f32x4*)(p.g_cq + l * 256 + lane * 4); u32x2 w; w.x = cvt_pk_bf16(x[0] * rs * g[0], x[1] * rs * g[1]); w.y = cvt_pk_bf16(x[2] * rs * g[2], x[3] * rs * g[3]);
    *(u32x2*)(p.A2b + (size_t)row * MLAK + lane * 4) = w; }
  { const unsigned v = *(const unsigned*)(pr + C_DKV + lane * 2); const float x0 = bflo(v), x1 = bfhi(v);
    const float ss = wave_sum(x0 * x0 + x1 * x1); const float rs = rsqrtf(ss * (1.f / 128.f) + 1e-6f);
    const float g0 = p.g_ckv[l * 128 + lane * 2], g1 = p.g_ckv[l * 128 + lane * 2 + 1];
    *(unsigned*)(p.A2b + (size_t)row * MLAK + 256 + lane * 2) = cvt_pk_bf16(x0 * rs * g0, x1 * rs * g1); }
  { const float x = bf2f(pr[C_KR + lane]); const float xp = shx(x, 16); float y = x;
    if (lat) { const int hh = lane >> 5, ii = lane & 31, fi = ii & 15; const float pos = (float)(hh == 0 ? (tok >> 6) : (tok & 63));
      const float ang = pos * __expf(-(float)fi * (9.210340371976184f / 16.f)); const float cs = __cosf(ang), sn = __sinf(ang);
      y = ii < 16 ? x * cs - xp * sn : x * cs + xp * sn; }
    unsigned u = __float_as_uint(y); u += 0x7fffu + ((u >> 16) & 1u); p.KRb[(size_t)row * 64 + lane] = (bf16_t)(u >> 16); }
}

struct EpiMla {
    static constexpr bool PERM = false;
    bf16_t *Q, *Kn, *V; const float* ROPE;
    __device__ __forceinline__ void operator()(const f32x4 (&acc)[2][2][4][2], const Unit& u, int wr, int wc, int fr, int fq) const {
        const int row0 = u.pm * BM + wr * 64 + fr; const bool ctxt = (u.pm % 17) == 0; const int tok0 = (u.pm % 17 - 1) * 256 + wr * 64 + fr;
        if (u.pn < 3) {
#pragma unroll
            for (int bj = 0; bj < 2; ++bj) { const int cg = u.pn * 256 + bj * 128 + wc * 32;
                const int g6 = (cg >> 5) % 6;
#pragma unroll
                for (int ai = 0; ai < 2; ++ai)
#pragma unroll
                    for (int m = 0; m < 4; ++m) { const int row = row0 + ai * HALF + m * 16; f32x4 v0 = acc[ai][bj][m][0], v1 = acc[ai][bj][m][1];
                        if (g6 >= 4 && !ctxt) { const int tok = tok0 + ai * HALF + m * 16; const int pos = g6 == 4 ? (tok >> 6) : (tok & 63);
                            const f32x4 cs = *(const f32x4*)(ROPE + pos * 32 + 4 * fq), sn = *(const f32x4*)(ROPE + pos * 32 + 16 + 4 * fq);
#pragma unroll
                            for (int j = 0; j < 4; ++j) { const float x1 = v0[j], x2 = v1[j]; v0[j] = x1 * cs[j] - x2 * sn[j]; v1[j] = x2 * cs[j] + x1 * sn[j]; } }
                        v0 = v0 * QSCALE; v1 = v1 * QSCALE;
                        bf16_t* qp = Q + (size_t)row * 768 + cg + 4 * fq; u32x2 w0, w1; w0.x = cvt_pk_bf16(v0[0], v0[1]); w0.y = cvt_pk_bf16(v0[2], v0[3]); w1.x = cvt_pk_bf16(v1[0], v1[1]); w1.y = cvt_pk_bf16(v1[2], v1[3]);
                        *(u32x2*)qp = w0; *(u32x2*)(qp + 16) = w1; } }
        } else { const int h = u.pn - 3;
#pragma unroll
            for (int bj = 0; bj < 2; ++bj) { bf16_t* base = (bj == 0 ? Kn : V) + h * 128 + wc * 32 + 4 * fq;
#pragma unroll
                for (int ai = 0; ai < 2; ++ai)
#pragma unroll
                    for (int m = 0; m < 4; ++m) { const int row = row0 + ai * HALF + m * 16; const f32x4 v0 = acc[ai][bj][m][0], v1 = acc[ai][bj][m][1];
                        u32x2 w0, w1; w0.x = cvt_pk_bf16(v0[0], v0[1]); w0.y = cvt_pk_bf16(v0[2], v0[3]); w1.x = cvt_pk_bf16(v1[0], v1[1]); w1.y = cvt_pk_bf16(v1[2], v1[3]);
                        *(u32x2*)(base + (size_t)row * 512) = w0; *(u32x2*)(base + (size_t)row * 512 + 16) = w1; } } }
    }
};
__device__ void ph_mla_gemm(const FP& p, int l, LAS unsigned char* lds) {
  Gemm g; g.A = p.A2b; g.Bt = p.Wt_mla + (size_t)l * MLAN * MLAK; g.M = T; g.N = MLAN; g.K = MLAK;
  StaticOrder S; S.init(T, MLAN, MLAK, gridDim.x, blockIdx.x); EpiMla E; E.Q = p.Qb; E.Kn = p.Knb; E.V = p.Vb; E.ROPE = p.ROPE;
  gemm_phase<EpiMla, StaticOrder>(lds, g, S, E);
}

namespace att {
constexpr int NW = 8, QBLK = 32, KVBLK = 64;
constexpr float THRL = 8.f * 1.4426950408889634f;
constexpr int SHM_V = KVBLK * 128 * 2, SHM_K = KVBLK * 128 * 2, SHM_R = KVBLK * 64 * 2;
constexpr int OFF_V = 0, OFF_K = 2 * SHM_V, OFF_R = OFF_K + 2 * SHM_K, OFF_WS = OFF_R + 2 * SHM_R, OFF_Q = OFF_WS + NW * 64 * 4, SHM_ATTN = OFF_Q + 256 * 128;
#define KSWZ(row, colB) ((row) * 256 + ((colB) ^ (((row) & 7) << 4)))
#define RSWZ(row, colB) ((row) * 128 + ((colB) ^ ((((row) >> 1) & 7) << 4)))
#define SBAR() __builtin_amdgcn_sched_barrier(0)
__device__ __forceinline__ int crow(int r, int hi) { return (r & 3) + 8 * (r >> 2) + 4 * hi; }
__device__ __forceinline__ void partialSM(f32x16& p0, f32x16& p1, float& m_reg, float& mn, float& alpha) {
  float pmax = p0[0];
#pragma unroll
  for (int r = 1; r < 16; ++r) pmax = fmaxf(pmax, p0[r]);
#pragma unroll
  for (int r = 0; r < 16; ++r) pmax = fmaxf(pmax, p1[r]);
  { auto rr = __builtin_amdgcn_permlane32_swap(__float_as_uint(pmax), __float_as_uint(pmax), false, false); pmax = fmaxf(__uint_as_float(rr[0]), __uint_as_float(rr[1])); }
  if (__builtin_expect(__all(pmax - m_reg <= THRL), 1)) { mn = m_reg; alpha = 1.f; }
  else { mn = fmaxf(m_reg, pmax); alpha = __builtin_amdgcn_exp2f(m_reg - mn); m_reg = mn; }
#pragma unroll
  for (int r = 0; r < 16; ++r) p0[r] = p0[r] - mn;
#pragma unroll
  for (int r = 0; r < 16; ++r) p1[r] = p1[r] - mn;
#pragma unroll
  for (int r = 0; r < 16; ++r) p0[r] = __builtin_amdgcn_exp2f(p0[r]);
}
__device__ __forceinline__ void finishSM(f32x16& p0, f32x16& p1, float alpha, float& l_reg, bf16x8& pa0, bf16x8& pa1, bf16x8& pa2, bf16x8& pa3) {
#pragma unroll
  for (int r = 0; r < 16; ++r) p1[r] = __builtin_amdgcn_exp2f(p1[r]);
  float ps = 0;
#pragma unroll
  for (int r = 0; r < 16; ++r) ps += p0[r];
#pragma unroll
  for (int r = 0; r < 16; ++r) ps += p1[r];
  { auto rr = __builtin_amdgcn_permlane32_swap(__float_as_uint(ps), __float_as_uint(ps), false, false); ps = __uint_as_float(rr[0]) + __uint_as_float(rr[1]); }
  l_reg = l_reg * alpha + ps;
#define PK4(P, BASE, OUT) do { unsigned a0 = cvt_pk_bf16(P[BASE + 0], P[BASE + 1]), a1 = cvt_pk_bf16(P[BASE + 2], P[BASE + 3]);   \
    unsigned b0 = cvt_pk_bf16(P[BASE + 4], P[BASE + 5]), b1 = cvt_pk_bf16(P[BASE + 6], P[BASE + 7]);                              \
    auto r0 = __builtin_amdgcn_permlane32_swap(a0, b0, false, false); auto r1 = __builtin_amdgcn_permlane32_swap(a1, b1, false, false); \
    u32x4 w = {r0[0], r1[0], r0[1], r1[1]}; OUT = *reinterpret_cast<bf16x8*>(&w); } while (0)
  PK4(p0, 0, pa0); PK4(p0, 8, pa1); PK4(p1, 0, pa2); PK4(p1, 8, pa3);
#undef PK4
}
__device__ __forceinline__ void qkt(f32x16& p0, f32x16& p1, const char* Ks, const char* Rs, const bf16x8* qr, const char* qrow, int qsw, int r32, int hi) {
  p0 = f32x16{}; p1 = f32x16{};
#pragma unroll
  for (int d0 = 0; d0 < 8; ++d0) { const int cb = (d0 * 16 + hi * 8) * 2;
    const bf16x8 b0 = *reinterpret_cast<const bf16x8*>(Ks + KSWZ(r32, cb));
    const bf16x8 b1 = *reinterpret_cast<const bf16x8*>(Ks + KSWZ(32 + r32, cb));
    p0 = __builtin_amdgcn_mfma_f32_32x32x16_bf16(b0, qr[d0], p0, 0, 0, 0);
    p1 = __builtin_amdgcn_mfma_f32_32x32x16_bf16(b1, qr[d0], p1, 0, 0, 0); }
#pragma unroll
  for (int d0 = 0; d0 < 4; ++d0) { const int cb = (d0 * 16 + hi * 8) * 2;
    const bf16x8 b0 = *reinterpret_cast<const bf16x8*>(Rs + RSWZ(r32, cb));
    const bf16x8 b1 = *reinterpret_cast<const bf16x8*>(Rs + RSWZ(32 + r32, cb));
    const bf16x8 qf = *reinterpret_cast<const bf16x8*>(qrow + (cb ^ qsw));
    p0 = __builtin_amdgcn_mfma_f32_32x32x16_bf16(b0, qf, p0, 0, 0, 0);
    p1 = __builtin_amdgcn_mfma_f32_32x32x16_bf16(b1, qf, p1, 0, 0, 0); }
}
__device__ __forceinline__ int v_st(int k, int c) { const int kk = (k & ~0xC) | ((k & 4) << 1) | ((k & 8) >> 1); return ((kk >> 3) * 4 + (c >> 5)) * 512 + ((kk & 7) * 32 + (c & 31)) * 2; }
__device__ __forceinline__ int v_rd_base(int lane) { return ((lane & 3) << 3) | (((lane >> 2) & 3) << 6) | (((lane >> 4) & 1) << 5) | (((lane >> 5) & 1) << 8); }
constexpr int v_rd_off(int d0, int ks, int half) { return d0 * 512 + ks * 4096 + half * 2048; }
template <int OFF> __device__ __forceinline__ s16x4 tr_read(int vb) { s16x4 r; asm volatile("ds_read_b64_tr_b16 %0, %1 offset:%2" : "=&v"(r) : "v"(vb), "i"(OFF) : "memory"); return r; }
template <int D0> __device__ __forceinline__ void pv_one(f32x16& od, int vb, bf16x8 pa0, bf16x8 pa1, bf16x8 pa2, bf16x8 pa3) {
  const s16x4 l0 = tr_read<v_rd_off(D0, 0, 0)>(vb), h0 = tr_read<v_rd_off(D0, 0, 1)>(vb), l1 = tr_read<v_rd_off(D0, 1, 0)>(vb), h1 = tr_read<v_rd_off(D0, 1, 1)>(vb);
  const s16x4 l2 = tr_read<v_rd_off(D0, 2, 0)>(vb), h2 = tr_read<v_rd_off(D0, 2, 1)>(vb), l3 = tr_read<v_rd_off(D0, 3, 0)>(vb), h3 = tr_read<v_rd_off(D0, 3, 1)>(vb);
  asm volatile("s_waitcnt lgkmcnt(0)" ::: "memory"); SBAR();
#define PK(L, H) (bf16x8){L[0], L[1], L[2], L[3], H[0], H[1], H[2], H[3]}
  od = __builtin_amdgcn_mfma_f32_32x32x16_bf16(pa0, PK(l0, h0), od, 0, 0, 0);
  od = __builtin_amdgcn_mfma_f32_32x32x16_bf16(pa1, PK(l1, h1), od, 0, 0, 0);
  od = __builtin_amdgcn_mfma_f32_32x32x16_bf16(pa2, PK(l2, h2), od, 0, 0, 0);
  od = __builtin_amdgcn_mfma_f32_32x32x16_bf16(pa3, PK(l3, h3), od, 0, 0, 0);
#undef PK
}
__device__ __forceinline__ void pv_d0(f32x16* o, int vb, bf16x8 pa0, bf16x8 pa1, bf16x8 pa2, bf16x8 pa3) {
  pv_one<0>(o[0], vb, pa0, pa1, pa2, pa3); pv_one<1>(o[1], vb, pa0, pa1, pa2, pa3); pv_one<2>(o[2], vb, pa0, pa1, pa2, pa3); pv_one<3>(o[3], vb, pa0, pa1, pa2, pa3);
}
template <bool PARTIAL = false> __device__ __forceinline__ void attn_body(const bf16_t* __restrict__ Qb, const bf16_t* __restrict__ Kh, const bf16_t* __restrict__ Rh, const bf16_t* __restrict__ Vh,
                                          bf16_t* __restrict__ Ob, int seq, char* lds, float* __restrict__ PO = nullptr, float* __restrict__ PML = nullptr) {
  const int tid = TIDX, wid = tid >> 6, lane = tid & 63, r32 = lane & 31, hi = lane >> 5;
  char* V_lds = lds + OFF_V; char* K_lds = lds + OFF_K; char* R_lds = lds + OFF_R;
  float* ws = (float*)(lds + OFF_WS) + wid * 64; float* li_l = ws; float* al_l = ws + 32;
  float m_reg = -1e30f, l_reg = 0; f32x16 o[4] = {}; bf16x8 qr[8];
  const bf16_t* Qw = Qb + (size_t)(wid * QBLK + r32) * 768 + hi * 8;
#pragma unroll
  for (int d0 = 0; d0 < 8; ++d0) qr[d0] = *reinterpret_cast<const bf16x8*>(Qw + d0 * 16);
  const int qrowi = wid * QBLK + r32; char* qrow = lds + OFF_Q + qrowi * 128; const int qsw = ((qrowi >> 1) & 7) << 4;
#pragma unroll
  for (int d0 = 0; d0 < 4; ++d0) *reinterpret_cast<bf16x8*>(qrow + (((d0 * 16 + hi * 8) * 2) ^ qsw)) = *reinterpret_cast<const bf16x8*>(Qw + (8 + d0) * 16);
  const int sr = tid >> 4, sc = (tid & 15) * 8, vst0 = v_st(sr, sc), vst1 = v_st(32 + sr, sc);
  const int rr = tid >> 3, rc = (tid & 7) * 8;
  const int vb0 = (int)(uintptr_t)V_lds + v_rd_base(lane);
  bf16x8 vs0, vs1, ks0, ks1, rs0;
  const unsigned kvo0 = (unsigned)(sr * 512 + sc) * 2u, kvo1 = kvo0 + 32u * 512u * 2u, ro0 = (unsigned)(rr * 64 + rc) * 2u;
#define SLOAD(k0) do { const char* Vt = (const char*)Vh + (size_t)(k0) * 1024; const char* Kt = (const char*)Kh + (size_t)(k0) * 1024; const char* Rt = (const char*)Rh + (size_t)(k0) * 128; \
    vs0 = *(const bf16x8*)(Vt + kvo0); vs1 = *(const bf16x8*)(Vt + kvo1); ks0 = *(const bf16x8*)(Kt + kvo0); ks1 = *(const bf16x8*)(Kt + kvo1); rs0 = *(const bf16x8*)(Rt + ro0); } while (0)
#define SWRITE(b) do { *(bf16x8*)(V_lds + (b) * SHM_V + vst0) = vs0; *(bf16x8*)(V_lds + (b) * SHM_V + vst1) = vs1; const int kc = sc * 2; \
    *(bf16x8*)(K_lds + (b) * SHM_K + KSWZ(sr, kc)) = ks0; *(bf16x8*)(K_lds + (b) * SHM_K + KSWZ(32 + sr, kc)) = ks1; \
    *(bf16x8*)(R_lds + (b) * SHM_R + RSWZ(rr, rc * 2)) = rs0; } while (0)
#define SWAIT() asm volatile("s_waitcnt vmcnt(0)" ::: "memory")
#define RESC(a) do { if (__any((a) < 1.f)) { if (hi == 0) al_l[r32] = (a); asm volatile("s_waitcnt lgkmcnt(0)" ::: "memory"); \
    _Pragma("unroll") for (int d = 0; d < 4; ++d) _Pragma("unroll") for (int r = 0; r < 16; ++r) o[d][r] *= al_l[crow(r, hi)]; } } while (0)
  f32x16 pA0, pA1, pB0, pB1; float mnA, mnB, alA, alB; bf16x8 pa0, pa1, pa2, pa3; const int NT = seq / KVBLK;
  SLOAD(0); SWAIT(); SWRITE(0); __syncthreads();
  qkt(pA0, pA1, K_lds, R_lds, qr, qrow, qsw, r32, hi); partialSM(pA0, pA1, m_reg, mnA, alA);
  SLOAD(KVBLK);
  SWAIT(); SWRITE(1); __syncthreads();
  for (int j = 1; j + 1 < NT; j += 2) {
    SBAR(); qkt(pB0, pB1, K_lds + SHM_K, R_lds + SHM_R, qr, qrow, qsw, r32, hi);
    finishSM(pA0, pA1, alA, l_reg, pa0, pa1, pa2, pa3); SBAR();
    SLOAD((j + 1) * KVBLK); SBAR();
    pv_d0(o, vb0, pa0, pa1, pa2, pa3); partialSM(pB0, pB1, m_reg, mnB, alB);
    __syncthreads(); SWAIT(); SWRITE(0);
    RESC(alB); __syncthreads();
    SBAR(); qkt(pA0, pA1, K_lds, R_lds, qr, qrow, qsw, r32, hi);
    finishSM(pB0, pB1, alB, l_reg, pa0, pa1, pa2, pa3); SBAR();
    SLOAD((j + 2) * KVBLK); SBAR();
    pv_d0(o, vb0 + SHM_V, pa0, pa1, pa2, pa3); partialSM(pA0, pA1, m_reg, mnA, alA);
    __syncthreads(); SWAIT(); SWRITE(1);
    RESC(alA); __syncthreads();
  }
  SBAR(); qkt(pB0, pB1, K_lds + SHM_K, R_lds + SHM_R, qr, qrow, qsw, r32, hi);
  finishSM(pA0, pA1, alA, l_reg, pa0, pa1, pa2, pa3); SBAR();
  pv_d0(o, vb0, pa0, pa1, pa2, pa3); partialSM(pB0, pB1, m_reg, mnB, alB);
  __syncthreads(); RESC(alB);
  finishSM(pB0, pB1, alB, l_reg, pa0, pa1, pa2, pa3); SBAR();
  pv_d0(o, vb0 + SHM_V, pa0, pa1, pa2, pa3);
  if (PARTIAL) { int tz = TIDX; const int wz = tz >> 6, lz = tz & 63;
    if ((lz >> 5) == 0) { PML[wz * QBLK + lz] = m_reg; PML[256 + wz * QBLK + lz] = l_reg; }
    float* po = PO + (size_t)(wz * QBLK + 4 * (lz >> 5)) * 128 + (lz & 31);
#pragma unroll
    for (int r = 0; r < 16; ++r)
#pragma unroll
      for (int d0 = 0; d0 < 4; ++d0) po[((r & 3) + 8 * (r >> 2)) * 128 + d0 * 32] = o[d0][r];
    __syncthreads(); return; }
  if (hi == 0) li_l[r32] = l_reg; asm volatile("s_waitcnt lgkmcnt(0)" ::: "memory");
  float rli[16];
#pragma unroll
  for (int r = 0; r < 16; ++r) rli[r] = __builtin_amdgcn_rcpf(li_l[crow(r, hi)]);
  { int tz = TIDX; const int wz = tz >> 6, lz = tz & 63; const unsigned ob = (unsigned)((wz * QBLK + 4 * (lz >> 5)) * 512 + (lz & 31)) * 2u;
#pragma unroll
    for (int r = 0; r < 16; ++r) {
#pragma unroll
      for (int d0 = 0; d0 < 4; ++d0) { unsigned u = __float_as_uint(o[d0][r] * rli[r]); u += 0x7fffu + ((u >> 16) & 1u);
        *(bf16_t*)((char*)Ob + ob + (unsigned)((((r & 3) + 8 * (r >> 2)) * 512 + d0 * 32) * 2)) = (bf16_t)(u >> 16); } } }
  __syncthreads();
#undef SLOAD
#undef SWRITE
#undef SWAIT
#undef RESC
}
}

constexpr int ATT_NSPLIT = 64, ATT_NPART = 3;
__device__ __forceinline__ float* att_po(const FP& p, int j) { return (float*)p.SCR + (size_t)j * 32768; }
__device__ __forceinline__ float* att_pml(const FP& p, int j) { return (float*)p.SCR + (size_t)ATT_NSPLIT * ATT_NPART * 32768 + (size_t)j * 512; }
__device__ void ph_attn(const FP& p, int l, char* shm) {
  const int nctx = (l == DEPTH - 1) ? 0 : NB * 4;
  const int G = gridDim.x, me = (int)blockIdx.x - 64, nb = G - 64; if (me < 0) return;
  for (int u = 64 + me; u < NB * 4 * 16; u += nb) { const int b = u >> 6, h = (u >> 4) & 3, qoff = CTX + (u & 15) * 256; const size_t r0 = (size_t)b * SB, q0 = r0 + qoff;
    att::attn_body<false>(p.Qb + q0 * 768 + h * 192, p.Knb + r0 * 512 + h * 128, p.KRb + r0 * 64, p.Vb + r0 * 512 + h * 128, p.AOb + q0 * 512 + h * 128, SB, shm); }
  for (int j = me; j < ATT_NSPLIT * ATT_NPART; j += nb) { const int u = j / ATT_NPART, part = j % ATT_NPART, h = (u >> 4) & 3, qoff = CTX + (u & 15) * 256; const size_t q0 = qoff;
    const int k0 = part == 0 ? 0 : 1536 + (part - 1) * 1408, len = part == 0 ? 1536 : 1408;
    att::attn_body<true>(p.Qb + q0 * 768 + h * 192, p.Knb + (size_t)k0 * 512 + h * 128, p.KRb + (size_t)k0 * 64, p.Vb + (size_t)k0 * 512 + h * 128, nullptr, len, shm, att_po(p, j), att_pml(p, j)); }
  for (int uu = me; uu < nctx; uu += nb) { const int b = uu >> 2, h = uu & 3; const size_t r0 = (size_t)b * SB;
    att::attn_body<false>(p.Qb + r0 * 768 + h * 192, p.Knb + r0 * 512 + h * 128, p.KRb + r0 * 64, p.Vb + r0 * 512 + h * 128, p.AOb + r0 * 512 + h * 128, CTX, shm); }
}

__device__ __forceinline__ void mla_out_row(const FP& p, int l, int row, int lane) {
  float x[8]; float ss = 0.f;
  if (row >= CTX && row < CTX + ATT_NSPLIT * 64) {
    const int tok = row - CTX, u = (lane >> 4) * 16 + (tok >> 8), qr = tok & 255; float m[ATT_NPART], lsum[ATT_NPART], M = -3.0e38f;
#pragma unroll
    for (int j = 0; j < ATT_NPART; ++j) { const float* ml = att_pml(p, u * ATT_NPART + j); m[j] = ml[qr]; lsum[j] = ml[256 + qr]; M = fmaxf(M, m[j]); }
    float L = 0.f;
#pragma unroll
    for (int e = 0; e < 8; ++e) x[e] = 0.f;
#pragma unroll
    for (int j = 0; j < ATT_NPART; ++j) { const float wj = __builtin_amdgcn_exp2f(m[j] - M); L += wj * lsum[j]; const float* po = att_po(p, u * ATT_NPART + j) + (size_t)qr * 128 + (lane & 15) * 8;
      const f32x4 a = *(const f32x4*)po, b2 = *(const f32x4*)(po + 4);
      x[0] += wj * a[0]; x[1] += wj * a[1]; x[2] += wj * a[2]; x[3] += wj * a[3]; x[4] += wj * b2[0]; x[5] += wj * b2[1]; x[6] += wj * b2[2]; x[7] += wj * b2[3]; }
    const float rl = 1.f / L;
#pragma unroll
    for (int e = 0; e < 8; ++e) x[e] = bf2f(f2bf(x[e] * rl));
  } else { const u32x4 v = *(const u32x4*)(p.AOb + (size_t)row * 512 + lane * 8);
    x[0] = bflo(v.x); x[1] = bfhi(v.x); x[2] = bflo(v.y); x[3] = bfhi(v.y); x[4] = bflo(v.z); x[5] = bfhi(v.z); x[6] = bflo(v.w); x[7] = bfhi(v.w); }
#pragma unroll
  for (int j = 0; j < 8; ++j) ss += x[j] * x[j];
  ss = wave_sum(ss); const float rs = rsqrtf(ss * (1.f / 512.f) + 1e-6f);
  const f32x4 g0 = *(const f32x4*)(p.g_mla + l * 512 + lane * 8), g1 = *(const f32x4*)(p.g_mla + l * 512 + lane * 8 + 4);
  u32x4 w; w.x = cvt_pk_bf16(x[0] * rs * g0[0], x[1] * rs * g0[1]); w.y = cvt_pk_bf16(x[2] * rs * g0[2], x[3] * rs * g0[3]);
  w.z = cvt_pk_bf16(x[4] * rs * g1[0], x[5] * rs * g1[1]); w.w = cvt_pk_bf16(x[6] * rs * g1[2], x[7] * rs * g1[3]);
  *(u32x4*)(p.CATb + (size_t)row * 1536 + lane * 8) = w;
}
constexpr int NCH = SB / 64;
__device__ __forceinline__ int item_idx(int dir, int bh, int cn) { return (dir * 16 + bh) * NCH + cn; }
__device__ __forceinline__ int scan_chunk(int dir, int n) { return dir == 0 ? n : (n < 4 ? 3 - n : 71 - n); }

__device__ __forceinline__ void prep_ret_row(const FP& p, int row, int lane) {
  const int s = row % SB; const bool lat = s >= CTX; const int tok = s - CTX;
  const bf16_t* pr = p.Pb + (size_t)row * INWP;
  const u32x4 qv = *(const u32x4*)(pr + C_RQ + lane * 8), kv = *(const u32x4*)(pr + C_RK + lane * 8);
  float q[8] = {bflo(qv.x), bfhi(qv.x), bflo(qv.y), bfhi(qv.y), bflo(qv.z), bfhi(qv.z), bflo(qv.w), bfhi(qv.w)};
  float k[8] = {bflo(kv.x), bfhi(kv.x), bflo(kv.y), bfhi(kv.y), bflo(kv.z), bfhi(kv.z), bflo(kv.w), bfhi(kv.w)};
  float qo[8], ko[8];
  const bool lowh = (lane & 4) == 0;
  const float pos = (float)(((lane >> 3) & 1) == 0 ? (tok >> 6) : (tok & 63));
#pragma unroll
  for (int e = 0; e < 8; ++e) { const float qp = shx(q[e], 4), kp = shx(k[e], 4);
    if (lat) { const int fi = (lane & 3) * 8 + e; const float ang = pos * __expf(-(float)fi * (9.210340371976184f / 32.f)); const float cs = __cosf(ang), sn = __sinf(ang);
      qo[e] = lowh ? q[e] * cs - qp * sn : q[e] * cs + qp * sn; ko[e] = lowh ? k[e] * cs - kp * sn : k[e] * cs + kp * sn; }
    else { qo[e] = q[e]; ko[e] = k[e]; } }
  const float sc = 0.08838834764831845f;
  u32x4 wq, wk; wq.x = cvt_pk_bf16(qo[0], qo[1]); wq.y = cvt_pk_bf16(qo[2], qo[3]); wq.z = cvt_pk_bf16(qo[4], qo[5]); wq.w = cvt_pk_bf16(qo[6], qo[7]);
  wk.x = cvt_pk_bf16(ko[0] * sc, ko[1] * sc); wk.y = cvt_pk_bf16(ko[2] * sc, ko[3] * sc); wk.z = cvt_pk_bf16(ko[4] * sc, ko[5] * sc); wk.w = cvt_pk_bf16(ko[6] * sc, ko[7] * sc);
  *(u32x4*)(p.RQb + (size_t)row * 512 + lane * 8) = wq; *(u32x4*)(p.RKb + (size_t)row * 512 + lane * 8) = wk;
}

__device__ __forceinline__ void r2_item(const FP& p, int l, int bh, int cn, int t, LAS unsigned char* hl) {
  const int b = bh >> 2, h = bh & 3; const size_t row0 = (size_t)b * SB + cn * 64;
  LAS bf16_t* sk = (LAS bf16_t*)hl; LAS bf16_t* sv = sk + 64 * 136;
#pragma unroll
  for (int i = 0; i < 4; ++i) { const int idx = t + 256 * i, r = idx >> 4, c8 = (idx & 15) * 8;
    *(LAS u32x4*)(sk + r * 136 + c8) = *(const u32x4*)(p.RKb + (row0 + r) * 512 + h * 128 + c8);
    *(LAS u32x4*)(sv + r * 136 + c8) = *(const u32x4*)(p.Pb + (row0 + r) * INWP + C_RV + h * 128 + c8); }
  __syncthreads();
  const float lgf = __log2f(1.f - __expf(p.ret_decay[l * 8 + h])), lgb = __log2f(1.f - __expf(p.ret_decay[l * 8 + 4 + h]));
#pragma unroll
  for (int q = 0; q < 4; ++q) { const int sidx = t + 256 * q, f = sidx >> 6, ln = sidx & 63, tt = f >> 2, s = f & 3, c = tt * 32 + (ln & 31), hh = ln >> 5;
    { float kf[8];
#pragma unroll
      for (int jj = 0; jj < 8; ++jj) kf[jj] = bf2f(sk[(16 * s + 8 * hh + jj) * 136 + c]);
      u32x4 wf, wb; unsigned tmpf[4], tmpb[4];
#pragma unroll
      for (int jp = 0; jp < 4; ++jp) { const int j0 = 16 * s + 8 * hh + 2 * jp;
        tmpf[jp] = cvt_pk_bf16(kf[2 * jp] * exp2f(lgf * (float)(63 - j0)), kf[2 * jp + 1] * exp2f(lgf * (float)(62 - j0)));
        tmpb[jp] = cvt_pk_bf16(kf[2 * jp] * exp2f(lgb * (float)j0), kf[2 * jp + 1] * exp2f(lgb * (float)(j0 + 1))); }
      wf.x = tmpf[0]; wf.y = tmpf[1]; wf.z = tmpf[2]; wf.w = tmpf[3]; wb.x = tmpb[0]; wb.y = tmpb[1]; wb.z = tmpb[2]; wb.w = tmpb[3];
      *(u32x4*)(p.RKWT + (size_t)item_idx(0, bh, cn) * 8192 + sidx * 8) = wf; *(u32x4*)(p.RKWT + (size_t)item_idx(1, bh, cn) * 8192 + sidx * 8) = wb; }
    { unsigned short vb[8], va[8];
#pragma unroll
      for (int jj = 0; jj < 8; ++jj) { vb[jj] = sv[(16 * s + 8 * hh + jj) * 136 + c]; va[jj] = sv[(16 * s + 8 * (jj >> 2) + 4 * hh + (jj & 3)) * 136 + c]; }
      u32x4 wb2, wa2; wb2.x = vb[0] | ((unsigned)vb[1] << 16); wb2.y = vb[2] | ((unsigned)vb[3] << 16); wb2.z = vb[4] | ((unsigned)vb[5] << 16); wb2.w = vb[6] | ((unsigned)vb[7] << 16);
      wa2.x = va[0] | ((unsigned)va[1] << 16); wa2.y = va[2] | ((unsigned)va[3] << 16); wa2.z = va[4] | ((unsigned)va[5] << 16); wa2.w = va[6] | ((unsigned)va[7] << 16);
      *(u32x4*)(p.RVTB + ((size_t)bh * NCH + cn) * 8192 + sidx * 8) = wb2; *(u32x4*)(p.RVTA + ((size_t)bh * NCH + cn) * 8192 + sidx * 8) = wa2; } }
  __syncthreads();
}

__device__ void ret_scan_job(const FP& p, int l, int bh, int dir, LAS unsigned char* lds) {
  const int t = TIDX, wid = __builtin_amdgcn_readfirstlane(t >> 6), lane = t & 63, hi = lane >> 5;
  const int h = bh & 3; const float lg = __log2f(1.f - __expf(p.ret_decay[l * 8 + dir * 4 + h])); const float g64 = exp2f(lg * 64.f);
  f32x16 S[4];
#pragma unroll
  for (int d = 0; d < 4; ++d)
#pragma unroll
    for (int r = 0; r < 16; ++r) S[d][r] = 0.f;
#define RS_STAGE(cn, buf) do { const char* ga = (const char*)(p.RKWT + (size_t)item_idx(dir, bh, (cn)) * 8192) + (wid - 4) * 1024 + lane * 16; const char* gb = (const char*)(p.RVTB + ((size_t)bh * NCH + (cn)) * 8192) + (wid - 4) * 1024 + lane * 16; \
    LAS unsigned char* lb = lds + (buf) * 32768 + (wid - 4) * 1024; \
    _Pragma("unroll") for (int q_ = 0; q_ < 4; ++q_) { __builtin_amdgcn_global_load_lds((const unsigned*)(ga + q_ * 4096), (LAS unsigned*)(lb + q_ * 4096), 16, 0, 0); \
      __builtin_amdgcn_global_load_lds((const unsigned*)(gb + q_ * 4096), (LAS unsigned*)(lb + 16384 + q_ * 4096), 16, 0, 0); } } while (0)
  __syncthreads();
  if (wid >= 4) { RS_STAGE(scan_chunk(dir, 0), 0); RS_STAGE(scan_chunk(dir, 1), 1); }
  for (int n = 0; n < NCH; ++n) { const int cn = scan_chunk(dir, n), buf = n % 3;
    if (wid >= 4) { if (n + 1 < NCH) asm volatile("s_waitcnt vmcnt(8)" ::: "memory"); else asm volatile("s_waitcnt vmcnt(0)" ::: "memory"); }
    __builtin_amdgcn_s_barrier(); asm volatile("" ::: "memory");
    if (wid >= 4) { if (n + 2 < NCH) RS_STAGE(scan_chunk(dir, n + 2), (n + 2) % 3); }
    if (wid < 4) {
      asm volatile("s_nop 9\n\ts_nop 9" : "+v"(S[3]), "+v"(S[2]), "+v"(S[1]), "+v"(S[0]));
      bf16_t* st = p.RST + (size_t)item_idx(dir, bh, cn) * 16384;
#pragma unroll
      for (int dt = 0; dt < 4; ++dt)
#pragma unroll
        for (int g = 0; g < 4; ++g) { u32x2 w; w.x = cvt_pk_bf16(S[dt][4 * g], S[dt][4 * g + 1]); w.y = cvt_pk_bf16(S[dt][4 * g + 2], S[dt][4 * g + 3]);
          *(u32x2*)(st + ((wid * 8 + 2 * dt + (g >> 1)) * 64 + (lane & 31) + 32 * (g & 1)) * 8 + 4 * hi) = w; }
#pragma unroll
      for (int dt = 0; dt < 4; ++dt)
#pragma unroll
        for (int r = 0; r < 16; ++r) S[dt][r] *= g64;
      const LAS unsigned char* bb = lds + buf * 32768;
      bf16x8 af[4][4], bfr[4];
#pragma unroll
      for (int s = 0; s < 4; ++s) bfr[s] = *(const LAS bf16x8*)(bb + 16384 + (wid * 4 + s) * 1024 + lane * 16);
#pragma unroll
      for (int dt = 0; dt < 4; ++dt)
#pragma unroll
        for (int s = 0; s < 4; ++s) af[dt][s] = *(const LAS bf16x8*)(bb + (dt * 4 + s) * 1024 + lane * 16);
#pragma unroll
      for (int s = 0; s < 4; ++s)
#pragma unroll
        for (int dt = 0; dt < 4; ++dt) S[dt] = __builtin_amdgcn_mfma_f32_32x32x16_bf16(af[dt][s], bfr[s], S[dt], 0, 0, 0);
    }
  }
  asm volatile("s_waitcnt vmcnt(0)" ::: "memory"); __syncthreads();
#undef RS_STAGE
}

__device__ __forceinline__ bf16x8 pack8(float a0, float a1, float a2, float a3, float a4, float a5, float a6, float a7) {
  u32x4 pk;
  asm volatile("v_cvt_pk_bf16_f32 %0, %4, %5\n\tv_cvt_pk_bf16_f32 %1, %6, %7\n\tv_cvt_pk_bf16_f32 %2, %8, %9\n\tv_cvt_pk_bf16_f32 %3, %10, %11\n\ts_nop 1"
               : "=&v"(pk[0]), "=&v"(pk[1]), "=&v"(pk[2]), "=&v"(pk[3]) : "v"(a0), "v"(a1), "v"(a2), "v"(a3), "v"(a4), "v"(a5), "v"(a6), "v"(a7));
  return __builtin_bit_cast(bf16x8, pk);
}
__device__ __forceinline__ bf16x8 pack_step(const f32x16& x, int s) { return pack8(x[8 * s], x[8 * s + 1], x[8 * s + 2], x[8 * s + 3], x[8 * s + 4], x[8 * s + 5], x[8 * s + 6], x[8 * s + 7]); }
__device__ __forceinline__ bf16x8 scale_frag(bf16x8 a, float f) {
  const u32x4 v = __builtin_bit_cast(u32x4, a);
  return pack8(bflo(v.x) * f, bfhi(v.x) * f, bflo(v.y) * f, bfhi(v.y) * f, bflo(v.z) * f, bfhi(v.z) * f, bflo(v.w) * f, bfhi(v.w) * f);
}

__device__ void ret_out_unit(const FP& p, int l, int bh, int cn, int ih, int lane) {
  const int b = bh >> 2, h = bh & 3, c32 = lane & 31, hi = lane >> 5; const size_t row0 = (size_t)b * SB + cn * 64; const int ipos = 32 * ih + c32;
  const float lgf = __log2f(1.f - __expf(p.ret_decay[l * 8 + h])), lgb = __log2f(1.f - __expf(p.ret_decay[l * 8 + 4 + h]));
  const unsigned lo16 = (unsigned)lane * 16u;
  f32x16 P0, P1;
#pragma unroll
  for (int r = 0; r < 16; ++r) { P0[r] = 0.f; P1[r] = 0.f; }
  const char* qb = (const char*)(p.RQb + (row0 + 32 * ih) * 512 + h * 128); const char* kb = (const char*)(p.RKb + row0 * 512 + h * 128);
  const unsigned rowoff = (unsigned)(c32 * 512 + 8 * hi) * 2u;
#pragma unroll 1
  for (int s = 0; s < 8; ++s) { const bf16x8 qf = *(const bf16x8*)(qb + rowoff + s * 32); const bf16x8 k0 = *(const bf16x8*)(kb + rowoff + s * 32), k1 = *(const bf16x8*)(kb + 32 * 1024 + rowoff + s * 32);
    P0 = __builtin_amdgcn_mfma_f32_32x32x16_bf16(k0, qf, P0, 0, 0, 0); P1 = __builtin_amdgcn_mfma_f32_32x32x16_bf16(k1, qf, P1, 0, 0, 0); }
  bf16x8 pb[2][2][2];
#pragma unroll
  for (int dir = 0; dir < 2; ++dir) { const float lg = dir == 0 ? lgf : lgb;
#pragma unroll
    for (int jt = 0; jt < 2; ++jt) { f32x16 pd;
#pragma unroll
      for (int r = 0; r < 16; ++r) { const int j = 32 * jt + crow16(r, hi); const int dlt = dir == 0 ? ipos - j : j - ipos; const float pv = jt == 0 ? P0[r] : P1[r]; pd[r] = dlt >= 0 ? pv * exp2f(lg * (float)dlt) : 0.f; }
      pb[dir][jt][0] = pack_step(pd, 0); pb[dir][jt][1] = pack_step(pd, 1); } }
  __builtin_amdgcn_sched_barrier(0);
  f32x16 O[4];
  const char* va = (const char*)(p.RVTA + ((size_t)bh * NCH + cn) * 8192);
#pragma unroll
  for (int et = 0; et < 4; ++et) { f32x16 a;
#pragma unroll
    for (int r = 0; r < 16; ++r) a[r] = 0.f;
    const char* vae = va + et * 4096;
#pragma unroll
    for (int jt = 0; jt < 2; ++jt)
#pragma unroll
      for (int ss = 0; ss < 2; ++ss) { const bf16x8 af = *(const bf16x8*)(vae + lo16 + (2 * jt + ss) * 1024);
        a = __builtin_amdgcn_mfma_f32_32x32x16_bf16(af, pb[0][jt][ss], a, 0, 0, 0); a = __builtin_amdgcn_mfma_f32_32x32x16_bf16(af, pb[1][jt][ss], a, 0, 0, 0); }
    O[et] = a; __builtin_amdgcn_sched_barrier(0); }
  const float facf = exp2f(lgf * (float)(ipos + 1)), facb = exp2f(lgb * (float)(64 - ipos));
  const char* stf = (const char*)(p.RST + (size_t)item_idx(0, bh, cn) * 16384); const char* stb = (const char*)(p.RST + (size_t)item_idx(1, bh, cn) * 16384);
#pragma unroll 1
  for (int s = 0; s < 8; ++s) { const bf16x8 qf = *(const bf16x8*)(qb + rowoff + s * 32); const bf16x8 qsf = scale_frag(qf, facf), qsb = scale_frag(qf, facb);
#pragma unroll
    for (int et = 0; et < 4; ++et) { const bf16x8 af = *(const bf16x8*)(stf + et * 8192 + s * 1024 + lo16), ab = *(const bf16x8*)(stb + et * 8192 + s * 1024 + lo16);
      O[et] = __builtin_amdgcn_mfma_f32_32x32x16_bf16(af, qsf, O[et], 0, 0, 0); O[et] = __builtin_amdgcn_mfma_f32_32x32x16_bf16(ab, qsb, O[et], 0, 0, 0); } }
  float sm = 0.f;
#pragma unroll
  for (int et = 0; et < 4; ++et)
#pragma unroll
    for (int r = 0; r < 16; ++r) sm += O[et][r];
  sm += shx(sm, 32); const float mu = sm * (1.f / 128.f); float vq = 0.f;
#pragma unroll
  for (int et = 0; et < 4; ++et)
#pragma unroll
    for (int r = 0; r < 16; ++r) { const float dd = O[et][r] - mu; vq += dd * dd; }
  vq += shx(vq, 32); const float rs = rsqrtf(vq * (1.f / 128.f) + 1e-5f);
  const size_t row = row0 + ipos; const bf16_t* gp = p.Pb + row * INWP + C_RG + h * 128; const float* gr = p.g_ret + l * 512 + h * 128; bf16_t* op = p.CATb + row * 1536 + 512 + h * 128;
#pragma unroll
  for (int et = 0; et < 4; ++et)
#pragma unroll
    for (int g = 0; g < 4; ++g) { const int e0 = 32 * et + 8 * g + 4 * hi; const u32x2 gz = *(const u32x2*)(gp + e0); const f32x4 gg = *(const f32x4*)(gr + e0);
      const float z[4] = {bflo(gz.x), bfhi(gz.x), bflo(gz.y), bfhi(gz.y)}; float y[4];
#pragma unroll
      for (int j = 0; j < 4; ++j) y[j] = (O[et][4 * g + j] - mu) * rs * gg[j] * silu_f(z[j]);
      u32x2 w; w.x = cvt_pk_bf16(y[0], y[1]); w.y = cvt_pk_bf16(y[2], y[3]); *(u32x2*)(op + e0) = w; }
}
#define N2SWZ(r, c) ((r) * 2048 + ((((c) & ~15) | (((c) ^ (r)) & 15)) << 4))
__device__ void ph_norm2m(const FP& p, int l, LAS unsigned char* lds) {
  const int t = TIDX, wid = t >> 6, lane = t & 63, c32 = lane & 31, hi = lane >> 5;
  const float* MODl = p.MOD + (size_t)l * 5 * 6144; const float* g2 = p.g_norm2 + l * D; int* cntl = p.cnt + l * 32;
  LAS float* lgt = (LAS float*)(lds + 131072);
  const bf16_t* wf = p.WRF + (size_t)l * 2 * 64 * 512;
  __syncthreads();
  for (int tile = blockIdx.x; tile < T / 32; tile += gridDim.x) { const int trow0 = tile * 32; const int b = trow0 / SB, s0 = trow0 % SB, rmod = s0 < CTX ? 4 : b;
    const bool routed = !(l == DEPTH - 1 && s0 < CTX);
    bf16x8 bh[8], bl[8];
#pragma unroll
    for (int q = 0; q < 8; ++q) { bh[q] = *(const bf16x8*)(wf + ((size_t)(wid * 8 + q) * 64 + lane) * 8); bl[q] = *(const bf16x8*)(wf + ((size_t)(64 + wid * 8 + q) * 64 + lane) * 8); }
    f32x4 x[4][4];
#pragma unroll
    for (int q = 0; q < 4; ++q)
#pragma unroll
      for (int i = 0; i < 4; ++i) x[q][i] = *(const f32x4*)(p.X + (size_t)(trow0 + wid * 4 + q) * D + i * 256 + lane * 4);
    const float* m = MODl + (size_t)rmod * 6144;
#pragma unroll
    for (int q = 0; q < 4; ++q) { const int r = wid * 4 + q, row = trow0 + r; float ss = 0.f;
#pragma unroll
      for (int i = 0; i < 4; ++i) ss += x[q][i][0] * x[q][i][0] + x[q][i][1] * x[q][i][1] + x[q][i][2] * x[q][i][2] + x[q][i][3] * x[q][i][3];
      ss = wave_sum(ss); const float rs = rsqrtf(ss * (1.f / 1024.f) + 1e-6f);
#pragma unroll
      for (int i = 0; i < 4; ++i) { const int c = i * 256 + lane * 4; const f32x4 g = *(const f32x4*)(g2 + c), sc = *(const f32x4*)(m + 4096 + c), sh = *(const f32x4*)(m + 3072 + c);
        const f32x4 h = x[q][i] * rs * g * (sc + 1.f) + sh;
        u32x2 whi; whi.x = cvt_pk_bf16(h[0], h[1]); whi.y = cvt_pk_bf16(h[2], h[3]);
        const f32x4 res = (f32x4){h[0] - bflo(whi.x), h[1] - bfhi(whi.x), h[2] - bflo(whi.y), h[3] - bfhi(whi.y)};
        u32x2 wlo; wlo.x = cvt_pk_bf16(res[0], res[1]); wlo.y = cvt_pk_bf16(res[2], res[3]);
        if (routed) *(u32x2*)(p.H2b + (size_t)row * D + c) = whi;
        const int ch = i * 32 + (lane >> 1); const int off = N2SWZ(r, ch) + (lane & 1) * 8;
        *(LAS u32x2*)(lds + off) = whi; *(LAS u32x2*)(lds + 65536 + off) = wlo; } }
    __syncthreads();
    f32x16 acc;
#pragma unroll
    for (int r = 0; r < 16; ++r) acc[r] = 0.f;
#pragma unroll
    for (int q = 0; q < 8; ++q) { const int ch = 2 * (wid * 8 + q) + hi; const bf16x8 ah = *(const LAS bf16x8*)(lds + N2SWZ(c32, ch)), al = *(const LAS bf16x8*)(lds + 65536 + N2SWZ(c32, ch));
      acc = __builtin_amdgcn_mfma_f32_32x32x16_bf16(ah, bh[q], acc, 0, 0, 0); acc = __builtin_amdgcn_mfma_f32_32x32x16_bf16(al, bh[q], acc, 0, 0, 0); acc = __builtin_amdgcn_mfma_f32_32x32x16_bf16(ah, bl[q], acc, 0, 0, 0); }
    __syncthreads();
    { LAS float* part = (LAS float*)lds + wid * 1024;
#pragma unroll
      for (int r = 0; r < 16; ++r) part[crow16(r, hi) * 32 + c32] = acc[r]; }
    __syncthreads();
    { const int r = t >> 4, e2 = (t & 15) * 2; float s0_ = 0.f, s1_ = 0.f;
#pragma unroll
      for (int w = 0; w < 8; ++w) { s0_ += ((LAS float*)lds)[w * 1024 + r * 32 + e2]; s1_ += ((LAS float*)lds)[w * 1024 + r * 32 + e2 + 1]; }
      lgt[r * 33 + e2] = s0_ + p.b_router[l * NE + e2]; lgt[r * 33 + e2 + 1] = s1_ + p.b_router[l * NE + e2 + 1]; }
    __syncthreads();
    if (t < 32 && routed) { const int row = trow0 + t; float lg[32];
#pragma unroll
      for (int e = 0; e < 32; ++e) lg[e] = lgt[t * 33 + e];
      float tv[4]; int ti[4];
#pragma unroll
      for (int k = 0; k < 4; ++k) { float bv = -3.0e38f; int bi = 0;
#pragma unroll
        for (int e = 0; e < 32; ++e) { if (lg[e] > bv) { bv = lg[e]; bi = e; } }
        tv[k] = bv; ti[k] = bi;
#pragma unroll
        for (int e = 0; e < 32; ++e) if (e == bi) lg[e] = -3.0e38f; }
      float e4[4], sum = 0.f;
#pragma unroll
      for (int k = 0; k < 4; ++k) { e4[k] = expf(tv[k] - tv[0]); sum += e4[k]; }
      const float inv = 1.f / sum;
      LAS int* lc = (LAS int*)(lds + 131072 + 8192); lc[t] = 0;
      int rk[4];
#pragma unroll
      for (int k = 0; k < 4; ++k) rk[k] = __hip_atomic_fetch_add(&lc[ti[k]], 1, __ATOMIC_RELAXED, __HIP_MEMORY_SCOPE_WAVEFRONT);
      const int mine = lc[t]; const int base = mine > 0 ? atomicAdd(&cntl[t], mine) : 0; lc[32 + t] = base;
#pragma unroll
      for (int k = 0; k < 4; ++k) { const int pos = lc[32 + ti[k]] + rk[k]; p.TOPE[row * 4 + k] = ti[k]; p.TOPP[row * 4 + k] = pos; p.TOPW[row * 4 + k] = e4[k] * inv;
        __hip_atomic_store(&p.ROWTOK[(size_t)ti[k] * T + pos], row, __ATOMIC_RELAXED, __HIP_MEMORY_SCOPE_AGENT); } }
    __syncthreads(); }
}
struct ConvW { f32x4 w[5][3][2]; };
__device__ __forceinline__ void load_convw(const FP& p, int l, int lane, ConvW& cw) {
  const float* c0 = p.gdn_conv + (size_t)l * 5 * 1536;
#pragma unroll
  for (int j = 0; j < 5; ++j)
#pragma unroll
    for (int blk = 0; blk < 3; ++blk) { cw.w[j][blk][0] = *(const f32x4*)(c0 + j * 1536 + blk * 512 + lane * 8); cw.w[j][blk][1] = *(const f32x4*)(c0 + j * 1536 + blk * 512 + lane * 8 + 4); }
}
__device__ __forceinline__ void prep_gdn_row(const FP& p, int l, int row, int lane, const ConvW& cw) {
  const int s = row % SB; const bool lat = s >= CTX; const int lo = lat ? CTX : 0, hi_ = lat ? SB : CTX;
  float o[3][8];
#pragma unroll
  for (int blk = 0; blk < 3; ++blk) {
#pragma unroll
    for (int e = 0; e < 8; ++e) o[blk][e] = 0.f;
#pragma unroll
    for (int j = 0; j < 5; ++j) { const int s2 = s + j - 2; if (s2 < lo || s2 >= hi_) continue;
      const u32x4 xv = *(const u32x4*)(p.Pb + (size_t)(row + j - 2) * INWP + C_GQ + blk * 512 + lane * 8);
      const f32x4 w0 = cw.w[j][blk][0], w1 = cw.w[j][blk][1];
      o[blk][0] += w0[0] * bflo(xv.x); o[blk][1] += w0[1] * bfhi(xv.x); o[blk][2] += w0[2] * bflo(xv.y); o[blk][3] += w0[3] * bfhi(xv.y);
      o[blk][4] += w1[0] * bflo(xv.z); o[blk][5] += w1[1] * bfhi(xv.z); o[blk][6] += w1[2] * bflo(xv.w); o[blk][7] += w1[3] * bfhi(xv.w); }
#pragma unroll
    for (int e = 0; e < 8; ++e) o[blk][e] = silu_f(o[blk][e]); }
#pragma unroll
  for (int blk = 0; blk < 2; ++blk) { float ss = 0.f;
#pragma unroll
    for (int e = 0; e < 8; ++e) ss += o[blk][e] * o[blk][e];
    ss += shx(ss, 1); ss += shx(ss, 2); ss += shx(ss, 4); ss += shx(ss, 8);
    const float rs = rsqrtf(ss + 1e-6f) * (blk == 0 ? 0.08838834764831845f : 1.f);
#pragma unroll
    for (int e = 0; e < 8; ++e) o[blk][e] *= rs; }
  u32x4 w;
  w.x = cvt_pk_bf16(o[0][0], o[0][1]); w.y = cvt_pk_bf16(o[0][2], o[0][3]); w.z = cvt_pk_bf16(o[0][4], o[0][5]); w.w = cvt_pk_bf16(o[0][6], o[0][7]); *(u32x4*)(p.GQb + (size_t)row * 512 + lane * 8) = w;
  w.x = cvt_pk_bf16(o[1][0], o[1][1]); w.y = cvt_pk_bf16(o[1][2], o[1][3]); w.z = cvt_pk_bf16(o[1][4], o[1][5]); w.w = cvt_pk_bf16(o[1][6], o[1][7]); *(u32x4*)(p.GKb + (size_t)row * 512 + lane * 8) = w;
  w.x = cvt_pk_bf16(o[2][0], o[2][1]); w.y = cvt_pk_bf16(o[2][2], o[2][3]); w.z = cvt_pk_bf16(o[2][4], o[2][5]); w.w = cvt_pk_bf16(o[2][6], o[2][7]); *(u32x4*)(p.GVb + (size_t)row * 512 + lane * 8) = w;
  if (lane < 8) { const float a = p.GAB[(size_t)row * 16 + lane] + p.gdn_dt_bias[l * 8 + lane]; const float xe = __expf(a);
    const float sp = a > 20.f ? a : (xe < 0.03f ? xe * (1.f - xe * (0.5f - xe * (1.f / 3.f))) : __logf(1.f + xe));
    p.GLA[(size_t)row * 8 + lane] = -__expf(p.gdn_a_log[l * 8 + lane]) * sp; p.GBETA[(size_t)row * 8 + lane] = 1.f / (1.f + __expf(-p.GAB[(size_t)row * 16 + 8 + lane])); }
}

typedef float f32x2_t __attribute__((ext_vector_type(2)));
template <int dir, int VAR = 0> __device__ __forceinline__ void g2_item(const FP& p, int bh, int cn, int t, LAS unsigned char* hl) {
  const int b = bh >> 2, h = bh & 3, w = t >> 6, lane = t & 63, c32 = lane & 31, hi = lane >> 5; const size_t row0 = (size_t)b * SB + cn * 64;
  LAS float* sA = (LAS float*)hl; LAS float* sg = sA + 64 * 64; LAS float* sb = sg + 64;
  LAS bf16_t* sK = (LAS bf16_t*)(hl + 16896); LAS bf16_t* sV = sK + 64 * 136; LAS bf16_t* sT1 = sV + 64 * 136; LAS bf16_t* sT2 = sT1 + 64 * 72;
  const int item = item_idx(dir, bh, cn);
  const int ws = (TIDX >> 8) & 1;
#pragma unroll
  for (int i = 0; i < 4; ++i) { const int idx = t + 256 * i, r = idx >> 4, c8 = (idx & 15) * 8;
    *(LAS u32x4*)(sK + r * 136 + c8) = *(const u32x4*)(p.GKb + (row0 + r) * 512 + h * 128 + c8); *(LAS u32x4*)(sV + r * 136 + c8) = *(const u32x4*)(p.GVb + (row0 + r) * 512 + h * 128 + c8); }
  if (w == 0) { float la = p.GLA[(row0 + lane) * 8 + dir * 4 + h]; const float bt = p.GBETA[(row0 + lane) * 8 + dir * 4 + h];
#pragma unroll
    for (int o = 1; o < 64; o <<= 1) { const float v = dir == 0 ? shup(la, o) : shdn(la, o); if (dir == 0 ? lane >= o : lane + o < 64) la += v; }
    sg[lane] = la; sb[lane] = bt; p.GG[(size_t)item * 64 + lane] = la; }
  __syncthreads();
  { const int it = w >> 1, jt = w & 1; f32x16 a;
#pragma unroll
    for (int r = 0; r < 16; ++r) a[r] = 0.f;
    const LAS bf16_t* ka = sK + (32 * it + c32) * 136 + 8 * hi; const LAS bf16_t* kb = sK + (32 * jt + c32) * 136 + 8 * hi;
#pragma unroll
    for (int s = 0; s < 8; ++s) a = __builtin_amdgcn_mfma_f32_32x32x16_bf16(*(const LAS bf16x8*)(ka + 16 * s), *(const LAS bf16x8*)(kb + 16 * s), a, 0, 0, 0);
    const int j = 32 * jt + c32; const float gj = sg[j];
#pragma unroll
    for (int r = 0; r < 16; ++r) { const int i = 32 * it + crow16(r, hi); const bool before = dir == 0 ? j < i : j > i;
      const float v = before ? sb[i] * a[r] * __expf(fminf(sg[i] - gj, 0.f)) : 0.f;
      if (dir == 0) sA[j * 64 + i] = v; else sA[(63 - j) * 64 + (63 - i)] = v; } }
  __syncthreads();
  if (w == ws) { f32x2_t x[32];
#pragma unroll
    for (int q = 0; q < 32; ++q) { x[q][0] = (2 * q == lane) ? 1.f : 0.f; x[q][1] = (2 * q + 1 == lane) ? 1.f : 0.f; }
#pragma unroll
    for (int jp = 0; jp < 63; ++jp) { const float xj = x[jp >> 1][jp & 1]; const f32x2_t xj2 = (f32x2_t){xj, xj};
#pragma unroll
      for (int q = (jp + 1) >> 2; q < 16; ++q) { const f32x4 r = *(const LAS f32x4*)(sA + jp * 64 + 4 * q);
        x[2 * q] = x[2 * q] - (f32x2_t){r[0], r[1]} * xj2; x[2 * q + 1] = x[2 * q + 1] - (f32x2_t){r[2], r[3]} * xj2; } }
    const int j = dir == 0 ? lane : 63 - lane; const float bj = sb[j], bje = bj * __expf(sg[j]);
#pragma unroll
    for (int ip = 0; ip < 64; ++ip) { const int i = dir == 0 ? ip : 63 - ip; const float v = x[ip >> 1][ip & 1]; sT1[i * 72 + j] = f2bf(v * bj); sT2[i * 72 + j] = f2bf(v * bje); }
  } else if (((w - ws - 1) & 3) < 2) { const int d = ((w - ws - 1) & 3) * 64 + lane; bf16_t* kt = p.GKTT + (size_t)item * 8192; const float glast = sg[dir == 0 ? 63 : 0];
#pragma unroll
    for (int grp = 0; grp < 16; ++grp) { const int s4 = grp >> 2, a = (grp >> 1) & 1, hp = grp & 1; float kv4[4];
#pragma unroll
      for (int r3 = 0; r3 < 4; ++r3) { const int i = 16 * s4 + 8 * a + 4 * hp + r3; kv4[r3] = bf2f(sK[i * 136 + d]) * __expf(glast - sg[i]); }
      u32x2 w2; w2.x = cvt_pk_bf16(kv4[0], kv4[1]); w2.y = cvt_pk_bf16(kv4[2], kv4[3]);
      *(u32x2*)(kt + (((d >> 5) * 4 + s4) * 64 + (d & 31) + 32 * hp) * 8 + 4 * a) = w2; } }
  __syncthreads();
  { f32x16 aU[2], aW[2];
#pragma unroll
    for (int it = 0; it < 2; ++it)
#pragma unroll
      for (int r = 0; r < 16; ++r) { aU[it][r] = 0.f; aW[it][r] = 0.f; }
#pragma unroll
    for (int s = 0; s < 4; ++s) { bf16x8 fv, fk;
#pragma unroll
      for (int jj = 0; jj < 8; ++jj) { fv[jj] = sV[(16 * s + 8 * hi + jj) * 136 + 32 * w + c32]; fk[jj] = sK[(16 * s + 8 * hi + jj) * 136 + 32 * w + c32]; }
#pragma unroll
      for (int it = 0; it < 2; ++it) { const bf16x8 t1 = *(const LAS bf16x8*)(sT1 + (32 * it + c32) * 72 + 16 * s + 8 * hi), t2 = *(const LAS bf16x8*)(sT2 + (32 * it + c32) * 72 + 16 * s + 8 * hi);
        aU[it] = __builtin_amdgcn_mfma_f32_32x32x16_bf16(t1, fv, aU[it], 0, 0, 0); aW[it] = __builtin_amdgcn_mfma_f32_32x32x16_bf16(fk, t2, aW[it], 0, 0, 0); } }
    asm volatile("s_nop 9\n\ts_nop 9" : "+v"(aU[0]), "+v"(aU[1]), "+v"(aW[0]), "+v"(aW[1]));
    bf16_t* ut = p.GUT + (size_t)item * 8192; bf16_t* gw = p.GWb + (size_t)item * 8192;
#pragma unroll
    for (int it2 = 0; it2 < 2; ++it2) {
#pragma unroll
      for (int g = 0; g < 4; ++g) { u32x2 w2; w2.x = cvt_pk_bf16(aU[it2][4 * g], aU[it2][4 * g + 1]); w2.y = cvt_pk_bf16(aU[it2][4 * g + 2], aU[it2][4 * g + 3]);
        *(u32x2*)(ut + (((w * 2 + it2) * 4 + g) * 64 + lane) * 4) = w2; }
#pragma unroll
      for (int sl = 0; sl < 2; ++sl) { u32x4 w4; w4.x = cvt_pk_bf16(aW[it2][8 * sl], aW[it2][8 * sl + 1]); w4.y = cvt_pk_bf16(aW[it2][8 * sl + 2], aW[it2][8 * sl + 3]);
        w4.z = cvt_pk_bf16(aW[it2][8 * sl + 4], aW[it2][8 * sl + 5]); w4.w = cvt_pk_bf16(aW[it2][8 * sl + 6], aW[it2][8 * sl + 7]);
        *(u32x4*)(gw + ((it2 * 8 + 2 * w + sl) * 64 + lane) * 8) = w4; } } }
  __syncthreads();
}

__device__ void gdn_scan_job(const FP& p, int bh, int dir, LAS unsigned char* lds) {
  const int t = TIDX, wid = __builtin_amdgcn_readfirstlane(t >> 6), lane = t & 63, hi = lane >> 5;
  f32x16 S[4];
#pragma unroll
  for (int d = 0; d < 4; ++d)
#pragma unroll
    for (int r = 0; r < 16; ++r) S[d][r] = 0.f;
#define GS_STAGE(cn, buf) do { const size_t io = (size_t)item_idx(dir, bh, (cn)) * 8192 * 2 + (size_t)(wid - 4) * 1024 + (size_t)lane * 16; const char* g0 = (const char*)p.GWb + io; const char* g1 = (const char*)p.GKTT + io; const char* g2 = (const char*)p.GUT + io; \
    LAS unsigned char* lb = lds + (buf) * 49152 + (wid - 4) * 1024; \
    _Pragma("unroll") for (int q_ = 0; q_ < 4; ++q_) { __builtin_amdgcn_global_load_lds((const unsigned*)(g0 + q_ * 4096), (LAS unsigned*)(lb + q_ * 4096), 16, 0, 0); \
      __builtin_amdgcn_global_load_lds((const unsigned*)(g1 + q_ * 4096), (LAS unsigned*)(lb + 16384 + q_ * 4096), 16, 0, 0); __builtin_amdgcn_global_load_lds((const unsigned*)(g2 + q_ * 4096), (LAS unsigned*)(lb + 32768 + q_ * 4096), 16, 0, 0); } } while (0)
  float dec0, dec1;
  { const int n0 = lane, n1 = 64 + (lane & 3); dec0 = __expf(p.GG[(size_t)item_idx(dir, bh, scan_chunk(dir, n0)) * 64 + (dir == 0 ? 63 : 0)]);
    dec1 = __expf(p.GG[(size_t)item_idx(dir, bh, scan_chunk(dir, n1)) * 64 + (dir == 0 ? 63 : 0)]); }
  __syncthreads();
  if (wid >= 4) { GS_STAGE(scan_chunk(dir, 0), 0); GS_STAGE(scan_chunk(dir, 1), 1); }
  for (int n = 0; n < NCH; ++n) { const int cn = scan_chunk(dir, n), buf = n % 3;
    if (wid >= 4) { if (n + 1 < NCH) asm volatile("s_waitcnt vmcnt(12)" ::: "memory"); else asm volatile("s_waitcnt vmcnt(0)" ::: "memory"); }
    __builtin_amdgcn_s_barrier(); asm volatile("" ::: "memory");
    if (wid >= 4) { if (n + 2 < NCH) GS_STAGE(scan_chunk(dir, n + 2), (n + 2) % 3); }
    if (wid < 4) { const int item = item_idx(dir, bh, cn);
      const float adec = __uint_as_float(__builtin_amdgcn_readlane(__float_as_uint(n < 64 ? dec0 : dec1), n & 63));
      asm volatile("s_nop 9\n\ts_nop 9" : "+v"(S[3]), "+v"(S[2]), "+v"(S[1]), "+v"(S[0]));
      bf16_t* st = p.GST + (size_t)item * 16384;
#pragma unroll
      for (int dt = 0; dt < 4; ++dt)
#pragma unroll
        for (int g = 0; g < 4; ++g) { u32x2 w; w.x = cvt_pk_bf16(S[dt][4 * g], S[dt][4 * g + 1]); w.y = cvt_pk_bf16(S[dt][4 * g + 2], S[dt][4 * g + 3]);
#ifdef PROBE_NOSTORE
          if (n == 1000)
#endif
          *(u32x2*)(st + ((wid * 8 + 2 * dt + (g >> 1)) * 64 + (lane & 31) + 32 * (g & 1)) * 8 + 4 * hi) = w; }
      const LAS unsigned char* bb = lds + buf * 49152;
      f32x16 vn[2];
#pragma unroll
      for (int it = 0; it < 2; ++it)
#pragma unroll
        for (int r = 0; r < 16; ++r) vn[it][r] = 0.f;
      bf16x8 wf[2][8];
#pragma unroll
      for (int it = 0; it < 2; ++it)
#pragma unroll
        for (int s = 0; s < 8; ++s) wf[it][s] = *(const LAS bf16x8*)(bb + (it * 8 + s) * 1024 + lane * 16);
#pragma unroll
      for (int s = 0; s < 8; ++s) { const bf16x8 sf = pack_step(S[s >> 1], s & 1);
#pragma unroll
        for (int it = 0; it < 2; ++it) vn[it] = __builtin_amdgcn_mfma_f32_32x32x16_bf16(wf[it][s], sf, vn[it], 0, 0, 0); }
      bf16x8 kf[4][4];
#pragma unroll
      for (int dt = 0; dt < 4; ++dt)
#pragma unroll
        for (int s = 0; s < 4; ++s) kf[dt][s] = *(const LAS bf16x8*)(bb + 16384 + (dt * 4 + s) * 1024 + lane * 16);
      bf16_t* vt = p.GVNT + (size_t)item * 8192;
#pragma unroll
      for (int it = 0; it < 2; ++it)
#pragma unroll
        for (int g = 0; g < 4; ++g) { const u32x2 uu = *(const LAS u32x2*)(bb + 32768 + (((wid * 2 + it) * 4 + g) * 64 + lane) * 8);
          vn[it][4 * g] = bflo(uu.x) - vn[it][4 * g]; vn[it][4 * g + 1] = bfhi(uu.x) - vn[it][4 * g + 1]; vn[it][4 * g + 2] = bflo(uu.y) - vn[it][4 * g + 2]; vn[it][4 * g + 3] = bfhi(uu.y) - vn[it][4 * g + 3];
          u32x2 w; w.x = cvt_pk_bf16(vn[it][4 * g], vn[it][4 * g + 1]); w.y = cvt_pk_bf16(vn[it][4 * g + 2], vn[it][4 * g + 3]);
#ifdef PROBE_NOSTORE
          if (n == 1000)
#endif
          *(u32x2*)(vt + ((wid * 4 + 2 * it + (g >> 1)) * 64 + lane) * 8 + 4 * (g & 1)) = w; }
#pragma unroll
      for (int dt = 0; dt < 4; ++dt)
#pragma unroll
        for (int r = 0; r < 16; ++r) S[dt][r] *= adec;
#pragma unroll
      for (int s = 0; s < 4; ++s) { const bf16x8 vf = pack_step(vn[s >> 1], s & 1);
#pragma unroll
        for (int dt = 0; dt < 4; ++dt) S[dt] = __builtin_amdgcn_mfma_f32_32x32x16_bf16(kf[dt][s], vf, S[dt], 0, 0, 0); }
    }
  }
  asm volatile("s_waitcnt vmcnt(0)" ::: "memory"); __syncthreads();
#undef GS_STAGE
}

__device__ void gdn_out_unit(const FP& p, int l, int bh, int cn, int ih, int lane) {
  const int b = bh >> 2, h = bh & 3, c32 = lane & 31, hi = lane >> 5; const size_t row0 = (size_t)b * SB + cn * 64; const int ipos = 32 * ih + c32;
  const unsigned lo16 = (unsigned)lane * 16u;
  const int itf = item_idx(0, bh, cn), itb = item_idx(1, bh, cn);
  f32x16 P0, P1;
#pragma unroll
  for (int r = 0; r < 16; ++r) { P0[r] = 0.f; P1[r] = 0.f; }
  const char* qb = (const char*)(p.GQb + (row0 + 32 * ih) * 512 + h * 128); const char* kb = (const char*)(p.GKb + row0 * 512 + h * 128);
  const unsigned rowoff = (unsigned)(c32 * 512 + 8 * hi) * 2u;
#pragma unroll 1
  for (int s = 0; s < 8; ++s) { const bf16x8 qf = *(const bf16x8*)(qb + rowoff + s * 32); const bf16x8 k0 = *(const bf16x8*)(kb + rowoff + s * 32), k1 = *(const bf16x8*)(kb + 32 * 1024 + rowoff + s * 32);
    P0 = __builtin_amdgcn_mfma_f32_32x32x16_bf16(k0, qf, P0, 0, 0, 0); P1 = __builtin_amdgcn_mfma_f32_32x32x16_bf16(k1, qf, P1, 0, 0, 0); }
  const float* ggf = p.GG + (size_t)itf * 64; const float* ggb = p.GG + (size_t)itb * 64;
  const float gfi = ggf[ipos], gbi = ggb[ipos];
  bf16x8 pb[2][2][2];
#pragma unroll
  for (int dir = 0; dir < 2; ++dir) { const float* gg = dir == 0 ? ggf : ggb; const float gi = dir == 0 ? gfi : gbi;
#pragma unroll
    for (int jt = 0; jt < 2; ++jt) { f32x16 pd;
#pragma unroll
      for (int g = 0; g < 4; ++g) { const f32x4 gj = *(const f32x4*)(gg + 32 * jt + 8 * g + 4 * hi);
#pragma unroll
        for (int r3 = 0; r3 < 4; ++r3) { const int r = 4 * g + r3; const int j = 32 * jt + 8 * g + 4 * hi + r3; const bool ok = dir == 0 ? j <= ipos : j >= ipos; const float pv = jt == 0 ? P0[r] : P1[r];
          pd[r] = ok ? pv * __expf(fminf(gi - gj[r3], 0.f)) : 0.f; } }
      pb[dir][jt][0] = pack_step(pd, 0); pb[dir][jt][1] = pack_step(pd, 1); } }
  __builtin_amdgcn_sched_barrier(0);
  f32x16 O[4];
  const char* vaf = (const char*)(p.GVNT + (size_t)itf * 8192); const char* vab = (const char*)(p.GVNT + (size_t)itb * 8192);
#pragma unroll
  for (int et = 0; et < 4; ++et) { f32x16 a;
#pragma unroll
    for (int r = 0; r < 16; ++r) a[r] = 0.f;
#pragma unroll
    for (int jt = 0; jt < 2; ++jt)
#pragma unroll
      for (int ss = 0; ss < 2; ++ss) { const bf16x8 af = *(const bf16x8*)(vaf + et * 4096 + lo16 + (2 * jt + ss) * 1024), ab = *(const bf16x8*)(vab + et * 4096 + lo16 + (2 * jt + ss) * 1024);
        a = __builtin_amdgcn_mfma_f32_32x32x16_bf16(af, pb[0][jt][ss], a, 0, 0, 0); a = __builtin_amdgcn_mfma_f32_32x32x16_bf16(ab, pb[1][jt][ss], a, 0, 0, 0); }
    O[et] = a; __builtin_amdgcn_sched_barrier(0); }
  const float facf = __expf(gfi), facb = __expf(gbi);
  const char* stf = (const char*)(p.GST + (size_t)itf * 16384); const char* stb = (const char*)(p.GST + (size_t)itb * 16384);
#pragma unroll 1
  for (int s = 0; s < 8; ++s) { const bf16x8 qf = *(const bf16x8*)(qb + rowoff + s * 32); const bf16x8 qsf = scale_frag(qf, facf), qsb = scale_frag(qf, facb);
#pragma unroll
    for (int et = 0; et < 4; ++et) { const bf16x8 af = *(const bf16x8*)(stf + et * 8192 + s * 1024 + lo16), ab = *(const bf16x8*)(stb + et * 8192 + s * 1024 + lo16);
      O[et] = __builtin_amdgcn_mfma_f32_32x32x16_bf16(af, qsf, O[et], 0, 0, 0); O[et] = __builtin_amdgcn_mfma_f32_32x32x16_bf16(ab, qsb, O[et], 0, 0, 0); } }
  float ss2 = 0.f;
#pragma unroll
  for (int et = 0; et < 4; ++et)
#pragma unroll
    for (int r = 0; r < 16; ++r) ss2 += O[et][r] * O[et][r];
  ss2 += shx(ss2, 32); const float rs = rsqrtf(ss2 * (1.f / 128.f) + 1e-6f);
  const size_t row = row0 + ipos; const bf16_t* zp = p.Pb + row * INWP + C_GZ + h * 128; const float* gr = p.g_gdn + l * 128; bf16_t* op = p.CATb + row * 1536 + 1024 + h * 128;
#pragma unroll
  for (int et = 0; et < 4; ++et)
#pragma unroll
    for (int g = 0; g < 4; ++g) { const int e0 = 32 * et + 8 * g + 4 * hi; const u32x2 gz = *(const u32x2*)(zp + e0); const f32x4 gg = *(const f32x4*)(gr + e0);
      const float z[4] = {bflo(gz.x), bfhi(gz.x), bflo(gz.y), bfhi(gz.y)}; float y[4];
#pragma unroll
      for (int j = 0; j < 4; ++j) y[j] = O[et][4 * g + j] * rs * gg[j] * silu_f(z[j]);
      u32x2 w; w.x = cvt_pk_bf16(y[0], y[1]); w.y = cvt_pk_bf16(y[2], y[3]); *(u32x2*)(op + e0) = w; }
}
template <bool GDN> __device__ __forceinline__ void post_unit(const FP& p, int l, int bh, int cn, LAS float* stats) {
  const int t = TIDX, wid = t >> 6, lane = t & 63, ih = wid >> 2, et = wid & 3, c32 = lane & 31, hi = lane >> 5;
  const int b = bh >> 2, h = bh & 3; const size_t row0 = (size_t)b * SB + cn * 64; const int ipos = 32 * ih + c32;
  const int itf = item_idx(0, bh, cn), itb = item_idx(1, bh, cn);
  const unsigned lo16 = (unsigned)lane * 16u;
  const bf16_t* Qp = GDN ? p.GQb : p.RQb; const bf16_t* Kp = GDN ? p.GKb : p.RKb; const bf16_t* STp = GDN ? p.GST : p.RST;
  bf16x8 qf[8], kf0[8], kf1[8], sf[8], sb[8];
  { const char* qb = (const char*)(Qp + (row0 + ipos) * 512 + h * 128 + 8 * hi); const char* kb = (const char*)(Kp + (row0 + c32) * 512 + h * 128 + 8 * hi);
#pragma unroll
    for (int s = 0; s < 8; ++s) qf[s] = *(const bf16x8*)(qb + s * 32);
#pragma unroll
    for (int s = 0; s < 8; ++s) kf0[s] = *(const bf16x8*)(kb + s * 32);
#pragma unroll
    for (int s = 0; s < 8; ++s) kf1[s] = *(const bf16x8*)(kb + 32 * 1024 + s * 32);
    const char* stf = (const char*)(STp + (size_t)itf * 16384) + et * 8192 + lo16; const char* stb = (const char*)(STp + (size_t)itb * 16384) + et * 8192 + lo16;
#pragma unroll
    for (int s = 0; s < 8; ++s) sf[s] = *(const bf16x8*)(stf + s * 1024);
    (void)stb; }
  const float* ggf = p.GG + (size_t)itf * 64; const float* ggb = p.GG + (size_t)itb * 64;
  float gfi = 0.f, gbi = 0.f, lgf = 0.f, lgb = 0.f;
  if (GDN) { gfi = ggf[ipos]; gbi = ggb[ipos]; }
  else { lgf = __log2f(1.f - __expf(p.ret_decay[l * 8 + h])); lgb = __log2f(1.f - __expf(p.ret_decay[l * 8 + 4 + h])); }
  f32x16 P0, P1;
#pragma unroll
  for (int r = 0; r < 16; ++r) { P0[r] = 0.f; P1[r] = 0.f; }
#pragma unroll
  for (int s = 0; s < 8; ++s) { P0 = __builtin_amdgcn_mfma_f32_32x32x16_bf16(kf0[s], qf[s], P0, 0, 0, 0); P1 = __builtin_amdgcn_mfma_f32_32x32x16_bf16(kf1[s], qf[s], P1, 0, 0, 0); }
  { const char* stb = (const char*)(STp + (size_t)itb * 16384) + et * 8192 + lo16;
#pragma unroll
    for (int s = 0; s < 8; ++s) sb[s] = *(const bf16x8*)(stb + s * 1024); }
  bf16x8 vf[4], vb[4];
  { const char* vaf = (const char*)(GDN ? p.GVNT + (size_t)itf * 8192 : p.RVTA + ((size_t)bh * NCH + cn) * 8192) + et * 4096 + lo16;
#pragma unroll
    for (int s = 0; s < 4; ++s) vf[s] = *(const bf16x8*)(vaf + s * 1024);
    if (GDN) { const char* vab = (const char*)(p.GVNT + (size_t)itb * 8192) + et * 4096 + lo16;
#pragma unroll
      for (int s = 0; s < 4; ++s) vb[s] = *(const bf16x8*)(vab + s * 1024); }
    else {
#pragma unroll
      for (int s = 0; s < 4; ++s) vb[s] = vf[s]; } }
  f32x16 O;
#pragma unroll
  for (int r = 0; r < 16; ++r) O[r] = 0.f;
#pragma unroll
  for (int dir = 0; dir < 2; ++dir)
#pragma unroll
    for (int jt = 0; jt < 2; ++jt) { f32x16 pd;
#pragma unroll
      for (int g = 0; g < 4; ++g) { f32x4 gj4 = (f32x4){0.f, 0.f, 0.f, 0.f}; if (GDN) gj4 = *(const f32x4*)((dir == 0 ? ggf : ggb) + 32 * jt + 8 * g + 4 * hi);
#pragma unroll
        for (int r3 = 0; r3 < 4; ++r3) { const int r = 4 * g + r3; const int j = 32 * jt + 8 * g + 4 * hi + r3; const float pv = jt == 0 ? P0[r] : P1[r]; float w;
          if (GDN) { const bool ok = dir == 0 ? j <= ipos : j >= ipos; const float gi = dir == 0 ? gfi : gbi; const float gj = gj4[r3]; w = ok ? __expf(fminf(gi - gj, 0.f)) : 0.f; }
          else { const int dlt = dir == 0 ? ipos - j : j - ipos; w = dlt >= 0 ? exp2f((dir == 0 ? lgf : lgb) * (float)dlt) : 0.f; }
          pd[r] = pv * w; } }
#pragma unroll
      for (int ss = 0; ss < 2; ++ss) { const bf16x8 pbf = pack_step(pd, ss); O = __builtin_amdgcn_mfma_f32_32x32x16_bf16(dir == 0 ? vf[2 * jt + ss] : vb[2 * jt + ss], pbf, O, 0, 0, 0); } }
  { const float facf = GDN ? __expf(gfi) : exp2f(lgf * (float)(ipos + 1)), facb = GDN ? __expf(gbi) : exp2f(lgb * (float)(64 - ipos));
#pragma unroll
    for (int s = 0; s < 8; ++s) { const bf16x8 qsf = scale_frag(qf[s], facf), qsb = scale_frag(qf[s], facb);
      O = __builtin_amdgcn_mfma_f32_32x32x16_bf16(sf[s], qsf, O, 0, 0, 0); O = __builtin_amdgcn_mfma_f32_32x32x16_bf16(sb[s], qsb, O, 0, 0, 0); } }
  float s1 = 0.f, s2 = 0.f;
#pragma unroll
  for (int r = 0; r < 16; ++r) { s1 += O[r]; s2 += O[r] * O[r]; }
  s1 += shx(s1, 32); s2 += shx(s2, 32);
  if (hi == 0) { stats[((ih * 4 + et) * 32 + c32) * 2] = s1; stats[((ih * 4 + et) * 32 + c32) * 2 + 1] = s2; }
  __syncthreads();
  float t1 = 0.f, t2 = 0.f;
#pragma unroll
  for (int e2 = 0; e2 < 4; ++e2) { t1 += stats[((ih * 4 + e2) * 32 + c32) * 2]; t2 += stats[((ih * 4 + e2) * 32 + c32) * 2 + 1]; }
  float mu, rs;
  if (GDN) { mu = 0.f; rs = rsqrtf(t2 * (1.f / 128.f) + 1e-6f); }
  else { mu = t1 * (1.f / 128.f); rs = rsqrtf(fmaxf(t2 * (1.f / 128.f) - mu * mu, 0.f) + 1e-5f); }
  const size_t row = row0 + ipos; const bf16_t* gp = p.Pb + row * INWP + (GDN ? C_GZ : C_RG) + h * 128; const float* gr = GDN ? p.g_gdn + l * 128 : p.g_ret + l * 512 + h * 128;
  bf16_t* op = p.CATb + row * 1536 + (GDN ? 1024 : 512) + h * 128;
#pragma unroll
  for (int g = 0; g < 4; ++g) { const int e0 = 32 * et + 8 * g + 4 * hi; const u32x2 gz = *(const u32x2*)(gp + e0); const f32x4 gg = *(const f32x4*)(gr + e0);
    const float z[4] = {bflo(gz.x), bfhi(gz.x), bflo(gz.y), bfhi(gz.y)}; float y[4];
#pragma unroll
    for (int j = 0; j < 4; ++j) y[j] = (O[4 * g + j] - mu) * rs * gg[j] * silu_f(z[j]);
    u32x2 w; w.x = cvt_pk_bf16(y[0], y[1]); w.y = cvt_pk_bf16(y[2], y[3]); *(u32x2*)(op + e0) = w; }
}
__device__ __forceinline__ void ph_post2(const FP& p, int l, LAS unsigned char* lds) {
  const int t = TIDX, lane = t & 63, gw = blockIdx.x * NWAVES + (t >> 6), GWN = gridDim.x * NWAVES;
  for (int row = gw; row < T; row += GWN) mla_out_row(p, l, row, lane);
  int par = 0;
  const int nch = (l == DEPTH - 1) ? NCH - 4 : NCH, c0 = NCH - nch;
  for (int u = blockIdx.x; u < 2 * 16 * nch; u += gridDim.x, par ^= 1) { const int m = u & 1, uu = u >> 1;
    if (m) post_unit<true>(p, l, uu / nch, c0 + uu % nch, (LAS float*)lds + par * 512); else post_unit<false>(p, l, uu / nch, c0 + uu % nch, (LAS float*)lds + par * 512); }
}
namespace p3 { constexpr int OK_ = 0, OQ = 16384, OSF = 32768, OSB = 65536, OVF = 98304, OVB = 114688, OST = 131072; }
template <bool GDN> __device__ __forceinline__ void post3_stage(const FP& p, int bh, int cn, LAS unsigned char* lds) {
  const int t = TIDX, wid = __builtin_amdgcn_readfirstlane(t >> 6), lane = t & 63;
  const int b = bh >> 2, h = bh & 3; const size_t row0 = (size_t)b * SB + cn * 64;
  const int itf = item_idx(0, bh, cn), itb = item_idx(1, bh, cn);
  const bf16_t* Kp = (GDN ? p.GKb : p.RKb) + row0 * 512 + h * 128; const bf16_t* Qp = (GDN ? p.GQb : p.RQb) + row0 * 512 + h * 128;
#pragma unroll
  for (int q = 0; q < 2; ++q) { const int pc = wid + 8 * q, row = 4 * pc + (lane >> 4), ch = (lane & 15) ^ (row & 7);
    __builtin_amdgcn_global_load_lds((const unsigned*)(Kp + (size_t)row * 512 + ch * 8), (LAS unsigned*)(lds + p3::OK_ + pc * 1024), 16, 0, 0);
    __builtin_amdgcn_global_load_lds((const unsigned*)(Qp + (size_t)row * 512 + ch * 8), (LAS unsigned*)(lds + p3::OQ + pc * 1024), 16, 0, 0); }
  const char* sf = (const char*)((GDN ? p.GST : p.RST) + (size_t)itf * 16384) + lane * 16; const char* sb = (const char*)((GDN ? p.GST : p.RST) + (size_t)itb * 16384) + lane * 16;
#pragma unroll
  for (int q = 0; q < 4; ++q) { const int pc = wid + 8 * q;
    __builtin_amdgcn_global_load_lds((const unsigned*)(sf + pc * 1024), (LAS unsigned*)(lds + p3::OSF + pc * 1024), 16, 0, 0);
    __builtin_amdgcn_global_load_lds((const unsigned*)(sb + pc * 1024), (LAS unsigned*)(lds + p3::OSB + pc * 1024), 16, 0, 0); }
  const char* vf = (const char*)(GDN ? p.GVNT + (size_t)itf * 8192 : p.RVTA + ((size_t)bh * NCH + cn) * 8192) + lane * 16;
#pragma unroll
  for (int q = 0; q < 2; ++q) { const int pc = wid + 8 * q; __builtin_amdgcn_global_load_lds((const unsigned*)(vf + pc * 1024), (LAS unsigned*)(lds + p3::OVF + pc * 1024), 16, 0, 0); }
  if (GDN) { const char* vb = (const char*)(p.GVNT + (size_t)itb * 8192) + lane * 16;
#pragma unroll
    for (int q = 0; q < 2; ++q) { const int pc = wid + 8 * q; __builtin_amdgcn_global_load_lds((const unsigned*)(vb + pc * 1024), (LAS unsigned*)(lds + p3::OVB + pc * 1024), 16, 0, 0); } }
}
#define P3SWZ(row, ch) ((row) * 256 + (((ch) ^ ((row) & 7)) << 4))
template <bool GDN, bool NGDN> __device__ __forceinline__ void post3_unit(const FP& p, int l, int bh, int cn, LAS unsigned char* lds, int par, bool hasnext, int nbh, int ncn) {
  const int t = TIDX, wid = t >> 6, lane = t & 63, ih = wid >> 2, et = wid & 3, c32 = lane & 31, hi = lane >> 5;
  const int b = bh >> 2, h = bh & 3; const size_t row0 = (size_t)b * SB + cn * 64; const int ipos = 32 * ih + c32;
  const int itf = item_idx(0, bh, cn), itb = item_idx(1, bh, cn);
  LAS float* stats = (LAS float*)(lds + p3::OST) + par * 512;
  const float* ggf = p.GG + (size_t)itf * 64; const float* ggb = p.GG + (size_t)itb * 64;
  float gfi = 0.f, gbi = 0.f, lgf = 0.f, lgb = 0.f;
  if (GDN) { gfi = ggf[ipos]; gbi = ggb[ipos]; }
  else { lgf = __log2f(1.f - __expf(p.ret_decay[l * 8 + h])); lgb = __log2f(1.f - __expf(p.ret_decay[l * 8 + 4 + h])); }
  const size_t row = row0 + ipos; const bf16_t* gp = p.Pb + row * INWP + (GDN ? C_GZ : C_RG) + h * 128; const float* gr = GDN ? p.g_gdn + l * 128 : p.g_ret + l * 512 + h * 128;
  u32x2 gz[4]; f32x4 gg[4];
#pragma unroll
  for (int g = 0; g < 4; ++g) { const int e0 = 32 * et + 8 * g + 4 * hi; gz[g] = *(const u32x2*)(gp + e0); gg[g] = *(const f32x4*)(gr + e0); }
  bf16x8 qf[8];
  { const int qr = 32 * ih + c32;
#pragma unroll
    for (int s = 0; s < 8; ++s) qf[s] = *(const LAS bf16x8*)(lds + p3::OQ + P3SWZ(qr, 2 * s + hi)); }
  f32x16 P0, P1;
#pragma unroll
  for (int r = 0; r < 16; ++r) { P0[r] = 0.f; P1[r] = 0.f; }
#pragma unroll
  for (int s = 0; s < 8; ++s) { const bf16x8 k0 = *(const LAS bf16x8*)(lds + p3::OK_ + P3SWZ(c32, 2 * s + hi)), k1 = *(const LAS bf16x8*)(lds + p3::OK_ + P3SWZ(32 + c32, 2 * s + hi));
    P0 = __builtin_amdgcn_mfma_f32_32x32x16_bf16(k0, qf[s], P0, 0, 0, 0); P1 = __builtin_amdgcn_mfma_f32_32x32x16_bf16(k1, qf[s], P1, 0, 0, 0); }
  f32x16 O;
#pragma unroll
  for (int r = 0; r < 16; ++r) O[r] = 0.f;
#pragma unroll
  for (int dir = 0; dir < 2; ++dir)
#pragma unroll
    for (int jt = 0; jt < 2; ++jt) { f32x16 pd;
#pragma unroll
      for (int g = 0; g < 4; ++g) { f32x4 gj4 = (f32x4){0.f, 0.f, 0.f, 0.f}; if (GDN) gj4 = *(const f32x4*)((dir == 0 ? ggf : ggb) + 32 * jt + 8 * g + 4 * hi);
#pragma unroll
        for (int r3 = 0; r3 < 4; ++r3) { const int r = 4 * g + r3; const int j = 32 * jt + 8 * g + 4 * hi + r3; const float pv = jt == 0 ? P0[r] : P1[r]; float w;
          if (GDN) { const bool ok = dir == 0 ? j <= ipos : j >= ipos; const float gi = dir == 0 ? gfi : gbi; w = ok ? __expf(fminf(gi - gj4[r3], 0.f)) : 0.f; }
          else { const int dlt = dir == 0 ? ipos - j : j - ipos; w = dlt >= 0 ? exp2f((dir == 0 ? lgf : lgb) * (float)dlt) : 0.f; }
          pd[r] = pv * w; } }
#pragma unroll
      for (int ss = 0; ss < 2; ++ss) { const bf16x8 pbf = pack_step(pd, ss);
        const bf16x8 vfr = *(const LAS bf16x8*)(lds + ((GDN && dir == 1) ? p3::OVB : p3::OVF) + (et * 4 + 2 * jt + ss) * 1024 + lane * 16);
        O = __builtin_amdgcn_mfma_f32_32x32x16_bf16(vfr, pbf, O, 0, 0, 0); } }
  { const float facf = GDN ? __expf(gfi) : exp2f(lgf * (float)(ipos + 1)), facb = GDN ? __expf(gbi) : exp2f(lgb * (float)(64 - ipos));
#pragma unroll
    for (int s = 0; s < 8; ++s) { const bf16x8 qsf = scale_frag(qf[s], facf), qsb = scale_frag(qf[s], facb);
      const bf16x8 sfr = *(const LAS bf16x8*)(lds + p3::OSF + (et * 8 + s) * 1024 + lane * 16), sbr = *(const LAS bf16x8*)(lds + p3::OSB + (et * 8 + s) * 1024 + lane * 16);
      O = __builtin_amdgcn_mfma_f32_32x32x16_bf16(sfr, qsf, O, 0, 0, 0); O = __builtin_amdgcn_mfma_f32_32x32x16_bf16(sbr, qsb, O, 0, 0, 0); } }
  float fz[16];
#pragma unroll
  for (int g = 0; g < 4; ++g) { fz[4 * g] = gg[g][0] * silu_f(bflo(gz[g].x)); fz[4 * g + 1] = gg[g][1] * silu_f(bfhi(gz[g].x)); fz[4 * g + 2] = gg[g][2] * silu_f(bflo(gz[g].y)); fz[4 * g + 3] = gg[g][3] * silu_f(bfhi(gz[g].y)); }
  float s1 = 0.f, s2 = 0.f;
#pragma unroll
  for (int r = 0; r < 16; ++r) { s1 += O[r]; s2 += O[r] * O[r]; }
  s1 += shx(s1, 32); s2 += shx(s2, 32);
  if (hi == 0) { stats[((ih * 4 + et) * 32 + c32) * 2] = s1; stats[((ih * 4 + et) * 32 + c32) * 2 + 1] = s2; }
  __syncthreads();
  if (hasnext) post3_stage<NGDN>(p, nbh, ncn, lds);
  float t1 = 0.f, t2 = 0.f;
#pragma unroll
  for (int e2 = 0; e2 < 4; ++e2) { t1 += stats[((ih * 4 + e2) * 32 + c32) * 2]; t2 += stats[((ih * 4 + e2) * 32 + c32) * 2 + 1]; }
  float mu, rs;
  if (GDN) { mu = 0.f; rs = rsqrtf(t2 * (1.f / 128.f) + 1e-6f); }
  else { mu = t1 * (1.f / 128.f); rs = rsqrtf(fmaxf(t2 * (1.f / 128.f) - mu * mu, 0.f) + 1e-5f); }
  bf16_t* op = p.CATb + row * 1536 + (GDN ? 1024 : 512) + h * 128;
#pragma unroll
  for (int g = 0; g < 4; ++g) { const int e0 = 32 * et + 8 * g + 4 * hi; float y[4];
#pragma unroll
    for (int j = 0; j < 4; ++j) y[j] = (O[4 * g + j] - mu) * rs * fz[4 * g + j];
    u32x2 w; w.x = cvt_pk_bf16(y[0], y[1]); w.y = cvt_pk_bf16(y[2], y[3]); *(u32x2*)(op + e0) = w; }
}
__device__ __forceinline__ void ph_post3(const FP& p, int l, LAS unsigned char* lds) {
  const int t = TIDX, lane = t & 63, gw = blockIdx.x * NWAVES + (t >> 6), GWN = gridDim.x * NWAVES;
  for (int row = gw; row < T; row += GWN) mla_out_row(p, l, row, lane);
  const int nch = (l == DEPTH - 1) ? NCH - 4 : NCH, c0 = NCH - nch, NU = 16 * nch, G = gridDim.x;
  int u = blockIdx.x; if (u >= 2 * NU) return;
  __syncthreads();
  if (u < NU) post3_stage<false>(p, u / nch, c0 + u % nch, lds); else post3_stage<true>(p, (u - NU) / nch, c0 + (u - NU) % nch, lds);
  for (int par = 0; u < 2 * NU; u += G, par ^= 1) { const int un = u + G; const bool hasnext = un < 2 * NU; const bool gd = u >= NU, ngd = un >= NU;
    const int uu = gd ? u - NU : u, vv = ngd ? un - NU : un; const int bh = uu / nch, cn = c0 + uu % nch, nbh = vv / nch, ncn = c0 + vv % nch;
    asm volatile("s_waitcnt vmcnt(0)" ::: "memory"); __syncthreads();
    if (!gd) { if (ngd) post3_unit<false, true>(p, l, bh, cn, lds, par, hasnext, nbh, ncn); else post3_unit<false, false>(p, l, bh, cn, lds, par, hasnext, nbh, ncn); }
    else post3_unit<true, true>(p, l, bh, cn, lds, par, hasnext, nbh, ncn); }
}
#define XB_TMO      128
#define XB_XCNT(j)  (256  + 64 * (j))
#define XB_XSUB(j)  (1280 + 64 * (j))
#define XB_XGEN(j)  (2304 + 64 * (j))
#define XB_TOP      3328
#define XB_TOPGEN   3392
#define XCD_BAR_WORDS 3456
#define XB_SPIN_CAP (1u << 18)

__device__ __forceinline__ unsigned xb_ld(unsigned* p)              { return __hip_atomic_load(p, __ATOMIC_RELAXED, __HIP_MEMORY_SCOPE_AGENT); }
__device__ __forceinline__ unsigned xb_add(unsigned* p, unsigned v) { return __hip_atomic_fetch_add(p, v, __ATOMIC_RELAXED, __HIP_MEMORY_SCOPE_AGENT); }
__device__ __forceinline__ unsigned xb_xcc_id() { return (unsigned)__builtin_amdgcn_s_getreg((3 << 11) | 20) & 0xFu; }
#define XB_SPIN(cond, bar) do { unsigned _sp = 0; while (cond) { __builtin_amdgcn_s_sleep(1); \
    if ((++_sp & 255u) == 0u) { if (xb_ld(&(bar)[XB_TMO])) break; if (_sp > XB_SPIN_CAP) { atomicAdd(&(bar)[XB_TMO], 1u); break; } } } } while (0)

struct XcdBarrier {
    unsigned* bar; unsigned x;
    volatile LAS unsigned* st;
};

__device__ __forceinline__ XcdBarrier xcd_barrier_post(unsigned* bar, volatile LAS unsigned* st) {
    XcdBarrier b; b.bar = bar; b.x = xb_xcc_id(); b.st = st;
    if (threadIdx.x == 0) (void)xb_add(&bar[XB_XCNT(b.x)], 1u);
    return b;
}
__device__ __forceinline__ void xcd_barrier_complete(unsigned* bar, unsigned x, unsigned& nloc, unsigned& nx) {
    const unsigned G = gridDim.x * gridDim.y * gridDim.z;
    unsigned sum, cnt, mine, sp = 0u;
    for (;;) {
        sum = 0u; cnt = 0u; mine = 0u;
#pragma unroll
        for (unsigned j = 0; j < 16; ++j) { const unsigned c = xb_ld(&bar[XB_XCNT(j)]); sum += c; cnt += (c > 0u) ? 1u : 0u; mine = (j == x) ? c : mine; }
        if (sum == G) break;
        __builtin_amdgcn_s_sleep(1);
        if ((++sp & 255u) == 0u) { if (xb_ld(&bar[XB_TMO])) break; if (sp > XB_SPIN_CAP) { atomicAdd(&bar[XB_TMO], 1u); break; } }
    }
    nloc = mine > 0u ? mine : 1u; nx = cnt > 0u ? cnt : 1u;
}

__device__ __forceinline__ void xcd_barrier(const XcdBarrier& b) {
    asm volatile("s_waitcnt vmcnt(0)" ::: "memory");
    __syncthreads();
    if (threadIdx.x == 0) {
        unsigned* bar = b.bar; unsigned bx = b.x; asm volatile("" : "+s"(bx));
        __builtin_amdgcn_s_waitcnt(0);
        unsigned nloc = b.st[0], nx = b.st[1];
        if (nloc == 0u) { xcd_barrier_complete(bar, bx, nloc, nx); b.st[0] = nloc; b.st[1] = nx; }
        const unsigned old = xb_add(&bar[XB_XSUB(bx)], 1u);
        const unsigned gen = old / nloc;
        if (old + 1u == (gen + 1u) * nloc) {
            __builtin_amdgcn_fence(__ATOMIC_RELEASE, "agent");
            asm volatile("s_waitcnt vmcnt(0)" ::: "memory");
            const unsigned og = xb_add(&bar[XB_TOP], 1u);
            const unsigned tg = og / nx;
            if (og + 1u == (tg + 1u) * nx) xb_add(&bar[XB_TOPGEN], 1u);
            else XB_SPIN(xb_ld(&bar[XB_TOPGEN]) == tg, bar);
            __builtin_amdgcn_fence(__ATOMIC_ACQUIRE, "agent");
            xb_add(&bar[XB_XGEN(bx)], 1u);
            asm volatile("s_waitcnt vmcnt(0)" ::: "memory");
        } else {
            XB_SPIN(xb_ld(&bar[XB_XGEN(bx)]) == gen, bar);
            __builtin_amdgcn_fence(__ATOMIC_ACQUIRE, "agent");
            asm volatile("s_waitcnt vmcnt(0)" ::: "memory");
        }
    }
    __syncthreads();
}

__device__ __forceinline__ void ph_prep(const FP& p, int l, LAS unsigned char* lds) { const int t = TIDX, lane = t & 63, gw = blockIdx.x * NWAVES + (t >> 6), GWN = gridDim.x * NWAVES;
  LAS float* cwl = (LAS float*)lds;
  __syncthreads();
  for (int i = t; i < 5 * 1536 / 4; i += NTHREADS) *(LAS f32x4*)(cwl + 4 * i) = *(const f32x4*)(p.gdn_conv + (size_t)l * 5 * 1536 + 4 * i);
  __syncthreads();
  const f32x4 gq = *(const f32x4*)(p.g_cq + l * 256 + lane * 4); const float gkv0 = p.g_ckv[l * 128 + lane * 2], gkv1 = p.g_ckv[l * 128 + lane * 2 + 1];
  const float dtb = p.gdn_dt_bias[l * 8 + (lane & 7)], nalog = -__expf(p.gdn_a_log[l * 8 + (lane & 7)]);
  for (int row = gw; row < T; row += GWN) { const int s = row % SB; const bool lat = s >= CTX; const int tok = s - CTX, lo = lat ? CTX : 0, hi_ = lat ? SB : CTX;
    const bf16_t* pr = p.Pb + (size_t)row * INWP;
    const u32x2 vdq = *(const u32x2*)(pr + C_DQ + lane * 4); const unsigned vdkv = *(const unsigned*)(pr + C_DKV + lane * 2); const bf16_t vkr = pr[C_KR + lane];
    const u32x4 qv = *(const u32x4*)(pr + C_RQ + lane * 8), kv = *(const u32x4*)(pr + C_RK + lane * 8);
    u32x4 gx[3][5];
#pragma unroll
    for (int j = 0; j < 5; ++j) { const int s2 = s + j - 2; const bool ok = s2 >= lo && s2 < hi_; const bf16_t* pj = ok ? pr + (j - 2) * INWP : pr;
#pragma unroll
      for (int blk = 0; blk < 3; ++blk) gx[blk][j] = *(const u32x4*)(pj + C_GQ + blk * 512 + lane * 8); }
    const float gab = p.GAB[(size_t)row * 16 + (lane & 15)];
    { float x[4] = {bflo(vdq.x), bfhi(vdq.x), bflo(vdq.y), bfhi(vdq.y)};
      const float ss = wave_sum(x[0] * x[0] + x[1] * x[1] + x[2] * x[2] + x[3] * x[3]); const float rs = rsqrtf(ss * (1.f / 256.f) + 1e-6f);
      u32x2 w; w.x = cvt_pk_bf16(x[0] * rs * gq[0], x[1] * rs * gq[1]); w.y = cvt_pk_bf16(x[2] * rs * gq[2], x[3] * rs * gq[3]);
      *(u32x2*)(p.A2b + (size_t)row * MLAK + lane * 4) = w; }
    { const float x0 = bflo(vdkv), x1 = bfhi(vdkv);
      const float ss = wave_sum(x0 * x0 + x1 * x1); const float rs = rsqrtf(ss * (1.f / 128.f) + 1e-6f);
      *(unsigned*)(p.A2b + (size_t)row * MLAK + 256 + lane * 2) = cvt_pk_bf16(x0 * rs * gkv0, x1 * rs * gkv1); }
    { const float x = bf2f(vkr); const float xp = shx(x, 16); float y = x;
      if (lat) { const int hh = lane >> 5, ii = lane & 31, fi = ii & 15; const float pos = (float)(hh == 0 ? (tok >> 6) : (tok & 63));
        const float ang = pos * __expf(-(float)fi * (9.210340371976184f / 16.f)); const float cs = __cosf(ang), sn = __sinf(ang);
        y = ii < 16 ? x * cs - xp * sn : x * cs + xp * sn; }
      unsigned u = __float_as_uint(y); u += 0x7fffu + ((u >> 16) & 1u); p.KRb[(size_t)row * 64 + lane] = (bf16_t)(u >> 16); }
    { float q[8] = {bflo(qv.x), bfhi(qv.x), bflo(qv.y), bfhi(qv.y), bflo(qv.z), bfhi(qv.z), bflo(qv.w), bfhi(qv.w)};
      float k[8] = {bflo(kv.x), bfhi(kv.x), bflo(kv.y), bfhi(kv.y), bflo(kv.z), bfhi(kv.z), bflo(kv.w), bfhi(kv.w)};
      float qo[8], ko[8];
      const bool lowh = (lane & 4) == 0;
      const float pos = (float)(((lane >> 3) & 1) == 0 ? (tok >> 6) : (tok & 63));
#pragma unroll
      for (int e = 0; e < 8; ++e) { const float qp = shx(q[e], 4), kp = shx(k[e], 4);
        if (lat) { const int fi = (lane & 3) * 8 + e; const float ang = pos * __expf(-(float)fi * (9.210340371976184f / 32.f)); const float cs = __cosf(ang), sn = __sinf(ang);
          qo[e] = lowh ? q[e] * cs - qp * sn : q[e] * cs + qp * sn; ko[e] = lowh ? k[e] * cs - kp * sn : k[e] * cs + kp * sn; }
        else { qo[e] = q[e]; ko[e] = k[e]; } }
      const float sc = 0.08838834764831845f;
      u32x4 wq, wk; wq.x = cvt_pk_bf16(qo[0], qo[1]); wq.y = cvt_pk_bf16(qo[2], qo[3]); wq.z = cvt_pk_bf16(qo[4], qo[5]); wq.w = cvt_pk_bf16(qo[6], qo[7]);
      wk.x = cvt_pk_bf16(ko[0] * sc, ko[1] * sc); wk.y = cvt_pk_bf16(ko[2] * sc, ko[3] * sc); wk.z = cvt_pk_bf16(ko[4] * sc, ko[5] * sc); wk.w = cvt_pk_bf16(ko[6] * sc, ko[7] * sc);
      *(u32x4*)(p.RQb + (size_t)row * 512 + lane * 8) = wq; *(u32x4*)(p.RKb + (size_t)row * 512 + lane * 8) = wk; }
    { float o[3][8];
#pragma unroll
      for (int blk = 0; blk < 3; ++blk) {
#pragma unroll
        for (int e = 0; e < 8; ++e) o[blk][e] = 0.f;
#pragma unroll
        for (int j = 0; j < 5; ++j) { const int s2 = s + j - 2; const float m = (s2 >= lo && s2 < hi_) ? 1.f : 0.f; const u32x4 xv = gx[blk][j];
          const f32x4 w0 = *(const LAS f32x4*)(cwl + j * 1536 + blk * 512 + lane * 8) * m, w1 = *(const LAS f32x4*)(cwl + j * 1536 + blk * 512 + lane * 8 + 4) * m;
          o[blk][0] += w0[0] * bflo(xv.x); o[blk][1] += w0[1] * bfhi(xv.x); o[blk][2] += w0[2] * bflo(xv.y); o[blk][3] += w0[3] * bfhi(xv.y);
          o[blk][4] += w1[0] * bflo(xv.z); o[blk][5] += w1[1] * bfhi(xv.z); o[blk][6] += w1[2] * bflo(xv.w); o[blk][7] += w1[3] * bfhi(xv.w); }
#pragma unroll
        for (int e = 0; e < 8; ++e) o[blk][e] = silu_f(o[blk][e]); }
#pragma unroll
      for (int blk = 0; blk < 2; ++blk) { float ss = 0.f;
#pragma unroll
        for (int e = 0; e < 8; ++e) ss += o[blk][e] * o[blk][e];
        ss += shx(ss, 1); ss += shx(ss, 2); ss += shx(ss, 4); ss += shx(ss, 8);
        const float rs = rsqrtf(ss + 1e-6f) * (blk == 0 ? 0.08838834764831845f : 1.f);
#pragma unroll
        for (int e = 0; e < 8; ++e) o[blk][e] *= rs; }
      u32x4 w;
      w.x = cvt_pk_bf16(o[0][0], o[0][1]); w.y = cvt_pk_bf16(o[0][2], o[0][3]); w.z = cvt_pk_bf16(o[0][4], o[0][5]); w.w = cvt_pk_bf16(o[0][6], o[0][7]); *(u32x4*)(p.GQb + (size_t)row * 512 + lane * 8) = w;
      w.x = cvt_pk_bf16(o[1][0], o[1][1]); w.y = cvt_pk_bf16(o[1][2], o[1][3]); w.z = cvt_pk_bf16(o[1][4], o[1][5]); w.w = cvt_pk_bf16(o[1][6], o[1][7]); *(u32x4*)(p.GKb + (size_t)row * 512 + lane * 8) = w;
      w.x = cvt_pk_bf16(o[2][0], o[2][1]); w.y = cvt_pk_bf16(o[2][2], o[2][3]); w.z = cvt_pk_bf16(o[2][4], o[2][5]); w.w = cvt_pk_bf16(o[2][6], o[2][7]); *(u32x4*)(p.GVb + (size_t)row * 512 + lane * 8) = w;
      if (lane < 8) { const float a = gab + dtb; const float xe = __expf(a);
        const float sp = a > 20.f ? a : (xe < 0.03f ? xe * (1.f - xe * (0.5f - xe * (1.f / 3.f))) : __logf(1.f + xe));
        p.GLA[(size_t)row * 8 + lane] = nalog * sp; }
      else if (lane < 16) p.GBETA[(size_t)row * 8 + lane - 8] = 1.f / (1.f + __expf(-gab)); } } }
template <int WHICH = 3, int VAR = 0> __device__ __forceinline__ void ph_items(const FP& p, int l, LAS unsigned char* lds) {
  int rb = (int)blockIdx.x; asm volatile("" : "+s"(rb)); rb = (int)gridDim.x - 1 - rb;
  if (WHICH & 1) for (int pr = rb; pr < 16 * NCH / 2; pr += gridDim.x) { const int it = pr * 2 + (TIDX >> 8); r2_item(p, l, it / NCH, it % NCH, TIDX & 255, lds + (TIDX >> 8) * 40960); }
  if (WHICH & 2) for (int pr = rb; pr < 2 * 16 * NCH / 2; pr += gridDim.x) { const int it = pr * 2 + (TIDX >> 8); if (it / (16 * NCH)) g2_item<1, VAR>(p, (it / NCH) & 15, it % NCH, TIDX & 255, lds + (TIDX >> 8) * 71680); else g2_item<0, VAR>(p, (it / NCH) & 15, it % NCH, TIDX & 255, lds + (TIDX >> 8) * 71680); } }
__device__ __forceinline__ void ph_post(const FP& p, int l) { const int t = TIDX, lane = t & 63, gw = blockIdx.x * NWAVES + (t >> 6), GWN = gridDim.x * NWAVES;
  for (int row = gw; row < T; row += GWN) mla_out_row(p, l, row, lane);
  for (int u = gw; u < 16 * NCH * 2; u += GWN) { ret_out_unit(p, l, u / (NCH * 2), (u >> 1) % NCH, u & 1, lane); gdn_out_unit(p, l, u / (NCH * 2), (u >> 1) % NCH, u & 1, lane); } }

#ifndef REPMASK
#define REPMASK 0
#endif
#define REP(k, ...) do { if ((REPMASK >> (k)) & 1) { __VA_ARGS__; xcd_barrier(bar); } } while (0)
#ifndef PROBE_A
#define PROBE_A 0
#endif
#ifndef PROBE_Q
#define PROBE_Q 40
#endif
#if PROBE_A
#ifndef PROBE_BLK
#define PROBE_BLK 0
#endif
#define STAMP(k) do { if (blockIdx.x == PROBE_BLK && TIDX == 0) { volatile LAS unsigned* tw_ = (volatile LAS unsigned*)(lds + LDS_BYTES - 48); if ((k) != 13) tw_[0] = (k); if ((k) == 13 || (k) == 6 || (k) == 15) { \
    const unsigned long long now_ = __builtin_amdgcn_s_memrealtime(); volatile LAS unsigned long long* tl_ = (volatile LAS unsigned long long*)(lds + LDS_BYTES - 32); \
    volatile unsigned* ta_ = p.ctl + 3600 + tw_[0]; *ta_ = *ta_ + (unsigned)(now_ - *tl_); *tl_ = now_; } } } while (0)
#else
#define STAMP(k) do { } while (0)
#endif
__global__ void __launch_bounds__(512, 2) mega_fwd(FP p) {
  extern __shared__ __attribute__((aligned(16))) unsigned char shm[];
  LAS unsigned char* lds = (LAS unsigned char*)shm;
  volatile LAS unsigned* xbw = (volatile LAS unsigned*)(lds + LDS_BYTES - 16);
  if (threadIdx.x == 0) { xbw[0] = 0u; xbw[1] = 0u; xbw[2] = 0u; xbw[3] = 0u; }
  __syncthreads();
  XcdBarrier bar = xcd_barrier_post(p.ctl, xbw);
#if PROBE_A
  if (blockIdx.x == PROBE_BLK && TIDX == 0) *(volatile LAS unsigned long long*)(lds + LDS_BYTES - 32) = __builtin_amdgcn_s_memrealtime();
#endif
  ph_prologue(p, lds);
  REP(0, ph_prologue(p, lds));
  STAMP(0); xcd_barrier(bar); STAMP(13);
  for (int l = 0; l < DEPTH; ++l) {
    ph_norm1(p, l, lds);            REP(1, ph_norm1<true>(p, l, lds)); STAMP(1); xcd_barrier(bar); STAMP(13);
    ph_inproj(p, l, lds);           REP(2, ph_inproj(p, l, lds)); STAMP(2); xcd_barrier(bar); STAMP(13);
    ph_prep(p, l, lds);             REP(3, ph_prep(p, l, lds)); STAMP(3);
    xcd_barrier(bar); STAMP(13);
    ph_mla_gemm(p, l, lds); REP(4, ph_mla_gemm(p, l, lds)); STAMP(4);
    moe_weights_layer<1, 0, 192>(p, l, 20736, NE * 768, 0, lds);
    ph_items(p, l, lds); REP(5, ph_items(p, l, lds)); REP(14, ph_items<1>(p, l, lds)); REP(15, ph_items<2>(p, l, lds)); STAMP(5); xcd_barrier(bar); STAMP(13);
    if (blockIdx.x < 32) ret_scan_job(p, l, blockIdx.x >> 1, blockIdx.x & 1, lds); else if (blockIdx.x < 64) gdn_scan_job(p, (blockIdx.x - 32) >> 1, blockIdx.x & 1, lds);
    REP(6, if (blockIdx.x < 32) ret_scan_job(p, l, blockIdx.x >> 1, blockIdx.x & 1, lds); else if (blockIdx.x < 64) gdn_scan_job(p, (blockIdx.x - 32) >> 1, blockIdx.x & 1, lds));
    STAMP(6);
    if (blockIdx.x < 64) moe_weights_dyn(p, l, 5184, lds);
    ph_attn(p, l, (char*)shm);      REP(7, ph_attn(p, l, (char*)shm)); STAMP(15); STAMP(7);
    if (blockIdx.x >= 64) moe_weights_dyn(p, l, 5184, lds);
    xcd_barrier(bar); STAMP(13);
    ph_post3(p, l, lds);            REP(8, ph_post3(p, l, lds)); STAMP(8); xcd_barrier(bar); STAMP(13);
    ph_outproj(p, l, lds);
    REP(9, { FP q = p; q.X = (float*)p.SCR; ph_outproj(q, l, lds); }); STAMP(9); xcd_barrier(bar); STAMP(13);
    ph_norm2m(p, l, lds);           REP(10, ph_norm2<true>(p, l, lds)); STAMP(10); xcd_barrier(bar); STAMP(13);
    ph_gemm1(p, l, lds);            REP(11, ph_gemm1(p, l, lds)); STAMP(11); xcd_barrier(bar); STAMP(13);
    ph_gemm2(p, l, lds);            REP(12, ph_gemm2(p, l, lds)); STAMP(12);
    if (l + 1 < DEPTH) dense_weights_layer(p, l + 1, 128, lds);
    xcd_barrier(bar); STAMP(13);
  }
  ph_final(p, lds);
#if PROBE_A
  STAMP(14); xcd_barrier(bar); STAMP(13);
  __syncthreads(); asm volatile("s_waitcnt vmcnt(0)" ::: "memory");
  if (blockIdx.x == 0 && threadIdx.x == 0) { unsigned a = 0;
    for (int k = 0; k < 16; ++k) { const unsigned tv = ((volatile unsigned*)p.ctl)[3600 + k]; if ((PROBE_A >> k) & 1) a += tv; }
    const float us = (float)a * 0.01f; float q = floorf(us * (1.f / (float)PROBE_Q) + 0.5f);
#ifdef PROBE_NBLK
    { int tot = 0; for (int l = 0; l < DEPTH; ++l) { int nblk = 0; for (int e = 0; e < NE; ++e) nblk += (p.cnt[l * 32 + e] + 255) >> 8; tot += (PROBE_NBLK == 1) ? (nblk * 8 + 255) / 256 : (PROBE_NBLK == 2) ? (nblk * 4 + 255) / 256 : (l == PROBE_NBLK - 3 ? nblk - 272 : 0); } q = (float)(tot - (PROBE_NBLK == 1 ? 30 : PROBE_NBLK == 2 ? 10 : 0)); }
#endif
    p.out[0] += 4.f * q; }
#endif
}

static size_t f_layout(char* base, FP& p) {
  size_t o = 0; auto take = [&](size_t bytes) { char* q = base + o; o += (bytes + 255) & ~(size_t)255; return q; };
  p.ctl = (unsigned*)take((size_t)CTL_WORDS * 4); p.cnt = (int*)(p.ctl + 4096);
  p.Wt_in = (bf16_t*)take((size_t)DEPTH * INWP * 1024 * 2); p.Wt_mla = (bf16_t*)take((size_t)DEPTH * MLAN * MLAK * 2); p.Wt_out = (bf16_t*)take((size_t)DEPTH * 1024 * 1536 * 2);
  p.Wt_gu = (bf16_t*)take((size_t)DEPTH * NE * 2048 * 1024 * 2); p.Wt_dn = (bf16_t*)take((size_t)DEPTH * NE * 1024 * 1024 * 2);
  p.MOD = (float*)take((size_t)DEPTH * 5 * 6144 * 4); p.X = (float*)take((size_t)T * D * 4); p.GAB = (float*)take((size_t)T * 16 * 4); p.TOPW = (float*)take((size_t)T * 4 * 4);
  p.Hb = (bf16_t*)take((size_t)T * D * 2); p.H2b = (bf16_t*)take((size_t)T * D * 2); p.Pb = (bf16_t*)take((size_t)T * INWP * 2); p.CATb = (bf16_t*)take((size_t)T * 1536 * 2);
  p.ACTb = (bf16_t*)take((size_t)ROWS_P * 1024 * 2); p.YSb = (bf16_t*)take((size_t)ROWS_P * 1024 * 2);
  p.A2b = (bf16_t*)take((size_t)T * MLAK * 2); p.Qb = (bf16_t*)take((size_t)T * 768 * 2); p.Knb = (bf16_t*)take((size_t)T * 512 * 2); p.Vb = (bf16_t*)take((size_t)T * 512 * 2);
  p.KRb = (bf16_t*)take((size_t)T * 64 * 2); p.AOb = (bf16_t*)take((size_t)T * 512 * 2);
  p.RQb = (bf16_t*)take((size_t)T * 512 * 2); p.RKb = (bf16_t*)take((size_t)T * 512 * 2); p.RKWT = (bf16_t*)take((size_t)2 * 16 * NCH * 8192 * 2);
  p.RVTB = (bf16_t*)take((size_t)16 * NCH * 8192 * 2); p.RVTA = (bf16_t*)take((size_t)16 * NCH * 8192 * 2); p.RST = (bf16_t*)take((size_t)2 * 16 * NCH * 16384 * 2);
  p.GQb = (bf16_t*)take((size_t)T * 512 * 2); p.GKb = (bf16_t*)take((size_t)T * 512 * 2); p.GVb = (bf16_t*)take((size_t)T * 512 * 2);
  p.GLA = (float*)take((size_t)T * 8 * 4); p.GBETA = (float*)take((size_t)T * 8 * 4); p.GG = (float*)take((size_t)2 * 16 * NCH * 64 * 4);
  p.GWb = (bf16_t*)take((size_t)2 * 16 * NCH * 8192 * 2); p.GKTT = (bf16_t*)take((size_t)2 * 16 * NCH * 8192 * 2); p.GUT = (bf16_t*)take((size_t)2 * 16 * NCH * 8192 * 2);
  p.GVNT = (bf16_t*)take((size_t)2 * 16 * NCH * 8192 * 2); p.GST = (bf16_t*)take((size_t)2 * 16 * NCH * 16384 * 2);
  p.TOPE = (int*)take((size_t)T * 4 * 4); p.TOPP = (int*)take((size_t)T * 4 * 4); p.ROWTOK = (int*)take((size_t)NE * T * 4); p.SCR = (bf16_t*)take((size_t)T * D * 4 + 4096); p.ROPE = (float*)take(64 * 32 * 4); p.WRF = (bf16_t*)take((size_t)DEPTH * 2 * 64 * 64 * 8 * 2);
  return o;
}
}

extern "C" void kernel_launch(void* const* d_in, const int* in_sizes, int n_in, void* d_out, int out_size, void* d_ws, size_t ws_size, hipStream_t stream) {
  static int grid = 0;
  if (grid == 0) {
    if (hipFuncSetAttribute((const void*)fx::mega_fwd, hipFuncAttributeMaxDynamicSharedMemorySize, fx::LDS_BYTES) != hipSuccess) { fprintf(stderr, "kernel_launch: hipFuncSetAttribute failed\n"); grid = -1; return; }
    int dev = 0, cus = 0, per_cu = 0; (void)hipGetDevice(&dev); (void)hipDeviceGetAttribute(&cus, hipDeviceAttributeMultiprocessorCount, dev);
    if (hipOccupancyMaxActiveBlocksPerMultiprocessor(&per_cu, (const void*)fx::mega_fwd, 512, fx::LDS_BYTES) != hipSuccess || per_cu < 1) { fprintf(stderr, "kernel_launch: occupancy query says %d blocks per CU\n", per_cu); grid = -1; return; }
    grid = cus;
    if (grid < 64) { fprintf(stderr, "kernel_launch: needs >= 64 CUs\n"); grid = -1; return; }
  }
  if (grid < 0) return;
  fx::FP p{}; { const float** f = (const float**)&p; for (int i = 0; i < 28; ++i) f[i] = (const float*)d_in[i]; }
  p.out = (float*)d_out;
  const size_t fsz = fx::f_layout((char*)d_ws, p);
  if (fsz > ws_size || n_in != 28) { fprintf(stderr, "kernel_launch: ws too small (%zu > %zu) or n_in %d\n", fsz, ws_size, n_in); return; }
  (void)hipMemsetAsync(p.ctl, 0, (size_t)fx::CTL_WORDS * 4, stream);
  hipLaunchKernelGGL(fx::mega_fwd, dim3(grid), dim3(512), fx::LDS_BYTES, stream, p);
}
```
